# Optimizing an MI355X kernel written in HIP

```python
import functools
import jax
import jax.numpy as jnp
from jax import lax
import numpy as np

D_MODEL = 1024
BATCH = 16
SEQ = 4096
DEPTH = 1

GRID_W = 64
CTX_LEN = 256
D_MIX = D_MODEL
GLA_WIDTH = D_MIX // 2
GLA_HEADS = 4
GLA_DV = GLA_WIDTH // GLA_HEADS
GLA_DK = GLA_DV // 2
GLA_QK = GLA_HEADS * GLA_DK
GATE_RANK = 16
GATE_NORMALIZER = 16.0
CHUNK = 64
CONV_WIDTH = D_MIX - GLA_WIDTH
CONV_K = 3
N_EXPERTS = 32
TOP_K = 4
D_FF = D_MODEL
SWIGLU_LIMIT = 7.0
SWIGLU_ALPHA = 1.702
MOE_BLOCK = 256
EPS = 1e-6

Q_END = GLA_QK
K_END = Q_END + GLA_QK
V_END = K_END + GLA_WIDTH
R_END = V_END + GLA_WIDTH
AF_END = R_END + GATE_RANK
AB_END = AF_END + GATE_RANK
B_END = AB_END + CONV_WIDTH
C_END = B_END + CONV_WIDTH
PROJ_WIDTH = C_END + CONV_WIDTH
PROJ_SPLITS = (Q_END, K_END, V_END, R_END, AF_END, AB_END, B_END, C_END)

kernel_name = 'hybrid_gla_shortconv_moe_dit'


def rms_norm(x, w):
    x32 = x.astype(jnp.float32)
    y = x32 * lax.rsqrt(jnp.mean(x32 * x32, axis=-1, keepdims=True) + EPS)
    return (y * w.astype(jnp.float32)).astype(x.dtype)


def modulate(x, shift, scale):
    return x * (1.0 + scale[:, None, :]) + shift[:, None, :]


def rev(t):
    return jnp.flip(t, axis=1)


def heads(t, d):
    bsz, length, _ = t.shape
    return t.reshape(bsz, length, GLA_HEADS, d).astype(jnp.float32)


def zero_state(bsz):
    return jnp.zeros((bsz, GLA_HEADS, GLA_DK, GLA_DV), jnp.float32)


def log_forget_gate(z_low, up, bias):
    bsz, length, _ = z_low.shape
    z = (z_low @ up + bias).astype(jnp.float32)
    return (jax.nn.log_sigmoid(z) / GATE_NORMALIZER).reshape(bsz, length, GLA_HEADS, GLA_DK)


def to_chunks(t):
    bsz, length, nh, d = t.shape
    return t.reshape(bsz, length // CHUNK, CHUNK, nh, d)


def gla_states(k, v, log_a, s0):
    k, v, log_a = to_chunks(k), to_chunks(v), to_chunks(log_a)
    b = jnp.cumsum(log_a, axis=2)
    b_end = b[:, :, -1]
    k_to_end = k * jnp.exp(b_end[:, :, None] - b)
    chunk_kv = jnp.einsum('bnshd,bnshv->bnhdv', k_to_end, v)
    decay = jnp.exp(b_end)

    def step(s, inp):
        dec, kv = inp
        return dec[..., None] * s + kv, s

    s_final, s_start = lax.scan(step, s0, (jnp.moveaxis(decay, 1, 0), jnp.moveaxis(chunk_kv, 1, 0)))
    return b, jnp.moveaxis(s_start, 0, 1), s_final


def gla_direction(q, k, v, log_a, s0):
    bsz, length = q.shape[:2]
    b, s_start, s_final = gla_states(k, v, log_a, s0)
    qc, kc, vc = to_chunks(q), to_chunks(k), to_chunks(v)
    q_dec = qc * jnp.exp(b)
    k_inv = kc * jnp.exp(-b)
    within = jnp.tril(jnp.ones((CHUNK, CHUNK), dtype=bool))
    scores = jnp.where(within, jnp.einsum('bnthd,bnshd->bnhts', q_dec, k_inv), 0.0)
    intra = jnp.einsum('bnhts,bnshv->bnthv', scores, vc)
    inter = jnp.einsum('bnthd,bnhdv->bnthv', q_dec, s_start)
    return (intra + inter).reshape(bsz, length, GLA_HEADS, GLA_DV), s_final


def gla_mixer(pq, pk, pv, pr, paf, pab, a_up_f, a_bias_f, a_up_b, a_bias_b, gla_norm_w, s0_f, s0_b):
    bsz, length = pq.shape[:2]
    q = heads(pq, GLA_DK) * (GLA_DK ** -0.5)
    k = heads(pk, GLA_DK)
    v = heads(pv, GLA_DV)
    la_f = log_forget_gate(paf, a_up_f, a_bias_f)
    la_b = log_forget_gate(pab, a_up_b, a_bias_b)
    o_f, s_f = gla_direction(q, k, v, la_f, s0_f)
    o_b, s_b = gla_direction(rev(q), rev(k), rev(v), rev(la_b), s0_b)
    o = rms_norm(o_f + rev(o_b), gla_norm_w)
    y = o.reshape(bsz, length, GLA_WIDTH) * jax.nn.silu(pr.astype(jnp.float32))
    return y.astype(pr.dtype), s_f, s_b


def depthwise_conv(u, w):
    return lax.conv_general_dilated(
        u, w[:, None, :].astype(u.dtype), window_strides=(1,), padding='SAME',
        dimension_numbers=('NWC', 'WIO', 'NWC'), feature_group_count=u.shape[-1])


def conv_rows(u, w, rows):
    bsz, length, ch = u.shape
    return depthwise_conv(u.reshape(bsz * rows, GRID_W, ch), w).reshape(bsz, length, ch)


def token_mixer(hn, conv_fn, s0_f, s0_b, w_in, a_up_f, a_bias_f, a_up_b, a_bias_b, gla_norm_w, conv_w, w_out):
    p = hn @ w_in
    pq, pk, pv, pr, paf, pab, p_b, p_c, p_x = jnp.split(p, PROJ_SPLITS, axis=-1)
    y_gla, s_f, s_b = gla_mixer(pq, pk, pv, pr, paf, pab, a_up_f, a_bias_f, a_up_b, a_bias_b,
                                gla_norm_w, s0_f, s0_b)
    y_conv = p_b * conv_fn(p_c * p_x, conv_w)
    y = jnp.concatenate([y_gla, y_conv], axis=-1) @ w_out
    return y, s_f, s_b


def context_states(hn, w_in, a_up_f, a_bias_f, a_up_b, a_bias_b):
    k = heads(hn @ w_in[:, Q_END:K_END], GLA_DK)
    v = heads(hn @ w_in[:, K_END:V_END], GLA_DV)
    la_f = log_forget_gate(hn @ w_in[:, R_END:AF_END], a_up_f, a_bias_f)
    la_b = log_forget_gate(hn @ w_in[:, AF_END:AB_END], a_up_b, a_bias_b)
    s0 = zero_state(hn.shape[0])
    s_f = gla_states(k, v, la_f, s0)[2]
    s_b = gla_states(rev(k), rev(v), rev(la_b), s0)[2]
    return s_f, s_b


def channel_mixer(hn, router_w, router_b, w_gu, b_gu, w_dn, b_dn):
    bsz, length, d = hn.shape
    xt = hn.reshape(-1, d)
    n_tok = xt.shape[0]
    logits = (xt @ router_w + router_b).astype(jnp.float32)
    top_val, top_idx = lax.top_k(logits, TOP_K)
    weights = jax.nn.softmax(top_val, axis=-1).astype(hn.dtype)
    flat_e = top_idx.reshape(-1)
    n_assign = n_tok * TOP_K
    order = jnp.argsort(flat_e)
    sorted_e = flat_e[order]
    sorted_tok = (order // TOP_K).astype(jnp.int32)
    sorted_w = weights.reshape(-1)[order]
    counts = jnp.bincount(flat_e, length=N_EXPERTS)
    padded = (counts + MOE_BLOCK - 1) // MOE_BLOCK * MOE_BLOCK
    pad_end = jnp.cumsum(padded)
    pad_start = pad_end - padded
    grp_start = jnp.cumsum(counts) - counts
    slot = pad_start[sorted_e] + (jnp.arange(n_assign) - grp_start[sorted_e])
    n_blocks = -(-n_assign // MOE_BLOCK) + N_EXPERTS
    n_slots = n_blocks * MOE_BLOCK
    slot_tok = jnp.full((n_slots,), n_tok, jnp.int32).at[slot].set(sorted_tok)
    slot_w = jnp.zeros((n_slots,), hn.dtype).at[slot].set(sorted_w)
    block_e = jnp.minimum(jnp.searchsorted(pad_end, jnp.arange(n_blocks) * MOE_BLOCK, side='right'),
                          N_EXPERTS - 1)
    x_pad = jnp.concatenate([xt, jnp.zeros((1, d), xt.dtype)], axis=0)

    def expert_block(args):
        tok, e = args
        gu = x_pad[tok] @ w_gu[e] + b_gu[e]
        gate = jnp.minimum(gu[:, 0::2], SWIGLU_LIMIT)
        up = jnp.clip(gu[:, 1::2], -SWIGLU_LIMIT, SWIGLU_LIMIT)
        act = (up + 1.0) * (gate * jax.nn.sigmoid(SWIGLU_ALPHA * gate))
        return act @ w_dn[e] + b_dn[e]

    y_slots = lax.map(expert_block, (slot_tok.reshape(n_blocks, MOE_BLOCK), block_e))
    y = jnp.zeros((n_tok + 1, d), hn.dtype).at[slot_tok].add(y_slots.reshape(n_slots, d) * slot_w[:, None])
    return y[:n_tok].reshape(bsz, length, d)


def setup_inputs(seed: int = 0) -> dict:
    key = jax.random.key(seed)
    ks = jax.random.split(key, 23)

    def nrm(k, shape, scale):
        return jax.random.normal(k, shape, jnp.float32) * scale

    return {
        'x': nrm(ks[0], (BATCH, SEQ, D_MODEL), 1.0),
        'c': nrm(ks[1], (BATCH, D_MODEL), 1.0),
        'ctx': nrm(ks[2], (BATCH, CTX_LEN, D_MODEL), 1.0),
        'c_ctx': nrm(ks[3], (D_MODEL,), 1.0),
        'w_ada': nrm(ks[4], (DEPTH, D_MODEL, 6 * D_MODEL), D_MODEL ** -0.5),
        'b_ada': nrm(ks[5], (DEPTH, 6 * D_MODEL), 0.01),
        'norm1_w': 1.0 + nrm(ks[6], (DEPTH, D_MODEL), 0.02),
        'w_in': nrm(ks[7], (DEPTH, D_MODEL, PROJ_WIDTH), D_MODEL ** -0.5),
        'a_up_f': nrm(ks[8], (DEPTH, GATE_RANK, GLA_QK), GATE_RANK ** -0.5),
        'a_bias_f': nrm(ks[9], (DEPTH, GLA_QK), 0.5),
        'a_up_b': nrm(ks[10], (DEPTH, GATE_RANK, GLA_QK), GATE_RANK ** -0.5),
        'a_bias_b': nrm(ks[11], (DEPTH, GLA_QK), 0.5),
        'gla_norm_w': 1.0 + nrm(ks[12], (DEPTH, GLA_DV), 0.02),
        'conv_w': nrm(ks[13], (DEPTH, CONV_K, CONV_WIDTH), CONV_K ** -0.5),
        'w_out': nrm(ks[14], (DEPTH, D_MIX, D_MODEL), D_MIX ** -0.5),
        'norm2_w': 1.0 + nrm(ks[15], (DEPTH, D_MODEL), 0.02),
        'router_w': nrm(ks[16], (DEPTH, D_MODEL, N_EXPERTS), D_MODEL ** -0.5),
        'router_b': nrm(ks[17], (DEPTH, N_EXPERTS), 0.01),
        'w_gu': nrm(ks[18], (DEPTH, N_EXPERTS, D_MODEL, 2 * D_FF), D_MODEL ** -0.5),
        'b_gu': nrm(ks[19], (DEPTH, N_EXPERTS, 2 * D_FF), 0.01),
        'w_dn': nrm(ks[20], (DEPTH, N_EXPERTS, D_FF, D_MODEL), D_FF ** -0.5),
        'b_dn': nrm(ks[21], (DEPTH, N_EXPERTS, D_MODEL), 0.01),
        'final_norm_w': 1.0 + nrm(ks[22], (D_MODEL,), 0.02),
    }


def reference(x, c, ctx, c_ctx, w_ada, b_ada, norm1_w, w_in, a_up_f, a_bias_f, a_up_b, a_bias_b,
              gla_norm_w, conv_w, w_out, norm2_w, router_w, router_b, w_gu, b_gu, w_dn, b_dn,
              final_norm_w):
    rows = x.shape[1] // GRID_W
    latent_conv = functools.partial(conv_rows, rows=rows)
    h, h_ctx = x, ctx
    for l in range(DEPTH):
        mix_w = (w_in[l], a_up_f[l], a_bias_f[l], a_up_b[l], a_bias_b[l], gla_norm_w[l], conv_w[l], w_out[l])
        moe_w = (router_w[l], router_b[l], w_gu[l], b_gu[l], w_dn[l], b_dn[l])
        mod = jax.nn.silu(c) @ w_ada[l] + b_ada[l]
        mod_ctx = (jax.nn.silu(c_ctx) @ w_ada[l] + b_ada[l])[None]
        sh1, sc1, g1, sh2, sc2, g2 = jnp.split(mod, 6, axis=-1)
        csh1, csc1, cg1, csh2, csc2, cg2 = jnp.split(mod_ctx, 6, axis=-1)
        last = l == DEPTH - 1

        hn_ctx = modulate(rms_norm(h_ctx, norm1_w[l]), csh1, csc1)
        if last:
            s_f, s_b = context_states(hn_ctx, *mix_w[:5])
        else:
            zs = zero_state(h_ctx.shape[0])
            y_ctx, s_f, s_b = token_mixer(hn_ctx, depthwise_conv, zs, zs, *mix_w)

        hn = modulate(rms_norm(h, norm1_w[l]), sh1, sc1)
        y, _, _ = token_mixer(hn, latent_conv, s_f, s_b, *mix_w)
        h = h + g1[:, None, :] * y
        h = h + g2[:, None, :] * channel_mixer(modulate(rms_norm(h, norm2_w[l]), sh2, sc2), *moe_w)

        if not last:
            h_ctx = h_ctx + cg1[:, None, :] * y_ctx
            h_ctx = h_ctx + cg2[:, None, :] * channel_mixer(
                modulate(rms_norm(h_ctx, norm2_w[l]), csh2, csc2), *moe_w)
    return rms_norm(h, final_norm_w)
```

```cpp
#include <hip/hip_runtime.h>
#include <cstdio>
#include <cstdint>

#ifndef MK_N_LAUNCHES
#define MK_N_LAUNCHES 19
#endif

#define GAS __attribute__((address_space(1)))
#define LAS __attribute__((address_space(3)))
typedef unsigned short bf16;
typedef unsigned v4u __attribute__((ext_vector_type(4)));
typedef unsigned v2u __attribute__((ext_vector_type(2)));
typedef float f32x4 __attribute__((ext_vector_type(4)));
typedef float f32x2 __attribute__((ext_vector_type(2)));
typedef short bf16x8 __attribute__((ext_vector_type(8)));
typedef short s16x4 __attribute__((ext_vector_type(4)));
#define RLX_AGENT __ATOMIC_RELAXED, __HIP_MEMORY_SCOPE_AGENT
#define LDS_WAIT() asm volatile("s_waitcnt lgkmcnt(0)" ::: "memory")
#define VM_WAIT() asm volatile("s_waitcnt vmcnt(0)" ::: "memory")

__device__ __forceinline__ unsigned f2bf(float f) { unsigned u = __builtin_bit_cast(unsigned, f); return (u + 0x7fffu + ((u >> 16) & 1u)) >> 16; }
__device__ __forceinline__ unsigned pk2(float lo, float hi) { return f2bf(lo) | (f2bf(hi) << 16); }
__device__ __forceinline__ float bflo(unsigned w) { return __builtin_bit_cast(float, w << 16); }
__device__ __forceinline__ float bfhi(unsigned w) { return __builtin_bit_cast(float, w & 0xffff0000u); }
__device__ __forceinline__ float bf2f(bf16 b) { return __builtin_bit_cast(float, ((unsigned)b) << 16); }
__device__ __forceinline__ float fexp(float x) { return __builtin_amdgcn_exp2f(x * 1.4426950408889634f); }
__device__ __forceinline__ float wave_sum(float v) {
#pragma unroll
    for (int o = 1; o < 64; o <<= 1) v += __shfl_xor(v, o);
    return v;
}

constexpr int D = 1024, NBATCH = 16, SEQ = 4096, CTXL = 256;
constexpr int NLAT = NBATCH * SEQ;
constexpr int NCTXR = NBATCH * CTXL;
constexpr int NROWS = NLAT + NCTXR;
constexpr int PW = 3104, PWP = 3328;
constexpr int CQ = 0, CK = 256, CV = 512, CR = 1024, CAF = 1536, CAB = 1552, CPB = 1568, CPC = 2080, CPX = 2592;
constexpr int NCC = 68;
constexpr int NEXP = 32, DFF = 1024;
constexpr float EPS = 1e-6f;
constexpr int LISTCAP = 65536;
constexpr int RTILES = 256;
constexpr int MAXROUNDS = 5;

constexpr size_t MiB = 1u << 20;
constexpr size_t WS_CTL = 0, CTL_ZERO_BYTES = 1 * MiB;
constexpr size_t WS_MOD = 1 * MiB;
constexpr size_t WS_DECAY = 2 * MiB;
constexpr size_t WS_WIN = 6 * MiB;
constexpr size_t WS_WOUT = 13 * MiB;
constexpr size_t WS_WDN = 16 * MiB;
constexpr size_t WS_WGU = 80 * MiB;
constexpr size_t WS_HN = 208 * MiB;
constexpr size_t WS_KV = 208 * MiB;
constexpr size_t WS_HN2 = 208 * MiB;
constexpr size_t WS_LAID = 336 * MiB;
constexpr size_t WS_LW = 344 * MiB;
constexpr size_t WS_P = 344 * MiB;
constexpr size_t WS_S = 757 * MiB;
constexpr size_t WS_YMIX = 885 * MiB;
constexpr size_t WS_ACT = 352 * MiB;
constexpr size_t WS_YA = 480 * MiB;
constexpr size_t WS_END = 1013 * MiB;
static_assert(WS_P + (size_t)NROWS * PW * 2 <= WS_S && WS_YMIX + (size_t)NLAT * D * 2 <= WS_END && WS_YA + (size_t)NLAT * 4 * D * 2 <= WS_END, "ws map");
static_assert(WS_HN + (size_t)NROWS * D * 2 <= WS_P && WS_HN2 + (size_t)NLAT * D * 2 <= WS_LAID, "ws map 2");
constexpr int CW_CNT = 64;
constexpr int CW_BAR = 4096;

constexpr int RING_BYTES = 131072;
constexpr int MISC_OFF = RING_BYTES;
constexpr int LDS_BYTES = 147456;
constexpr int NWAVES = 8, NTHREADS = 512;

namespace pg8 {
constexpr int BM = 256, BK = 64, HALF = 128, HTB = HALF * BK * 2, STAGE_BYTES = 8 * HTB, KD = 1024, NT = KD / BK;
__host__ __device__ __forceinline__ int lds_byte(int r, int c) { const int st = (r >> 4) * 2 + (c >> 5), rr = r & 15, cc = c & 31, ob = rr * 64 + cc * 2; return st * 1024 + (ob ^ (((ob >> 9) & 1) << 5)); }
__host__ __device__ __forceinline__ void stage_rc(int b, int& R, int& C) { const int st = b / 1024, sb = b % 1024, swz = sb ^ (((sb >> 9) & 1) << 5); R = (st >> 1) * 16 + swz / 64; C = (st & 1) * 32 + (swz % 64) / 2; }
__host__ __device__ __forceinline__ int perm32(int rho) { const int n = rho >> 4, i = rho & 15; return 8 * (i >> 2) + 4 * n + (i & 3); }

struct Unit { int pm, pn, e, lt; };
__device__ __forceinline__ unsigned cvt_pk_bf16(float lo, float hi) { unsigned r; asm volatile("v_cvt_pk_bf16_f32 %0, %1, %2" : "=v"(r) : "v"(lo), "v"(hi)); return r; }

template <class Epi, class Sched, bool ALIGN_EPI>
__device__ __forceinline__ void gemm_phase(LAS unsigned char* lds, const char* Abase, const Sched& S, const Epi& E) {
    int tid_ = threadIdx.x; asm volatile("" : "+v"(tid_));
    const int tid = tid_, wid = __builtin_amdgcn_readfirstlane(tid >> 6), lane = tid & 63, wr = wid >> 2, wc = wid & 3, fr = lane & 15, fq = lane >> 4;
    int Rr[2]; unsigned coffA[2], voffB[2];
#pragma unroll
    for (int i = 0; i < 2; ++i) { int R, C; stage_rc(tid * 16 + i * 8192, R, C); const int Rb = Epi::PERM ? ((R & ~31) + perm32(R & 31)) : R;
        Rr[i] = R; coffA[i] = (unsigned)C * 2u; voffB[i] = (unsigned)(Rb * KD + C) * 2u; }
    const size_t kstep = (size_t)(BK * 2);
    const size_t hstep = (size_t)HALF * KD * 2;
    const unsigned ldsw = (unsigned)wid * 1024u;
    const int aoff = lds_byte(wr * 64 + fr, fq * 8), boff = lds_byte(wc * 32 + fr, fq * 8);
#define PG8_SA(b, h) (((b) * 2 + (h)) * HTB)
#define PG8_SB(b, h) ((4 + (b) * 2 + (h)) * HTB)
#define PG8_STAGE(bufoff, gbase, voff) do { _Pragma("unroll") for (int _i = 0; _i < 2; ++_i) \
        __builtin_amdgcn_global_load_lds((const unsigned*)((const char*)(gbase) + (voff)[_i]), (LAS unsigned*)(lds + (bufoff) + ldsw + _i * 8192), 16, 0, 0); } while (0)
#define PG8_LDA(dst, b, h) do { _Pragma("unroll") for (int m = 0; m < 4; ++m) _Pragma("unroll") for (int k = 0; k < 2; ++k) dst[m][k] = *(const LAS bf16x8*)(lds + PG8_SA(b, h) + aoff + m * 2048 + k * 1024); } while (0)
#define PG8_LDB(dst, b, h) do { _Pragma("unroll") for (int n = 0; n < 2; ++n) _Pragma("unroll") for (int k = 0; k < 2; ++k) dst[n][k] = *(const LAS bf16x8*)(lds + PG8_SB(b, h) + boff + n * 2048 + k * 1024); } while (0)
#define PG8_MMA(ai, bj, At, Bt) do { __builtin_amdgcn_s_setprio(1); _Pragma("unroll") for (int m = 0; m < 4; ++m) _Pragma("unroll") for (int n = 0; n < 2; ++n) _Pragma("unroll") for (int k = 0; k < 2; ++k) \
        acc[ai][bj][m][n] = __builtin_amdgcn_mfma_f32_16x16x32_bf16(Bt[n][k], At[m][k], acc[ai][bj][m][n], 0, 0, 0); __builtin_amdgcn_s_setprio(0); } while (0)
#define PG8_WAIT_V(n) asm volatile("s_waitcnt vmcnt(" #n ")" ::: "memory")
#define PG8_WAIT_L(n) asm volatile("s_waitcnt lgkmcnt(" #n ")" ::: "memory")
#define PG8_BAR __builtin_amdgcn_s_barrier()
#define PG8_SCHED __builtin_amdgcn_sched_barrier(0)
    Unit cur, nxt; int ui = 0;
    if (!S.next(0, cur)) return;
    f32x4 acc[2][2][4][2];
#pragma unroll
    for (int a = 0; a < 2; ++a)
#pragma unroll
        for (int b = 0; b < 2; ++b)
#pragma unroll
            for (int m = 0; m < 4; ++m)
#pragma unroll
                for (int n = 0; n < 2; ++n) acc[a][b][m][n] = (f32x4){0.f, 0.f, 0.f, 0.f};
    bf16x8 At[4][2], B0[2][2], B1[2][2];
    unsigned oC[2][2];
#pragma unroll
    for (int h = 0; h < 2; ++h)
#pragma unroll
        for (int i = 0; i < 2; ++i) oC[h][i] = (unsigned)S.arow(cur, h * HALF + Rr[i]) * (unsigned)(KD * 2) + coffA[i];
    const char* cB = S.bptr(cur);
    PG8_STAGE(PG8_SB(0, 0), cB, voffB); PG8_STAGE(PG8_SB(0, 1), cB + hstep, voffB); PG8_STAGE(PG8_SA(0, 0), Abase, oC[0]); PG8_STAGE(PG8_SA(0, 1), Abase, oC[1]);
    if (wr == 1) PG8_BAR;
    PG8_WAIT_V(2); PG8_BAR;
    PG8_STAGE(PG8_SB(1, 0), cB + kstep, voffB); PG8_STAGE(PG8_SA(1, 0), Abase + kstep, oC[0]); PG8_STAGE(PG8_SB(1, 1), cB + hstep + kstep, voffB);
    PG8_WAIT_V(6); PG8_BAR;
    for (;;) {
        const bool has_next = S.next(ui + 1, nxt);
        if (!has_next) nxt = cur;
        const char* nB = S.bptr(nxt);
        for (int t = 0; t < NT; t += 2) {
            const bool last = (t == NT - 2);
            const char* ka1 = Abase + (size_t)(t + 1) * kstep;
            const char* ka2 = last ? Abase : Abase + (size_t)(t + 2) * kstep; const char* b2 = last ? nB : cB + (size_t)(t + 2) * kstep;
            const char* ka3 = ka2 + kstep; const char* b3 = b2 + kstep;
            PG8_LDB(B0, 0, 0); PG8_LDB(B1, 0, 1); PG8_SCHED; PG8_LDA(At, 0, 0); PG8_STAGE(PG8_SA(1, 1), ka1, oC[1]);
            PG8_WAIT_V(8); PG8_WAIT_L(0); PG8_BAR; PG8_MMA(0, 0, At, B0); PG8_MMA(0, 1, At, B1); PG8_BAR; PG8_SCHED;
            if (last) {
#pragma unroll
                for (int h = 0; h < 2; ++h)
#pragma unroll
                    for (int i = 0; i < 2; ++i) oC[h][i] = (unsigned)S.arow(nxt, h * HALF + Rr[i]) * (unsigned)(KD * 2) + coffA[i];
            }
            PG8_LDA(At, 0, 1); PG8_STAGE(PG8_SB(0, 0), b2, voffB); PG8_STAGE(PG8_SB(0, 1), b2 + hstep, voffB); PG8_STAGE(PG8_SA(0, 0), ka2, oC[0]);
            PG8_WAIT_V(8); PG8_WAIT_L(0); PG8_BAR; PG8_MMA(1, 0, At, B0); PG8_MMA(1, 1, At, B1); PG8_BAR; PG8_SCHED;
            PG8_LDB(B0, 1, 0); PG8_LDB(B1, 1, 1); PG8_SCHED; PG8_LDA(At, 1, 0); PG8_STAGE(PG8_SA(0, 1), ka2, oC[1]);
            PG8_WAIT_V(8); PG8_WAIT_L(0); PG8_BAR; PG8_MMA(0, 0, At, B0); PG8_MMA(0, 1, At, B1); PG8_BAR; PG8_SCHED;
            PG8_LDA(At, 1, 1); PG8_STAGE(PG8_SB(1, 0), b3, voffB); PG8_STAGE(PG8_SB(1, 1), b3 + hstep, voffB); PG8_STAGE(PG8_SA(1, 0), ka3, oC[0]);
            PG8_WAIT_V(8); PG8_WAIT_L(0); PG8_BAR; PG8_MMA(1, 0, At, B0); PG8_MMA(1, 1, At, B1); PG8_BAR; PG8_SCHED;
        }
        if constexpr (ALIGN_EPI) { if (wr == 0) PG8_BAR; }
        E(acc, cur, wr, wc, fr, fq);
        if (!has_next) break;
#pragma unroll
        for (int a = 0; a < 2; ++a)
#pragma unroll
            for (int b = 0; b < 2; ++b)
#pragma unroll
                for (int m = 0; m < 4; ++m)
#pragma unroll
                    for (int n = 0; n < 2; ++n) acc[a][b][m][n] = (f32x4){0.f, 0.f, 0.f, 0.f};
        cur = nxt; cB = nB; ++ui;
        if constexpr (ALIGN_EPI) { if (wr == 1) PG8_BAR; }
    }
    PG8_WAIT_V(0);
    if constexpr (!ALIGN_EPI) { if (wr == 0) PG8_BAR; }
    PG8_BAR;
#undef PG8_SA
#undef PG8_SB
#undef PG8_STAGE
#undef PG8_LDA
#undef PG8_LDB
#undef PG8_MMA
#undef PG8_WAIT_V
#undef PG8_WAIT_L
#undef PG8_BAR
#undef PG8_SCHED
}
}

#define XB_TMO      128
#define XB_XCNT(j)  (256  + 64 * (j))
#define XB_XSUB(j)  (1280 + 64 * (j))
#define XB_XGEN(j)  (2304 + 64 * (j))
#define XB_TOP      3328
#define XB_TOPGEN   3392
#define XCD_BAR_WORDS 3456
#define XB_SPIN_CAP (1u << 22)
__device__ __forceinline__ unsigned xb_ld(unsigned* p)              { return __hip_atomic_load(p, __ATOMIC_RELAXED, __HIP_MEMORY_SCOPE_AGENT); }
__device__ __forceinline__ unsigned xb_add(unsigned* p, unsigned v) { return __hip_atomic_fetch_add(p, v, __ATOMIC_RELAXED, __HIP_MEMORY_SCOPE_AGENT); }
__device__ __forceinline__ unsigned xb_xcc_id() { return (unsigned)__builtin_amdgcn_s_getreg((3 << 11) | 20) & 0xFu; }
#define XB_SPIN(cond, bar) do { unsigned _sp = 0; while (cond) { __builtin_amdgcn_s_sleep(1); \
    if ((++_sp & 255u) == 0u) { if (xb_ld(&(bar)[XB_TMO])) break; if (_sp > XB_SPIN_CAP) { atomicAdd(&(bar)[XB_TMO], 1u); break; } } } } while (0)
struct XcdBarrier { unsigned* bar; unsigned x; volatile LAS unsigned* st; };
__device__ __forceinline__ XcdBarrier xcd_barrier_post(unsigned* bar, volatile LAS unsigned* st) {
    XcdBarrier b; b.bar = bar; b.x = xb_xcc_id(); b.st = st;
    if (threadIdx.x == 0) (void)xb_add(&bar[XB_XCNT(b.x)], 1u);
    return b;
}
__device__ __forceinline__ void xcd_barrier_complete(unsigned* bar, unsigned x, unsigned& nloc, unsigned& nx) {
    const unsigned G = gridDim.x * gridDim.y * gridDim.z;
    unsigned sum, cnt, mine, sp = 0u;
    for (;;) {
        sum = 0u; cnt = 0u; mine = 0u;
#pragma unroll
        for (unsigned j = 0; j < 16; ++j) { const unsigned c = xb_ld(&bar[XB_XCNT(j)]); sum += c; cnt += (c > 0u) ? 1u : 0u; mine = (j == x) ? c : mine; }
        if (sum == G) break;
        __builtin_amdgcn_s_sleep(1);
        if ((++sp & 255u) == 0u) { if (xb_ld(&bar[XB_TMO])) break; if (sp > XB_SPIN_CAP) { atomicAdd(&bar[XB_TMO], 1u); break; } }
    }
    nloc = mine > 0u ? mine : 1u; nx = cnt > 0u ? cnt : 1u;
}
__device__ __forceinline__ void xcd_barrier(const XcdBarrier& b) {
    asm volatile("s_waitcnt vmcnt(0)" ::: "memory");
    __syncthreads();
    if (threadIdx.x == 0) {
        unsigned* bar = b.bar;
        __builtin_amdgcn_s_waitcnt(0);
        unsigned nloc = b.st[0], nx = b.st[1];
        if (nloc == 0u) { xcd_barrier_complete(bar, b.x, nloc, nx); b.st[0] = nloc; b.st[1] = nx; }
        const unsigned old = xb_add(&bar[XB_XSUB(b.x)], 1u);
        const unsigned gen = old / nloc;
        if (old + 1u == (gen + 1u) * nloc) {
            __builtin_amdgcn_fence(__ATOMIC_RELEASE, "agent");
            asm volatile("s_waitcnt vmcnt(0)" ::: "memory");
            const unsigned og = xb_add(&bar[XB_TOP], 1u);
            const unsigned tg = og / nx;
            if (og + 1u == (tg + 1u) * nx) xb_add(&bar[XB_TOPGEN], 1u);
            else XB_SPIN(xb_ld(&bar[XB_TOPGEN]) == tg, bar);
            __builtin_amdgcn_fence(__ATOMIC_ACQUIRE, "agent");
            xb_add(&bar[XB_XGEN(b.x)], 1u);
            asm volatile("s_waitcnt vmcnt(0)" ::: "memory");
        } else {
            XB_SPIN(xb_ld(&bar[XB_XGEN(b.x)]) == gen, bar);
            __builtin_amdgcn_fence(__ATOMIC_ACQUIRE, "agent");
            asm volatile("s_waitcnt vmcnt(0)" ::: "memory");
        }
    }
    __syncthreads();
}

struct Args { const float* in[23]; float* out; unsigned char* ws; int ph_lo, ph_hi; };
typedef const Args __attribute__((address_space(4))) CArgs;
__device__ __forceinline__ CArgs* opaque_args() { CArgs* p = (CArgs*)__builtin_amdgcn_kernarg_segment_ptr(); asm volatile("" : "+s"(p)); return p; }
struct Frame {
    LAS unsigned char* lds;
    int tid, lane, wave, G, bid;
    float* out; unsigned char* ws;
};

struct DenseSched {
    int nM, nN, nwg, G, c; const char* Bt;
    __device__ __forceinline__ void init(int M, int N, int G_, int c_, const void* Bt_) { nM = M / 256; nN = N / 256; nwg = nM * nN; G = G_; c = c_; Bt = (const char*)Bt_; }
    __device__ __forceinline__ bool next(int i, pg8::Unit& u) const {
        const long L = (long)i * G + c; if (L >= nwg) return false;
        int wgid = (int)L; { const int q = nwg / 8, r = nwg % 8, xcd = wgid % 8, off = wgid / 8; wgid = (xcd < r ? xcd * (q + 1) : r * (q + 1) + (xcd - r) * q) + off; }
        const int nig = 8 * nN, gid = wgid / nig, fm = gid * 8, gsz = (nM - fm) < 8 ? (nM - fm) : 8;
        u.pm = fm + ((wgid % nig) % gsz); u.pn = (wgid % nig) / gsz; u.e = 0; u.lt = 0; return true;
    }
    __device__ __forceinline__ int arow(const pg8::Unit& u, int r) const { return u.pm * 256 + r; }
    __device__ __forceinline__ const char* bptr(const pg8::Unit& u) const { return Bt + (size_t)u.pn * 256 * 2048; }
};
struct EpiProj {
    static constexpr bool PERM = true;
    bf16* O;
    __device__ __forceinline__ void operator()(const f32x4 (&acc)[2][2][4][2], const pg8::Unit& u, int wr, int wc, int fr, int fq) const {
        const int row0 = u.pm * 256 + wr * 64 + fr, col0 = u.pn * 256 + wc * 32 + 8 * fq;
#pragma unroll
        for (int ai = 0; ai < 2; ++ai)
#pragma unroll
            for (int m = 0; m < 4; ++m) { bf16* rowp = O + (size_t)(row0 + ai * 128 + m * 16) * PW + col0;
#pragma unroll
                for (int bj = 0; bj < 2; ++bj) { if (col0 + bj * 128 < PW) { const f32x4 v0 = acc[ai][bj][m][0], v1 = acc[ai][bj][m][1];
                    v4u w; w.x = pg8::cvt_pk_bf16(v0[0], v0[1]); w.y = pg8::cvt_pk_bf16(v0[2], v0[3]); w.z = pg8::cvt_pk_bf16(v1[0], v1[1]); w.w = pg8::cvt_pk_bf16(v1[2], v1[3]);
                    *(v4u*)(rowp + bj * 128) = w; } } }
    }
};
struct EpiOut {
    static constexpr bool PERM = false;
    const float* x; const float* mod; float* H;
    __device__ __forceinline__ void operator()(const f32x4 (&acc)[2][2][4][2], const pg8::Unit& u, int wr, int wc, int fr, int fq) const {
        const int row0 = u.pm * 256 + wr * 64 + fr, col0 = u.pn * 256 + wc * 32 + 4 * fq;
        const float* g1 = mod + (size_t)(u.pm >> 4) * 6144 + 2048;
        f32x4 gv[2][2];
#pragma unroll
        for (int bj = 0; bj < 2; ++bj)
#pragma unroll
            for (int n = 0; n < 2; ++n) gv[bj][n] = *(const f32x4*)(g1 + col0 + bj * 128 + n * 16);
#pragma unroll
        for (int ai = 0; ai < 2; ++ai)
#pragma unroll
            for (int m = 0; m < 4; ++m) { const size_t off = (size_t)(row0 + ai * 128 + m * 16) * D + col0;
#pragma unroll
                for (int bj = 0; bj < 2; ++bj)
#pragma unroll
                    for (int n = 0; n < 2; ++n) { const f32x4 xv = *(const f32x4*)(x + off + bj * 128 + n * 16); *(f32x4*)(H + off + bj * 128 + n * 16) = xv + gv[bj][n] * acc[ai][bj][m][n]; }
                asm volatile("" ::: "memory"); }
    }
};
struct MoeSched {
    const LAS int* TS; int round, ntr, G, c; bool gu; const int* laid; const char* W;
    __device__ __forceinline__ bool next(int i, pg8::Unit& u) const {
        const int x = c & 7, j = c >> 3; int tl, pn;
        if (gu) { tl = (i * 8 + x) * 4 + (j >> 3); pn = j & 7; } else { tl = (i * 8 + x) * 8 + (j >> 2); pn = j & 3; }
        if (tl >= ntr) return false;
        const int tau = round * RTILES + tl; int e = 0;
#pragma unroll 1
        for (int k = 1; k < NEXP; ++k) e = (TS[k] <= tau) ? k : e;
        u.pm = tl; u.pn = pn; u.e = e; u.lt = tau - TS[e]; return true;
    }
    __device__ __forceinline__ int arow(const pg8::Unit& u, int r) const {
        if (!gu) return u.pm * 256 + r;
        const int pos = u.lt * 256 + r, cnt = TS[33 + u.e];
        return pos < cnt ? (laid[(size_t)u.e * LISTCAP + pos] >> 2) : 0;
    }
    __device__ __forceinline__ const char* bptr(const pg8::Unit& u) const { return W + ((size_t)u.e * (gu ? 2048 : 1024) + (size_t)u.pn * 256) * 2048; }
};
struct EpiGU {
    static constexpr bool PERM = true;
    bf16* ACT; const float* b_gu;
    __device__ __forceinline__ void operator()(const f32x4 (&acc)[2][2][4][2], const pg8::Unit& u, int wr, int wc, int fr, int fq) const {
        const int row0 = u.pm * 256 + wr * 64 + fr, j0 = u.pn * 128 + wc * 32 + 8 * fq;
        const float* bp = b_gu + (size_t)u.e * 2048 + 2 * j0;
        f32x4 bv[4];
#pragma unroll
        for (int q = 0; q < 4; ++q) bv[q] = *(const f32x4*)(bp + 4 * q);
#pragma unroll
        for (int ai = 0; ai < 2; ++ai)
#pragma unroll
            for (int m = 0; m < 4; ++m) { bf16* rowp = ACT + (size_t)(row0 + ai * 128 + m * 16) * DFF + j0; float a[8];
#pragma unroll
                for (int n = 0; n < 2; ++n)
#pragma unroll
                    for (int i = 0; i < 4; ++i) { const int jj = 4 * n + i; float g = acc[ai][0][m][n][i] + bv[jj >> 1][2 * (jj & 1)], up = acc[ai][1][m][n][i] + bv[jj >> 1][2 * (jj & 1) + 1];
                        g = fminf(g, 7.0f); up = fminf(fmaxf(up, -7.0f), 7.0f);
                        a[jj] = (up + 1.0f) * (g * __builtin_amdgcn_rcpf(1.0f + fexp(-1.702f * g))); }
                v4u w; w.x = pg8::cvt_pk_bf16(a[0], a[1]); w.y = pg8::cvt_pk_bf16(a[2], a[3]); w.z = pg8::cvt_pk_bf16(a[4], a[5]); w.w = pg8::cvt_pk_bf16(a[6], a[7]);
                *(v4u*)rowp = w; }
    }
};
struct EpiDN {
    static constexpr bool PERM = true;
    bf16* YA; const float* b_dn; const int* laid; const float* lw; const LAS int* TS;
    __device__ __forceinline__ void operator()(const f32x4 (&acc)[2][2][4][2], const pg8::Unit& u, int wr, int wc, int fr, int fq) const {
        const int col0 = u.pn * 256 + wc * 32 + 8 * fq, cnt = TS[33 + u.e];
        f32x4 bv[2][2];
#pragma unroll
        for (int bj = 0; bj < 2; ++bj)
#pragma unroll
            for (int n = 0; n < 2; ++n) bv[bj][n] = *(const f32x4*)(b_dn + (size_t)u.e * D + col0 + bj * 128 + 4 * n);
#pragma unroll
        for (int ai = 0; ai < 2; ++ai)
#pragma unroll
            for (int m = 0; m < 4; ++m) { const int pos = u.lt * 256 + ai * 128 + wr * 64 + m * 16 + fr;
                if (pos < cnt) { const int aid = laid[(size_t)u.e * LISTCAP + pos]; const float wt = lw[(size_t)u.e * LISTCAP + pos]; bf16* rowp = YA + (size_t)aid * D + col0;
#pragma unroll
                    for (int bj = 0; bj < 2; ++bj) { const f32x4 v0 = (acc[ai][bj][m][0] + bv[bj][0]) * wt, v1 = (acc[ai][bj][m][1] + bv[bj][1]) * wt;
                        v4u w; w.x = pg8::cvt_pk_bf16(v0[0], v0[1]); w.y = pg8::cvt_pk_bf16(v0[2], v0[3]); w.z = pg8::cvt_pk_bf16(v1[0], v1[1]); w.w = pg8::cvt_pk_bf16(v1[2], v1[3]);
                        *(v4u*)(rowp + bj * 128) = w; } } }
    }
};

template <bool MAPGU>
__device__ __forceinline__ void p0_transpose_item(const float* W, int N, bf16* WT, LAS float* scr, int item, int lane) {
    const int nblk = N / 32, kb = item / nblk, nb = item % nblk, k0 = 64 * kb, n0 = 32 * nb;
#pragma unroll 8
    for (int i = 0; i < 32; ++i) { const int kk = 2 * i + (lane >> 5); scr[kk * 33 + (lane & 31)] = W[(size_t)(k0 + kk) * N + n0 + (lane & 31)]; }
    LDS_WAIT(); asm volatile("" ::: "memory");
    const int c = lane & 7;
#pragma unroll
    for (int j = 0; j < 4; ++j) { const int n = (lane >> 3) + 8 * j; const LAS float* s = scr + (8 * c) * 33 + n;
        v4u o; o.x = pk2(s[0 * 33], s[1 * 33]); o.y = pk2(s[2 * 33], s[3 * 33]); o.z = pk2(s[4 * 33], s[5 * 33]); o.w = pk2(s[6 * 33], s[7 * 33]);
        int row = n0 + n;
        if (MAPGU) { const int jj = row >> 1; row = (jj >> 7) * 256 + (row & 1) * 128 + (jj & 127); }
        *(v4u*)(WT + (size_t)row * D + k0 + 8 * c) = o; }
    LDS_WAIT(); asm volatile("" ::: "memory");
}
__device__ __forceinline__ void p0_phase(const Frame& F, CArgs* A) {
    LAS float* scr = (LAS float*)(F.lds + F.wave * 16384);
    const int gw = F.bid * NWAVES + F.wave, NGW = F.G * NWAVES;
    constexpr int I_IN = 16 * (PW / 32), I_OUT = 16 * 32, I_GU = 16 * 64, I_DN = 16 * 32;
    constexpr int NITEMS = I_IN + I_OUT + NEXP * I_GU + NEXP * I_DN;
    for (int it = gw; it < NITEMS; it += NGW) {
        int r = it;
        if (r < I_IN) { p0_transpose_item<false>(A->in[7], PW, ((bf16*)(F.ws + WS_WIN)), scr, r, F.lane); continue; } r -= I_IN;
        if (r < I_OUT) { p0_transpose_item<false>(A->in[14], D, ((bf16*)(F.ws + WS_WOUT)), scr, r, F.lane); continue; } r -= I_OUT;
        if (r < NEXP * I_GU) { const int e = r / I_GU; p0_transpose_item<true>(A->in[18] + (size_t)e * D * 2048, 2048, ((bf16*)(F.ws + WS_WGU)) + (size_t)e * 2048 * D, scr, r % I_GU, F.lane); continue; } r -= NEXP * I_GU;
        { const int e = r / I_DN; p0_transpose_item<false>(A->in[20] + (size_t)e * D * D, D, ((bf16*)(F.ws + WS_WDN)) + (size_t)e * D * D, scr, r % I_DN, F.lane); }
    }
    { v4u z = {0u, 0u, 0u, 0u}; v4u* p = (v4u*)(((bf16*)(F.ws + WS_WIN)) + (size_t)PW * D); const int n16 = (PWP - PW) * D * 2 / 16;
      for (int i = F.bid * NTHREADS + F.tid; i < n16; i += F.G * NTHREADS) p[i] = z; }
    __syncthreads();
    LAS float* sl = (LAS float*)F.lds;
    LAS float* red = (LAS float*)(F.lds + 1024 * 20 * 4);
    bool filled = false;
    for (int it = F.bid; it < 6144 / 64; it += F.G) {
        if (!filled) {
            for (int i = F.tid; i < 17 * 1024; i += NTHREADS) { const int m = i >> 10, k = i & 1023; const float v = (m < 16) ? A->in[1][m * 1024 + k] : A->in[3][k]; sl[k * 20 + m] = v * __builtin_amdgcn_rcpf(1.0f + fexp(-v)); }
            filled = true; __syncthreads();
        }
        float a[17];
#pragma unroll
        for (int m = 0; m < 17; ++m) a[m] = 0.f;
        const int j = it * 64 + F.lane;
        for (int kk = 0; kk < 128; ++kk) { const int k = F.wave * 128 + kk; const float w = A->in[4][(size_t)k * 6144 + j];
            const LAS float* sp = sl + k * 20;
            const f32x4 s0 = *(const LAS f32x4*)sp, s1 = *(const LAS f32x4*)(sp + 4), s2 = *(const LAS f32x4*)(sp + 8), s3 = *(const LAS f32x4*)(sp + 12); const float s4 = sp[16];
            a[0] += s0[0] * w; a[1] += s0[1] * w; a[2] += s0[2] * w; a[3] += s0[3] * w; a[4] += s1[0] * w; a[5] += s1[1] * w; a[6] += s1[2] * w; a[7] += s1[3] * w;
            a[8] += s2[0] * w; a[9] += s2[1] * w; a[10] += s2[2] * w; a[11] += s2[3] * w; a[12] += s3[0] * w; a[13] += s3[1] * w; a[14] += s3[2] * w; a[15] += s3[3] * w; a[16] += s4 * w; }
#pragma unroll
        for (int m = 0; m < 17; ++m) red[(F.wave * 17 + m) * 64 + F.lane] = a[m];
        __syncthreads();
        for (int i = F.tid; i < 17 * 64; i += NTHREADS) { const int m = i >> 6, l = i & 63; float s = 0.f;
#pragma unroll
            for (int w = 0; w < 8; ++w) s += red[(w * 17 + m) * 64 + l];
            ((float*)(F.ws + WS_MOD))[(size_t)m * 6144 + it * 64 + l] = s + A->in[5][it * 64 + l]; }
        __syncthreads();
    }
}

__device__ __forceinline__ void p1_phase(const Frame& F, CArgs* A) {
    const int gw = F.bid * NWAVES + F.wave, NGW = F.G * NWAVES;
    for (int r = gw; r < NROWS; r += NGW) {
        const float* xr = (r < NLAT) ? A->in[0] + (size_t)r * D : A->in[2] + (size_t)(r - NLAT) * D;
        const int mrow = (r < NLAT) ? (r >> 12) : 16;
        const float* sh = ((float*)(F.ws + WS_MOD)) + (size_t)mrow * 6144; const float* sc = sh + 1024;
        f32x4 v[4]; float s = 0.f;
#pragma unroll
        for (int j = 0; j < 4; ++j) { v[j] = ((const f32x4*)xr)[F.lane + 64 * j]; s += (v[j].x * v[j].x + v[j].y * v[j].y) + (v[j].z * v[j].z + v[j].w * v[j].w); }
        const float rstd = 1.0f / sqrtf(wave_sum(s) * (1.f / D) + EPS);
        unsigned long long* o8 = (unsigned long long*)(((bf16*)(F.ws + WS_HN)) + (size_t)r * D) + F.lane;
#pragma unroll
        for (int j = 0; j < 4; ++j) { const int c4 = F.lane + 64 * j; const f32x4 w = ((const f32x4*)A->in[6])[c4], a = ((const f32x4*)sc)[c4], b = ((const f32x4*)sh)[c4];
            const f32x4 y = (v[j] * rstd) * w * (a + 1.0f) + b;
            o8[64 * j] = (unsigned long long)pk2(y.x, y.y) | ((unsigned long long)pk2(y.z, y.w) << 32); }
    }
}

constexpr int GL_ZL = 0;
constexpr int GL_BC = 8192;
constexpr int GL_TOT = GL_BC + 32768;
constexpr int GL_V = GL_TOT + 512;
constexpr int GL_A = GL_V + 64 * 136 * 2;
constexpr int GL_B = GL_A + 2 * 64 * 72 * 2;
constexpr int GL_P = GL_B + 2 * 64 * 72 * 2;
constexpr int GL_SS = GL_P + 64 * 72 * 2;
constexpr int GL_END = GL_SS + 512;
static_assert(GL_END <= RING_BYTES && (GL_V % 16) == 0 && (GL_A % 16) == 0 && (GL_B % 16) == 0 && (GL_P % 16) == 0, "GLA LDS map");

__device__ __forceinline__ s16x4 tr_read(unsigned lds_addr) { s16x4 r; asm volatile("ds_read_b64_tr_b16 %0, %1\n\ts_waitcnt lgkmcnt(0)" : "=&v"(r) : "v"(lds_addr) : "memory"); return r; }
__device__ __forceinline__ bf16x8 v_frag(LAS unsigned char* lds, int ks, int v0, int lane) {
    const int i = lane & 15, g = lane >> 4;
    const unsigned a0 = (unsigned)(uintptr_t)(lds + GL_V) + (unsigned)(((32 * ks + 8 * g + (i >> 2)) * 136 + v0 + 4 * (i & 3)) * 2);
    const s16x4 lo = tr_read(a0), hi = tr_read(a0 + 4 * 136 * 2);
    bf16x8 r; r[0] = lo[0]; r[1] = lo[1]; r[2] = lo[2]; r[3] = lo[3]; r[4] = hi[0]; r[5] = hi[1]; r[6] = hi[2]; r[7] = hi[3]; return r;
}
__device__ __forceinline__ void gla_prep(const Frame& F, CArgs* A, size_t prow, int h) {
    LAS unsigned char* lds = F.lds; const int tid = F.tid;
    if (tid < 256) { const int t = tid >> 2, q = tid & 3; const v4u w = *(const v4u*)(((bf16*)(F.ws + WS_P)) + (prow + t) * PW + CAF + 8 * q);
        LAS float* z = (LAS float*)(lds + GL_ZL) + (q >> 1) * 1024 + t * 16 + (q & 1) * 8;
        *(LAS f32x4*)z = (f32x4){bflo(w.x), bfhi(w.x), bflo(w.y), bfhi(w.y)}; *(LAS f32x4*)(z + 4) = (f32x4){bflo(w.z), bfhi(w.z), bflo(w.w), bfhi(w.w)}; }
#pragma unroll
    for (int i = 0; i < 2; ++i) { const int pc = tid + i * NTHREADS, t = pc >> 4, c = pc & 15;
        *(LAS v4u*)(lds + GL_V + (t * 136 + c * 8) * 2) = *(const v4u*)(((bf16*)(F.ws + WS_P)) + (prow + t) * PW + CV + h * 128 + c * 8); }
    __syncthreads();
    if (tid < 128) { const int dir = tid >> 6, d = tid & 63; const float* up = dir ? A->in[10] : A->in[8]; const float bias = (dir ? A->in[11] : A->in[9])[h * 64 + d];
        float u[16];
#pragma unroll
        for (int r = 0; r < 16; ++r) u[r] = up[r * 256 + h * 64 + d];
        const LAS float* zl = (const LAS float*)(lds + GL_ZL) + dir * 1024; LAS float* bc = (LAS float*)(lds + GL_BC) + dir * 4096 + d;
        float cum = 0.f;
        for (int i = 0; i < 64; ++i) { const int t = dir ? 63 - i : i; const LAS float* zp = zl + t * 16;
            const f32x4 z0 = *(const LAS f32x4*)zp, z1 = *(const LAS f32x4*)(zp + 4), z2 = *(const LAS f32x4*)(zp + 8), z3 = *(const LAS f32x4*)(zp + 12);
            float z = bias + z0[0] * u[0] + z0[1] * u[1] + z0[2] * u[2] + z0[3] * u[3] + z1[0] * u[4] + z1[1] * u[5] + z1[2] * u[6] + z1[3] * u[7]
                           + z2[0] * u[8] + z2[1] * u[9] + z2[2] * u[10] + z2[3] * u[11] + z3[0] * u[12] + z3[1] * u[13] + z3[2] * u[14] + z3[3] * u[15];
            const float ls = fminf(z, 0.f) - __logf(1.0f + __expf(-fabsf(z)));
            cum += ls * (1.0f / 16.0f); bc[t * 64] = cum; }
        ((LAS float*)(lds + GL_TOT))[dir * 64 + d] = cum; }
    __syncthreads();
}

__device__ __forceinline__ size_t chunk_row(int b, int cc) { return cc < 4 ? (size_t)NLAT + b * CTXL + cc * 64 : (size_t)b * SEQ + (cc - 4) * 64; }
__device__ __forceinline__ void p3_phase(const Frame& F, CArgs* A) {
    LAS unsigned char* lds = F.lds; const int tid = F.tid, lane = F.lane, wave = F.wave;
    for (int it = F.bid; it < NBATCH * NCC * 4; it += F.G) {
        const int h = it & 3, bc = it >> 2, b = bc / NCC, cc = bc % NCC; const size_t prow = chunk_row(b, cc);
        gla_prep(F, A, prow, h);
        if (tid < 128) { const int dir = tid >> 6, d = tid & 63; ((float*)(F.ws + WS_DECAY))[(((size_t)dir * NBATCH + b) * NCC + cc) * 256 + h * 64 + d] = __expf(((const LAS float*)(lds + GL_TOT))[dir * 64 + d]); }
        { const int d = tid & 63, tg = tid >> 6; float kf[8];
#pragma unroll
          for (int j = 0; j < 8; ++j) kf[j] = bf2f(((bf16*)(F.ws + WS_P))[(prow + tg * 8 + j) * PW + CK + h * 64 + d]);
#pragma unroll
          for (int dir = 0; dir < 2; ++dir) { const float tot = ((const LAS float*)(lds + GL_TOT))[dir * 64 + d]; const LAS float* bcp = (const LAS float*)(lds + GL_BC) + dir * 4096 + (tg * 8) * 64 + d; float s[8];
#pragma unroll
              for (int j = 0; j < 8; ++j) s[j] = kf[j] * __expf(tot - bcp[j * 64]);
              v4u w; w.x = pk2(s[0], s[1]); w.y = pk2(s[2], s[3]); w.z = pk2(s[4], s[5]); w.w = pk2(s[6], s[7]);
              *(LAS v4u*)(lds + GL_A + ((dir * 64 + d) * 72 + tg * 8) * 2) = w; } }
        __syncthreads();
        { const int dir = wave & 1, dt = wave >> 1, i = lane & 15, g = lane >> 4;
          bf16x8 af[2];
#pragma unroll
          for (int ks = 0; ks < 2; ++ks) af[ks] = *(const LAS bf16x8*)(lds + GL_A + ((dir * 64 + dt * 16 + i) * 72 + 32 * ks + 8 * g) * 2);
          bf16* kvp = ((bf16*)(F.ws + WS_KV)) + ((((size_t)dir * NBATCH + b) * NCC + cc) * 4 + h) * 8192;
#pragma unroll 2
          for (int vt = 0; vt < 8; ++vt) { f32x4 acc = {0.f, 0.f, 0.f, 0.f};
#pragma unroll
              for (int ks = 0; ks < 2; ++ks) { const bf16x8 vf = v_frag(lds, ks, vt * 16, lane); acc = __builtin_amdgcn_mfma_f32_16x16x32_bf16(af[ks], vf, acc, 0, 0, 0); }
              v2u w; w.x = pk2(acc[0], acc[1]); w.y = pk2(acc[2], acc[3]);
              *(v2u*)(kvp + (size_t)(vt * 16 + i) * 64 + dt * 16 + 4 * g) = w; } }
        __syncthreads();
    }
}

__device__ __forceinline__ void p4_phase(const Frame& F, CArgs* A) {
    for (int idx = F.bid * NTHREADS + F.tid; idx < 2 * NBATCH * 4 * 1024; idx += F.G * NTHREADS) {
        const int e8 = idx & 1023, ch = idx >> 10, h = ch & 3, b = (ch >> 2) & 15, dir = ch >> 6; const int d0 = (e8 & 7) * 8;
        float s[8];
#pragma unroll
        for (int j = 0; j < 8; ++j) s[j] = 0.f;
#pragma unroll 4
        for (int st = 0; st < NCC; ++st) {
            const int cc = dir ? (st < 4 ? 3 - st : 71 - st) : st;
            const size_t ci = ((size_t)dir * NBATCH + b) * NCC + cc;
            const v4u kv = *(const v4u*)(((bf16*)(F.ws + WS_KV)) + (ci * 4 + h) * 8192 + (size_t)e8 * 8);
            const f32x4 dc0 = *(const f32x4*)(((float*)(F.ws + WS_DECAY)) + ci * 256 + h * 64 + d0), dc1 = *(const f32x4*)(((float*)(F.ws + WS_DECAY)) + ci * 256 + h * 64 + d0 + 4);
            if (cc >= 4) { v4u w; w.x = pk2(s[0], s[1]); w.y = pk2(s[2], s[3]); w.z = pk2(s[4], s[5]); w.w = pk2(s[6], s[7]);
                *(v4u*)(((bf16*)(F.ws + WS_S)) + ((((size_t)dir * NBATCH + b) * 64 + (cc - 4)) * 4 + h) * 8192 + (size_t)e8 * 8) = w; }
            s[0] = s[0] * dc0[0] + bflo(kv.x); s[1] = s[1] * dc0[1] + bfhi(kv.x); s[2] = s[2] * dc0[2] + bflo(kv.y); s[3] = s[3] * dc0[3] + bfhi(kv.y);
            s[4] = s[4] * dc1[0] + bflo(kv.z); s[5] = s[5] * dc1[1] + bfhi(kv.z); s[6] = s[6] * dc1[2] + bflo(kv.w); s[7] = s[7] * dc1[3] + bfhi(kv.w);
        }
    }
}

__device__ __forceinline__ void p5a_phase(const Frame& F, CArgs* A) {
    LAS unsigned char* lds = F.lds; const int tid = F.tid, lane = F.lane, wave = F.wave, i = lane & 15, g = lane >> 4;
    for (int it = F.bid; it < NBATCH * 64 * 4; it += F.G) {
        const int h = it & 3, bn = it >> 2, b = bn >> 6, n = bn & 63; const size_t prow = (size_t)b * SEQ + n * 64;
        gla_prep(F, A, prow, h);
        { const int t = tid >> 3, d0 = (tid & 7) * 8;
          const v4u qw = *(const v4u*)(((bf16*)(F.ws + WS_P)) + (prow + t) * PW + CQ + h * 64 + d0), kw = *(const v4u*)(((bf16*)(F.ws + WS_P)) + (prow + t) * PW + CK + h * 64 + d0);
          const float q[8] = {bflo(qw.x), bfhi(qw.x), bflo(qw.y), bfhi(qw.y), bflo(qw.z), bfhi(qw.z), bflo(qw.w), bfhi(qw.w)};
          const float k[8] = {bflo(kw.x), bfhi(kw.x), bflo(kw.y), bfhi(kw.y), bflo(kw.z), bfhi(kw.z), bflo(kw.w), bfhi(kw.w)};
#pragma unroll
          for (int dir = 0; dir < 2; ++dir) { const LAS float* bp = (const LAS float*)(lds + GL_BC) + dir * 4096 + t * 64 + d0;
              const f32x4 b0 = *(const LAS f32x4*)bp, b1 = *(const LAS f32x4*)(bp + 4); const float bb[8] = {b0[0], b0[1], b0[2], b0[3], b1[0], b1[1], b1[2], b1[3]};
              float qd[8], ki[8];
#pragma unroll
              for (int j = 0; j < 8; ++j) { qd[j] = q[j] * __expf(bb[j]) * 0.125f; ki[j] = k[j] * __expf(-bb[j]); }
              v4u w; w.x = pk2(qd[0], qd[1]); w.y = pk2(qd[2], qd[3]); w.z = pk2(qd[4], qd[5]); w.w = pk2(qd[6], qd[7]);
              *(LAS v4u*)(lds + GL_A + ((dir * 64 + t) * 72 + d0) * 2) = w;
              w.x = pk2(ki[0], ki[1]); w.y = pk2(ki[2], ki[3]); w.z = pk2(ki[4], ki[5]); w.w = pk2(ki[6], ki[7]);
              *(LAS v4u*)(lds + GL_B + ((dir * 64 + t) * 72 + d0) * 2) = w; } }
        __syncthreads();
#pragma unroll
        for (int kk = 0; kk < 2; ++kk) { const int pi = wave * 2 + kk, tt = pi >> 2, st = pi & 3;
            f32x4 aF = {0.f, 0.f, 0.f, 0.f}, aB = {0.f, 0.f, 0.f, 0.f};
            if (st <= tt) {
#pragma unroll
                for (int ks = 0; ks < 2; ++ks) { const bf16x8 kf = *(const LAS bf16x8*)(lds + GL_B + ((st * 16 + i) * 72 + 32 * ks + 8 * g) * 2), qf = *(const LAS bf16x8*)(lds + GL_A + ((tt * 16 + i) * 72 + 32 * ks + 8 * g) * 2);
                    aF = __builtin_amdgcn_mfma_f32_16x16x32_bf16(kf, qf, aF, 0, 0, 0); } }
            if (st >= tt) {
#pragma unroll
                for (int ks = 0; ks < 2; ++ks) { const bf16x8 kf = *(const LAS bf16x8*)(lds + GL_B + ((64 + st * 16 + i) * 72 + 32 * ks + 8 * g) * 2), qf = *(const LAS bf16x8*)(lds + GL_A + ((64 + tt * 16 + i) * 72 + 32 * ks + 8 * g) * 2);
                    aB = __builtin_amdgcn_mfma_f32_16x16x32_bf16(kf, qf, aB, 0, 0, 0); } }
            const int t = tt * 16 + i, s0 = st * 16 + 4 * g; float p[4];
#pragma unroll
            for (int r = 0; r < 4; ++r) p[r] = ((s0 + r <= t) ? aF[r] : 0.f) + ((s0 + r >= t) ? aB[r] : 0.f);
            v2u w; w.x = pk2(p[0], p[1]); w.y = pk2(p[2], p[3]);
            *(LAS v2u*)(lds + GL_P + (t * 72 + s0) * 2) = w; }
        __syncthreads();
        { const int tt = wave & 3, vh = wave >> 2; const int t = tt * 16 + i;
          bf16x8 pf[2], qf[2][2];
#pragma unroll
          for (int ks = 0; ks < 2; ++ks) { pf[ks] = *(const LAS bf16x8*)(lds + GL_P + (t * 72 + 32 * ks + 8 * g) * 2);
              qf[0][ks] = *(const LAS bf16x8*)(lds + GL_A + (t * 72 + 32 * ks + 8 * g) * 2); qf[1][ks] = *(const LAS bf16x8*)(lds + GL_A + ((64 + t) * 72 + 32 * ks + 8 * g) * 2); }
          f32x4 acc[4]; float ss = 0.f;
#pragma unroll
          for (int k = 0; k < 4; ++k) { const int vt = vh * 4 + k; f32x4 a = {0.f, 0.f, 0.f, 0.f};
#pragma unroll
              for (int ks = 0; ks < 2; ++ks) { const bf16x8 vf = v_frag(lds, ks, vt * 16, lane); a = __builtin_amdgcn_mfma_f32_16x16x32_bf16(vf, pf[ks], a, 0, 0, 0); }
#pragma unroll
              for (int dir = 0; dir < 2; ++dir) { const bf16* sp = ((bf16*)(F.ws + WS_S)) + ((((size_t)dir * NBATCH + b) * 64 + n) * 4 + h) * 8192 + (size_t)(vt * 16 + i) * 64 + 8 * g;
#pragma unroll
                  for (int ks = 0; ks < 2; ++ks) { const bf16x8 sf = *(const bf16x8*)(sp + 32 * ks); a = __builtin_amdgcn_mfma_f32_16x16x32_bf16(sf, qf[dir][ks], a, 0, 0, 0); } }
              acc[k] = a; ss += (a[0] * a[0] + a[1] * a[1]) + (a[2] * a[2] + a[3] * a[3]); }
          ss += __shfl_xor(ss, 16); ss += __shfl_xor(ss, 32);
          if (g == 0) ((LAS float*)(lds + GL_SS))[vh * 64 + t] = ss;
          __syncthreads();
          const float tot = ((const LAS float*)(lds + GL_SS))[t] + ((const LAS float*)(lds + GL_SS))[64 + t];
          const float rstd = 1.0f / sqrtf(tot * (1.0f / 128.0f) + EPS);
#pragma unroll
          for (int k = 0; k < 4; ++k) { const int v = (vh * 4 + k) * 16 + 4 * g;
              const f32x4 gw = *(const f32x4*)(A->in[12] + v); const v2u rw = *(const v2u*)(((bf16*)(F.ws + WS_P)) + (prow + t) * PW + CR + h * 128 + v);
              const float r[4] = {bflo(rw.x), bfhi(rw.x), bflo(rw.y), bfhi(rw.y)}; float y[4];
#pragma unroll
              for (int j = 0; j < 4; ++j) y[j] = acc[k][j] * rstd * gw[j] * (r[j] * __builtin_amdgcn_rcpf(1.0f + __expf(-r[j])));
              v2u w; w.x = pk2(y[0], y[1]); w.y = pk2(y[2], y[3]);
              *(v2u*)(((bf16*)(F.ws + WS_YMIX)) + (prow + t) * D + h * 128 + v) = w; } }
        __syncthreads();
    }
    for (int it = F.bid; it < NBATCH * 64; it += F.G) {
        const size_t prow = (size_t)it * 64;
#pragma unroll 1
        for (int rep = 0; rep < 8; ++rep) { const int idx = tid + rep * NTHREADS, t = idx >> 6, c0 = (idx & 63) * 8;
            float cv[8];
#pragma unroll
            for (int j = 0; j < 8; ++j) cv[j] = 0.f;
#pragma unroll
            for (int dt = -1; dt <= 1; ++dt) { const int tt = t + dt; if (tt >= 0 && tt < 64) {
                const v4u cw = *(const v4u*)(((bf16*)(F.ws + WS_P)) + (prow + tt) * PW + CPC + c0), xw = *(const v4u*)(((bf16*)(F.ws + WS_P)) + (prow + tt) * PW + CPX + c0);
                const f32x4 w0 = *(const f32x4*)(A->in[13] + (dt + 1) * 512 + c0), w1 = *(const f32x4*)(A->in[13] + (dt + 1) * 512 + c0 + 4);
                cv[0] += w0[0] * bflo(cw.x) * bflo(xw.x); cv[1] += w0[1] * bfhi(cw.x) * bfhi(xw.x); cv[2] += w0[2] * bflo(cw.y) * bflo(xw.y); cv[3] += w0[3] * bfhi(cw.y) * bfhi(xw.y);
                cv[4] += w1[0] * bflo(cw.z) * bflo(xw.z); cv[5] += w1[1] * bfhi(cw.z) * bfhi(xw.z); cv[6] += w1[2] * bflo(cw.w) * bflo(xw.w); cv[7] += w1[3] * bfhi(cw.w) * bfhi(xw.w); } }
            const v4u bw = *(const v4u*)(((bf16*)(F.ws + WS_P)) + (prow + t) * PW + CPB + c0);
            v4u w; w.x = pk2(cv[0] * bflo(bw.x), cv[1] * bfhi(bw.x)); w.y = pk2(cv[2] * bflo(bw.y), cv[3] * bfhi(bw.y)); w.z = pk2(cv[4] * bflo(bw.z), cv[5] * bfhi(bw.z)); w.w = pk2(cv[6] * bflo(bw.w), cv[7] * bfhi(bw.w));
            *(v4u*)(((bf16*)(F.ws + WS_YMIX)) + (prow + t) * D + 512 + c0) = w; }
    }
}

constexpr int RT_W = 0;
constexpr int RT_LG = 32 * 1032 * 2;
constexpr int RT_HIST = RT_LG + 128 * 33 * 4;
__device__ __forceinline__ void p5c_phase(const Frame& F, CArgs* A) {
    LAS unsigned char* lds = F.lds; const int tid = F.tid, lane = F.lane, wave = F.wave, i = lane & 15, g = lane >> 4;
    for (int idx = tid; idx < 32768; idx += NTHREADS) { const int k = idx >> 5, e = idx & 31; *(LAS bf16*)(lds + RT_W + (e * 1032 + k) * 2) = (bf16)f2bf(A->in[16][idx]); }
    LAS int* hist = (LAS int*)(lds + RT_HIST); LAS float* lg = (LAS float*)(lds + RT_LG);
    unsigned* gcnt = ((unsigned*)(F.ws + WS_CTL)) + CW_CNT;
    __syncthreads();
    for (int it = F.bid; it < NLAT / 128; it += F.G) {
        const int R = it * 128 + wave * 16 + i, b = it >> 5;
        const float* hr = F.out + (size_t)R * D; const float* sh2 = ((float*)(F.ws + WS_MOD)) + (size_t)b * 6144 + 3072; const float* sc2 = sh2 + 1024;
        if (tid < 32) hist[tid] = 0;
        float ss = 0.f;
#pragma unroll 4
        for (int ks = 0; ks < 32; ++ks) { const f32x4 a0 = *(const f32x4*)(hr + 32 * ks + 8 * g), a1 = *(const f32x4*)(hr + 32 * ks + 8 * g + 4);
            ss += (a0[0] * a0[0] + a0[1] * a0[1]) + (a0[2] * a0[2] + a0[3] * a0[3]) + (a1[0] * a1[0] + a1[1] * a1[1]) + (a1[2] * a1[2] + a1[3] * a1[3]); }
        ss += __shfl_xor(ss, 16); ss += __shfl_xor(ss, 32);
        const float rstd = 1.0f / sqrtf(ss * (1.f / D) + EPS);
        f32x4 l0 = {0.f, 0.f, 0.f, 0.f}, l1 = {0.f, 0.f, 0.f, 0.f};
#pragma unroll 2
        for (int ks = 0; ks < 32; ++ks) { const int k0 = 32 * ks + 8 * g;
            const f32x4 a0 = *(const f32x4*)(hr + k0), a1 = *(const f32x4*)(hr + k0 + 4), w0 = *(const f32x4*)(A->in[15] + k0), w1 = *(const f32x4*)(A->in[15] + k0 + 4);
            const f32x4 c0 = *(const f32x4*)(sc2 + k0), c1 = *(const f32x4*)(sc2 + k0 + 4), s0 = *(const f32x4*)(sh2 + k0), s1 = *(const f32x4*)(sh2 + k0 + 4);
            const f32x4 y0 = (a0 * rstd) * w0 * (c0 + 1.0f) + s0, y1 = (a1 * rstd) * w1 * (c1 + 1.0f) + s1;
            v4u w; w.x = pk2(y0[0], y0[1]); w.y = pk2(y0[2], y0[3]); w.z = pk2(y1[0], y1[1]); w.w = pk2(y1[2], y1[3]);
            *(v4u*)(((bf16*)(F.ws + WS_HN2)) + (size_t)R * D + k0) = w;
            const bf16x8 af = __builtin_bit_cast(bf16x8, w);
            const bf16x8 r0 = *(const LAS bf16x8*)(lds + RT_W + (i * 1032 + k0) * 2), r1 = *(const LAS bf16x8*)(lds + RT_W + ((16 + i) * 1032 + k0) * 2);
            l0 = __builtin_amdgcn_mfma_f32_16x16x32_bf16(af, r0, l0, 0, 0, 0); l1 = __builtin_amdgcn_mfma_f32_16x16x32_bf16(af, r1, l1, 0, 0, 0); }
        { const float rb0 = A->in[17][i], rb1 = A->in[17][16 + i];
#pragma unroll
          for (int r = 0; r < 4; ++r) { lg[(wave * 16 + 4 * g + r) * 33 + i] = l0[r] + rb0; lg[(wave * 16 + 4 * g + r) * 33 + 16 + i] = l1[r] + rb1; } }
        __syncthreads();
        int te[4] = {0, 0, 0, 0}; float tv[4] = {-3.0e38f, -3.0e38f, -3.0e38f, -3.0e38f}; int lp[4] = {0, 0, 0, 0};
        if (lane < 16) { const LAS float* lr = lg + (wave * 16 + lane) * 33;
            for (int e = 0; e < 32; ++e) { const float x = lr[e];
                if (x > tv[3]) { if (x > tv[2]) { tv[3] = tv[2]; te[3] = te[2]; if (x > tv[1]) { tv[2] = tv[1]; te[2] = te[1]; if (x > tv[0]) { tv[1] = tv[0]; te[1] = te[0]; tv[0] = x; te[0] = e; } else { tv[1] = x; te[1] = e; } } else { tv[2] = x; te[2] = e; } } else { tv[3] = x; te[3] = e; } } }
            const float e1 = __expf(tv[1] - tv[0]), e2 = __expf(tv[2] - tv[0]), e3 = __expf(tv[3] - tv[0]), inv = 1.0f / (1.0f + e1 + e2 + e3);
            tv[0] = inv; tv[1] = e1 * inv; tv[2] = e2 * inv; tv[3] = e3 * inv;
#pragma unroll
            for (int k = 0; k < 4; ++k) lp[k] = __hip_atomic_fetch_add(&hist[te[k]], 1, __ATOMIC_RELAXED, __HIP_MEMORY_SCOPE_WORKGROUP); }
        __syncthreads();
        if (tid < 32) { const int c = hist[tid]; hist[32 + tid] = c ? (int)__hip_atomic_fetch_add(gcnt + tid, (unsigned)c, RLX_AGENT) : 0; }
        __syncthreads();
        if (lane < 16) { const int Rt = it * 128 + wave * 16 + lane;
#pragma unroll
            for (int k = 0; k < 4; ++k) { const size_t pos = (size_t)te[k] * LISTCAP + hist[32 + te[k]] + lp[k]; ((int*)(F.ws + WS_LAID))[pos] = Rt * 4 + k; ((float*)(F.ws + WS_LW))[pos] = tv[k]; } }
        __syncthreads();
    }
}

__device__ __forceinline__ void p8_phase(const Frame& F, CArgs* A) {
    const int gw = F.bid * NWAVES + F.wave, NGW = F.G * NWAVES;
    for (int r = gw; r < NLAT; r += NGW) {
        float* hr = F.out + (size_t)r * D; const float* g2 = ((float*)(F.ws + WS_MOD)) + (size_t)(r >> 12) * 6144 + 5120;
        f32x4 v[4]; float s = 0.f;
#pragma unroll
        for (int j = 0; j < 4; ++j) { const int c4 = F.lane + 64 * j; f32x4 y = {0.f, 0.f, 0.f, 0.f};
#pragma unroll
            for (int k = 0; k < 4; ++k) { const v2u w = ((const v2u*)(((bf16*)(F.ws + WS_YA)) + ((size_t)r * 4 + k) * D))[c4]; y[0] += bflo(w.x); y[1] += bfhi(w.x); y[2] += bflo(w.y); y[3] += bfhi(w.y); }
            v[j] = ((const f32x4*)hr)[c4] + ((const f32x4*)g2)[c4] * y;
            s += (v[j].x * v[j].x + v[j].y * v[j].y) + (v[j].z * v[j].z + v[j].w * v[j].w); }
        const float rstd = 1.0f / sqrtf(wave_sum(s) * (1.f / D) + EPS);
#pragma unroll
        for (int j = 0; j < 4; ++j) { const int c4 = F.lane + 64 * j; ((f32x4*)hr)[c4] = (v[j] * rstd) * ((const f32x4*)A->in[22])[c4]; }
    }
}

constexpr int NPHASES = 19;
__global__ void __launch_bounds__(NTHREADS, 2) fwd_kernel(Args args) {
    extern __shared__ __attribute__((aligned(16))) unsigned char lds_raw[];
    Frame F;
    F.lds = (LAS unsigned char*)lds_raw;
    F.tid = threadIdx.x; F.lane = F.tid & 63; F.wave = __builtin_amdgcn_readfirstlane(F.tid >> 6); F.G = gridDim.x; F.bid = blockIdx.x;
    F.out = args.out; F.ws = args.ws;
        for (int u = F.tid; u < (LDS_BYTES - MISC_OFF) / 4; u += NTHREADS) ((LAS unsigned*)(F.lds + MISC_OFF))[u] = 0u;
    __syncthreads();
    volatile LAS unsigned* MISC = (volatile LAS unsigned*)(F.lds + MISC_OFF);
    LAS int* TS = (LAS int*)(F.lds + MISC_OFF + 256);
    const int lo = args.ph_lo, hi = args.ph_hi;
    const bool multi = (hi - lo) > 1;
    XcdBarrier bar; bar.bar = (unsigned*)((unsigned*)(F.ws + WS_CTL)) + CW_BAR; bar.x = 0; bar.st = nullptr;
    if (multi) bar = xcd_barrier_post((unsigned*)((unsigned*)(F.ws + WS_CTL)) + CW_BAR, MISC + 8);
#ifndef PHMASK
#define PHMASK 0x7ffff
#endif
#define IN(k) (((PHMASK >> (k)) & 1) && lo <= (k) && (k) < hi)
#define SEAM(k) do { if (IN(k) && IN((k) + 1)) xcd_barrier(bar); } while (0)

    if (IN(0)) { p0_phase(F, opaque_args()); } SEAM(0);
    if (IN(1)) { p1_phase(F, opaque_args()); } SEAM(1);
    if (IN(2)) { DenseSched S; S.init(NROWS, PWP, F.G, F.bid, ((bf16*)(F.ws + WS_WIN))); EpiProj E{((bf16*)(F.ws + WS_P))};
        pg8::gemm_phase<EpiProj, DenseSched, true>(F.lds, (const char*)((bf16*)(F.ws + WS_HN)), S, E); } SEAM(2);
    if (IN(3)) { p3_phase(F, opaque_args()); } SEAM(3);
    if (IN(4)) { p4_phase(F, opaque_args()); } SEAM(4);
    if (IN(5)) { p5a_phase(F, opaque_args()); } SEAM(5);
    if (IN(6)) { DenseSched S; S.init(NLAT, D, F.G, F.bid, ((bf16*)(F.ws + WS_WOUT))); EpiOut E{opaque_args()->in[0], ((float*)(F.ws + WS_MOD)), F.out};
        pg8::gemm_phase<EpiOut, DenseSched, true>(F.lds, (const char*)((bf16*)(F.ws + WS_YMIX)), S, E); } SEAM(6);
    if (IN(7)) { p5c_phase(F, opaque_args()); } SEAM(7);
#pragma unroll 1
    for (int ph = 8; ph < 18; ++ph) {
        if (IN(ph)) {
            const int round = (ph - 8) >> 1; const bool gu = ((ph - 8) & 1) == 0;
            if (F.tid == 0) { int acc = 0;
                for (int e = 0; e < NEXP; ++e) { const int c = (int)__hip_atomic_load(((unsigned*)(F.ws + WS_CTL)) + CW_CNT + e, RLX_AGENT); TS[e] = acc; TS[33 + e] = c; acc += (c + 255) >> 8; }
                TS[32] = acc; }
            __syncthreads();
            const int ntot = TS[32]; int ntr = ntot - round * RTILES; ntr = ntr > RTILES ? RTILES : ntr;
            if (ntr > 0) {
                MoeSched S; S.TS = TS; S.round = round; S.ntr = ntr; S.G = F.G; S.c = F.bid; S.gu = gu; S.laid = ((int*)(F.ws + WS_LAID)); S.W = (const char*)(gu ? ((bf16*)(F.ws + WS_WGU)) : ((bf16*)(F.ws + WS_WDN)));
                if (gu) { EpiGU E{((bf16*)(F.ws + WS_ACT)), opaque_args()->in[19]}; pg8::gemm_phase<EpiGU, MoeSched, true>(F.lds, (const char*)((bf16*)(F.ws + WS_HN2)), S, E); }
                else { EpiDN E{((bf16*)(F.ws + WS_YA)), opaque_args()->in[21], ((int*)(F.ws + WS_LAID)), ((float*)(F.ws + WS_LW)), TS}; pg8::gemm_phase<EpiDN, MoeSched, true>(F.lds, (const char*)((bf16*)(F.ws + WS_ACT)), S, E); }
            }
        }
        SEAM(ph);
    }
    if (IN(18)) { p8_phase(F, opaque_args()); }
#undef IN
#undef SEAM
}

extern "C" void kernel_launch(void* const* d_in, const int* in_sizes, int n_in, void* d_out, int out_size, void* d_ws, size_t ws_size, hipStream_t stream) {
    static int grid = 0;
    if (grid == 0) {
        if (n_in != 23 || in_sizes[0] != NLAT * D || out_size != NLAT * D || ws_size < WS_END) {
            fprintf(stderr, "kernel_launch: unexpected shapes: n_in %d, in0 %d, out %d, ws %zu (need %zu); nothing launched\n", n_in, n_in > 0 ? in_sizes[0] : -1, out_size, ws_size, (size_t)WS_END); grid = -1; return; }
        int dev = 0, cus = 0, per_cu = 0;
        if (hipGetDevice(&dev) != hipSuccess || hipDeviceGetAttribute(&cus, hipDeviceAttributeMultiprocessorCount, dev) != hipSuccess) { fprintf(stderr, "kernel_launch: device query failed\n"); grid = -1; return; }
        if (hipFuncSetAttribute((const void*)fwd_kernel, hipFuncAttributeMaxDynamicSharedMemorySize, LDS_BYTES) != hipSuccess) { fprintf(stderr, "kernel_launch: hipFuncSetAttribute failed\n"); grid = -1; return; }
        if (hipOccupancyMaxActiveBlocksPerMultiprocessor(&per_cu, (const void*)fwd_kernel, NTHREADS, LDS_BYTES) != hipSuccess || per_cu < 1) {
            fprintf(stderr, "kernel_launch: occupancy query reports %d workgroups per CU; nothing launched\n", per_cu); (void)hipGetLastError(); grid = -1; return; }
        grid = cus;
        if (grid > 256) grid = 256;
    }
    if (grid < 0) return;
    if (hipMemsetAsync((char*)d_ws + WS_CTL, 0, CTL_ZERO_BYTES, stream) != hipSuccess) { fprintf(stderr, "kernel_launch: hipMemsetAsync failed\n"); return; }
    Args a{};
    for (int i = 0; i < 23; ++i) a.in[i] = (const float*)d_in[i];
    a.out = (float*)d_out; a.ws = (unsigned char*)d_ws;
#if MK_N_LAUNCHES == 1
    a.ph_lo = 0; a.ph_hi = NPHASES;
    hipLaunchKernelGGL(fwd_kernel, dim3(grid), dim3(NTHREADS), LDS_BYTES, stream, a);
#else
    for (int p = 0; p < NPHASES; ++p) { a.ph_lo = p; a.ph_hi = p + 1; hipLaunchKernelGGL(fwd_kernel, dim3(grid), dim3(NTHREADS), LDS_BYTES, stream, a); }
#endif
    const hipError_t le = hipPeekAtLastError();
    if (le != hipSuccess) fprintf(stderr, "kernel_launch: launch failed: %s\n", hipGetErrorName(le));
}
```

```cpp
#include <hip/hip_runtime.h>
#include <cstdio>
#include <cstdint>

#ifndef MK_N_LAUNCHES
#define MK_N_LAUNCHES 1
#endif

#define GAS __attribute__((address_space(1)))
#define LAS __attribute__((address_space(3)))
typedef unsigned short bf16;
typedef unsigned v4u __attribute__((ext_vector_type(4)));
typedef unsigned v2u __attribute__((ext_vector_type(2)));
typedef float f32x4 __attribute__((ext_vector_type(4)));
typedef float f32x2 __attribute__((ext_vector_type(2)));
typedef short bf16x8 __attribute__((ext_vector_type(8)));
typedef short s16x4 __attribute__((ext_vector_type(4)));
#define RLX_AGENT __ATOMIC_RELAXED, __HIP_MEMORY_SCOPE_AGENT
#define LDS_WAIT() asm volatile("s_waitcnt lgkmcnt(0)" ::: "memory")
#define VM_WAIT() asm volatile("s_waitcnt vmcnt(0)" ::: "memory")
#define LDS_BARRIER() do { asm volatile("s_waitcnt lgkmcnt(0)" ::: "memory"); __builtin_amdgcn_s_barrier(); asm volatile("" ::: "memory"); } while (0)

typedef __bf16 bf16x2_t __attribute__((ext_vector_type(2)));
__device__ __forceinline__ unsigned pk2(float lo, float hi) { const f32x2 v = {lo, hi}; return __builtin_bit_cast(unsigned, __builtin_convertvector(v, bf16x2_t)); }
__device__ __forceinline__ unsigned f2bf(float f) { return (unsigned)__builtin_bit_cast(unsigned short, (__bf16)f); }
__device__ __forceinline__ unsigned pk4_fp8(float a, float b, float c, float d) { int w = __builtin_amdgcn_cvt_pk_fp8_f32(a, b, 0, false); w = __builtin_amdgcn_cvt_pk_fp8_f32(c, d, w, true); return (unsigned)w; }
__device__ __forceinline__ float bflo(unsigned w) { return __builtin_bit_cast(float, w << 16); }
__device__ __forceinline__ float bfhi(unsigned w) { return __builtin_bit_cast(float, w & 0xffff0000u); }
__device__ __forceinline__ float bf2f(bf16 b) { return __builtin_bit_cast(float, ((unsigned)b) << 16); }
__device__ __forceinline__ float fexp(float x) { return __builtin_amdgcn_exp2f(x * 1.4426950408889634f); }
__device__ __forceinline__ float wave_sum(float v) {
#pragma unroll
    for (int o = 1; o < 64; o <<= 1) v += __shfl_xor(v, o);
    return v;
}

constexpr int D = 1024, NBATCH = 16, SEQ = 4096, CTXL = 256;
constexpr int NLAT = NBATCH * SEQ;
constexpr int NCTXR = NBATCH * CTXL;
constexpr int NROWS = NLAT + NCTXR;
constexpr int PW = 3104, PWP = 3328;
constexpr int CQ = 0, CK = 256, CV = 512, CR = 1024, CAF = 1536, CAB = 1552, CPB = 1568, CPC = 2080, CPX = 2592;
constexpr int NCC = 68;
constexpr int NEXP = 32, DFF = 1024;
constexpr float EPS = 1e-6f;
constexpr int LISTCAP = 65536;
constexpr float WSCALE = 32.0f, WSCALE_INV = 1.0f / 32.0f;

#ifndef OUTPROJ_F8
#define OUTPROJ_F8 1
#endif
constexpr size_t MiB = 1u << 20;
constexpr size_t WS_CTL = 0, CTL_ZERO_BYTES = 32768;
constexpr size_t WS_MOD = 1 * MiB;
constexpr size_t WS_DECAY = 2 * MiB;
constexpr size_t WS_WIN = 6 * MiB;
constexpr size_t WS_WOUT = 13 * MiB;
constexpr size_t WS_HN = 16 * MiB;
constexpr size_t WS_KV = 16 * MiB;
constexpr size_t WS_P = 152 * MiB;
constexpr size_t WS_S = 565 * MiB;
constexpr size_t WS_YMIX = 693 * MiB;
constexpr size_t WS_Y1 = 821 * MiB;
constexpr size_t WS_ACT = 16 * MiB;
constexpr size_t WS_YA = 280 * MiB;
constexpr size_t WS_VT = 949 * MiB;
constexpr size_t WS_END = 1013 * MiB;
constexpr size_t WS_TSLOT = 1013 * MiB;
constexpr size_t WS_TW = 1015 * MiB;
constexpr size_t WS_TOTAL = 1017 * MiB;
constexpr size_t DO_WDN = 0;
constexpr size_t DO_WGU = 32 * MiB;
constexpr size_t DO_HN2 = 96 * MiB;
constexpr size_t DO_LAID = 160 * MiB;
constexpr size_t DO_LW = 168 * MiB;
static_assert(WS_P + (size_t)NROWS * PW * 2 <= WS_S && WS_YMIX + (size_t)NLAT * D * 2 <= WS_Y1 && WS_YA + (size_t)1056 * 256 * D <= WS_Y1 && WS_Y1 + (size_t)NLAT * D * 2 <= WS_VT && WS_VT + (size_t)NLAT * 512 * 2 <= WS_END, "ws map");
static_assert(WS_HN + (size_t)NROWS * D * 2 <= WS_P && WS_ACT + (size_t)1056 * 256 * 1024 <= WS_YA && DO_LW + (size_t)NEXP * LISTCAP * 4 <= (size_t)NLAT * D * 4, "ws map 2");
constexpr int CW_CNT = 64;
constexpr int CW_BAR = 4096;

constexpr int RING_BYTES = 131072;
constexpr int MISC_OFF = RING_BYTES;
constexpr int LDS_BYTES = 147456;
constexpr int NWAVES = 8, NTHREADS = 512;

namespace pg8 {
constexpr int BM = 256, BK = 64, HALF = 128, HTB = HALF * BK * 2, STAGE_BYTES = 8 * HTB;
__host__ __device__ __forceinline__ int lds_byte(int r, int c) { const int st = (r >> 4) * 2 + (c >> 5), rr = r & 15, cc = c & 31, ob = rr * 64 + cc * 2; return st * 1024 + (ob ^ (((ob >> 9) & 1) << 5)); }
__host__ __device__ __forceinline__ void stage_rc(int b, int& R, int& C) { const int st = b / 1024, sb = b % 1024, swz = sb ^ (((sb >> 9) & 1) << 5); R = (st >> 1) * 16 + swz / 64; C = (st & 1) * 32 + (swz % 64) / 2; }
__host__ __device__ __forceinline__ int perm32(int rho) { const int n = rho >> 4, i = rho & 15; return 8 * (i >> 2) + 4 * n + (i & 3); }

typedef int v8i __attribute__((ext_vector_type(8)));
typedef int v4i __attribute__((ext_vector_type(4)));
__device__ __forceinline__ v8i cat8(bf16x8 lo, bf16x8 hi) { return __builtin_shufflevector(__builtin_bit_cast(v4i, lo), __builtin_bit_cast(v4i, hi), 0, 1, 2, 3, 4, 5, 6, 7); }
struct Unit { int pm, pn, e, lt; };
__device__ __forceinline__ unsigned cvt_pk_bf16(float lo, float hi) { unsigned r; asm volatile("v_cvt_pk_bf16_f32 %0, %1, %2" : "=v"(r) : "v"(lo), "v"(hi)); return r; }

template <class Epi, class Sched, bool ALIGN_EPI, bool F8>
__device__ __forceinline__ void gemm_phase(LAS unsigned char* lds, const char* Abase, const Sched& S, const Epi& E) {
    int tid_ = threadIdx.x; asm volatile("" : "+v"(tid_));
    const int tid = tid_, wid = __builtin_amdgcn_readfirstlane(tid >> 6), lane = tid & 63, wr = wid >> 2, wc = wid & 3, fr = lane & 15, fq = lane >> 4;
    constexpr int KB = F8 ? 1024 : 2048, NT = KB / 128;
    unsigned voffB[2];
#pragma unroll
    for (int i = 0; i < 2; ++i) { int R, C; stage_rc(tid * 16 + i * 8192, R, C); const int Rb = Epi::PERM ? ((R & ~31) + perm32(R & 31)) : R; voffB[i] = (unsigned)(Rb * KB + C * 2); }
#define PG8_AROWS(u_, dst_) do { _Pragma("unroll") for (int h_ = 0; h_ < 2; ++h_) _Pragma("unroll") for (int i_ = 0; i_ < 2; ++i_) { int R_, C_; stage_rc(tid * 16 + i_ * 8192, R_, C_); \
        dst_[h_][i_] = (unsigned)S.arow(u_, h_ * HALF + R_); } } while (0)
#define PG8_AOFF2(dst_) do { _Pragma("unroll") for (int h_ = 0; h_ < 2; ++h_) _Pragma("unroll") for (int i_ = 0; i_ < 2; ++i_) { int R_, C_; stage_rc(tid * 16 + i_ * 8192, R_, C_); \
        dst_[h_][i_] = dst_[h_][i_] * (unsigned)KB + (unsigned)C_ * 2u; } } while (0)
    const size_t kstep = (size_t)(BK * 2);
    const size_t hstep = (size_t)HALF * KB;
    const unsigned ldsw = (unsigned)wid * 1024u;
    const int aoff = lds_byte(wr * 64 + fr, fq * 8), boff = lds_byte(wc * 32 + fr, fq * 8);
#define PG8_SA(b, h) (((b) * 2 + (h)) * HTB)
#define PG8_SB(b, h) ((4 + (b) * 2 + (h)) * HTB)
#define PG8_STAGE(bufoff, gbase, voff) do { _Pragma("unroll") for (int _i = 0; _i < 2; ++_i) \
        __builtin_amdgcn_global_load_lds((const unsigned*)((const char*)(gbase) + (voff)[_i]), (LAS unsigned*)(lds + (bufoff) + ldsw + _i * 8192), 16, 0, 0); } while (0)
#define PG8_LDA(dst, b, h) do { _Pragma("unroll") for (int m = 0; m < 4; ++m) _Pragma("unroll") for (int k = 0; k < 2; ++k) dst[m][k] = *(const LAS bf16x8*)(lds + PG8_SA(b, h) + aoff + m * 2048 + k * 1024); } while (0)
#define PG8_LDB(dst, b, h) do { _Pragma("unroll") for (int n = 0; n < 2; ++n) _Pragma("unroll") for (int k = 0; k < 2; ++k) dst[n][k] = *(const LAS bf16x8*)(lds + PG8_SB(b, h) + boff + n * 2048 + k * 1024); } while (0)
#define PG8_MMA(ai, bj, At, Bt) do { if (skipmma && ((bj) == 1 || wc > 0)) break; __builtin_amdgcn_s_setprio(1); _Pragma("unroll") for (int m = 0; m < 4; ++m) _Pragma("unroll") for (int n = 0; n < 2; ++n) { \
        if constexpr (F8) { asm volatile("v_mfma_f32_16x16x128_f8f6f4 %0, %1, %2, %0" : "+v"(acc[ai][bj][m][n]) : "v"(cat8(Bt[n][0], Bt[n][1])), "v"(cat8(At[m][0], At[m][1]))); } \
        else { _Pragma("unroll") for (int k = 0; k < 2; ++k) acc[ai][bj][m][n] = __builtin_amdgcn_mfma_f32_16x16x32_bf16(Bt[n][k], At[m][k], acc[ai][bj][m][n], 0, 0, 0); } } \
        __builtin_amdgcn_s_setprio(0); } while (0)
#define PG8_WAIT_V(n) asm volatile("s_waitcnt vmcnt(" #n ")" ::: "memory")
#define PG8_WAIT_L(n) asm volatile("s_waitcnt lgkmcnt(" #n ")" ::: "memory")
#define PG8_BAR __builtin_amdgcn_s_barrier()
#define PG8_SCHED __builtin_amdgcn_sched_barrier(0)
    Unit cur, nxt; int ui = 0;
    if (!S.next(0, cur)) return;
    f32x4 acc[2][2][4][2];
#pragma unroll
    for (int a = 0; a < 2; ++a)
#pragma unroll
        for (int b = 0; b < 2; ++b)
#pragma unroll
            for (int m = 0; m < 4; ++m)
#pragma unroll
                for (int n = 0; n < 2; ++n) acc[a][b][m][n] = (f32x4){0.f, 0.f, 0.f, 0.f};
    bf16x8 At[4][2], B0[2][2], B1[2][2];
    unsigned oC[2][2];
    PG8_AROWS(cur, oC); PG8_AOFF2(oC);
    unsigned rN[2] = {0u, 0u};
    const char* cB = S.bptr(cur);
    PG8_STAGE(PG8_SB(0, 0), cB, voffB); PG8_STAGE(PG8_SB(0, 1), cB + hstep, voffB); PG8_STAGE(PG8_SA(0, 0), Abase, oC[0]); PG8_STAGE(PG8_SA(0, 1), Abase, oC[1]);
    if (wr == 1) PG8_BAR;
    PG8_WAIT_V(2); PG8_BAR;
    PG8_STAGE(PG8_SB(1, 0), cB + kstep, voffB); PG8_STAGE(PG8_SA(1, 0), Abase + kstep, oC[0]); PG8_STAGE(PG8_SB(1, 1), cB + hstep + kstep, voffB);
    PG8_WAIT_V(6); PG8_BAR;
    for (;;) {
        const bool skipmma = S.mostly_padding(cur);
        const bool has_next = S.next(ui + 1, nxt);
        if (!has_next) nxt = cur;
        const char* nB = S.bptr(nxt);
        for (int t = 0; t < NT; t += 2) {
            const bool last = (t == NT - 2);
            const char* ka1 = Abase + (size_t)(t + 1) * kstep;
            const char* ka2 = last ? Abase : Abase + (size_t)(t + 2) * kstep; const char* b2 = last ? nB : cB + (size_t)(t + 2) * kstep;
            const char* ka3 = ka2 + kstep; const char* b3 = b2 + kstep;
            PG8_LDB(B0, 0, 0); PG8_LDB(B1, 0, 1); PG8_SCHED; PG8_LDA(At, 0, 0); PG8_STAGE(PG8_SA(1, 1), ka1, oC[1]);
            PG8_WAIT_V(8); PG8_WAIT_L(0); PG8_BAR; PG8_MMA(0, 0, At, B0); PG8_MMA(0, 1, At, B1); PG8_BAR; PG8_SCHED;
            if constexpr (Sched::GATHER) { if (t == NT - 4) { unsigned r4[2][2]; PG8_AROWS(nxt, r4); rN[0] = r4[0][0] | (r4[0][1] << 16); rN[1] = r4[1][0] | (r4[1][1] << 16); } }
            if (last) {
                if constexpr (Sched::GATHER) { oC[0][0] = rN[0] & 0xffffu; oC[0][1] = rN[0] >> 16; oC[1][0] = rN[1] & 0xffffu; oC[1][1] = rN[1] >> 16; }
                else { PG8_AROWS(nxt, oC); }
                PG8_AOFF2(oC); }
            PG8_LDA(At, 0, 1); PG8_STAGE(PG8_SB(0, 0), b2, voffB); PG8_STAGE(PG8_SB(0, 1), b2 + hstep, voffB); PG8_STAGE(PG8_SA(0, 0), ka2, oC[0]);
            PG8_WAIT_V(8); PG8_WAIT_L(0); PG8_BAR; PG8_MMA(1, 0, At, B0); PG8_MMA(1, 1, At, B1); PG8_BAR; PG8_SCHED;
            PG8_LDB(B0, 1, 0); PG8_LDB(B1, 1, 1); PG8_SCHED; PG8_LDA(At, 1, 0); PG8_STAGE(PG8_SA(0, 1), ka2, oC[1]);
            PG8_WAIT_V(8); PG8_WAIT_L(0); PG8_BAR; PG8_MMA(0, 0, At, B0); PG8_MMA(0, 1, At, B1); PG8_BAR; PG8_SCHED;
            PG8_LDA(At, 1, 1); PG8_STAGE(PG8_SB(1, 0), b3, voffB); PG8_STAGE(PG8_SB(1, 1), b3 + hstep, voffB); PG8_STAGE(PG8_SA(1, 0), ka3, oC[0]);
            PG8_WAIT_V(8); PG8_WAIT_L(0); PG8_BAR; PG8_MMA(1, 0, At, B0); PG8_MMA(1, 1, At, B1); PG8_BAR; PG8_SCHED;
        }
        if constexpr (ALIGN_EPI) { if (wr == 0) PG8_BAR; }
        if constexpr (F8) asm volatile("s_nop 15\n\ts_nop 7" ::: "memory");
        { int fr_o = fr, fq_o = fq; asm volatile("" : "+v"(fr_o), "+v"(fq_o));
          E(acc, cur, wr, wc, fr_o, fq_o); }
        if (!has_next) break;
#pragma unroll
        for (int a = 0; a < 2; ++a)
#pragma unroll
            for (int b = 0; b < 2; ++b)
#pragma unroll
                for (int m = 0; m < 4; ++m)
#pragma unroll
                    for (int n = 0; n < 2; ++n) acc[a][b][m][n] = (f32x4){0.f, 0.f, 0.f, 0.f};
        cur = nxt; cB = nB; ++ui;
        if constexpr (ALIGN_EPI) { if (wr == 1) PG8_BAR; }
    }
    PG8_WAIT_V(0);
    if constexpr (!ALIGN_EPI) { if (wr == 0) PG8_BAR; }
    PG8_BAR;
#undef PG8_AROWS
#undef PG8_AOFF2
#undef PG8_SA
#undef PG8_SB
#undef PG8_STAGE
#undef PG8_LDA
#undef PG8_LDB
#undef PG8_MMA
#undef PG8_WAIT_V
#undef PG8_WAIT_L
#undef PG8_BAR
#undef PG8_SCHED
}
}

#define XB_TMO      128
#define XB_XCNT(j)  (256  + 64 * (j))
#define XB_XSUB(j)  (1280 + 64 * (j))
#define XB_XGEN(j)  (2304 + 64 * (j))
#define XB_TOP      3328
#define XB_TOPGEN   3392
#define XCD_BAR_WORDS 3456
#define XB_SPIN_CAP (1u << 22)
__device__ __forceinline__ unsigned xb_ld(unsigned* p)              { return __hip_atomic_load(p, __ATOMIC_RELAXED, __HIP_MEMORY_SCOPE_AGENT); }
__device__ __forceinline__ unsigned xb_add(unsigned* p, unsigned v) { return __hip_atomic_fetch_add(p, v, __ATOMIC_RELAXED, __HIP_MEMORY_SCOPE_AGENT); }
__device__ __forceinline__ unsigned xb_xcc_id() { return (unsigned)__builtin_amdgcn_s_getreg((3 << 11) | 20) & 0xFu; }
#define XB_SPIN(cond, bar) do { unsigned _sp = 0; while (cond) { __builtin_amdgcn_s_sleep(1); \
    if ((++_sp & 255u) == 0u) { if (xb_ld(&(bar)[XB_TMO])) break; if (_sp > XB_SPIN_CAP) { atomicAdd(&(bar)[XB_TMO], 1u); break; } } } } while (0)
struct XcdBarrier { unsigned* bar; unsigned x; volatile LAS unsigned* st; };
__device__ __forceinline__ XcdBarrier xcd_barrier_post(unsigned* bar, volatile LAS unsigned* st) {
    XcdBarrier b; b.bar = bar; b.x = xb_xcc_id(); b.st = st;
    if (threadIdx.x == 0) (void)xb_add(&bar[XB_XCNT(b.x)], 1u);
    return b;
}
__device__ __forceinline__ void xcd_barrier_complete(unsigned* bar, unsigned x, unsigned& nloc, unsigned& nx) {
    const unsigned G = gridDim.x * gridDim.y * gridDim.z;
    unsigned sum, cnt, mine, sp = 0u;
    for (;;) {
        sum = 0u; cnt = 0u; mine = 0u;
#pragma unroll 1
        for (unsigned j = 0; j < 16; ++j) { const unsigned c = xb_ld(&bar[XB_XCNT(j)]); sum += c; cnt += (c > 0u) ? 1u : 0u; mine = (j == x) ? c : mine; }
        if (sum == G) break;
        __builtin_amdgcn_s_sleep(1);
        if ((++sp & 255u) == 0u) { if (xb_ld(&bar[XB_TMO])) break; if (sp > XB_SPIN_CAP) { atomicAdd(&bar[XB_TMO], 1u); break; } }
    }
    nloc = mine > 0u ? mine : 1u; nx = cnt > 0u ? cnt : 1u;
}
__device__ __forceinline__ void xcd_barrier(const XcdBarrier& b) {
    asm volatile("s_waitcnt vmcnt(0)" ::: "memory");
    __syncthreads();
    if (threadIdx.x == 0) {
        unsigned* bar = b.bar;
        __builtin_amdgcn_s_waitcnt(0);
        unsigned nloc = b.st[0], nx = b.st[1];
        if (nloc == 0u) { xcd_barrier_complete(bar, b.x, nloc, nx); b.st[0] = nloc; b.st[1] = nx; }
        const unsigned old = xb_add(&bar[XB_XSUB(b.x)], 1u);
        const unsigned gen = old / nloc;
        if (old + 1u == (gen + 1u) * nloc) {
            __builtin_amdgcn_fence(__ATOMIC_RELEASE, "agent");
            asm volatile("s_waitcnt vmcnt(0)" ::: "memory");
            const unsigned og = xb_add(&bar[XB_TOP], 1u);
            const unsigned tg = og / nx;
            if (og + 1u == (tg + 1u) * nx) xb_add(&bar[XB_TOPGEN], 1u);
            else XB_SPIN(xb_ld(&bar[XB_TOPGEN]) == tg, bar);
            __builtin_amdgcn_fence(__ATOMIC_ACQUIRE, "agent");
            xb_add(&bar[XB_XGEN(b.x)], 1u);
            asm volatile("s_waitcnt vmcnt(0)" ::: "memory");
        } else {
            XB_SPIN(xb_ld(&bar[XB_XGEN(b.x)]) == gen, bar);
            __builtin_amdgcn_fence(__ATOMIC_ACQUIRE, "agent");
            asm volatile("s_waitcnt vmcnt(0)" ::: "memory");
        }
    }
    __syncthreads();
}

struct Args { const float* in[23]; float* out; unsigned char* ws; int ph_lo, ph_hi; };
typedef const Args __attribute__((address_space(4))) CArgs;
__device__ __forceinline__ CArgs* opaque_args() { CArgs* p = (CArgs*)__builtin_amdgcn_kernarg_segment_ptr(); asm volatile("" : "+s"(p)); return p; }
struct Frame {
    LAS unsigned char* lds;
    int tid, lane, wave, G, bid;
    float* out; unsigned char* ws;
};

struct EpiNull {
    static constexpr bool PERM = true;
    __device__ __forceinline__ void operator()(const f32x4 (&acc)[2][2][4][2], const pg8::Unit&, int, int, int, int) const {
#pragma unroll
        for (int a = 0; a < 2; ++a)
#pragma unroll
            for (int b = 0; b < 2; ++b)
#pragma unroll
                for (int m = 0; m < 4; ++m)
#pragma unroll
                    for (int n = 0; n < 2; ++n) asm volatile("" :: "v"(acc[a][b][m][n]));
    }
};
struct DenseSched {
    static constexpr bool GATHER = false;
    int nM, nN, nwg, G, c, kb; const char* Bt; const LAS int* UT;
    __device__ __forceinline__ void init(int M, int N, int G_, int c_, const void* Bt_) { nM = M / 256; nN = N / 256; nwg = nM * nN; G = G_; c = c_; Bt = (const char*)Bt_; UT = nullptr; kb = 2048; }
    __device__ __forceinline__ void build(LAS int* ut, int tid) { if (tid < 32) { pg8::Unit u; ut[tid] = next_calc(tid, u) ? (u.pm | (u.pn << 16)) : -1; } UT = ut; __syncthreads(); }
    __device__ __forceinline__ bool next(int i, pg8::Unit& u) const { const int w = (i < 32) ? UT[i] : -1; if (w < 0) return false; u.pm = w & 0xffff; u.pn = w >> 16; u.e = 0; u.lt = 0; return true; }
    __device__ __forceinline__ bool next_calc(int i, pg8::Unit& u) const {
        const long L = (long)i * G + c; if (L >= nwg) return false;
        int wgid = (int)L; { const int q = nwg / 8, r = nwg % 8, xcd = wgid % 8, off = wgid / 8; wgid = (xcd < r ? xcd * (q + 1) : r * (q + 1) + (xcd - r) * q) + off; }
        const int nig = 8 * nN, gid = wgid / nig, fm = gid * 8, gsz = (nM - fm) < 8 ? (nM - fm) : 8;
        u.pm = fm + ((wgid % nig) % gsz); u.pn = (wgid % nig) / gsz; u.e = 0; u.lt = 0; return true;
    }
    __device__ __forceinline__ int arow(const pg8::Unit& u, int r) const { return u.pm * 256 + r; }
    __device__ __forceinline__ bool mostly_padding(const pg8::Unit& u) const { return nN == PWP / 256 && u.pn == nN - 1; }
    __device__ __forceinline__ const char* bptr(const pg8::Unit& u) const { return Bt + (size_t)u.pn * 256 * kb; }
};
struct EpiProj {
    static constexpr bool PERM = true;
    bf16* O;
    __device__ __forceinline__ void operator()(const f32x4 (&acc)[2][2][4][2], const pg8::Unit& u, int wr, int wc, int fr, int fq) const {
        const int row0 = u.pm * 256 + wr * 64 + fr, col0 = u.pn * 256 + wc * 32 + 8 * fq;
#pragma unroll
        for (int ai = 0; ai < 2; ++ai)
#pragma unroll
            for (int m = 0; m < 4; ++m) { bf16* rowp = O + (size_t)(row0 + ai * 128 + m * 16) * PW + col0;
#pragma unroll
                for (int bj = 0; bj < 2; ++bj) { if (col0 + bj * 128 < PW) { const f32x4 v0 = acc[ai][bj][m][0], v1 = acc[ai][bj][m][1];
                    v4u w; w.x = pk2(v0[0], v0[1]); w.y = pk2(v0[2], v0[3]); w.z = pk2(v1[0], v1[1]); w.w = pk2(v1[2], v1[3]);
                    *(v4u*)(rowp + bj * 128) = w; } } }
    }
};
struct EpiOut {
    static constexpr bool PERM = true;
    const float* x; const float* mod; bf16* Y1; float sc;
    __device__ __forceinline__ void operator()(const f32x4 (&acc)[2][2][4][2], const pg8::Unit& u, int wr, int wc, int fr, int fq) const {
        const int row0 = u.pm * 256 + wr * 64 + fr, col0 = u.pn * 256 + wc * 32 + 8 * fq;
        const float* g1 = mod + (size_t)(u.pm >> 4) * 6144 + 2048;
        f32x4 gv[2][2];
#pragma unroll
        for (int bj = 0; bj < 2; ++bj)
#pragma unroll
            for (int n = 0; n < 2; ++n) gv[bj][n] = *(const f32x4*)(g1 + col0 + bj * 128 + 4 * n) * sc;
#pragma unroll
        for (int ai = 0; ai < 2; ++ai)
#pragma unroll
            for (int m = 0; m < 4; ++m) { const size_t off = (size_t)(row0 + ai * 128 + m * 16) * D + col0; bf16* rowp = Y1 + off;
#pragma unroll
                for (int bj = 0; bj < 2; ++bj) { const f32x4 x0 = *(const f32x4*)(x + off + bj * 128), x1 = *(const f32x4*)(x + off + bj * 128 + 4);
                    const f32x4 v0 = x0 + acc[ai][bj][m][0] * gv[bj][0], v1 = x1 + acc[ai][bj][m][1] * gv[bj][1];
                    v4u w; w.x = pk2(v0[0], v0[1]); w.y = pk2(v0[2], v0[3]); w.z = pk2(v1[0], v1[1]); w.w = pk2(v1[2], v1[3]);
                    *(v4u*)(rowp + bj * 128) = w; } }
    }
};
template <bool GU> struct MoeSched {
    static constexpr bool GATHER = GU;
    static constexpr bool gu = GU;
    const LAS int* TS; int ntr, G, c; const int* laid; const char* W;
    __device__ __forceinline__ bool next(int i, pg8::Unit& u) const {
        const int x = c & 7, j = c >> 3; int tl, pn;
        if (G != 256) { const int L = i * G + c, npn = gu ? 8 : 4; tl = L / npn; pn = L % npn; }
        else if (gu) { tl = (i * 8 + x) * 4 + (j >> 3); pn = j & 7; } else { tl = (i * 8 + x) * 8 + (j >> 2); pn = j & 3; }
        if (tl >= ntr) return false;
        const int tau = tl; const int e = ((const LAS unsigned char*)(TS + 72))[tau];
        u.pm = tl; u.pn = pn; u.e = e; u.lt = tau - TS[e]; return true;
    }
    __device__ __forceinline__ bool mostly_padding(const pg8::Unit&) const { return false; }
    __device__ __forceinline__ int arow(const pg8::Unit& u, int r) const {
        if (!gu) return u.pm * 256 + r;
        const int pos = u.lt * 256 + r, cnt = TS[33 + u.e];
        return pos < cnt ? (laid[(size_t)u.e * LISTCAP + pos] >> 2) : 0;
    }
    __device__ __forceinline__ const char* bptr(const pg8::Unit& u) const { return W + ((size_t)u.e * (gu ? 2048 : 1024) + (size_t)u.pn * 256) * 1024; }
};
struct EpiGU {
    static constexpr bool PERM = true;
    unsigned char* ACT; const float* b_gu;
    __device__ __forceinline__ void operator()(const f32x4 (&acc)[2][2][4][2], const pg8::Unit& u, int wr, int wc, int fr, int fq) const {
        const int row0 = u.pm * 256 + wr * 64 + fr, j0 = u.pn * 128 + wc * 32 + 8 * fq;
        const float* bp = b_gu + (size_t)u.e * 2048 + 2 * j0;
        f32x4 bv[4];
#pragma unroll
        for (int q = 0; q < 4; ++q) bv[q] = *(const f32x4*)(bp + 4 * q);
        f32x2 bg[4], bu[4];
#pragma unroll
        for (int q = 0; q < 4; ++q) { bg[q] = (f32x2){bv[q][0], bv[q][2]}; bu[q] = (f32x2){bv[q][1], bv[q][3]}; }
#pragma unroll
        for (int ai = 0; ai < 2; ++ai)
#pragma unroll
            for (int m = 0; m < 4; ++m) { unsigned char* rowp = ACT + (size_t)(row0 + ai * 128 + m * 16) * DFF + j0; f32x2 a[4];
#pragma unroll
                for (int n = 0; n < 2; ++n)
#pragma unroll
                    for (int p = 0; p < 2; ++p) { const int q = 2 * n + p;
                        const f32x4 ag = acc[ai][0][m][n], au = acc[ai][1][m][n];
                        f32x2 g = (f32x2){ag[2 * p], ag[2 * p + 1]} * WSCALE_INV + bg[q], up = (f32x2){au[2 * p], au[2 * p + 1]} * WSCALE_INV + bu[q];
                        g.x = fminf(g.x, 7.0f); g.y = fminf(g.y, 7.0f); up.x = __builtin_amdgcn_fmed3f(up.x, -7.0f, 7.0f); up.y = __builtin_amdgcn_fmed3f(up.y, -7.0f, 7.0f);
                        const f32x2 t = g * (-1.702f * 1.4426950408889634f); f32x2 e; e.x = __builtin_amdgcn_exp2f(t.x); e.y = __builtin_amdgcn_exp2f(t.y);
                        const f32x2 d = e + 1.0f; f32x2 sg; sg.x = __builtin_amdgcn_rcpf(d.x); sg.y = __builtin_amdgcn_rcpf(d.y);
                        a[q] = ((up + 1.0f) * g) * sg; }
                v2u w; w.x = pk4_fp8(a[0].x, a[0].y, a[1].x, a[1].y); w.y = pk4_fp8(a[2].x, a[2].y, a[3].x, a[3].y);
                *(v2u*)rowp = w; }
    }
};
struct EpiDN {
    static constexpr bool PERM = true;
    unsigned char* YA; const float* b_dn; const LAS int* TS;
    __device__ __forceinline__ void operator()(const f32x4 (&acc)[2][2][4][2], const pg8::Unit& u, int wr, int wc, int fr, int fq) const {
        const int col0 = u.pn * 256 + wc * 32 + 8 * fq, cnt = TS[33 + u.e];
        f32x4 bv[2][2];
#pragma unroll
        for (int bj = 0; bj < 2; ++bj)
#pragma unroll
            for (int n = 0; n < 2; ++n) bv[bj][n] = *(const f32x4*)(b_dn + (size_t)u.e * D + col0 + bj * 128 + 4 * n);
#pragma unroll
        for (int ai = 0; ai < 2; ++ai)
#pragma unroll
            for (int m = 0; m < 4; ++m) { const int r = ai * 128 + wr * 64 + m * 16 + fr;
                if (u.lt * 256 + r < cnt) { unsigned char* rowp = YA + ((size_t)u.pm * 256 + r) * D + col0;
#pragma unroll
                    for (int bj = 0; bj < 2; ++bj) { const f32x4 v0 = acc[ai][bj][m][0] * WSCALE_INV + bv[bj][0], v1 = acc[ai][bj][m][1] * WSCALE_INV + bv[bj][1];
                        v2u w; w.x = pk4_fp8(v0[0], v0[1], v0[2], v0[3]); w.y = pk4_fp8(v1[0], v1[1], v1[2], v1[3]);
                        *(v2u*)(rowp + bj * 128) = w; } }
                asm volatile("" ::: "memory"); }
    }
};

template <bool MAPGU>
__device__ __forceinline__ void p0_transpose_item(const float* W, int N, bf16* WT, LAS float* scr, int item, int lane) {
    const int nblk = N / 32, kb = item / nblk, nb = item % nblk, k0 = 64 * kb, n0 = 32 * nb;
#pragma unroll
    for (int i = 0; i < 32; ++i) { const int kk = 2 * i + (lane >> 5); scr[kk * 33 + (lane & 31)] = W[(size_t)(k0 + kk) * N + n0 + (lane & 31)]; }
    LDS_WAIT(); asm volatile("" ::: "memory");
    const int c = lane & 7;
#pragma unroll
    for (int j = 0; j < 4; ++j) { const int n = (lane >> 3) + 8 * j; const LAS float* s = scr + (8 * c) * 33 + n;
        v4u o; o.x = pk2(s[0 * 33], s[1 * 33]); o.y = pk2(s[2 * 33], s[3 * 33]); o.z = pk2(s[4 * 33], s[5 * 33]); o.w = pk2(s[6 * 33], s[7 * 33]);
        int row = n0 + n;
        if (MAPGU) { const int jj = row >> 1; row = (jj >> 7) * 256 + (row & 1) * 128 + (jj & 127); }
        *(v4u*)(WT + (size_t)row * D + k0 + 8 * c) = o; }
    LDS_WAIT(); asm volatile("" ::: "memory");
}
template <bool MAPGU>
__device__ __forceinline__ void p0_transpose_item_f8(const float* W, int N, unsigned char* WT, LAS float* scr, int item, int lane) {
    const int nblk = N / 32, kb = item / nblk, nb = item % nblk, k0 = 64 * kb, n0 = 32 * nb;
#pragma unroll
    for (int i = 0; i < 32; ++i) { const int kk = 2 * i + (lane >> 5); scr[kk * 33 + (lane & 31)] = W[(size_t)(k0 + kk) * N + n0 + (lane & 31)] * WSCALE; }
    LDS_WAIT(); asm volatile("" ::: "memory");
    const int c = lane & 3;
#pragma unroll
    for (int j = 0; j < 2; ++j) { const int n = (lane >> 2) + 16 * j; const LAS float* s = scr + (16 * c) * 33 + n;
        v4u o; o.x = pk4_fp8(s[0 * 33], s[1 * 33], s[2 * 33], s[3 * 33]); o.y = pk4_fp8(s[4 * 33], s[5 * 33], s[6 * 33], s[7 * 33]);
        o.z = pk4_fp8(s[8 * 33], s[9 * 33], s[10 * 33], s[11 * 33]); o.w = pk4_fp8(s[12 * 33], s[13 * 33], s[14 * 33], s[15 * 33]);
        int row = n0 + n;
        if (MAPGU) { const int jj = row >> 1; row = (jj >> 7) * 256 + (row & 1) * 128 + (jj & 127); }
        *(v4u*)(WT + (size_t)row * D + k0 + 16 * c) = o; }
    LDS_WAIT(); asm volatile("" ::: "memory");
}
constexpr int P0_TS = 144;
struct P0Item { const float* W; void* O; int N, k0, n0, kind; };
__device__ __forceinline__ P0Item p0_item(const Frame& F, CArgs* A, int it) {
    constexpr int I_IN = 8 * 25, I_OUT = 8 * 8, I_GU = 8 * 16, I_DN = 8 * 8;
    P0Item r; int x = it;
    if (x < I_IN) { r.W = A->in[7]; r.O = (void*)(F.ws + WS_WIN); r.N = PW; r.k0 = (x / 25) * 128; r.n0 = (x % 25) * 128; r.kind = 0; return r; } x -= I_IN;
    if (x < I_OUT) { r.W = A->in[14]; r.O = (void*)(F.ws + WS_WOUT); r.N = D; r.k0 = (x >> 3) * 128; r.n0 = (x & 7) * 128; r.kind = OUTPROJ_F8 ? 1 : 0; return r; } x -= I_OUT;
    if (x < NEXP * I_GU) { const int e = x / I_GU, y = x % I_GU; r.W = A->in[18] + (size_t)e * D * 2048; r.O = (void*)((unsigned char*)F.out + DO_WGU + (size_t)e * 2048 * D); r.N = 2048; r.k0 = (y >> 4) * 128; r.n0 = (y & 15) * 128; r.kind = 2; return r; } x -= NEXP * I_GU;
    { const int e = x / I_DN, y = x % I_DN; r.W = A->in[20] + (size_t)e * D * D; r.O = (void*)((unsigned char*)F.out + DO_WDN + (size_t)e * D * D); r.N = D; r.k0 = (y >> 3) * 128; r.n0 = (y & 7) * 128; r.kind = 1; return r; }
}
__device__ __forceinline__ void p0_load(const P0Item& I, int tid, f32x4 (&v)[8]) {
#pragma unroll
    for (int q = 0; q < 8; ++q) { const int idx = tid + NTHREADS * q, k = idx >> 5, col = I.n0 + 4 * (idx & 31);
        v[q] = (col < I.N) ? *(const f32x4*)(I.W + (size_t)(I.k0 + k) * I.N + col) : (f32x4){0.f, 0.f, 0.f, 0.f}; }
}
__device__ __forceinline__ void p0_emit(const P0Item& I, LAS unsigned char* lds, int wave, int i, int g) {
    const unsigned a0 = (unsigned)(uintptr_t)lds + (unsigned)(((32 * g + (i >> 2)) * P0_TS + 16 * wave + 4 * (i & 3)) * 2);
    s16x4 r[8];
    asm volatile("ds_read_b64_tr_b16 %0, %8\n\tds_read_b64_tr_b16 %1, %8 offset:1152\n\tds_read_b64_tr_b16 %2, %8 offset:2304\n\tds_read_b64_tr_b16 %3, %8 offset:3456\n\t"
                 "ds_read_b64_tr_b16 %4, %8 offset:4608\n\tds_read_b64_tr_b16 %5, %8 offset:5760\n\tds_read_b64_tr_b16 %6, %8 offset:6912\n\tds_read_b64_tr_b16 %7, %8 offset:8064\n\ts_waitcnt lgkmcnt(0)"
                 : "=&v"(r[0]), "=&v"(r[1]), "=&v"(r[2]), "=&v"(r[3]), "=&v"(r[4]), "=&v"(r[5]), "=&v"(r[6]), "=&v"(r[7]) : "v"(a0) : "memory");
    const int n = I.n0 + 16 * wave + i;
    if (n < I.N) {
        if (I.kind == 0) { bf16* op = (bf16*)I.O + (size_t)n * D + I.k0 + 32 * g;
#pragma unroll
            for (int q = 0; q < 4; ++q) { v4u w; w.x = (unsigned)(unsigned short)r[2 * q][0] | ((unsigned)(unsigned short)r[2 * q][1] << 16); w.y = (unsigned)(unsigned short)r[2 * q][2] | ((unsigned)(unsigned short)r[2 * q][3] << 16);
                w.z = (unsigned)(unsigned short)r[2 * q + 1][0] | ((unsigned)(unsigned short)r[2 * q + 1][1] << 16); w.w = (unsigned)(unsigned short)r[2 * q + 1][2] | ((unsigned)(unsigned short)r[2 * q + 1][3] << 16);
                *(v4u*)(op + 8 * q) = w; } }
        else { int row = n; if (I.kind == 2) { const int jj = n >> 1; row = (jj >> 7) * 256 + (n & 1) * 128 + (jj & 127); }
            unsigned char* op = (unsigned char*)I.O + (size_t)row * D + I.k0 + 32 * g;
#pragma unroll
            for (int q = 0; q < 2; ++q) { v4u w; unsigned* wp = (unsigned*)&w;
#pragma unroll
                for (int j = 0; j < 4; ++j) { const s16x4 x = r[4 * q + j]; wp[j] = pk4_fp8(bf2f((bf16)x[0]) * WSCALE, bf2f((bf16)x[1]) * WSCALE, bf2f((bf16)x[2]) * WSCALE, bf2f((bf16)x[3]) * WSCALE); }
                *(v4u*)(op + 16 * q) = w; } } }
}
__device__ __forceinline__ void p0_phase(const Frame& F, CArgs* A) {
    LAS unsigned char* lds = F.lds; const int tid = F.tid, lane = F.lane, wave = F.wave, i = lane & 15, g = lane >> 4;
    constexpr int NITEMS = 8 * 25 + 8 * 8 + NEXP * 8 * 16 + NEXP * 8 * 8;
    f32x4 va[8], vb[8];
    if (F.bid < NITEMS) { const P0Item I0 = p0_item(F, A, F.bid); p0_load(I0, tid, va); }
    if (F.bid + F.G < NITEMS) { const P0Item I1 = p0_item(F, A, F.bid + F.G); p0_load(I1, tid, vb); }
#define P0_STEP(VCUR, it_) do { const P0Item I = p0_item(F, A, it_); \
        _Pragma("unroll") for (int q = 0; q < 8; ++q) { const int idx = tid + NTHREADS * q, k = idx >> 5, p = idx & 31; v2u w; w.x = pk2(VCUR[q][0], VCUR[q][1]); w.y = pk2(VCUR[q][2], VCUR[q][3]); \
            *(LAS v2u*)(lds + (k * P0_TS + 4 * p) * 2) = w; } \
        if ((it_) + 2 * F.G < NITEMS) { const P0Item In = p0_item(F, A, (it_) + 2 * F.G); p0_load(In, tid, VCUR); } \
        LDS_BARRIER(); \
        p0_emit(I, lds, wave, i, g); \
        LDS_BARRIER(); } while (0)
#pragma unroll 1
    for (int it = F.bid; it < NITEMS; it += 2 * F.G) {
        P0_STEP(va, it);
        if (it + F.G < NITEMS) P0_STEP(vb, it + F.G);
    }
#undef P0_STEP
    { v4u z = {0u, 0u, 0u, 0u}; v4u* p = (v4u*)(((bf16*)(F.ws + WS_WIN)) + (size_t)PW * D); const int n16 = (PWP - PW) * D * 2 / 16;
      for (int i = F.bid * NTHREADS + F.tid; i < n16; i += F.G * NTHREADS) p[i] = z; }
    __syncthreads();
    LAS float* sl = (LAS float*)F.lds;
    LAS float* red = (LAS float*)(F.lds + 1024 * 20 * 4);
    bool filled = false;
    for (int it = F.bid; it < 6144 / 64; it += F.G) {
        if (!filled) {
            for (int i = F.tid; i < 17 * 1024; i += NTHREADS) { const int m = i >> 10, k = i & 1023; const float v = (m < 16) ? A->in[1][m * 1024 + k] : A->in[3][k]; sl[k * 20 + m] = v * __builtin_amdgcn_rcpf(1.0f + fexp(-v)); }
            filled = true; __syncthreads();
        }
        float a[17];
#pragma unroll
        for (int m = 0; m < 17; ++m) a[m] = 0.f;
        const int j = it * 64 + F.lane;
#pragma unroll 1
        for (int kb = 0; kb < 128; kb += 16) { float wv[16];
#pragma unroll
          for (int q = 0; q < 16; ++q) wv[q] = A->in[4][(size_t)(F.wave * 128 + kb + q) * 6144 + j];
#pragma unroll
          for (int q = 0; q < 16; ++q) { const int k = F.wave * 128 + kb + q; const float w = wv[q];
            const LAS float* sp = sl + k * 20;
            const f32x4 s0 = *(const LAS f32x4*)sp, s1 = *(const LAS f32x4*)(sp + 4), s2 = *(const LAS f32x4*)(sp + 8), s3 = *(const LAS f32x4*)(sp + 12); const float s4 = sp[16];
            a[0] += s0[0] * w; a[1] += s0[1] * w; a[2] += s0[2] * w; a[3] += s0[3] * w; a[4] += s1[0] * w; a[5] += s1[1] * w; a[6] += s1[2] * w; a[7] += s1[3] * w;
            a[8] += s2[0] * w; a[9] += s2[1] * w; a[10] += s2[2] * w; a[11] += s2[3] * w; a[12] += s3[0] * w; a[13] += s3[1] * w; a[14] += s3[2] * w; a[15] += s3[3] * w; a[16] += s4 * w; } }
#pragma unroll
        for (int m = 0; m < 17; ++m) red[(F.wave * 17 + m) * 64 + F.lane] = a[m];
        __syncthreads();
        for (int i = F.tid; i < 17 * 64; i += NTHREADS) { const int m = i >> 6, l = i & 63; float s = 0.f;
#pragma unroll
            for (int w = 0; w < 8; ++w) s += red[(w * 17 + m) * 64 + l];
            ((float*)(F.ws + WS_MOD))[(size_t)m * 6144 + it * 64 + l] = s + A->in[5][it * 64 + l]; }
        __syncthreads();
    }
}

__device__ __forceinline__ void p1_phase(const Frame& F, CArgs* A) {
    const int gw = F.bid * NWAVES + F.wave, NGW = F.G * NWAVES;
    for (int r0 = gw; r0 < NROWS; r0 += 2 * NGW) {
        const int r1 = r0 + NGW; const bool two = r1 < NROWS;
        const float* xa = (r0 < NLAT) ? A->in[0] + (size_t)r0 * D : A->in[2] + (size_t)(r0 - NLAT) * D;
        const float* xb = !two ? xa : ((r1 < NLAT) ? A->in[0] + (size_t)r1 * D : A->in[2] + (size_t)(r1 - NLAT) * D);
        f32x4 va[4], vb[4];
#pragma unroll
        for (int j = 0; j < 4; ++j) { va[j] = ((const f32x4*)xa)[F.lane + 64 * j]; vb[j] = ((const f32x4*)xb)[F.lane + 64 * j]; }
#pragma unroll
        for (int which = 0; which < 2; ++which) { if (which == 1 && !two) break;
            const int r = which ? r1 : r0; const int mrow = (r < NLAT) ? (r >> 12) : 16;
            const float* sh = ((float*)(F.ws + WS_MOD)) + (size_t)mrow * 6144; const float* sc = sh + 1024;
            float s = 0.f;
#pragma unroll
            for (int j = 0; j < 4; ++j) { const f32x4 v = which ? vb[j] : va[j]; s += (v.x * v.x + v.y * v.y) + (v.z * v.z + v.w * v.w); }
            const float rstd = 1.0f / sqrtf(wave_sum(s) * (1.f / D) + EPS);
            unsigned long long* o8 = (unsigned long long*)(((bf16*)(F.ws + WS_HN)) + (size_t)r * D) + F.lane;
#pragma unroll
            for (int j = 0; j < 4; ++j) { const int c4 = F.lane + 64 * j; const f32x4 v = which ? vb[j] : va[j]; const f32x4 w = ((const f32x4*)A->in[6])[c4], a = ((const f32x4*)sc)[c4], b = ((const f32x4*)sh)[c4];
                const f32x4 y = (v * rstd) * w * (a + 1.0f) + b;
                o8[64 * j] = (unsigned long long)pk2(y.x, y.y) | ((unsigned long long)pk2(y.z, y.w) << 32); } }
    }
}

constexpr int GL_ZL = 0;
constexpr int GL_BC = 8192;
constexpr int GL_TOT = GL_BC + 32768;
constexpr int GL_V = GL_TOT + 512;
constexpr int GL_A = GL_V + 64 * 136 * 2;
constexpr int GL_B = GL_A + 2 * 64 * 72 * 2;
constexpr int GL_P = GL_B + 2 * 64 * 72 * 2;
constexpr int GL_SS = GL_P + 64 * 72 * 2;
constexpr int GL_SEG = GL_SS + 512;
constexpr int GL_END = GL_SEG + 2048;
static_assert(GL_END <= RING_BYTES && (GL_V % 16) == 0 && (GL_A % 16) == 0 && (GL_B % 16) == 0 && (GL_P % 16) == 0, "GLA LDS map");

__device__ __forceinline__ s16x4 tr_read(unsigned lds_addr) { s16x4 r; asm volatile("ds_read_b64_tr_b16 %0, %1\n\ts_waitcnt lgkmcnt(0)" : "=&v"(r) : "v"(lds_addr) : "memory"); return r; }
__device__ __forceinline__ void v_frag2(LAS unsigned char* lds, int v0, int lane, bf16x8& f0, bf16x8& f1) {
    const int i = lane & 15, g = lane >> 4;
    const unsigned a0 = (unsigned)(uintptr_t)(lds + GL_V) + (unsigned)(((8 * g + (i >> 2)) * 136 + v0 + 4 * (i & 3)) * 2);
    s16x4 r0, r1, r2, r3;
    asm volatile("ds_read_b64_tr_b16 %0, %4\n\tds_read_b64_tr_b16 %1, %4 offset:1088\n\tds_read_b64_tr_b16 %2, %4 offset:8704\n\tds_read_b64_tr_b16 %3, %4 offset:9792\n\ts_waitcnt lgkmcnt(0)"
                 : "=&v"(r0), "=&v"(r1), "=&v"(r2), "=&v"(r3) : "v"(a0) : "memory");
    f0[0] = r0[0]; f0[1] = r0[1]; f0[2] = r0[2]; f0[3] = r0[3]; f0[4] = r1[0]; f0[5] = r1[1]; f0[6] = r1[2]; f0[7] = r1[3];
    f1[0] = r2[0]; f1[1] = r2[1]; f1[2] = r2[2]; f1[3] = r2[3]; f1[4] = r3[0]; f1[5] = r3[1]; f1[6] = r3[2]; f1[7] = r3[3];
}
__device__ __forceinline__ bf16x8 v_frag(LAS unsigned char* lds, int ks, int v0, int lane) {
    const int i = lane & 15, g = lane >> 4;
    const unsigned a0 = (unsigned)(uintptr_t)(lds + GL_V) + (unsigned)(((32 * ks + 8 * g + (i >> 2)) * 136 + v0 + 4 * (i & 3)) * 2);
    const s16x4 lo = tr_read(a0), hi = tr_read(a0 + 4 * 136 * 2);
    bf16x8 r; r[0] = lo[0]; r[1] = lo[1]; r[2] = lo[2]; r[3] = lo[3]; r[4] = hi[0]; r[5] = hi[1]; r[6] = hi[2]; r[7] = hi[3]; return r;
}
struct GlaRegs { v4u zw, vw[2]; };
__device__ __forceinline__ GlaRegs gla_load(const Frame& F, size_t prow, int h) {
    GlaRegs r; const int tid = F.tid; const bf16* P = (const bf16*)(F.ws + WS_P);
    { const int t = (tid & 255) >> 2, q = tid & 3; r.zw = *(const v4u*)(P + (prow + t) * PW + CAF + 8 * q); }
#pragma unroll
    for (int i = 0; i < 2; ++i) { const int pc = tid + i * NTHREADS, t = pc >> 4, c = pc & 15; r.vw[i] = *(const v4u*)(P + (prow + t) * PW + CV + h * 128 + c * 8); }
    return r;
}
__device__ __forceinline__ void gla_prep(const Frame& F, CArgs* A, const GlaRegs& R, int h) {
    LAS unsigned char* lds = F.lds; const int tid = F.tid;
    if (tid < 256) { const int t = tid >> 2, q = tid & 3; const v4u w = R.zw;
        LAS float* z = (LAS float*)(lds + GL_ZL) + (q >> 1) * 1024 + t * 16 + (q & 1) * 8;
        *(LAS f32x4*)z = (f32x4){bflo(w.x), bfhi(w.x), bflo(w.y), bfhi(w.y)}; *(LAS f32x4*)(z + 4) = (f32x4){bflo(w.z), bfhi(w.z), bflo(w.w), bfhi(w.w)}; }
#pragma unroll
    for (int i = 0; i < 2; ++i) { const int pc = tid + i * NTHREADS, t = pc >> 4, c = pc & 15; *(LAS v4u*)(lds + GL_V + (t * 136 + c * 8) * 2) = R.vw[i]; }
    __syncthreads();
    { const int dir = tid >> 8, seg = (tid >> 6) & 3, d = tid & 63;
      const float* up = dir ? A->in[10] : A->in[8]; const float bias = (dir ? A->in[11] : A->in[9])[h * 64 + d];
      float u[16];
#pragma unroll
      for (int r = 0; r < 16; ++r) u[r] = up[r * 256 + h * 64 + d];
      const LAS float* zl = (const LAS float*)(lds + GL_ZL) + dir * 1024; LAS float* bc = (LAS float*)(lds + GL_BC) + dir * 4096 + d;
      LAS float* sg = (LAS float*)(lds + GL_SEG) + dir * 256 + d;
      float c[16]; float cum = 0.f;
#pragma unroll
      for (int i = 0; i < 16; ++i) { const int t = seg * 16 + (dir ? 15 - i : i); const LAS float* zp = zl + t * 16;
          const f32x4 z0 = *(const LAS f32x4*)zp, z1 = *(const LAS f32x4*)(zp + 4), z2 = *(const LAS f32x4*)(zp + 8), z3 = *(const LAS f32x4*)(zp + 12);
          float z = bias + z0[0] * u[0] + z0[1] * u[1] + z0[2] * u[2] + z0[3] * u[3] + z1[0] * u[4] + z1[1] * u[5] + z1[2] * u[6] + z1[3] * u[7]
                         + z2[0] * u[8] + z2[1] * u[9] + z2[2] * u[10] + z2[3] * u[11] + z3[0] * u[12] + z3[1] * u[13] + z3[2] * u[14] + z3[3] * u[15];
          const float ls = fminf(z, 0.f) - __logf(1.0f + __expf(-fabsf(z)));
          cum += ls * (1.0f / 16.0f); c[i] = cum; }
      sg[seg * 64] = cum;
      __syncthreads();
      float off = 0.f, tot = 0.f;
#pragma unroll
      for (int s2 = 0; s2 < 4; ++s2) { const float v = sg[s2 * 64]; tot += v; off += (dir ? (s2 > seg) : (s2 < seg)) ? v : 0.f; }
#pragma unroll
      for (int i = 0; i < 16; ++i) { const int t = seg * 16 + (dir ? 15 - i : i); bc[t * 64] = off + c[i]; }
      if (seg == 0) ((LAS float*)(lds + GL_TOT))[dir * 64 + d] = tot; }
    __syncthreads();
}

__device__ __forceinline__ size_t chunk_row(int b, int cc) { return cc < 4 ? (size_t)NLAT + b * CTXL + cc * 64 : (size_t)b * SEQ + (cc - 4) * 64; }
__device__ __forceinline__ void p3_phase(const Frame& F, CArgs* A) {
    LAS unsigned char* lds = F.lds; const int tid = F.tid, lane = F.lane, wave = F.wave;
    GlaRegs cur; if (F.bid < NBATCH * NCC * 4) { const int bc0 = F.bid >> 2; cur = gla_load(F, chunk_row(bc0 / NCC, bc0 % NCC), F.bid & 3); }
    for (int it = F.bid; it < NBATCH * NCC * 4; it += F.G) {
        const int h = it & 3, bc = it >> 2, b = bc / NCC, cc = bc % NCC; const size_t prow = chunk_row(b, cc);
        GlaRegs nxt = cur; { const int itn = it + F.G; if (itn < NBATCH * NCC * 4) { const int bcn = itn >> 2; nxt = gla_load(F, chunk_row(bcn / NCC, bcn % NCC), itn & 3); } }
        float kf[8];
        { const int d = tid & 63, tg = tid >> 6;
#pragma unroll
          for (int j = 0; j < 8; ++j) kf[j] = bf2f(((bf16*)(F.ws + WS_P))[(prow + tg * 8 + j) * PW + CK + h * 64 + d]); }
        gla_prep(F, A, cur, h); cur = nxt;
        if (tid < 128) { const int dir = tid >> 6, d = tid & 63; ((float*)(F.ws + WS_DECAY))[(((size_t)dir * NBATCH + b) * NCC + cc) * 256 + h * 64 + d] = __expf(((const LAS float*)(lds + GL_TOT))[dir * 64 + d]); }
        { const int d = tid & 63, tg = tid >> 6;
#pragma unroll
          for (int dir = 0; dir < 2; ++dir) { const float tot = ((const LAS float*)(lds + GL_TOT))[dir * 64 + d]; const LAS float* bcp = (const LAS float*)(lds + GL_BC) + dir * 4096 + (tg * 8) * 64 + d; float s[8];
#pragma unroll
              for (int j = 0; j < 8; ++j) s[j] = kf[j] * __expf(tot - bcp[j * 64]);
              v4u w; w.x = pk2(s[0], s[1]); w.y = pk2(s[2], s[3]); w.z = pk2(s[4], s[5]); w.w = pk2(s[6], s[7]);
              *(LAS v4u*)(lds + GL_A + ((dir * 64 + d) * 72 + tg * 8) * 2) = w; } }
        __syncthreads();
        { const int dir = wave & 1, dt = wave >> 1, i = lane & 15, g = lane >> 4;
          bf16x8 af[2];
#pragma unroll
          for (int ks = 0; ks < 2; ++ks) af[ks] = *(const LAS bf16x8*)(lds + GL_A + ((dir * 64 + dt * 16 + i) * 72 + 32 * ks + 8 * g) * 2);
          bf16* kvp = ((bf16*)(F.ws + WS_KV)) + ((((size_t)dir * NBATCH + b) * NCC + cc) * 4 + h) * 8192;
#pragma unroll 2
          for (int vt = 0; vt < 8; ++vt) { f32x4 acc = {0.f, 0.f, 0.f, 0.f}; bf16x8 vf0, vf1; v_frag2(lds, vt * 16, lane, vf0, vf1);
              acc = __builtin_amdgcn_mfma_f32_16x16x32_bf16(af[0], vf0, acc, 0, 0, 0); acc = __builtin_amdgcn_mfma_f32_16x16x32_bf16(af[1], vf1, acc, 0, 0, 0);
              v2u w; w.x = pk2(acc[0], acc[1]); w.y = pk2(acc[2], acc[3]);
              *(v2u*)(kvp + (size_t)(vt * 16 + i) * 64 + dt * 16 + 4 * g) = w; } }
        __syncthreads();
    }
}

constexpr int G2_ZL = 0;
constexpr int G2_HT = 8192;
constexpr int G2_TOT = G2_HT + 4096;
constexpr int G2_A = G2_TOT + 1024;
constexpr int G2_B = G2_A + 256 * 72 * 2;
constexpr int G2_VS = 528;
static_assert(G2_B + 64 * G2_VS * 2 <= RING_BYTES && G2_B + 256 * 72 * 2 <= RING_BYTES && (G2_A % 16) == 0 && (G2_B % 16) == 0, "GLA v2 LDS map");
__device__ __forceinline__ void tr_frag2(unsigned tile_addr, int c0, int lane, bf16x8& f0, bf16x8& f1) {
    const int i = lane & 15, g = lane >> 4;
    const unsigned a0 = tile_addr + (unsigned)(((8 * g + (i >> 2)) * G2_VS + c0 + 4 * (i & 3)) * 2);
    s16x4 r0, r1, r2, r3;
    asm volatile("ds_read_b64_tr_b16 %0, %4\n\tds_read_b64_tr_b16 %1, %4 offset:4224\n\tds_read_b64_tr_b16 %2, %4 offset:33792\n\tds_read_b64_tr_b16 %3, %4 offset:38016\n\ts_waitcnt lgkmcnt(0)"
                 : "=&v"(r0), "=&v"(r1), "=&v"(r2), "=&v"(r3) : "v"(a0) : "memory");
    f0[0] = r0[0]; f0[1] = r0[1]; f0[2] = r0[2]; f0[3] = r0[3]; f0[4] = r1[0]; f0[5] = r1[1]; f0[6] = r1[2]; f0[7] = r1[3];
    f1[0] = r2[0]; f1[1] = r2[1]; f1[2] = r2[2]; f1[3] = r2[3]; f1[4] = r3[0]; f1[5] = r3[1]; f1[6] = r3[2]; f1[7] = r3[3];
}
static_assert(4 * G2_VS * 2 == 4224 && 32 * G2_VS * 2 == 33792 && 36 * G2_VS * 2 == 38016, "tr_frag2 offsets");
__device__ __forceinline__ float log_sigmoid16(float z) { return (fminf(z, 0.f) - __logf(1.0f + __expf(-fabsf(z)))) * (1.0f / 16.0f); }

__device__ __forceinline__ void p3v2_phase(const Frame& F, CArgs* A) {
    LAS unsigned char* lds = F.lds; const int tid = F.tid, lane = F.lane, wave = F.wave, i = lane & 15, g = lane >> 4;
    const int c = tid & 255, th = tid >> 8;
    const bf16* P = (const bf16*)(F.ws + WS_P);
#pragma unroll 1
    for (int it = F.bid; it < NBATCH * NCC; it += F.G) {
        const int b = it / NCC, cc = it % NCC; const size_t prow = chunk_row(b, cc);
        if (tid < 256) { const int t = tid >> 2, q = tid & 3; const v4u w = *(const v4u*)(P + (prow + t) * PW + CAF + 8 * q);
            LAS float* z = (LAS float*)(lds + G2_ZL) + (q >> 1) * 1024 + t * 16 + (q & 1) * 8;
            *(LAS f32x4*)z = (f32x4){bflo(w.x), bfhi(w.x), bflo(w.y), bfhi(w.y)}; *(LAS f32x4*)(z + 4) = (f32x4){bflo(w.z), bfhi(w.z), bflo(w.w), bfhi(w.w)}; }
#pragma unroll
        for (int j = 0; j < 8; ++j) { const int pc = tid + j * NTHREADS, t = pc >> 6, cv = pc & 63;
            *(LAS v4u*)(lds + G2_B + (t * G2_VS + cv * 8) * 2) = *(const v4u*)(P + (prow + t) * PW + CV + cv * 8); }
        float kk[32];
#pragma unroll
        for (int tl = 0; tl < 32; ++tl) kk[tl] = bf2f(P[(prow + th * 32 + tl) * PW + CK + c]);
        __syncthreads();
#pragma unroll
        for (int dir = 0; dir < 2; ++dir) {
            { const float* up = dir ? A->in[10] : A->in[8]; const float bias = (dir ? A->in[11] : A->in[9])[c];
              float u[16];
#pragma unroll
              for (int r = 0; r < 16; ++r) u[r] = up[r * 256 + c];
              const LAS float* zl = (const LAS float*)(lds + G2_ZL) + dir * 1024 + th * 512;
              float cl[32]; float cum = 0.f;
#pragma unroll
              for (int ii = 0; ii < 32; ++ii) { const int tl = dir ? 31 - ii : ii; const LAS float* zp = zl + tl * 16;
                  const f32x4 z0 = *(const LAS f32x4*)zp, z1 = *(const LAS f32x4*)(zp + 4), z2 = *(const LAS f32x4*)(zp + 8), z3 = *(const LAS f32x4*)(zp + 12);
                  const float z = bias + z0[0] * u[0] + z0[1] * u[1] + z0[2] * u[2] + z0[3] * u[3] + z1[0] * u[4] + z1[1] * u[5] + z1[2] * u[6] + z1[3] * u[7]
                                       + z2[0] * u[8] + z2[1] * u[9] + z2[2] * u[10] + z2[3] * u[11] + z3[0] * u[12] + z3[1] * u[13] + z3[2] * u[14] + z3[3] * u[15];
                  cum += log_sigmoid16(z); cl[tl] = cum; }
              LAS float* ht = (LAS float*)(lds + G2_HT) + dir * 512;
              ht[th * 256 + c] = cum;
              __syncthreads();
              const float other = ht[(1 - th) * 256 + c], tot = cum + other;
              const float off = (dir == 0) ? (th ? other : 0.f) : (th ? 0.f : other);
              if (th == 0) { ((LAS float*)(lds + G2_TOT))[c] = tot; ((float*)(F.ws + WS_DECAY))[(((size_t)dir * NBATCH + b) * NCC + cc) * 256 + c] = __expf(tot); }
#pragma unroll
              for (int j = 0; j < 4; ++j) { float e[8];
#pragma unroll
                  for (int q = 0; q < 8; ++q) e[q] = kk[8 * j + q] * __expf(-(off + cl[8 * j + q]));
                  v4u w; w.x = pk2(e[0], e[1]); w.y = pk2(e[2], e[3]); w.z = pk2(e[4], e[5]); w.w = pk2(e[6], e[7]);
                  *(LAS v4u*)(lds + G2_A + (c * 72 + th * 32 + 8 * j) * 2) = w; } }
            __syncthreads();
            { const int h = wave >> 1, vh = wave & 1;
              bf16x8 af[4][2];
#pragma unroll
              for (int dt = 0; dt < 4; ++dt)
#pragma unroll
                  for (int ks = 0; ks < 2; ++ks) af[dt][ks] = *(const LAS bf16x8*)(lds + G2_A + ((h * 64 + dt * 16 + i) * 72 + 32 * ks + 8 * g) * 2);
              f32x4 et[4];
#pragma unroll
              for (int dt = 0; dt < 4; ++dt) { const f32x4 tv = *(const LAS f32x4*)(lds + G2_TOT + (h * 64 + dt * 16 + 4 * g) * 4); et[dt] = (f32x4){__expf(tv[0]), __expf(tv[1]), __expf(tv[2]), __expf(tv[3])}; }
              bf16* kvp = ((bf16*)(F.ws + WS_KV)) + ((((size_t)dir * NBATCH + b) * NCC + cc) * 4 + h) * 8192;
              bf16* vtp = ((bf16*)(F.ws + WS_VT)) + (((size_t)b * 64 + (cc - 4)) * 4 + h) * 8192;
#pragma unroll
              for (int vt = 0; vt < 4; ++vt) { const int v0 = vh * 64 + vt * 16; bf16x8 vf0, vf1; tr_frag2((unsigned)(uintptr_t)(lds + G2_B), h * 128 + v0, lane, vf0, vf1);
                  if (dir == 0 && cc >= 4) { *(bf16x8*)(vtp + (size_t)(v0 + i) * 64 + 8 * g) = vf0; *(bf16x8*)(vtp + (size_t)(v0 + i) * 64 + 32 + 8 * g) = vf1; }
#pragma unroll
                  for (int dt = 0; dt < 4; ++dt) { f32x4 acc = {0.f, 0.f, 0.f, 0.f};
                      acc = __builtin_amdgcn_mfma_f32_16x16x32_bf16(af[dt][0], vf0, acc, 0, 0, 0); acc = __builtin_amdgcn_mfma_f32_16x16x32_bf16(af[dt][1], vf1, acc, 0, 0, 0);
                      acc = acc * et[dt];
                      v2u w; w.x = pk2(acc[0], acc[1]); w.y = pk2(acc[2], acc[3]);
                      *(v2u*)(kvp + (size_t)(v0 + i) * 64 + dt * 16 + 4 * g) = w; } } }
            __syncthreads();
        }
    }
}

struct GateConst { bf16x8 bw[2][2]; float bias[2][2]; };
__device__ __forceinline__ GateConst gate_setup(CArgs* A, int wave, int lane) {
    GateConst G; const int i = lane & 15, g = lane >> 4;
#pragma unroll
    for (int dir = 0; dir < 2; ++dir)
#pragma unroll
        for (int cti = 0; cti < 2; ++cti) { const int c = 32 * wave + 16 * cti + i; const float* up = dir ? A->in[10] : A->in[8];
            G.bias[dir][cti] = (dir ? A->in[11] : A->in[9])[c];
#pragma unroll
            for (int jj = 0; jj < 8; ++jj) { const float v = up[(8 * (g & 1) + jj) * 256 + c]; const unsigned hi = f2bf(v); const float rem = v - __builtin_bit_cast(float, hi << 16);
                G.bw[dir][cti][jj] = (short)((g < 2) ? hi : f2bf(rem)); } }
    return G;
}
__device__ __forceinline__ float log_sigmoid16_fast(float z) { const float e = __builtin_amdgcn_exp2f(fabsf(z) * -1.4426950409f); return (fminf(z, 0.f) - __builtin_amdgcn_logf(1.0f + e) * 0.6931471806f) * 0.0625f; }
__device__ __forceinline__ void gate_b(const GateConst& G, const bf16* P, size_t prow, int lane, f32x4 (&bv)[2][2][4], float (&tot)[2][2]) {
    const int i = lane & 15, g = lane >> 4;
    bf16x8 za[2][4];
#pragma unroll
    for (int dir = 0; dir < 2; ++dir)
#pragma unroll
        for (int tt = 0; tt < 4; ++tt) za[dir][tt] = *(const bf16x8*)(P + (prow + 16 * tt + i) * PW + CAF + 16 * dir + 8 * (g & 1));
#pragma unroll
    for (int dir = 0; dir < 2; ++dir)
#pragma unroll
        for (int cti = 0; cti < 2; ++cti) { float carry = 0.f;
#pragma unroll
            for (int q = 0; q < 4; ++q) { const int tt = dir ? 3 - q : q;
                f32x4 z = {0.f, 0.f, 0.f, 0.f}; z = __builtin_amdgcn_mfma_f32_16x16x32_bf16(za[dir][tt], G.bw[dir][cti], z, 0, 0, 0);
                float la[4];
#pragma unroll
                for (int r = 0; r < 4; ++r) la[r] = log_sigmoid16_fast(z[r] + G.bias[dir][cti]);
                float p[4];
                if (dir == 0) { p[0] = la[0]; p[1] = p[0] + la[1]; p[2] = p[1] + la[2]; p[3] = p[2] + la[3];
                    const float s = p[3]; float incl = s; const float t1 = __shfl_up(incl, 16); if (g >= 1) incl += t1; const float t2 = __shfl_up(incl, 32); if (g >= 2) incl += t2;
                    const float base = carry + (incl - s); carry += __shfl(incl, 48 + i);
                    bv[dir][cti][tt] = (f32x4){base + p[0], base + p[1], base + p[2], base + p[3]}; }
                else { p[3] = la[3]; p[2] = p[3] + la[2]; p[1] = p[2] + la[1]; p[0] = p[1] + la[0];
                    const float s = p[0]; float incl = s; const float t1 = __shfl_down(incl, 16); if (g <= 2) incl += t1; const float t2 = __shfl_down(incl, 32); if (g <= 1) incl += t2;
                    const float base = carry + (incl - s); carry += __shfl(incl, i);
                    bv[dir][cti][tt] = (f32x4){base + p[0], base + p[1], base + p[2], base + p[3]}; } }
            tot[dir][cti] = carry; }
}

constexpr int G3_ST = 0;
constexpr int G3_TOT = 8 * 16 * 144;
constexpr int G3_A = G3_TOT + 1024;
constexpr int G3_B = G3_A + 256 * 72 * 2;
static_assert(G3_B + 64 * G2_VS * 2 <= RING_BYTES && (G3_A % 16) == 0 && (G3_B % 16) == 0, "P3 LDS map");
template <int MODE>
__device__ __forceinline__ void p3v3_phase(const Frame& F, CArgs* A) {
    int tid_ = F.tid; asm volatile("" : "+v"(tid_));
    LAS unsigned char* lds = F.lds; const int tid = tid_, lane = tid & 63, wave = __builtin_amdgcn_readfirstlane(tid >> 6), i = lane & 15, g = lane >> 4;
    const bf16* P = (const bf16*)(F.ws + WS_P);
    const GateConst G = gate_setup(A, wave, lane);
    LAS unsigned char* st = lds + G3_ST + wave * (16 * 144);
#pragma unroll 1
    for (int it = F.bid; it < NBATCH * NCC; it += F.G) {
        const int b = it / NCC, cc = it % NCC; const size_t prow = chunk_row(b, cc);
        unsigned pf0 = 0u, pf1 = 0u;
#pragma unroll
        for (int j = 0; j < 8; ++j) { const int pc = tid + j * NTHREADS, t = pc >> 6, cv = pc & 63;
            *(LAS v4u*)(lds + G3_B + (t * G2_VS + cv * 8) * 2) = *(const v4u*)(P + (prow + t) * PW + CV + cv * 8); }
        unsigned kk[2][4][2];
#pragma unroll
        for (int cti = 0; cti < 2; ++cti)
#pragma unroll
            for (int tt = 0; tt < 4; ++tt)
#pragma unroll
                for (int r = 0; r < 4; r += 2) { const bf16* kp = P + (prow + 16 * tt + 4 * g + r) * PW + CK + 32 * wave + 16 * cti + i; kk[cti][tt][r >> 1] = (unsigned)kp[0] | ((unsigned)kp[PW] << 16); }
        f32x4 bv[2][2][4]; float tot[2][2];
        if (MODE < 4) gate_b(G, P, prow, lane, bv, tot); else {
#pragma unroll
            for (int a_ = 0; a_ < 2; ++a_)
#pragma unroll
                for (int b_ = 0; b_ < 2; ++b_) { tot[a_][b_] = 0.f;
#pragma unroll
                    for (int c_ = 0; c_ < 4; ++c_) bv[a_][b_][c_] = (f32x4){0.f, 0.f, 0.f, 0.f}; } }
#pragma unroll
        for (int dir = 0; dir < 2; ++dir) {
#pragma unroll
            for (int cti = 0; cti < 2; ++cti) { const int c = 32 * wave + 16 * cti + i;
#pragma unroll
                for (int tt = 0; tt < 4; ++tt) { float e[4];
#pragma unroll
                    for (int r = 0; r < 4; ++r) e[r] = ((r & 1) ? bfhi(kk[cti][tt][r >> 1]) : bflo(kk[cti][tt][r >> 1])) * __builtin_amdgcn_exp2f(bv[dir][cti][tt][r] * -1.4426950409f);
                    v2u w; w.x = pk2(e[0], e[1]); w.y = pk2(e[2], e[3]);
                    *(LAS v2u*)(lds + G3_A + (c * 72 + 16 * tt + 4 * g) * 2) = w; }
                if (g == 0) { ((LAS float*)(lds + G3_TOT))[c] = tot[dir][cti]; if (!MODE) ((float*)(F.ws + WS_DECAY))[(((size_t)dir * NBATCH + b) * NCC + cc) * 256 + c] = __expf(tot[dir][cti]); } }
            LDS_BARRIER();
            if (dir == 0) {
                const int itn = it + F.G; if (itn < NBATCH * NCC) { const char* pr = (const char*)(P + (chunk_row(itn / NCC, itn % NCC) + (tid >> 3)) * PW); const int j = tid & 7;
                    pf0 = *(const unsigned*)(pr + 512 + 128 * j); pf1 = *(const unsigned*)(pr + (j < 5 ? 512 + 128 * (8 + j) : 3072 + 32 * (j - 5))); } }
            if (MODE < 3) { const int h = wave >> 1, vh = wave & 1;
              bf16x8 af[4][2];
#pragma unroll
              for (int dt = 0; dt < 4; ++dt)
#pragma unroll
                  for (int ks = 0; ks < 2; ++ks) af[dt][ks] = *(const LAS bf16x8*)(lds + G3_A + ((h * 64 + dt * 16 + i) * 72 + 32 * ks + 8 * g) * 2);
              bf16* kvp = ((bf16*)(F.ws + WS_KV)) + ((((size_t)dir * NBATCH + b) * NCC + cc) * 4 + h) * 8192;
              bf16* vtp = ((bf16*)(F.ws + WS_VT)) + (((size_t)b * 64 + (cc - 4)) * 4 + h) * 8192;
              if (MODE) { kvp = ((bf16*)(F.ws + WS_TOTAL)) + (size_t)(F.bid * 8 + wave) * 512; vtp = kvp + 1024 * 1024; }
#pragma unroll
              for (int vt = 0; vt < 4; ++vt) { const int v0 = vh * 64 + vt * 16; bf16x8 vf0, vf1; tr_frag2((unsigned)(uintptr_t)(lds + G3_B), h * 128 + v0, lane, vf0, vf1);
                  if (dir == 0 && cc >= 4) {
                      *(LAS bf16x8*)(st + i * 144 + 16 * g) = vf0; *(LAS bf16x8*)(st + i * 144 + 64 + 16 * g) = vf1;
                      LDS_WAIT();
#pragma unroll
                      for (int j = 0; j < 2; ++j) { const int pc = lane + 64 * j, row = pc >> 3, ch = pc & 7; const v4u x_ = *(const LAS v4u*)(st + row * 144 + ch * 16); if (MODE == 2) asm volatile("" :: "v"(x_)); else *(v4u*)(vtp + (size_t)((MODE ? 0 : v0) + row) * 64 + ch * 8) = x_; }
                      LDS_WAIT(); }
#pragma unroll
                  for (int dt = 0; dt < 4; ++dt) { f32x4 acc = {0.f, 0.f, 0.f, 0.f};
                      acc = __builtin_amdgcn_mfma_f32_16x16x32_bf16(af[dt][0], vf0, acc, 0, 0, 0); acc = __builtin_amdgcn_mfma_f32_16x16x32_bf16(af[dt][1], vf1, acc, 0, 0, 0);
                      { const f32x4 tv = *(const LAS f32x4*)(lds + G3_TOT + (h * 64 + dt * 16 + 4 * g) * 4);
                        acc = acc * (f32x4){__builtin_amdgcn_exp2f(tv[0] * 1.4426950409f), __builtin_amdgcn_exp2f(tv[1] * 1.4426950409f), __builtin_amdgcn_exp2f(tv[2] * 1.4426950409f), __builtin_amdgcn_exp2f(tv[3] * 1.4426950409f)}; }
                      v2u w; w.x = pk2(acc[0], acc[1]); w.y = pk2(acc[2], acc[3]);
                      *(LAS v2u*)(st + i * 144 + (16 * dt + 4 * g) * 2) = w; }
                  LDS_WAIT();
#pragma unroll
                  for (int j = 0; j < 2; ++j) { const int pc = lane + 64 * j, row = pc >> 3, ch = pc & 7; const v4u x_ = *(const LAS v4u*)(st + row * 144 + ch * 16); if (MODE == 2) asm volatile("" :: "v"(x_)); else *(v4u*)(kvp + (size_t)((MODE ? 0 : v0) + row) * 64 + ch * 8) = x_; }
                  LDS_WAIT(); } }
            LDS_BARRIER();
        }
        asm volatile("" :: "v"(pf0), "v"(pf1));
    }
}

__device__ __forceinline__ void gate_b_dir(const GateConst& G, const bf16* P, size_t prow, int lane, int dir, f32x4 (&bv)[2][4]) {
    const int i = lane & 15, g = lane >> 4;
    bf16x8 za[4];
#pragma unroll
    for (int tt = 0; tt < 4; ++tt) za[tt] = *(const bf16x8*)(P + (prow + 16 * tt + i) * PW + CAF + 16 * dir + 8 * (g & 1));
#pragma unroll
    for (int cti = 0; cti < 2; ++cti) { float carry = 0.f;
#pragma unroll
        for (int q = 0; q < 4; ++q) { const int tt = dir ? 3 - q : q;
            f32x4 z = {0.f, 0.f, 0.f, 0.f}; z = __builtin_amdgcn_mfma_f32_16x16x32_bf16(za[tt], G.bw[dir][cti], z, 0, 0, 0);
            float la[4];
#pragma unroll
            for (int r = 0; r < 4; ++r) la[r] = log_sigmoid16_fast(z[r] + G.bias[dir][cti]);
            float p[4];
            if (dir == 0) { p[0] = la[0]; p[1] = p[0] + la[1]; p[2] = p[1] + la[2]; p[3] = p[2] + la[3];
                const float s = p[3]; float incl = s; const float t1 = __shfl_up(incl, 16); if (g >= 1) incl += t1; const float t2 = __shfl_up(incl, 32); if (g >= 2) incl += t2;
                const float base = carry + (incl - s); carry += __shfl(incl, 48 + i);
                bv[cti][tt] = (f32x4){base + p[0], base + p[1], base + p[2], base + p[3]}; }
            else { p[3] = la[3]; p[2] = p[3] + la[2]; p[1] = p[2] + la[1]; p[0] = p[1] + la[0];
                const float s = p[0]; float incl = s; const float t1 = __shfl_down(incl, 16); if (g <= 2) incl += t1; const float t2 = __shfl_down(incl, 32); if (g <= 1) incl += t2;
                const float base = carry + (incl - s); carry += __shfl(incl, i);
                bv[cti][tt] = (f32x4){base + p[0], base + p[1], base + p[2], base + p[3]}; } } }
}

constexpr int G5_Q = 0;
constexpr int G5_K = 4 * 64 * 72 * 2;
constexpr int G5_P = 2 * G5_K;
static_assert(G5_P + 4 * 64 * 72 * 2 <= RING_BYTES && 8 * 16 * 272 <= G5_K, "P5 LDS map");
template <int MODE>
__device__ __forceinline__ void p5av3_phase(const Frame& F, CArgs* A) {
    LAS unsigned char* lds = F.lds;
    const bf16* P = (const bf16*)(F.ws + WS_P);
    const GateConst G = gate_setup(A, F.wave, F.lane);
#pragma unroll 1
    for (int it = F.bid; it < NBATCH * 64; it += F.G) {
        int tid_ = F.tid; asm volatile("" : "+v"(tid_));
        const int tid = tid_, lane = tid & 63, wave = __builtin_amdgcn_readfirstlane(tid >> 6), i = lane & 15, g = lane >> 4;
        const int h = wave >> 1, half = wave & 1;
        LAS unsigned char* st = lds + G5_Q + wave * (16 * 272);
        const int b = it >> 6, n = it & 63; const size_t prow = (size_t)b * SEQ + n * 64;
        unsigned pfv[9];
#pragma unroll
        for (int q = 0; q < 9; ++q) pfv[q] = 0u;
        const int dh = 32 * half + i;
        f32x4 pdiag[2], oacc[2][8];
#pragma unroll
        for (int a = 0; a < 2; ++a) { pdiag[a] = (f32x4){0.f, 0.f, 0.f, 0.f};
#pragma unroll
            for (int q = 0; q < 8; ++q) oacc[a][q] = (f32x4){0.f, 0.f, 0.f, 0.f}; }
#pragma unroll
        for (int dir = 0; dir < (MODE >= 4 ? 0 : 2); ++dir) {
            { unsigned qk[2][4][4];
#pragma unroll
              for (int cti = 0; cti < 2; ++cti)
#pragma unroll
                  for (int tt = 0; tt < 4; ++tt)
#pragma unroll
                      for (int r = 0; r < 4; ++r) { const bf16* rp = P + (prow + 16 * tt + 4 * g + r) * PW + h * 64 + dh + 16 * cti; qk[cti][tt][r] = (unsigned)rp[CQ] | ((unsigned)rp[CK] << 16); }
              f32x4 bv[2][4]; gate_b_dir(G, P, prow, lane, dir, bv);
#pragma unroll
              for (int cti = 0; cti < 2; ++cti)
#pragma unroll
                  for (int tt = 0; tt < 4; ++tt)
#pragma unroll
                      for (int r = 0; r < 4; ++r) { const float e = __builtin_amdgcn_exp2f(bv[cti][tt][r] * 1.4426950409f); const unsigned w = qk[cti][tt][r];
                          const int off = ((h * 64 + 16 * tt + 4 * g + r) * 72 + dh + 16 * cti) * 2;
                          *(LAS bf16*)(lds + G5_Q + off) = (bf16)f2bf(bflo(w) * e * 0.125f); *(LAS bf16*)(lds + G5_K + off) = (bf16)f2bf(bfhi(w) * __builtin_amdgcn_rcpf(e)); } }
            LDS_BARRIER();
            if (MODE < 3) { bf16x8 qf[2][2];
#pragma unroll
              for (int tti = 0; tti < 2; ++tti)
#pragma unroll
                  for (int ks = 0; ks < 2; ++ks) qf[tti][ks] = *(const LAS bf16x8*)(lds + G5_Q + ((h * 64 + (2 * half + tti) * 16 + i) * 72 + 32 * ks + 8 * g) * 2);
              const bf16* sp = ((const bf16*)(F.ws + WS_S)) + ((((size_t)dir * NBATCH + b) * 64 + n) * 4 + h) * 8192 + (size_t)i * 64 + 8 * g;
#pragma unroll
              for (int st_ = 0; st_ < 4; ++st_) { const bf16x8 kf0 = *(const LAS bf16x8*)(lds + G5_K + ((h * 64 + st_ * 16 + i) * 72 + 8 * g) * 2), kf1 = *(const LAS bf16x8*)(lds + G5_K + ((h * 64 + st_ * 16 + i) * 72 + 32 + 8 * g) * 2);
#pragma unroll
                  for (int tti = 0; tti < 2; ++tti) { const int tt = 2 * half + tti;
                      if (dir == 0 ? (st_ <= tt) : (st_ >= tt)) { f32x4 a = {0.f, 0.f, 0.f, 0.f};
                          a = __builtin_amdgcn_mfma_f32_16x16x32_bf16(kf0, qf[tti][0], a, 0, 0, 0); a = __builtin_amdgcn_mfma_f32_16x16x32_bf16(kf1, qf[tti][1], a, 0, 0, 0);
                          const int t = tt * 16 + i, s0 = st_ * 16 + 4 * g;
                          if (st_ == tt) {
#pragma unroll
                              for (int r = 0; r < 4; ++r) pdiag[tti][r] += (dir == 0 ? (s0 + r <= t) : (s0 + r >= t)) ? a[r] : 0.f;
                              a = pdiag[tti]; }
                          if (st_ != tt || dir == 1) { v2u w; w.x = pk2(a[0], a[1]); w.y = pk2(a[2], a[3]);
                              *(LAS v2u*)(lds + G5_P + ((h * 64 + t) * 72 + s0) * 2) = w; } } } }
              bf16x8 sfr[4][2];
#pragma unroll
              for (int vt = 0; vt < 4; ++vt) { sfr[vt][0] = *(const bf16x8*)(sp + (size_t)vt * 1024); sfr[vt][1] = *(const bf16x8*)(sp + (size_t)vt * 1024 + 32); }
#pragma unroll
              for (int vt = 0; vt < 8; ++vt) {
#pragma unroll
                  for (int tti = 0; tti < 2; ++tti) { oacc[tti][vt] = __builtin_amdgcn_mfma_f32_16x16x32_bf16(sfr[vt & 3][0], qf[tti][0], oacc[tti][vt], 0, 0, 0); oacc[tti][vt] = __builtin_amdgcn_mfma_f32_16x16x32_bf16(sfr[vt & 3][1], qf[tti][1], oacc[tti][vt], 0, 0, 0); }
                  asm volatile("" : "+v"(oacc[0][vt]), "+v"(oacc[1][vt]) :: "memory");
                  if (vt < 4) { sfr[vt][0] = *(const bf16x8*)(sp + (size_t)(vt + 4) * 1024); sfr[vt][1] = *(const bf16x8*)(sp + (size_t)(vt + 4) * 1024 + 32); } } }
            LDS_BARRIER();
        }
        LDS_WAIT();
        if (MODE < 2) { bf16x8 pfr[2][2];
#pragma unroll
          for (int tti = 0; tti < 2; ++tti)
#pragma unroll
              for (int ks = 0; ks < 2; ++ks) pfr[tti][ks] = *(const LAS bf16x8*)(lds + G5_P + ((h * 64 + (2 * half + tti) * 16 + i) * 72 + 32 * ks + 8 * g) * 2);
          const bf16* vp = ((const bf16*)(F.ws + WS_VT)) + (((size_t)b * 64 + n) * 4 + h) * 8192 + (size_t)i * 64 + 8 * g;
          bf16x8 vfr[8][2];
#pragma unroll
          for (int vt = 0; vt < 8; ++vt) { vfr[vt][0] = *(const bf16x8*)(vp + (size_t)vt * 1024); vfr[vt][1] = *(const bf16x8*)(vp + (size_t)vt * 1024 + 32); }
#pragma unroll
          for (int vt = 0; vt < 8; ++vt)
#pragma unroll
              for (int tti = 0; tti < 2; ++tti) { oacc[tti][vt] = __builtin_amdgcn_mfma_f32_16x16x32_bf16(vfr[vt][0], pfr[tti][0], oacc[tti][vt], 0, 0, 0); oacc[tti][vt] = __builtin_amdgcn_mfma_f32_16x16x32_bf16(vfr[vt][1], pfr[tti][1], oacc[tti][vt], 0, 0, 0); } }
#pragma unroll
        for (int tti = 0; tti < (MODE >= 2 ? 0 : 2); ++tti) { const int t = (2 * half + tti) * 16 + i; float ss = 0.f;
#pragma unroll
            for (int vt = 0; vt < 8; ++vt) { const f32x4 a = oacc[tti][vt]; ss += (a[0] * a[0] + a[1] * a[1]) + (a[2] * a[2] + a[3] * a[3]); }
            ss += __shfl_xor(ss, 16); ss += __shfl_xor(ss, 32);
            const float rstd = 1.0f / sqrtf(ss * (1.0f / 128.0f) + EPS);
#pragma unroll
            for (int vt = 0; vt < 8; ++vt) { const int v = vt * 16 + 4 * g; const f32x4 gw = *(const f32x4*)(A->in[12] + v); const v2u rw = *(const v2u*)(P + (prow + t) * PW + CR + h * 128 + v);
                const float r[4] = {bflo(rw.x), bfhi(rw.x), bflo(rw.y), bfhi(rw.y)}; float y[4];
#pragma unroll
                for (int j = 0; j < 4; ++j) y[j] = oacc[tti][vt][j] * rstd * gw[j] * (r[j] * __builtin_amdgcn_rcpf(1.0f + __builtin_amdgcn_exp2f(r[j] * -1.4426950409f)));
                if (OUTPROJ_F8) *(LAS unsigned*)(st + i * 144 + v) = pk4_fp8(y[0], y[1], y[2], y[3]);
                else { v2u w; w.x = pk2(y[0], y[1]); w.y = pk2(y[2], y[3]);
                    *(LAS v2u*)(st + i * 272 + v * 2) = w; }
                if ((vt & 3) == 3) asm volatile("" ::: "memory"); }
            LDS_WAIT();
            if (OUTPROJ_F8) {
#pragma unroll
                for (int j = 0; j < 2; ++j) { const int pc = lane + 64 * j, row = pc >> 3, ch = pc & 7;
                    *(v4u*)(F.ws + WS_YMIX + (prow + (2 * half + tti) * 16 + row) * D + h * 128 + ch * 16) = *(const LAS v4u*)(st + row * 144 + ch * 16); } }
            else {
#pragma unroll
                for (int j = 0; j < 4; ++j) { const int pc = lane + 64 * j, row = pc >> 4, ch = pc & 15;
                    *(v4u*)(((bf16*)(F.ws + WS_YMIX)) + (prow + (2 * half + tti) * 16 + row) * D + h * 128 + ch * 8) = *(const LAS v4u*)(st + row * 272 + ch * 16); } }
            LDS_WAIT(); }
        if (MODE < 1) { const int c0 = (tid & 63) * 8, t0 = (tid >> 6) * 8;
            v4u cw[10], xw[10], bw[8];
#pragma unroll
            for (int q = 0; q < 10; ++q) { const int tt = t0 - 1 + q; cw[q] = (v4u){0u, 0u, 0u, 0u}; xw[q] = cw[q];
                if (tt >= 0 && tt < 64) { cw[q] = *(const v4u*)(P + (prow + tt) * PW + CPC + c0); xw[q] = *(const v4u*)(P + (prow + tt) * PW + CPX + c0); } }
#pragma unroll
            for (int q = 0; q < 8; ++q) bw[q] = *(const v4u*)(P + (prow + t0 + q) * PW + CPB + c0);
            f32x4 wv[3][2];
#pragma unroll
            for (int dt = 0; dt < 3; ++dt) { wv[dt][0] = *(const f32x4*)(A->in[13] + dt * 512 + c0); wv[dt][1] = *(const f32x4*)(A->in[13] + dt * 512 + c0 + 4); }
            { const int itn = it + F.G; if (itn < NBATCH * 64) { const int bn_ = itn >> 6, nn_ = itn & 63; const char* pr = (const char*)(P + ((size_t)bn_ * SEQ + nn_ * 64 + (tid >> 3)) * PW); const int j = tid & 7;
#pragma unroll
                  for (int q = 0; q < 6; ++q) { const int ln = j + 8 * q; const int off = ln < 8 ? 128 * ln : 2048 + 128 * (ln - 8); if (off < PW * 2) pfv[q] = *(const unsigned*)(pr + off); }
                  const char* sb = (const char*)(((const bf16*)(F.ws + WS_S)) + (((size_t)bn_ * 64 + nn_) * 4) * 8192) + (size_t)tid * 128;
                  pfv[6] = *(const unsigned*)sb; pfv[7] = *(const unsigned*)(sb + (size_t)NBATCH * 64 * 4 * 8192 * 2);
                  pfv[8] = *(const unsigned*)((const char*)(((const bf16*)(F.ws + WS_VT)) + (((size_t)bn_ * 64 + nn_) * 4) * 8192) + (size_t)tid * 128); } }
            f32x2 ov[8][4];
#pragma unroll
            for (int j = 0; j < 8; ++j)
#pragma unroll
                for (int p = 0; p < 4; ++p) ov[j][p] = (f32x2){0.f, 0.f};
            f32x2 w2[3][4];
#pragma unroll
            for (int dt = 0; dt < 3; ++dt) { w2[dt][0] = (f32x2){wv[dt][0][0], wv[dt][0][1]}; w2[dt][1] = (f32x2){wv[dt][0][2], wv[dt][0][3]}; w2[dt][2] = (f32x2){wv[dt][1][0], wv[dt][1][1]}; w2[dt][3] = (f32x2){wv[dt][1][2], wv[dt][1][3]}; }
#pragma unroll
            for (int q = 0; q < 10; ++q) { const v4u c_ = cw[q], x_ = xw[q]; f32x2 u[4];
                u[0] = (f32x2){bflo(c_.x), bfhi(c_.x)} * (f32x2){bflo(x_.x), bfhi(x_.x)}; u[1] = (f32x2){bflo(c_.y), bfhi(c_.y)} * (f32x2){bflo(x_.y), bfhi(x_.y)};
                u[2] = (f32x2){bflo(c_.z), bfhi(c_.z)} * (f32x2){bflo(x_.z), bfhi(x_.z)}; u[3] = (f32x2){bflo(c_.w), bfhi(c_.w)} * (f32x2){bflo(x_.w), bfhi(x_.w)};
#pragma unroll
                for (int dt = 0; dt < 3; ++dt) { const int j = q - dt;
                    if (j >= 0 && j < 8) {
#pragma unroll
                        for (int p = 0; p < 4; ++p) ov[j][p] += w2[dt][p] * u[p]; } } }
#pragma unroll
            for (int q = 0; q < 8; ++q) { const v4u b_ = bw[q];
                const f32x2 y0 = ov[q][0] * (f32x2){bflo(b_.x), bfhi(b_.x)}, y1 = ov[q][1] * (f32x2){bflo(b_.y), bfhi(b_.y)}, y2 = ov[q][2] * (f32x2){bflo(b_.z), bfhi(b_.z)}, y3 = ov[q][3] * (f32x2){bflo(b_.w), bfhi(b_.w)};
                if (OUTPROJ_F8) { v2u w; w.x = pk4_fp8(y0.x, y0.y, y1.x, y1.y); w.y = pk4_fp8(y2.x, y2.y, y3.x, y3.y);
                    *(v2u*)(F.ws + WS_YMIX + (prow + t0 + q) * D + 512 + c0) = w; }
                else { v4u w; w.x = pk2(y0.x, y0.y); w.y = pk2(y1.x, y1.y); w.z = pk2(y2.x, y2.y); w.w = pk2(y3.x, y3.y);
                    *(v4u*)(((bf16*)(F.ws + WS_YMIX)) + (prow + t0 + q) * D + 512 + c0) = w; } } }
#pragma unroll
        for (int q = 0; q < 9; ++q) asm volatile("" :: "v"(pfv[q]));
        LDS_BARRIER();
    }
}

__device__ __forceinline__ void p4_phase(const Frame& F, CArgs* A) {
    for (int idx = F.bid * NTHREADS + F.tid; idx < 2 * NBATCH * 4 * 1024; idx += F.G * NTHREADS) {
        const int e8 = idx & 1023, ch = idx >> 10, h = ch & 3, b = (ch >> 2) & 15, dir = ch >> 6; const int d0 = (e8 & 7) * 8;
        float s[8];
#pragma unroll
        for (int j = 0; j < 8; ++j) s[j] = 0.f;
#pragma unroll 17
        for (int st = 0; st < NCC; ++st) {
            const int cc = dir ? (st < 4 ? 3 - st : 71 - st) : st;
            const size_t ci = ((size_t)dir * NBATCH + b) * NCC + cc;
            const v4u kv = *(const v4u*)(((bf16*)(F.ws + WS_KV)) + (ci * 4 + h) * 8192 + (size_t)e8 * 8);
            const f32x4 dc0 = *(const f32x4*)(((float*)(F.ws + WS_DECAY)) + ci * 256 + h * 64 + d0), dc1 = *(const f32x4*)(((float*)(F.ws + WS_DECAY)) + ci * 256 + h * 64 + d0 + 4);
            if (cc >= 4) { v4u w; w.x = pk2(s[0], s[1]); w.y = pk2(s[2], s[3]); w.z = pk2(s[4], s[5]); w.w = pk2(s[6], s[7]);
                *(v4u*)(((bf16*)(F.ws + WS_S)) + ((((size_t)dir * NBATCH + b) * 64 + (cc - 4)) * 4 + h) * 8192 + (size_t)e8 * 8) = w; }
            s[0] = s[0] * dc0[0] + bflo(kv.x); s[1] = s[1] * dc0[1] + bfhi(kv.x); s[2] = s[2] * dc0[2] + bflo(kv.y); s[3] = s[3] * dc0[3] + bfhi(kv.y);
            s[4] = s[4] * dc1[0] + bflo(kv.z); s[5] = s[5] * dc1[1] + bfhi(kv.z); s[6] = s[6] * dc1[2] + bflo(kv.w); s[7] = s[7] * dc1[3] + bfhi(kv.w);
        }
    }
}

__device__ __forceinline__ void p5a_phase(const Frame& F, CArgs* A) {
    LAS unsigned char* lds = F.lds; const int tid = F.tid, lane = F.lane, wave = F.wave, i = lane & 15, g = lane >> 4;
    GlaRegs cur; if (F.bid < NBATCH * 64 * 4) cur = gla_load(F, (size_t)(F.bid >> 2) * 64, F.bid & 3);
    f32x4 gw[4];
#pragma unroll
    for (int k = 0; k < 4; ++k) gw[k] = *(const f32x4*)(A->in[12] + ((wave >> 2) * 4 + k) * 16 + 4 * g);
    for (int it = F.bid; it < NBATCH * 64 * 4; it += F.G) {
        const int h = it & 3, bn = it >> 2, b = bn >> 6, n = bn & 63; const size_t prow = (size_t)b * SEQ + n * 64;
        GlaRegs nxt = cur; { const int itn = it + F.G; if (itn < NBATCH * 64 * 4) nxt = gla_load(F, (size_t)(itn >> 2) * 64, itn & 3); }
        v4u qw, kw; { const int t = tid >> 3, d0 = (tid & 7) * 8; qw = *(const v4u*)(((bf16*)(F.ws + WS_P)) + (prow + t) * PW + CQ + h * 64 + d0); kw = *(const v4u*)(((bf16*)(F.ws + WS_P)) + (prow + t) * PW + CK + h * 64 + d0); }
        gla_prep(F, A, cur, h); cur = nxt;
        bf16x8 sfr[4][2][2]; v2u rwv[4];
        { const int tt = wave & 3, vh = wave >> 2, t = tt * 16 + i;
#pragma unroll
          for (int k = 0; k < 4; ++k) { const int vt = vh * 4 + k;
#pragma unroll
              for (int dir = 0; dir < 2; ++dir) { const bf16* sp = ((bf16*)(F.ws + WS_S)) + ((((size_t)dir * NBATCH + b) * 64 + n) * 4 + h) * 8192 + (size_t)(vt * 16 + i) * 64 + 8 * g;
                  sfr[k][dir][0] = *(const bf16x8*)sp; sfr[k][dir][1] = *(const bf16x8*)(sp + 32); }
              rwv[k] = *(const v2u*)(((bf16*)(F.ws + WS_P)) + (prow + t) * PW + CR + h * 128 + vt * 16 + 4 * g); } }
        { const int t = tid >> 3, d0 = (tid & 7) * 8;
          const float q[8] = {bflo(qw.x), bfhi(qw.x), bflo(qw.y), bfhi(qw.y), bflo(qw.z), bfhi(qw.z), bflo(qw.w), bfhi(qw.w)};
          const float k[8] = {bflo(kw.x), bfhi(kw.x), bflo(kw.y), bfhi(kw.y), bflo(kw.z), bfhi(kw.z), bflo(kw.w), bfhi(kw.w)};
#pragma unroll
          for (int dir = 0; dir < 2; ++dir) { const LAS float* bp = (const LAS float*)(lds + GL_BC) + dir * 4096 + t * 64 + d0;
              const f32x4 b0 = *(const LAS f32x4*)bp, b1 = *(const LAS f32x4*)(bp + 4); const float bb[8] = {b0[0], b0[1], b0[2], b0[3], b1[0], b1[1], b1[2], b1[3]};
              float qd[8], ki[8];
#pragma unroll
              for (int j = 0; j < 8; ++j) { qd[j] = q[j] * __expf(bb[j]) * 0.125f; ki[j] = k[j] * __expf(-bb[j]); }
              v4u w; w.x = pk2(qd[0], qd[1]); w.y = pk2(qd[2], qd[3]); w.z = pk2(qd[4], qd[5]); w.w = pk2(qd[6], qd[7]);
              *(LAS v4u*)(lds + GL_A + ((dir * 64 + t) * 72 + d0) * 2) = w;
              w.x = pk2(ki[0], ki[1]); w.y = pk2(ki[2], ki[3]); w.z = pk2(ki[4], ki[5]); w.w = pk2(ki[6], ki[7]);
              *(LAS v4u*)(lds + GL_B + ((dir * 64 + t) * 72 + d0) * 2) = w; } }
        __syncthreads();
#pragma unroll
        for (int kk = 0; kk < 2; ++kk) { const int pi = wave * 2 + kk, tt = pi >> 2, st = pi & 3;
            f32x4 aF = {0.f, 0.f, 0.f, 0.f}, aB = {0.f, 0.f, 0.f, 0.f};
            if (st <= tt) {
#pragma unroll
                for (int ks = 0; ks < 2; ++ks) { const bf16x8 kf = *(const LAS bf16x8*)(lds + GL_B + ((st * 16 + i) * 72 + 32 * ks + 8 * g) * 2), qf = *(const LAS bf16x8*)(lds + GL_A + ((tt * 16 + i) * 72 + 32 * ks + 8 * g) * 2);
                    aF = __builtin_amdgcn_mfma_f32_16x16x32_bf16(kf, qf, aF, 0, 0, 0); } }
            if (st >= tt) {
#pragma unroll
                for (int ks = 0; ks < 2; ++ks) { const bf16x8 kf = *(const LAS bf16x8*)(lds + GL_B + ((64 + st * 16 + i) * 72 + 32 * ks + 8 * g) * 2), qf = *(const LAS bf16x8*)(lds + GL_A + ((64 + tt * 16 + i) * 72 + 32 * ks + 8 * g) * 2);
                    aB = __builtin_amdgcn_mfma_f32_16x16x32_bf16(kf, qf, aB, 0, 0, 0); } }
            const int t = tt * 16 + i, s0 = st * 16 + 4 * g; float p[4];
#pragma unroll
            for (int r = 0; r < 4; ++r) p[r] = ((s0 + r <= t) ? aF[r] : 0.f) + ((s0 + r >= t) ? aB[r] : 0.f);
            v2u w; w.x = pk2(p[0], p[1]); w.y = pk2(p[2], p[3]);
            *(LAS v2u*)(lds + GL_P + (t * 72 + s0) * 2) = w; }
        __syncthreads();
        { const int tt = wave & 3, vh = wave >> 2; const int t = tt * 16 + i;
          bf16x8 pf[2], qf[2][2];
#pragma unroll
          for (int ks = 0; ks < 2; ++ks) { pf[ks] = *(const LAS bf16x8*)(lds + GL_P + (t * 72 + 32 * ks + 8 * g) * 2);
              qf[0][ks] = *(const LAS bf16x8*)(lds + GL_A + (t * 72 + 32 * ks + 8 * g) * 2); qf[1][ks] = *(const LAS bf16x8*)(lds + GL_A + ((64 + t) * 72 + 32 * ks + 8 * g) * 2); }
          f32x4 acc[4]; float ss = 0.f;
#pragma unroll
          for (int k = 0; k < 4; ++k) { const int vt = vh * 4 + k; f32x4 a = {0.f, 0.f, 0.f, 0.f};
              { bf16x8 vf0, vf1; v_frag2(lds, vt * 16, lane, vf0, vf1); a = __builtin_amdgcn_mfma_f32_16x16x32_bf16(vf0, pf[0], a, 0, 0, 0); a = __builtin_amdgcn_mfma_f32_16x16x32_bf16(vf1, pf[1], a, 0, 0, 0); }
#pragma unroll
              for (int dir = 0; dir < 2; ++dir)
#pragma unroll
                  for (int ks = 0; ks < 2; ++ks) a = __builtin_amdgcn_mfma_f32_16x16x32_bf16(sfr[k][dir][ks], qf[dir][ks], a, 0, 0, 0);
              acc[k] = a; ss += (a[0] * a[0] + a[1] * a[1]) + (a[2] * a[2] + a[3] * a[3]); }
          ss += __shfl_xor(ss, 16); ss += __shfl_xor(ss, 32);
          if (g == 0) ((LAS float*)(lds + GL_SS))[vh * 64 + t] = ss;
          __syncthreads();
          const float tot = ((const LAS float*)(lds + GL_SS))[t] + ((const LAS float*)(lds + GL_SS))[64 + t];
          const float rstd = 1.0f / sqrtf(tot * (1.0f / 128.0f) + EPS);
#pragma unroll
          for (int k = 0; k < 4; ++k) { const int v = (vh * 4 + k) * 16 + 4 * g;
              const v2u rw = rwv[k];
              const float r[4] = {bflo(rw.x), bfhi(rw.x), bflo(rw.y), bfhi(rw.y)}; float y[4];
#pragma unroll
              for (int j = 0; j < 4; ++j) y[j] = acc[k][j] * rstd * gw[k][j] * (r[j] * __builtin_amdgcn_rcpf(1.0f + __expf(-r[j])));
              v2u w; w.x = pk2(y[0], y[1]); w.y = pk2(y[2], y[3]);
              *(v2u*)(((bf16*)(F.ws + WS_YMIX)) + (prow + t) * D + h * 128 + v) = w; } }
        __syncthreads();
    }
    for (int it = F.bid; it < NBATCH * 64; it += F.G) {
        const size_t prow = (size_t)it * 64;
#pragma unroll 1
        for (int rep = 0; rep < 8; ++rep) { const int idx = tid + rep * NTHREADS, t = idx >> 6, c0 = (idx & 63) * 8;
            float cv[8];
#pragma unroll
            for (int j = 0; j < 8; ++j) cv[j] = 0.f;
#pragma unroll
            for (int dt = -1; dt <= 1; ++dt) { const int tt = t + dt; if (tt >= 0 && tt < 64) {
                const v4u cw = *(const v4u*)(((bf16*)(F.ws + WS_P)) + (prow + tt) * PW + CPC + c0), xw = *(const v4u*)(((bf16*)(F.ws + WS_P)) + (prow + tt) * PW + CPX + c0);
                const f32x4 w0 = *(const f32x4*)(A->in[13] + (dt + 1) * 512 + c0), w1 = *(const f32x4*)(A->in[13] + (dt + 1) * 512 + c0 + 4);
                cv[0] += w0[0] * bflo(cw.x) * bflo(xw.x); cv[1] += w0[1] * bfhi(cw.x) * bfhi(xw.x); cv[2] += w0[2] * bflo(cw.y) * bflo(xw.y); cv[3] += w0[3] * bfhi(cw.y) * bfhi(xw.y);
                cv[4] += w1[0] * bflo(cw.z) * bflo(xw.z); cv[5] += w1[1] * bfhi(cw.z) * bfhi(xw.z); cv[6] += w1[2] * bflo(cw.w) * bflo(xw.w); cv[7] += w1[3] * bfhi(cw.w) * bfhi(xw.w); } }
            const v4u bw = *(const v4u*)(((bf16*)(F.ws + WS_P)) + (prow + t) * PW + CPB + c0);
            v4u w; w.x = pk2(cv[0] * bflo(bw.x), cv[1] * bfhi(bw.x)); w.y = pk2(cv[2] * bflo(bw.y), cv[3] * bfhi(bw.y)); w.z = pk2(cv[4] * bflo(bw.z), cv[5] * bfhi(bw.z)); w.w = pk2(cv[6] * bflo(bw.w), cv[7] * bfhi(bw.w));
            *(v4u*)(((bf16*)(F.ws + WS_YMIX)) + (prow + t) * D + 512 + c0) = w; }
    }
}

constexpr int RT_W = 0;
constexpr int RT_LG = 32 * 1032 * 2;
constexpr int RT_HIST = RT_LG + 128 * 33 * 4;
constexpr int RT_WC = RT_HIST + 256;
__device__ __forceinline__ void p5c_phase(const Frame& F, CArgs* A) {
    LAS unsigned char* lds = F.lds; const int tid = F.tid, lane = F.lane, wave = F.wave, i = lane & 15, g = lane >> 4;
    v4u yv[32];
    if (F.bid < NLAT / 128) { const bf16* yg = ((const bf16*)(F.ws + WS_Y1)) + (size_t)(F.bid * 128 + wave * 16 + i) * D + 8 * g;
#pragma unroll
        for (int ks = 0; ks < 32; ++ks) yv[ks] = *(const v4u*)(yg + 32 * ks); }
#pragma unroll 1
    for (int i0 = 0; i0 < 32768; i0 += 16 * NTHREADS) { float rv[16];
#pragma unroll
        for (int q = 0; q < 16; ++q) rv[q] = A->in[16][i0 + q * NTHREADS + tid];
#pragma unroll
        for (int q = 0; q < 16; ++q) { const int idx = i0 + q * NTHREADS + tid, k = idx >> 5, e = idx & 31; *(LAS bf16*)(lds + RT_W + (e * 1032 + k) * 2) = (bf16)f2bf(rv[q]); } }
    LAS int* hist = (LAS int*)(lds + RT_HIST); LAS float* lg = (LAS float*)(lds + RT_LG);
    unsigned* gcnt = ((unsigned*)(F.ws + WS_CTL)) + CW_CNT;
    __syncthreads();
#pragma unroll 1
    for (int it = F.bid; it < NLAT / 128; it += F.G) {
        const int R = it * 128 + wave * 16 + i, b = it >> 5;
        unsigned char* hn2g = (unsigned char*)F.out + DO_HN2 + (size_t)R * D + 8 * g;
        const LAS unsigned char* rw0 = lds + RT_W + (i * 1032 + 8 * g) * 2; const LAS unsigned char* rw1 = rw0 + 16 * 1032 * 2;
        if (tid < 32) hist[tid] = 0;
        { const int c0 = 2 * tid; const f32x2 w_ = *(const f32x2*)(A->in[15] + c0), c_ = *(const f32x2*)(((float*)(F.ws + WS_MOD)) + (size_t)b * 6144 + 4096 + c0), s_ = *(const f32x2*)(((float*)(F.ws + WS_MOD)) + (size_t)b * 6144 + 3072 + c0);
          *(LAS f32x2*)(lds + RT_WC + c0 * 4) = w_ * (c_ + 1.0f); *(LAS f32x2*)(lds + RT_WC + 4096 + c0 * 4) = s_; }
        float ss = 0.f;
#pragma unroll
        for (int ks = 0; ks < 32; ++ks) { const v4u yw = yv[ks];
            const float h0 = bflo(yw.x), h1 = bfhi(yw.x), h2 = bflo(yw.y), h3 = bfhi(yw.y), h4 = bflo(yw.z), h5 = bfhi(yw.z), h6 = bflo(yw.w), h7 = bfhi(yw.w);
            ss += (h0 * h0 + h1 * h1) + (h2 * h2 + h3 * h3) + (h4 * h4 + h5 * h5) + (h6 * h6 + h7 * h7); }
        ss += __shfl_xor(ss, 16); ss += __shfl_xor(ss, 32);
        const float rstd = 1.0f / sqrtf(ss * (1.f / D) + EPS);
#pragma unroll
        for (int ks = 0; ks < 32; ++ks) asm volatile("" : "+v"(yv[ks]));
        LDS_BARRIER();
        f32x4 l0 = {0.f, 0.f, 0.f, 0.f}, l1 = {0.f, 0.f, 0.f, 0.f};
        const LAS unsigned char* wcg = lds + RT_WC + 32 * g;
#pragma unroll
        for (int ks = 0; ks < 32; ++ks) {
            const v4u yw = yv[ks];
            const f32x4 a0 = {bflo(yw.x), bfhi(yw.x), bflo(yw.y), bfhi(yw.y)}, a1 = {bflo(yw.z), bfhi(yw.z), bflo(yw.w), bfhi(yw.w)};
            const f32x4 c0 = *(const LAS f32x4*)(wcg + 128 * ks), c1 = *(const LAS f32x4*)(wcg + 128 * ks + 16), s0 = *(const LAS f32x4*)(wcg + 4096 + 128 * ks), s1 = *(const LAS f32x4*)(wcg + 4096 + 128 * ks + 16);
            const f32x4 y0 = (a0 * rstd) * c0 + s0, y1 = (a1 * rstd) * c1 + s1;
            v4u w; w.x = pk2(y0[0], y0[1]); w.y = pk2(y0[2], y0[3]); w.z = pk2(y1[0], y1[1]); w.w = pk2(y1[2], y1[3]);
            { v2u w8; w8.x = pk4_fp8(y0[0], y0[1], y0[2], y0[3]); w8.y = pk4_fp8(y1[0], y1[1], y1[2], y1[3]); *(v2u*)(hn2g + 32 * ks) = w8; }
            const bf16x8 af = __builtin_bit_cast(bf16x8, w);
            const bf16x8 r0 = *(const LAS bf16x8*)(rw0 + 64 * ks), r1 = *(const LAS bf16x8*)(rw1 + 64 * ks);
            l0 = __builtin_amdgcn_mfma_f32_16x16x32_bf16(af, r0, l0, 0, 0, 0); l1 = __builtin_amdgcn_mfma_f32_16x16x32_bf16(af, r1, l1, 0, 0, 0);
            asm volatile("" : "+v"(l0), "+v"(l1) :: "memory"); }
        { const int itn = it + F.G; if (itn < NLAT / 128) { const bf16* yg = ((const bf16*)(F.ws + WS_Y1)) + (size_t)(itn * 128 + wave * 16 + i) * D + 8 * g;
#pragma unroll
            for (int ks = 0; ks < 32; ++ks) yv[ks] = *(const v4u*)(yg + 32 * ks); } }
        { const float rb0 = A->in[17][i], rb1 = A->in[17][16 + i];
#pragma unroll
          for (int r = 0; r < 4; ++r) { lg[(wave * 16 + 4 * g + r) * 33 + i] = l0[r] + rb0; lg[(wave * 16 + 4 * g + r) * 33 + 16 + i] = l1[r] + rb1; } }
        __syncthreads();
        int te[4] = {0, 0, 0, 0}; float tv[4] = {-3.0e38f, -3.0e38f, -3.0e38f, -3.0e38f}; int lp[4] = {0, 0, 0, 0};
        if (lane < 16) { const LAS float* lr = lg + (wave * 16 + lane) * 33;
            for (int e = 0; e < 32; ++e) { const float x = lr[e];
                if (x > tv[3]) { if (x > tv[2]) { tv[3] = tv[2]; te[3] = te[2]; if (x > tv[1]) { tv[2] = tv[1]; te[2] = te[1]; if (x > tv[0]) { tv[1] = tv[0]; te[1] = te[0]; tv[0] = x; te[0] = e; } else { tv[1] = x; te[1] = e; } } else { tv[2] = x; te[2] = e; } } else { tv[3] = x; te[3] = e; } } }
            const float e1 = __expf(tv[1] - tv[0]), e2 = __expf(tv[2] - tv[0]), e3 = __expf(tv[3] - tv[0]), inv = 1.0f / (1.0f + e1 + e2 + e3);
            tv[0] = inv; tv[1] = e1 * inv; tv[2] = e2 * inv; tv[3] = e3 * inv;
#pragma unroll
            for (int k = 0; k < 4; ++k) lp[k] = __hip_atomic_fetch_add(&hist[te[k]], 1, __ATOMIC_RELAXED, __HIP_MEMORY_SCOPE_WORKGROUP); }
        __syncthreads();
        if (tid < 32) { const int c = hist[tid]; hist[32 + tid] = c ? (int)__hip_atomic_fetch_add(gcnt + tid, (unsigned)c, RLX_AGENT) : 0; }
        __syncthreads();
        if (lane < 16) { const int Rt = it * 128 + wave * 16 + lane;
#pragma unroll
            for (int k = 0; k < 4; ++k) { const size_t pos = (size_t)te[k] * LISTCAP + hist[32 + te[k]] + lp[k]; ((int*)((unsigned char*)F.out + DO_LAID))[pos] = Rt * 4 + k;
                ((int*)(F.ws + WS_TSLOT))[Rt * 4 + k] = (te[k] << 20) | (hist[32 + te[k]] + lp[k]); ((float*)(F.ws + WS_TW))[Rt * 4 + k] = tv[k]; } }
        __syncthreads();
    }
}

__device__ __forceinline__ void p8_phase(const Frame& F, CArgs* A, const LAS int* TS) {
    const int gw = F.bid * NWAVES + F.wave, NGW = F.G * NWAVES;
    for (int r = gw; r < NLAT; r += NGW) {
        float* hr = F.out + (size_t)r * D; const float* g2 = ((float*)(F.ws + WS_MOD)) + (size_t)(r >> 12) * 6144 + 5120;
        const bf16* yr = ((const bf16*)(F.ws + WS_Y1)) + (size_t)r * D;
        const unsigned char* ys[4]; float wk[4];
#pragma unroll
        for (int k = 0; k < 4; ++k) { const int ep = ((const int*)(F.ws + WS_TSLOT))[r * 4 + k]; wk[k] = ((const float*)(F.ws + WS_TW))[r * 4 + k];
            ys[k] = (const unsigned char*)(F.ws + WS_YA) + ((size_t)TS[ep >> 20] * 256 + (ep & 0xFFFFF)) * D; }
        f32x4 v[4]; float s = 0.f;
#pragma unroll
        for (int j = 0; j < 4; ++j) { const int c4 = F.lane + 64 * j; f32x4 y = {0.f, 0.f, 0.f, 0.f};
#pragma unroll
            for (int k = 0; k < 4; ++k) { const int w = ((const int*)ys[k])[c4]; const f32x2 lo = __builtin_amdgcn_cvt_pk_f32_fp8(w, false), hi = __builtin_amdgcn_cvt_pk_f32_fp8(w, true);
                y[0] += wk[k] * lo[0]; y[1] += wk[k] * lo[1]; y[2] += wk[k] * hi[0]; y[3] += wk[k] * hi[1]; }
            const v2u yw = ((const v2u*)yr)[c4]; const f32x4 y1 = {bflo(yw.x), bfhi(yw.x), bflo(yw.y), bfhi(yw.y)};
            v[j] = y1 + ((const f32x4*)g2)[c4] * y;
            s += (v[j].x * v[j].x + v[j].y * v[j].y) + (v[j].z * v[j].z + v[j].w * v[j].w); }
        const float rstd = 1.0f / sqrtf(wave_sum(s) * (1.f / D) + EPS);
#pragma unroll
        for (int j = 0; j < 4; ++j) { const int c4 = F.lane + 64 * j; ((f32x4*)hr)[c4] = (v[j] * rstd) * ((const f32x4*)A->in[22])[c4]; }
    }
}

constexpr int NPHASES = 11;
__global__ void __launch_bounds__(NTHREADS, 2) fwd_kernel(Args args) {
    extern __shared__ __attribute__((aligned(16))) unsigned char lds_raw[];
    Frame F;
    F.lds = (LAS unsigned char*)lds_raw;
    F.tid = threadIdx.x; F.lane = F.tid & 63; F.wave = __builtin_amdgcn_readfirstlane(F.tid >> 6); F.G = gridDim.x; F.bid = blockIdx.x;
    F.out = args.out; F.ws = args.ws;
        for (int u = F.tid; u < (LDS_BYTES - MISC_OFF) / 4; u += NTHREADS) ((LAS unsigned*)(F.lds + MISC_OFF))[u] = 0u;
    __syncthreads();
    volatile LAS unsigned* MISC = (volatile LAS unsigned*)(F.lds + MISC_OFF);
    LAS int* TS = (LAS int*)(F.lds + MISC_OFF + 256);
    const int lo = args.ph_lo, hi = args.ph_hi;
    const bool multi = (hi - lo) > 1;
    XcdBarrier bar; bar.bar = (unsigned*)((unsigned*)(F.ws + WS_CTL)) + CW_BAR; bar.x = 0; bar.st = nullptr;
    if (multi) bar = xcd_barrier_post((unsigned*)((unsigned*)(F.ws + WS_CTL)) + CW_BAR, MISC + 8);
#ifndef PHMASK
#define PHMASK 0x7ff
#endif
#define IN(k) (((PHMASK >> (k)) & 1) && lo <= (k) && (k) < hi)
#define BUILD_TS() do { if (F.tid < NEXP) TS[33 + F.tid] = (int)__hip_atomic_load(((unsigned*)(F.ws + WS_CTL)) + CW_CNT + F.tid, RLX_AGENT);     \
        __syncthreads(); \
        if (F.tid == 0) { int acc_ = 0; for (int e = 0; e < NEXP; ++e) { TS[e] = acc_; acc_ += (TS[33 + e] + 255) >> 8; } TS[32] = acc_; } __syncthreads(); \
        for (int t_ = F.tid; t_ < TS[32]; t_ += NTHREADS) { int e_ = 0; for (int k_ = 1; k_ < NEXP; ++k_) e_ = (TS[k_] <= t_) ? k_ : e_; ((LAS unsigned char*)(TS + 72))[t_] = (unsigned char)e_; } \
        __syncthreads(); } while (0)
#define SEAM(k) do { if (IN(k) && IN((k) + 1)) xcd_barrier(bar); } while (0)
#ifndef PROBE_DUP
#define PROBE_DUP 0
#endif
#define REPS(k) for (int rep_ = 0; rep_ < (((PROBE_DUP >> (k)) & 1) ? 2 : 1); ++rep_)

    if (IN(0)) REPS(0) { p0_phase(F, opaque_args()); } SEAM(0);
    if (IN(1)) REPS(1) { p1_phase(F, opaque_args()); } SEAM(1);
    if (IN(2)) REPS(2) { DenseSched S; S.init(NROWS, PWP, F.G, F.bid, ((bf16*)(F.ws + WS_WIN))); S.build((LAS int*)(TS + 400), F.tid); EpiProj E{((bf16*)(F.ws + WS_P))};
        pg8::gemm_phase<EpiProj, DenseSched, true, false>(F.lds, (const char*)((bf16*)(F.ws + WS_HN)), S, E);
#ifdef PROBE_INNULL
        { EpiNull E0; pg8::gemm_phase<EpiNull, DenseSched, true, false>(F.lds, (const char*)((bf16*)(F.ws + WS_HN)), S, E0); }
#endif
    } SEAM(2);
    if (IN(3)) { p3v3_phase<0>(F, opaque_args());
#ifdef PROBE_P3
        p3v3_phase<PROBE_P3>(F, opaque_args());
#endif
    } SEAM(3);
    if (IN(4)) REPS(4) { p4_phase(F, opaque_args()); } SEAM(4);
    if (IN(5)) {
#ifdef PROBE_P5
        p5a_phase(F, opaque_args()); p5av3_phase<PROBE_P5>(F, opaque_args());
#else
        p5av3_phase<0>(F, opaque_args());
#endif
    } SEAM(5);
    if (IN(6)) REPS(6) { DenseSched S; S.init(NLAT, D, F.G, F.bid, ((bf16*)(F.ws + WS_WOUT))); S.kb = OUTPROJ_F8 ? 1024 : 2048; S.build((LAS int*)(TS + 400), F.tid); EpiOut E{opaque_args()->in[0], ((float*)(F.ws + WS_MOD)), ((bf16*)(F.ws + WS_Y1)), OUTPROJ_F8 ? 1.0f / WSCALE : 1.0f};
        pg8::gemm_phase<EpiOut, DenseSched, true, OUTPROJ_F8 != 0>(F.lds, (const char*)((bf16*)(F.ws + WS_YMIX)), S, E); } SEAM(6);
    if (IN(7)) { p5c_phase(F, opaque_args()); } SEAM(7);
#pragma unroll 1
    for (int ph = 8; ph < 10; ++ph) {
        if (IN(ph)) {
            const bool gu = (ph == 8);
            BUILD_TS();
            const int ntr = TS[32];
            REPS(ph) {
                if (gu) { MoeSched<true> S; S.TS = TS; S.ntr = ntr; S.G = F.G; S.c = F.bid; S.laid = ((int*)((unsigned char*)F.out + DO_LAID)); S.W = (const char*)F.out + DO_WGU;
                    EpiGU E{(unsigned char*)(F.ws + WS_ACT), opaque_args()->in[19]}; pg8::gemm_phase<EpiGU, MoeSched<true>, true, true>(F.lds, (const char*)((unsigned char*)F.out + DO_HN2), S, E);
#ifdef PROBE_GUNULL
                    { EpiNull E0; pg8::gemm_phase<EpiNull, MoeSched<true>, true, true>(F.lds, (const char*)((unsigned char*)F.out + DO_HN2), S, E0); }
#endif
                }
                else { MoeSched<false> S; S.TS = TS; S.ntr = ntr; S.G = F.G; S.c = F.bid; S.laid = nullptr; S.W = (const char*)F.out + DO_WDN;
                    EpiDN E{(unsigned char*)(F.ws + WS_YA), opaque_args()->in[21], TS}; pg8::gemm_phase<EpiDN, MoeSched<false>, true, true>(F.lds, (const char*)(F.ws + WS_ACT), S, E); }
            }
        }
        SEAM(ph);
    }
    if (IN(10)) { BUILD_TS(); p8_phase(F, opaque_args(), TS); }
#undef IN
#undef SEAM
}

extern "C" void kernel_launch(void* const* d_in, const int* in_sizes, int n_in, void* d_out, int out_size, void* d_ws, size_t ws_size, hipStream_t stream) {
    static int grid = 0;
    if (grid == 0) {
        if (n_in != 23 || in_sizes[0] != NLAT * D || out_size != NLAT * D || ws_size < WS_TOTAL) {
            fprintf(stderr, "kernel_launch: unexpected shapes: n_in %d, in0 %d, out %d, ws %zu (need %zu); nothing launched\n", n_in, n_in > 0 ? in_sizes[0] : -1, out_size, ws_size, (size_t)WS_TOTAL); grid = -1; return; }
        int dev = 0, cus = 0, per_cu = 0;
        if (hipGetDevice(&dev) != hipSuccess || hipDeviceGetAttribute(&cus, hipDeviceAttributeMultiprocessorCount, dev) != hipSuccess) { fprintf(stderr, "kernel_launch: device query failed\n"); grid = -1; return; }
        if (hipFuncSetAttribute((const void*)fwd_kernel, hipFuncAttributeMaxDynamicSharedMemorySize, LDS_BYTES) != hipSuccess) { fprintf(stderr, "kernel_launch: hipFuncSetAttribute failed\n"); grid = -1; return; }
        if (hipOccupancyMaxActiveBlocksPerMultiprocessor(&per_cu, (const void*)fwd_kernel, NTHREADS, LDS_BYTES) != hipSuccess || per_cu < 1) {
            fprintf(stderr, "kernel_launch: occupancy query reports %d workgroups per CU; nothing launched\n", per_cu); (void)hipGetLastError(); grid = -1; return; }
        grid = cus;
        if (grid > 256) grid = 256;
    }
    if (grid < 0) return;
    if (hipMemsetAsync((char*)d_ws + WS_CTL, 0, CTL_ZERO_BYTES, stream) != hipSuccess) { fprintf(stderr, "kernel_launch: hipMemsetAsync failed\n"); return; }
    Args a{};
    for (int i = 0; i < 23; ++i) a.in[i] = (const float*)d_in[i];
    a.out = (float*)d_out; a.ws = (unsigned char*)d_ws;
#if MK_N_LAUNCHES == 1
    a.ph_lo = 0; a.ph_hi = NPHASES;
    hipLaunchKernelGGL(fwd_kernel, dim3(grid), dim3(NTHREADS), LDS_BYTES, stream, a);
#else
    for (int p = 0; p < NPHASES; ++p) { a.ph_lo = p; a.ph_hi = p + 1; hipLaunchKernelGGL(fwd_kernel, dim3(grid), dim3(NTHREADS), LDS_BYTES, stream, a); }
#endif
    const hipError_t le = hipPeekAtLastError();
    if (le != hipSuccess) fprintf(stderr, "kernel_launch: launch failed: %s\n", hipGetErrorName(le));
}
```

```cpp
#include <hip/hip_runtime.h>
#include <cstdio>
#include <cstdint>

#ifndef MK_N_LAUNCHES
#define MK_N_LAUNCHES 1
#endif

#define GAS __attribute__((address_space(1)))
#define LAS __attribute__((address_space(3)))
typedef unsigned short bf16;
typedef unsigned v4u __attribute__((ext_vector_type(4)));
typedef unsigned v2u __attribute__((ext_vector_type(2)));
typedef float f32x4 __attribute__((ext_vector_type(4)));
typedef float f32x2 __attribute__((ext_vector_type(2)));
typedef short bf16x8 __attribute__((ext_vector_type(8)));
typedef short s16x4 __attribute__((ext_vector_type(4)));
#define RLX_AGENT __ATOMIC_RELAXED, __HIP_MEMORY_SCOPE_AGENT
#define LDS_WAIT() asm volatile("s_waitcnt lgkmcnt(0)" ::: "memory")
#define VM_WAIT() asm volatile("s_waitcnt vmcnt(0)" ::: "memory")
#define LDS_BARRIER() do { asm volatile("s_waitcnt lgkmcnt(0)" ::: "memory"); __builtin_amdgcn_s_barrier(); asm volatile("" ::: "memory"); } while (0)

typedef __bf16 bf16x2_t __attribute__((ext_vector_type(2)));
__device__ __forceinline__ unsigned pk2(float lo, float hi) { const f32x2 v = {lo, hi}; return __builtin_bit_cast(unsigned, __builtin_convertvector(v, bf16x2_t)); }
__device__ __forceinline__ unsigned f2bf(float f) { return (unsigned)__builtin_bit_cast(unsigned short, (__bf16)f); }
__device__ __forceinline__ unsigned pk4_fp8(float a, float b, float c, float d) { int w = __builtin_amdgcn_cvt_pk_fp8_f32(a, b, 0, false); w = __builtin_amdgcn_cvt_pk_fp8_f32(c, d, w, true); return (unsigned)w; }
__device__ __forceinline__ float bflo(unsigned w) { return __builtin_bit_cast(float, w << 16); }
__device__ __forceinline__ float bfhi(unsigned w) { return __builtin_bit_cast(float, w & 0xffff0000u); }
__device__ __forceinline__ float bf2f(bf16 b) { return __builtin_bit_cast(float, ((unsigned)b) << 16); }
__device__ __forceinline__ float fexp(float x) { return __builtin_amdgcn_exp2f(x * 1.4426950408889634f); }
__device__ __forceinline__ float wave_sum(float v) {
#pragma unroll
    for (int o = 1; o < 64; o <<= 1) v += __shfl_xor(v, o);
    return v;
}

constexpr int D = 1024, NBATCH = 16, SEQ = 4096, CTXL = 256;
constexpr int NLAT = NBATCH * SEQ;
constexpr int NCTXR = NBATCH * CTXL;
constexpr int NROWS = NLAT + NCTXR;
constexpr int PW = 3104, PWP = 3328;
constexpr int CQ = 0, CK = 256, CV = 512, CR = 1024, CAF = 1536, CAB = 1552, CPB = 1568, CPC = 2080, CPX = 2592;
constexpr int NCC = 68;
constexpr int NEXP = 32, DFF = 1024;
constexpr float EPS = 1e-6f;
constexpr int LISTCAP = 65536;
constexpr float WSCALE = 32.0f, WSCALE_INV = 1.0f / 32.0f;

#ifndef OUTPROJ_F8
#define OUTPROJ_F8 1
#endif
constexpr size_t MiB = 1u << 20;
constexpr size_t WS_CTL = 0, CTL_ZERO_BYTES = 32768;
constexpr size_t WS_MOD = 1 * MiB;
constexpr size_t WS_DECAY = 2 * MiB;
constexpr size_t WS_WIN = 6 * MiB;
constexpr size_t WS_WOUT = 13 * MiB;
constexpr size_t WS_HN = 16 * MiB;
constexpr size_t WS_KV = 16 * MiB;
constexpr size_t WS_P = 152 * MiB;
constexpr size_t WS_S = 565 * MiB;
constexpr size_t WS_YMIX = 693 * MiB;
constexpr size_t WS_Y1 = 821 * MiB;
constexpr size_t WS_ACT = 16 * MiB;
constexpr size_t WS_YA = 280 * MiB;
constexpr size_t WS_VT = 949 * MiB;
constexpr size_t WS_END = 1013 * MiB;
constexpr size_t WS_TSLOT = 1013 * MiB;
constexpr size_t WS_TW = 1015 * MiB;
constexpr size_t WS_TOTAL = 1017 * MiB;
constexpr size_t DO_WDN = 0;
constexpr size_t DO_WGU = 32 * MiB;
constexpr size_t DO_HN2 = 96 * MiB;
constexpr size_t DO_LAID = 160 * MiB;
constexpr size_t DO_LW = 168 * MiB;
static_assert(WS_P + (size_t)NROWS * PW * 2 <= WS_S && WS_YMIX + (size_t)NLAT * D * 2 <= WS_Y1 && WS_YA + (size_t)1056 * 256 * D <= WS_Y1 && WS_Y1 + (size_t)NLAT * D * 2 <= WS_VT && WS_VT + (size_t)NLAT * 512 * 2 <= WS_END, "ws map");
static_assert(WS_HN + (size_t)NROWS * D * 2 <= WS_P && WS_ACT + (size_t)1056 * 256 * 1024 <= WS_YA && DO_LW + (size_t)NEXP * LISTCAP * 4 <= (size_t)NLAT * D * 4, "ws map 2");
constexpr int CW_CNT = 64;
constexpr int CW_BAR = 4096;

constexpr int RING_BYTES = 131072;
constexpr int MISC_OFF = RING_BYTES;
constexpr int LDS_BYTES = 147456;
constexpr int NWAVES = 8, NTHREADS = 512;

namespace pg8 {
constexpr int BM = 256, BK = 64, HALF = 128, HTB = HALF * BK * 2, STAGE_BYTES = 8 * HTB;
__host__ __device__ __forceinline__ int lds_byte(int r, int c) { const int st = (r >> 4) * 2 + (c >> 5), rr = r & 15, cc = c & 31, ob = rr * 64 + cc * 2; return st * 1024 + (ob ^ (((ob >> 9) & 1) << 5)); }
__host__ __device__ __forceinline__ void stage_rc(int b, int& R, int& C) { const int st = b / 1024, sb = b % 1024, swz = sb ^ (((sb >> 9) & 1) << 5); R = (st >> 1) * 16 + swz / 64; C = (st & 1) * 32 + (swz % 64) / 2; }
__host__ __device__ __forceinline__ int perm32(int rho) { const int n = rho >> 4, i = rho & 15; return 8 * (i >> 2) + 4 * n + (i & 3); }

typedef int v8i __attribute__((ext_vector_type(8)));
typedef int v4i __attribute__((ext_vector_type(4)));
__device__ __forceinline__ v8i cat8(bf16x8 lo, bf16x8 hi) { return __builtin_shufflevector(__builtin_bit_cast(v4i, lo), __builtin_bit_cast(v4i, hi), 0, 1, 2, 3, 4, 5, 6, 7); }
struct Unit { int pm, pn, e, lt; };
__device__ __forceinline__ unsigned cvt_pk_bf16(float lo, float hi) { unsigned r; asm volatile("v_cvt_pk_bf16_f32 %0, %1, %2" : "=v"(r) : "v"(lo), "v"(hi)); return r; }

template <class Epi, class Sched, bool ALIGN_EPI, bool F8>
__device__ __forceinline__ void gemm_phase(LAS unsigned char* lds, const char* Abase, const Sched& S, const Epi& E) {
    int tid_ = threadIdx.x; asm volatile("" : "+v"(tid_));
    const int tid = tid_, wid = __builtin_amdgcn_readfirstlane(tid >> 6), lane = tid & 63, wr = wid >> 2, wc = wid & 3, fr = lane & 15, fq = lane >> 4;
    constexpr int KB = F8 ? 1024 : 2048, NT = KB / 128;
    unsigned voffB[2];
#pragma unroll
    for (int i = 0; i < 2; ++i) { int R, C; stage_rc(tid * 16 + i * 8192, R, C); const int Rb = Epi::PERM ? ((R & ~31) + perm32(R & 31)) : R; voffB[i] = (unsigned)(Rb * KB + C * 2); }
#define PG8_AROWS(u_, dst_) do { _Pragma("unroll") for (int h_ = 0; h_ < 2; ++h_) _Pragma("unroll") for (int i_ = 0; i_ < 2; ++i_) { int R_, C_; stage_rc(tid * 16 + i_ * 8192, R_, C_); \
        dst_[h_][i_] = (unsigned)S.arow(u_, h_ * HALF + R_); } } while (0)
#define PG8_AOFF2(dst_) do { _Pragma("unroll") for (int h_ = 0; h_ < 2; ++h_) _Pragma("unroll") for (int i_ = 0; i_ < 2; ++i_) { int R_, C_; stage_rc(tid * 16 + i_ * 8192, R_, C_); \
        dst_[h_][i_] = dst_[h_][i_] * (unsigned)KB + (unsigned)C_ * 2u; } } while (0)
    const size_t kstep = (size_t)(BK * 2);
    const size_t hstep = (size_t)HALF * KB;
    const unsigned ldsw = (unsigned)wid * 1024u;
    const int aoff = lds_byte(wr * 64 + fr, fq * 8), boff = lds_byte(wc * 32 + fr, fq * 8);
#define PG8_SA(b, h) (((b) * 2 + (h)) * HTB)
#define PG8_SB(b, h) ((4 + (b) * 2 + (h)) * HTB)
#define PG8_STAGE(bufoff, gbase, voff) do { _Pragma("unroll") for (int _i = 0; _i < 2; ++_i) \
        __builtin_amdgcn_global_load_lds((const unsigned*)((const char*)(gbase) + (voff)[_i]), (LAS unsigned*)(lds + (bufoff) + ldsw + _i * 8192), 16, 0, 0); } while (0)
#define PG8_LDA(dst, b, h) do { _Pragma("unroll") for (int m = 0; m < 4; ++m) _Pragma("unroll") for (int k = 0; k < 2; ++k) dst[m][k] = *(const LAS bf16x8*)(lds + PG8_SA(b, h) + aoff + m * 2048 + k * 1024); } while (0)
#define PG8_LDB(dst, b, h) do { _Pragma("unroll") for (int n = 0; n < 2; ++n) _Pragma("unroll") for (int k = 0; k < 2; ++k) dst[n][k] = *(const LAS bf16x8*)(lds + PG8_SB(b, h) + boff + n * 2048 + k * 1024); } while (0)
#define PG8_MMA(ai, bj, At, Bt) do { if (skipmma && ((bj) == 1 || wc > 0)) break; __builtin_amdgcn_s_setprio(1); _Pragma("unroll") for (int m = 0; m < 4; ++m) _Pragma("unroll") for (int n = 0; n < 2; ++n) { \
        if constexpr (F8) { asm volatile("v_mfma_f32_16x16x128_f8f6f4 %0, %1, %2, %0" : "+v"(acc[ai][bj][m][n]) : "v"(cat8(Bt[n][0], Bt[n][1])), "v"(cat8(At[m][0], At[m][1]))); } \
        else { _Pragma("unroll") for (int k = 0; k < 2; ++k) acc[ai][bj][m][n] = __builtin_amdgcn_mfma_f32_16x16x32_bf16(Bt[n][k], At[m][k], acc[ai][bj][m][n], 0, 0, 0); } } \
        __builtin_amdgcn_s_setprio(0); } while (0)
#define PG8_WAIT_V(n) asm volatile("s_waitcnt vmcnt(" #n ")" ::: "memory")
#define PG8_WAIT_L(n) asm volatile("s_waitcnt lgkmcnt(" #n ")" ::: "memory")
#define PG8_BAR __builtin_amdgcn_s_barrier()
#define PG8_SCHED __builtin_amdgcn_sched_barrier(0)
    Unit cur, nxt; int ui = 0;
    if (!S.next(0, cur)) return;
    f32x4 acc[2][2][4][2];
#pragma unroll
    for (int a = 0; a < 2; ++a)
#pragma unroll
        for (int b = 0; b < 2; ++b)
#pragma unroll
            for (int m = 0; m < 4; ++m)
#pragma unroll
                for (int n = 0; n < 2; ++n) acc[a][b][m][n] = (f32x4){0.f, 0.f, 0.f, 0.f};
    bf16x8 At[4][2], B0[2][2], B1[2][2];
    unsigned oC[2][2];
    PG8_AROWS(cur, oC); PG8_AOFF2(oC);
    unsigned rN[2] = {0u, 0u};
    const char* cB = S.bptr(cur);
    PG8_STAGE(PG8_SB(0, 0), cB, voffB); PG8_STAGE(PG8_SB(0, 1), cB + hstep, voffB); PG8_STAGE(PG8_SA(0, 0), Abase, oC[0]); PG8_STAGE(PG8_SA(0, 1), Abase, oC[1]);
    if (wr == 1) PG8_BAR;
    PG8_WAIT_V(2); PG8_BAR;
    PG8_STAGE(PG8_SB(1, 0), cB + kstep, voffB); PG8_STAGE(PG8_SA(1, 0), Abase + kstep, oC[0]); PG8_STAGE(PG8_SB(1, 1), cB + hstep + kstep, voffB);
    PG8_WAIT_V(6); PG8_BAR;
    for (;;) {
        const bool skipmma = S.mostly_padding(cur);
        const bool has_next = S.next(ui + 1, nxt);
        if (!has_next) nxt = cur;
        const char* nB = S.bptr(nxt);
        for (int t = 0; t < NT; t += 2) {
            const bool last = (t == NT - 2);
            const char* ka1 = Abase + (size_t)(t + 1) * kstep;
            const char* ka2 = last ? Abase : Abase + (size_t)(t + 2) * kstep; const char* b2 = last ? nB : cB + (size_t)(t + 2) * kstep;
            const char* ka3 = ka2 + kstep; const char* b3 = b2 + kstep;
            PG8_LDB(B0, 0, 0); PG8_LDB(B1, 0, 1); PG8_SCHED; PG8_LDA(At, 0, 0); PG8_STAGE(PG8_SA(1, 1), ka1, oC[1]);
            PG8_WAIT_V(8); PG8_WAIT_L(0); PG8_BAR; PG8_MMA(0, 0, At, B0); PG8_MMA(0, 1, At, B1); PG8_BAR; PG8_SCHED;
            if constexpr (Sched::GATHER) { if (t == NT - 4) { unsigned r4[2][2]; PG8_AROWS(nxt, r4); rN[0] = r4[0][0] | (r4[0][1] << 16); rN[1] = r4[1][0] | (r4[1][1] << 16); } }
            if (last) {
                if constexpr (Sched::GATHER) { oC[0][0] = rN[0] & 0xffffu; oC[0][1] = rN[0] >> 16; oC[1][0] = rN[1] & 0xffffu; oC[1][1] = rN[1] >> 16; }
                else { PG8_AROWS(nxt, oC); }
                PG8_AOFF2(oC); }
            PG8_LDA(At, 0, 1); PG8_STAGE(PG8_SB(0, 0), b2, voffB); PG8_STAGE(PG8_SB(0, 1), b2 + hstep, voffB); PG8_STAGE(PG8_SA(0, 0), ka2, oC[0]);
            PG8_WAIT_V(8); PG8_WAIT_L(0); PG8_BAR; PG8_MMA(1, 0, At, B0); PG8_MMA(1, 1, At, B1); PG8_BAR; PG8_SCHED;
            PG8_LDB(B0, 1, 0); PG8_LDB(B1, 1, 1); PG8_SCHED; PG8_LDA(At, 1, 0); PG8_STAGE(PG8_SA(0, 1), ka2, oC[1]);
            PG8_WAIT_V(8); PG8_WAIT_L(0); PG8_BAR; PG8_MMA(0, 0, At, B0); PG8_MMA(0, 1, At, B1); PG8_BAR; PG8_SCHED;
            PG8_LDA(At, 1, 1); PG8_STAGE(PG8_SB(1, 0), b3, voffB); PG8_STAGE(PG8_SB(1, 1), b3 + hstep, voffB); PG8_STAGE(PG8_SA(1, 0), ka3, oC[0]);
            PG8_WAIT_V(8); PG8_WAIT_L(0); PG8_BAR; PG8_MMA(1, 0, At, B0); PG8_MMA(1, 1, At, B1); PG8_BAR; PG8_SCHED;
        }
        if constexpr (ALIGN_EPI) { if (wr == 0) PG8_BAR; }
        if constexpr (F8) asm volatile("s_nop 15\n\ts_nop 7" ::: "memory");
        { int fr_o = fr, fq_o = fq; asm volatile("" : "+v"(fr_o), "+v"(fq_o));
          E(acc, cur, wr, wc, fr_o, fq_o); }
        if (!has_next) break;
#pragma unroll
        for (int a = 0; a < 2; ++a)
#pragma unroll
            for (int b = 0; b < 2; ++b)
#pragma unroll
                for (int m = 0; m < 4; ++m)
#pragma unroll
                    for (int n = 0; n < 2; ++n) acc[a][b][m][n] = (f32x4){0.f, 0.f, 0.f, 0.f};
        cur = nxt; cB = nB; ++ui;
        if constexpr (ALIGN_EPI) { if (wr == 1) PG8_BAR; }
    }
    PG8_WAIT_V(0);
    if constexpr (!ALIGN_EPI) { if (wr == 0) PG8_BAR; }
    PG8_BAR;
#undef PG8_AROWS
#undef PG8_AOFF2
#undef PG8_SA
#undef PG8_SB
#undef PG8_STAGE
#undef PG8_LDA
#undef PG8_LDB
#undef PG8_MMA
#undef PG8_WAIT_V
#undef PG8_WAIT_L
#undef PG8_BAR
#undef PG8_SCHED
}
}

#define XB_TMO      128
#define XB_XCNT(j)  (256  + 64 * (j))
#define XB_XSUB(j)  (1280 + 64 * (j))
#define XB_XGEN(j)  (2304 + 64 * (j))
#define XB_TOP      3328
#define XB_TOPGEN   3392
#define XCD_BAR_WORDS 3456
#define XB_SPIN_CAP (1u << 22)
__device__ __forceinline__ unsigned xb_ld(unsigned* p)              { return __hip_atomic_load(p, __ATOMIC_RELAXED, __HIP_MEMORY_SCOPE_AGENT); }
__device__ __forceinline__ unsigned xb_add(unsigned* p, unsigned v) { return __hip_atomic_fetch_add(p, v, __ATOMIC_RELAXED, __HIP_MEMORY_SCOPE_AGENT); }
__device__ __forceinline__ unsigned xb_xcc_id() { return (unsigned)__builtin_amdgcn_s_getreg((3 << 11) | 20) & 0xFu; }
#define XB_SPIN(cond, bar) do { unsigned _sp = 0; while (cond) { __builtin_amdgcn_s_sleep(1); \
    if ((++_sp & 255u) == 0u) { if (xb_ld(&(bar)[XB_TMO])) break; if (_sp > XB_SPIN_CAP) { atomicAdd(&(bar)[XB_TMO], 1u); break; } } } } while (0)
struct XcdBarrier { unsigned* bar; unsigned x; volatile LAS unsigned* st; };
__device__ __forceinline__ XcdBarrier xcd_barrier_post(unsigned* bar, volatile LAS unsigned* st) {
    XcdBarrier b; b.bar = bar; b.x = xb_xcc_id(); b.st = st;
    if (threadIdx.x == 0) (void)xb_add(&bar[XB_XCNT(b.x)], 1u);
    return b;
}
__device__ __forceinline__ void xcd_barrier_complete(unsigned* bar, unsigned x, unsigned& nloc, unsigned& nx) {
    const unsigned G = gridDim.x * gridDim.y * gridDim.z;
    unsigned sum, cnt, mine, sp = 0u;
    for (;;) {
        sum = 0u; cnt = 0u; mine = 0u;
#pragma unroll 1
        for (unsigned j = 0; j < 16; ++j) { const unsigned c = xb_ld(&bar[XB_XCNT(j)]); sum += c; cnt += (c > 0u) ? 1u : 0u; mine = (j == x) ? c : mine; }
        if (sum == G) break;
        __builtin_amdgcn_s_sleep(1);
        if ((++sp & 255u) == 0u) { if (xb_ld(&bar[XB_TMO])) break; if (sp > XB_SPIN_CAP) { atomicAdd(&bar[XB_TMO], 1u); break; } }
    }
    nloc = mine > 0u ? mine : 1u; nx = cnt > 0u ? cnt : 1u;
}
__device__ __forceinline__ void xcd_barrier(const XcdBarrier& b) {
    asm volatile("s_waitcnt vmcnt(0)" ::: "memory");
    __syncthreads();
    if (threadIdx.x == 0) {
        unsigned* bar = b.bar;
        __builtin_amdgcn_s_waitcnt(0);
        unsigned nloc = b.st[0], nx = b.st[1];
        if (nloc == 0u) { xcd_barrier_complete(bar, b.x, nloc, nx); b.st[0] = nloc; b.st[1] = nx; }
        const unsigned old = xb_add(&bar[XB_XSUB(b.x)], 1u);
        const unsigned gen = old / nloc;
        if (old + 1u == (gen + 1u) * nloc) {
            __builtin_amdgcn_fence(__ATOMIC_RELEASE, "agent");
            asm volatile("s_waitcnt vmcnt(0)" ::: "memory");
            const unsigned og = xb_add(&bar[XB_TOP], 1u);
            const unsigned tg = og / nx;
            if (og + 1u == (tg + 1u) * nx) xb_add(&bar[XB_TOPGEN], 1u);
            else XB_SPIN(xb_ld(&bar[XB_TOPGEN]) == tg, bar);
            __builtin_amdgcn_fence(__ATOMIC_ACQUIRE, "agent");
            xb_add(&bar[XB_XGEN(b.x)], 1u);
            asm volatile("s_waitcnt vmcnt(0)" ::: "memory");
        } else {
            XB_SPIN(xb_ld(&bar[XB_XGEN(b.x)]) == gen, bar);
            __builtin_amdgcn_fence(__ATOMIC_ACQUIRE, "agent");
            asm volatile("s_waitcnt vmcnt(0)" ::: "memory");
        }
    }
    __syncthreads();
}

struct Args { const float* in[23]; float* out; unsigned char* ws; int ph_lo, ph_hi; };
typedef const Args __attribute__((address_space(4))) CArgs;
__device__ __forceinline__ CArgs* opaque_args() { CArgs* p = (CArgs*)__builtin_amdgcn_kernarg_segment_ptr(); asm volatile("" : "+s"(p)); return p; }
struct Frame {
    LAS unsigned char* lds;
    int tid, lane, wave, G, bid;
    float* out; unsigned char* ws;
};

struct EpiNull {
    static constexpr bool PERM = true;
    __device__ __forceinline__ void operator()(const f32x4 (&acc)[2][2][4][2], const pg8::Unit&, int, int, int, int) const {
#pragma unroll
        for (int a = 0; a < 2; ++a)
#pragma unroll
            for (int b = 0; b < 2; ++b)
#pragma unroll
                for (int m = 0; m < 4; ++m)
#pragma unroll
                    for (int n = 0; n < 2; ++n) asm volatile("" :: "v"(acc[a][b][m][n]));
    }
};
struct DenseSched {
    static constexpr bool GATHER = false;
    int nM, nN, nwg, G, c, kb; const char* Bt; const LAS int* UT;
    __device__ __forceinline__ void init(int M, int N, int G_, int c_, const void* Bt_) { nM = M / 256; nN = N / 256; nwg = nM * nN; G = G_; c = c_; Bt = (const char*)Bt_; UT = nullptr; kb = 2048; }
    __device__ __forceinline__ void build(LAS int* ut, int tid) { if (tid < 32) { pg8::Unit u; ut[tid] = next_calc(tid, u) ? (u.pm | (u.pn << 16)) : -1; } UT = ut; __syncthreads(); }
    __device__ __forceinline__ bool next(int i, pg8::Unit& u) const { const int w = (i < 32) ? UT[i] : -1; if (w < 0) return false; u.pm = w & 0xffff; u.pn = w >> 16; u.e = 0; u.lt = 0; return true; }
    __device__ __forceinline__ bool next_calc(int i, pg8::Unit& u) const {
        const long L = (long)i * G + c; if (L >= nwg) return false;
        int wgid = (int)L; { const int q = nwg / 8, r = nwg % 8, xcd = wgid % 8, off = wgid / 8; wgid = (xcd < r ? xcd * (q + 1) : r * (q + 1) + (xcd - r) * q) + off; }
        const int nig = 8 * nN, gid = wgid / nig, fm = gid * 8, gsz = (nM - fm) < 8 ? (nM - fm) : 8;
        u.pm = fm + ((wgid % nig) % gsz); u.pn = (wgid % nig) / gsz; u.e = 0; u.lt = 0; return true;
    }
    __device__ __forceinline__ int arow(const pg8::Unit& u, int r) const { return u.pm * 256 + r; }
    __device__ __forceinline__ bool mostly_padding(const pg8::Unit& u) const { return nN == PWP / 256 && u.pn == nN - 1; }
    __device__ __forceinline__ const char* bptr(const pg8::Unit& u) const { return Bt + (size_t)u.pn * 256 * kb; }
};
struct EpiProj {
    static constexpr bool PERM = true;
    bf16* O;
    __device__ __forceinline__ void operator()(const f32x4 (&acc)[2][2][4][2], const pg8::Unit& u, int wr, int wc, int fr, int fq) const {
        const int row0 = u.pm * 256 + wr * 64 + fr, col0 = u.pn * 256 + wc * 32 + 8 * fq;
#pragma unroll
        for (int ai = 0; ai < 2; ++ai)
#pragma unroll
            for (int m = 0; m < 4; ++m) { bf16* rowp = O + (size_t)(row0 + ai * 128 + m * 16) * PW + col0;
#pragma unroll
                for (int bj = 0; bj < 2; ++bj) { if (col0 + bj * 128 < PW) { const f32x4 v0 = acc[ai][bj][m][0], v1 = acc[ai][bj][m][1];
                    v4u w; w.x = pk2(v0[0], v0[1]); w.y = pk2(v0[2], v0[3]); w.z = pk2(v1[0], v1[1]); w.w = pk2(v1[2], v1[3]);
                    *(v4u*)(rowp + bj * 128) = w; } } }
    }
};
struct EpiOut {
    static constexpr bool PERM = true;
    const float* x; const float* mod; bf16* Y1; float sc;
    __device__ __forceinline__ void operator()(const f32x4 (&acc)[2][2][4][2], const pg8::Unit& u, int wr, int wc, int fr, int fq) const {
        const int row0 = u.pm * 256 + wr * 64 + fr, col0 = u.pn * 256 + wc * 32 + 8 * fq;
        const float* g1 = mod + (size_t)(u.pm >> 4) * 6144 + 2048;
        f32x4 gv[2][2];
#pragma unroll
        for (int bj = 0; bj < 2; ++bj)
#pragma unroll
            for (int n = 0; n < 2; ++n) gv[bj][n] = *(const f32x4*)(g1 + col0 + bj * 128 + 4 * n) * sc;
#pragma unroll
        for (int ai = 0; ai < 2; ++ai)
#pragma unroll
            for (int m = 0; m < 4; ++m) { const size_t off = (size_t)(row0 + ai * 128 + m * 16) * D + col0; bf16* rowp = Y1 + off;
#pragma unroll
                for (int bj = 0; bj < 2; ++bj) { const f32x4 x0 = *(const f32x4*)(x + off + bj * 128), x1 = *(const f32x4*)(x + off + bj * 128 + 4);
                    const f32x4 v0 = x0 + acc[ai][bj][m][0] * gv[bj][0], v1 = x1 + acc[ai][bj][m][1] * gv[bj][1];
                    v4u w; w.x = pk2(v0[0], v0[1]); w.y = pk2(v0[2], v0[3]); w.z = pk2(v1[0], v1[1]); w.w = pk2(v1[2], v1[3]);
                    *(v4u*)(rowp + bj * 128) = w; } }
    }
};
template <bool GU> struct MoeSched {
    static constexpr bool GATHER = GU;
    static constexpr bool gu = GU;
    const LAS int* TS; int ntr, G, c; const int* laid; const char* W;
    __device__ __forceinline__ bool next(int i, pg8::Unit& u) const {
        const int x = c & 7, j = c >> 3; int tl, pn;
        if (G != 256) { const int L = i * G + c, npn = gu ? 8 : 4; tl = L / npn; pn = L % npn; }
        else if (gu) { tl = (i * 8 + x) * 4 + (j >> 3); pn = j & 7; } else { tl = (i * 8 + x) * 8 + (j >> 2); pn = j & 3; }
        if (tl >= ntr) return false;
        const int tau = tl; const int e = ((const LAS unsigned char*)(TS + 72))[tau];
        u.pm = tl; u.pn = pn; u.e = e; u.lt = tau - TS[e]; return true;
    }
    __device__ __forceinline__ bool mostly_padding(const pg8::Unit&) const { return false; }
    __device__ __forceinline__ int arow(const pg8::Unit& u, int r) const {
        if (!gu) return u.pm * 256 + r;
        const int pos = u.lt * 256 + r, cnt = TS[33 + u.e];
        return pos < cnt ? (laid[(size_t)u.e * LISTCAP + pos] >> 2) : 0;
    }
    __device__ __forceinline__ const char* bptr(const pg8::Unit& u) const { return W + ((size_t)u.e * (gu ? 2048 : 1024) + (size_t)u.pn * 256) * 1024; }
};
struct EpiGU {
    static constexpr bool PERM = true;
    unsigned char* ACT; const float* b_gu;
    __device__ __forceinline__ void operator()(const f32x4 (&acc)[2][2][4][2], const pg8::Unit& u, int wr, int wc, int fr, int fq) const {
        const int row0 = u.pm * 256 + wr * 64 + fr, j0 = u.pn * 128 + wc * 32 + 8 * fq;
        const float* bp = b_gu + (size_t)u.e * 2048 + 2 * j0;
        f32x4 bv[4];
#pragma unroll
        for (int q = 0; q < 4; ++q) bv[q] = *(const f32x4*)(bp + 4 * q);
        f32x2 bg[4], bu[4];
#pragma unroll
        for (int q = 0; q < 4; ++q) { bg[q] = (f32x2){bv[q][0], bv[q][2]}; bu[q] = (f32x2){bv[q][1], bv[q][3]}; }
#pragma unroll
        for (int ai = 0; ai < 2; ++ai)
#pragma unroll
            for (int m = 0; m < 4; ++m) { unsigned char* rowp = ACT + (size_t)(row0 + ai * 128 + m * 16) * DFF + j0; f32x2 a[4];
#pragma unroll
                for (int n = 0; n < 2; ++n)
#pragma unroll
                    for (int p = 0; p < 2; ++p) { const int q = 2 * n + p;
                        const f32x4 ag = acc[ai][0][m][n], au = acc[ai][1][m][n];
                        f32x2 g = (f32x2){ag[2 * p], ag[2 * p + 1]} * WSCALE_INV + bg[q], up = (f32x2){au[2 * p], au[2 * p + 1]} * WSCALE_INV + bu[q];
                        g.x = fminf(g.x, 7.0f); g.y = fminf(g.y, 7.0f); up.x = __builtin_amdgcn_fmed3f(up.x, -7.0f, 7.0f); up.y = __builtin_amdgcn_fmed3f(up.y, -7.0f, 7.0f);
                        const f32x2 t = g * (-1.702f * 1.4426950408889634f); f32x2 e; e.x = __builtin_amdgcn_exp2f(t.x); e.y = __builtin_amdgcn_exp2f(t.y);
                        const f32x2 d = e + 1.0f; f32x2 sg; sg.x = __builtin_amdgcn_rcpf(d.x); sg.y = __builtin_amdgcn_rcpf(d.y);
                        a[q] = ((up + 1.0f) * g) * sg; }
                v2u w; w.x = pk4_fp8(a[0].x, a[0].y, a[1].x, a[1].y); w.y = pk4_fp8(a[2].x, a[2].y, a[3].x, a[3].y);
                *(v2u*)rowp = w; }
    }
};
struct EpiDN {
    static constexpr bool PERM = true;
    unsigned char* YA; const float* b_dn; const LAS int* TS;
    __device__ __forceinline__ void operator()(const f32x4 (&acc)[2][2][4][2], const pg8::Unit& u, int wr, int wc, int fr, int fq) const {
        const int col0 = u.pn * 256 + wc * 32 + 8 * fq, cnt = TS[33 + u.e];
        f32x4 bv[2][2];
#pragma unroll
        for (int bj = 0; bj < 2; ++bj)
#pragma unroll
            for (int n = 0; n < 2; ++n) bv[bj][n] = *(const f32x4*)(b_dn + (size_t)u.e * D + col0 + bj * 128 + 4 * n);
#pragma unroll
        for (int ai = 0; ai < 2; ++ai)
#pragma unroll
            for (int m = 0; m < 4; ++m) { const int r = ai * 128 + wr * 64 + m * 16 + fr;
                if (u.lt * 256 + r < cnt) { unsigned char* rowp = YA + ((size_t)u.pm * 256 + r) * D + col0;
#pragma unroll
                    for (int bj = 0; bj < 2; ++bj) { const f32x4 v0 = acc[ai][bj][m][0] * WSCALE_INV + bv[bj][0], v1 = acc[ai][bj][m][1] * WSCALE_INV + bv[bj][1];
                        v2u w; w.x = pk4_fp8(v0[0], v0[1], v0[2], v0[3]); w.y = pk4_fp8(v1[0], v1[1], v1[2], v1[3]);
                        *(v2u*)(rowp + bj * 128) = w; } }
                asm volatile("" ::: "memory"); }
    }
};

template <bool MAPGU>
__device__ __forceinline__ void p0_transpose_item(const float* W, int N, bf16* WT, LAS float* scr, int item, int lane) {
    const int nblk = N / 32, kb = item / nblk, nb = item % nblk, k0 = 64 * kb, n0 = 32 * nb;
#pragma unroll
    for (int i = 0; i < 32; ++i) { const int kk = 2 * i + (lane >> 5); scr[kk * 33 + (lane & 31)] = W[(size_t)(k0 + kk) * N + n0 + (lane & 31)]; }
    LDS_WAIT(); asm volatile("" ::: "memory");
    const int c = lane & 7;
#pragma unroll
    for (int j = 0; j < 4; ++j) { const int n = (lane >> 3) + 8 * j; const LAS float* s = scr + (8 * c) * 33 + n;
        v4u o; o.x = pk2(s[0 * 33], s[1 * 33]); o.y = pk2(s[2 * 33], s[3 * 33]); o.z = pk2(s[4 * 33], s[5 * 33]); o.w = pk2(s[6 * 33], s[7 * 33]);
        int row = n0 + n;
        if (MAPGU) { const int jj = row >> 1; row = (jj >> 7) * 256 + (row & 1) * 128 + (jj & 127); }
        *(v4u*)(WT + (size_t)row * D + k0 + 8 * c) = o; }
    LDS_WAIT(); asm volatile("" ::: "memory");
}
template <bool MAPGU>
__device__ __forceinline__ void p0_transpose_item_f8(const float* W, int N, unsigned char* WT, LAS float* scr, int item, int lane) {
    const int nblk = N / 32, kb = item / nblk, nb = item % nblk, k0 = 64 * kb, n0 = 32 * nb;
#pragma unroll
    for (int i = 0; i < 32; ++i) { const int kk = 2 * i + (lane >> 5); scr[kk * 33 + (lane & 31)] = W[(size_t)(k0 + kk) * N + n0 + (lane & 31)] * WSCALE; }
    LDS_WAIT(); asm volatile("" ::: "memory");
    const int c = lane & 3;
#pragma unroll
    for (int j = 0; j < 2; ++j) { const int n = (lane >> 2) + 16 * j; const LAS float* s = scr + (16 * c) * 33 + n;
        v4u o; o.x = pk4_fp8(s[0 * 33], s[1 * 33], s[2 * 33], s[3 * 33]); o.y = pk4_fp8(s[4 * 33], s[5 * 33], s[6 * 33], s[7 * 33]);
        o.z = pk4_fp8(s[8 * 33], s[9 * 33], s[10 * 33], s[11 * 33]); o.w = pk4_fp8(s[12 * 33], s[13 * 33], s[14 * 33], s[15 * 33]);
        int row = n0 + n;
        if (MAPGU) { const int jj = row >> 1; row = (jj >> 7) * 256 + (row & 1) * 128 + (jj & 127); }
        *(v4u*)(WT + (size_t)row * D + k0 + 16 * c) = o; }
    LDS_WAIT(); asm volatile("" ::: "memory");
}
constexpr int P0_TS = 144;
struct P0Item { const float* W; void* O; int N, k0, n0, kind; };
__device__ __forceinline__ P0Item p0_item(const Frame& F, CArgs* A, int it) {
    constexpr int I_IN = 8 * 25, I_OUT = 8 * 8, I_GU = 8 * 16, I_DN = 8 * 8;
    P0Item r; int x = it;
    if (x < I_IN) { r.W = A->in[7]; r.O = (void*)(F.ws + WS_WIN); r.N = PW; r.k0 = (x / 25) * 128; r.n0 = (x % 25) * 128; r.kind = 0; return r; } x -= I_IN;
    if (x < I_OUT) { r.W = A->in[14]; r.O = (void*)(F.ws + WS_WOUT); r.N = D; r.k0 = (x >> 3) * 128; r.n0 = (x & 7) * 128; r.kind = OUTPROJ_F8 ? 1 : 0; return r; } x -= I_OUT;
    if (x < NEXP * I_GU) { const int e = x / I_GU, y = x % I_GU; r.W = A->in[18] + (size_t)e * D * 2048; r.O = (void*)((unsigned char*)F.out + DO_WGU + (size_t)e * 2048 * D); r.N = 2048; r.k0 = (y >> 4) * 128; r.n0 = (y & 15) * 128; r.kind = 2; return r; } x -= NEXP * I_GU;
    { const int e = x / I_DN, y = x % I_DN; r.W = A->in[20] + (size_t)e * D * D; r.O = (void*)((unsigned char*)F.out + DO_WDN + (size_t)e * D * D); r.N = D; r.k0 = (y >> 3) * 128; r.n0 = (y & 7) * 128; r.kind = 1; return r; }
}
__device__ __forceinline__ void p0_load(const P0Item& I, int tid, f32x4 (&v)[8]) {
#pragma unroll
    for (int q = 0; q < 8; ++q) { const int idx = tid + NTHREADS * q, k = idx >> 5, col = I.n0 + 4 * (idx & 31);
        v[q] = (col < I.N) ? *(const f32x4*)(I.W + (size_t)(I.k0 + k) * I.N + col) : (f32x4){0.f, 0.f, 0.f, 0.f}; }
}
__device__ __forceinline__ void p0_emit(const P0Item& I, LAS unsigned char* lds, int wave, int i, int g) {
    const unsigned a0 = (unsigned)(uintptr_t)lds + (unsigned)(((32 * g + (i >> 2)) * P0_TS + 16 * wave + 4 * (i & 3)) * 2);
    s16x4 r[8];
    asm volatile("ds_read_b64_tr_b16 %0, %8\n\tds_read_b64_tr_b16 %1, %8 offset:1152\n\tds_read_b64_tr_b16 %2, %8 offset:2304\n\tds_read_b64_tr_b16 %3, %8 offset:3456\n\t"
                 "ds_read_b64_tr_b16 %4, %8 offset:4608\n\tds_read_b64_tr_b16 %5, %8 offset:5760\n\tds_read_b64_tr_b16 %6, %8 offset:6912\n\tds_read_b64_tr_b16 %7, %8 offset:8064\n\ts_waitcnt lgkmcnt(0)"
                 : "=&v"(r[0]), "=&v"(r[1]), "=&v"(r[2]), "=&v"(r[3]), "=&v"(r[4]), "=&v"(r[5]), "=&v"(r[6]), "=&v"(r[7]) : "v"(a0) : "memory");
    const int n = I.n0 + 16 * wave + i;
    if (n < I.N) {
        if (I.kind == 0) { bf16* op = (bf16*)I.O + (size_t)n * D + I.k0 + 32 * g;
#pragma unroll
            for (int q = 0; q < 4; ++q) { v4u w; w.x = (unsigned)(unsigned short)r[2 * q][0] | ((unsigned)(unsigned short)r[2 * q][1] << 16); w.y = (unsigned)(unsigned short)r[2 * q][2] | ((unsigned)(unsigned short)r[2 * q][3] << 16);
                w.z = (unsigned)(unsigned short)r[2 * q + 1][0] | ((unsigned)(unsigned short)r[2 * q + 1][1] << 16); w.w = (unsigned)(unsigned short)r[2 * q + 1][2] | ((unsigned)(unsigned short)r[2 * q + 1][3] << 16);
                *(v4u*)(op + 8 * q) = w; } }
        else { int row = n; if (I.kind == 2) { const int jj = n >> 1; row = (jj >> 7) * 256 + (n & 1) * 128 + (jj & 127); }
            unsigned char* op = (unsigned char*)I.O + (size_t)row * D + I.k0 + 32 * g;
#pragma unroll
            for (int q = 0; q < 2; ++q) { v4u w; unsigned* wp = (unsigned*)&w;
#pragma unroll
                for (int j = 0; j < 4; ++j) { const s16x4 x = r[4 * q + j]; wp[j] = pk4_fp8(bf2f((bf16)x[0]) * WSCALE, bf2f((bf16)x[1]) * WSCALE, bf2f((bf16)x[2]) * WSCALE, bf2f((bf16)x[3]) * WSCALE); }
                *(v4u*)(op + 16 * q) = w; } } }
}
__device__ __forceinline__ void p0_phase(const Frame& F, CArgs* A) {
    LAS unsigned char* lds = F.lds; const int tid = F.tid, lane = F.lane, wave = F.wave, i = lane & 15, g = lane >> 4;
    constexpr int NITEMS = 8 * 25 + 8 * 8 + NEXP * 8 * 16 + NEXP * 8 * 8;
    f32x4 va[8], vb[8];
    if (F.bid < NITEMS) { const P0Item I0 = p0_item(F, A, F.bid); p0_load(I0, tid, va); }
    if (F.bid + F.G < NITEMS) { const P0Item I1 = p0_item(F, A, F.bid + F.G); p0_load(I1, tid, vb); }
#define P0_STEP(VCUR, it_) do { const P0Item I = p0_item(F, A, it_); \
        _Pragma("unroll") for (int q = 0; q < 8; ++q) { const int idx = tid + NTHREADS * q, k = idx >> 5, p = idx & 31; v2u w; w.x = pk2(VCUR[q][0], VCUR[q][1]); w.y = pk2(VCUR[q][2], VCUR[q][3]); \
            *(LAS v2u*)(lds + (k * P0_TS + 4 * p) * 2) = w; } \
        if ((it_) + 2 * F.G < NITEMS) { const P0Item In = p0_item(F, A, (it_) + 2 * F.G); p0_load(In, tid, VCUR); } \
        LDS_BARRIER(); \
        p0_emit(I, lds, wave, i, g); \
        LDS_BARRIER(); } while (0)
#pragma unroll 1
    for (int it = F.bid; it < NITEMS; it += 2 * F.G) {
        P0_STEP(va, it);
        if (it + F.G < NITEMS) P0_STEP(vb, it + F.G);
    }
#undef P0_STEP
    { v4u z = {0u, 0u, 0u, 0u}; v4u* p = (v4u*)(((bf16*)(F.ws + WS_WIN)) + (size_t)PW * D); const int n16 = (PWP - PW) * D * 2 / 16;
      for (int i = F.bid * NTHREADS + F.tid; i < n16; i += F.G * NTHREADS) p[i] = z; }
    __syncthreads();
    LAS float* sl = (LAS float*)F.lds;
    LAS float* red = (LAS float*)(F.lds + 1024 * 20 * 4);
    bool filled = false;
    for (int it = F.bid; it < 6144 / 64; it += F.G) {
        if (!filled) {
            for (int i = F.tid; i < 17 * 1024; i += NTHREADS) { const int m = i >> 10, k = i & 1023; const float v = (m < 16) ? A->in[1][m * 1024 + k] : A->in[3][k]; sl[k * 20 + m] = v * __builtin_amdgcn_rcpf(1.0f + fexp(-v)); }
            filled = true; __syncthreads();
        }
        float a[17];
#pragma unroll
        for (int m = 0; m < 17; ++m) a[m] = 0.f;
        const int j = it * 64 + F.lane;
#pragma unroll 1
        for (int kb = 0; kb < 128; kb += 16) { float wv[16];
#pragma unroll
          for (int q = 0; q < 16; ++q) wv[q] = A->in[4][(size_t)(F.wave * 128 + kb + q) * 6144 + j];
#pragma unroll
          for (int q = 0; q < 16; ++q) { const int k = F.wave * 128 + kb + q; const float w = wv[q];
            const LAS float* sp = sl + k * 20;
            const f32x4 s0 = *(const LAS f32x4*)sp, s1 = *(const LAS f32x4*)(sp + 4), s2 = *(const LAS f32x4*)(sp + 8), s3 = *(const LAS f32x4*)(sp + 12); const float s4 = sp[16];
            a[0] += s0[0] * w; a[1] += s0[1] * w; a[2] += s0[2] * w; a[3] += s0[3] * w; a[4] += s1[0] * w; a[5] += s1[1] * w; a[6] += s1[2] * w; a[7] += s1[3] * w;
            a[8] += s2[0] * w; a[9] += s2[1] * w; a[10] += s2[2] * w; a[11] += s2[3] * w; a[12] += s3[0] * w; a[13] += s3[1] * w; a[14] += s3[2] * w; a[15] += s3[3] * w; a[16] += s4 * w; } }
#pragma unroll
        for (int m = 0; m < 17; ++m) red[(F.wave * 17 + m) * 64 + F.lane] = a[m];
        __syncthreads();
        for (int i = F.tid; i < 17 * 64; i += NTHREADS) { const int m = i >> 6, l = i & 63; float s = 0.f;
#pragma unroll
            for (int w = 0; w < 8; ++w) s += red[(w * 17 + m) * 64 + l];
            ((float*)(F.ws + WS_MOD))[(size_t)m * 6144 + it * 64 + l] = s + A->in[5][it * 64 + l]; }
        __syncthreads();
    }
}

__device__ __forceinline__ void p1_phase(const Frame& F, CArgs* A) {
    const int gw = F.bid * NWAVES + F.wave, NGW = F.G * NWAVES;
    for (int r0 = gw; r0 < NROWS; r0 += 2 * NGW) {
        const int r1 = r0 + NGW; const bool two = r1 < NROWS;
        const float* xa = (r0 < NLAT) ? A->in[0] + (size_t)r0 * D : A->in[2] + (size_t)(r0 - NLAT) * D;
        const float* xb = !two ? xa : ((r1 < NLAT) ? A->in[0] + (size_t)r1 * D : A->in[2] + (size_t)(r1 - NLAT) * D);
        f32x4 va[4], vb[4];
#pragma unroll
        for (int j = 0; j < 4; ++j) { va[j] = ((const f32x4*)xa)[F.lane + 64 * j]; vb[j] = ((const f32x4*)xb)[F.lane + 64 * j]; }
#pragma unroll
        for (int which = 0; which < 2; ++which) { if (which == 1 && !two) break;
            const int r = which ? r1 : r0; const int mrow = (r < NLAT) ? (r >> 12) : 16;
            const float* sh = ((float*)(F.ws + WS_MOD)) + (size_t)mrow * 6144; const float* sc = sh + 1024;
            float s = 0.f;
#pragma unroll
            for (int j = 0; j < 4; ++j) { const f32x4 v = which ? vb[j] : va[j]; s += (v.x * v.x + v.y * v.y) + (v.z * v.z + v.w * v.w); }
            const float rstd = 1.0f / sqrtf(wave_sum(s) * (1.f / D) + EPS);
            unsigned long long* o8 = (unsigned long long*)(((bf16*)(F.ws + WS_HN)) + (size_t)r * D) + F.lane;
#pragma unroll
            for (int j = 0; j < 4; ++j) { const int c4 = F.lane + 64 * j; const f32x4 v = which ? vb[j] : va[j]; const f32x4 w = ((const f32x4*)A->in[6])[c4], a = ((const f32x4*)sc)[c4], b = ((const f32x4*)sh)[c4];
                const f32x4 y = (v * rstd) * w * (a + 1.0f) + b;
                o8[64 * j] = (unsigned long long)pk2(y.x, y.y) | ((unsigned long long)pk2(y.z, y.w) << 32); } }
    }
}

constexpr int GL_ZL = 0;
constexpr int GL_BC = 8192;
constexpr int GL_TOT = GL_BC + 32768;
constexpr int GL_V = GL_TOT + 512;
constexpr int GL_A = GL_V + 64 * 136 * 2;
constexpr int GL_B = GL_A + 2 * 64 * 72 * 2;
constexpr int GL_P = GL_B + 2 * 64 * 72 * 2;
constexpr int GL_SS = GL_P + 64 * 72 * 2;
constexpr int GL_SEG = GL_SS + 512;
constexpr int GL_END = GL_SEG + 2048;
static_assert(GL_END <= RING_BYTES && (GL_V % 16) == 0 && (GL_A % 16) == 0 && (GL_B % 16) == 0 && (GL_P % 16) == 0, "GLA LDS map");

__device__ __forceinline__ s16x4 tr_read(unsigned lds_addr) { s16x4 r; asm volatile("ds_read_b64_tr_b16 %0, %1\n\ts_waitcnt lgkmcnt(0)" : "=&v"(r) : "v"(lds_addr) : "memory"); return r; }
__device__ __forceinline__ void v_frag2(LAS unsigned char* lds, int v0, int lane, bf16x8& f0, bf16x8& f1) {
    const int i = lane & 15, g = lane >> 4;
    const unsigned a0 = (unsigned)(uintptr_t)(lds + GL_V) + (unsigned)(((8 * g + (i >> 2)) * 136 + v0 + 4 * (i & 3)) * 2);
    s16x4 r0, r1, r2, r3;
    asm volatile("ds_read_b64_tr_b16 %0, %4\n\tds_read_b64_tr_b16 %1, %4 offset:1088\n\tds_read_b64_tr_b16 %2, %4 offset:8704\n\tds_read_b64_tr_b16 %3, %4 offset:9792\n\ts_waitcnt lgkmcnt(0)"
                 : "=&v"(r0), "=&v"(r1), "=&v"(r2), "=&v"(r3) : "v"(a0) : "memory");
    f0[0] = r0[0]; f0[1] = r0[1]; f0[2] = r0[2]; f0[3] = r0[3]; f0[4] = r1[0]; f0[5] = r1[1]; f0[6] = r1[2]; f0[7] = r1[3];
    f1[0] = r2[0]; f1[1] = r2[1]; f1[2] = r2[2]; f1[3] = r2[3]; f1[4] = r3[0]; f1[5] = r3[1]; f1[6] = r3[2]; f1[7] = r3[3];
}
__device__ __forceinline__ bf16x8 v_frag(LAS unsigned char* lds, int ks, int v0, int lane) {
    const int i = lane & 15, g = lane >> 4;
    const unsigned a0 = (unsigned)(uintptr_t)(lds + GL_V) + (unsigned)(((32 * ks + 8 * g + (i >> 2)) * 136 + v0 + 4 * (i & 3)) * 2);
    const s16x4 lo = tr_read(a0), hi = tr_read(a0 + 4 * 136 * 2);
    bf16x8 r; r[0] = lo[0]; r[1] = lo[1]; r[2] = lo[2]; r[3] = lo[3]; r[4] = hi[0]; r[5] = hi[1]; r[6] = hi[2]; r[7] = hi[3]; return r;
}
struct GlaRegs { v4u zw, vw[2]; };
__device__ __forceinline__ GlaRegs gla_load(const Frame& F, size_t prow, int h) {
    GlaRegs r; const int tid = F.tid; const bf16* P = (const bf16*)(F.ws + WS_P);
    { const int t = (tid & 255) >> 2, q = tid & 3; r.zw = *(const v4u*)(P + (prow + t) * PW + CAF + 8 * q); }
#pragma unroll
    for (int i = 0; i < 2; ++i) { const int pc = tid + i * NTHREADS, t = pc >> 4, c = pc & 15; r.vw[i] = *(const v4u*)(P + (prow + t) * PW + CV + h * 128 + c * 8); }
    return r;
}
__device__ __forceinline__ void gla_prep(const Frame& F, CArgs* A, const GlaRegs& R, int h) {
    LAS unsigned char* lds = F.lds; const int tid = F.tid;
    if (tid < 256) { const int t = tid >> 2, q = tid & 3; const v4u w = R.zw;
        LAS float* z = (LAS float*)(lds + GL_ZL) + (q >> 1) * 1024 + t * 16 + (q & 1) * 8;
        *(LAS f32x4*)z = (f32x4){bflo(w.x), bfhi(w.x), bflo(w.y), bfhi(w.y)}; *(LAS f32x4*)(z + 4) = (f32x4){bflo(w.z), bfhi(w.z), bflo(w.w), bfhi(w.w)}; }
#pragma unroll
    for (int i = 0; i < 2; ++i) { const int pc = tid + i * NTHREADS, t = pc >> 4, c = pc & 15; *(LAS v4u*)(lds + GL_V + (t * 136 + c * 8) * 2) = R.vw[i]; }
    __syncthreads();
    { const int dir = tid >> 8, seg = (tid >> 6) & 3, d = tid & 63;
      const float* up = dir ? A->in[10] : A->in[8]; const float bias = (dir ? A->in[11] : A->in[9])[h * 64 + d];
      float u[16];
#pragma unroll
      for (int r = 0; r < 16; ++r) u[r] = up[r * 256 + h * 64 + d];
      const LAS float* zl = (const LAS float*)(lds + GL_ZL) + dir * 1024; LAS float* bc = (LAS float*)(lds + GL_BC) + dir * 4096 + d;
      LAS float* sg = (LAS float*)(lds + GL_SEG) + dir * 256 + d;
      float c[16]; float cum = 0.f;
#pragma unroll
      for (int i = 0; i < 16; ++i) { const int t = seg * 16 + (dir ? 15 - i : i); const LAS float* zp = zl + t * 16;
          const f32x4 z0 = *(const LAS f32x4*)zp, z1 = *(const LAS f32x4*)(zp + 4), z2 = *(const LAS f32x4*)(zp + 8), z3 = *(const LAS f32x4*)(zp + 12);
          float z = bias + z0[0] * u[0] + z0[1] * u[1] + z0[2] * u[2] + z0[3] * u[3] + z1[0] * u[4] + z1[1] * u[5] + z1[2] * u[6] + z1[3] * u[7]
                         + z2[0] * u[8] + z2[1] * u[9] + z2[2] * u[10] + z2[3] * u[11] + z3[0] * u[12] + z3[1] * u[13] + z3[2] * u[14] + z3[3] * u[15];
          const float ls = fminf(z, 0.f) - __logf(1.0f + __expf(-fabsf(z)));
          cum += ls * (1.0f / 16.0f); c[i] = cum; }
      sg[seg * 64] = cum;
      __syncthreads();
      float off = 0.f, tot = 0.f;
#pragma unroll
      for (int s2 = 0; s2 < 4; ++s2) { const float v = sg[s2 * 64]; tot += v; off += (dir ? (s2 > seg) : (s2 < seg)) ? v : 0.f; }
#pragma unroll
      for (int i = 0; i < 16; ++i) { const int t = seg * 16 + (dir ? 15 - i : i); bc[t * 64] = off + c[i]; }
      if (seg == 0) ((LAS float*)(lds + GL_TOT))[dir * 64 + d] = tot; }
    __syncthreads();
}

__device__ __forceinline__ size_t chunk_row(int b, int cc) { return cc < 4 ? (size_t)NLAT + b * CTXL + cc * 64 : (size_t)b * SEQ + (cc - 4) * 64; }
__device__ __forceinline__ void p3_phase(const Frame& F, CArgs* A) {
    LAS unsigned char* lds = F.lds; const int tid = F.tid, lane = F.lane, wave = F.wave;
    GlaRegs cur; if (F.bid < NBATCH * NCC * 4) { const int bc0 = F.bid >> 2; cur = gla_load(F, chunk_row(bc0 / NCC, bc0 % NCC), F.bid & 3); }
    for (int it = F.bid; it < NBATCH * NCC * 4; it += F.G) {
        const int h = it & 3, bc = it >> 2, b = bc / NCC, cc = bc % NCC; const size_t prow = chunk_row(b, cc);
        GlaRegs nxt = cur; { const int itn = it + F.G; if (itn < NBATCH * NCC * 4) { const int bcn = itn >> 2; nxt = gla_load(F, chunk_row(bcn / NCC, bcn % NCC), itn & 3); } }
        float kf[8];
        { const int d = tid & 63, tg = tid >> 6;
#pragma unroll
          for (int j = 0; j < 8; ++j) kf[j] = bf2f(((bf16*)(F.ws + WS_P))[(prow + tg * 8 + j) * PW + CK + h * 64 + d]); }
        gla_prep(F, A, cur, h); cur = nxt;
        if (tid < 128) { const int dir = tid >> 6, d = tid & 63; ((float*)(F.ws + WS_DECAY))[(((size_t)dir * NBATCH + b) * NCC + cc) * 256 + h * 64 + d] = __expf(((const LAS float*)(lds + GL_TOT))[dir * 64 + d]); }
        { const int d = tid & 63, tg = tid >> 6;
#pragma unroll
          for (int dir = 0; dir < 2; ++dir) { const float tot = ((const LAS float*)(lds + GL_TOT))[dir * 64 + d]; const LAS float* bcp = (const LAS float*)(lds + GL_BC) + dir * 4096 + (tg * 8) * 64 + d; float s[8];
#pragma unroll
              for (int j = 0; j < 8; ++j) s[j] = kf[j] * __expf(tot - bcp[j * 64]);
              v4u w; w.x = pk2(s[0], s[1]); w.y = pk2(s[2], s[3]); w.z = pk2(s[4], s[5]); w.w = pk2(s[6], s[7]);
              *(LAS v4u*)(lds + GL_A + ((dir * 64 + d) * 72 + tg * 8) * 2) = w; } }
        __syncthreads();
        { const int dir = wave & 1, dt = wave >> 1, i = lane & 15, g = lane >> 4;
          bf16x8 af[2];
#pragma unroll
          for (int ks = 0; ks < 2; ++ks) af[ks] = *(const LAS bf16x8*)(lds + GL_A + ((dir * 64 + dt * 16 + i) * 72 + 32 * ks + 8 * g) * 2);
          bf16* kvp = ((bf16*)(F.ws + WS_KV)) + ((((size_t)dir * NBATCH + b) * NCC + cc) * 4 + h) * 8192;
#pragma unroll 2
          for (int vt = 0; vt < 8; ++vt) { f32x4 acc = {0.f, 0.f, 0.f, 0.f}; bf16x8 vf0, vf1; v_frag2(lds, vt * 16, lane, vf0, vf1);
              acc = __builtin_amdgcn_mfma_f32_16x16x32_bf16(af[0], vf0, acc, 0, 0, 0); acc = __builtin_amdgcn_mfma_f32_16x16x32_bf16(af[1], vf1, acc, 0, 0, 0);
              v2u w; w.x = pk2(acc[0], acc[1]); w.y = pk2(acc[2], acc[3]);
              *(v2u*)(kvp + (size_t)(vt * 16 + i) * 64 + dt * 16 + 4 * g) = w; } }
        __syncthreads();
    }
}

constexpr int G2_ZL = 0;
constexpr int G2_HT = 8192;
constexpr int G2_TOT = G2_HT + 4096;
constexpr int G2_A = G2_TOT + 1024;
constexpr int G2_B = G2_A + 256 * 72 * 2;
constexpr int G2_VS = 528;
static_assert(G2_B + 64 * G2_VS * 2 <= RING_BYTES && G2_B + 256 * 72 * 2 <= RING_BYTES && (G2_A % 16) == 0 && (G2_B % 16) == 0, "GLA v2 LDS map");
__device__ __forceinline__ void tr_frag2(unsigned tile_addr, int c0, int lane, bf16x8& f0, bf16x8& f1) {
    const int i = lane & 15, g = lane >> 4;
    const unsigned a0 = tile_addr + (unsigned)(((8 * g + (i >> 2)) * G2_VS + c0 + 4 * (i & 3)) * 2);
    s16x4 r0, r1, r2, r3;
    asm volatile("ds_read_b64_tr_b16 %0, %4\n\tds_read_b64_tr_b16 %1, %4 offset:4224\n\tds_read_b64_tr_b16 %2, %4 offset:33792\n\tds_read_b64_tr_b16 %3, %4 offset:38016\n\ts_waitcnt lgkmcnt(0)"
                 : "=&v"(r0), "=&v"(r1), "=&v"(r2), "=&v"(r3) : "v"(a0) : "memory");
    f0[0] = r0[0]; f0[1] = r0[1]; f0[2] = r0[2]; f0[3] = r0[3]; f0[4] = r1[0]; f0[5] = r1[1]; f0[6] = r1[2]; f0[7] = r1[3];
    f1[0] = r2[0]; f1[1] = r2[1]; f1[2] = r2[2]; f1[3] = r2[3]; f1[4] = r3[0]; f1[5] = r3[1]; f1[6] = r3[2]; f1[7] = r3[3];
}
static_assert(4 * G2_VS * 2 == 4224 && 32 * G2_VS * 2 == 33792 && 36 * G2_VS * 2 == 38016, "tr_frag2 offsets");
__device__ __forceinline__ float log_sigmoid16(float z) { return (fminf(z, 0.f) - __logf(1.0f + __expf(-fabsf(z)))) * (1.0f / 16.0f); }

__device__ __forceinline__ void p3v2_phase(const Frame& F, CArgs* A) {
    LAS unsigned char* lds = F.lds; const int tid = F.tid, lane = F.lane, wave = F.wave, i = lane & 15, g = lane >> 4;
    const int c = tid & 255, th = tid >> 8;
    const bf16* P = (const bf16*)(F.ws + WS_P);
#pragma unroll 1
    for (int it = F.bid; it < NBATCH * NCC; it += F.G) {
        const int b = it / NCC, cc = it % NCC; const size_t prow = chunk_row(b, cc);
        if (tid < 256) { const int t = tid >> 2, q = tid & 3; const v4u w = *(const v4u*)(P + (prow + t) * PW + CAF + 8 * q);
            LAS float* z = (LAS float*)(lds + G2_ZL) + (q >> 1) * 1024 + t * 16 + (q & 1) * 8;
            *(LAS f32x4*)z = (f32x4){bflo(w.x), bfhi(w.x), bflo(w.y), bfhi(w.y)}; *(LAS f32x4*)(z + 4) = (f32x4){bflo(w.z), bfhi(w.z), bflo(w.w), bfhi(w.w)}; }
#pragma unroll
        for (int j = 0; j < 8; ++j) { const int pc = tid + j * NTHREADS, t = pc >> 6, cv = pc & 63;
            *(LAS v4u*)(lds + G2_B + (t * G2_VS + cv * 8) * 2) = *(const v4u*)(P + (prow + t) * PW + CV + cv * 8); }
        float kk[32];
#pragma unroll
        for (int tl = 0; tl < 32; ++tl) kk[tl] = bf2f(P[(prow + th * 32 + tl) * PW + CK + c]);
        __syncthreads();
#pragma unroll
        for (int dir = 0; dir < 2; ++dir) {
            { const float* up = dir ? A->in[10] : A->in[8]; const float bias = (dir ? A->in[11] : A->in[9])[c];
              float u[16];
#pragma unroll
              for (int r = 0; r < 16; ++r) u[r] = up[r * 256 + c];
              const LAS float* zl = (const LAS float*)(lds + G2_ZL) + dir * 1024 + th * 512;
              float cl[32]; float cum = 0.f;
#pragma unroll
              for (int ii = 0; ii < 32; ++ii) { const int tl = dir ? 31 - ii : ii; const LAS float* zp = zl + tl * 16;
                  const f32x4 z0 = *(const LAS f32x4*)zp, z1 = *(const LAS f32x4*)(zp + 4), z2 = *(const LAS f32x4*)(zp + 8), z3 = *(const LAS f32x4*)(zp + 12);
                  const float z = bias + z0[0] * u[0] + z0[1] * u[1] + z0[2] * u[2] + z0[3] * u[3] + z1[0] * u[4] + z1[1] * u[5] + z1[2] * u[6] + z1[3] * u[7]
                                       + z2[0] * u[8] + z2[1] * u[9] + z2[2] * u[10] + z2[3] * u[11] + z3[0] * u[12] + z3[1] * u[13] + z3[2] * u[14] + z3[3] * u[15];
                  cum += log_sigmoid16(z); cl[tl] = cum; }
              LAS float* ht = (LAS float*)(lds + G2_HT) + dir * 512;
              ht[th * 256 + c] = cum;
              __syncthreads();
              const float other = ht[(1 - th) * 256 + c], tot = cum + other;
              const float off = (dir == 0) ? (th ? other : 0.f) : (th ? 0.f : other);
              if (th == 0) { ((LAS float*)(lds + G2_TOT))[c] = tot; ((float*)(F.ws + WS_DECAY))[(((size_t)dir * NBATCH + b) * NCC + cc) * 256 + c] = __expf(tot); }
#pragma unroll
              for (int j = 0; j < 4; ++j) { float e[8];
#pragma unroll
                  for (int q = 0; q < 8; ++q) e[q] = kk[8 * j + q] * __expf(-(off + cl[8 * j + q]));
                  v4u w; w.x = pk2(e[0], e[1]); w.y = pk2(e[2], e[3]); w.z = pk2(e[4], e[5]); w.w = pk2(e[6], e[7]);
                  *(LAS v4u*)(lds + G2_A + (c * 72 + th * 32 + 8 * j) * 2) = w; } }
            __syncthreads();
            { const int h = wave >> 1, vh = wave & 1;
              bf16x8 af[4][2];
#pragma unroll
              for (int dt = 0; dt < 4; ++dt)
#pragma unroll
                  for (int ks = 0; ks < 2; ++ks) af[dt][ks] = *(const LAS bf16x8*)(lds + G2_A + ((h * 64 + dt * 16 + i) * 72 + 32 * ks + 8 * g) * 2);
              f32x4 et[4];
#pragma unroll
              for (int dt = 0; dt < 4; ++dt) { const f32x4 tv = *(const LAS f32x4*)(lds + G2_TOT + (h * 64 + dt * 16 + 4 * g) * 4); et[dt] = (f32x4){__expf(tv[0]), __expf(tv[1]), __expf(tv[2]), __expf(tv[3])}; }
              bf16* kvp = ((bf16*)(F.ws + WS_KV)) + ((((size_t)dir * NBATCH + b) * NCC + cc) * 4 + h) * 8192;
              bf16* vtp = ((bf16*)(F.ws + WS_VT)) + (((size_t)b * 64 + (cc - 4)) * 4 + h) * 8192;
#pragma unroll
              for (int vt = 0; vt < 4; ++vt) { const int v0 = vh * 64 + vt * 16; bf16x8 vf0, vf1; tr_frag2((unsigned)(uintptr_t)(lds + G2_B), h * 128 + v0, lane, vf0, vf1);
                  if (dir == 0 && cc >= 4) { *(bf16x8*)(vtp + (size_t)(v0 + i) * 64 + 8 * g) = vf0; *(bf16x8*)(vtp + (size_t)(v0 + i) * 64 + 32 + 8 * g) = vf1; }
#pragma unroll
                  for (int dt = 0; dt < 4; ++dt) { f32x4 acc = {0.f, 0.f, 0.f, 0.f};
                      acc = __builtin_amdgcn_mfma_f32_16x16x32_bf16(af[dt][0], vf0, acc, 0, 0, 0); acc = __builtin_amdgcn_mfma_f32_16x16x32_bf16(af[dt][1], vf1, acc, 0, 0, 0);
                      acc = acc * et[dt];
                      v2u w; w.x = pk2(acc[0], acc[1]); w.y = pk2(acc[2], acc[3]);
                      *(v2u*)(kvp + (size_t)(v0 + i) * 64 + dt * 16 + 4 * g) = w; } } }
            __syncthreads();
        }
    }
}

struct GateConst { bf16x8 bw[2][2]; float bias[2][2]; };
__device__ __forceinline__ GateConst gate_setup(CArgs* A, int wave, int lane) {
    GateConst G; const int i = lane & 15, g = lane >> 4;
#pragma unroll
    for (int dir = 0; dir < 2; ++dir)
#pragma unroll
        for (int cti = 0; cti < 2; ++cti) { const int c = 32 * wave + 16 * cti + i; const float* up = dir ? A->in[10] : A->in[8];
            G.bias[dir][cti] = (dir ? A->in[11] : A->in[9])[c];
#pragma unroll
            for (int jj = 0; jj < 8; ++jj) { const float v = up[(8 * (g & 1) + jj) * 256 + c]; const unsigned hi = f2bf(v); const float rem = v - __builtin_bit_cast(float, hi << 16);
                G.bw[dir][cti][jj] = (short)((g < 2) ? hi : f2bf(rem)); } }
    return G;
}
__device__ __forceinline__ float log_sigmoid16_fast(float z) { const float e = __builtin_amdgcn_exp2f(fabsf(z) * -1.4426950409f); return (fminf(z, 0.f) - __builtin_amdgcn_logf(1.0f + e) * 0.6931471806f) * 0.0625f; }
__device__ __forceinline__ void gate_b(const GateConst& G, const bf16* P, size_t prow, int lane, f32x4 (&bv)[2][2][4], float (&tot)[2][2]) {
    const int i = lane & 15, g = lane >> 4;
    bf16x8 za[2][4];
#pragma unroll
    for (int dir = 0; dir < 2; ++dir)
#pragma unroll
        for (int tt = 0; tt < 4; ++tt) za[dir][tt] = *(const bf16x8*)(P + (prow + 16 * tt + i) * PW + CAF + 16 * dir + 8 * (g & 1));
#pragma unroll
    for (int dir = 0; dir < 2; ++dir)
#pragma unroll
        for (int cti = 0; cti < 2; ++cti) { float carry = 0.f;
#pragma unroll
            for (int q = 0; q < 4; ++q) { const int tt = dir ? 3 - q : q;
                f32x4 z = {0.f, 0.f, 0.f, 0.f}; z = __builtin_amdgcn_mfma_f32_16x16x32_bf16(za[dir][tt], G.bw[dir][cti], z, 0, 0, 0);
                float la[4];
#pragma unroll
                for (int r = 0; r < 4; ++r) la[r] = log_sigmoid16_fast(z[r] + G.bias[dir][cti]);
                float p[4];
                if (dir == 0) { p[0] = la[0]; p[1] = p[0] + la[1]; p[2] = p[1] + la[2]; p[3] = p[2] + la[3];
                    const float s = p[3]; float incl = s; const float t1 = __shfl_up(incl, 16); if (g >= 1) incl += t1; const float t2 = __shfl_up(incl, 32); if (g >= 2) incl += t2;
                    const float base = carry + (incl - s); carry += __shfl(incl, 48 + i);
                    bv[dir][cti][tt] = (f32x4){base + p[0], base + p[1], base + p[2], base + p[3]}; }
                else { p[3] = la[3]; p[2] = p[3] + la[2]; p[1] = p[2] + la[1]; p[0] = p[1] + la[0];
                    const float s = p[0]; float incl = s; const float t1 = __shfl_down(incl, 16); if (g <= 2) incl += t1; const float t2 = __shfl_down(incl, 32); if (g <= 1) incl += t2;
                    const float base = carry + (incl - s); carry += __shfl(incl, i);
                    bv[dir][cti][tt] = (f32x4){base + p[0], base + p[1], base + p[2], base + p[3]}; } }
            tot[dir][cti] = carry; }
}

constexpr int G3_ST = 0;
constexpr int G3_TOT = 8 * 16 * 144;
constexpr int G3_A = G3_TOT + 1024;
constexpr int G3_B = G3_A + 256 * 72 * 2;
static_assert(G3_B + 64 * G2_VS * 2 <= RING_BYTES && (G3_A % 16) == 0 && (G3_B % 16) == 0, "P3 LDS map");
template <int MODE>
__device__ __forceinline__ void p3v3_phase(const Frame& F, CArgs* A) {
    int tid_ = F.tid; asm volatile("" : "+v"(tid_));
    LAS unsigned char* lds = F.lds; const int tid = tid_, lane = tid & 63, wave = __builtin_amdgcn_readfirstlane(tid >> 6), i = lane & 15, g = lane >> 4;
    const bf16* P = (const bf16*)(F.ws + WS_P);
    const GateConst G = gate_setup(A, wave, lane);
    LAS unsigned char* st = lds + G3_ST + wave * (16 * 144);
#pragma unroll 1
    for (int it = F.bid; it < NBATCH * NCC; it += F.G) {
        const int b = it / NCC, cc = it % NCC; const size_t prow = chunk_row(b, cc);
        unsigned pf0 = 0u, pf1 = 0u;
#pragma unroll
        for (int j = 0; j < 8; ++j) { const int pc = tid + j * NTHREADS, t = pc >> 6, cv = pc & 63;
            *(LAS v4u*)(lds + G3_B + (t * G2_VS + cv * 8) * 2) = *(const v4u*)(P + (prow + t) * PW + CV + cv * 8); }
        unsigned kk[2][4][2];
#pragma unroll
        for (int cti = 0; cti < 2; ++cti)
#pragma unroll
            for (int tt = 0; tt < 4; ++tt)
#pragma unroll
                for (int r = 0; r < 4; r += 2) { const bf16* kp = P + (prow + 16 * tt + 4 * g + r) * PW + CK + 32 * wave + 16 * cti + i; kk[cti][tt][r >> 1] = (unsigned)kp[0] | ((unsigned)kp[PW] << 16); }
        f32x4 bv[2][2][4]; float tot[2][2];
        if (MODE < 4) gate_b(G, P, prow, lane, bv, tot); else {
#pragma unroll
            for (int a_ = 0; a_ < 2; ++a_)
#pragma unroll
                for (int b_ = 0; b_ < 2; ++b_) { tot[a_][b_] = 0.f;
#pragma unroll
                    for (int c_ = 0; c_ < 4; ++c_) bv[a_][b_][c_] = (f32x4){0.f, 0.f, 0.f, 0.f}; } }
#pragma unroll
        for (int dir = 0; dir < 2; ++dir) {
#pragma unroll
            for (int cti = 0; cti < 2; ++cti) { const int c = 32 * wave + 16 * cti + i;
#pragma unroll
                for (int tt = 0; tt < 4; ++tt) { float e[4];
#pragma unroll
                    for (int r = 0; r < 4; ++r) e[r] = ((r & 1) ? bfhi(kk[cti][tt][r >> 1]) : bflo(kk[cti][tt][r >> 1])) * __builtin_amdgcn_exp2f(bv[dir][cti][tt][r] * -1.4426950409f);
                    v2u w; w.x = pk2(e[0], e[1]); w.y = pk2(e[2], e[3]);
                    *(LAS v2u*)(lds + G3_A + (c * 72 + 16 * tt + 4 * g) * 2) = w; }
                if (g == 0) { ((LAS float*)(lds + G3_TOT))[c] = tot[dir][cti]; if (!MODE) ((float*)(F.ws + WS_DECAY))[(((size_t)dir * NBATCH + b) * NCC + cc) * 256 + c] = __expf(tot[dir][cti]); } }
            LDS_BARRIER();
            if (dir == 0) {
                const int itn = it + F.G; if (itn < NBATCH * NCC) { const char* pr = (const char*)(P + (chunk_row(itn / NCC, itn % NCC) + (tid >> 3)) * PW); const int j = tid & 7;
                    pf0 = *(const unsigned*)(pr + 512 + 128 * j); pf1 = *(const unsigned*)(pr + (j < 5 ? 512 + 128 * (8 + j) : 3072 + 32 * (j - 5))); } }
            if (MODE < 3) { const int h = wave >> 1, vh = wave & 1;
              bf16x8 af[4][2];
#pragma unroll
              for (int dt = 0; dt < 4; ++dt)
#pragma unroll
                  for (int ks = 0; ks < 2; ++ks) af[dt][ks] = *(const LAS bf16x8*)(lds + G3_A + ((h * 64 + dt * 16 + i) * 72 + 32 * ks + 8 * g) * 2);
              bf16* kvp = ((bf16*)(F.ws + WS_KV)) + ((((size_t)dir * NBATCH + b) * NCC + cc) * 4 + h) * 8192;
              bf16* vtp = ((bf16*)(F.ws + WS_VT)) + (((size_t)b * 64 + (cc - 4)) * 4 + h) * 8192;
              if (MODE) { kvp = ((bf16*)(F.ws + WS_TOTAL)) + (size_t)(F.bid * 8 + wave) * 512; vtp = kvp + 1024 * 1024; }
#pragma unroll
              for (int vt = 0; vt < 4; ++vt) { const int v0 = vh * 64 + vt * 16; bf16x8 vf0, vf1; tr_frag2((unsigned)(uintptr_t)(lds + G3_B), h * 128 + v0, lane, vf0, vf1);
                  if (dir == 0 && cc >= 4) {
                      *(LAS bf16x8*)(st + i * 144 + 16 * g) = vf0; *(LAS bf16x8*)(st + i * 144 + 64 + 16 * g) = vf1;
                      LDS_WAIT();
#pragma unroll
                      for (int j = 0; j < 2; ++j) { const int pc = lane + 64 * j, row = pc >> 3, ch = pc & 7; const v4u x_ = *(const LAS v4u*)(st + row * 144 + ch * 16); if (MODE == 2) asm volatile("" :: "v"(x_)); else *(v4u*)(vtp + (size_t)((MODE ? 0 : v0) + row) * 64 + ch * 8) = x_; }
                      LDS_WAIT(); }
#pragma unroll
                  for (int dt = 0; dt < 4; ++dt) { f32x4 acc = {0.f, 0.f, 0.f, 0.f};
                      acc = __builtin_amdgcn_mfma_f32_16x16x32_bf16(af[dt][0], vf0, acc, 0, 0, 0); acc = __builtin_amdgcn_mfma_f32_16x16x32_bf16(af[dt][1], vf1, acc, 0, 0, 0);
                      { const f32x4 tv = *(const LAS f32x4*)(lds + G3_TOT + (h * 64 + dt * 16 + 4 * g) * 4);
                        acc = acc * (f32x4){__builtin_amdgcn_exp2f(tv[0] * 1.4426950409f), __builtin_amdgcn_exp2f(tv[1] * 1.4426950409f), __builtin_amdgcn_exp2f(tv[2] * 1.4426950409f), __builtin_amdgcn_exp2f(tv[3] * 1.4426950409f)}; }
                      v2u w; w.x = pk2(acc[0], acc[1]); w.y = pk2(acc[2], acc[3]);
                      *(LAS v2u*)(st + i * 144 + (16 * dt + 4 * g) * 2) = w; }
                  LDS_WAIT();
#pragma unroll
                  for (int j = 0; j < 2; ++j) { const int pc = lane + 64 * j, row = pc >> 3, ch = pc & 7; const v4u x_ = *(const LAS v4u*)(st + row * 144 + ch * 16); if (MODE == 2) asm volatile("" :: "v"(x_)); else *(v4u*)(kvp + (size_t)((MODE ? 0 : v0) + row) * 64 + ch * 8) = x_; }
                  LDS_WAIT(); } }
            LDS_BARRIER();
        }
        asm volatile("" :: "v"(pf0), "v"(pf1));
    }
}

__device__ __forceinline__ void gate_b_dir(const GateConst& G, const bf16* P, size_t prow, int lane, int dir, f32x4 (&bv)[2][4]) {
    const int i = lane & 15, g = lane >> 4;
    bf16x8 za[4];
#pragma unroll
    for (int tt = 0; tt < 4; ++tt) za[tt] = *(const bf16x8*)(P + (prow + 16 * tt + i) * PW + CAF + 16 * dir + 8 * (g & 1));
#pragma unroll
    for (int cti = 0; cti < 2; ++cti) { float carry = 0.f;
#pragma unroll
        for (int q = 0; q < 4; ++q) { const int tt = dir ? 3 - q : q;
            f32x4 z = {0.f, 0.f, 0.f, 0.f}; z = __builtin_amdgcn_mfma_f32_16x16x32_bf16(za[tt], G.bw[dir][cti], z, 0, 0, 0);
            float la[4];
#pragma unroll
            for (int r = 0; r < 4; ++r) la[r] = log_sigmoid16_fast(z[r] + G.bias[dir][cti]);
            float p[4];
            if (dir == 0) { p[0] = la[0]; p[1] = p[0] + la[1]; p[2] = p[1] + la[2]; p[3] = p[2] + la[3];
                const float s = p[3]; float incl = s; const float t1 = __shfl_up(incl, 16); if (g >= 1) incl += t1; const float t2 = __shfl_up(incl, 32); if (g >= 2) incl += t2;
                const float base = carry + (incl - s); carry += __shfl(incl, 48 + i);
                bv[cti][tt] = (f32x4){base + p[0], base + p[1], base + p[2], base + p[3]}; }
            else { p[3] = la[3]; p[2] = p[3] + la[2]; p[1] = p[2] + la[1]; p[0] = p[1] + la[0];
                const float s = p[0]; float incl = s; const float t1 = __shfl_down(incl, 16); if (g <= 2) incl += t1; const float t2 = __shfl_down(incl, 32); if (g <= 1) incl += t2;
                const float base = carry + (incl - s); carry += __shfl(incl, i);
                bv[cti][tt] = (f32x4){base + p[0], base + p[1], base + p[2], base + p[3]}; } } }
}

constexpr int G5_Q = 0;
constexpr int G5_K = 4 * 64 * 72 * 2;
constexpr int G5_P = 2 * G5_K;
static_assert(G5_P + 4 * 64 * 72 * 2 <= RING_BYTES && 8 * 16 * 272 <= G5_K, "P5 LDS map");
template <int MODE>
__device__ __forceinline__ void p5av3_phase(const Frame& F, CArgs* A) {
    LAS unsigned char* lds = F.lds;
    const bf16* P = (const bf16*)(F.ws + WS_P);
    const GateConst G = gate_setup(A, F.wave, F.lane);
#pragma unroll 1
    for (int it = F.bid; it < NBATCH * 64; it += F.G) {
        int tid_ = F.tid; asm volatile("" : "+v"(tid_));
        const int tid = tid_, lane = tid & 63, wave = __builtin_amdgcn_readfirstlane(tid >> 6), i = lane & 15, g = lane >> 4;
        const int h = wave >> 1, half = wave & 1;
        LAS unsigned char* st = lds + G5_Q + wave * (16 * 272);
        const int b = it >> 6, n = it & 63; const size_t prow = (size_t)b * SEQ + n * 64;
        unsigned pfv[9];
#pragma unroll
        for (int q = 0; q < 9; ++q) pfv[q] = 0u;
        const int dh = 32 * half + i;
        f32x4 pdiag[2], oacc[2][8];
#pragma unroll
        for (int a = 0; a < 2; ++a) { pdiag[a] = (f32x4){0.f, 0.f, 0.f, 0.f};
#pragma unroll
            for (int q = 0; q < 8; ++q) oacc[a][q] = (f32x4){0.f, 0.f, 0.f, 0.f}; }
#pragma unroll
        for (int dir = 0; dir < (MODE >= 4 ? 0 : 2); ++dir) {
            { unsigned qk[2][4][4];
#pragma unroll
              for (int cti = 0; cti < 2; ++cti)
#pragma unroll
                  for (int tt = 0; tt < 4; ++tt)
#pragma unroll
                      for (int r = 0; r < 4; ++r) { const bf16* rp = P + (prow + 16 * tt + 4 * g + r) * PW + h * 64 + dh + 16 * cti; qk[cti][tt][r] = (unsigned)rp[CQ] | ((unsigned)rp[CK] << 16); }
              f32x4 bv[2][4]; gate_b_dir(G, P, prow, lane, dir, bv);
#pragma unroll
              for (int cti = 0; cti < 2; ++cti)
#pragma unroll
                  for (int tt = 0; tt < 4; ++tt)
#pragma unroll
                      for (int r = 0; r < 4; ++r) { const float e = __builtin_amdgcn_exp2f(bv[cti][tt][r] * 1.4426950409f); const unsigned w = qk[cti][tt][r];
                          const int off = ((h * 64 + 16 * tt + 4 * g + r) * 72 + dh + 16 * cti) * 2;
                          *(LAS bf16*)(lds + G5_Q + off) = (bf16)f2bf(bflo(w) * e * 0.125f); *(LAS bf16*)(lds + G5_K + off) = (bf16)f2bf(bfhi(w) * __builtin_amdgcn_rcpf(e)); } }
            LDS_BARRIER();
            if (MODE < 3) { bf16x8 qf[2][2];
#pragma unroll
              for (int tti = 0; tti < 2; ++tti)
#pragma unroll
                  for (int ks = 0; ks < 2; ++ks) qf[tti][ks] = *(const LAS bf16x8*)(lds + G5_Q + ((h * 64 + (2 * half + tti) * 16 + i) * 72 + 32 * ks + 8 * g) * 2);
              const bf16* sp = ((const bf16*)(F.ws + WS_S)) + ((((size_t)dir * NBATCH + b) * 64 + n) * 4 + h) * 8192 + (size_t)i * 64 + 8 * g;
#pragma unroll
              for (int st_ = 0; st_ < 4; ++st_) { const bf16x8 kf0 = *(const LAS bf16x8*)(lds + G5_K + ((h * 64 + st_ * 16 + i) * 72 + 8 * g) * 2), kf1 = *(const LAS bf16x8*)(lds + G5_K + ((h * 64 + st_ * 16 + i) * 72 + 32 + 8 * g) * 2);
#pragma unroll
                  for (int tti = 0; tti < 2; ++tti) { const int tt = 2 * half + tti;
                      if (dir == 0 ? (st_ <= tt) : (st_ >= tt)) { f32x4 a = {0.f, 0.f, 0.f, 0.f};
                          a = __builtin_amdgcn_mfma_f32_16x16x32_bf16(kf0, qf[tti][0], a, 0, 0, 0); a = __builtin_amdgcn_mfma_f32_16x16x32_bf16(kf1, qf[tti][1], a, 0, 0, 0);
                          const int t = tt * 16 + i, s0 = st_ * 16 + 4 * g;
                          if (st_ == tt) {
#pragma unroll
                              for (int r = 0; r < 4; ++r) pdiag[tti][r] += (dir == 0 ? (s0 + r <= t) : (s0 + r >= t)) ? a[r] : 0.f;
                              a = pdiag[tti]; }
                          if (st_ != tt || dir == 1) { v2u w; w.x = pk2(a[0], a[1]); w.y = pk2(a[2], a[3]);
                              *(LAS v2u*)(lds + G5_P + ((h * 64 + t) * 72 + s0) * 2) = w; } } } }
              bf16x8 sfr[4][2];
#pragma unroll
              for (int vt = 0; vt < 4; ++vt) { sfr[vt][0] = *(const bf16x8*)(sp + (size_t)vt * 1024); sfr[vt][1] = *(const bf16x8*)(sp + (size_t)vt * 1024 + 32); }
#pragma unroll
              for (int vt = 0; vt < 8; ++vt) {
#pragma unroll
                  for (int tti = 0; tti < 2; ++tti) { oacc[tti][vt] = __builtin_amdgcn_mfma_f32_16x16x32_bf16(sfr[vt & 3][0], qf[tti][0], oacc[tti][vt], 0, 0, 0); oacc[tti][vt] = __builtin_amdgcn_mfma_f32_16x16x32_bf16(sfr[vt & 3][1], qf[tti][1], oacc[tti][vt], 0, 0, 0); }
                  asm volatile("" : "+v"(oacc[0][vt]), "+v"(oacc[1][vt]) :: "memory");
                  if (vt < 4) { sfr[vt][0] = *(const bf16x8*)(sp + (size_t)(vt + 4) * 1024); sfr[vt][1] = *(const bf16x8*)(sp + (size_t)(vt + 4) * 1024 + 32); } } }
            LDS_BARRIER();
        }
        LDS_WAIT();
        if (MODE < 2) { bf16x8 pfr[2][2];
#pragma unroll
          for (int tti = 0; tti < 2; ++tti)
#pragma unroll
              for (int ks = 0; ks < 2; ++ks) pfr[tti][ks] = *(const LAS bf16x8*)(lds + G5_P + ((h * 64 + (2 * half + tti) * 16 + i) * 72 + 32 * ks + 8 * g) * 2);
          const bf16* vp = ((const bf16*)(F.ws + WS_VT)) + (((size_t)b * 64 + n) * 4 + h) * 8192 + (size_t)i * 64 + 8 * g;
          bf16x8 vfr[8][2];
#pragma unroll
          for (int vt = 0; vt < 8; ++vt) { vfr[vt][0] = *(const bf16x8*)(vp + (size_t)vt * 1024); vfr[vt][1] = *(const bf16x8*)(vp + (size_t)vt * 1024 + 32); }
#pragma unroll
          for (int vt = 0; vt < 8; ++vt)
#pragma unroll
              for (int tti = 0; tti < 2; ++tti) { oacc[tti][vt] = __builtin_amdgcn_mfma_f32_16x16x32_bf16(vfr[vt][0], pfr[tti][0], oacc[tti][vt], 0, 0, 0); oacc[tti][vt] = __builtin_amdgcn_mfma_f32_16x16x32_bf16(vfr[vt][1], pfr[tti][1], oacc[tti][vt], 0, 0, 0); } }
#pragma unroll
        for (int tti = 0; tti < (MODE >= 2 ? 0 : 2); ++tti) { const int t = (2 * half + tti) * 16 + i; float ss = 0.f;
#pragma unroll
            for (int vt = 0; vt < 8; ++vt) { const f32x4 a = oacc[tti][vt]; ss += (a[0] * a[0] + a[1] * a[1]) + (a[2] * a[2] + a[3] * a[3]); }
            ss += __shfl_xor(ss, 16); ss += __shfl_xor(ss, 32);
            const float rstd = 1.0f / sqrtf(ss * (1.0f / 128.0f) + EPS);
#pragma unroll
            for (int vt = 0; vt < 8; ++vt) { const int v = vt * 16 + 4 * g; const f32x4 gw = *(const f32x4*)(A->in[12] + v); const v2u rw = *(const v2u*)(P + (prow + t) * PW + CR + h * 128 + v);
                const float r[4] = {bflo(rw.x), bfhi(rw.x), bflo(rw.y), bfhi(rw.y)}; float y[4];
#pragma unroll
                for (int j = 0; j < 4; ++j) y[j] = oacc[tti][vt][j] * rstd * gw[j] * (r[j] * __builtin_amdgcn_rcpf(1.0f + __builtin_amdgcn_exp2f(r[j] * -1.4426950409f)));
                if (OUTPROJ_F8) *(LAS unsigned*)(st + i * 144 + v) = pk4_fp8(y[0], y[1], y[2], y[3]);
                else { v2u w; w.x = pk2(y[0], y[1]); w.y = pk2(y[2], y[3]);
                    *(LAS v2u*)(st + i * 272 + v * 2) = w; }
                if ((vt & 3) == 3) asm volatile("" ::: "memory"); }
            LDS_WAIT();
            if (OUTPROJ_F8) {
#pragma unroll
                for (int j = 0; j < 2; ++j) { const int pc = lane + 64 * j, row = pc >> 3, ch = pc & 7;
                    *(v4u*)(F.ws + WS_YMIX + (prow + (2 * half + tti) * 16 + row) * D + h * 128 + ch * 16) = *(const LAS v4u*)(st + row * 144 + ch * 16); } }
            else {
#pragma unroll
                for (int j = 0; j < 4; ++j) { const int pc = lane + 64 * j, row = pc >> 4, ch = pc & 15;
                    *(v4u*)(((bf16*)(F.ws + WS_YMIX)) + (prow + (2 * half + tti) * 16 + row) * D + h * 128 + ch * 8) = *(const LAS v4u*)(st + row * 272 + ch * 16); } }
            LDS_WAIT(); }
        if (MODE < 1) { const int c0 = (tid & 63) * 8, t0 = (tid >> 6) * 8;
            v4u cw[10], xw[10], bw[8];
#pragma unroll
            for (int q = 0; q < 10; ++q) { const int tt = t0 - 1 + q; cw[q] = (v4u){0u, 0u, 0u, 0u}; xw[q] = cw[q];
                if (tt >= 0 && tt < 64) { cw[q] = *(const v4u*)(P + (prow + tt) * PW + CPC + c0); xw[q] = *(const v4u*)(P + (prow + tt) * PW + CPX + c0); } }
#pragma unroll
            for (int q = 0; q < 8; ++q) bw[q] = *(const v4u*)(P + (prow + t0 + q) * PW + CPB + c0);
            f32x4 wv[3][2];
#pragma unroll
            for (int dt = 0; dt < 3; ++dt) { wv[dt][0] = *(const f32x4*)(A->in[13] + dt * 512 + c0); wv[dt][1] = *(const f32x4*)(A->in[13] + dt * 512 + c0 + 4); }
            { const int itn = it + F.G; if (itn < NBATCH * 64) { const int bn_ = itn >> 6, nn_ = itn & 63; const char* pr = (const char*)(P + ((size_t)bn_ * SEQ + nn_ * 64 + (tid >> 3)) * PW); const int j = tid & 7;
#pragma unroll
                  for (int q = 0; q < 6; ++q) { const int ln = j + 8 * q; const int off = ln < 8 ? 128 * ln : 2048 + 128 * (ln - 8); if (off < PW * 2) pfv[q] = *(const unsigned*)(pr + off); }
                  const char* sb = (const char*)(((const bf16*)(F.ws + WS_S)) + (((size_t)bn_ * 64 + nn_) * 4) * 8192) + (size_t)tid * 128;
                  pfv[6] = *(const unsigned*)sb; pfv[7] = *(const unsigned*)(sb + (size_t)NBATCH * 64 * 4 * 8192 * 2);
                  pfv[8] = *(const unsigned*)((const char*)(((const bf16*)(F.ws + WS_VT)) + (((size_t)bn_ * 64 + nn_) * 4) * 8192) + (size_t)tid * 128); } }
            f32x2 ov[8][4];
#pragma unroll
            for (int j = 0; j < 8; ++j)
#pragma unroll
                for (int p = 0; p < 4; ++p) ov[j][p] = (f32x2){0.f, 0.f};
            f32x2 w2[3][4];
#pragma unroll
            for (int dt = 0; dt < 3; ++dt) { w2[dt][0] = (f32x2){wv[dt][0][0], wv[dt][0][1]}; w2[dt][1] = (f32x2){wv[dt][0][2], wv[dt][0][3]}; w2[dt][2] = (f32x2){wv[dt][1][0], wv[dt][1][1]}; w2[dt][3] = (f32x2){wv[dt][1][2], wv[dt][1][3]}; }
#pragma unroll
            for (int q = 0; q < 10; ++q) { const v4u c_ = cw[q], x_ = xw[q]; f32x2 u[4];
                u[0] = (f32x2){bflo(c_.x), bfhi(c_.x)} * (f32x2){bflo(x_.x), bfhi(x_.x)}; u[1] = (f32x2){bflo(c_.y), bfhi(c_.y)} * (f32x2){bflo(x_.y), bfhi(x_.y)};
                u[2] = (f32x2){bflo(c_.z), bfhi(c_.z)} * (f32x2){bflo(x_.z), bfhi(x_.z)}; u[3] = (f32x2){bflo(c_.w), bfhi(c_.w)} * (f32x2){bflo(x_.w), bfhi(x_.w)};
#pragma unroll
                for (int dt = 0; dt < 3; ++dt) { const int j = q - dt;
                    if (j >= 0 && j < 8) {
#pragma unroll
                        for (int p = 0; p < 4; ++p) ov[j][p] += w2[dt][p] * u[p]; } } }
#pragma unroll
            for (int q = 0; q < 8; ++q) { const v4u b_ = bw[q];
                const f32x2 y0 = ov[q][0] * (f32x2){bflo(b_.x), bfhi(b_.x)}, y1 = ov[q][1] * (f32x2){bflo(b_.y), bfhi(b_.y)}, y2 = ov[q][2] * (f32x2){bflo(b_.z), bfhi(b_.z)}, y3 = ov[q][3] * (f32x2){bflo(b_.w), bfhi(b_.w)};
                if (OUTPROJ_F8) { v2u w; w.x = pk4_fp8(y0.x, y0.y, y1.x, y1.y); w.y = pk4_fp8(y2.x, y2.y, y3.x, y3.y);
                    *(v2u*)(F.ws + WS_YMIX + (prow + t0 + q) * D + 512 + c0) = w; }
                else { v4u w; w.x = pk2(y0.x, y0.y); w.y = pk2(y1.x, y1.y); w.z = pk2(y2.x, y2.y); w.w = pk2(y3.x, y3.y);
                    *(v4u*)(((bf16*)(F.ws + WS_YMIX)) + (prow + t0 + q) * D + 512 + c0) = w; } } }
#pragma unroll
        for (int q = 0; q < 9; ++q) asm volatile("" :: "v"(pfv[q]));
        LDS_BARRIER();
    }
}

__device__ __forceinline__ void p4_phase(const Frame& F, CArgs* A) {
    for (int idx = F.bid * NTHREADS + F.tid; idx < 2 * NBATCH * 4 * 1024; idx += F.G * NTHREADS) {
        const int e8 = idx & 1023, ch = idx >> 10, h = ch & 3, b = (ch >> 2) & 15, dir = ch >> 6; const int d0 = (e8 & 7) * 8;
        float s[8];
#pragma unroll
        for (int j = 0; j < 8; ++j) s[j] = 0.f;
#pragma unroll 17
        for (int st = 0; st < NCC; ++st) {
            const int cc = dir ? (st < 4 ? 3 - st : 71 - st) : st;
            const size_t ci = ((size_t)dir * NBATCH + b) * NCC + cc;
            const v4u kv = *(const v4u*)(((bf16*)(F.ws + WS_KV)) + (ci * 4 + h) * 8192 + (size_t)e8 * 8);
            const f32x4 dc0 = *(const f32x4*)(((float*)(F.ws + WS_DECAY)) + ci * 256 + h * 64 + d0), dc1 = *(const f32x4*)(((float*)(F.ws + WS_DECAY)) + ci * 256 + h * 64 + d0 + 4);
            if (cc >= 4) { v4u w; w.x = pk2(s[0], s[1]); w.y = pk2(s[2], s[3]); w.z = pk2(s[4], s[5]); w.w = pk2(s[6], s[7]);
                *(v4u*)(((bf16*)(F.ws + WS_S)) + ((((size_t)dir * NBATCH + b) * 64 + (cc - 4)) * 4 + h) * 8192 + (size_t)e8 * 8) = w; }
            s[0] = s[0] * dc0[0] + bflo(kv.x); s[1] = s[1] * dc0[1] + bfhi(kv.x); s[2] = s[2] * dc0[2] + bflo(kv.y); s[3] = s[3] * dc0[3] + bfhi(kv.y);
            s[4] = s[4] * dc1[0] + bflo(kv.z); s[5] = s[5] * dc1[1] + bfhi(kv.z); s[6] = s[6] * dc1[2] + bflo(kv.w); s[7] = s[7] * dc1[3] + bfhi(kv.w);
        }
    }
}

__device__ __forceinline__ void p5a_phase(const Frame& F, CArgs* A) {
    LAS unsigned char* lds = F.lds; const int tid = F.tid, lane = F.lane, wave = F.wave, i = lane & 15, g = lane >> 4;
    GlaRegs cur; if (F.bid < NBATCH * 64 * 4) cur = gla_load(F, (size_t)(F.bid >> 2) * 64, F.bid & 3);
    f32x4 gw[4];
#pragma unroll
    for (int k = 0; k < 4; ++k) gw[k] = *(const f32x4*)(A->in[12] + ((wave >> 2) * 4 + k) * 16 + 4 * g);
    for (int it = F.bid; it < NBATCH * 64 * 4; it += F.G) {
        const int h = it & 3, bn = it >> 2, b = bn >> 6, n = bn & 63; const size_t prow = (size_t)b * SEQ + n * 64;
        GlaRegs nxt = cur; { const int itn = it + F.G; if (itn < NBATCH * 64 * 4) nxt = gla_load(F, (size_t)(itn >> 2) * 64, itn & 3); }
        v4u qw, kw; { const int t = tid >> 3, d0 = (tid & 7) * 8; qw = *(const v4u*)(((bf16*)(F.ws + WS_P)) + (prow + t) * PW + CQ + h * 64 + d0); kw = *(const v4u*)(((bf16*)(F.ws + WS_P)) + (prow + t) * PW + CK + h * 64 + d0); }
        gla_prep(F, A, cur, h); cur = nxt;
        bf16x8 sfr[4][2][2]; v2u rwv[4];
        { const int tt = wave & 3, vh = wave >> 2, t = tt * 16 + i;
#pragma unroll
          for (int k = 0; k < 4; ++k) { const int vt = vh * 4 + k;
#pragma unroll
              for (int dir = 0; dir < 2; ++dir) { const bf16* sp = ((bf16*)(F.ws + WS_S)) + ((((size_t)dir * NBATCH + b) * 64 + n) * 4 + h) * 8192 + (size_t)(vt * 16 + i) * 64 + 8 * g;
                  sfr[k][dir][0] = *(const bf16x8*)sp; sfr[k][dir][1] = *(const bf16x8*)(sp + 32); }
              rwv[k] = *(const v2u*)(((bf16*)(F.ws + WS_P)) + (prow + t) * PW + CR + h * 128 + vt * 16 + 4 * g); } }
        { const int t = tid >> 3, d0 = (tid & 7) * 8;
          const float q[8] = {bflo(qw.x), bfhi(qw.x), bflo(qw.y), bfhi(qw.y), bflo(qw.z), bfhi(qw.z), bflo(qw.w), bfhi(qw.w)};
          const float k[8] = {bflo(kw.x), bfhi(kw.x), bflo(kw.y), bfhi(kw.y), bflo(kw.z), bfhi(kw.z), bflo(kw.w), bfhi(kw.w)};
#pragma unroll
          for (int dir = 0; dir < 2; ++dir) { const LAS float* bp = (const LAS float*)(lds + GL_BC) + dir * 4096 + t * 64 + d0;
              const f32x4 b0 = *(const LAS f32x4*)bp, b1 = *(const LAS f32x4*)(bp + 4); const float bb[8] = {b0[0], b0[1], b0[2], b0[3], b1[0], b1[1], b1[2], b1[3]};
              float qd[8], ki[8];
#pragma unroll
              for (int j = 0; j < 8; ++j) { qd[j] = q[j] * __expf(bb[j]) * 0.125f; ki[j] = k[j] * __expf(-bb[j]); }
              v4u w; w.x = pk2(qd[0], qd[1]); w.y = pk2(qd[2], qd[3]); w.z = pk2(qd[4], qd[5]); w.w = pk2(qd[6], qd[7]);
              *(LAS v4u*)(lds + GL_A + ((dir * 64 + t) * 72 + d0) * 2) = w;
              w.x = pk2(ki[0], ki[1]); w.y = pk2(ki[2], ki[3]); w.z = pk2(ki[4], ki[5]); w.w = pk2(ki[6], ki[7]);
              *(LAS v4u*)(lds + GL_B + ((dir * 64 + t) * 72 + d0) * 2) = w; } }
        __syncthreads();
#pragma unroll
        for (int kk = 0; kk < 2; ++kk) { const int pi = wave * 2 + kk, tt = pi >> 2, st = pi & 3;
            f32x4 aF = {0.f, 0.f, 0.f, 0.f}, aB = {0.f, 0.f, 0.f, 0.f};
            if (st <= tt) {
#pragma unroll
                for (int ks = 0; ks < 2; ++ks) { const bf16x8 kf = *(const LAS bf16x8*)(lds + GL_B + ((st * 16 + i) * 72 + 32 * ks + 8 * g) * 2), qf = *(const LAS bf16x8*)(lds + GL_A + ((tt * 16 + i) * 72 + 32 * ks + 8 * g) * 2);
                    aF = __builtin_amdgcn_mfma_f32_16x16x32_bf16(kf, qf, aF, 0, 0, 0); } }
            if (st >= tt) {
#pragma unroll
                for (int ks = 0; ks < 2; ++ks) { const bf16x8 kf = *(const LAS bf16x8*)(lds + GL_B + ((64 + st * 16 + i) * 72 + 32 * ks + 8 * g) * 2), qf = *(const LAS bf16x8*)(lds + GL_A + ((64 + tt * 16 + i) * 72 + 32 * ks + 8 * g) * 2);
                    aB = __builtin_amdgcn_mfma_f32_16x16x32_bf16(kf, qf, aB, 0, 0, 0); } }
            const int t = tt * 16 + i, s0 = st * 16 + 4 * g; float p[4];
#pragma unroll
            for (int r = 0; r < 4; ++r) p[r] = ((s0 + r <= t) ? aF[r] : 0.f) + ((s0 + r >= t) ? aB[r] : 0.f);
            v2u w; w.x = pk2(p[0], p[1]); w.y = pk2(p[2], p[3]);
            *(LAS v2u*)(lds + GL_P + (t * 72 + s0) * 2) = w; }
        __syncthreads();
        { const int tt = wave & 3, vh = wave >> 2; const int t = tt * 16 + i;
          bf16x8 pf[2], qf[2][2];
#pragma unroll
          for (int ks = 0; ks < 2; ++ks) { pf[ks] = *(const LAS bf16x8*)(lds + GL_P + (t * 72 + 32 * ks + 8 * g) * 2);
              qf[0][ks] = *(const LAS bf16x8*)(lds + GL_A + (t * 72 + 32 * ks + 8 * g) * 2); qf[1][ks] = *(const LAS bf16x8*)(lds + GL_A + ((64 + t) * 72 + 32 * ks + 8 * g) * 2); }
          f32x4 acc[4]; float ss = 0.f;
#pragma unroll
          for (int k = 0; k < 4; ++k) { const int vt = vh * 4 + k; f32x4 a = {0.f, 0.f, 0.f, 0.f};
              { bf16x8 vf0, vf1; v_frag2(lds, vt * 16, lane, vf0, vf1); a = __builtin_amdgcn_mfma_f32_16x16x32_bf16(vf0, pf[0], a, 0, 0, 0); a = __builtin_amdgcn_mfma_f32_16x16x32_bf16(vf1, pf[1], a, 0, 0, 0); }
#pragma unroll
              for (int dir = 0; dir < 2; ++dir)
#pragma unroll
                  for (int ks = 0; ks < 2; ++ks) a = __builtin_amdgcn_mfma_f32_16x16x32_bf16(sfr[k][dir][ks], qf[dir][ks], a, 0, 0, 0);
              acc[k] = a; ss += (a[0] * a[0] + a[1] * a[1]) + (a[2] * a[2] + a[3] * a[3]); }
          ss += __shfl_xor(ss, 16); ss += __shfl_xor(ss, 32);
          if (g == 0) ((LAS float*)(lds + GL_SS))[vh * 64 + t] = ss;
          __syncthreads();
          const float tot = ((const LAS float*)(lds + GL_SS))[t] + ((const LAS float*)(lds + GL_SS))[64 + t];
          const float rstd = 1.0f / sqrtf(tot * (1.0f / 128.0f) + EPS);
#pragma unroll
          for (int k = 0; k < 4; ++k) { const int v = (vh * 4 + k) * 16 + 4 * g;
              const v2u rw = rwv[k];
              const float r[4] = {bflo(rw.x), bfhi(rw.x), bflo(rw.y), bfhi(rw.y)}; float y[4];
#pragma unroll
              for (int j = 0; j < 4; ++j) y[j] = acc[k][j] * rstd * gw[k][j] * (r[j] * __builtin_amdgcn_rcpf(1.0f + __expf(-r[j])));
              v2u w; w.x = pk2(y[0], y[1]); w.y = pk2(y[2], y[3]);
              *(v2u*)(((bf16*)(F.ws + WS_YMIX)) + (prow + t) * D + h * 128 + v) = w; } }
        __syncthreads();
    }
    for (int it = F.bid; it < NBATCH * 64; it += F.G) {
        const size_t prow = (size_t)it * 64;
#pragma unroll 1
        for (int rep = 0; rep < 8; ++rep) { const int idx = tid + rep * NTHREADS, t = idx >> 6, c0 = (idx & 63) * 8;
            float cv[8];
#pragma unroll
            for (int j = 0; j < 8; ++j) cv[j] = 0.f;
#pragma unroll
            for (int dt = -1; dt <= 1; ++dt) { const int tt = t + dt; if (tt >= 0 && tt < 64) {
                const v4u cw = *(const v4u*)(((bf16*)(F.ws + WS_P)) + (prow + tt) * PW + CPC + c0), xw = *(const v4u*)(((bf16*)(F.ws + WS_P)) + (prow + tt) * PW + CPX + c0);
                const f32x4 w0 = *(const f32x4*)(A->in[13] + (dt + 1) * 512 + c0), w1 = *(const f32x4*)(A->in[13] + (dt + 1) * 512 + c0 + 4);
                cv[0] += w0[0] * bflo(cw.x) * bflo(xw.x); cv[1] += w0[1] * bfhi(cw.x) * bfhi(xw.x); cv[2] += w0[2] * bflo(cw.y) * bflo(xw.y); cv[3] += w0[3] * bfhi(cw.y) * bfhi(xw.y);
                cv[4] += w1[0] * bflo(cw.z) * bflo(xw.z); cv[5] += w1[1] * bfhi(cw.z) * bfhi(xw.z); cv[6] += w1[2] * bflo(cw.w) * bflo(xw.w); cv[7] += w1[3] * bfhi(cw.w) * bfhi(xw.w); } }
            const v4u bw = *(const v4u*)(((bf16*)(F.ws + WS_P)) + (prow + t) * PW + CPB + c0);
            v4u w; w.x = pk2(cv[0] * bflo(bw.x), cv[1] * bfhi(bw.x)); w.y = pk2(cv[2] * bflo(bw.y), cv[3] * bfhi(bw.y)); w.z = pk2(cv[4] * bflo(bw.z), cv[5] * bfhi(bw.z)); w.w = pk2(cv[6] * bflo(bw.w), cv[7] * bfhi(bw.w));
            *(v4u*)(((bf16*)(F.ws + WS_YMIX)) + (prow + t) * D + 512 + c0) = w; }
    }
}

constexpr int RT_W = 0;
constexpr int RT_LG = 32 * 1032 * 2;
constexpr int RT_HIST = RT_LG + 128 * 33 * 4;
constexpr int RT_WC = RT_HIST + 256;
__device__ __forceinline__ void p5c_phase(const Frame& F, CArgs* A) {
    LAS unsigned char* lds = F.lds; const int tid = F.tid, lane = F.lane, wave = F.wave, i = lane & 15, g = lane >> 4;
#pragma unroll 1
    for (int i0 = 0; i0 < 32768; i0 += 16 * NTHREADS) { float rv[16];
#pragma unroll
        for (int q = 0; q < 16; ++q) rv[q] = A->in[16][i0 + q * NTHREADS + tid];
#pragma unroll
        for (int q = 0; q < 16; ++q) { const int idx = i0 + q * NTHREADS + tid, k = idx >> 5, e = idx & 31; *(LAS bf16*)(lds + RT_W + (e * 1032 + k) * 2) = (bf16)f2bf(rv[q]); } }
    LAS int* hist = (LAS int*)(lds + RT_HIST); LAS float* lg = (LAS float*)(lds + RT_LG);
    unsigned* gcnt = ((unsigned*)(F.ws + WS_CTL)) + CW_CNT;
    __syncthreads();
#pragma unroll 1
    for (int it = F.bid; it < NLAT / 128; it += F.G) {
        const int R = it * 128 + wave * 16 + i, b = it >> 5;
        const bf16* yg = ((const bf16*)(F.ws + WS_Y1)) + (size_t)R * D + 8 * g;
        unsigned char* hn2g = (unsigned char*)F.out + DO_HN2 + (size_t)R * D + 8 * g;
        const LAS unsigned char* rw0 = lds + RT_W + (i * 1032 + 8 * g) * 2; const LAS unsigned char* rw1 = rw0 + 16 * 1032 * 2;
        if (tid < 32) hist[tid] = 0;
        { const int c0 = 2 * tid; const f32x2 w_ = *(const f32x2*)(A->in[15] + c0), c_ = *(const f32x2*)(((float*)(F.ws + WS_MOD)) + (size_t)b * 6144 + 4096 + c0), s_ = *(const f32x2*)(((float*)(F.ws + WS_MOD)) + (size_t)b * 6144 + 3072 + c0);
          *(LAS f32x2*)(lds + RT_WC + c0 * 4) = w_ * (c_ + 1.0f); *(LAS f32x2*)(lds + RT_WC + 4096 + c0 * 4) = s_; }
        v4u yv[32];
#pragma unroll
        for (int ks = 0; ks < 32; ++ks) yv[ks] = *(const v4u*)(yg + 32 * ks);
        float ss = 0.f;
#pragma unroll
        for (int ks = 0; ks < 32; ++ks) { const v4u yw = yv[ks];
            const float h0 = bflo(yw.x), h1 = bfhi(yw.x), h2 = bflo(yw.y), h3 = bfhi(yw.y), h4 = bflo(yw.z), h5 = bfhi(yw.z), h6 = bflo(yw.w), h7 = bfhi(yw.w);
            ss += (h0 * h0 + h1 * h1) + (h2 * h2 + h3 * h3) + (h4 * h4 + h5 * h5) + (h6 * h6 + h7 * h7); }
        ss += __shfl_xor(ss, 16); ss += __shfl_xor(ss, 32);
        const float rstd = 1.0f / sqrtf(ss * (1.f / D) + EPS);
#pragma unroll
        for (int ks = 0; ks < 32; ++ks) asm volatile("" : "+v"(yv[ks]));
        LDS_BARRIER();
        f32x4 l0 = {0.f, 0.f, 0.f, 0.f}, l1 = {0.f, 0.f, 0.f, 0.f};
        const LAS unsigned char* wcg = lds + RT_WC + 32 * g;
#pragma unroll
        for (int ks = 0; ks < 32; ++ks) {
            const v4u yw = yv[ks];
            const f32x4 a0 = {bflo(yw.x), bfhi(yw.x), bflo(yw.y), bfhi(yw.y)}, a1 = {bflo(yw.z), bfhi(yw.z), bflo(yw.w), bfhi(yw.w)};
            const f32x4 c0 = *(const LAS f32x4*)(wcg + 128 * ks), c1 = *(const LAS f32x4*)(wcg + 128 * ks + 16), s0 = *(const LAS f32x4*)(wcg + 4096 + 128 * ks), s1 = *(const LAS f32x4*)(wcg + 4096 + 128 * ks + 16);
            const f32x4 y0 = (a0 * rstd) * c0 + s0, y1 = (a1 * rstd) * c1 + s1;
            v4u w; w.x = pk2(y0[0], y0[1]); w.y = pk2(y0[2], y0[3]); w.z = pk2(y1[0], y1[1]); w.w = pk2(y1[2], y1[3]);
            { v2u w8; w8.x = pk4_fp8(y0[0], y0[1], y0[2], y0[3]); w8.y = pk4_fp8(y1[0], y1[1], y1[2], y1[3]); *(v2u*)(hn2g + 32 * ks) = w8; }
            const bf16x8 af = __builtin_bit_cast(bf16x8, w);
            const bf16x8 r0 = *(const LAS bf16x8*)(rw0 + 64 * ks), r1 = *(const LAS bf16x8*)(rw1 + 64 * ks);
            l0 = __builtin_amdgcn_mfma_f32_16x16x32_bf16(af, r0, l0, 0, 0, 0); l1 = __builtin_amdgcn_mfma_f32_16x16x32_bf16(af, r1, l1, 0, 0, 0);
            asm volatile("" : "+v"(l0), "+v"(l1) :: "memory"); }
        { const float rb0 = A->in[17][i], rb1 = A->in[17][16 + i];
#pragma unroll
          for (int r = 0; r < 4; ++r) { lg[(wave * 16 + 4 * g + r) * 33 + i] = l0[r] + rb0; lg[(wave * 16 + 4 * g + r) * 33 + 16 + i] = l1[r] + rb1; } }
        __syncthreads();
        int te[4] = {0, 0, 0, 0}; float tv[4] = {-3.0e38f, -3.0e38f, -3.0e38f, -3.0e38f}; int lp[4] = {0, 0, 0, 0};
        if (lane < 16) { const LAS float* lr = lg + (wave * 16 + lane) * 33;
            for (int e = 0; e < 32; ++e) { const float x = lr[e];
                if (x > tv[3]) { if (x > tv[2]) { tv[3] = tv[2]; te[3] = te[2]; if (x > tv[1]) { tv[2] = tv[1]; te[2] = te[1]; if (x > tv[0]) { tv[1] = tv[0]; te[1] = te[0]; tv[0] = x; te[0] = e; } else { tv[1] = x; te[1] = e; } } else { tv[2] = x; te[2] = e; } } else { tv[3] = x; te[3] = e; } } }
            const float e1 = __expf(tv[1] - tv[0]), e2 = __expf(tv[2] - tv[0]), e3 = __expf(tv[3] - tv[0]), inv = 1.0f / (1.0f + e1 + e2 + e3);
            tv[0] = inv; tv[1] = e1 * inv; tv[2] = e2 * inv; tv[3] = e3 * inv;
#pragma unroll
            for (int k = 0; k < 4; ++k) lp[k] = __hip_atomic_fetch_add(&hist[te[k]], 1, __ATOMIC_RELAXED, __HIP_MEMORY_SCOPE_WORKGROUP); }
        __syncthreads();
        if (tid < 32) { const int c = hist[tid]; hist[32 + tid] = c ? (int)__hip_atomic_fetch_add(gcnt + tid, (unsigned)c, RLX_AGENT) : 0; }
        __syncthreads();
        if (lane < 16) { const int Rt = it * 128 + wave * 16 + lane;
#pragma unroll
            for (int k = 0; k < 4; ++k) { const size_t pos = (size_t)te[k] * LISTCAP + hist[32 + te[k]] + lp[k]; ((int*)((unsigned char*)F.out + DO_LAID))[pos] = Rt * 4 + k;
                ((int*)(F.ws + WS_TSLOT))[Rt * 4 + k] = (te[k] << 20) | (hist[32 + te[k]] + lp[k]); ((float*)(F.ws + WS_TW))[Rt * 4 + k] = tv[k]; } }
        __syncthreads();
    }
}

__device__ __forceinline__ void p8_phase(const Frame& F, CArgs* A, const LAS int* TS) {
    const int gw = F.bid * NWAVES + F.wave, NGW = F.G * NWAVES;
    for (int r0 = gw; r0 < NLAT; r0 += 2 * NGW) {
        const int r1 = (r0 + NGW < NLAT) ? r0 + NGW : r0; const bool two = r0 + NGW < NLAT;
        int ep[2][4]; float wk[2][4];
#pragma unroll
        for (int a = 0; a < 2; ++a) { const int r = a ? r1 : r0;
#pragma unroll
            for (int k = 0; k < 4; ++k) { ep[a][k] = ((const int*)(F.ws + WS_TSLOT))[r * 4 + k]; wk[a][k] = ((const float*)(F.ws + WS_TW))[r * 4 + k]; } }
        int yw8[2][4][4]; v2u hw[2][4];
#pragma unroll
        for (int a = 0; a < 2; ++a) { const int r = a ? r1 : r0; const bf16* yr = ((const bf16*)(F.ws + WS_Y1)) + (size_t)r * D;
#pragma unroll
            for (int k = 0; k < 4; ++k) { const int* ys = (const int*)((const unsigned char*)(F.ws + WS_YA) + ((size_t)TS[ep[a][k] >> 20] * 256 + (ep[a][k] & 0xFFFFF)) * D);
#pragma unroll
                for (int j = 0; j < 4; ++j) yw8[a][k][j] = ys[F.lane + 64 * j]; }
#pragma unroll
            for (int j = 0; j < 4; ++j) hw[a][j] = ((const v2u*)yr)[F.lane + 64 * j]; }
#pragma unroll
        for (int a = 0; a < 2; ++a) { if (a == 1 && !two) break;
            const int r = a ? r1 : r0; float* hr = F.out + (size_t)r * D; const float* g2 = ((float*)(F.ws + WS_MOD)) + (size_t)(r >> 12) * 6144 + 5120;
            f32x4 v[4]; float s = 0.f;
#pragma unroll
            for (int j = 0; j < 4; ++j) { const int c4 = F.lane + 64 * j; f32x4 y = {0.f, 0.f, 0.f, 0.f};
#pragma unroll
                for (int k = 0; k < 4; ++k) { const int w = yw8[a][k][j]; const f32x2 lo = __builtin_amdgcn_cvt_pk_f32_fp8(w, false), hi = __builtin_amdgcn_cvt_pk_f32_fp8(w, true);
                    y[0] += wk[a][k] * lo[0]; y[1] += wk[a][k] * lo[1]; y[2] += wk[a][k] * hi[0]; y[3] += wk[a][k] * hi[1]; }
                const v2u yw = hw[a][j]; const f32x4 y1 = {bflo(yw.x), bfhi(yw.x), bflo(yw.y), bfhi(yw.y)};
                v[j] = y1 + ((const f32x4*)g2)[c4] * y;
                s += (v[j].x * v[j].x + v[j].y * v[j].y) + (v[j].z * v[j].z + v[j].w * v[j].w); }
            const float rstd = 1.0f / sqrtf(wave_sum(s) * (1.f / D) + EPS);
#pragma unroll
            for (int j = 0; j < 4; ++j) { const int c4 = F.lane + 64 * j; ((f32x4*)hr)[c4] = (v[j] * rstd) * ((const f32x4*)A->in[22])[c4]; } }
    }
}

constexpr int NPHASES = 11;
__global__ void __launch_bounds__(NTHREADS, 2) fwd_kernel(Args args) {
    extern __shared__ __attribute__((aligned(16))) unsigned char lds_raw[];
    Frame F;
    F.lds = (LAS unsigned char*)lds_raw;
    F.tid = threadIdx.x; F.lane = F.tid & 63; F.wave = __builtin_amdgcn_readfirstlane(F.tid >> 6); F.G = gridDim.x; F.bid = blockIdx.x;
    F.out = args.out; F.ws = args.ws;
        for (int u = F.tid; u < (LDS_BYTES - MISC_OFF) / 4; u += NTHREADS) ((LAS unsigned*)(F.lds + MISC_OFF))[u] = 0u;
    __syncthreads();
    volatile LAS unsigned* MISC = (volatile LAS unsigned*)(F.lds + MISC_OFF);
    LAS int* TS = (LAS int*)(F.lds + MISC_OFF + 256);
    const int lo = args.ph_lo, hi = args.ph_hi;
    const bool multi = (hi - lo) > 1;
    XcdBarrier bar; bar.bar = (unsigned*)((unsigned*)(F.ws + WS_CTL)) + CW_BAR; bar.x = 0; bar.st = nullptr;
    if (multi) bar = xcd_barrier_post((unsigned*)((unsigned*)(F.ws + WS_CTL)) + CW_BAR, MISC + 8);
#ifndef PHMASK
#define PHMASK 0x7ff
#endif
#define IN(k) (((PHMASK >> (k)) & 1) && lo <= (k) && (k) < hi)
#define BUILD_TS() do { if (F.tid < NEXP) TS[33 + F.tid] = (int)__hip_atomic_load(((unsigned*)(F.ws + WS_CTL)) + CW_CNT + F.tid, RLX_AGENT);     \
        __syncthreads(); \
        if (F.tid == 0) { int acc_ = 0; for (int e = 0; e < NEXP; ++e) { TS[e] = acc_; acc_ += (TS[33 + e] + 255) >> 8; } TS[32] = acc_; } __syncthreads(); \
        for (int t_ = F.tid; t_ < TS[32]; t_ += NTHREADS) { int e_ = 0; for (int k_ = 1; k_ < NEXP; ++k_) e_ = (TS[k_] <= t_) ? k_ : e_; ((LAS unsigned char*)(TS + 72))[t_] = (unsigned char)e_; } \
        __syncthreads(); } while (0)
#define SEAM(k) do { if (IN(k) && IN((k) + 1)) xcd_barrier(bar); } while (0)
#ifndef PROBE_DUP
#define PROBE_DUP 0
#endif
#define REPS(k) for (int rep_ = 0; rep_ < (((PROBE_DUP >> (k)) & 1) ? 2 : 1); ++rep_)

    if (IN(0)) REPS(0) { p0_phase(F, opaque_args()); } SEAM(0);
    if (IN(1)) REPS(1) { p1_phase(F, opaque_args()); } SEAM(1);
    if (IN(2)) REPS(2) { DenseSched S; S.init(NROWS, PWP, F.G, F.bid, ((bf16*)(F.ws + WS_WIN))); S.build((LAS int*)(TS + 400), F.tid); EpiProj E{((bf16*)(F.ws + WS_P))};
        pg8::gemm_phase<EpiProj, DenseSched, true, false>(F.lds, (const char*)((bf16*)(F.ws + WS_HN)), S, E);
#ifdef PROBE_INNULL
        { EpiNull E0; pg8::gemm_phase<EpiNull, DenseSched, true, false>(F.lds, (const char*)((bf16*)(F.ws + WS_HN)), S, E0); }
#endif
    } SEAM(2);
    if (IN(3)) { p3v3_phase<0>(F, opaque_args());
#ifdef PROBE_P3
        p3v3_phase<PROBE_P3>(F, opaque_args());
#endif
    } SEAM(3);
    if (IN(4)) REPS(4) { p4_phase(F, opaque_args()); } SEAM(4);
    if (IN(5)) {
#ifdef PROBE_P5
        p5a_phase(F, opaque_args()); p5av3_phase<PROBE_P5>(F, opaque_args());
#else
        p5av3_phase<0>(F, opaque_args());
#endif
    } SEAM(5);
    if (IN(6)) REPS(6) { DenseSched S; S.init(NLAT, D, F.G, F.bid, ((bf16*)(F.ws + WS_WOUT))); S.kb = OUTPROJ_F8 ? 1024 : 2048; S.build((LAS int*)(TS + 400), F.tid); EpiOut E{opaque_args()->in[0], ((float*)(F.ws + WS_MOD)), ((bf16*)(F.ws + WS_Y1)), OUTPROJ_F8 ? 1.0f / WSCALE : 1.0f};
        pg8::gemm_phase<EpiOut, DenseSched, true, OUTPROJ_F8 != 0>(F.lds, (const char*)((bf16*)(F.ws + WS_YMIX)), S, E); } SEAM(6);
    if (IN(7)) { p5c_phase(F, opaque_args()); } SEAM(7);
#pragma unroll 1
    for (int ph = 8; ph < 10; ++ph) {
        if (IN(ph)) {
            const bool gu = (ph == 8);
            BUILD_TS();
            const int ntr = TS[32];
            REPS(ph) {
                if (gu) { MoeSched<true> S; S.TS = TS; S.ntr = ntr; S.G = F.G; S.c = F.bid; S.laid = ((int*)((unsigned char*)F.out + DO_LAID)); S.W = (const char*)F.out + DO_WGU;
                    EpiGU E{(unsigned char*)(F.ws + WS_ACT), opaque_args()->in[19]}; pg8::gemm_phase<EpiGU, MoeSched<true>, true, true>(F.lds, (const char*)((unsigned char*)F.out + DO_HN2), S, E);
#ifdef PROBE_GUNULL
                    { EpiNull E0; pg8::gemm_phase<EpiNull, MoeSched<true>, true, true>(F.lds, (const char*)((unsigned char*)F.out + DO_HN2), S, E0); }
#endif
                }
                else { MoeSched<false> S; S.TS = TS; S.ntr = ntr; S.G = F.G; S.c = F.bid; S.laid = nullptr; S.W = (const char*)F.out + DO_WDN;
                    EpiDN E{(unsigned char*)(F.ws + WS_YA), opaque_args()->in[21], TS}; pg8::gemm_phase<EpiDN, MoeSched<false>, true, true>(F.lds, (const char*)(F.ws + WS_ACT), S, E); }
            }
        }
        SEAM(ph);
    }
    if (IN(10)) { BUILD_TS(); p8_phase(F, opaque_args(), TS); }
#undef IN
#undef SEAM
}

extern "C" void kernel_launch(void* const* d_in, const int* in_sizes, int n_in, void* d_out, int out_size, void* d_ws, size_t ws_size, hipStream_t stream) {
    static int grid = 0;
    if (grid == 0) {
        if (n_in != 23 || in_sizes[0] != NLAT * D || out_size != NLAT * D || ws_size < WS_TOTAL) {
            fprintf(stderr, "kernel_launch: unexpected shapes: n_in %d, in0 %d, out %d, ws %zu (need %zu); nothing launched\n", n_in, n_in > 0 ? in_sizes[0] : -1, out_size, ws_size, (size_t)WS_TOTAL); grid = -1; return; }
        int dev = 0, cus = 0, per_cu = 0;
        if (hipGetDevice(&dev) != hipSuccess || hipDeviceGetAttribute(&cus, hipDeviceAttributeMultiprocessorCount, dev) != hipSuccess) { fprintf(stderr, "kernel_launch: device query failed\n"); grid = -1; return; }
        if (hipFuncSetAttribute((const void*)fwd_kernel, hipFuncAttributeMaxDynamicSharedMemorySize, LDS_BYTES) != hipSuccess) { fprintf(stderr, "kernel_launch: hipFuncSetAttribute failed\n"); grid = -1; return; }
        if (hipOccupancyMaxActiveBlocksPerMultiprocessor(&per_cu, (const void*)fwd_kernel, NTHREADS, LDS_BYTES) != hipSuccess || per_cu < 1) {
            fprintf(stderr, "kernel_launch: occupancy query reports %d workgroups per CU; nothing launched\n", per_cu); (void)hipGetLastError(); grid = -1; return; }
        grid = cus;
        if (grid > 256) grid = 256;
    }
    if (grid < 0) return;
    if (hipMemsetAsync((char*)d_ws + WS_CTL, 0, CTL_ZERO_BYTES, stream) != hipSuccess) { fprintf(stderr, "kernel_launch: hipMemsetAsync failed\n"); return; }
    Args a{};
    for (int i = 0; i < 23; ++i) a.in[i] = (const float*)d_in[i];
    a.out = (float*)d_out; a.ws = (unsigned char*)d_ws;
#if MK_N_LAUNCHES == 1
    a.ph_lo = 0; a.ph_hi = NPHASES;
    hipLaunchKernelGGL(fwd_kernel, dim3(grid), dim3(NTHREADS), LDS_BYTES, stream, a);
#else
    for (int p = 0; p < NPHASES; ++p) { a.ph_lo = p; a.ph_hi = p + 1; hipLaunchKernelGGL(fwd_kernel, dim3(grid), dim3(NTHREADS), LDS_BYTES, stream, a); }
#endif
    const hipError_t le = hipPeekAtLastError();
    if (le != hipSuccess) fprintf(stderr, "kernel_launch: launch failed: %s\n", hipGetErrorName(le));
}
```

```cpp
#include <hip/hip_runtime.h>
#include <cstdio>
#include <cstdint>

#ifndef MK_N_LAUNCHES
#define MK_N_LAUNCHES 1
#endif

#define GAS __attribute__((address_space(1)))
#define LAS __attribute__((address_space(3)))
typedef unsigned short bf16;
typedef unsigned v4u __attribute__((ext_vector_type(4)));
typedef unsigned v2u __attribute__((ext_vector_type(2)));
typedef float f32x4 __attribute__((ext_vector_type(4)));
typedef float f32x2 __attribute__((ext_vector_type(2)));
typedef short bf16x8 __attribute__((ext_vector_type(8)));
typedef short s16x4 __attribute__((ext_vector_type(4)));
#define RLX_AGENT __ATOMIC_RELAXED, __HIP_MEMORY_SCOPE_AGENT
#define LDS_WAIT() asm volatile("s_waitcnt lgkmcnt(0)" ::: "memory")
#define VM_WAIT() asm volatile("s_waitcnt vmcnt(0)" ::: "memory")
#define LDS_BARRIER() do { asm volatile("s_waitcnt lgkmcnt(0)" ::: "memory"); __builtin_amdgcn_s_barrier(); asm volatile("" ::: "memory"); } while (0)

typedef __bf16 bf16x2_t __attribute__((ext_vector_type(2)));
__device__ __forceinline__ unsigned pk2(float lo, float hi) { const f32x2 v = {lo, hi}; return __builtin_bit_cast(unsigned, __builtin_convertvector(v, bf16x2_t)); }
__device__ __forceinline__ unsigned f2bf(float f) { return (unsigned)__builtin_bit_cast(unsigned short, (__bf16)f); }
__device__ __forceinline__ unsigned pk4_fp8(float a, float b, float c, float d) { int w = __builtin_amdgcn_cvt_pk_fp8_f32(a, b, 0, false); w = __builtin_amdgcn_cvt_pk_fp8_f32(c, d, w, true); return (unsigned)w; }
__device__ __forceinline__ float bflo(unsigned w) { return __builtin_bit_cast(float, w << 16); }
__device__ __forceinline__ float bfhi(unsigned w) { return __builtin_bit_cast(float, w & 0xffff0000u); }
__device__ __forceinline__ float bf2f(bf16 b) { return __builtin_bit_cast(float, ((unsigned)b) << 16); }
__device__ __forceinline__ float fexp(float x) { return __builtin_amdgcn_exp2f(x * 1.4426950408889634f); }
__device__ __forceinline__ float wave_sum(float v) {
#pragma unroll
    for (int o = 1; o < 64; o <<= 1) v += __shfl_xor(v, o);
    return v;
}

constexpr int D = 1024, NBATCH = 16, SEQ = 4096, CTXL = 256;
constexpr int NLAT = NBATCH * SEQ;
constexpr int NCTXR = NBATCH * CTXL;
constexpr int NROWS = NLAT + NCTXR;
constexpr int PW = 3104, PWP = 3328;
constexpr int CQ = 0, CK = 256, CV = 512, CR = 1024, CAF = 1536, CAB = 1552, CPB = 1568, CPC = 2080, CPX = 2592;
constexpr int NCC = 68;
constexpr int NEXP = 32, DFF = 1024;
constexpr float EPS = 1e-6f;
constexpr int LISTCAP = 65536;
constexpr float WSCALE = 32.0f, WSCALE_INV = 1.0f / 32.0f;

#ifndef OUTPROJ_F8
#define OUTPROJ_F8 1
#endif
constexpr size_t MiB = 1u << 20;
constexpr size_t WS_CTL = 0, CTL_ZERO_BYTES = 32768;
constexpr size_t WS_MOD = 1 * MiB;
constexpr size_t WS_DECAY = 2 * MiB;
constexpr size_t WS_WIN = 6 * MiB;
constexpr size_t WS_WOUT = 13 * MiB;
constexpr size_t WS_HN = 16 * MiB;
constexpr size_t WS_KV = 16 * MiB;
constexpr size_t WS_P = 152 * MiB;
constexpr size_t WS_S = 565 * MiB;
constexpr size_t WS_YMIX = 693 * MiB;
constexpr size_t WS_Y1 = 821 * MiB;
constexpr size_t WS_ACT = 16 * MiB;
constexpr size_t WS_YA = 280 * MiB;
constexpr size_t WS_VT = 949 * MiB;
constexpr size_t WS_END = 1013 * MiB;
constexpr size_t WS_TSLOT = 1013 * MiB;
constexpr size_t WS_TW = 1015 * MiB;
constexpr size_t WS_TOTAL = 1017 * MiB;
constexpr size_t DO_WDN = 0;
constexpr size_t DO_WGU = 32 * MiB;
constexpr size_t DO_HN2 = 96 * MiB;
constexpr size_t DO_LAID = 160 * MiB;
constexpr size_t DO_LW = 168 * MiB;
static_assert(WS_P + (size_t)NROWS * PW * 2 <= WS_S && WS_YMIX + (size_t)NLAT * D * 2 <= WS_Y1 && WS_YA + (size_t)1056 * 256 * D <= WS_Y1 && WS_Y1 + (size_t)NLAT * D * 2 <= WS_VT && WS_VT + (size_t)NLAT * 512 * 2 <= WS_END, "ws map");
static_assert(WS_HN + (size_t)NROWS * D * 2 <= WS_P && WS_ACT + (size_t)1056 * 256 * 1024 <= WS_YA && DO_LW + (size_t)NEXP * LISTCAP * 4 <= (size_t)NLAT * D * 4, "ws map 2");
constexpr int CW_CNT = 64;
constexpr int CW_BAR = 4096;

constexpr int RING_BYTES = 131072;
constexpr int MISC_OFF = RING_BYTES;
constexpr int LDS_BYTES = 147456;
constexpr int NWAVES = 8, NTHREADS = 512;

namespace pg8 {
constexpr int BM = 256, BK = 64, HALF = 128, HTB = HALF * BK * 2, STAGE_BYTES = 8 * HTB;
__host__ __device__ __forceinline__ int lds_byte(int r, int c) { const int st = (r >> 4) * 2 + (c >> 5), rr = r & 15, cc = c & 31, ob = rr * 64 + cc * 2; return st * 1024 + (ob ^ (((ob >> 9) & 1) << 5)); }
__host__ __device__ __forceinline__ void stage_rc(int b, int& R, int& C) { const int st = b / 1024, sb = b % 1024, swz = sb ^ (((sb >> 9) & 1) << 5); R = (st >> 1) * 16 + swz / 64; C = (st & 1) * 32 + (swz % 64) / 2; }
__host__ __device__ __forceinline__ int perm32(int rho) { const int n = rho >> 4, i = rho & 15; return 8 * (i >> 2) + 4 * n + (i & 3); }

typedef int v8i __attribute__((ext_vector_type(8)));
typedef int v4i __attribute__((ext_vector_type(4)));
__device__ __forceinline__ v8i cat8(bf16x8 lo, bf16x8 hi) { return __builtin_shufflevector(__builtin_bit_cast(v4i, lo), __builtin_bit_cast(v4i, hi), 0, 1, 2, 3, 4, 5, 6, 7); }
struct Unit { int pm, pn, e, lt; };
__device__ __forceinline__ unsigned cvt_pk_bf16(float lo, float hi) { unsigned r; asm volatile("v_cvt_pk_bf16_f32 %0, %1, %2" : "=v"(r) : "v"(lo), "v"(hi)); return r; }

template <class Epi, class Sched, bool ALIGN_EPI, bool F8>
__device__ __forceinline__ void gemm_phase(LAS unsigned char* lds, const char* Abase, const Sched& S, const Epi& E) {
    int tid_ = threadIdx.x; asm volatile("" : "+v"(tid_));
    const int tid = tid_, wid = __builtin_amdgcn_readfirstlane(tid >> 6), lane = tid & 63, wr = wid >> 2, wc = wid & 3, fr = lane & 15, fq = lane >> 4;
    constexpr int KB = F8 ? 1024 : 2048, NT = KB / 128;
    unsigned voffB[2];
#pragma unroll
    for (int i = 0; i < 2; ++i) { int R, C; stage_rc(tid * 16 + i * 8192, R, C); const int Rb = Epi::PERM ? ((R & ~31) + perm32(R & 31)) : R; voffB[i] = (unsigned)(Rb * KB + C * 2); }
#define PG8_AROWS(u_, dst_) do { _Pragma("unroll") for (int h_ = 0; h_ < 2; ++h_) _Pragma("unroll") for (int i_ = 0; i_ < 2; ++i_) { int R_, C_; stage_rc(tid * 16 + i_ * 8192, R_, C_); \
        dst_[h_][i_] = (unsigned)S.arow(u_, h_ * HALF + R_); } } while (0)
#define PG8_AOFF2(dst_) do { _Pragma("unroll") for (int h_ = 0; h_ < 2; ++h_) _Pragma("unroll") for (int i_ = 0; i_ < 2; ++i_) { int R_, C_; stage_rc(tid * 16 + i_ * 8192, R_, C_); \
        dst_[h_][i_] = dst_[h_][i_] * (unsigned)KB + (unsigned)C_ * 2u; } } while (0)
    const size_t kstep = (size_t)(BK * 2);
    const size_t hstep = (size_t)HALF * KB;
    const unsigned ldsw = (unsigned)wid * 1024u;
    const int aoff = lds_byte(wr * 64 + fr, fq * 8), boff = lds_byte(wc * 32 + fr, fq * 8);
#define PG8_SA(b, h) (((b) * 2 + (h)) * HTB)
#define PG8_SB(b, h) ((4 + (b) * 2 + (h)) * HTB)
#define PG8_STAGE(bufoff, gbase, voff) do { _Pragma("unroll") for (int _i = 0; _i < 2; ++_i) \
        __builtin_amdgcn_global_load_lds((const unsigned*)((const char*)(gbase) + (voff)[_i]), (LAS unsigned*)(lds + (bufoff) + ldsw + _i * 8192), 16, 0, 0); } while (0)
#define PG8_LDA(dst, b, h) do { _Pragma("unroll") for (int m = 0; m < 4; ++m) _Pragma("unroll") for (int k = 0; k < 2; ++k) dst[m][k] = *(const LAS bf16x8*)(lds + PG8_SA(b, h) + aoff + m * 2048 + k * 1024); } while (0)
#define PG8_LDB(dst, b, h) do { _Pragma("unroll") for (int n = 0; n < 2; ++n) _Pragma("unroll") for (int k = 0; k < 2; ++k) dst[n][k] = *(const LAS bf16x8*)(lds + PG8_SB(b, h) + boff + n * 2048 + k * 1024); } while (0)
#define PG8_MMA(ai, bj, At, Bt) do { if (skipmma && ((bj) == 1 || wc > 0)) break; __builtin_amdgcn_s_setprio(1); _Pragma("unroll") for (int m = 0; m < 4; ++m) _Pragma("unroll") for (int n = 0; n < 2; ++n) { \
        if constexpr (F8) { asm volatile("v_mfma_f32_16x16x128_f8f6f4 %0, %1, %2, %0" : "+v"(acc[ai][bj][m][n]) : "v"(cat8(Bt[n][0], Bt[n][1])), "v"(cat8(At[m][0], At[m][1]))); } \
        else { _Pragma("unroll") for (int k = 0; k < 2; ++k) acc[ai][bj][m][n] = __builtin_amdgcn_mfma_f32_16x16x32_bf16(Bt[n][k], At[m][k], acc[ai][bj][m][n], 0, 0, 0); } } \
        __builtin_amdgcn_s_setprio(0); } while (0)
#define PG8_WAIT_V(n) asm volatile("s_waitcnt vmcnt(" #n ")" ::: "memory")
#define PG8_WAIT_L(n) asm volatile("s_waitcnt lgkmcnt(" #n ")" ::: "memory")
#define PG8_BAR __builtin_amdgcn_s_barrier()
#define PG8_SCHED __builtin_amdgcn_sched_barrier(0)
    Unit cur, nxt; int ui = 0;
    if (!S.next(0, cur)) return;
    f32x4 acc[2][2][4][2];
#pragma unroll
    for (int a = 0; a < 2; ++a)
#pragma unroll
        for (int b = 0; b < 2; ++b)
#pragma unroll
            for (int m = 0; m < 4; ++m)
#pragma unroll
                for (int n = 0; n < 2; ++n) acc[a][b][m][n] = (f32x4){0.f, 0.f, 0.f, 0.f};
    bf16x8 At[4][2], B0[2][2], B1[2][2];
    unsigned oC[2][2];
    PG8_AROWS(cur, oC); PG8_AOFF2(oC);
    unsigned rN[2] = {0u, 0u};
    const char* cB = S.bptr(cur);
    PG8_STAGE(PG8_SB(0, 0), cB, voffB); PG8_STAGE(PG8_SB(0, 1), cB + hstep, voffB); PG8_STAGE(PG8_SA(0, 0), Abase, oC[0]); PG8_STAGE(PG8_SA(0, 1), Abase, oC[1]);
    if (wr == 1) PG8_BAR;
    PG8_WAIT_V(2); PG8_BAR;
    PG8_STAGE(PG8_SB(1, 0), cB + kstep, voffB); PG8_STAGE(PG8_SA(1, 0), Abase + kstep, oC[0]); PG8_STAGE(PG8_SB(1, 1), cB + hstep + kstep, voffB);
    PG8_WAIT_V(6); PG8_BAR;
    for (;;) {
        const bool skipmma = S.mostly_padding(cur);
        const bool has_next = S.next(ui + 1, nxt);
        if (!has_next) nxt = cur;
        const char* nB = S.bptr(nxt);
        for (int t = 0; t < NT; t += 2) {
            const bool last = (t == NT - 2);
            const char* ka1 = Abase + (size_t)(t + 1) * kstep;
            const char* ka2 = last ? Abase : Abase + (size_t)(t + 2) * kstep; const char* b2 = last ? nB : cB + (size_t)(t + 2) * kstep;
            const char* ka3 = ka2 + kstep; const char* b3 = b2 + kstep;
            PG8_LDB(B0, 0, 0); PG8_LDB(B1, 0, 1); PG8_SCHED; PG8_LDA(At, 0, 0); PG8_STAGE(PG8_SA(1, 1), ka1, oC[1]);
            PG8_WAIT_V(8); PG8_WAIT_L(0); PG8_BAR; PG8_MMA(0, 0, At, B0); PG8_MMA(0, 1, At, B1); PG8_BAR; PG8_SCHED;
            if constexpr (Sched::GATHER) { if (t == NT - 4) { unsigned r4[2][2]; PG8_AROWS(nxt, r4); rN[0] = r4[0][0] | (r4[0][1] << 16); rN[1] = r4[1][0] | (r4[1][1] << 16); } }
            if (last) {
                if constexpr (Sched::GATHER) { oC[0][0] = rN[0] & 0xffffu; oC[0][1] = rN[0] >> 16; oC[1][0] = rN[1] & 0xffffu; oC[1][1] = rN[1] >> 16; }
                else { PG8_AROWS(nxt, oC); }
                PG8_AOFF2(oC); }
            PG8_LDA(At, 0, 1); PG8_STAGE(PG8_SB(0, 0), b2, voffB); PG8_STAGE(PG8_SB(0, 1), b2 + hstep, voffB); PG8_STAGE(PG8_SA(0, 0), ka2, oC[0]);
            PG8_WAIT_V(8); PG8_WAIT_L(0); PG8_BAR; PG8_MMA(1, 0, At, B0); PG8_MMA(1, 1, At, B1); PG8_BAR; PG8_SCHED;
            PG8_LDB(B0, 1, 0); PG8_LDB(B1, 1, 1); PG8_SCHED; PG8_LDA(At, 1, 0); PG8_STAGE(PG8_SA(0, 1), ka2, oC[1]);
            PG8_WAIT_V(8); PG8_WAIT_L(0); PG8_BAR; PG8_MMA(0, 0, At, B0); PG8_MMA(0, 1, At, B1); PG8_BAR; PG8_SCHED;
            PG8_LDA(At, 1, 1); PG8_STAGE(PG8_SB(1, 0), b3, voffB); PG8_STAGE(PG8_SB(1, 1), b3 + hstep, voffB); PG8_STAGE(PG8_SA(1, 0), ka3, oC[0]);
            PG8_WAIT_V(8); PG8_WAIT_L(0); PG8_BAR; PG8_MMA(1, 0, At, B0); PG8_MMA(1, 1, At, B1); PG8_BAR; PG8_SCHED;
        }
        if constexpr (ALIGN_EPI) { if (wr == 0) PG8_BAR; }
        if constexpr (F8) asm volatile("s_nop 15\n\ts_nop 7" ::: "memory");
        { int fr_o = fr, fq_o = fq; asm volatile("" : "+v"(fr_o), "+v"(fq_o));
          E(acc, cur, wr, wc, fr_o, fq_o); }
        if (!has_next) break;
#pragma unroll
        for (int a = 0; a < 2; ++a)
#pragma unroll
            for (int b = 0; b < 2; ++b)
#pragma unroll
                for (int m = 0; m < 4; ++m)
#pragma unroll
                    for (int n = 0; n < 2; ++n) acc[a][b][m][n] = (f32x4){0.f, 0.f, 0.f, 0.f};
        cur = nxt; cB = nB; ++ui;
        if constexpr (ALIGN_EPI) { if (wr == 1) PG8_BAR; }
    }
    PG8_WAIT_V(0);
    if constexpr (!ALIGN_EPI) { if (wr == 0) PG8_BAR; }
    PG8_BAR;
#undef PG8_AROWS
#undef PG8_AOFF2
#undef PG8_SA
#undef PG8_SB
#undef PG8_STAGE
#undef PG8_LDA
#undef PG8_LDB
#undef PG8_MMA
#undef PG8_WAIT_V
#undef PG8_WAIT_L
#undef PG8_BAR
#undef PG8_SCHED
}
}

#define XB_TMO      128
#define XB_XCNT(j)  (256  + 64 * (j))
#define XB_XSUB(j)  (1280 + 64 * (j))
#define XB_XGEN(j)  (2304 + 64 * (j))
#define XB_TOP      3328
#define XB_TOPGEN   3392
#define XCD_BAR_WORDS 3456
#define XB_SPIN_CAP (1u << 22)
__device__ __forceinline__ unsigned xb_ld(unsigned* p)              { return __hip_atomic_load(p, __ATOMIC_RELAXED, __HIP_MEMORY_SCOPE_AGENT); }
__device__ __forceinline__ unsigned xb_add(unsigned* p, unsigned v) { return __hip_atomic_fetch_add(p, v, __ATOMIC_RELAXED, __HIP_MEMORY_SCOPE_AGENT); }
__device__ __forceinline__ unsigned xb_xcc_id() { return (unsigned)__builtin_amdgcn_s_getreg((3 << 11) | 20) & 0xFu; }
#define XB_SPIN(cond, bar) do { unsigned _sp = 0; while (cond) { __builtin_amdgcn_s_sleep(1); \
    if ((++_sp & 255u) == 0u) { if (xb_ld(&(bar)[XB_TMO])) break; if (_sp > XB_SPIN_CAP) { atomicAdd(&(bar)[XB_TMO], 1u); break; } } } } while (0)
struct XcdBarrier { unsigned* bar; unsigned x; volatile LAS unsigned* st; };
__device__ __forceinline__ XcdBarrier xcd_barrier_post(unsigned* bar, volatile LAS unsigned* st) {
    XcdBarrier b; b.bar = bar; b.x = xb_xcc_id(); b.st = st;
    if (threadIdx.x == 0) (void)xb_add(&bar[XB_XCNT(b.x)], 1u);
    return b;
}
__device__ __forceinline__ void xcd_barrier_complete(unsigned* bar, unsigned x, unsigned& nloc, unsigned& nx) {
    const unsigned G = gridDim.x * gridDim.y * gridDim.z;
    unsigned sum, cnt, mine, sp = 0u;
    for (;;) {
        sum = 0u; cnt = 0u; mine = 0u;
#pragma unroll 1
        for (unsigned j = 0; j < 16; ++j) { const unsigned c = xb_ld(&bar[XB_XCNT(j)]); sum += c; cnt += (c > 0u) ? 1u : 0u; mine = (j == x) ? c : mine; }
        if (sum == G) break;
        __builtin_amdgcn_s_sleep(1);
        if ((++sp & 255u) == 0u) { if (xb_ld(&bar[XB_TMO])) break; if (sp > XB_SPIN_CAP) { atomicAdd(&bar[XB_TMO], 1u); break; } }
    }
    nloc = mine > 0u ? mine : 1u; nx = cnt > 0u ? cnt : 1u;
}
__device__ __forceinline__ void xcd_barrier(const XcdBarrier& b) {
    asm volatile("s_waitcnt vmcnt(0)" ::: "memory");
    __syncthreads();
    if (threadIdx.x == 0) {
        unsigned* bar = b.bar;
        __builtin_amdgcn_s_waitcnt(0);
        unsigned nloc = b.st[0], nx = b.st[1];
        if (nloc == 0u) { xcd_barrier_complete(bar, b.x, nloc, nx); b.st[0] = nloc; b.st[1] = nx; }
        const unsigned old = xb_add(&bar[XB_XSUB(b.x)], 1u);
        const unsigned gen = old / nloc;
        if (old + 1u == (gen + 1u) * nloc) {
            __builtin_amdgcn_fence(__ATOMIC_RELEASE, "agent");
            asm volatile("s_waitcnt vmcnt(0)" ::: "memory");
            const unsigned og = xb_add(&bar[XB_TOP], 1u);
            const unsigned tg = og / nx;
            if (og + 1u == (tg + 1u) * nx) xb_add(&bar[XB_TOPGEN], 1u);
            else XB_SPIN(xb_ld(&bar[XB_TOPGEN]) == tg, bar);
            __builtin_amdgcn_fence(__ATOMIC_ACQUIRE, "agent");
            xb_add(&bar[XB_XGEN(b.x)], 1u);
            asm volatile("s_waitcnt vmcnt(0)" ::: "memory");
        } else {
            XB_SPIN(xb_ld(&bar[XB_XGEN(b.x)]) == gen, bar);
            __builtin_amdgcn_fence(__ATOMIC_ACQUIRE, "agent");
            asm volatile("s_waitcnt vmcnt(0)" ::: "memory");
        }
    }
    __syncthreads();
}

struct Args { const float* in[23]; float* out; unsigned char* ws; int ph_lo, ph_hi; };
typedef const Args __attribute__((address_space(4))) CArgs;
__device__ __forceinline__ CArgs* opaque_args() { CArgs* p = (CArgs*)__builtin_amdgcn_kernarg_segment_ptr(); asm volatile("" : "+s"(p)); return p; }
struct Frame {
    LAS unsigned char* lds;
    int tid, lane, wave, G, bid;
    float* out; unsigned char* ws;
};

struct EpiNull {
    static constexpr bool PERM = true;
    __device__ __forceinline__ void operator()(const f32x4 (&acc)[2][2][4][2], const pg8::Unit&, int, int, int, int) const {
#pragma unroll
        for (int a = 0; a < 2; ++a)
#pragma unroll
            for (int b = 0; b < 2; ++b)
#pragma unroll
                for (int m = 0; m < 4; ++m)
#pragma unroll
                    for (int n = 0; n < 2; ++n) asm volatile("" :: "v"(acc[a][b][m][n]));
    }
};
struct DenseSched {
    static constexpr bool GATHER = false;
    int nM, nN, nwg, G, c, kb; const char* Bt; const LAS int* UT;
    __device__ __forceinline__ void init(int M, int N, int G_, int c_, const void* Bt_) { nM = M / 256; nN = N / 256; nwg = nM * nN; G = G_; c = c_; Bt = (const char*)Bt_; UT = nullptr; kb = 2048; }
    __device__ __forceinline__ void build(LAS int* ut, int tid) { if (tid < 32) { pg8::Unit u; ut[tid] = next_calc(tid, u) ? (u.pm | (u.pn << 16)) : -1; } UT = ut; __syncthreads(); }
    __device__ __forceinline__ bool next(int i, pg8::Unit& u) const { const int w = (i < 32) ? UT[i] : -1; if (w < 0) return false; u.pm = w & 0xffff; u.pn = w >> 16; u.e = 0; u.lt = 0; return true; }
    __device__ __forceinline__ bool next_calc(int i, pg8::Unit& u) const {
        const long L = (long)i * G + c; if (L >= nwg) return false;
        int wgid = (int)L; { const int q = nwg / 8, r = nwg % 8, xcd = wgid % 8, off = wgid / 8; wgid = (xcd < r ? xcd * (q + 1) : r * (q + 1) + (xcd - r) * q) + off; }
        const int nig = 8 * nN, gid = wgid / nig, fm = gid * 8, gsz = (nM - fm) < 8 ? (nM - fm) : 8;
        u.pm = fm + ((wgid % nig) % gsz); u.pn = (wgid % nig) / gsz; u.e = 0; u.lt = 0; return true;
    }
    __device__ __forceinline__ int arow(const pg8::Unit& u, int r) const { return u.pm * 256 + r; }
    __device__ __forceinline__ bool mostly_padding(const pg8::Unit& u) const { return nN == PWP / 256 && u.pn == nN - 1; }
    __device__ __forceinline__ const char* bptr(const pg8::Unit& u) const { return Bt + (size_t)u.pn * 256 * kb; }
};
struct EpiProj {
    static constexpr bool PERM = true;
    bf16* O;
    __device__ __forceinline__ void operator()(const f32x4 (&acc)[2][2][4][2], const pg8::Unit& u, int wr, int wc, int fr, int fq) const {
        const int row0 = u.pm * 256 + wr * 64 + fr, col0 = u.pn * 256 + wc * 32 + 8 * fq;
#pragma unroll
        for (int ai = 0; ai < 2; ++ai)
#pragma unroll
            for (int m = 0; m < 4; ++m) { bf16* rowp = O + (size_t)(row0 + ai * 128 + m * 16) * PW + col0;
#pragma unroll
                for (int bj = 0; bj < 2; ++bj) { if (col0 + bj * 128 < PW) { const f32x4 v0 = acc[ai][bj][m][0], v1 = acc[ai][bj][m][1];
                    v4u w; w.x = pk2(v0[0], v0[1]); w.y = pk2(v0[2], v0[3]); w.z = pk2(v1[0], v1[1]); w.w = pk2(v1[2], v1[3]);
                    *(v4u*)(rowp + bj * 128) = w; } } }
    }
};
struct EpiOut {
    static constexpr bool PERM = true;
    const float* x; const float* mod; bf16* Y1; float sc;
    __device__ __forceinline__ void operator()(const f32x4 (&acc)[2][2][4][2], const pg8::Unit& u, int wr, int wc, int fr, int fq) const {
        const int row0 = u.pm * 256 + wr * 64 + fr, col0 = u.pn * 256 + wc * 32 + 8 * fq;
        const float* g1 = mod + (size_t)(u.pm >> 4) * 6144 + 2048;
        f32x4 gv[2][2];
#pragma unroll
        for (int bj = 0; bj < 2; ++bj)
#pragma unroll
            for (int n = 0; n < 2; ++n) gv[bj][n] = *(const f32x4*)(g1 + col0 + bj * 128 + 4 * n) * sc;
#pragma unroll
        for (int ai = 0; ai < 2; ++ai)
#pragma unroll
            for (int m = 0; m < 4; ++m) { const size_t off = (size_t)(row0 + ai * 128 + m * 16) * D + col0; bf16* rowp = Y1 + off;
#pragma unroll
                for (int bj = 0; bj < 2; ++bj) { const f32x4 x0 = *(const f32x4*)(x + off + bj * 128), x1 = *(const f32x4*)(x + off + bj * 128 + 4);
                    const f32x4 v0 = x0 + acc[ai][bj][m][0] * gv[bj][0], v1 = x1 + acc[ai][bj][m][1] * gv[bj][1];
                    v4u w; w.x = pk2(v0[0], v0[1]); w.y = pk2(v0[2], v0[3]); w.z = pk2(v1[0], v1[1]); w.w = pk2(v1[2], v1[3]);
                    *(v4u*)(rowp + bj * 128) = w; } }
    }
};
template <bool GU> struct MoeSched {
    static constexpr bool GATHER = GU;
    static constexpr bool gu = GU;
    const LAS int* TS; int ntr, G, c; const int* laid; const char* W;
    __device__ __forceinline__ bool next(int i, pg8::Unit& u) const {
        const int x = c & 7, j = c >> 3; int tl, pn;
        if (G != 256) { const int L = i * G + c, npn = gu ? 8 : 4; tl = L / npn; pn = L % npn; }
        else if (gu) { tl = (i * 8 + x) * 4 + (j >> 3); pn = j & 7; } else { tl = (i * 8 + x) * 8 + (j >> 2); pn = j & 3; }
        if (tl >= ntr) return false;
        const int tau = tl; const int e = ((const LAS unsigned char*)(TS + 72))[tau];
        u.pm = tl; u.pn = pn; u.e = e; u.lt = tau - TS[e]; return true;
    }
    __device__ __forceinline__ bool mostly_padding(const pg8::Unit&) const { return false; }
    __device__ __forceinline__ int arow(const pg8::Unit& u, int r) const {
        if (!gu) return u.pm * 256 + r;
        const int pos = u.lt * 256 + r, cnt = TS[33 + u.e];
        return pos < cnt ? (laid[(size_t)u.e * LISTCAP + pos] >> 2) : 0;
    }
    __device__ __forceinline__ const char* bptr(const pg8::Unit& u) const { return W + ((size_t)u.e * (gu ? 2048 : 1024) + (size_t)u.pn * 256) * 1024; }
};
struct EpiGU {
    static constexpr bool PERM = true;
    unsigned char* ACT; const float* b_gu;
    __device__ __forceinline__ void operator()(const f32x4 (&acc)[2][2][4][2], const pg8::Unit& u, int wr, int wc, int fr, int fq) const {
        const int row0 = u.pm * 256 + wr * 64 + fr, j0 = u.pn * 128 + wc * 32 + 8 * fq;
        const float* bp = b_gu + (size_t)u.e * 2048 + 2 * j0;
        f32x4 bv[4];
#pragma unroll
        for (int q = 0; q < 4; ++q) bv[q] = *(const f32x4*)(bp + 4 * q);
        f32x2 bg[4], bu[4];
#pragma unroll
        for (int q = 0; q < 4; ++q) { bg[q] = (f32x2){bv[q][0], bv[q][2]}; bu[q] = (f32x2){bv[q][1], bv[q][3]}; }
#pragma unroll
        for (int ai = 0; ai < 2; ++ai)
#pragma unroll
            for (int m = 0; m < 4; ++m) { unsigned char* rowp = ACT + (size_t)(row0 + ai * 128 + m * 16) * DFF + j0; f32x2 a[4];
#pragma unroll
                for (int n = 0; n < 2; ++n)
#pragma unroll
                    for (int p = 0; p < 2; ++p) { const int q = 2 * n + p;
                        const f32x4 ag = acc[ai][0][m][n], au = acc[ai][1][m][n];
                        f32x2 g = (f32x2){ag[2 * p], ag[2 * p + 1]} * WSCALE_INV + bg[q], up = (f32x2){au[2 * p], au[2 * p + 1]} * WSCALE_INV + bu[q];
                        g.x = fminf(g.x, 7.0f); g.y = fminf(g.y, 7.0f); up.x = __builtin_amdgcn_fmed3f(up.x, -7.0f, 7.0f); up.y = __builtin_amdgcn_fmed3f(up.y, -7.0f, 7.0f);
                        const f32x2 t = g * (-1.702f * 1.4426950408889634f); f32x2 e; e.x = __builtin_amdgcn_exp2f(t.x); e.y = __builtin_amdgcn_exp2f(t.y);
                        const f32x2 d = e + 1.0f; f32x2 sg; sg.x = __builtin_amdgcn_rcpf(d.x); sg.y = __builtin_amdgcn_rcpf(d.y);
                        a[q] = ((up + 1.0f) * g) * sg; }
                v2u w; w.x = pk4_fp8(a[0].x, a[0].y, a[1].x, a[1].y); w.y = pk4_fp8(a[2].x, a[2].y, a[3].x, a[3].y);
                *(v2u*)rowp = w; }
    }
};
struct EpiDN {
    static constexpr bool PERM = true;
    unsigned char* YA; const float* b_dn; const LAS int* TS;
    __device__ __forceinline__ void operator()(const f32x4 (&acc)[2][2][4][2], const pg8::Unit& u, int wr, int wc, int fr, int fq) const {
        const int col0 = u.pn * 256 + wc * 32 + 8 * fq, cnt = TS[33 + u.e];
        f32x4 bv[2][2];
#pragma unroll
        for (int bj = 0; bj < 2; ++bj)
#pragma unroll
            for (int n = 0; n < 2; ++n) bv[bj][n] = *(const f32x4*)(b_dn + (size_t)u.e * D + col0 + bj * 128 + 4 * n);
#pragma unroll
        for (int ai = 0; ai < 2; ++ai)
#pragma unroll
            for (int m = 0; m < 4; ++m) { const int r = ai * 128 + wr * 64 + m * 16 + fr;
                if (u.lt * 256 + r < cnt) { unsigned char* rowp = YA + ((size_t)u.pm * 256 + r) * D + col0;
#pragma unroll
                    for (int bj = 0; bj < 2; ++bj) { const f32x4 v0 = acc[ai][bj][m][0] * WSCALE_INV + bv[bj][0], v1 = acc[ai][bj][m][1] * WSCALE_INV + bv[bj][1];
                        v2u w; w.x = pk4_fp8(v0[0], v0[1], v0[2], v0[3]); w.y = pk4_fp8(v1[0], v1[1], v1[2], v1[3]);
                        *(v2u*)(rowp + bj * 128) = w; } }
                asm volatile("" ::: "memory"); }
    }
};

template <bool MAPGU>
__device__ __forceinline__ void p0_transpose_item(const float* W, int N, bf16* WT, LAS float* scr, int item, int lane) {
    const int nblk = N / 32, kb = item / nblk, nb = item % nblk, k0 = 64 * kb, n0 = 32 * nb;
#pragma unroll
    for (int i = 0; i < 32; ++i) { const int kk = 2 * i + (lane >> 5); scr[kk * 33 + (lane & 31)] = W[(size_t)(k0 + kk) * N + n0 + (lane & 31)]; }
    LDS_WAIT(); asm volatile("" ::: "memory");
    const int c = lane & 7;
#pragma unroll
    for (int j = 0; j < 4; ++j) { const int n = (lane >> 3) + 8 * j; const LAS float* s = scr + (8 * c) * 33 + n;
        v4u o; o.x = pk2(s[0 * 33], s[1 * 33]); o.y = pk2(s[2 * 33], s[3 * 33]); o.z = pk2(s[4 * 33], s[5 * 33]); o.w = pk2(s[6 * 33], s[7 * 33]);
        int row = n0 + n;
        if (MAPGU) { const int jj = row >> 1; row = (jj >> 7) * 256 + (row & 1) * 128 + (jj & 127); }
        *(v4u*)(WT + (size_t)row * D + k0 + 8 * c) = o; }
    LDS_WAIT(); asm volatile("" ::: "memory");
}
template <bool MAPGU>
__device__ __forceinline__ void p0_transpose_item_f8(const float* W, int N, unsigned char* WT, LAS float* scr, int item, int lane) {
    const int nblk = N / 32, kb = item / nblk, nb = item % nblk, k0 = 64 * kb, n0 = 32 * nb;
#pragma unroll
    for (int i = 0; i < 32; ++i) { const int kk = 2 * i + (lane >> 5); scr[kk * 33 + (lane & 31)] = W[(size_t)(k0 + kk) * N + n0 + (lane & 31)] * WSCALE; }
    LDS_WAIT(); asm volatile("" ::: "memory");
    const int c = lane & 3;
#pragma unroll
    for (int j = 0; j < 2; ++j) { const int n = (lane >> 2) + 16 * j; const LAS float* s = scr + (16 * c) * 33 + n;
        v4u o; o.x = pk4_fp8(s[0 * 33], s[1 * 33], s[2 * 33], s[3 * 33]); o.y = pk4_fp8(s[4 * 33], s[5 * 33], s[6 * 33], s[7 * 33]);
        o.z = pk4_fp8(s[8 * 33], s[9 * 33], s[10 * 33], s[11 * 33]); o.w = pk4_fp8(s[12 * 33], s[13 * 33], s[14 * 33], s[15 * 33]);
        int row = n0 + n;
        if (MAPGU) { const int jj = row >> 1; row = (jj >> 7) * 256 + (row & 1) * 128 + (jj & 127); }
        *(v4u*)(WT + (size_t)row * D + k0 + 16 * c) = o; }
    LDS_WAIT(); asm volatile("" ::: "memory");
}
constexpr int P0_TS = 144;
struct P0Item { const float* W; void* O; int N, k0, n0, kind; };
__device__ __forceinline__ P0Item p0_item(const Frame& F, CArgs* A, int it) {
    constexpr int I_IN = 8 * 25, I_OUT = 8 * 8, I_GU = 8 * 16, I_DN = 8 * 8;
    P0Item r; int x = it;
    if (x < I_IN) { r.W = A->in[7]; r.O = (void*)(F.ws + WS_WIN); r.N = PW; r.k0 = (x / 25) * 128; r.n0 = (x % 25) * 128; r.kind = 0; return r; } x -= I_IN;
    if (x < I_OUT) { r.W = A->in[14]; r.O = (void*)(F.ws + WS_WOUT); r.N = D; r.k0 = (x >> 3) * 128; r.n0 = (x & 7) * 128; r.kind = OUTPROJ_F8 ? 1 : 0; return r; } x -= I_OUT;
    if (x < NEXP * I_GU) { const int e = x / I_GU, y = x % I_GU; r.W = A->in[18] + (size_t)e * D * 2048; r.O = (void*)((unsigned char*)F.out + DO_WGU + (size_t)e * 2048 * D); r.N = 2048; r.k0 = (y >> 4) * 128; r.n0 = (y & 15) * 128; r.kind = 2; return r; } x -= NEXP * I_GU;
    { const int e = x / I_DN, y = x % I_DN; r.W = A->in[20] + (size_t)e * D * D; r.O = (void*)((unsigned char*)F.out + DO_WDN + (size_t)e * D * D); r.N = D; r.k0 = (y >> 3) * 128; r.n0 = (y & 7) * 128; r.kind = 1; return r; }
}
__device__ __forceinline__ void p0_load(const P0Item& I, int tid, f32x4 (&v)[8]) {
#pragma unroll
    for (int q = 0; q < 8; ++q) { const int idx = tid + NTHREADS * q, k = idx >> 5, col = I.n0 + 4 * (idx & 31);
        v[q] = (col < I.N) ? *(const f32x4*)(I.W + (size_t)(I.k0 + k) * I.N + col) : (f32x4){0.f, 0.f, 0.f, 0.f}; }
}
__device__ __forceinline__ void p0_emit(const P0Item& I, LAS unsigned char* lds, int wave, int i, int g) {
    const unsigned a0 = (unsigned)(uintptr_t)lds + (unsigned)(((32 * g + (i >> 2)) * P0_TS + 16 * wave + 4 * (i & 3)) * 2);
    s16x4 r[8];
    asm volatile("ds_read_b64_tr_b16 %0, %8\n\tds_read_b64_tr_b16 %1, %8 offset:1152\n\tds_read_b64_tr_b16 %2, %8 offset:2304\n\tds_read_b64_tr_b16 %3, %8 offset:3456\n\t"
                 "ds_read_b64_tr_b16 %4, %8 offset:4608\n\tds_read_b64_tr_b16 %5, %8 offset:5760\n\tds_read_b64_tr_b16 %6, %8 offset:6912\n\tds_read_b64_tr_b16 %7, %8 offset:8064\n\ts_waitcnt lgkmcnt(0)"
                 : "=&v"(r[0]), "=&v"(r[1]), "=&v"(r[2]), "=&v"(r[3]), "=&v"(r[4]), "=&v"(r[5]), "=&v"(r[6]), "=&v"(r[7]) : "v"(a0) : "memory");
    const int n = I.n0 + 16 * wave + i;
    if (n < I.N) {
        if (I.kind == 0) { bf16* op = (bf16*)I.O + (size_t)n * D + I.k0 + 32 * g;
#pragma unroll
            for (int q = 0; q < 4; ++q) { v4u w; w.x = (unsigned)(unsigned short)r[2 * q][0] | ((unsigned)(unsigned short)r[2 * q][1] << 16); w.y = (unsigned)(unsigned short)r[2 * q][2] | ((unsigned)(unsigned short)r[2 * q][3] << 16);
                w.z = (unsigned)(unsigned short)r[2 * q + 1][0] | ((unsigned)(unsigned short)r[2 * q + 1][1] << 16); w.w = (unsigned)(unsigned short)r[2 * q + 1][2] | ((unsigned)(unsigned short)r[2 * q + 1][3] << 16);
                *(v4u*)(op + 8 * q) = w; } }
        else { int row = n; if (I.kind == 2) { const int jj = n >> 1; row = (jj >> 7) * 256 + (n & 1) * 128 + (jj & 127); }
            unsigned char* op = (unsigned char*)I.O + (size_t)row * D + I.k0 + 32 * g;
#pragma unroll
            for (int q = 0; q < 2; ++q) { v4u w; unsigned* wp = (unsigned*)&w;
#pragma unroll
                for (int j = 0; j < 4; ++j) { const s16x4 x = r[4 * q + j]; wp[j] = pk4_fp8(bf2f((bf16)x[0]) * WSCALE, bf2f((bf16)x[1]) * WSCALE, bf2f((bf16)x[2]) * WSCALE, bf2f((bf16)x[3]) * WSCALE); }
                *(v4u*)(op + 16 * q) = w; } } }
}
__device__ __forceinline__ void p0_phase(const Frame& F, CArgs* A) {
    LAS unsigned char* lds = F.lds; const int tid = F.tid, lane = F.lane, wave = F.wave, i = lane & 15, g = lane >> 4;
    constexpr int NITEMS = 8 * 25 + 8 * 8 + NEXP * 8 * 16 + NEXP * 8 * 8;
    { v4u z = {0u, 0u, 0u, 0u}; v4u* p = (v4u*)(((bf16*)(F.ws + WS_WIN)) + (size_t)PW * D); const int n16 = (PWP - PW) * D * 2 / 16;
      for (int i = F.bid * NTHREADS + F.tid; i < n16; i += F.G * NTHREADS) p[i] = z; }
    __syncthreads();
    LAS float* sl = (LAS float*)F.lds;
    LAS float* red = (LAS float*)(F.lds + 1024 * 20 * 4);
    bool filled = false;
    for (int it = F.bid; it < 6144 / 64; it += F.G) {
        if (!filled) {
            for (int i = F.tid; i < 17 * 1024; i += NTHREADS) { const int m = i >> 10, k = i & 1023; const float v = (m < 16) ? A->in[1][m * 1024 + k] : A->in[3][k]; sl[k * 20 + m] = v * __builtin_amdgcn_rcpf(1.0f + fexp(-v)); }
            filled = true; __syncthreads();
        }
        float a[17];
#pragma unroll
        for (int m = 0; m < 17; ++m) a[m] = 0.f;
        const int j = it * 64 + F.lane;
#pragma unroll 1
        for (int kb = 0; kb < 128; kb += 16) { float wv[16];
#pragma unroll
          for (int q = 0; q < 16; ++q) wv[q] = A->in[4][(size_t)(F.wave * 128 + kb + q) * 6144 + j];
#pragma unroll
          for (int q = 0; q < 16; ++q) { const int k = F.wave * 128 + kb + q; const float w = wv[q];
            const LAS float* sp = sl + k * 20;
            const f32x4 s0 = *(const LAS f32x4*)sp, s1 = *(const LAS f32x4*)(sp + 4), s2 = *(const LAS f32x4*)(sp + 8), s3 = *(const LAS f32x4*)(sp + 12); const float s4 = sp[16];
            a[0] += s0[0] * w; a[1] += s0[1] * w; a[2] += s0[2] * w; a[3] += s0[3] * w; a[4] += s1[0] * w; a[5] += s1[1] * w; a[6] += s1[2] * w; a[7] += s1[3] * w;
            a[8] += s2[0] * w; a[9] += s2[1] * w; a[10] += s2[2] * w; a[11] += s2[3] * w; a[12] += s3[0] * w; a[13] += s3[1] * w; a[14] += s3[2] * w; a[15] += s3[3] * w; a[16] += s4 * w; } }
#pragma unroll
        for (int m = 0; m < 17; ++m) red[(F.wave * 17 + m) * 64 + F.lane] = a[m];
        __syncthreads();
        for (int i = F.tid; i < 17 * 64; i += NTHREADS) { const int m = i >> 6, l = i & 63; float s = 0.f;
#pragma unroll
            for (int w = 0; w < 8; ++w) s += red[(w * 17 + m) * 64 + l];
            ((float*)(F.ws + WS_MOD))[(size_t)m * 6144 + it * 64 + l] = s + A->in[5][it * 64 + l]; }
        __syncthreads();
    }
    __syncthreads();
    int first = F.bid, stride = F.G, cnt = (NITEMS + F.G - 1) / F.G;
    if (F.G == 256) { if (F.bid >= 96) { first = F.bid - 96; stride = 160; cnt = 26; } else { first = 160 * 26 + F.bid; stride = 96; cnt = 24; } }
    static_assert(160 * 26 + 96 * 24 >= NITEMS, "P0 item split");
    f32x4 va[8], vb[8];
    if (first < NITEMS) { const P0Item I0 = p0_item(F, A, first); p0_load(I0, tid, va); }
    if (cnt > 1 && first + stride < NITEMS) { const P0Item I1 = p0_item(F, A, first + stride); p0_load(I1, tid, vb); }
#define P0_STEP(VCUR, k_) do { const int it_ = first + (k_) * stride; const P0Item I = p0_item(F, A, it_); \
        _Pragma("unroll") for (int q = 0; q < 8; ++q) { const int idx = tid + NTHREADS * q, k = idx >> 5, p = idx & 31; v2u w; w.x = pk2(VCUR[q][0], VCUR[q][1]); w.y = pk2(VCUR[q][2], VCUR[q][3]); \
            *(LAS v2u*)(lds + (k * P0_TS + 4 * p) * 2) = w; } \
        if ((k_) + 2 < cnt && it_ + 2 * stride < NITEMS) { const P0Item In = p0_item(F, A, it_ + 2 * stride); p0_load(In, tid, VCUR); } \
        LDS_BARRIER(); \
        p0_emit(I, lds, wave, i, g); \
        LDS_BARRIER(); } while (0)
#pragma unroll 1
    for (int k = 0; k < cnt && first + k * stride < NITEMS; k += 2) {
        P0_STEP(va, k);
        if (k + 1 < cnt && first + (k + 1) * stride < NITEMS) P0_STEP(vb, k + 1);
    }
#undef P0_STEP
}

__device__ __forceinline__ void p1_phase(const Frame& F, CArgs* A) {
    const int gw = F.bid * NWAVES + F.wave, NGW = F.G * NWAVES;
    for (int r0 = gw; r0 < NROWS; r0 += 2 * NGW) {
        const int r1 = r0 + NGW; const bool two = r1 < NROWS;
        const float* xa = (r0 < NLAT) ? A->in[0] + (size_t)r0 * D : A->in[2] + (size_t)(r0 - NLAT) * D;
        const float* xb = !two ? xa : ((r1 < NLAT) ? A->in[0] + (size_t)r1 * D : A->in[2] + (size_t)(r1 - NLAT) * D);
        f32x4 va[4], vb[4];
#pragma unroll
        for (int j = 0; j < 4; ++j) { va[j] = ((const f32x4*)xa)[F.lane + 64 * j]; vb[j] = ((const f32x4*)xb)[F.lane + 64 * j]; }
#pragma unroll
        for (int which = 0; which < 2; ++which) { if (which == 1 && !two) break;
            const int r = which ? r1 : r0; const int mrow = (r < NLAT) ? (r >> 12) : 16;
            const float* sh = ((float*)(F.ws + WS_MOD)) + (size_t)mrow * 6144; const float* sc = sh + 1024;
            float s = 0.f;
#pragma unroll
            for (int j = 0; j < 4; ++j) { const f32x4 v = which ? vb[j] : va[j]; s += (v.x * v.x + v.y * v.y) + (v.z * v.z + v.w * v.w); }
            const float rstd = 1.0f / sqrtf(wave_sum(s) * (1.f / D) + EPS);
            unsigned long long* o8 = (unsigned long long*)(((bf16*)(F.ws + WS_HN)) + (size_t)r * D) + F.lane;
#pragma unroll
            for (int j = 0; j < 4; ++j) { const int c4 = F.lane + 64 * j; const f32x4 v = which ? vb[j] : va[j]; const f32x4 w = ((const f32x4*)A->in[6])[c4], a = ((const f32x4*)sc)[c4], b = ((const f32x4*)sh)[c4];
                const f32x4 y = (v * rstd) * w * (a + 1.0f) + b;
                o8[64 * j] = (unsigned long long)pk2(y.x, y.y) | ((unsigned long long)pk2(y.z, y.w) << 32); } }
    }
}

constexpr int GL_ZL = 0;
constexpr int GL_BC = 8192;
constexpr int GL_TOT = GL_BC + 32768;
constexpr int GL_V = GL_TOT + 512;
constexpr int GL_A = GL_V + 64 * 136 * 2;
constexpr int GL_B = GL_A + 2 * 64 * 72 * 2;
constexpr int GL_P = GL_B + 2 * 64 * 72 * 2;
constexpr int GL_SS = GL_P + 64 * 72 * 2;
constexpr int GL_SEG = GL_SS + 512;
constexpr int GL_END = GL_SEG + 2048;
static_assert(GL_END <= RING_BYTES && (GL_V % 16) == 0 && (GL_A % 16) == 0 && (GL_B % 16) == 0 && (GL_P % 16) == 0, "GLA LDS map");

__device__ __forceinline__ s16x4 tr_read(unsigned lds_addr) { s16x4 r; asm volatile("ds_read_b64_tr_b16 %0, %1\n\ts_waitcnt lgkmcnt(0)" : "=&v"(r) : "v"(lds_addr) : "memory"); return r; }
__device__ __forceinline__ void v_frag2(LAS unsigned char* lds, int v0, int lane, bf16x8& f0, bf16x8& f1) {
    const int i = lane & 15, g = lane >> 4;
    const unsigned a0 = (unsigned)(uintptr_t)(lds + GL_V) + (unsigned)(((8 * g + (i >> 2)) * 136 + v0 + 4 * (i & 3)) * 2);
    s16x4 r0, r1, r2, r3;
    asm volatile("ds_read_b64_tr_b16 %0, %4\n\tds_read_b64_tr_b16 %1, %4 offset:1088\n\tds_read_b64_tr_b16 %2, %4 offset:8704\n\tds_read_b64_tr_b16 %3, %4 offset:9792\n\ts_waitcnt lgkmcnt(0)"
                 : "=&v"(r0), "=&v"(r1), "=&v"(r2), "=&v"(r3) : "v"(a0) : "memory");
    f0[0] = r0[0]; f0[1] = r0[1]; f0[2] = r0[2]; f0[3] = r0[3]; f0[4] = r1[0]; f0[5] = r1[1]; f0[6] = r1[2]; f0[7] = r1[3];
    f1[0] = r2[0]; f1[1] = r2[1]; f1[2] = r2[2]; f1[3] = r2[3]; f1[4] = r3[0]; f1[5] = r3[1]; f1[6] = r3[2]; f1[7] = r3[3];
}
__device__ __forceinline__ bf16x8 v_frag(LAS unsigned char* lds, int ks, int v0, int lane) {
    const int i = lane & 15, g = lane >> 4;
    const unsigned a0 = (unsigned)(uintptr_t)(lds + GL_V) + (unsigned)(((32 * ks + 8 * g + (i >> 2)) * 136 + v0 + 4 * (i & 3)) * 2);
    const s16x4 lo = tr_read(a0), hi = tr_read(a0 + 4 * 136 * 2);
    bf16x8 r; r[0] = lo[0]; r[1] = lo[1]; r[2] = lo[2]; r[3] = lo[3]; r[4] = hi[0]; r[5] = hi[1]; r[6] = hi[2]; r[7] = hi[3]; return r;
}
struct GlaRegs { v4u zw, vw[2]; };
__device__ __forceinline__ GlaRegs gla_load(const Frame& F, size_t prow, int h) {
    GlaRegs r; const int tid = F.tid; const bf16* P = (const bf16*)(F.ws + WS_P);
    { const int t = (tid & 255) >> 2, q = tid & 3; r.zw = *(const v4u*)(P + (prow + t) * PW + CAF + 8 * q); }
#pragma unroll
    for (int i = 0; i < 2; ++i) { const int pc = tid + i * NTHREADS, t = pc >> 4, c = pc & 15; r.vw[i] = *(const v4u*)(P + (prow + t) * PW + CV + h * 128 + c * 8); }
    return r;
}
__device__ __forceinline__ void gla_prep(const Frame& F, CArgs* A, const GlaRegs& R, int h) {
    LAS unsigned char* lds = F.lds; const int tid = F.tid;
    if (tid < 256) { const int t = tid >> 2, q = tid & 3; const v4u w = R.zw;
        LAS float* z = (LAS float*)(lds + GL_ZL) + (q >> 1) * 1024 + t * 16 + (q & 1) * 8;
        *(LAS f32x4*)z = (f32x4){bflo(w.x), bfhi(w.x), bflo(w.y), bfhi(w.y)}; *(LAS f32x4*)(z + 4) = (f32x4){bflo(w.z), bfhi(w.z), bflo(w.w), bfhi(w.w)}; }
#pragma unroll
    for (int i = 0; i < 2; ++i) { const int pc = tid + i * NTHREADS, t = pc >> 4, c = pc & 15; *(LAS v4u*)(lds + GL_V + (t * 136 + c * 8) * 2) = R.vw[i]; }
    __syncthreads();
    { const int dir = tid >> 8, seg = (tid >> 6) & 3, d = tid & 63;
      const float* up = dir ? A->in[10] : A->in[8]; const float bias = (dir ? A->in[11] : A->in[9])[h * 64 + d];
      float u[16];
#pragma unroll
      for (int r = 0; r < 16; ++r) u[r] = up[r * 256 + h * 64 + d];
      const LAS float* zl = (const LAS float*)(lds + GL_ZL) + dir * 1024; LAS float* bc = (LAS float*)(lds + GL_BC) + dir * 4096 + d;
      LAS float* sg = (LAS float*)(lds + GL_SEG) + dir * 256 + d;
      float c[16]; float cum = 0.f;
#pragma unroll
      for (int i = 0; i < 16; ++i) { const int t = seg * 16 + (dir ? 15 - i : i); const LAS float* zp = zl + t * 16;
          const f32x4 z0 = *(const LAS f32x4*)zp, z1 = *(const LAS f32x4*)(zp + 4), z2 = *(const LAS f32x4*)(zp + 8), z3 = *(const LAS f32x4*)(zp + 12);
          float z = bias + z0[0] * u[0] + z0[1] * u[1] + z0[2] * u[2] + z0[3] * u[3] + z1[0] * u[4] + z1[1] * u[5] + z1[2] * u[6] + z1[3] * u[7]
                         + z2[0] * u[8] + z2[1] * u[9] + z2[2] * u[10] + z2[3] * u[11] + z3[0] * u[12] + z3[1] * u[13] + z3[2] * u[14] + z3[3] * u[15];
          const float ls = fminf(z, 0.f) - __logf(1.0f + __expf(-fabsf(z)));
          cum += ls * (1.0f / 16.0f); c[i] = cum; }
      sg[seg * 64] = cum;
      __syncthreads();
      float off = 0.f, tot = 0.f;
#pragma unroll
      for (int s2 = 0; s2 < 4; ++s2) { const float v = sg[s2 * 64]; tot += v; off += (dir ? (s2 > seg) : (s2 < seg)) ? v : 0.f; }
#pragma unroll
      for (int i = 0; i < 16; ++i) { const int t = seg * 16 + (dir ? 15 - i : i); bc[t * 64] = off + c[i]; }
      if (seg == 0) ((LAS float*)(lds + GL_TOT))[dir * 64 + d] = tot; }
    __syncthreads();
}

__device__ __forceinline__ size_t chunk_row(int b, int cc) { return cc < 4 ? (size_t)NLAT + b * CTXL + cc * 64 : (size_t)b * SEQ + (cc - 4) * 64; }
__device__ __forceinline__ void p3_phase(const Frame& F, CArgs* A) {
    LAS unsigned char* lds = F.lds; const int tid = F.tid, lane = F.lane, wave = F.wave;
    GlaRegs cur; if (F.bid < NBATCH * NCC * 4) { const int bc0 = F.bid >> 2; cur = gla_load(F, chunk_row(bc0 / NCC, bc0 % NCC), F.bid & 3); }
    for (int it = F.bid; it < NBATCH * NCC * 4; it += F.G) {
        const int h = it & 3, bc = it >> 2, b = bc / NCC, cc = bc % NCC; const size_t prow = chunk_row(b, cc);
        GlaRegs nxt = cur; { const int itn = it + F.G; if (itn < NBATCH * NCC * 4) { const int bcn = itn >> 2; nxt = gla_load(F, chunk_row(bcn / NCC, bcn % NCC), itn & 3); } }
        float kf[8];
        { const int d = tid & 63, tg = tid >> 6;
#pragma unroll
          for (int j = 0; j < 8; ++j) kf[j] = bf2f(((bf16*)(F.ws + WS_P))[(prow + tg * 8 + j) * PW + CK + h * 64 + d]); }
        gla_prep(F, A, cur, h); cur = nxt;
        if (tid < 128) { const int dir = tid >> 6, d = tid & 63; ((float*)(F.ws + WS_DECAY))[(((size_t)dir * NBATCH + b) * NCC + cc) * 256 + h * 64 + d] = __expf(((const LAS float*)(lds + GL_TOT))[dir * 64 + d]); }
        { const int d = tid & 63, tg = tid >> 6;
#pragma unroll
          for (int dir = 0; dir < 2; ++dir) { const float tot = ((const LAS float*)(lds + GL_TOT))[dir * 64 + d]; const LAS float* bcp = (const LAS float*)(lds + GL_BC) + dir * 4096 + (tg * 8) * 64 + d; float s[8];
#pragma unroll
              for (int j = 0; j < 8; ++j) s[j] = kf[j] * __expf(tot - bcp[j * 64]);
              v4u w; w.x = pk2(s[0], s[1]); w.y = pk2(s[2], s[3]); w.z = pk2(s[4], s[5]); w.w = pk2(s[6], s[7]);
              *(LAS v4u*)(lds + GL_A + ((dir * 64 + d) * 72 + tg * 8) * 2) = w; } }
        __syncthreads();
        { const int dir = wave & 1, dt = wave >> 1, i = lane & 15, g = lane >> 4;
          bf16x8 af[2];
#pragma unroll
          for (int ks = 0; ks < 2; ++ks) af[ks] = *(const LAS bf16x8*)(lds + GL_A + ((dir * 64 + dt * 16 + i) * 72 + 32 * ks + 8 * g) * 2);
          bf16* kvp = ((bf16*)(F.ws + WS_KV)) + ((((size_t)dir * NBATCH + b) * NCC + cc) * 4 + h) * 8192;
#pragma unroll 2
          for (int vt = 0; vt < 8; ++vt) { f32x4 acc = {0.f, 0.f, 0.f, 0.f}; bf16x8 vf0, vf1; v_frag2(lds, vt * 16, lane, vf0, vf1);
              acc = __builtin_amdgcn_mfma_f32_16x16x32_bf16(af[0], vf0, acc, 0, 0, 0); acc = __builtin_amdgcn_mfma_f32_16x16x32_bf16(af[1], vf1, acc, 0, 0, 0);
              v2u w; w.x = pk2(acc[0], acc[1]); w.y = pk2(acc[2], acc[3]);
              *(v2u*)(kvp + (size_t)(vt * 16 + i) * 64 + dt * 16 + 4 * g) = w; } }
        __syncthreads();
    }
}

constexpr int G2_ZL = 0;
constexpr int G2_HT = 8192;
constexpr int G2_TOT = G2_HT + 4096;
constexpr int G2_A = G2_TOT + 1024;
constexpr int G2_B = G2_A + 256 * 72 * 2;
constexpr int G2_VS = 528;
static_assert(G2_B + 64 * G2_VS * 2 <= RING_BYTES && G2_B + 256 * 72 * 2 <= RING_BYTES && (G2_A % 16) == 0 && (G2_B % 16) == 0, "GLA v2 LDS map");
__device__ __forceinline__ void tr_frag2(unsigned tile_addr, int c0, int lane, bf16x8& f0, bf16x8& f1) {
    const int i = lane & 15, g = lane >> 4;
    const unsigned a0 = tile_addr + (unsigned)(((8 * g + (i >> 2)) * G2_VS + c0 + 4 * (i & 3)) * 2);
    s16x4 r0, r1, r2, r3;
    asm volatile("ds_read_b64_tr_b16 %0, %4\n\tds_read_b64_tr_b16 %1, %4 offset:4224\n\tds_read_b64_tr_b16 %2, %4 offset:33792\n\tds_read_b64_tr_b16 %3, %4 offset:38016\n\ts_waitcnt lgkmcnt(0)"
                 : "=&v"(r0), "=&v"(r1), "=&v"(r2), "=&v"(r3) : "v"(a0) : "memory");
    f0[0] = r0[0]; f0[1] = r0[1]; f0[2] = r0[2]; f0[3] = r0[3]; f0[4] = r1[0]; f0[5] = r1[1]; f0[6] = r1[2]; f0[7] = r1[3];
    f1[0] = r2[0]; f1[1] = r2[1]; f1[2] = r2[2]; f1[3] = r2[3]; f1[4] = r3[0]; f1[5] = r3[1]; f1[6] = r3[2]; f1[7] = r3[3];
}
static_assert(4 * G2_VS * 2 == 4224 && 32 * G2_VS * 2 == 33792 && 36 * G2_VS * 2 == 38016, "tr_frag2 offsets");
__device__ __forceinline__ float log_sigmoid16(float z) { return (fminf(z, 0.f) - __logf(1.0f + __expf(-fabsf(z)))) * (1.0f / 16.0f); }

__device__ __forceinline__ void p3v2_phase(const Frame& F, CArgs* A) {
    LAS unsigned char* lds = F.lds; const int tid = F.tid, lane = F.lane, wave = F.wave, i = lane & 15, g = lane >> 4;
    const int c = tid & 255, th = tid >> 8;
    const bf16* P = (const bf16*)(F.ws + WS_P);
#pragma unroll 1
    for (int it = F.bid; it < NBATCH * NCC; it += F.G) {
        const int b = it / NCC, cc = it % NCC; const size_t prow = chunk_row(b, cc);
        if (tid < 256) { const int t = tid >> 2, q = tid & 3; const v4u w = *(const v4u*)(P + (prow + t) * PW + CAF + 8 * q);
            LAS float* z = (LAS float*)(lds + G2_ZL) + (q >> 1) * 1024 + t * 16 + (q & 1) * 8;
            *(LAS f32x4*)z = (f32x4){bflo(w.x), bfhi(w.x), bflo(w.y), bfhi(w.y)}; *(LAS f32x4*)(z + 4) = (f32x4){bflo(w.z), bfhi(w.z), bflo(w.w), bfhi(w.w)}; }
#pragma unroll
        for (int j = 0; j < 8; ++j) { const int pc = tid + j * NTHREADS, t = pc >> 6, cv = pc & 63;
            *(LAS v4u*)(lds + G2_B + (t * G2_VS + cv * 8) * 2) = *(const v4u*)(P + (prow + t) * PW + CV + cv * 8); }
        float kk[32];
#pragma unroll
        for (int tl = 0; tl < 32; ++tl) kk[tl] = bf2f(P[(prow + th * 32 + tl) * PW + CK + c]);
        __syncthreads();
#pragma unroll
        for (int dir = 0; dir < 2; ++dir) {
            { const float* up = dir ? A->in[10] : A->in[8]; const float bias = (dir ? A->in[11] : A->in[9])[c];
              float u[16];
#pragma unroll
              for (int r = 0; r < 16; ++r) u[r] = up[r * 256 + c];
              const LAS float* zl = (const LAS float*)(lds + G2_ZL) + dir * 1024 + th * 512;
              float cl[32]; float cum = 0.f;
#pragma unroll
              for (int ii = 0; ii < 32; ++ii) { const int tl = dir ? 31 - ii : ii; const LAS float* zp = zl + tl * 16;
                  const f32x4 z0 = *(const LAS f32x4*)zp, z1 = *(const LAS f32x4*)(zp + 4), z2 = *(const LAS f32x4*)(zp + 8), z3 = *(const LAS f32x4*)(zp + 12);
                  const float z = bias + z0[0] * u[0] + z0[1] * u[1] + z0[2] * u[2] + z0[3] * u[3] + z1[0] * u[4] + z1[1] * u[5] + z1[2] * u[6] + z1[3] * u[7]
                                       + z2[0] * u[8] + z2[1] * u[9] + z2[2] * u[10] + z2[3] * u[11] + z3[0] * u[12] + z3[1] * u[13] + z3[2] * u[14] + z3[3] * u[15];
                  cum += log_sigmoid16(z); cl[tl] = cum; }
              LAS float* ht = (LAS float*)(lds + G2_HT) + dir * 512;
              ht[th * 256 + c] = cum;
              __syncthreads();
              const float other = ht[(1 - th) * 256 + c], tot = cum + other;
              const float off = (dir == 0) ? (th ? other : 0.f) : (th ? 0.f : other);
              if (th == 0) { ((LAS float*)(lds + G2_TOT))[c] = tot; ((float*)(F.ws + WS_DECAY))[(((size_t)dir * NBATCH + b) * NCC + cc) * 256 + c] = __expf(tot); }
#pragma unroll
              for (int j = 0; j < 4; ++j) { float e[8];
#pragma unroll
                  for (int q = 0; q < 8; ++q) e[q] = kk[8 * j + q] * __expf(-(off + cl[8 * j + q]));
                  v4u w; w.x = pk2(e[0], e[1]); w.y = pk2(e[2], e[3]); w.z = pk2(e[4], e[5]); w.w = pk2(e[6], e[7]);
                  *(LAS v4u*)(lds + G2_A + (c * 72 + th * 32 + 8 * j) * 2) = w; } }
            __syncthreads();
            { const int h = wave >> 1, vh = wave & 1;
              bf16x8 af[4][2];
#pragma unroll
              for (int dt = 0; dt < 4; ++dt)
#pragma unroll
                  for (int ks = 0; ks < 2; ++ks) af[dt][ks] = *(const LAS bf16x8*)(lds + G2_A + ((h * 64 + dt * 16 + i) * 72 + 32 * ks + 8 * g) * 2);
              f32x4 et[4];
#pragma unroll
              for (int dt = 0; dt < 4; ++dt) { const f32x4 tv = *(const LAS f32x4*)(lds + G2_TOT + (h * 64 + dt * 16 + 4 * g) * 4); et[dt] = (f32x4){__expf(tv[0]), __expf(tv[1]), __expf(tv[2]), __expf(tv[3])}; }
              bf16* kvp = ((bf16*)(F.ws + WS_KV)) + ((((size_t)dir * NBATCH + b) * NCC + cc) * 4 + h) * 8192;
              bf16* vtp = ((bf16*)(F.ws + WS_VT)) + (((size_t)b * 64 + (cc - 4)) * 4 + h) * 8192;
#pragma unroll
              for (int vt = 0; vt < 4; ++vt) { const int v0 = vh * 64 + vt * 16; bf16x8 vf0, vf1; tr_frag2((unsigned)(uintptr_t)(lds + G2_B), h * 128 + v0, lane, vf0, vf1);
                  if (dir == 0 && cc >= 4) { *(bf16x8*)(vtp + (size_t)(v0 + i) * 64 + 8 * g) = vf0; *(bf16x8*)(vtp + (size_t)(v0 + i) * 64 + 32 + 8 * g) = vf1; }
#pragma unroll
                  for (int dt = 0; dt < 4; ++dt) { f32x4 acc = {0.f, 0.f, 0.f, 0.f};
                      acc = __builtin_amdgcn_mfma_f32_16x16x32_bf16(af[dt][0], vf0, acc, 0, 0, 0); acc = __builtin_amdgcn_mfma_f32_16x16x32_bf16(af[dt][1], vf1, acc, 0, 0, 0);
                      acc = acc * et[dt];
                      v2u w; w.x = pk2(acc[0], acc[1]); w.y = pk2(acc[2], acc[3]);
                      *(v2u*)(kvp + (size_t)(v0 + i) * 64 + dt * 16 + 4 * g) = w; } } }
            __syncthreads();
        }
    }
}

struct GateConst { bf16x8 bw[2][2]; float bias[2][2]; };
__device__ __forceinline__ GateConst gate_setup(CArgs* A, int wave, int lane) {
    GateConst G; const int i = lane & 15, g = lane >> 4;
#pragma unroll
    for (int dir = 0; dir < 2; ++dir)
#pragma unroll
        for (int cti = 0; cti < 2; ++cti) { const int c = 32 * wave + 16 * cti + i; const float* up = dir ? A->in[10] : A->in[8];
            G.bias[dir][cti] = (dir ? A->in[11] : A->in[9])[c];
#pragma unroll
            for (int jj = 0; jj < 8; ++jj) { const float v = up[(8 * (g & 1) + jj) * 256 + c]; const unsigned hi = f2bf(v); const float rem = v - __builtin_bit_cast(float, hi << 16);
                G.bw[dir][cti][jj] = (short)((g < 2) ? hi : f2bf(rem)); } }
    return G;
}
__device__ __forceinline__ float log_sigmoid16_fast(float z) { const float e = __builtin_amdgcn_exp2f(fabsf(z) * -1.4426950409f); return (fminf(z, 0.f) - __builtin_amdgcn_logf(1.0f + e) * 0.6931471806f) * 0.0625f; }
__device__ __forceinline__ void gate_b(const GateConst& G, const bf16* P, size_t prow, int lane, f32x4 (&bv)[2][2][4], float (&tot)[2][2]) {
    const int i = lane & 15, g = lane >> 4;
    bf16x8 za[2][4];
#pragma unroll
    for (int dir = 0; dir < 2; ++dir)
#pragma unroll
        for (int tt = 0; tt < 4; ++tt) za[dir][tt] = *(const bf16x8*)(P + (prow + 16 * tt + i) * PW + CAF + 16 * dir + 8 * (g & 1));
#pragma unroll
    for (int dir = 0; dir < 2; ++dir)
#pragma unroll
        for (int cti = 0; cti < 2; ++cti) { float carry = 0.f;
#pragma unroll
            for (int q = 0; q < 4; ++q) { const int tt = dir ? 3 - q : q;
                f32x4 z = {0.f, 0.f, 0.f, 0.f}; z = __builtin_amdgcn_mfma_f32_16x16x32_bf16(za[dir][tt], G.bw[dir][cti], z, 0, 0, 0);
                float la[4];
#pragma unroll
                for (int r = 0; r < 4; ++r) la[r] = log_sigmoid16_fast(z[r] + G.bias[dir][cti]);
                float p[4];
                if (dir == 0) { p[0] = la[0]; p[1] = p[0] + la[1]; p[2] = p[1] + la[2]; p[3] = p[2] + la[3];
                    const float s = p[3]; float incl = s; const float t1 = __shfl_up(incl, 16); if (g >= 1) incl += t1; const float t2 = __shfl_up(incl, 32); if (g >= 2) incl += t2;
                    const float base = carry + (incl - s); carry += __shfl(incl, 48 + i);
                    bv[dir][cti][tt] = (f32x4){base + p[0], base + p[1], base + p[2], base + p[3]}; }
                else { p[3] = la[3]; p[2] = p[3] + la[2]; p[1] = p[2] + la[1]; p[0] = p[1] + la[0];
                    const float s = p[0]; float incl = s; const float t1 = __shfl_down(incl, 16); if (g <= 2) incl += t1; const float t2 = __shfl_down(incl, 32); if (g <= 1) incl += t2;
                    const float base = carry + (incl - s); carry += __shfl(incl, i);
                    bv[dir][cti][tt] = (f32x4){base + p[0], base + p[1], base + p[2], base + p[3]}; } }
            tot[dir][cti] = carry; }
}

constexpr int G3_ST = 0;
constexpr int G3_TOT = 8 * 16 * 144;
constexpr int G3_A = G3_TOT + 1024;
constexpr int G3_B = G3_A + 256 * 72 * 2;
static_assert(G3_B + 64 * G2_VS * 2 <= RING_BYTES && (G3_A % 16) == 0 && (G3_B % 16) == 0, "P3 LDS map");
template <int MODE>
__device__ __forceinline__ void p3v3_phase(const Frame& F, CArgs* A) {
    int tid_ = F.tid; asm volatile("" : "+v"(tid_));
    LAS unsigned char* lds = F.lds; const int tid = tid_, lane = tid & 63, wave = __builtin_amdgcn_readfirstlane(tid >> 6), i = lane & 15, g = lane >> 4;
    const bf16* P = (const bf16*)(F.ws + WS_P);
    const GateConst G = gate_setup(A, wave, lane);
    LAS unsigned char* st = lds + G3_ST + wave * (16 * 144);
#pragma unroll 1
    for (int it = F.bid; it < NBATCH * NCC; it += F.G) {
        const int b = it / NCC, cc = it % NCC; const size_t prow = chunk_row(b, cc);
        unsigned pf0 = 0u, pf1 = 0u;
#pragma unroll
        for (int j = 0; j < 8; ++j) { const int pc = tid + j * NTHREADS, t = pc >> 6, cv = pc & 63;
            *(LAS v4u*)(lds + G3_B + (t * G2_VS + cv * 8) * 2) = *(const v4u*)(P + (prow + t) * PW + CV + cv * 8); }
        unsigned kk[2][4][2];
#pragma unroll
        for (int cti = 0; cti < 2; ++cti)
#pragma unroll
            for (int tt = 0; tt < 4; ++tt)
#pragma unroll
                for (int r = 0; r < 4; r += 2) { const bf16* kp = P + (prow + 16 * tt + 4 * g + r) * PW + CK + 32 * wave + 16 * cti + i; kk[cti][tt][r >> 1] = (unsigned)kp[0] | ((unsigned)kp[PW] << 16); }
        f32x4 bv[2][2][4]; float tot[2][2];
        if (MODE < 4) gate_b(G, P, prow, lane, bv, tot); else {
#pragma unroll
            for (int a_ = 0; a_ < 2; ++a_)
#pragma unroll
                for (int b_ = 0; b_ < 2; ++b_) { tot[a_][b_] = 0.f;
#pragma unroll
                    for (int c_ = 0; c_ < 4; ++c_) bv[a_][b_][c_] = (f32x4){0.f, 0.f, 0.f, 0.f}; } }
#pragma unroll
        for (int dir = 0; dir < 2; ++dir) {
#pragma unroll
            for (int cti = 0; cti < 2; ++cti) { const int c = 32 * wave + 16 * cti + i;
#pragma unroll
                for (int tt = 0; tt < 4; ++tt) { float e[4];
#pragma unroll
                    for (int r = 0; r < 4; ++r) e[r] = ((r & 1) ? bfhi(kk[cti][tt][r >> 1]) : bflo(kk[cti][tt][r >> 1])) * __builtin_amdgcn_exp2f(bv[dir][cti][tt][r] * -1.4426950409f);
                    v2u w; w.x = pk2(e[0], e[1]); w.y = pk2(e[2], e[3]);
                    *(LAS v2u*)(lds + G3_A + (c * 72 + 16 * tt + 4 * g) * 2) = w; }
                if (g == 0) { ((LAS float*)(lds + G3_TOT))[c] = tot[dir][cti]; if (!MODE) ((float*)(F.ws + WS_DECAY))[(((size_t)dir * NBATCH + b) * NCC + cc) * 256 + c] = __expf(tot[dir][cti]); } }
            LDS_BARRIER();
            if (dir == 0) {
                const int itn = it + F.G; if (itn < NBATCH * NCC) { const char* pr = (const char*)(P + (chunk_row(itn / NCC, itn % NCC) + (tid >> 3)) * PW); const int j = tid & 7;
                    pf0 = *(const unsigned*)(pr + 512 + 128 * j); pf1 = *(const unsigned*)(pr + (j < 5 ? 512 + 128 * (8 + j) : 3072 + 32 * (j - 5))); } }
            if (MODE < 3) { const int h = wave >> 1, vh = wave & 1;
              bf16x8 af[4][2];
#pragma unroll
              for (int dt = 0; dt < 4; ++dt)
#pragma unroll
                  for (int ks = 0; ks < 2; ++ks) af[dt][ks] = *(const LAS bf16x8*)(lds + G3_A + ((h * 64 + dt * 16 + i) * 72 + 32 * ks + 8 * g) * 2);
              bf16* kvp = ((bf16*)(F.ws + WS_KV)) + ((((size_t)dir * NBATCH + b) * NCC + cc) * 4 + h) * 8192;
              bf16* vtp = ((bf16*)(F.ws + WS_VT)) + (((size_t)b * 64 + (cc - 4)) * 4 + h) * 8192;
              if (MODE) { kvp = ((bf16*)(F.ws + WS_TOTAL)) + (size_t)(F.bid * 8 + wave) * 512; vtp = kvp + 1024 * 1024; }
#pragma unroll
              for (int vt = 0; vt < 4; ++vt) { const int v0 = vh * 64 + vt * 16; bf16x8 vf0, vf1; tr_frag2((unsigned)(uintptr_t)(lds + G3_B), h * 128 + v0, lane, vf0, vf1);
                  if (dir == 0 && cc >= 4) {
                      *(LAS bf16x8*)(st + i * 144 + 16 * g) = vf0; *(LAS bf16x8*)(st + i * 144 + 64 + 16 * g) = vf1;
                      LDS_WAIT();
#pragma unroll
                      for (int j = 0; j < 2; ++j) { const int pc = lane + 64 * j, row = pc >> 3, ch = pc & 7; const v4u x_ = *(const LAS v4u*)(st + row * 144 + ch * 16); if (MODE == 2) asm volatile("" :: "v"(x_)); else *(v4u*)(vtp + (size_t)((MODE ? 0 : v0) + row) * 64 + ch * 8) = x_; }
                      LDS_WAIT(); }
#pragma unroll
                  for (int dt = 0; dt < 4; ++dt) { f32x4 acc = {0.f, 0.f, 0.f, 0.f};
                      acc = __builtin_amdgcn_mfma_f32_16x16x32_bf16(af[dt][0], vf0, acc, 0, 0, 0); acc = __builtin_amdgcn_mfma_f32_16x16x32_bf16(af[dt][1], vf1, acc, 0, 0, 0);
                      { const f32x4 tv = *(const LAS f32x4*)(lds + G3_TOT + (h * 64 + dt * 16 + 4 * g) * 4);
                        acc = acc * (f32x4){__builtin_amdgcn_exp2f(tv[0] * 1.4426950409f), __builtin_amdgcn_exp2f(tv[1] * 1.4426950409f), __builtin_amdgcn_exp2f(tv[2] * 1.4426950409f), __builtin_amdgcn_exp2f(tv[3] * 1.4426950409f)}; }
                      v2u w; w.x = pk2(acc[0], acc[1]); w.y = pk2(acc[2], acc[3]);
                      *(LAS v2u*)(st + i * 144 + (16 * dt + 4 * g) * 2) = w; }
                  LDS_WAIT();
#pragma unroll
                  for (int j = 0; j < 2; ++j) { const int pc = lane + 64 * j, row = pc >> 3, ch = pc & 7; const v4u x_ = *(const LAS v4u*)(st + row * 144 + ch * 16); if (MODE == 2) asm volatile("" :: "v"(x_)); else *(v4u*)(kvp + (size_t)((MODE ? 0 : v0) + row) * 64 + ch * 8) = x_; }
                  LDS_WAIT(); } }
            LDS_BARRIER();
        }
        asm volatile("" :: "v"(pf0), "v"(pf1));
    }
}

__device__ __forceinline__ void gate_b_dir(const GateConst& G, const bf16* P, size_t prow, int lane, int dir, f32x4 (&bv)[2][4]) {
    const int i = lane & 15, g = lane >> 4;
    bf16x8 za[4];
#pragma unroll
    for (int tt = 0; tt < 4; ++tt) za[tt] = *(const bf16x8*)(P + (prow + 16 * tt + i) * PW + CAF + 16 * dir + 8 * (g & 1));
#pragma unroll
    for (int cti = 0; cti < 2; ++cti) { float carry = 0.f;
#pragma unroll
        for (int q = 0; q < 4; ++q) { const int tt = dir ? 3 - q : q;
            f32x4 z = {0.f, 0.f, 0.f, 0.f}; z = __builtin_amdgcn_mfma_f32_16x16x32_bf16(za[tt], G.bw[dir][cti], z, 0, 0, 0);
            float la[4];
#pragma unroll
            for (int r = 0; r < 4; ++r) la[r] = log_sigmoid16_fast(z[r] + G.bias[dir][cti]);
            float p[4];
            if (dir == 0) { p[0] = la[0]; p[1] = p[0] + la[1]; p[2] = p[1] + la[2]; p[3] = p[2] + la[3];
                const float s = p[3]; float incl = s; const float t1 = __shfl_up(incl, 16); if (g >= 1) incl += t1; const float t2 = __shfl_up(incl, 32); if (g >= 2) incl += t2;
                const float base = carry + (incl - s); carry += __shfl(incl, 48 + i);
                bv[cti][tt] = (f32x4){base + p[0], base + p[1], base + p[2], base + p[3]}; }
            else { p[3] = la[3]; p[2] = p[3] + la[2]; p[1] = p[2] + la[1]; p[0] = p[1] + la[0];
                const float s = p[0]; float incl = s; const float t1 = __shfl_down(incl, 16); if (g <= 2) incl += t1; const float t2 = __shfl_down(incl, 32); if (g <= 1) incl += t2;
                const float base = carry + (incl - s); carry += __shfl(incl, i);
                bv[cti][tt] = (f32x4){base + p[0], base + p[1], base + p[2], base + p[3]}; } } }
}

constexpr int G5_Q = 0;
constexpr int G5_K = 4 * 64 * 72 * 2;
constexpr int G5_P = 2 * G5_K;
static_assert(G5_P + 4 * 64 * 72 * 2 <= RING_BYTES && 8 * 16 * 272 <= G5_K, "P5 LDS map");
template <int MODE>
__device__ __forceinline__ void p5av3_phase(const Frame& F, CArgs* A) {
    LAS unsigned char* lds = F.lds;
    const bf16* P = (const bf16*)(F.ws + WS_P);
    const GateConst G = gate_setup(A, F.wave, F.lane);
#pragma unroll 1
    for (int it = F.bid; it < NBATCH * 64; it += F.G) {
        int tid_ = F.tid; asm volatile("" : "+v"(tid_));
        const int tid = tid_, lane = tid & 63, wave = __builtin_amdgcn_readfirstlane(tid >> 6), i = lane & 15, g = lane >> 4;
        const int h = wave >> 1, half = wave & 1;
        LAS unsigned char* st = lds + G5_Q + wave * (16 * 272);
        const int b = it >> 6, n = it & 63; const size_t prow = (size_t)b * SEQ + n * 64;
        unsigned pfv[9];
#pragma unroll
        for (int q = 0; q < 9; ++q) pfv[q] = 0u;
        const int dh = 32 * half + i;
        f32x4 pdiag[2], oacc[2][8];
#pragma unroll
        for (int a = 0; a < 2; ++a) { pdiag[a] = (f32x4){0.f, 0.f, 0.f, 0.f};
#pragma unroll
            for (int q = 0; q < 8; ++q) oacc[a][q] = (f32x4){0.f, 0.f, 0.f, 0.f}; }
#pragma unroll
        for (int dir = 0; dir < (MODE >= 4 ? 0 : 2); ++dir) {
            { unsigned qk[2][4][4];
#pragma unroll
              for (int cti = 0; cti < 2; ++cti)
#pragma unroll
                  for (int tt = 0; tt < 4; ++tt)
#pragma unroll
                      for (int r = 0; r < 4; ++r) { const bf16* rp = P + (prow + 16 * tt + 4 * g + r) * PW + h * 64 + dh + 16 * cti; qk[cti][tt][r] = (unsigned)rp[CQ] | ((unsigned)rp[CK] << 16); }
              f32x4 bv[2][4]; gate_b_dir(G, P, prow, lane, dir, bv);
#pragma unroll
              for (int cti = 0; cti < 2; ++cti)
#pragma unroll
                  for (int tt = 0; tt < 4; ++tt)
#pragma unroll
                      for (int r = 0; r < 4; ++r) { const float e = __builtin_amdgcn_exp2f(bv[cti][tt][r] * 1.4426950409f); const unsigned w = qk[cti][tt][r];
                          const int off = ((h * 64 + 16 * tt + 4 * g + r) * 72 + dh + 16 * cti) * 2;
                          *(LAS bf16*)(lds + G5_Q + off) = (bf16)f2bf(bflo(w) * e * 0.125f); *(LAS bf16*)(lds + G5_K + off) = (bf16)f2bf(bfhi(w) * __builtin_amdgcn_rcpf(e)); } }
            LDS_BARRIER();
            if (MODE < 3) { bf16x8 qf[2][2];
#pragma unroll
              for (int tti = 0; tti < 2; ++tti)
#pragma unroll
                  for (int ks = 0; ks < 2; ++ks) qf[tti][ks] = *(const LAS bf16x8*)(lds + G5_Q + ((h * 64 + (2 * half + tti) * 16 + i) * 72 + 32 * ks + 8 * g) * 2);
              const bf16* sp = ((const bf16*)(F.ws + WS_S)) + ((((size_t)dir * NBATCH + b) * 64 + n) * 4 + h) * 8192 + (size_t)i * 64 + 8 * g;
#pragma unroll
              for (int st_ = 0; st_ < 4; ++st_) { const bf16x8 kf0 = *(const LAS bf16x8*)(lds + G5_K + ((h * 64 + st_ * 16 + i) * 72 + 8 * g) * 2), kf1 = *(const LAS bf16x8*)(lds + G5_K + ((h * 64 + st_ * 16 + i) * 72 + 32 + 8 * g) * 2);
#pragma unroll
                  for (int tti = 0; tti < 2; ++tti) { const int tt = 2 * half + tti;
                      if (dir == 0 ? (st_ <= tt) : (st_ >= tt)) { f32x4 a = {0.f, 0.f, 0.f, 0.f};
                          a = __builtin_amdgcn_mfma_f32_16x16x32_bf16(kf0, qf[tti][0], a, 0, 0, 0); a = __builtin_amdgcn_mfma_f32_16x16x32_bf16(kf1, qf[tti][1], a, 0, 0, 0);
                          const int t = tt * 16 + i, s0 = st_ * 16 + 4 * g;
                          if (st_ == tt) {
#pragma unroll
                              for (int r = 0; r < 4; ++r) pdiag[tti][r] += (dir == 0 ? (s0 + r <= t) : (s0 + r >= t)) ? a[r] : 0.f;
                              a = pdiag[tti]; }
                          if (st_ != tt || dir == 1) { v2u w; w.x = pk2(a[0], a[1]); w.y = pk2(a[2], a[3]);
                              *(LAS v2u*)(lds + G5_P + ((h * 64 + t) * 72 + s0) * 2) = w; } } } }
              bf16x8 sfr[4][2];
#pragma unroll
              for (int vt = 0; vt < 4; ++vt) { sfr[vt][0] = *(const bf16x8*)(sp + (size_t)vt * 1024); sfr[vt][1] = *(const bf16x8*)(sp + (size_t)vt * 1024 + 32); }
#pragma unroll
              for (int vt = 0; vt < 8; ++vt) {
#pragma unroll
                  for (int tti = 0; tti < 2; ++tti) { oacc[tti][vt] = __builtin_amdgcn_mfma_f32_16x16x32_bf16(sfr[vt & 3][0], qf[tti][0], oacc[tti][vt], 0, 0, 0); oacc[tti][vt] = __builtin_amdgcn_mfma_f32_16x16x32_bf16(sfr[vt & 3][1], qf[tti][1], oacc[tti][vt], 0, 0, 0); }
                  asm volatile("" : "+v"(oacc[0][vt]), "+v"(oacc[1][vt]) :: "memory");
                  if (vt < 4) { sfr[vt][0] = *(const bf16x8*)(sp + (size_t)(vt + 4) * 1024); sfr[vt][1] = *(const bf16x8*)(sp + (size_t)(vt + 4) * 1024 + 32); } } }
            LDS_BARRIER();
        }
        LDS_WAIT();
        if (MODE < 2) { bf16x8 pfr[2][2];
#pragma unroll
          for (int tti = 0; tti < 2; ++tti)
#pragma unroll
              for (int ks = 0; ks < 2; ++ks) pfr[tti][ks] = *(const LAS bf16x8*)(lds + G5_P + ((h * 64 + (2 * half + tti) * 16 + i) * 72 + 32 * ks + 8 * g) * 2);
          const bf16* vp = ((const bf16*)(F.ws + WS_VT)) + (((size_t)b * 64 + n) * 4 + h) * 8192 + (size_t)i * 64 + 8 * g;
          bf16x8 vfr[8][2];
#pragma unroll
          for (int vt = 0; vt < 8; ++vt) { vfr[vt][0] = *(const bf16x8*)(vp + (size_t)vt * 1024); vfr[vt][1] = *(const bf16x8*)(vp + (size_t)vt * 1024 + 32); }
#pragma unroll
          for (int vt = 0; vt < 8; ++vt)
#pragma unroll
              for (int tti = 0; tti < 2; ++tti) { oacc[tti][vt] = __builtin_amdgcn_mfma_f32_16x16x32_bf16(vfr[vt][0], pfr[tti][0], oacc[tti][vt], 0, 0, 0); oacc[tti][vt] = __builtin_amdgcn_mfma_f32_16x16x32_bf16(vfr[vt][1], pfr[tti][1], oacc[tti][vt], 0, 0, 0); } }
#pragma unroll
        for (int tti = 0; tti < (MODE >= 2 ? 0 : 2); ++tti) { const int t = (2 * half + tti) * 16 + i; float ss = 0.f;
#pragma unroll
            for (int vt = 0; vt < 8; ++vt) { const f32x4 a = oacc[tti][vt]; ss += (a[0] * a[0] + a[1] * a[1]) + (a[2] * a[2] + a[3] * a[3]); }
            ss += __shfl_xor(ss, 16); ss += __shfl_xor(ss, 32);
            const float rstd = 1.0f / sqrtf(ss * (1.0f / 128.0f) + EPS);
#pragma unroll
            for (int vt = 0; vt < 8; ++vt) { const int v = vt * 16 + 4 * g; const f32x4 gw = *(const f32x4*)(A->in[12] + v); const v2u rw = *(const v2u*)(P + (prow + t) * PW + CR + h * 128 + v);
                const float r[4] = {bflo(rw.x), bfhi(rw.x), bflo(rw.y), bfhi(rw.y)}; float y[4];
#pragma unroll
                for (int j = 0; j < 4; ++j) y[j] = oacc[tti][vt][j] * rstd * gw[j] * (r[j] * __builtin_amdgcn_rcpf(1.0f + __builtin_amdgcn_exp2f(r[j] * -1.4426950409f)));
                if (OUTPROJ_F8) *(LAS unsigned*)(st + i * 144 + v) = pk4_fp8(y[0], y[1], y[2], y[3]);
                else { v2u w; w.x = pk2(y[0], y[1]); w.y = pk2(y[2], y[3]);
                    *(LAS v2u*)(st + i * 272 + v * 2) = w; }
                if ((vt & 3) == 3) asm volatile("" ::: "memory"); }
            LDS_WAIT();
            if (OUTPROJ_F8) {
#pragma unroll
                for (int j = 0; j < 2; ++j) { const int pc = lane + 64 * j, row = pc >> 3, ch = pc & 7;
                    *(v4u*)(F.ws + WS_YMIX + (prow + (2 * half + tti) * 16 + row) * D + h * 128 + ch * 16) = *(const LAS v4u*)(st + row * 144 + ch * 16); } }
            else {
#pragma unroll
                for (int j = 0; j < 4; ++j) { const int pc = lane + 64 * j, row = pc >> 4, ch = pc & 15;
                    *(v4u*)(((bf16*)(F.ws + WS_YMIX)) + (prow + (2 * half + tti) * 16 + row) * D + h * 128 + ch * 8) = *(const LAS v4u*)(st + row * 272 + ch * 16); } }
            LDS_WAIT(); }
        if (MODE < 1) { const int c0 = (tid & 63) * 8, t0 = (tid >> 6) * 8;
            v4u cw[10], xw[10], bw[8];
#pragma unroll
            for (int q = 0; q < 10; ++q) { const int tt = t0 - 1 + q; cw[q] = (v4u){0u, 0u, 0u, 0u}; xw[q] = cw[q];
                if (tt >= 0 && tt < 64) { cw[q] = *(const v4u*)(P + (prow + tt) * PW + CPC + c0); xw[q] = *(const v4u*)(P + (prow + tt) * PW + CPX + c0); } }
#pragma unroll
            for (int q = 0; q < 8; ++q) bw[q] = *(const v4u*)(P + (prow + t0 + q) * PW + CPB + c0);
            f32x4 wv[3][2];
#pragma unroll
            for (int dt = 0; dt < 3; ++dt) { wv[dt][0] = *(const f32x4*)(A->in[13] + dt * 512 + c0); wv[dt][1] = *(const f32x4*)(A->in[13] + dt * 512 + c0 + 4); }
            { const int itn = it + F.G; if (itn < NBATCH * 64) { const int bn_ = itn >> 6, nn_ = itn & 63; const char* pr = (const char*)(P + ((size_t)bn_ * SEQ + nn_ * 64 + (tid >> 3)) * PW); const int j = tid & 7;
#pragma unroll
                  for (int q = 0; q < 6; ++q) { const int ln = j + 8 * q; const int off = ln < 8 ? 128 * ln : 2048 + 128 * (ln - 8); if (off < PW * 2) pfv[q] = *(const unsigned*)(pr + off); }
                  const char* sb = (const char*)(((const bf16*)(F.ws + WS_S)) + (((size_t)bn_ * 64 + nn_) * 4) * 8192) + (size_t)tid * 128;
                  pfv[6] = *(const unsigned*)sb; pfv[7] = *(const unsigned*)(sb + (size_t)NBATCH * 64 * 4 * 8192 * 2);
                  pfv[8] = *(const unsigned*)((const char*)(((const bf16*)(F.ws + WS_VT)) + (((size_t)bn_ * 64 + nn_) * 4) * 8192) + (size_t)tid * 128); } }
            f32x2 ov[8][4];
#pragma unroll
            for (int j = 0; j < 8; ++j)
#pragma unroll
                for (int p = 0; p < 4; ++p) ov[j][p] = (f32x2){0.f, 0.f};
            f32x2 w2[3][4];
#pragma unroll
            for (int dt = 0; dt < 3; ++dt) { w2[dt][0] = (f32x2){wv[dt][0][0], wv[dt][0][1]}; w2[dt][1] = (f32x2){wv[dt][0][2], wv[dt][0][3]}; w2[dt][2] = (f32x2){wv[dt][1][0], wv[dt][1][1]}; w2[dt][3] = (f32x2){wv[dt][1][2], wv[dt][1][3]}; }
#pragma unroll
            for (int q = 0; q < 10; ++q) { const v4u c_ = cw[q], x_ = xw[q]; f32x2 u[4];
                u[0] = (f32x2){bflo(c_.x), bfhi(c_.x)} * (f32x2){bflo(x_.x), bfhi(x_.x)}; u[1] = (f32x2){bflo(c_.y), bfhi(c_.y)} * (f32x2){bflo(x_.y), bfhi(x_.y)};
                u[2] = (f32x2){bflo(c_.z), bfhi(c_.z)} * (f32x2){bflo(x_.z), bfhi(x_.z)}; u[3] = (f32x2){bflo(c_.w), bfhi(c_.w)} * (f32x2){bflo(x_.w), bfhi(x_.w)};
#pragma unroll
                for (int dt = 0; dt < 3; ++dt) { const int j = q - dt;
                    if (j >= 0 && j < 8) {
#pragma unroll
                        for (int p = 0; p < 4; ++p) ov[j][p] += w2[dt][p] * u[p]; } } }
#pragma unroll
            for (int q = 0; q < 8; ++q) { const v4u b_ = bw[q];
                const f32x2 y0 = ov[q][0] * (f32x2){bflo(b_.x), bfhi(b_.x)}, y1 = ov[q][1] * (f32x2){bflo(b_.y), bfhi(b_.y)}, y2 = ov[q][2] * (f32x2){bflo(b_.z), bfhi(b_.z)}, y3 = ov[q][3] * (f32x2){bflo(b_.w), bfhi(b_.w)};
                if (OUTPROJ_F8) { v2u w; w.x = pk4_fp8(y0.x, y0.y, y1.x, y1.y); w.y = pk4_fp8(y2.x, y2.y, y3.x, y3.y);
                    *(v2u*)(F.ws + WS_YMIX + (prow + t0 + q) * D + 512 + c0) = w; }
                else { v4u w; w.x = pk2(y0.x, y0.y); w.y = pk2(y1.x, y1.y); w.z = pk2(y2.x, y2.y); w.w = pk2(y3.x, y3.y);
                    *(v4u*)(((bf16*)(F.ws + WS_YMIX)) + (prow + t0 + q) * D + 512 + c0) = w; } } }
#pragma unroll
        for (int q = 0; q < 9; ++q) asm volatile("" :: "v"(pfv[q]));
        LDS_BARRIER();
    }
}

__device__ __forceinline__ void p4_phase(const Frame& F, CArgs* A) {
    for (int idx = F.bid * NTHREADS + F.tid; idx < 2 * NBATCH * 4 * 1024; idx += F.G * NTHREADS) {
        const int e8 = idx & 1023, ch = idx >> 10, h = ch & 3, b = (ch >> 2) & 15, dir = ch >> 6; const int d0 = (e8 & 7) * 8;
        float s[8];
#pragma unroll
        for (int j = 0; j < 8; ++j) s[j] = 0.f;
#pragma unroll 17
        for (int st = 0; st < NCC; ++st) {
            const int cc = dir ? (st < 4 ? 3 - st : 71 - st) : st;
            const size_t ci = ((size_t)dir * NBATCH + b) * NCC + cc;
            const v4u kv = *(const v4u*)(((bf16*)(F.ws + WS_KV)) + (ci * 4 + h) * 8192 + (size_t)e8 * 8);
            const f32x4 dc0 = *(const f32x4*)(((float*)(F.ws + WS_DECAY)) + ci * 256 + h * 64 + d0), dc1 = *(const f32x4*)(((float*)(F.ws + WS_DECAY)) + ci * 256 + h * 64 + d0 + 4);
            if (cc >= 4) { v4u w; w.x = pk2(s[0], s[1]); w.y = pk2(s[2], s[3]); w.z = pk2(s[4], s[5]); w.w = pk2(s[6], s[7]);
                *(v4u*)(((bf16*)(F.ws + WS_S)) + ((((size_t)dir * NBATCH + b) * 64 + (cc - 4)) * 4 + h) * 8192 + (size_t)e8 * 8) = w; }
            s[0] = s[0] * dc0[0] + bflo(kv.x); s[1] = s[1] * dc0[1] + bfhi(kv.x); s[2] = s[2] * dc0[2] + bflo(kv.y); s[3] = s[3] * dc0[3] + bfhi(kv.y);
            s[4] = s[4] * dc1[0] + bflo(kv.z); s[5] = s[5] * dc1[1] + bfhi(kv.z); s[6] = s[6] * dc1[2] + bflo(kv.w); s[7] = s[7] * dc1[3] + bfhi(kv.w);
        }
    }
}

__device__ __forceinline__ void p5a_phase(const Frame& F, CArgs* A) {
    LAS unsigned char* lds = F.lds; const int tid = F.tid, lane = F.lane, wave = F.wave, i = lane & 15, g = lane >> 4;
    GlaRegs cur; if (F.bid < NBATCH * 64 * 4) cur = gla_load(F, (size_t)(F.bid >> 2) * 64, F.bid & 3);
    f32x4 gw[4];
#pragma unroll
    for (int k = 0; k < 4; ++k) gw[k] = *(const f32x4*)(A->in[12] + ((wave >> 2) * 4 + k) * 16 + 4 * g);
    for (int it = F.bid; it < NBATCH * 64 * 4; it += F.G) {
        const int h = it & 3, bn = it >> 2, b = bn >> 6, n = bn & 63; const size_t prow = (size_t)b * SEQ + n * 64;
        GlaRegs nxt = cur; { const int itn = it + F.G; if (itn < NBATCH * 64 * 4) nxt = gla_load(F, (size_t)(itn >> 2) * 64, itn & 3); }
        v4u qw, kw; { const int t = tid >> 3, d0 = (tid & 7) * 8; qw = *(const v4u*)(((bf16*)(F.ws + WS_P)) + (prow + t) * PW + CQ + h * 64 + d0); kw = *(const v4u*)(((bf16*)(F.ws + WS_P)) + (prow + t) * PW + CK + h * 64 + d0); }
        gla_prep(F, A, cur, h); cur = nxt;
        bf16x8 sfr[4][2][2]; v2u rwv[4];
        { const int tt = wave & 3, vh = wave >> 2, t = tt * 16 + i;
#pragma unroll
          for (int k = 0; k < 4; ++k) { const int vt = vh * 4 + k;
#pragma unroll
              for (int dir = 0; dir < 2; ++dir) { const bf16* sp = ((bf16*)(F.ws + WS_S)) + ((((size_t)dir * NBATCH + b) * 64 + n) * 4 + h) * 8192 + (size_t)(vt * 16 + i) * 64 + 8 * g;
                  sfr[k][dir][0] = *(const bf16x8*)sp; sfr[k][dir][1] = *(const bf16x8*)(sp + 32); }
              rwv[k] = *(const v2u*)(((bf16*)(F.ws + WS_P)) + (prow + t) * PW + CR + h * 128 + vt * 16 + 4 * g); } }
        { const int t = tid >> 3, d0 = (tid & 7) * 8;
          const float q[8] = {bflo(qw.x), bfhi(qw.x), bflo(qw.y), bfhi(qw.y), bflo(qw.z), bfhi(qw.z), bflo(qw.w), bfhi(qw.w)};
          const float k[8] = {bflo(kw.x), bfhi(kw.x), bflo(kw.y), bfhi(kw.y), bflo(kw.z), bfhi(kw.z), bflo(kw.w), bfhi(kw.w)};
#pragma unroll
          for (int dir = 0; dir < 2; ++dir) { const LAS float* bp = (const LAS float*)(lds + GL_BC) + dir * 4096 + t * 64 + d0;
              const f32x4 b0 = *(const LAS f32x4*)bp, b1 = *(const LAS f32x4*)(bp + 4); const float bb[8] = {b0[0], b0[1], b0[2], b0[3], b1[0], b1[1], b1[2], b1[3]};
              float qd[8], ki[8];
#pragma unroll
              for (int j = 0; j < 8; ++j) { qd[j] = q[j] * __expf(bb[j]) * 0.125f; ki[j] = k[j] * __expf(-bb[j]); }
              v4u w; w.x = pk2(qd[0], qd[1]); w.y = pk2(qd[2], qd[3]); w.z = pk2(qd[4], qd[5]); w.w = pk2(qd[6], qd[7]);
              *(LAS v4u*)(lds + GL_A + ((dir * 64 + t) * 72 + d0) * 2) = w;
              w.x = pk2(ki[0], ki[1]); w.y = pk2(ki[2], ki[3]); w.z = pk2(ki[4], ki[5]); w.w = pk2(ki[6], ki[7]);
              *(LAS v4u*)(lds + GL_B + ((dir * 64 + t) * 72 + d0) * 2) = w; } }
        __syncthreads();
#pragma unroll
        for (int kk = 0; kk < 2; ++kk) { const int pi = wave * 2 + kk, tt = pi >> 2, st = pi & 3;
            f32x4 aF = {0.f, 0.f, 0.f, 0.f}, aB = {0.f, 0.f, 0.f, 0.f};
            if (st <= tt) {
#pragma unroll
                for (int ks = 0; ks < 2; ++ks) { const bf16x8 kf = *(const LAS bf16x8*)(lds + GL_B + ((st * 16 + i) * 72 + 32 * ks + 8 * g) * 2), qf = *(const LAS bf16x8*)(lds + GL_A + ((tt * 16 + i) * 72 + 32 * ks + 8 * g) * 2);
                    aF = __builtin_amdgcn_mfma_f32_16x16x32_bf16(kf, qf, aF, 0, 0, 0); } }
            if (st >= tt) {
#pragma unroll
                for (int ks = 0; ks < 2; ++ks) { const bf16x8 kf = *(const LAS bf16x8*)(lds + GL_B + ((64 + st * 16 + i) * 72 + 32 * ks + 8 * g) * 2), qf = *(const LAS bf16x8*)(lds + GL_A + ((64 + tt * 16 + i) * 72 + 32 * ks + 8 * g) * 2);
                    aB = __builtin_amdgcn_mfma_f32_16x16x32_bf16(kf, qf, aB, 0, 0, 0); } }
            const int t = tt * 16 + i, s0 = st * 16 + 4 * g; float p[4];
#pragma unroll
            for (int r = 0; r < 4; ++r) p[r] = ((s0 + r <= t) ? aF[r] : 0.f) + ((s0 + r >= t) ? aB[r] : 0.f);
            v2u w; w.x = pk2(p[0], p[1]); w.y = pk2(p[2], p[3]);
            *(LAS v2u*)(lds + GL_P + (t * 72 + s0) * 2) = w; }
        __syncthreads();
        { const int tt = wave & 3, vh = wave >> 2; const int t = tt * 16 + i;
          bf16x8 pf[2], qf[2][2];
#pragma unroll
          for (int ks = 0; ks < 2; ++ks) { pf[ks] = *(const LAS bf16x8*)(lds + GL_P + (t * 72 + 32 * ks + 8 * g) * 2);
              qf[0][ks] = *(const LAS bf16x8*)(lds + GL_A + (t * 72 + 32 * ks + 8 * g) * 2); qf[1][ks] = *(const LAS bf16x8*)(lds + GL_A + ((64 + t) * 72 + 32 * ks + 8 * g) * 2); }
          f32x4 acc[4]; float ss = 0.f;
#pragma unroll
          for (int k = 0; k < 4; ++k) { const int vt = vh * 4 + k; f32x4 a = {0.f, 0.f, 0.f, 0.f};
              { bf16x8 vf0, vf1; v_frag2(lds, vt * 16, lane, vf0, vf1); a = __builtin_amdgcn_mfma_f32_16x16x32_bf16(vf0, pf[0], a, 0, 0, 0); a = __builtin_amdgcn_mfma_f32_16x16x32_bf16(vf1, pf[1], a, 0, 0, 0); }
#pragma unroll
              for (int dir = 0; dir < 2; ++dir)
#pragma unroll
                  for (int ks = 0; ks < 2; ++ks) a = __builtin_amdgcn_mfma_f32_16x16x32_bf16(sfr[k][dir][ks], qf[dir][ks], a, 0, 0, 0);
              acc[k] = a; ss += (a[0] * a[0] + a[1] * a[1]) + (a[2] * a[2] + a[3] * a[3]); }
          ss += __shfl_xor(ss, 16); ss += __shfl_xor(ss, 32);
          if (g == 0) ((LAS float*)(lds + GL_SS))[vh * 64 + t] = ss;
          __syncthreads();
          const float tot = ((const LAS float*)(lds + GL_SS))[t] + ((const LAS float*)(lds + GL_SS))[64 + t];
          const float rstd = 1.0f / sqrtf(tot * (1.0f / 128.0f) + EPS);
#pragma unroll
          for (int k = 0; k < 4; ++k) { const int v = (vh * 4 + k) * 16 + 4 * g;
              const v2u rw = rwv[k];
              const float r[4] = {bflo(rw.x), bfhi(rw.x), bflo(rw.y), bfhi(rw.y)}; float y[4];
#pragma unroll
              for (int j = 0; j < 4; ++j) y[j] = acc[k][j] * rstd * gw[k][j] * (r[j] * __builtin_amdgcn_rcpf(1.0f + __expf(-r[j])));
              v2u w; w.x = pk2(y[0], y[1]); w.y = pk2(y[2], y[3]);
              *(v2u*)(((bf16*)(F.ws + WS_YMIX)) + (prow + t) * D + h * 128 + v) = w; } }
        __syncthreads();
    }
    for (int it = F.bid; it < NBATCH * 64; it += F.G) {
        const size_t prow = (size_t)it * 64;
#pragma unroll 1
        for (int rep = 0; rep < 8; ++rep) { const int idx = tid + rep * NTHREADS, t = idx >> 6, c0 = (idx & 63) * 8;
            float cv[8];
#pragma unroll
            for (int j = 0; j < 8; ++j) cv[j] = 0.f;
#pragma unroll
            for (int dt = -1; dt <= 1; ++dt) { const int tt = t + dt; if (tt >= 0 && tt < 64) {
                const v4u cw = *(const v4u*)(((bf16*)(F.ws + WS_P)) + (prow + tt) * PW + CPC + c0), xw = *(const v4u*)(((bf16*)(F.ws + WS_P)) + (prow + tt) * PW + CPX + c0);
                const f32x4 w0 = *(const f32x4*)(A->in[13] + (dt + 1) * 512 + c0), w1 = *(const f32x4*)(A->in[13] + (dt + 1) * 512 + c0 + 4);
                cv[0] += w0[0] * bflo(cw.x) * bflo(xw.x); cv[1] += w0[1] * bfhi(cw.x) * bfhi(xw.x); cv[2] += w0[2] * bflo(cw.y) * bflo(xw.y); cv[3] += w0[3] * bfhi(cw.y) * bfhi(xw.y);
                cv[4] += w1[0] * bflo(cw.z) * bflo(xw.z); cv[5] += w1[1] * bfhi(cw.z) * bfhi(xw.z); cv[6] += w1[2] * bflo(cw.w) * bflo(xw.w); cv[7] += w1[3] * bfhi(cw.w) * bfhi(xw.w); } }
            const v4u bw = *(const v4u*)(((bf16*)(F.ws + WS_P)) + (prow + t) * PW + CPB + c0);
            v4u w; w.x = pk2(cv[0] * bflo(bw.x), cv[1] * bfhi(bw.x)); w.y = pk2(cv[2] * bflo(bw.y), cv[3] * bfhi(bw.y)); w.z = pk2(cv[4] * bflo(bw.z), cv[5] * bfhi(bw.z)); w.w = pk2(cv[6] * bflo(bw.w), cv[7] * bfhi(bw.w));
            *(v4u*)(((bf16*)(F.ws + WS_YMIX)) + (prow + t) * D + 512 + c0) = w; }
    }
}

constexpr int RT_W = 0;
constexpr int RT_LG = 32 * 1032 * 2;
constexpr int RT_HIST = RT_LG + 128 * 33 * 4;
constexpr int RT_WC = RT_HIST + 256;
__device__ __forceinline__ void p5c_phase(const Frame& F, CArgs* A) {
    LAS unsigned char* lds = F.lds; const int tid = F.tid, lane = F.lane, wave = F.wave, i = lane & 15, g = lane >> 4;
#pragma unroll 1
    for (int i0 = 0; i0 < 32768; i0 += 16 * NTHREADS) { float rv[16];
#pragma unroll
        for (int q = 0; q < 16; ++q) rv[q] = A->in[16][i0 + q * NTHREADS + tid];
#pragma unroll
        for (int q = 0; q < 16; ++q) { const int idx = i0 + q * NTHREADS + tid, k = idx >> 5, e = idx & 31; *(LAS bf16*)(lds + RT_W + (e * 1032 + k) * 2) = (bf16)f2bf(rv[q]); } }
    LAS int* hist = (LAS int*)(lds + RT_HIST); LAS float* lg = (LAS float*)(lds + RT_LG);
    unsigned* gcnt = ((unsigned*)(F.ws + WS_CTL)) + CW_CNT;
    __syncthreads();
#pragma unroll 1
    for (int it = F.bid; it < NLAT / 128; it += F.G) {
        const int R = it * 128 + wave * 16 + i, b = it >> 5;
        const bf16* yg = ((const bf16*)(F.ws + WS_Y1)) + (size_t)R * D + 8 * g;
        unsigned char* hn2g = (unsigned char*)F.out + DO_HN2 + (size_t)R * D + 8 * g;
        const LAS unsigned char* rw0 = lds + RT_W + (i * 1032 + 8 * g) * 2; const LAS unsigned char* rw1 = rw0 + 16 * 1032 * 2;
        if (tid < 32) hist[tid] = 0;
        { const int c0 = 2 * tid; const f32x2 w_ = *(const f32x2*)(A->in[15] + c0), c_ = *(const f32x2*)(((float*)(F.ws + WS_MOD)) + (size_t)b * 6144 + 4096 + c0), s_ = *(const f32x2*)(((float*)(F.ws + WS_MOD)) + (size_t)b * 6144 + 3072 + c0);
          *(LAS f32x2*)(lds + RT_WC + c0 * 4) = w_ * (c_ + 1.0f); *(LAS f32x2*)(lds + RT_WC + 4096 + c0 * 4) = s_; }
        v4u yv[32];
#pragma unroll
        for (int ks = 0; ks < 32; ++ks) yv[ks] = *(const v4u*)(yg + 32 * ks);
        float ss = 0.f;
#pragma unroll
        for (int ks = 0; ks < 32; ++ks) { const v4u yw = yv[ks];
            const float h0 = bflo(yw.x), h1 = bfhi(yw.x), h2 = bflo(yw.y), h3 = bfhi(yw.y), h4 = bflo(yw.z), h5 = bfhi(yw.z), h6 = bflo(yw.w), h7 = bfhi(yw.w);
            ss += (h0 * h0 + h1 * h1) + (h2 * h2 + h3 * h3) + (h4 * h4 + h5 * h5) + (h6 * h6 + h7 * h7); }
        ss += __shfl_xor(ss, 16); ss += __shfl_xor(ss, 32);
        const float rstd = 1.0f / sqrtf(ss * (1.f / D) + EPS);
#pragma unroll
        for (int ks = 0; ks < 32; ++ks) asm volatile("" : "+v"(yv[ks]));
        LDS_BARRIER();
        f32x4 l0 = {0.f, 0.f, 0.f, 0.f}, l1 = {0.f, 0.f, 0.f, 0.f};
        const LAS unsigned char* wcg = lds + RT_WC + 32 * g;
#pragma unroll
        for (int ks = 0; ks < 32; ++ks) {
            const v4u yw = yv[ks];
            const f32x4 a0 = {bflo(yw.x), bfhi(yw.x), bflo(yw.y), bfhi(yw.y)}, a1 = {bflo(yw.z), bfhi(yw.z), bflo(yw.w), bfhi(yw.w)};
            const f32x4 c0 = *(const LAS f32x4*)(wcg + 128 * ks), c1 = *(const LAS f32x4*)(wcg + 128 * ks + 16), s0 = *(const LAS f32x4*)(wcg + 4096 + 128 * ks), s1 = *(const LAS f32x4*)(wcg + 4096 + 128 * ks + 16);
            const f32x4 y0 = (a0 * rstd) * c0 + s0, y1 = (a1 * rstd) * c1 + s1;
            v4u w; w.x = pk2(y0[0], y0[1]); w.y = pk2(y0[2], y0[3]); w.z = pk2(y1[0], y1[1]); w.w = pk2(y1[2], y1[3]);
            { v2u w8; w8.x = pk4_fp8(y0[0], y0[1], y0[2], y0[3]); w8.y = pk4_fp8(y1[0], y1[1], y1[2], y1[3]); *(v2u*)(hn2g + 32 * ks) = w8; }
            const bf16x8 af = __builtin_bit_cast(bf16x8, w);
            const bf16x8 r0 = *(const LAS bf16x8*)(rw0 + 64 * ks), r1 = *(const LAS bf16x8*)(rw1 + 64 * ks);
            l0 = __builtin_amdgcn_mfma_f32_16x16x32_bf16(af, r0, l0, 0, 0, 0); l1 = __builtin_amdgcn_mfma_f32_16x16x32_bf16(af, r1, l1, 0, 0, 0);
            asm volatile("" : "+v"(l0), "+v"(l1) :: "memory"); }
        { const float rb0 = A->in[17][i], rb1 = A->in[17][16 + i];
#pragma unroll
          for (int r = 0; r < 4; ++r) { lg[(wave * 16 + 4 * g + r) * 33 + i] = l0[r] + rb0; lg[(wave * 16 + 4 * g + r) * 33 + 16 + i] = l1[r] + rb1; } }
        __syncthreads();
        int te[4] = {0, 0, 0, 0}; float tv[4] = {-3.0e38f, -3.0e38f, -3.0e38f, -3.0e38f}; int lp[4] = {0, 0, 0, 0};
        if (lane < 16) { const LAS float* lr = lg + (wave * 16 + lane) * 33;
            for (int e = 0; e < 32; ++e) { const float x = lr[e];
                if (x > tv[3]) { if (x > tv[2]) { tv[3] = tv[2]; te[3] = te[2]; if (x > tv[1]) { tv[2] = tv[1]; te[2] = te[1]; if (x > tv[0]) { tv[1] = tv[0]; te[1] = te[0]; tv[0] = x; te[0] = e; } else { tv[1] = x; te[1] = e; } } else { tv[2] = x; te[2] = e; } } else { tv[3] = x; te[3] = e; } } }
            const float e1 = __expf(tv[1] - tv[0]), e2 = __expf(tv[2] - tv[0]), e3 = __expf(tv[3] - tv[0]), inv = 1.0f / (1.0f + e1 + e2 + e3);
            tv[0] = inv; tv[1] = e1 * inv; tv[2] = e2 * inv; tv[3] = e3 * inv;
#pragma unroll
            for (int k = 0; k < 4; ++k) lp[k] = __hip_atomic_fetch_add(&hist[te[k]], 1, __ATOMIC_RELAXED, __HIP_MEMORY_SCOPE_WORKGROUP); }
        __syncthreads();
        if (tid < 32) { const int c = hist[tid]; hist[32 + tid] = c ? (int)__hip_atomic_fetch_add(gcnt + tid, (unsigned)c, RLX_AGENT) : 0; }
        __syncthreads();
        if (lane < 16) { const int Rt = it * 128 + wave * 16 + lane;
#pragma unroll
            for (int k = 0; k < 4; ++k) { const size_t pos = (size_t)te[k] * LISTCAP + hist[32 + te[k]] + lp[k]; ((int*)((unsigned char*)F.out + DO_LAID))[pos] = Rt * 4 + k;
                ((int*)(F.ws + WS_TSLOT))[Rt * 4 + k] = (te[k] << 20) | (hist[32 + te[k]] + lp[k]); ((float*)(F.ws + WS_TW))[Rt * 4 + k] = tv[k]; } }
        __syncthreads();
    }
}

__device__ __forceinline__ void p8_phase(const Frame& F, CArgs* A, const LAS int* TS) {
    const int gw = F.bid * NWAVES + F.wave, NGW = F.G * NWAVES;
    for (int r0 = gw; r0 < NLAT; r0 += 2 * NGW) {
        const int r1 = (r0 + NGW < NLAT) ? r0 + NGW : r0; const bool two = r0 + NGW < NLAT;
        int ep[2][4]; float wk[2][4];
#pragma unroll
        for (int a = 0; a < 2; ++a) { const int r = a ? r1 : r0;
#pragma unroll
            for (int k = 0; k < 4; ++k) { ep[a][k] = ((const int*)(F.ws + WS_TSLOT))[r * 4 + k]; wk[a][k] = ((const float*)(F.ws + WS_TW))[r * 4 + k]; } }
        int yw8[2][4][4]; v2u hw[2][4];
#pragma unroll
        for (int a = 0; a < 2; ++a) { const int r = a ? r1 : r0; const bf16* yr = ((const bf16*)(F.ws + WS_Y1)) + (size_t)r * D;
#pragma unroll
            for (int k = 0; k < 4; ++k) { const int* ys = (const int*)((const unsigned char*)(F.ws + WS_YA) + ((size_t)TS[ep[a][k] >> 20] * 256 + (ep[a][k] & 0xFFFFF)) * D);
#pragma unroll
                for (int j = 0; j < 4; ++j) yw8[a][k][j] = ys[F.lane + 64 * j]; }
#pragma unroll
            for (int j = 0; j < 4; ++j) hw[a][j] = ((const v2u*)yr)[F.lane + 64 * j]; }
#pragma unroll
        for (int a = 0; a < 2; ++a) { if (a == 1 && !two) break;
            const int r = a ? r1 : r0; float* hr = F.out + (size_t)r * D; const float* g2 = ((float*)(F.ws + WS_MOD)) + (size_t)(r >> 12) * 6144 + 5120;
            f32x4 v[4]; float s = 0.f;
#pragma unroll
            for (int j = 0; j < 4; ++j) { const int c4 = F.lane + 64 * j; f32x4 y = {0.f, 0.f, 0.f, 0.f};
#pragma unroll
                for (int k = 0; k < 4; ++k) { const int w = yw8[a][k][j]; const f32x2 lo = __builtin_amdgcn_cvt_pk_f32_fp8(w, false), hi = __builtin_amdgcn_cvt_pk_f32_fp8(w, true);
                    y[0] += wk[a][k] * lo[0]; y[1] += wk[a][k] * lo[1]; y[2] += wk[a][k] * hi[0]; y[3] += wk[a][k] * hi[1]; }
                const v2u yw = hw[a][j]; const f32x4 y1 = {bflo(yw.x), bfhi(yw.x), bflo(yw.y), bfhi(yw.y)};
                v[j] = y1 + ((const f32x4*)g2)[c4] * y;
                s += (v[j].x * v[j].x + v[j].y * v[j].y) + (v[j].z * v[j].z + v[j].w * v[j].w); }
            const float rstd = 1.0f / sqrtf(wave_sum(s) * (1.f / D) + EPS);
#pragma unroll
            for (int j = 0; j < 4; ++j) { const int c4 = F.lane + 64 * j; ((f32x4*)hr)[c4] = (v[j] * rstd) * ((const f32x4*)A->in[22])[c4]; } }
    }
}

constexpr int NPHASES = 11;
__global__ void __launch_bounds__(NTHREADS, 2) fwd_kernel(Args args) {
    extern __shared__ __attribute__((aligned(16))) unsigned char lds_raw[];
    Frame F;
    F.lds = (LAS unsigned char*)lds_raw;
    F.tid = threadIdx.x; F.lane = F.tid & 63; F.wave = __builtin_amdgcn_readfirstlane(F.tid >> 6); F.G = gridDim.x; F.bid = blockIdx.x;
    F.out = args.out; F.ws = args.ws;
        for (int u = F.tid; u < (LDS_BYTES - MISC_OFF) / 4; u += NTHREADS) ((LAS unsigned*)(F.lds + MISC_OFF))[u] = 0u;
    __syncthreads();
    volatile LAS unsigned* MISC = (volatile LAS unsigned*)(F.lds + MISC_OFF);
    LAS int* TS = (LAS int*)(F.lds + MISC_OFF + 256);
    const int lo = args.ph_lo, hi = args.ph_hi;
    const bool multi = (hi - lo) > 1;
    XcdBarrier bar; bar.bar = (unsigned*)((unsigned*)(F.ws + WS_CTL)) + CW_BAR; bar.x = 0; bar.st = nullptr;
    if (multi) bar = xcd_barrier_post((unsigned*)((unsigned*)(F.ws + WS_CTL)) + CW_BAR, MISC + 8);
#ifndef PHMASK
#define PHMASK 0x7ff
#endif
#define IN(k) (((PHMASK >> (k)) & 1) && lo <= (k) && (k) < hi)
#define BUILD_TS() do { if (F.tid < NEXP) TS[33 + F.tid] = (int)__hip_atomic_load(((unsigned*)(F.ws + WS_CTL)) + CW_CNT + F.tid, RLX_AGENT);     \
        __syncthreads(); \
        if (F.tid == 0) { int acc_ = 0; for (int e = 0; e < NEXP; ++e) { TS[e] = acc_; acc_ += (TS[33 + e] + 255) >> 8; } TS[32] = acc_; } __syncthreads(); \
        for (int t_ = F.tid; t_ < TS[32]; t_ += NTHREADS) { int e_ = 0; for (int k_ = 1; k_ < NEXP; ++k_) e_ = (TS[k_] <= t_) ? k_ : e_; ((LAS unsigned char*)(TS + 72))[t_] = (unsigned char)e_; } \
        __syncthreads(); } while (0)
#define SEAM(k) do { if (IN(k) && IN((k) + 1)) xcd_barrier(bar); } while (0)
#ifndef PROBE_DUP
#define PROBE_DUP 0
#endif
#define REPS(k) for (int rep_ = 0; rep_ < (((PROBE_DUP >> (k)) & 1) ? 2 : 1); ++rep_)

    if (IN(0)) REPS(0) { p0_phase(F, opaque_args()); } SEAM(0);
    if (IN(1)) REPS(1) { p1_phase(F, opaque_args()); } SEAM(1);
    if (IN(2)) REPS(2) { DenseSched S; S.init(NROWS, PWP, F.G, F.bid, ((bf16*)(F.ws + WS_WIN))); S.build((LAS int*)(TS + 400), F.tid); EpiProj E{((bf16*)(F.ws + WS_P))};
        pg8::gemm_phase<EpiProj, DenseSched, true, false>(F.lds, (const char*)((bf16*)(F.ws + WS_HN)), S, E);
#ifdef PROBE_INNULL
        { EpiNull E0; pg8::gemm_phase<EpiNull, DenseSched, true, false>(F.lds, (const char*)((bf16*)(F.ws + WS_HN)), S, E0); }
#endif
    } SEAM(2);
    if (IN(3)) { p3v3_phase<0>(F, opaque_args());
#ifdef PROBE_P3
        p3v3_phase<PROBE_P3>(F, opaque_args());
#endif
    } SEAM(3);
    if (IN(4)) REPS(4) { p4_phase(F, opaque_args()); } SEAM(4);
    if (IN(5)) {
#ifdef PROBE_P5
        p5a_phase(F, opaque_args()); p5av3_phase<PROBE_P5>(F, opaque_args());
#else
        p5av3_phase<0>(F, opaque_args());
#endif
    } SEAM(5);
    if (IN(6)) REPS(6) { DenseSched S; S.init(NLAT, D, F.G, F.bid, ((bf16*)(F.ws + WS_WOUT))); S.kb = OUTPROJ_F8 ? 1024 : 2048; S.build((LAS int*)(TS + 400), F.tid); EpiOut E{opaque_args()->in[0], ((float*)(F.ws + WS_MOD)), ((bf16*)(F.ws + WS_Y1)), OUTPROJ_F8 ? 1.0f / WSCALE : 1.0f};
        pg8::gemm_phase<EpiOut, DenseSched, true, OUTPROJ_F8 != 0>(F.lds, (const char*)((bf16*)(F.ws + WS_YMIX)), S, E); } SEAM(6);
    if (IN(7)) { p5c_phase(F, opaque_args()); } SEAM(7);
#pragma unroll 1
    for (int ph = 8; ph < 10; ++ph) {
        if (IN(ph)) {
            const bool gu = (ph == 8);
            BUILD_TS();
            const int ntr = TS[32];
            REPS(ph) {
                if (gu) { MoeSched<true> S; S.TS = TS; S.ntr = ntr; S.G = F.G; S.c = F.bid; S.laid = ((int*)((unsigned char*)F.out + DO_LAID)); S.W = (const char*)F.out + DO_WGU;
                    EpiGU E{(unsigned char*)(F.ws + WS_ACT), opaque_args()->in[19]}; pg8::gemm_phase<EpiGU, MoeSched<true>, true, true>(F.lds, (const char*)((unsigned char*)F.out + DO_HN2), S, E);
#ifdef PROBE_GUNULL
                    { EpiNull E0; pg8::gemm_phase<EpiNull, MoeSched<true>, true, true>(F.lds, (const char*)((unsigned char*)F.out + DO_HN2), S, E0); }
#endif
                }
                else { MoeSched<false> S; S.TS = TS; S.ntr = ntr; S.G = F.G; S.c = F.bid; S.laid = nullptr; S.W = (const char*)F.out + DO_WDN;
                    EpiDN E{(unsigned char*)(F.ws + WS_YA), opaque_args()->in[21], TS}; pg8::gemm_phase<EpiDN, MoeSched<false>, true, true>(F.lds, (const char*)(F.ws + WS_ACT), S, E); }
            }
        }
        SEAM(ph);
    }
    if (IN(10)) { BUILD_TS(); p8_phase(F, opaque_args(), TS); }
#undef IN
#undef SEAM
}

extern "C" void kernel_launch(void* const* d_in, const int* in_sizes, int n_in, void* d_out, int out_size, void* d_ws, size_t ws_size, hipStream_t stream) {
    static int grid = 0;
    if (grid == 0) {
        if (n_in != 23 || in_sizes[0] != NLAT * D || out_size != NLAT * D || ws_size < WS_TOTAL) {
            fprintf(stderr, "kernel_launch: unexpected shapes: n_in %d, in0 %d, out %d, ws %zu (need %zu); nothing launched\n", n_in, n_in > 0 ? in_sizes[0] : -1, out_size, ws_size, (size_t)WS_TOTAL); grid = -1; return; }
        int dev = 0, cus = 0, per_cu = 0;
        if (hipGetDevice(&dev) != hipSuccess || hipDeviceGetAttribute(&cus, hipDeviceAttributeMultiprocessorCount, dev) != hipSuccess) { fprintf(stderr, "kernel_launch: device query failed\n"); grid = -1; return; }
        if (hipFuncSetAttribute((const void*)fwd_kernel, hipFuncAttributeMaxDynamicSharedMemorySize, LDS_BYTES) != hipSuccess) { fprintf(stderr, "kernel_launch: hipFuncSetAttribute failed\n"); grid = -1; return; }
        if (hipOccupancyMaxActiveBlocksPerMultiprocessor(&per_cu, (const void*)fwd_kernel, NTHREADS, LDS_BYTES) != hipSuccess || per_cu < 1) {
            fprintf(stderr, "kernel_launch: occupancy query reports %d workgroups per CU; nothing launched\n", per_cu); (void)hipGetLastError(); grid = -1; return; }
        grid = cus;
        if (grid > 256) grid = 256;
    }
    if (grid < 0) return;
    if (hipMemsetAsync((char*)d_ws + WS_CTL, 0, CTL_ZERO_BYTES, stream) != hipSuccess) { fprintf(stderr, "kernel_launch: hipMemsetAsync failed\n"); return; }
    Args a{};
    for (int i = 0; i < 23; ++i) a.in[i] = (const float*)d_in[i];
    a.out = (float*)d_out; a.ws = (unsigned char*)d_ws;
#if MK_N_LAUNCHES == 1
    a.ph_lo = 0; a.ph_hi = NPHASES;
    hipLaunchKernelGGL(fwd_kernel, dim3(grid), dim3(NTHREADS), LDS_BYTES, stream, a);
#else
    for (int p = 0; p < NPHASES; ++p) { a.ph_lo = p; a.ph_hi = p + 1; hipLaunchKernelGGL(fwd_kernel, dim3(grid), dim3(NTHREADS), LDS_BYTES, stream, a); }
#endif
    const hipError_t le = hipPeekAtLastError();
    if (le != hipSuccess) fprintf(stderr, "kernel_launch: launch failed: %s\n", hipGetErrorName(le));
}
```

```cpp
#include <hip/hip_runtime.h>
#include <cstdio>
#include <cstdint>

#ifndef MK_N_LAUNCHES
#define MK_N_LAUNCHES 1
#endif

#define GAS __attribute__((address_space(1)))
#define LAS __attribute__((address_space(3)))
typedef unsigned short bf16;
typedef unsigned v4u __attribute__((ext_vector_type(4)));
typedef unsigned v2u __attribute__((ext_vector_type(2)));
typedef float f32x4 __attribute__((ext_vector_type(4)));
typedef float f32x2 __attribute__((ext_vector_type(2)));
typedef short bf16x8 __attribute__((ext_vector_type(8)));
typedef short s16x4 __attribute__((ext_vector_type(4)));
#define RLX_AGENT __ATOMIC_RELAXED, __HIP_MEMORY_SCOPE_AGENT
#define LDS_WAIT() asm volatile("s_waitcnt lgkmcnt(0)" ::: "memory")
#define VM_WAIT() asm volatile("s_waitcnt vmcnt(0)" ::: "memory")
#define LDS_BARRIER() do { asm volatile("s_waitcnt lgkmcnt(0)" ::: "memory"); __builtin_amdgcn_s_barrier(); asm volatile("" ::: "memory"); } while (0)

typedef __bf16 bf16x2_t __attribute__((ext_vector_type(2)));
__device__ __forceinline__ unsigned pk2(float lo, float hi) { const f32x2 v = {lo, hi}; return __builtin_bit_cast(unsigned, __builtin_convertvector(v, bf16x2_t)); }
__device__ __forceinline__ unsigned f2bf(float f) { return (unsigned)__builtin_bit_cast(unsigned short, (__bf16)f); }
__device__ __forceinline__ unsigned pk4_fp8(float a, float b, float c, float d) { int w = __builtin_amdgcn_cvt_pk_fp8_f32(a, b, 0, false); w = __builtin_amdgcn_cvt_pk_fp8_f32(c, d, w, true); return (unsigned)w; }
__device__ __forceinline__ float bflo(unsigned w) { return __builtin_bit_cast(float, w << 16); }
__device__ __forceinline__ float bfhi(unsigned w) { return __builtin_bit_cast(float, w & 0xffff0000u); }
__device__ __forceinline__ float bf2f(bf16 b) { return __builtin_bit_cast(float, ((unsigned)b) << 16); }
__device__ __forceinline__ float fexp(float x) { return __builtin_amdgcn_exp2f(x * 1.4426950408889634f); }
__device__ __forceinline__ float wave_sum(float v) {
#pragma unroll
    for (int o = 1; o < 64; o <<= 1) v += __shfl_xor(v, o);
    return v;
}

constexpr int D = 1024, NBATCH = 16, SEQ = 4096, CTXL = 256;
constexpr int NLAT = NBATCH * SEQ;
constexpr int NCTXR = NBATCH * CTXL;
constexpr int NROWS = NLAT + NCTXR;
constexpr int PW = 3104, PWP = 3328;
constexpr int CQ = 0, CK = 256, CV = 512, CR = 1024, CAF = 1536, CAB = 1552, CPB = 1568, CPC = 2080, CPX = 2592;
constexpr int NCC = 68;
constexpr int NEXP = 32, DFF = 1024;
constexpr float EPS = 1e-6f;
constexpr int LISTCAP = 65536;
constexpr float WSCALE = 32.0f, WSCALE_INV = 1.0f / 32.0f;

#ifndef OUTPROJ_F8
#define OUTPROJ_F8 1
#endif
constexpr size_t MiB = 1u << 20;
constexpr size_t WS_CTL = 0, CTL_ZERO_BYTES = 32768;
constexpr size_t WS_MOD = 1 * MiB;
constexpr size_t WS_DECAY = 2 * MiB;
constexpr size_t WS_WIN = 6 * MiB;
constexpr size_t WS_WOUT = 13 * MiB;
constexpr size_t WS_HN = 16 * MiB;
constexpr size_t WS_KV = 16 * MiB;
constexpr size_t WS_P = 152 * MiB;
constexpr size_t WS_S = 565 * MiB;
constexpr size_t WS_YMIX = 693 * MiB;
constexpr size_t WS_Y1 = 821 * MiB;
constexpr size_t WS_ACT = 16 * MiB;
constexpr size_t WS_YA = 280 * MiB;
constexpr size_t WS_VT = 949 * MiB;
constexpr size_t WS_END = 1013 * MiB;
constexpr size_t WS_TSLOT = 1013 * MiB;
constexpr size_t WS_TW = 1015 * MiB;
constexpr size_t WS_TOTAL = 1017 * MiB;
constexpr size_t DO_WDN = 0;
constexpr size_t DO_WGU = 32 * MiB;
constexpr size_t DO_HN2 = 96 * MiB;
constexpr size_t DO_LAID = 160 * MiB;
constexpr size_t DO_LW = 168 * MiB;
static_assert(WS_P + (size_t)NROWS * PW * 2 <= WS_S && WS_YMIX + (size_t)NLAT * D * 2 <= WS_Y1 && WS_YA + (size_t)1056 * 256 * D <= WS_Y1 && WS_Y1 + (size_t)NLAT * D * 2 <= WS_VT && WS_VT + (size_t)NLAT * 512 * 2 <= WS_END, "ws map");
static_assert(WS_HN + (size_t)NROWS * D * 2 <= WS_P && WS_ACT + (size_t)1056 * 256 * 1024 <= WS_YA && DO_LW + (size_t)NEXP * LISTCAP * 4 <= (size_t)NLAT * D * 4, "ws map 2");
constexpr int CW_CNT = 64;
constexpr int CW_BAR = 4096;

constexpr int RING_BYTES = 131072;
constexpr int MISC_OFF = RING_BYTES;
constexpr int LDS_BYTES = 147456;
constexpr int NWAVES = 8, NTHREADS = 512;

namespace pg8 {
constexpr int BM = 256, BK = 64, HALF = 128, HTB = HALF * BK * 2, STAGE_BYTES = 8 * HTB;
__host__ __device__ __forceinline__ int lds_byte(int r, int c) { const int st = (r >> 4) * 2 + (c >> 5), rr = r & 15, cc = c & 31, ob = rr * 64 + cc * 2; return st * 1024 + (ob ^ (((ob >> 9) & 1) << 5)); }
__host__ __device__ __forceinline__ void stage_rc(int b, int& R, int& C) { const int st = b / 1024, sb = b % 1024, swz = sb ^ (((sb >> 9) & 1) << 5); R = (st >> 1) * 16 + swz / 64; C = (st & 1) * 32 + (swz % 64) / 2; }
__host__ __device__ __forceinline__ int perm32(int rho) { const int n = rho >> 4, i = rho & 15; return 8 * (i >> 2) + 4 * n + (i & 3); }

typedef int v8i __attribute__((ext_vector_type(8)));
typedef int v4i __attribute__((ext_vector_type(4)));
__device__ __forceinline__ v8i cat8(bf16x8 lo, bf16x8 hi) { return __builtin_shufflevector(__builtin_bit_cast(v4i, lo), __builtin_bit_cast(v4i, hi), 0, 1, 2, 3, 4, 5, 6, 7); }
struct Unit { int pm, pn, e, lt; };
__device__ __forceinline__ unsigned cvt_pk_bf16(float lo, float hi) { unsigned r; asm volatile("v_cvt_pk_bf16_f32 %0, %1, %2" : "=v"(r) : "v"(lo), "v"(hi)); return r; }

template <class Epi, class Sched, bool ALIGN_EPI, bool F8>
__device__ __forceinline__ void gemm_phase(LAS unsigned char* lds, const char* Abase, const Sched& S, const Epi& E) {
    int tid_ = threadIdx.x; asm volatile("" : "+v"(tid_));
    const int tid = tid_, wid = __builtin_amdgcn_readfirstlane(tid >> 6), lane = tid & 63, wr = wid >> 2, wc = wid & 3, fr = lane & 15, fq = lane >> 4;
    constexpr int KB = F8 ? 1024 : 2048, NT = KB / 128;
    unsigned voffB[2];
#pragma unroll
    for (int i = 0; i < 2; ++i) { int R, C; stage_rc(tid * 16 + i * 8192, R, C); const int Rb = Epi::PERM ? ((R & ~31) + perm32(R & 31)) : R; voffB[i] = (unsigned)(Rb * KB + C * 2); }
#define PG8_AROWS(u_, dst_) do { _Pragma("unroll") for (int h_ = 0; h_ < 2; ++h_) _Pragma("unroll") for (int i_ = 0; i_ < 2; ++i_) { int R_, C_; stage_rc(tid * 16 + i_ * 8192, R_, C_); \
        dst_[h_][i_] = (unsigned)S.arow(u_, h_ * HALF + R_); } } while (0)
#define PG8_AOFF2(dst_) do { _Pragma("unroll") for (int h_ = 0; h_ < 2; ++h_) _Pragma("unroll") for (int i_ = 0; i_ < 2; ++i_) { int R_, C_; stage_rc(tid * 16 + i_ * 8192, R_, C_); \
        dst_[h_][i_] = dst_[h_][i_] * (unsigned)KB + (unsigned)C_ * 2u; } } while (0)
    const size_t kstep = (size_t)(BK * 2);
    const size_t hstep = (size_t)HALF * KB;
    const unsigned ldsw = (unsigned)wid * 1024u;
    const int aoff = lds_byte(wr * 64 + fr, fq * 8), boff = lds_byte(wc * 32 + fr, fq * 8);
#define PG8_SA(b, h) (((b) * 2 + (h)) * HTB)
#define PG8_SB(b, h) ((4 + (b) * 2 + (h)) * HTB)
#define PG8_STAGE(bufoff, gbase, voff) do { _Pragma("unroll") for (int _i = 0; _i < 2; ++_i) \
        __builtin_amdgcn_global_load_lds((const unsigned*)((const char*)(gbase) + (voff)[_i]), (LAS unsigned*)(lds + (bufoff) + ldsw + _i * 8192), 16, 0, 0); } while (0)
#define PG8_LDA(dst, b, h) do { _Pragma("unroll") for (int m = 0; m < 4; ++m) _Pragma("unroll") for (int k = 0; k < 2; ++k) dst[m][k] = *(const LAS bf16x8*)(lds + PG8_SA(b, h) + aoff + m * 2048 + k * 1024); } while (0)
#define PG8_LDB(dst, b, h) do { _Pragma("unroll") for (int n = 0; n < 2; ++n) _Pragma("unroll") for (int k = 0; k < 2; ++k) dst[n][k] = *(const LAS bf16x8*)(lds + PG8_SB(b, h) + boff + n * 2048 + k * 1024); } while (0)
#define PG8_MMA(ai, bj, At, Bt) do { if (skipmma && ((bj) == 1 || wc > 0)) break; __builtin_amdgcn_s_setprio(1); _Pragma("unroll") for (int m = 0; m < 4; ++m) _Pragma("unroll") for (int n = 0; n < 2; ++n) { \
        if constexpr (F8) { asm volatile("v_mfma_f32_16x16x128_f8f6f4 %0, %1, %2, %0" : "+v"(acc[ai][bj][m][n]) : "v"(cat8(Bt[n][0], Bt[n][1])), "v"(cat8(At[m][0], At[m][1]))); } \
        else { _Pragma("unroll") for (int k = 0; k < 2; ++k) acc[ai][bj][m][n] = __builtin_amdgcn_mfma_f32_16x16x32_bf16(Bt[n][k], At[m][k], acc[ai][bj][m][n], 0, 0, 0); } } \
        __builtin_amdgcn_s_setprio(0); } while (0)
#define PG8_WAIT_V(n) asm volatile("s_waitcnt vmcnt(" #n ")" ::: "memory")
#define PG8_WAIT_L(n) asm volatile("s_waitcnt lgkmcnt(" #n ")" ::: "memory")
#define PG8_BAR __builtin_amdgcn_s_barrier()
#define PG8_SCHED __builtin_amdgcn_sched_barrier(0)
    Unit cur, nxt; int ui = 0;
    if (!S.next(0, cur)) return;
    f32x4 acc[2][2][4][2];
#pragma unroll
    for (int a = 0; a < 2; ++a)
#pragma unroll
        for (int b = 0; b < 2; ++b)
#pragma unroll
            for (int m = 0; m < 4; ++m)
#pragma unroll
                for (int n = 0; n < 2; ++n) acc[a][b][m][n] = (f32x4){0.f, 0.f, 0.f, 0.f};
    bf16x8 At[4][2], B0[2][2], B1[2][2];
    unsigned oC[2][2];
    PG8_AROWS(cur, oC); PG8_AOFF2(oC);
    unsigned rN[2] = {0u, 0u};
    const char* cB = S.bptr(cur);
    PG8_STAGE(PG8_SB(0, 0), cB, voffB); PG8_STAGE(PG8_SB(0, 1), cB + hstep, voffB); PG8_STAGE(PG8_SA(0, 0), Abase, oC[0]); PG8_STAGE(PG8_SA(0, 1), Abase, oC[1]);
    if (wr == 1) PG8_BAR;
    PG8_WAIT_V(2); PG8_BAR;
    PG8_STAGE(PG8_SB(1, 0), cB + kstep, voffB); PG8_STAGE(PG8_SA(1, 0), Abase + kstep, oC[0]); PG8_STAGE(PG8_SB(1, 1), cB + hstep + kstep, voffB);
    PG8_WAIT_V(6); PG8_BAR;
    for (;;) {
        const bool skipmma = S.mostly_padding(cur);
        const bool has_next = S.next(ui + 1, nxt);
        if (!has_next) nxt = cur;
        const char* nB = S.bptr(nxt);
        for (int t = 0; t < NT; t += 2) {
            const bool last = (t == NT - 2);
            const char* ka1 = Abase + (size_t)(t + 1) * kstep;
            const char* ka2 = last ? Abase : Abase + (size_t)(t + 2) * kstep; const char* b2 = last ? nB : cB + (size_t)(t + 2) * kstep;
            const char* ka3 = ka2 + kstep; const char* b3 = b2 + kstep;
            PG8_LDB(B0, 0, 0); PG8_LDB(B1, 0, 1); PG8_SCHED; PG8_LDA(At, 0, 0); PG8_STAGE(PG8_SA(1, 1), ka1, oC[1]);
            PG8_WAIT_V(8); PG8_WAIT_L(0); PG8_BAR; PG8_MMA(0, 0, At, B0); PG8_MMA(0, 1, At, B1); PG8_BAR; PG8_SCHED;
            if constexpr (Sched::GATHER) { if (t == NT - 4) { unsigned r4[2][2]; PG8_AROWS(nxt, r4); rN[0] = r4[0][0] | (r4[0][1] << 16); rN[1] = r4[1][0] | (r4[1][1] << 16); } }
            if (last) {
                if constexpr (Sched::GATHER) { oC[0][0] = rN[0] & 0xffffu; oC[0][1] = rN[0] >> 16; oC[1][0] = rN[1] & 0xffffu; oC[1][1] = rN[1] >> 16; }
                else { PG8_AROWS(nxt, oC); }
                PG8_AOFF2(oC); }
            PG8_LDA(At, 0, 1); PG8_STAGE(PG8_SB(0, 0), b2, voffB); PG8_STAGE(PG8_SB(0, 1), b2 + hstep, voffB); PG8_STAGE(PG8_SA(0, 0), ka2, oC[0]);
            PG8_WAIT_V(8); PG8_WAIT_L(0); PG8_BAR; PG8_MMA(1, 0, At, B0); PG8_MMA(1, 1, At, B1); PG8_BAR; PG8_SCHED;
            PG8_LDB(B0, 1, 0); PG8_LDB(B1, 1, 1); PG8_SCHED; PG8_LDA(At, 1, 0); PG8_STAGE(PG8_SA(0, 1), ka2, oC[1]);
            PG8_WAIT_V(8); PG8_WAIT_L(0); PG8_BAR; PG8_MMA(0, 0, At, B0); PG8_MMA(0, 1, At, B1); PG8_BAR; PG8_SCHED;
            PG8_LDA(At, 1, 1); PG8_STAGE(PG8_SB(1, 0), b3, voffB); PG8_STAGE(PG8_SB(1, 1), b3 + hstep, voffB); PG8_STAGE(PG8_SA(1, 0), ka3, oC[0]);
            PG8_WAIT_V(8); PG8_WAIT_L(0); PG8_BAR; PG8_MMA(1, 0, At, B0); PG8_MMA(1, 1, At, B1); PG8_BAR; PG8_SCHED;
        }
        if constexpr (ALIGN_EPI) { if (wr == 0) PG8_BAR; }
        if constexpr (F8) asm volatile("s_nop 15\n\ts_nop 7" ::: "memory");
        { int fr_o = fr, fq_o = fq; asm volatile("" : "+v"(fr_o), "+v"(fq_o));
          E(acc, cur, wr, wc, fr_o, fq_o); }
        if (!has_next) break;
#pragma unroll
        for (int a = 0; a < 2; ++a)
#pragma unroll
            for (int b = 0; b < 2; ++b)
#pragma unroll
                for (int m = 0; m < 4; ++m)
#pragma unroll
                    for (int n = 0; n < 2; ++n) acc[a][b][m][n] = (f32x4){0.f, 0.f, 0.f, 0.f};
        cur = nxt; cB = nB; ++ui;
        if constexpr (ALIGN_EPI) { if (wr == 1) PG8_BAR; }
    }
    PG8_WAIT_V(0);
    if constexpr (!ALIGN_EPI) { if (wr == 0) PG8_BAR; }
    PG8_BAR;
#undef PG8_AROWS
#undef PG8_AOFF2
#undef PG8_SA
#undef PG8_SB
#undef PG8_STAGE
#undef PG8_LDA
#undef PG8_LDB
#undef PG8_MMA
#undef PG8_WAIT_V
#undef PG8_WAIT_L
#undef PG8_BAR
#undef PG8_SCHED
}
}

#define XB_TMO      128
#define XB_XCNT(j)  (256  + 64 * (j))
#define XB_XSUB(j)  (1280 + 64 * (j))
#define XB_XGEN(j)  (2304 + 64 * (j))
#define XB_TOP      3328
#define XB_TOPGEN   3392
#define XCD_BAR_WORDS 3456
#define XB_SPIN_CAP (1u << 22)
__device__ __forceinline__ unsigned xb_ld(unsigned* p)              { return __hip_atomic_load(p, __ATOMIC_RELAXED, __HIP_MEMORY_SCOPE_AGENT); }
__device__ __forceinline__ unsigned xb_add(unsigned* p, unsigned v) { return __hip_atomic_fetch_add(p, v, __ATOMIC_RELAXED, __HIP_MEMORY_SCOPE_AGENT); }
__device__ __forceinline__ unsigned xb_xcc_id() { return (unsigned)__builtin_amdgcn_s_getreg((3 << 11) | 20) & 0xFu; }
#define XB_SPIN(cond, bar) do { unsigned _sp = 0; while (cond) { __builtin_amdgcn_s_sleep(1); \
    if ((++_sp & 255u) == 0u) { if (xb_ld(&(bar)[XB_TMO])) break; if (_sp > XB_SPIN_CAP) { atomicAdd(&(bar)[XB_TMO], 1u); break; } } } } while (0)
struct XcdBarrier { unsigned* bar; unsigned x; volatile LAS unsigned* st; };
__device__ __forceinline__ XcdBarrier xcd_barrier_post(unsigned* bar, volatile LAS unsigned* st) {
    XcdBarrier b; b.bar = bar; b.x = xb_xcc_id(); b.st = st;
    if (threadIdx.x == 0) (void)xb_add(&bar[XB_XCNT(b.x)], 1u);
    return b;
}
__device__ __forceinline__ void xcd_barrier_complete(unsigned* bar, unsigned x, unsigned& nloc, unsigned& nx) {
    const unsigned G = gridDim.x * gridDim.y * gridDim.z;
    unsigned sum, cnt, mine, sp = 0u;
    for (;;) {
        sum = 0u; cnt = 0u; mine = 0u;
#pragma unroll 1
        for (unsigned j = 0; j < 16; ++j) { const unsigned c = xb_ld(&bar[XB_XCNT(j)]); sum += c; cnt += (c > 0u) ? 1u : 0u; mine = (j == x) ? c : mine; }
        if (sum == G) break;
        __builtin_amdgcn_s_sleep(1);
        if ((++sp & 255u) == 0u) { if (xb_ld(&bar[XB_TMO])) break; if (sp > XB_SPIN_CAP) { atomicAdd(&bar[XB_TMO], 1u); break; } }
    }
    nloc = mine > 0u ? mine : 1u; nx = cnt > 0u ? cnt : 1u;
}
__device__ __forceinline__ void xcd_barrier(const XcdBarrier& b) {
    asm volatile("s_waitcnt vmcnt(0)" ::: "memory");
    __syncthreads();
    if (threadIdx.x == 0) {
        unsigned* bar = b.bar;
        __builtin_amdgcn_s_waitcnt(0);
        unsigned nloc = b.st[0], nx = b.st[1];
        if (nloc == 0u) { xcd_barrier_complete(bar, b.x, nloc, nx); b.st[0] = nloc; b.st[1] = nx; }
        const unsigned old = xb_add(&bar[XB_XSUB(b.x)], 1u);
        const unsigned gen = old / nloc;
        if (old + 1u == (gen + 1u) * nloc) {
            __builtin_amdgcn_fence(__ATOMIC_RELEASE, "agent");
            asm volatile("s_waitcnt vmcnt(0)" ::: "memory");
            const unsigned og = xb_add(&bar[XB_TOP], 1u);
            const unsigned tg = og / nx;
            if (og + 1u == (tg + 1u) * nx) xb_add(&bar[XB_TOPGEN], 1u);
            else XB_SPIN(xb_ld(&bar[XB_TOPGEN]) == tg, bar);
            __builtin_amdgcn_fence(__ATOMIC_ACQUIRE, "agent");
            xb_add(&bar[XB_XGEN(b.x)], 1u);
            asm volatile("s_waitcnt vmcnt(0)" ::: "memory");
        } else {
            XB_SPIN(xb_ld(&bar[XB_XGEN(b.x)]) == gen, bar);
            __builtin_amdgcn_fence(__ATOMIC_ACQUIRE, "agent");
            asm volatile("s_waitcnt vmcnt(0)" ::: "memory");
        }
    }
    __syncthreads();
}

struct Args { const float* in[23]; float* out; unsigned char* ws; int ph_lo, ph_hi; };
typedef const Args __attribute__((address_space(4))) CArgs;
__device__ __forceinline__ CArgs* opaque_args() { CArgs* p = (CArgs*)__builtin_amdgcn_kernarg_segment_ptr(); asm volatile("" : "+s"(p)); return p; }
struct Frame {
    LAS unsigned char* lds;
    int tid, lane, wave, G, bid;
    float* out; unsigned char* ws;
};

struct EpiNull {
    static constexpr bool PERM = true;
    __device__ __forceinline__ void operator()(const f32x4 (&acc)[2][2][4][2], const pg8::Unit&, int, int, int, int) const {
#pragma unroll
        for (int a = 0; a < 2; ++a)
#pragma unroll
            for (int b = 0; b < 2; ++b)
#pragma unroll
                for (int m = 0; m < 4; ++m)
#pragma unroll
                    for (int n = 0; n < 2; ++n) asm volatile("" :: "v"(acc[a][b][m][n]));
    }
};
struct DenseSched {
    static constexpr bool GATHER = false;
    int nM, nN, nwg, G, c, kb; const char* Bt; const LAS int* UT;
    __device__ __forceinline__ void init(int M, int N, int G_, int c_, const void* Bt_) { nM = M / 256; nN = N / 256; nwg = nM * nN; G = G_; c = c_; Bt = (const char*)Bt_; UT = nullptr; kb = 2048; }
    __device__ __forceinline__ void build(LAS int* ut, int tid) { if (tid < 32) { pg8::Unit u; ut[tid] = next_calc(tid, u) ? (u.pm | (u.pn << 16)) : -1; } UT = ut; __syncthreads(); }
    __device__ __forceinline__ bool next(int i, pg8::Unit& u) const { const int w = (i < 32) ? UT[i] : -1; if (w < 0) return false; u.pm = w & 0xffff; u.pn = w >> 16; u.e = 0; u.lt = 0; return true; }
    __device__ __forceinline__ bool next_calc(int i, pg8::Unit& u) const {
        const long L = (long)i * G + c; if (L >= nwg) return false;
        int wgid = (int)L; { const int q = nwg / 8, r = nwg % 8, xcd = wgid % 8, off = wgid / 8; wgid = (xcd < r ? xcd * (q + 1) : r * (q + 1) + (xcd - r) * q) + off; }
        const int nig = 8 * nN, gid = wgid / nig, fm = gid * 8, gsz = (nM - fm) < 8 ? (nM - fm) : 8;
        u.pm = fm + ((wgid % nig) % gsz); u.pn = (wgid % nig) / gsz; u.e = 0; u.lt = 0; return true;
    }
    __device__ __forceinline__ int arow(const pg8::Unit& u, int r) const { return u.pm * 256 + r; }
    __device__ __forceinline__ bool mostly_padding(const pg8::Unit& u) const { return nN == PWP / 256 && u.pn == nN - 1; }
    __device__ __forceinline__ const char* bptr(const pg8::Unit& u) const { return Bt + (size_t)u.pn * 256 * kb; }
};
struct EpiProj {
    static constexpr bool PERM = true;
    bf16* O;
    __device__ __forceinline__ void operator()(const f32x4 (&acc)[2][2][4][2], const pg8::Unit& u, int wr, int wc, int fr, int fq) const {
        const int row0 = u.pm * 256 + wr * 64 + fr, col0 = u.pn * 256 + wc * 32 + 8 * fq;
#pragma unroll
        for (int ai = 0; ai < 2; ++ai)
#pragma unroll
            for (int m = 0; m < 4; ++m) { bf16* rowp = O + (size_t)(row0 + ai * 128 + m * 16) * PW + col0;
#pragma unroll
                for (int bj = 0; bj < 2; ++bj) { if (col0 + bj * 128 < PW) { const f32x4 v0 = acc[ai][bj][m][0], v1 = acc[ai][bj][m][1];
                    v4u w; w.x = pk2(v0[0], v0[1]); w.y = pk2(v0[2], v0[3]); w.z = pk2(v1[0], v1[1]); w.w = pk2(v1[2], v1[3]);
                    *(v4u*)(rowp + bj * 128) = w; } } }
    }
};
struct EpiOut {
    static constexpr bool PERM = true;
    const float* x; const float* mod; bf16* Y1; float sc;
    __device__ __forceinline__ void operator()(const f32x4 (&acc)[2][2][4][2], const pg8::Unit& u, int wr, int wc, int fr, int fq) const {
        const int row0 = u.pm * 256 + wr * 64 + fr, col0 = u.pn * 256 + wc * 32 + 8 * fq;
        const float* g1 = mod + (size_t)(u.pm >> 4) * 6144 + 2048;
        f32x4 gv[2][2];
#pragma unroll
        for (int bj = 0; bj < 2; ++bj)
#pragma unroll
            for (int n = 0; n < 2; ++n) gv[bj][n] = *(const f32x4*)(g1 + col0 + bj * 128 + 4 * n) * sc;
#pragma unroll
        for (int ai = 0; ai < 2; ++ai)
#pragma unroll
            for (int m = 0; m < 4; ++m) { const size_t off = (size_t)(row0 + ai * 128 + m * 16) * D + col0; bf16* rowp = Y1 + off;
#pragma unroll
                for (int bj = 0; bj < 2; ++bj) { const f32x4 x0 = *(const f32x4*)(x + off + bj * 128), x1 = *(const f32x4*)(x + off + bj * 128 + 4);
                    const f32x4 v0 = x0 + acc[ai][bj][m][0] * gv[bj][0], v1 = x1 + acc[ai][bj][m][1] * gv[bj][1];
                    v4u w; w.x = pk2(v0[0], v0[1]); w.y = pk2(v0[2], v0[3]); w.z = pk2(v1[0], v1[1]); w.w = pk2(v1[2], v1[3]);
                    *(v4u*)(rowp + bj * 128) = w; } }
    }
};
template <bool GU> struct MoeSched {
    static constexpr bool GATHER = GU;
    static constexpr bool gu = GU;
    const LAS int* TS; int ntr, G, c; const int* laid; const char* W;
    __device__ __forceinline__ bool next(int i, pg8::Unit& u) const {
        const int x = c & 7, j = c >> 3; int tl, pn;
        if (G != 256) { const int L = i * G + c, npn = gu ? 8 : 4; tl = L / npn; pn = L % npn; }
        else if (gu) { tl = (i * 8 + x) * 4 + (j >> 3); pn = j & 7; } else { tl = (i * 8 + x) * 8 + (j >> 2); pn = j & 3; }
        if (tl >= ntr) return false;
        const int tau = tl; const int e = ((const LAS unsigned char*)(TS + 72))[tau];
        u.pm = tl; u.pn = pn; u.e = e; u.lt = tau - TS[e]; return true;
    }
    __device__ __forceinline__ bool mostly_padding(const pg8::Unit&) const { return false; }
    __device__ __forceinline__ int arow(const pg8::Unit& u, int r) const {
        if (!gu) return u.pm * 256 + r;
        const int pos = u.lt * 256 + r, cnt = TS[33 + u.e];
        return pos < cnt ? (laid[(size_t)u.e * LISTCAP + pos] >> 2) : 0;
    }
    __device__ __forceinline__ const char* bptr(const pg8::Unit& u) const { return W + ((size_t)u.e * (gu ? 2048 : 1024) + (size_t)u.pn * 256) * 1024; }
};
struct EpiGU {
    static constexpr bool PERM = true;
    unsigned char* ACT; const float* b_gu;
    __device__ __forceinline__ void operator()(const f32x4 (&acc)[2][2][4][2], const pg8::Unit& u, int wr, int wc, int fr, int fq) const {
        const int row0 = u.pm * 256 + wr * 64 + fr, j0 = u.pn * 128 + wc * 32 + 8 * fq;
        const float* bp = b_gu + (size_t)u.e * 2048 + 2 * j0;
        f32x4 bv[4];
#pragma unroll
        for (int q = 0; q < 4; ++q) bv[q] = *(const f32x4*)(bp + 4 * q);
        f32x2 bg[4], bu[4];
#pragma unroll
        for (int q = 0; q < 4; ++q) { bg[q] = (f32x2){bv[q][0], bv[q][2]}; bu[q] = (f32x2){bv[q][1], bv[q][3]}; }
#pragma unroll
        for (int ai = 0; ai < 2; ++ai)
#pragma unroll
            for (int m = 0; m < 4; ++m) { unsigned char* rowp = ACT + (size_t)(row0 + ai * 128 + m * 16) * DFF + j0; f32x2 a[4];
#pragma unroll
                for (int n = 0; n < 2; ++n)
#pragma unroll
                    for (int p = 0; p < 2; ++p) { const int q = 2 * n + p;
                        const f32x4 ag = acc[ai][0][m][n], au = acc[ai][1][m][n];
                        f32x2 g = (f32x2){ag[2 * p], ag[2 * p + 1]} * WSCALE_INV + bg[q], up = (f32x2){au[2 * p], au[2 * p + 1]} * WSCALE_INV + bu[q];
                        g.x = fminf(g.x, 7.0f); g.y = fminf(g.y, 7.0f); up.x = __builtin_amdgcn_fmed3f(up.x, -7.0f, 7.0f); up.y = __builtin_amdgcn_fmed3f(up.y, -7.0f, 7.0f);
                        const f32x2 t = g * (-1.702f * 1.4426950408889634f); f32x2 e; e.x = __builtin_amdgcn_exp2f(t.x); e.y = __builtin_amdgcn_exp2f(t.y);
                        const f32x2 d = e + 1.0f; f32x2 sg; sg.x = __builtin_amdgcn_rcpf(d.x); sg.y = __builtin_amdgcn_rcpf(d.y);
                        a[q] = ((up + 1.0f) * g) * sg; }
                v2u w; w.x = pk4_fp8(a[0].x, a[0].y, a[1].x, a[1].y); w.y = pk4_fp8(a[2].x, a[2].y, a[3].x, a[3].y);
                *(v2u*)rowp = w; }
    }
};
struct EpiDN {
    static constexpr bool PERM = true;
    unsigned char* YA; const float* b_dn; const LAS int* TS;
    __device__ __forceinline__ void operator()(const f32x4 (&acc)[2][2][4][2], const pg8::Unit& u, int wr, int wc, int fr, int fq) const {
        const int col0 = u.pn * 256 + wc * 32 + 8 * fq, cnt = TS[33 + u.e];
        f32x4 bv[2][2];
#pragma unroll
        for (int bj = 0; bj < 2; ++bj)
#pragma unroll
            for (int n = 0; n < 2; ++n) bv[bj][n] = *(const f32x4*)(b_dn + (size_t)u.e * D + col0 + bj * 128 + 4 * n);
#pragma unroll
        for (int ai = 0; ai < 2; ++ai)
#pragma unroll
            for (int m = 0; m < 4; ++m) { const int r = ai * 128 + wr * 64 + m * 16 + fr;
                if (u.lt * 256 + r < cnt) { unsigned char* rowp = YA + ((size_t)u.pm * 256 + r) * D + col0;
#pragma unroll
                    for (int bj = 0; bj < 2; ++bj) { const f32x4 v0 = acc[ai][bj][m][0] * WSCALE_INV + bv[bj][0], v1 = acc[ai][bj][m][1] * WSCALE_INV + bv[bj][1];
                        v2u w; w.x = pk4_fp8(v0[0], v0[1], v0[2], v0[3]); w.y = pk4_fp8(v1[0], v1[1], v1[2], v1[3]);
                        *(v2u*)(rowp + bj * 128) = w; } }
                asm volatile("" ::: "memory"); }
    }
};

template <bool MAPGU>
__device__ __forceinline__ void p0_transpose_item(const float* W, int N, bf16* WT, LAS float* scr, int item, int lane) {
    const int nblk = N / 32, kb = item / nblk, nb = item % nblk, k0 = 64 * kb, n0 = 32 * nb;
#pragma unroll
    for (int i = 0; i < 32; ++i) { const int kk = 2 * i + (lane >> 5); scr[kk * 33 + (lane & 31)] = W[(size_t)(k0 + kk) * N + n0 + (lane & 31)]; }
    LDS_WAIT(); asm volatile("" ::: "memory");
    const int c = lane & 7;
#pragma unroll
    for (int j = 0; j < 4; ++j) { const int n = (lane >> 3) + 8 * j; const LAS float* s = scr + (8 * c) * 33 + n;
        v4u o; o.x = pk2(s[0 * 33], s[1 * 33]); o.y = pk2(s[2 * 33], s[3 * 33]); o.z = pk2(s[4 * 33], s[5 * 33]); o.w = pk2(s[6 * 33], s[7 * 33]);
        int row = n0 + n;
        if (MAPGU) { const int jj = row >> 1; row = (jj >> 7) * 256 + (row & 1) * 128 + (jj & 127); }
        *(v4u*)(WT + (size_t)row * D + k0 + 8 * c) = o; }
    LDS_WAIT(); asm volatile("" ::: "memory");
}
template <bool MAPGU>
__device__ __forceinline__ void p0_transpose_item_f8(const float* W, int N, unsigned char* WT, LAS float* scr, int item, int lane) {
    const int nblk = N / 32, kb = item / nblk, nb = item % nblk, k0 = 64 * kb, n0 = 32 * nb;
#pragma unroll
    for (int i = 0; i < 32; ++i) { const int kk = 2 * i + (lane >> 5); scr[kk * 33 + (lane & 31)] = W[(size_t)(k0 + kk) * N + n0 + (lane & 31)] * WSCALE; }
    LDS_WAIT(); asm volatile("" ::: "memory");
    const int c = lane & 3;
#pragma unroll
    for (int j = 0; j < 2; ++j) { const int n = (lane >> 2) + 16 * j; const LAS float* s = scr + (16 * c) * 33 + n;
        v4u o; o.x = pk4_fp8(s[0 * 33], s[1 * 33], s[2 * 33], s[3 * 33]); o.y = pk4_fp8(s[4 * 33], s[5 * 33], s[6 * 33], s[7 * 33]);
        o.z = pk4_fp8(s[8 * 33], s[9 * 33], s[10 * 33], s[11 * 33]); o.w = pk4_fp8(s[12 * 33], s[13 * 33], s[14 * 33], s[15 * 33]);
        int row = n0 + n;
        if (MAPGU) { const int jj = row >> 1; row = (jj >> 7) * 256 + (row & 1) * 128 + (jj & 127); }
        *(v4u*)(WT + (size_t)row * D + k0 + 16 * c) = o; }
    LDS_WAIT(); asm volatile("" ::: "memory");
}
constexpr int P0_TS = 144;
struct P0Item { const float* W; void* O; int N, k0, n0, kind; };
__device__ __forceinline__ P0Item p0_item(const Frame& F, CArgs* A, int it) {
    constexpr int I_IN = 8 * 25, I_OUT = 8 * 8, I_GU = 8 * 16, I_DN = 8 * 8;
    P0Item r; int x = it;
    if (x < I_IN) { r.W = A->in[7]; r.O = (void*)(F.ws + WS_WIN); r.N = PW; r.k0 = (x / 25) * 128; r.n0 = (x % 25) * 128; r.kind = 0; return r; } x -= I_IN;
    if (x < I_OUT) { r.W = A->in[14]; r.O = (void*)(F.ws + WS_WOUT); r.N = D; r.k0 = (x >> 3) * 128; r.n0 = (x & 7) * 128; r.kind = OUTPROJ_F8 ? 1 : 0; return r; } x -= I_OUT;
    if (x < NEXP * I_GU) { const int e = x / I_GU, y = x % I_GU; r.W = A->in[18] + (size_t)e * D * 2048; r.O = (void*)((unsigned char*)F.out + DO_WGU + (size_t)e * 2048 * D); r.N = 2048; r.k0 = (y >> 4) * 128; r.n0 = (y & 15) * 128; r.kind = 2; return r; } x -= NEXP * I_GU;
    { const int e = x / I_DN, y = x % I_DN; r.W = A->in[20] + (size_t)e * D * D; r.O = (void*)((unsigned char*)F.out + DO_WDN + (size_t)e * D * D); r.N = D; r.k0 = (y >> 3) * 128; r.n0 = (y & 7) * 128; r.kind = 1; return r; }
}
__device__ __forceinline__ void p0_load(const P0Item& I, int tid, f32x4 (&v)[8]) {
#pragma unroll
    for (int q = 0; q < 8; ++q) { const int idx = tid + NTHREADS * q, k = idx >> 5, col = I.n0 + 4 * (idx & 31);
        v[q] = (col < I.N) ? *(const f32x4*)(I.W + (size_t)(I.k0 + k) * I.N + col) : (f32x4){0.f, 0.f, 0.f, 0.f}; }
}
__device__ __forceinline__ void p0_emit(const P0Item& I, LAS unsigned char* lds, int wave, int i, int g) {
    const unsigned a0 = (unsigned)(uintptr_t)lds + (unsigned)(((32 * g + (i >> 2)) * P0_TS + 16 * wave + 4 * (i & 3)) * 2);
    s16x4 r[8];
    asm volatile("ds_read_b64_tr_b16 %0, %8\n\tds_read_b64_tr_b16 %1, %8 offset:1152\n\tds_read_b64_tr_b16 %2, %8 offset:2304\n\tds_read_b64_tr_b16 %3, %8 offset:3456\n\t"
                 "ds_read_b64_tr_b16 %4, %8 offset:4608\n\tds_read_b64_tr_b16 %5, %8 offset:5760\n\tds_read_b64_tr_b16 %6, %8 offset:6912\n\tds_read_b64_tr_b16 %7, %8 offset:8064\n\ts_waitcnt lgkmcnt(0)"
                 : "=&v"(r[0]), "=&v"(r[1]), "=&v"(r[2]), "=&v"(r[3]), "=&v"(r[4]), "=&v"(r[5]), "=&v"(r[6]), "=&v"(r[7]) : "v"(a0) : "memory");
    const int n = I.n0 + 16 * wave + i;
    if (n < I.N) {
        if (I.kind == 0) { bf16* op = (bf16*)I.O + (size_t)n * D + I.k0 + 32 * g;
#pragma unroll
            for (int q = 0; q < 4; ++q) { v4u w; w.x = (unsigned)(unsigned short)r[2 * q][0] | ((unsigned)(unsigned short)r[2 * q][1] << 16); w.y = (unsigned)(unsigned short)r[2 * q][2] | ((unsigned)(unsigned short)r[2 * q][3] << 16);
                w.z = (unsigned)(unsigned short)r[2 * q + 1][0] | ((unsigned)(unsigned short)r[2 * q + 1][1] << 16); w.w = (unsigned)(unsigned short)r[2 * q + 1][2] | ((unsigned)(unsigned short)r[2 * q + 1][3] << 16);
                *(v4u*)(op + 8 * q) = w; } }
        else { int row = n; if (I.kind == 2) { const int jj = n >> 1; row = (jj >> 7) * 256 + (n & 1) * 128 + (jj & 127); }
            unsigned char* op = (unsigned char*)I.O + (size_t)row * D + I.k0 + 32 * g;
#pragma unroll
            for (int q = 0; q < 2; ++q) { v4u w; unsigned* wp = (unsigned*)&w;
#pragma unroll
                for (int j = 0; j < 4; ++j) { const s16x4 x = r[4 * q + j]; wp[j] = pk4_fp8(bf2f((bf16)x[0]) * WSCALE, bf2f((bf16)x[1]) * WSCALE, bf2f((bf16)x[2]) * WSCALE, bf2f((bf16)x[3]) * WSCALE); }
                *(v4u*)(op + 16 * q) = w; } } }
}
__device__ __forceinline__ void p0_phase(const Frame& F, CArgs* A) {
    LAS unsigned char* lds = F.lds; const int tid = F.tid, lane = F.lane, wave = F.wave, i = lane & 15, g = lane >> 4;
    constexpr int NITEMS = 8 * 25 + 8 * 8 + NEXP * 8 * 16 + NEXP * 8 * 8;
    { v4u z = {0u, 0u, 0u, 0u}; v4u* p = (v4u*)(((bf16*)(F.ws + WS_WIN)) + (size_t)PW * D); const int n16 = (PWP - PW) * D * 2 / 16;
      for (int i = F.bid * NTHREADS + F.tid; i < n16; i += F.G * NTHREADS) p[i] = z; }
    __syncthreads();
    LAS float* sl = (LAS float*)F.lds;
    LAS float* red = (LAS float*)(F.lds + 1024 * 20 * 4);
    bool filled = false;
    for (int it = F.bid; it < 6144 / 64; it += F.G) {
        if (!filled) {
            for (int i = F.tid; i < 17 * 1024; i += NTHREADS) { const int m = i >> 10, k = i & 1023; const float v = (m < 16) ? A->in[1][m * 1024 + k] : A->in[3][k]; sl[k * 20 + m] = v * __builtin_amdgcn_rcpf(1.0f + fexp(-v)); }
            filled = true; __syncthreads();
        }
        float a[17];
#pragma unroll
        for (int m = 0; m < 17; ++m) a[m] = 0.f;
        const int j = it * 64 + F.lane;
#pragma unroll 1
        for (int kb = 0; kb < 128; kb += 16) { float wv[16];
#pragma unroll
          for (int q = 0; q < 16; ++q) wv[q] = A->in[4][(size_t)(F.wave * 128 + kb + q) * 6144 + j];
#pragma unroll
          for (int q = 0; q < 16; ++q) { const int k = F.wave * 128 + kb + q; const float w = wv[q];
            const LAS float* sp = sl + k * 20;
            const f32x4 s0 = *(const LAS f32x4*)sp, s1 = *(const LAS f32x4*)(sp + 4), s2 = *(const LAS f32x4*)(sp + 8), s3 = *(const LAS f32x4*)(sp + 12); const float s4 = sp[16];
            a[0] += s0[0] * w; a[1] += s0[1] * w; a[2] += s0[2] * w; a[3] += s0[3] * w; a[4] += s1[0] * w; a[5] += s1[1] * w; a[6] += s1[2] * w; a[7] += s1[3] * w;
            a[8] += s2[0] * w; a[9] += s2[1] * w; a[10] += s2[2] * w; a[11] += s2[3] * w; a[12] += s3[0] * w; a[13] += s3[1] * w; a[14] += s3[2] * w; a[15] += s3[3] * w; a[16] += s4 * w; } }
#pragma unroll
        for (int m = 0; m < 17; ++m) red[(F.wave * 17 + m) * 64 + F.lane] = a[m];
        __syncthreads();
        for (int i = F.tid; i < 17 * 64; i += NTHREADS) { const int m = i >> 6, l = i & 63; float s = 0.f;
#pragma unroll
            for (int w = 0; w < 8; ++w) s += red[(w * 17 + m) * 64 + l];
            ((float*)(F.ws + WS_MOD))[(size_t)m * 6144 + it * 64 + l] = s + A->in[5][it * 64 + l]; }
        __syncthreads();
    }
    __syncthreads();
    int first = F.bid, stride = F.G, cnt = (NITEMS + F.G - 1) / F.G;
    if (F.G == 256) { if (F.bid >= 96) { first = F.bid - 96; stride = 160; cnt = 26; } else { first = 160 * 26 + F.bid; stride = 96; cnt = 24; } }
    static_assert(160 * 26 + 96 * 24 >= NITEMS, "P0 item split");
    f32x4 va[8], vb[8];
    if (first < NITEMS) { const P0Item I0 = p0_item(F, A, first); p0_load(I0, tid, va); }
    if (cnt > 1 && first + stride < NITEMS) { const P0Item I1 = p0_item(F, A, first + stride); p0_load(I1, tid, vb); }
#define P0_STEP(VCUR, k_) do { const int it_ = first + (k_) * stride; const P0Item I = p0_item(F, A, it_); \
        _Pragma("unroll") for (int q = 0; q < 8; ++q) { const int idx = tid + NTHREADS * q, k = idx >> 5, p = idx & 31; v2u w; w.x = pk2(VCUR[q][0], VCUR[q][1]); w.y = pk2(VCUR[q][2], VCUR[q][3]); \
            *(LAS v2u*)(lds + (k * P0_TS + 4 * p) * 2) = w; } \
        if ((k_) + 2 < cnt && it_ + 2 * stride < NITEMS) { const P0Item In = p0_item(F, A, it_ + 2 * stride); p0_load(In, tid, VCUR); } \
        LDS_BARRIER(); \
        p0_emit(I, lds, wave, i, g); \
        LDS_BARRIER(); } while (0)
#pragma unroll 1
    for (int k = 0; k < cnt && first + k * stride < NITEMS; k += 2) {
        P0_STEP(va, k);
        if (k + 1 < cnt && first + (k + 1) * stride < NITEMS) P0_STEP(vb, k + 1);
    }
#undef P0_STEP
}

__device__ __forceinline__ void p1_phase(const Frame& F, CArgs* A) {
    const int gw = F.bid * NWAVES + F.wave, NGW = F.G * NWAVES;
    for (int r0 = gw; r0 < NROWS; r0 += 2 * NGW) {
        const int r1 = r0 + NGW; const bool two = r1 < NROWS;
        const float* xa = (r0 < NLAT) ? A->in[0] + (size_t)r0 * D : A->in[2] + (size_t)(r0 - NLAT) * D;
        const float* xb = !two ? xa : ((r1 < NLAT) ? A->in[0] + (size_t)r1 * D : A->in[2] + (size_t)(r1 - NLAT) * D);
        f32x4 va[4], vb[4];
#pragma unroll
        for (int j = 0; j < 4; ++j) { va[j] = ((const f32x4*)xa)[F.lane + 64 * j]; vb[j] = ((const f32x4*)xb)[F.lane + 64 * j]; }
#pragma unroll
        for (int which = 0; which < 2; ++which) { if (which == 1 && !two) break;
            const int r = which ? r1 : r0; const int mrow = (r < NLAT) ? (r >> 12) : 16;
            const float* sh = ((float*)(F.ws + WS_MOD)) + (size_t)mrow * 6144; const float* sc = sh + 1024;
            float s = 0.f;
#pragma unroll
            for (int j = 0; j < 4; ++j) { const f32x4 v = which ? vb[j] : va[j]; s += (v.x * v.x + v.y * v.y) + (v.z * v.z + v.w * v.w); }
            const float rstd = 1.0f / sqrtf(wave_sum(s) * (1.f / D) + EPS);
            unsigned long long* o8 = (unsigned long long*)(((bf16*)(F.ws + WS_HN)) + (size_t)r * D) + F.lane;
#pragma unroll
            for (int j = 0; j < 4; ++j) { const int c4 = F.lane + 64 * j; const f32x4 v = which ? vb[j] : va[j]; const f32x4 w = ((const f32x4*)A->in[6])[c4], a = ((const f32x4*)sc)[c4], b = ((const f32x4*)sh)[c4];
                const f32x4 y = (v * rstd) * w * (a + 1.0f) + b;
                o8[64 * j] = (unsigned long long)pk2(y.x, y.y) | ((unsigned long long)pk2(y.z, y.w) << 32); } }
    }
}

constexpr int GL_ZL = 0;
constexpr int GL_BC = 8192;
constexpr int GL_TOT = GL_BC + 32768;
constexpr int GL_V = GL_TOT + 512;
constexpr int GL_A = GL_V + 64 * 136 * 2;
constexpr int GL_B = GL_A + 2 * 64 * 72 * 2;
constexpr int GL_P = GL_B + 2 * 64 * 72 * 2;
constexpr int GL_SS = GL_P + 64 * 72 * 2;
constexpr int GL_SEG = GL_SS + 512;
constexpr int GL_END = GL_SEG + 2048;
static_assert(GL_END <= RING_BYTES && (GL_V % 16) == 0 && (GL_A % 16) == 0 && (GL_B % 16) == 0 && (GL_P % 16) == 0, "GLA LDS map");

__device__ __forceinline__ s16x4 tr_read(unsigned lds_addr) { s16x4 r; asm volatile("ds_read_b64_tr_b16 %0, %1\n\ts_waitcnt lgkmcnt(0)" : "=&v"(r) : "v"(lds_addr) : "memory"); return r; }
__device__ __forceinline__ void v_frag2(LAS unsigned char* lds, int v0, int lane, bf16x8& f0, bf16x8& f1) {
    const int i = lane & 15, g = lane >> 4;
    const unsigned a0 = (unsigned)(uintptr_t)(lds + GL_V) + (unsigned)(((8 * g + (i >> 2)) * 136 + v0 + 4 * (i & 3)) * 2);
    s16x4 r0, r1, r2, r3;
    asm volatile("ds_read_b64_tr_b16 %0, %4\n\tds_read_b64_tr_b16 %1, %4 offset:1088\n\tds_read_b64_tr_b16 %2, %4 offset:8704\n\tds_read_b64_tr_b16 %3, %4 offset:9792\n\ts_waitcnt lgkmcnt(0)"
                 : "=&v"(r0), "=&v"(r1), "=&v"(r2), "=&v"(r3) : "v"(a0) : "memory");
    f0[0] = r0[0]; f0[1] = r0[1]; f0[2] = r0[2]; f0[3] = r0[3]; f0[4] = r1[0]; f0[5] = r1[1]; f0[6] = r1[2]; f0[7] = r1[3];
    f1[0] = r2[0]; f1[1] = r2[1]; f1[2] = r2[2]; f1[3] = r2[3]; f1[4] = r3[0]; f1[5] = r3[1]; f1[6] = r3[2]; f1[7] = r3[3];
}
__device__ __forceinline__ bf16x8 v_frag(LAS unsigned char* lds, int ks, int v0, int lane) {
    const int i = lane & 15, g = lane >> 4;
    const unsigned a0 = (unsigned)(uintptr_t)(lds + GL_V) + (unsigned)(((32 * ks + 8 * g + (i >> 2)) * 136 + v0 + 4 * (i & 3)) * 2);
    const s16x4 lo = tr_read(a0), hi = tr_read(a0 + 4 * 136 * 2);
    bf16x8 r; r[0] = lo[0]; r[1] = lo[1]; r[2] = lo[2]; r[3] = lo[3]; r[4] = hi[0]; r[5] = hi[1]; r[6] = hi[2]; r[7] = hi[3]; return r;
}
struct GlaRegs { v4u zw, vw[2]; };
__device__ __forceinline__ GlaRegs gla_load(const Frame& F, size_t prow, int h) {
    GlaRegs r; const int tid = F.tid; const bf16* P = (const bf16*)(F.ws + WS_P);
    { const int t = (tid & 255) >> 2, q = tid & 3; r.zw = *(const v4u*)(P + (prow + t) * PW + CAF + 8 * q); }
#pragma unroll
    for (int i = 0; i < 2; ++i) { const int pc = tid + i * NTHREADS, t = pc >> 4, c = pc & 15; r.vw[i] = *(const v4u*)(P + (prow + t) * PW + CV + h * 128 + c * 8); }
    return r;
}
__device__ __forceinline__ void gla_prep(const Frame& F, CArgs* A, const GlaRegs& R, int h) {
    LAS unsigned char* lds = F.lds; const int tid = F.tid;
    if (tid < 256) { const int t = tid >> 2, q = tid & 3; const v4u w = R.zw;
        LAS float* z = (LAS float*)(lds + GL_ZL) + (q >> 1) * 1024 + t * 16 + (q & 1) * 8;
        *(LAS f32x4*)z = (f32x4){bflo(w.x), bfhi(w.x), bflo(w.y), bfhi(w.y)}; *(LAS f32x4*)(z + 4) = (f32x4){bflo(w.z), bfhi(w.z), bflo(w.w), bfhi(w.w)}; }
#pragma unroll
    for (int i = 0; i < 2; ++i) { const int pc = tid + i * NTHREADS, t = pc >> 4, c = pc & 15; *(LAS v4u*)(lds + GL_V + (t * 136 + c * 8) * 2) = R.vw[i]; }
    __syncthreads();
    { const int dir = tid >> 8, seg = (tid >> 6) & 3, d = tid & 63;
      const float* up = dir ? A->in[10] : A->in[8]; const float bias = (dir ? A->in[11] : A->in[9])[h * 64 + d];
      float u[16];
#pragma unroll
      for (int r = 0; r < 16; ++r) u[r] = up[r * 256 + h * 64 + d];
      const LAS float* zl = (const LAS float*)(lds + GL_ZL) + dir * 1024; LAS float* bc = (LAS float*)(lds + GL_BC) + dir * 4096 + d;
      LAS float* sg = (LAS float*)(lds + GL_SEG) + dir * 256 + d;
      float c[16]; float cum = 0.f;
#pragma unroll
      for (int i = 0; i < 16; ++i) { const int t = seg * 16 + (dir ? 15 - i : i); const LAS float* zp = zl + t * 16;
          const f32x4 z0 = *(const LAS f32x4*)zp, z1 = *(const LAS f32x4*)(zp + 4), z2 = *(const LAS f32x4*)(zp + 8), z3 = *(const LAS f32x4*)(zp + 12);
          float z = bias + z0[0] * u[0] + z0[1] * u[1] + z0[2] * u[2] + z0[3] * u[3] + z1[0] * u[4] + z1[1] * u[5] + z1[2] * u[6] + z1[3] * u[7]
                         + z2[0] * u[8] + z2[1] * u[9] + z2[2] * u[10] + z2[3] * u[11] + z3[0] * u[12] + z3[1] * u[13] + z3[2] * u[14] + z3[3] * u[15];
          const float ls = fminf(z, 0.f) - __logf(1.0f + __expf(-fabsf(z)));
          cum += ls * (1.0f / 16.0f); c[i] = cum; }
      sg[seg * 64] = cum;
      __syncthreads();
      float off = 0.f, tot = 0.f;
#pragma unroll
      for (int s2 = 0; s2 < 4; ++s2) { const float v = sg[s2 * 64]; tot += v; off += (dir ? (s2 > seg) : (s2 < seg)) ? v : 0.f; }
#pragma unroll
      for (int i = 0; i < 16; ++i) { const int t = seg * 16 + (dir ? 15 - i : i); bc[t * 64] = off + c[i]; }
      if (seg == 0) ((LAS float*)(lds + GL_TOT))[dir * 64 + d] = tot; }
    __syncthreads();
}

__device__ __forceinline__ size_t chunk_row(int b, int cc) { return cc < 4 ? (size_t)NLAT + b * CTXL + cc * 64 : (size_t)b * SEQ + (cc - 4) * 64; }
__device__ __forceinline__ void p3_phase(const Frame& F, CArgs* A) {
    LAS unsigned char* lds = F.lds; const int tid = F.tid, lane = F.lane, wave = F.wave;
    GlaRegs cur; if (F.bid < NBATCH * NCC * 4) { const int bc0 = F.bid >> 2; cur = gla_load(F, chunk_row(bc0 / NCC, bc0 % NCC), F.bid & 3); }
    for (int it = F.bid; it < NBATCH * NCC * 4; it += F.G) {
        const int h = it & 3, bc = it >> 2, b = bc / NCC, cc = bc % NCC; const size_t prow = chunk_row(b, cc);
        GlaRegs nxt = cur; { const int itn = it + F.G; if (itn < NBATCH * NCC * 4) { const int bcn = itn >> 2; nxt = gla_load(F, chunk_row(bcn / NCC, bcn % NCC), itn & 3); } }
        float kf[8];
        { const int d = tid & 63, tg = tid >> 6;
#pragma unroll
          for (int j = 0; j < 8; ++j) kf[j] = bf2f(((bf16*)(F.ws + WS_P))[(prow + tg * 8 + j) * PW + CK + h * 64 + d]); }
        gla_prep(F, A, cur, h); cur = nxt;
        if (tid < 128) { const int dir = tid >> 6, d = tid & 63; ((float*)(F.ws + WS_DECAY))[(((size_t)dir * NBATCH + b) * NCC + cc) * 256 + h * 64 + d] = __expf(((const LAS float*)(lds + GL_TOT))[dir * 64 + d]); }
        { const int d = tid & 63, tg = tid >> 6;
#pragma unroll
          for (int dir = 0; dir < 2; ++dir) { const float tot = ((const LAS float*)(lds + GL_TOT))[dir * 64 + d]; const LAS float* bcp = (const LAS float*)(lds + GL_BC) + dir * 4096 + (tg * 8) * 64 + d; float s[8];
#pragma unroll
              for (int j = 0; j < 8; ++j) s[j] = kf[j] * __expf(tot - bcp[j * 64]);
              v4u w; w.x = pk2(s[0], s[1]); w.y = pk2(s[2], s[3]); w.z = pk2(s[4], s[5]); w.w = pk2(s[6], s[7]);
              *(LAS v4u*)(lds + GL_A + ((dir * 64 + d) * 72 + tg * 8) * 2) = w; } }
        __syncthreads();
        { const int dir = wave & 1, dt = wave >> 1, i = lane & 15, g = lane >> 4;
          bf16x8 af[2];
#pragma unroll
          for (int ks = 0; ks < 2; ++ks) af[ks] = *(const LAS bf16x8*)(lds + GL_A + ((dir * 64 + dt * 16 + i) * 72 + 32 * ks + 8 * g) * 2);
          bf16* kvp = ((bf16*)(F.ws + WS_KV)) + ((((size_t)dir * NBATCH + b) * NCC + cc) * 4 + h) * 8192;
#pragma unroll 2
          for (int vt = 0; vt < 8; ++vt) { f32x4 acc = {0.f, 0.f, 0.f, 0.f}; bf16x8 vf0, vf1; v_frag2(lds, vt * 16, lane, vf0, vf1);
              acc = __builtin_amdgcn_mfma_f32_16x16x32_bf16(af[0], vf0, acc, 0, 0, 0); acc = __builtin_amdgcn_mfma_f32_16x16x32_bf16(af[1], vf1, acc, 0, 0, 0);
              v2u w; w.x = pk2(acc[0], acc[1]); w.y = pk2(acc[2], acc[3]);
              *(v2u*)(kvp + (size_t)(vt * 16 + i) * 64 + dt * 16 + 4 * g) = w; } }
        __syncthreads();
    }
}

constexpr int G2_ZL = 0;
constexpr int G2_HT = 8192;
constexpr int G2_TOT = G2_HT + 4096;
constexpr int G2_A = G2_TOT + 1024;
constexpr int G2_B = G2_A + 256 * 72 * 2;
constexpr int G2_VS = 528;
static_assert(G2_B + 64 * G2_VS * 2 <= RING_BYTES && G2_B + 256 * 72 * 2 <= RING_BYTES && (G2_A % 16) == 0 && (G2_B % 16) == 0, "GLA v2 LDS map");
__device__ __forceinline__ void tr_frag2(unsigned tile_addr, int c0, int lane, bf16x8& f0, bf16x8& f1) {
    const int i = lane & 15, g = lane >> 4;
    const unsigned a0 = tile_addr + (unsigned)(((8 * g + (i >> 2)) * G2_VS + c0 + 4 * (i & 3)) * 2);
    s16x4 r0, r1, r2, r3;
    asm volatile("ds_read_b64_tr_b16 %0, %4\n\tds_read_b64_tr_b16 %1, %4 offset:4224\n\tds_read_b64_tr_b16 %2, %4 offset:33792\n\tds_read_b64_tr_b16 %3, %4 offset:38016\n\ts_waitcnt lgkmcnt(0)"
                 : "=&v"(r0), "=&v"(r1), "=&v"(r2), "=&v"(r3) : "v"(a0) : "memory");
    f0[0] = r0[0]; f0[1] = r0[1]; f0[2] = r0[2]; f0[3] = r0[3]; f0[4] = r1[0]; f0[5] = r1[1]; f0[6] = r1[2]; f0[7] = r1[3];
    f1[0] = r2[0]; f1[1] = r2[1]; f1[2] = r2[2]; f1[3] = r2[3]; f1[4] = r3[0]; f1[5] = r3[1]; f1[6] = r3[2]; f1[7] = r3[3];
}
static_assert(4 * G2_VS * 2 == 4224 && 32 * G2_VS * 2 == 33792 && 36 * G2_VS * 2 == 38016, "tr_frag2 offsets");
__device__ __forceinline__ float log_sigmoid16(float z) { return (fminf(z, 0.f) - __logf(1.0f + __expf(-fabsf(z)))) * (1.0f / 16.0f); }

__device__ __forceinline__ void p3v2_phase(const Frame& F, CArgs* A) {
    LAS unsigned char* lds = F.lds; const int tid = F.tid, lane = F.lane, wave = F.wave, i = lane & 15, g = lane >> 4;
    const int c = tid & 255, th = tid >> 8;
    const bf16* P = (const bf16*)(F.ws + WS_P);
#pragma unroll 1
    for (int it = F.bid; it < NBATCH * NCC; it += F.G) {
        const int b = it / NCC, cc = it % NCC; const size_t prow = chunk_row(b, cc);
        if (tid < 256) { const int t = tid >> 2, q = tid & 3; const v4u w = *(const v4u*)(P + (prow + t) * PW + CAF + 8 * q);
            LAS float* z = (LAS float*)(lds + G2_ZL) + (q >> 1) * 1024 + t * 16 + (q & 1) * 8;
            *(LAS f32x4*)z = (f32x4){bflo(w.x), bfhi(w.x), bflo(w.y), bfhi(w.y)}; *(LAS f32x4*)(z + 4) = (f32x4){bflo(w.z), bfhi(w.z), bflo(w.w), bfhi(w.w)}; }
#pragma unroll
        for (int j = 0; j < 8; ++j) { const int pc = tid + j * NTHREADS, t = pc >> 6, cv = pc & 63;
            *(LAS v4u*)(lds + G2_B + (t * G2_VS + cv * 8) * 2) = *(const v4u*)(P + (prow + t) * PW + CV + cv * 8); }
        float kk[32];
#pragma unroll
        for (int tl = 0; tl < 32; ++tl) kk[tl] = bf2f(P[(prow + th * 32 + tl) * PW + CK + c]);
        __syncthreads();
#pragma unroll
        for (int dir = 0; dir < 2; ++dir) {
            { const float* up = dir ? A->in[10] : A->in[8]; const float bias = (dir ? A->in[11] : A->in[9])[c];
              float u[16];
#pragma unroll
              for (int r = 0; r < 16; ++r) u[r] = up[r * 256 + c];
              const LAS float* zl = (const LAS float*)(lds + G2_ZL) + dir * 1024 + th * 512;
              float cl[32]; float cum = 0.f;
#pragma unroll
              for (int ii = 0; ii < 32; ++ii) { const int tl = dir ? 31 - ii : ii; const LAS float* zp = zl + tl * 16;
                  const f32x4 z0 = *(const LAS f32x4*)zp, z1 = *(const LAS f32x4*)(zp + 4), z2 = *(const LAS f32x4*)(zp + 8), z3 = *(const LAS f32x4*)(zp + 12);
                  const float z = bias + z0[0] * u[0] + z0[1] * u[1] + z0[2] * u[2] + z0[3] * u[3] + z1[0] * u[4] + z1[1] * u[5] + z1[2] * u[6] + z1[3] * u[7]
                                       + z2[0] * u[8] + z2[1] * u[9] + z2[2] * u[10] + z2[3] * u[11] + z3[0] * u[12] + z3[1] * u[13] + z3[2] * u[14] + z3[3] * u[15];
                  cum += log_sigmoid16(z); cl[tl] = cum; }
              LAS float* ht = (LAS float*)(lds + G2_HT) + dir * 512;
              ht[th * 256 + c] = cum;
              __syncthreads();
              const float other = ht[(1 - th) * 256 + c], tot = cum + other;
              const float off = (dir == 0) ? (th ? other : 0.f) : (th ? 0.f : other);
              if (th == 0) { ((LAS float*)(lds + G2_TOT))[c] = tot; ((float*)(F.ws + WS_DECAY))[(((size_t)dir * NBATCH + b) * NCC + cc) * 256 + c] = __expf(tot); }
#pragma unroll
              for (int j = 0; j < 4; ++j) { float e[8];
#pragma unroll
                  for (int q = 0; q < 8; ++q) e[q] = kk[8 * j + q] * __expf(-(off + cl[8 * j + q]));
                  v4u w; w.x = pk2(e[0], e[1]); w.y = pk2(e[2], e[3]); w.z = pk2(e[4], e[5]); w.w = pk2(e[6], e[7]);
                  *(LAS v4u*)(lds + G2_A + (c * 72 + th * 32 + 8 * j) * 2) = w; } }
            __syncthreads();
            { const int h = wave >> 1, vh = wave & 1;
              bf16x8 af[4][2];
#pragma unroll
              for (int dt = 0; dt < 4; ++dt)
#pragma unroll
                  for (int ks = 0; ks < 2; ++ks) af[dt][ks] = *(const LAS bf16x8*)(lds + G2_A + ((h * 64 + dt * 16 + i) * 72 + 32 * ks + 8 * g) * 2);
              f32x4 et[4];
#pragma unroll
              for (int dt = 0; dt < 4; ++dt) { const f32x4 tv = *(const LAS f32x4*)(lds + G2_TOT + (h * 64 + dt * 16 + 4 * g) * 4); et[dt] = (f32x4){__expf(tv[0]), __expf(tv[1]), __expf(tv[2]), __expf(tv[3])}; }
              bf16* kvp = ((bf16*)(F.ws + WS_KV)) + ((((size_t)dir * NBATCH + b) * NCC + cc) * 4 + h) * 8192;
              bf16* vtp = ((bf16*)(F.ws + WS_VT)) + (((size_t)b * 64 + (cc - 4)) * 4 + h) * 8192;
#pragma unroll
              for (int vt = 0; vt < 4; ++vt) { const int v0 = vh * 64 + vt * 16; bf16x8 vf0, vf1; tr_frag2((unsigned)(uintptr_t)(lds + G2_B), h * 128 + v0, lane, vf0, vf1);
                  if (dir == 0 && cc >= 4) { *(bf16x8*)(vtp + (size_t)(v0 + i) * 64 + 8 * g) = vf0; *(bf16x8*)(vtp + (size_t)(v0 + i) * 64 + 32 + 8 * g) = vf1; }
#pragma unroll
                  for (int dt = 0; dt < 4; ++dt) { f32x4 acc = {0.f, 0.f, 0.f, 0.f};
                      acc = __builtin_amdgcn_mfma_f32_16x16x32_bf16(af[dt][0], vf0, acc, 0, 0, 0); acc = __builtin_amdgcn_mfma_f32_16x16x32_bf16(af[dt][1], vf1, acc, 0, 0, 0);
                      acc = acc * et[dt];
                      v2u w; w.x = pk2(acc[0], acc[1]); w.y = pk2(acc[2], acc[3]);
                      *(v2u*)(kvp + (size_t)(v0 + i) * 64 + dt * 16 + 4 * g) = w; } } }
            __syncthreads();
        }
    }
}

struct GateConst { bf16x8 bw[2][2]; float bias[2][2]; };
__device__ __forceinline__ GateConst gate_setup(CArgs* A, int wave, int lane) {
    GateConst G; const int i = lane & 15, g = lane >> 4;
#pragma unroll
    for (int dir = 0; dir < 2; ++dir)
#pragma unroll
        for (int cti = 0; cti < 2; ++cti) { const int c = 32 * wave + 16 * cti + i; const float* up = dir ? A->in[10] : A->in[8];
            G.bias[dir][cti] = (dir ? A->in[11] : A->in[9])[c];
#pragma unroll
            for (int jj = 0; jj < 8; ++jj) { const float v = up[(8 * (g & 1) + jj) * 256 + c]; const unsigned hi = f2bf(v); const float rem = v - __builtin_bit_cast(float, hi << 16);
                G.bw[dir][cti][jj] = (short)((g < 2) ? hi : f2bf(rem)); } }
    return G;
}
__device__ __forceinline__ float log_sigmoid16_fast(float z) { const float e = __builtin_amdgcn_exp2f(fabsf(z) * -1.4426950409f); return (fminf(z, 0.f) - __builtin_amdgcn_logf(1.0f + e) * 0.6931471806f) * 0.0625f; }
__device__ __forceinline__ void gate_b(const GateConst& G, const bf16* P, size_t prow, int lane, f32x4 (&bv)[2][2][4], float (&tot)[2][2]) {
    const int i = lane & 15, g = lane >> 4;
    bf16x8 za[2][4];
#pragma unroll
    for (int dir = 0; dir < 2; ++dir)
#pragma unroll
        for (int tt = 0; tt < 4; ++tt) za[dir][tt] = *(const bf16x8*)(P + (prow + 16 * tt + i) * PW + CAF + 16 * dir + 8 * (g & 1));
#pragma unroll
    for (int dir = 0; dir < 2; ++dir)
#pragma unroll
        for (int cti = 0; cti < 2; ++cti) { float carry = 0.f;
#pragma unroll
            for (int q = 0; q < 4; ++q) { const int tt = dir ? 3 - q : q;
                f32x4 z = {0.f, 0.f, 0.f, 0.f}; z = __builtin_amdgcn_mfma_f32_16x16x32_bf16(za[dir][tt], G.bw[dir][cti], z, 0, 0, 0);
                float la[4];
#pragma unroll
                for (int r = 0; r < 4; ++r) la[r] = log_sigmoid16_fast(z[r] + G.bias[dir][cti]);
                float p[4];
                if (dir == 0) { p[0] = la[0]; p[1] = p[0] + la[1]; p[2] = p[1] + la[2]; p[3] = p[2] + la[3];
                    const float s = p[3]; float incl = s; const float t1 = __shfl_up(incl, 16); if (g >= 1) incl += t1; const float t2 = __shfl_up(incl, 32); if (g >= 2) incl += t2;
                    const float base = carry + (incl - s); carry += __shfl(incl, 48 + i);
                    bv[dir][cti][tt] = (f32x4){base + p[0], base + p[1], base + p[2], base + p[3]}; }
                else { p[3] = la[3]; p[2] = p[3] + la[2]; p[1] = p[2] + la[1]; p[0] = p[1] + la[0];
                    const float s = p[0]; float incl = s; const float t1 = __shfl_down(incl, 16); if (g <= 2) incl += t1; const float t2 = __shfl_down(incl, 32); if (g <= 1) incl += t2;
                    const float base = carry + (incl - s); carry += __shfl(incl, i);
                    bv[dir][cti][tt] = (f32x4){base + p[0], base + p[1], base + p[2], base + p[3]}; } }
            tot[dir][cti] = carry; }
}

constexpr int G3_ST = 0;
constexpr int G3_TOT = 8 * 16 * 144;
constexpr int G3_A = G3_TOT + 1024;
constexpr int G3_B = G3_A + 256 * 72 * 2;
static_assert(G3_B + 64 * G2_VS * 2 <= RING_BYTES && (G3_A % 16) == 0 && (G3_B % 16) == 0, "P3 LDS map");
template <int MODE>
__device__ __forceinline__ void p3v3_phase(const Frame& F, CArgs* A) {
    int tid_ = F.tid; asm volatile("" : "+v"(tid_));
    LAS unsigned char* lds = F.lds; const int tid = tid_, lane = tid & 63, wave = __builtin_amdgcn_readfirstlane(tid >> 6), i = lane & 15, g = lane >> 4;
    const bf16* P = (const bf16*)(F.ws + WS_P);
    const GateConst G = gate_setup(A, wave, lane);
    LAS unsigned char* st = lds + G3_ST + wave * (16 * 144);
#pragma unroll 1
    for (int it = F.bid; it < NBATCH * NCC; it += F.G) {
        const int b = it / NCC, cc = it % NCC; const size_t prow = chunk_row(b, cc);
        unsigned pf0 = 0u, pf1 = 0u;
#pragma unroll
        for (int j = 0; j < 8; ++j) { const int pc = tid + j * NTHREADS, t = pc >> 6, cv = pc & 63;
            *(LAS v4u*)(lds + G3_B + (t * G2_VS + cv * 8) * 2) = *(const v4u*)(P + (prow + t) * PW + CV + cv * 8); }
        unsigned kk[2][4][2];
#pragma unroll
        for (int cti = 0; cti < 2; ++cti)
#pragma unroll
            for (int tt = 0; tt < 4; ++tt)
#pragma unroll
                for (int r = 0; r < 4; r += 2) { const bf16* kp = P + (prow + 16 * tt + 4 * g + r) * PW + CK + 32 * wave + 16 * cti + i; kk[cti][tt][r >> 1] = (unsigned)kp[0] | ((unsigned)kp[PW] << 16); }
        f32x4 bv[2][2][4]; float tot[2][2];
        if (MODE < 4) gate_b(G, P, prow, lane, bv, tot); else {
#pragma unroll
            for (int a_ = 0; a_ < 2; ++a_)
#pragma unroll
                for (int b_ = 0; b_ < 2; ++b_) { tot[a_][b_] = 0.f;
#pragma unroll
                    for (int c_ = 0; c_ < 4; ++c_) bv[a_][b_][c_] = (f32x4){0.f, 0.f, 0.f, 0.f}; } }
#pragma unroll
        for (int dir = 0; dir < 2; ++dir) {
#pragma unroll
            for (int cti = 0; cti < 2; ++cti) { const int c = 32 * wave + 16 * cti + i;
#pragma unroll
                for (int tt = 0; tt < 4; ++tt) { float e[4];
#pragma unroll
                    for (int r = 0; r < 4; ++r) e[r] = ((r & 1) ? bfhi(kk[cti][tt][r >> 1]) : bflo(kk[cti][tt][r >> 1])) * __builtin_amdgcn_exp2f(bv[dir][cti][tt][r] * -1.4426950409f);
                    v2u w; w.x = pk2(e[0], e[1]); w.y = pk2(e[2], e[3]);
                    *(LAS v2u*)(lds + G3_A + (c * 72 + 16 * tt + 4 * g) * 2) = w; }
                if (g == 0) { ((LAS float*)(lds + G3_TOT))[c] = tot[dir][cti]; if (!MODE) ((float*)(F.ws + WS_DECAY))[(((size_t)dir * NBATCH + b) * NCC + cc) * 256 + c] = __expf(tot[dir][cti]); } }
            LDS_BARRIER();
            if (dir == 0) {
                const int itn = it + F.G; if (itn < NBATCH * NCC) { const char* pr = (const char*)(P + (chunk_row(itn / NCC, itn % NCC) + (tid >> 3)) * PW); const int j = tid & 7;
                    pf0 = *(const unsigned*)(pr + 512 + 128 * j); pf1 = *(const unsigned*)(pr + (j < 5 ? 512 + 128 * (8 + j) : 3072 + 32 * (j - 5))); } }
            if (MODE < 3) { const int h = wave >> 1, vh = wave & 1;
              bf16x8 af[4][2];
#pragma unroll
              for (int dt = 0; dt < 4; ++dt)
#pragma unroll
                  for (int ks = 0; ks < 2; ++ks) af[dt][ks] = *(const LAS bf16x8*)(lds + G3_A + ((h * 64 + dt * 16 + i) * 72 + 32 * ks + 8 * g) * 2);
              bf16* kvp = ((bf16*)(F.ws + WS_KV)) + ((((size_t)dir * NBATCH + b) * NCC + cc) * 4 + h) * 8192;
              bf16* vtp = ((bf16*)(F.ws + WS_VT)) + (((size_t)b * 64 + (cc - 4)) * 4 + h) * 8192;
              if (MODE) { kvp = ((bf16*)(F.ws + WS_TOTAL)) + (size_t)(F.bid * 8 + wave) * 512; vtp = kvp + 1024 * 1024; }
#pragma unroll
              for (int vt = 0; vt < 4; ++vt) { const int v0 = vh * 64 + vt * 16; bf16x8 vf0, vf1; tr_frag2((unsigned)(uintptr_t)(lds + G3_B), h * 128 + v0, lane, vf0, vf1);
                  if (dir == 0 && cc >= 4) {
                      *(LAS bf16x8*)(st + i * 144 + 16 * g) = vf0; *(LAS bf16x8*)(st + i * 144 + 64 + 16 * g) = vf1;
                      LDS_WAIT();
#pragma unroll
                      for (int j = 0; j < 2; ++j) { const int pc = lane + 64 * j, row = pc >> 3, ch = pc & 7; const v4u x_ = *(const LAS v4u*)(st + row * 144 + ch * 16); if (MODE == 2) asm volatile("" :: "v"(x_)); else *(v4u*)(vtp + (size_t)((MODE ? 0 : v0) + row) * 64 + ch * 8) = x_; }
                      LDS_WAIT(); }
#pragma unroll
                  for (int dt = 0; dt < 4; ++dt) { f32x4 acc = {0.f, 0.f, 0.f, 0.f};
                      acc = __builtin_amdgcn_mfma_f32_16x16x32_bf16(af[dt][0], vf0, acc, 0, 0, 0); acc = __builtin_amdgcn_mfma_f32_16x16x32_bf16(af[dt][1], vf1, acc, 0, 0, 0);
                      { const f32x4 tv = *(const LAS f32x4*)(lds + G3_TOT + (h * 64 + dt * 16 + 4 * g) * 4);
                        acc = acc * (f32x4){__builtin_amdgcn_exp2f(tv[0] * 1.4426950409f), __builtin_amdgcn_exp2f(tv[1] * 1.4426950409f), __builtin_amdgcn_exp2f(tv[2] * 1.4426950409f), __builtin_amdgcn_exp2f(tv[3] * 1.4426950409f)}; }
                      v2u w; w.x = pk2(acc[0], acc[1]); w.y = pk2(acc[2], acc[3]);
                      *(LAS v2u*)(st + i * 144 + (16 * dt + 4 * g) * 2) = w; }
                  LDS_WAIT();
#pragma unroll
                  for (int j = 0; j < 2; ++j) { const int pc = lane + 64 * j, row = pc >> 3, ch = pc & 7; const v4u x_ = *(const LAS v4u*)(st + row * 144 + ch * 16); if (MODE == 2) asm volatile("" :: "v"(x_)); else *(v4u*)(kvp + (size_t)((MODE ? 0 : v0) + row) * 64 + ch * 8) = x_; }
                  LDS_WAIT(); } }
            LDS_BARRIER();
        }
        asm volatile("" :: "v"(pf0), "v"(pf1));
    }
}

struct ConvRegs { v4u cw[6], xw[6], bw[4]; };
__device__ __forceinline__ void conv_load(const bf16* P, int u, int t, ConvRegs& R) {
    const int item = u >> 1, b = item >> 6, n = item & 63; const size_t prow = (size_t)b * SEQ + n * 64; const int t0 = (u & 1) * 32 + (t >> 6) * 4, c0 = (t & 63) * 8;
#pragma unroll
    for (int q = 0; q < 6; ++q) { const int tt = t0 - 1 + q, tc = tt < 0 ? 0 : (tt > 63 ? 63 : tt);
        R.cw[q] = *(const v4u*)(P + (prow + tc) * PW + CPC + c0); R.xw[q] = *(const v4u*)(P + (prow + tc) * PW + CPX + c0); }
#pragma unroll
    for (int q = 0; q < 4; ++q) R.bw[q] = *(const v4u*)(P + (prow + t0 + q) * PW + CPB + c0);
}
__device__ __forceinline__ void conv_pin(ConvRegs& R) {
    asm volatile("" ::: "memory");
#pragma unroll
    for (int q = 0; q < 6; ++q) { asm volatile("" : "+v"(R.cw[q])); asm volatile("" : "+v"(R.xw[q])); }
#pragma unroll
    for (int q = 0; q < 4; ++q) asm volatile("" : "+v"(R.bw[q]));
}
__device__ __forceinline__ void conv_emit(unsigned char* ws, const f32x2 (&w2)[3][4], int u, int t, const ConvRegs& R) {
    const int item = u >> 1, b = item >> 6, n = item & 63; const size_t prow = (size_t)b * SEQ + n * 64; const int t0 = (u & 1) * 32 + (t >> 6) * 4, c0 = (t & 63) * 8;
    f32x2 ov[4][4];
#pragma unroll
    for (int j = 0; j < 4; ++j)
#pragma unroll
        for (int p = 0; p < 4; ++p) ov[j][p] = (f32x2){0.f, 0.f};
#pragma unroll
    for (int q = 0; q < 6; ++q) { const int tt = t0 - 1 + q; const bool in = tt >= 0 && tt < 64; v4u c_ = R.cw[q]; const v4u x_ = R.xw[q]; f32x2 uu[4];
        c_.x = in ? c_.x : 0u; c_.y = in ? c_.y : 0u; c_.z = in ? c_.z : 0u; c_.w = in ? c_.w : 0u;
        uu[0] = (f32x2){bflo(c_.x), bfhi(c_.x)} * (f32x2){bflo(x_.x), bfhi(x_.x)}; uu[1] = (f32x2){bflo(c_.y), bfhi(c_.y)} * (f32x2){bflo(x_.y), bfhi(x_.y)};
        uu[2] = (f32x2){bflo(c_.z), bfhi(c_.z)} * (f32x2){bflo(x_.z), bfhi(x_.z)}; uu[3] = (f32x2){bflo(c_.w), bfhi(c_.w)} * (f32x2){bflo(x_.w), bfhi(x_.w)};
#pragma unroll
        for (int dt = 0; dt < 3; ++dt) { const int j = q - dt;
            if (j >= 0 && j < 4) {
#pragma unroll
                for (int p = 0; p < 4; ++p) ov[j][p] += w2[dt][p] * uu[p]; } } }
#pragma unroll
    for (int q = 0; q < 4; ++q) { const v4u b_ = R.bw[q];
        const f32x2 y0 = ov[q][0] * (f32x2){bflo(b_.x), bfhi(b_.x)}, y1 = ov[q][1] * (f32x2){bflo(b_.y), bfhi(b_.y)}, y2 = ov[q][2] * (f32x2){bflo(b_.z), bfhi(b_.z)}, y3 = ov[q][3] * (f32x2){bflo(b_.w), bfhi(b_.w)};
        if (OUTPROJ_F8) { v2u w; w.x = pk4_fp8(y0.x, y0.y, y1.x, y1.y); w.y = pk4_fp8(y2.x, y2.y, y3.x, y3.y);
            *(v2u*)(ws + WS_YMIX + (prow + t0 + q) * D + 512 + c0) = w; }
        else { v4u w; w.x = pk2(y0.x, y0.y); w.y = pk2(y1.x, y1.y); w.z = pk2(y2.x, y2.y); w.w = pk2(y3.x, y3.y);
            *(v4u*)(((bf16*)(ws + WS_YMIX)) + (prow + t0 + q) * D + 512 + c0) = w; } }
}
__device__ __forceinline__ void conv_stream(const Frame& F, CArgs* A, int t) {
    const bf16* P = (const bf16*)(F.ws + WS_P);
    constexpr int NU = NBATCH * 64 * 2;
    f32x2 w2[3][4];
    { const int c0 = (t & 63) * 8;
#pragma unroll
      for (int dt = 0; dt < 3; ++dt) { const f32x4 a = *(const f32x4*)(A->in[13] + dt * 512 + c0), b = *(const f32x4*)(A->in[13] + dt * 512 + c0 + 4);
          w2[dt][0] = (f32x2){a[0], a[1]}; w2[dt][1] = (f32x2){a[2], a[3]}; w2[dt][2] = (f32x2){b[0], b[1]}; w2[dt][3] = (f32x2){b[2], b[3]}; } }
    ConvRegs Ra, Rb;
    int u = F.bid;
    if (u < NU) conv_load(P, u, t, Ra);
#pragma unroll 1
    for (; u < NU; u += 2 * F.G) {
        const int un = (u + F.G < NU) ? u + F.G : u, un2 = (u + 2 * F.G < NU) ? u + 2 * F.G : u;
        conv_load(P, un, t, Rb); conv_pin(Ra);
        conv_emit(F.ws, w2, u, t, Ra);
        conv_load(P, un2, t, Ra); conv_pin(Rb);
        conv_emit(F.ws, w2, un, t, Rb);
    }
}

__device__ __forceinline__ void gate_b_dir(const GateConst& G, const bf16* P, size_t prow, int lane, int dir, f32x4 (&bv)[2][4]) {
    const int i = lane & 15, g = lane >> 4;
    bf16x8 za[4];
#pragma unroll
    for (int tt = 0; tt < 4; ++tt) za[tt] = *(const bf16x8*)(P + (prow + 16 * tt + i) * PW + CAF + 16 * dir + 8 * (g & 1));
#pragma unroll
    for (int cti = 0; cti < 2; ++cti) { float carry = 0.f;
#pragma unroll
        for (int q = 0; q < 4; ++q) { const int tt = dir ? 3 - q : q;
            f32x4 z = {0.f, 0.f, 0.f, 0.f}; z = __builtin_amdgcn_mfma_f32_16x16x32_bf16(za[tt], G.bw[dir][cti], z, 0, 0, 0);
            float la[4];
#pragma unroll
            for (int r = 0; r < 4; ++r) la[r] = log_sigmoid16_fast(z[r] + G.bias[dir][cti]);
            float p[4];
            if (dir == 0) { p[0] = la[0]; p[1] = p[0] + la[1]; p[2] = p[1] + la[2]; p[3] = p[2] + la[3];
                const float s = p[3]; float incl = s; const float t1 = __shfl_up(incl, 16); if (g >= 1) incl += t1; const float t2 = __shfl_up(incl, 32); if (g >= 2) incl += t2;
                const float base = carry + (incl - s); carry += __shfl(incl, 48 + i);
                bv[cti][tt] = (f32x4){base + p[0], base + p[1], base + p[2], base + p[3]}; }
            else { p[3] = la[3]; p[2] = p[3] + la[2]; p[1] = p[2] + la[1]; p[0] = p[1] + la[0];
                const float s = p[0]; float incl = s; const float t1 = __shfl_down(incl, 16); if (g <= 2) incl += t1; const float t2 = __shfl_down(incl, 32); if (g <= 1) incl += t2;
                const float base = carry + (incl - s); carry += __shfl(incl, i);
                bv[cti][tt] = (f32x4){base + p[0], base + p[1], base + p[2], base + p[3]}; } } }
}

constexpr int G5_Q = 0;
constexpr int G5_K = 4 * 64 * 72 * 2;
constexpr int G5_P = 2 * G5_K;
static_assert(G5_P + 4 * 64 * 72 * 2 <= RING_BYTES && 8 * 16 * 272 <= G5_K, "P5 LDS map");
template <int MODE>
__device__ __forceinline__ void p5av3_phase(const Frame& F, CArgs* A) {
    LAS unsigned char* lds = F.lds;
    const bf16* P = (const bf16*)(F.ws + WS_P);
    const GateConst G = gate_setup(A, F.wave, F.lane);
#pragma unroll 1
    for (int it = F.bid; it < NBATCH * 64; it += F.G) {
        int tid_ = F.tid; asm volatile("" : "+v"(tid_));
        const int tid = tid_, lane = tid & 63, wave = __builtin_amdgcn_readfirstlane(tid >> 6), i = lane & 15, g = lane >> 4;
        const int h = wave >> 1, half = wave & 1;
        LAS unsigned char* st = lds + G5_Q + wave * (16 * 272);
        const int b = it >> 6, n = it & 63; const size_t prow = (size_t)b * SEQ + n * 64;
        unsigned pfv[9];
#pragma unroll
        for (int q = 0; q < 9; ++q) pfv[q] = 0u;
        const int dh = 32 * half + i;
        f32x4 pdiag[2], oacc[2][8];
#pragma unroll
        for (int a = 0; a < 2; ++a) { pdiag[a] = (f32x4){0.f, 0.f, 0.f, 0.f};
#pragma unroll
            for (int q = 0; q < 8; ++q) oacc[a][q] = (f32x4){0.f, 0.f, 0.f, 0.f}; }
#pragma unroll
        for (int dir = 0; dir < (MODE >= 4 ? 0 : 2); ++dir) {
            { unsigned qk[2][4][4];
#pragma unroll
              for (int cti = 0; cti < 2; ++cti)
#pragma unroll
                  for (int tt = 0; tt < 4; ++tt)
#pragma unroll
                      for (int r = 0; r < 4; ++r) { const bf16* rp = P + (prow + 16 * tt + 4 * g + r) * PW + h * 64 + dh + 16 * cti; qk[cti][tt][r] = (unsigned)rp[CQ] | ((unsigned)rp[CK] << 16); }
              f32x4 bv[2][4]; gate_b_dir(G, P, prow, lane, dir, bv);
#pragma unroll
              for (int cti = 0; cti < 2; ++cti)
#pragma unroll
                  for (int tt = 0; tt < 4; ++tt)
#pragma unroll
                      for (int r = 0; r < 4; ++r) { const float e = __builtin_amdgcn_exp2f(bv[cti][tt][r] * 1.4426950409f); const unsigned w = qk[cti][tt][r];
                          const int off = ((h * 64 + 16 * tt + 4 * g + r) * 72 + dh + 16 * cti) * 2;
                          *(LAS bf16*)(lds + G5_Q + off) = (bf16)f2bf(bflo(w) * e * 0.125f); *(LAS bf16*)(lds + G5_K + off) = (bf16)f2bf(bfhi(w) * __builtin_amdgcn_rcpf(e)); } }
            LDS_BARRIER();
            if (MODE < 3) { bf16x8 qf[2][2];
#pragma unroll
              for (int tti = 0; tti < 2; ++tti)
#pragma unroll
                  for (int ks = 0; ks < 2; ++ks) qf[tti][ks] = *(const LAS bf16x8*)(lds + G5_Q + ((h * 64 + (2 * half + tti) * 16 + i) * 72 + 32 * ks + 8 * g) * 2);
              const bf16* sp = ((const bf16*)(F.ws + WS_S)) + ((((size_t)dir * NBATCH + b) * 64 + n) * 4 + h) * 8192 + (size_t)i * 64 + 8 * g;
#pragma unroll
              for (int st_ = 0; st_ < 4; ++st_) { const bf16x8 kf0 = *(const LAS bf16x8*)(lds + G5_K + ((h * 64 + st_ * 16 + i) * 72 + 8 * g) * 2), kf1 = *(const LAS bf16x8*)(lds + G5_K + ((h * 64 + st_ * 16 + i) * 72 + 32 + 8 * g) * 2);
#pragma unroll
                  for (int tti = 0; tti < 2; ++tti) { const int tt = 2 * half + tti;
                      if (dir == 0 ? (st_ <= tt) : (st_ >= tt)) { f32x4 a = {0.f, 0.f, 0.f, 0.f};
                          a = __builtin_amdgcn_mfma_f32_16x16x32_bf16(kf0, qf[tti][0], a, 0, 0, 0); a = __builtin_amdgcn_mfma_f32_16x16x32_bf16(kf1, qf[tti][1], a, 0, 0, 0);
                          const int t = tt * 16 + i, s0 = st_ * 16 + 4 * g;
                          if (st_ == tt) {
#pragma unroll
                              for (int r = 0; r < 4; ++r) pdiag[tti][r] += (dir == 0 ? (s0 + r <= t) : (s0 + r >= t)) ? a[r] : 0.f;
                              a = pdiag[tti]; }
                          if (st_ != tt || dir == 1) { v2u w; w.x = pk2(a[0], a[1]); w.y = pk2(a[2], a[3]);
                              *(LAS v2u*)(lds + G5_P + ((h * 64 + t) * 72 + s0) * 2) = w; } } } }
              bf16x8 sfr[4][2];
#pragma unroll
              for (int vt = 0; vt < 4; ++vt) { sfr[vt][0] = *(const bf16x8*)(sp + (size_t)vt * 1024); sfr[vt][1] = *(const bf16x8*)(sp + (size_t)vt * 1024 + 32); }
#pragma unroll
              for (int vt = 0; vt < 8; ++vt) {
#pragma unroll
                  for (int tti = 0; tti < 2; ++tti) { oacc[tti][vt] = __builtin_amdgcn_mfma_f32_16x16x32_bf16(sfr[vt & 3][0], qf[tti][0], oacc[tti][vt], 0, 0, 0); oacc[tti][vt] = __builtin_amdgcn_mfma_f32_16x16x32_bf16(sfr[vt & 3][1], qf[tti][1], oacc[tti][vt], 0, 0, 0); }
                  asm volatile("" : "+v"(oacc[0][vt]), "+v"(oacc[1][vt]) :: "memory");
                  if (vt < 4) { sfr[vt][0] = *(const bf16x8*)(sp + (size_t)(vt + 4) * 1024); sfr[vt][1] = *(const bf16x8*)(sp + (size_t)(vt + 4) * 1024 + 32); } } }
            LDS_BARRIER();
        }
        LDS_WAIT();
        if (MODE < 2) { bf16x8 pfr[2][2];
#pragma unroll
          for (int tti = 0; tti < 2; ++tti)
#pragma unroll
              for (int ks = 0; ks < 2; ++ks) pfr[tti][ks] = *(const LAS bf16x8*)(lds + G5_P + ((h * 64 + (2 * half + tti) * 16 + i) * 72 + 32 * ks + 8 * g) * 2);
          const bf16* vp = ((const bf16*)(F.ws + WS_VT)) + (((size_t)b * 64 + n) * 4 + h) * 8192 + (size_t)i * 64 + 8 * g;
          bf16x8 vfr[8][2];
#pragma unroll
          for (int vt = 0; vt < 8; ++vt) { vfr[vt][0] = *(const bf16x8*)(vp + (size_t)vt * 1024); vfr[vt][1] = *(const bf16x8*)(vp + (size_t)vt * 1024 + 32); }
          { const int itn = it + F.G; if (itn < NBATCH * 64) { const int bn_ = itn >> 6, nn_ = itn & 63; const char* pr = (const char*)(P + ((size_t)bn_ * SEQ + nn_ * 64 + (tid >> 3)) * PW); const int j = tid & 7;
                pfv[0] = *(const unsigned*)(pr + 128 * j); pfv[1] = *(const unsigned*)(pr + 2048 + 128 * j); if (j == 0) pfv[2] = *(const unsigned*)(pr + 3072);
                const char* sb = (const char*)(((const bf16*)(F.ws + WS_S)) + (((size_t)bn_ * 64 + nn_) * 4) * 8192) + (size_t)tid * 128;
                pfv[6] = *(const unsigned*)sb; pfv[7] = *(const unsigned*)(sb + (size_t)NBATCH * 64 * 4 * 8192 * 2);
                pfv[8] = *(const unsigned*)((const char*)(((const bf16*)(F.ws + WS_VT)) + (((size_t)bn_ * 64 + nn_) * 4) * 8192) + (size_t)tid * 128); } }
#pragma unroll
          for (int vt = 0; vt < 8; ++vt)
#pragma unroll
              for (int tti = 0; tti < 2; ++tti) { oacc[tti][vt] = __builtin_amdgcn_mfma_f32_16x16x32_bf16(vfr[vt][0], pfr[tti][0], oacc[tti][vt], 0, 0, 0); oacc[tti][vt] = __builtin_amdgcn_mfma_f32_16x16x32_bf16(vfr[vt][1], pfr[tti][1], oacc[tti][vt], 0, 0, 0); } }
#pragma unroll
        for (int tti = 0; tti < (MODE >= 2 ? 0 : 2); ++tti) { const int t = (2 * half + tti) * 16 + i; float ss = 0.f;
#pragma unroll
            for (int vt = 0; vt < 8; ++vt) { const f32x4 a = oacc[tti][vt]; ss += (a[0] * a[0] + a[1] * a[1]) + (a[2] * a[2] + a[3] * a[3]); }
            ss += __shfl_xor(ss, 16); ss += __shfl_xor(ss, 32);
            const float rstd = 1.0f / sqrtf(ss * (1.0f / 128.0f) + EPS);
#pragma unroll
            for (int vt = 0; vt < 8; ++vt) { const int v = vt * 16 + 4 * g; const f32x4 gw = *(const f32x4*)(A->in[12] + v); const v2u rw = *(const v2u*)(P + (prow + t) * PW + CR + h * 128 + v);
                const float r[4] = {bflo(rw.x), bfhi(rw.x), bflo(rw.y), bfhi(rw.y)}; float y[4];
#pragma unroll
                for (int j = 0; j < 4; ++j) y[j] = oacc[tti][vt][j] * rstd * gw[j] * (r[j] * __builtin_amdgcn_rcpf(1.0f + __builtin_amdgcn_exp2f(r[j] * -1.4426950409f)));
                if (OUTPROJ_F8) *(LAS unsigned*)(st + i * 144 + v) = pk4_fp8(y[0], y[1], y[2], y[3]);
                else { v2u w; w.x = pk2(y[0], y[1]); w.y = pk2(y[2], y[3]);
                    *(LAS v2u*)(st + i * 272 + v * 2) = w; }
                if ((vt & 3) == 3) asm volatile("" ::: "memory"); }
            LDS_WAIT();
            if (OUTPROJ_F8) {
#pragma unroll
                for (int j = 0; j < 2; ++j) { const int pc = lane + 64 * j, row = pc >> 3, ch = pc & 7;
                    *(v4u*)(F.ws + WS_YMIX + (prow + (2 * half + tti) * 16 + row) * D + h * 128 + ch * 16) = *(const LAS v4u*)(st + row * 144 + ch * 16); } }
            else {
#pragma unroll
                for (int j = 0; j < 4; ++j) { const int pc = lane + 64 * j, row = pc >> 4, ch = pc & 15;
                    *(v4u*)(((bf16*)(F.ws + WS_YMIX)) + (prow + (2 * half + tti) * 16 + row) * D + h * 128 + ch * 8) = *(const LAS v4u*)(st + row * 272 + ch * 16); } }
            LDS_WAIT(); }
#pragma unroll
        for (int q = 0; q < 9; ++q) asm volatile("" :: "v"(pfv[q]));
        LDS_BARRIER();
    }
    if (MODE < 1) { int tc_ = F.tid; asm volatile("" : "+v"(tc_)); conv_stream(F, A, tc_); }
}

__device__ __forceinline__ void p4_phase(const Frame& F, CArgs* A) {
    int tid_ = threadIdx.x; asm volatile("" : "+v"(tid_));
    const int tid = tid_;
    for (int idx = F.bid * NTHREADS + tid; idx < 2 * NBATCH * 4 * 1024; idx += F.G * NTHREADS) {
        const int e8 = idx & 1023, ch = idx >> 10, h = ch & 3, b = (ch >> 2) & 15, dir = ch >> 6; const int d0 = (e8 & 7) * 8;
        float s[8];
#pragma unroll
        for (int j = 0; j < 8; ++j) s[j] = 0.f;
#pragma unroll 17
        for (int st = 0; st < NCC; ++st) {
            const int cc = dir ? (st < 4 ? 3 - st : 71 - st) : st;
            const size_t ci = ((size_t)dir * NBATCH + b) * NCC + cc;
            const v4u kv = *(const v4u*)(((bf16*)(F.ws + WS_KV)) + (ci * 4 + h) * 8192 + (size_t)e8 * 8);
            const f32x4 dc0 = *(const f32x4*)(((float*)(F.ws + WS_DECAY)) + ci * 256 + h * 64 + d0), dc1 = *(const f32x4*)(((float*)(F.ws + WS_DECAY)) + ci * 256 + h * 64 + d0 + 4);
            if (cc >= 4) { v4u w; w.x = pk2(s[0], s[1]); w.y = pk2(s[2], s[3]); w.z = pk2(s[4], s[5]); w.w = pk2(s[6], s[7]);
                *(v4u*)(((bf16*)(F.ws + WS_S)) + ((((size_t)dir * NBATCH + b) * 64 + (cc - 4)) * 4 + h) * 8192 + (size_t)e8 * 8) = w; }
            s[0] = s[0] * dc0[0] + bflo(kv.x); s[1] = s[1] * dc0[1] + bfhi(kv.x); s[2] = s[2] * dc0[2] + bflo(kv.y); s[3] = s[3] * dc0[3] + bfhi(kv.y);
            s[4] = s[4] * dc1[0] + bflo(kv.z); s[5] = s[5] * dc1[1] + bfhi(kv.z); s[6] = s[6] * dc1[2] + bflo(kv.w); s[7] = s[7] * dc1[3] + bfhi(kv.w);
        }
    }
}

__device__ __forceinline__ void p5a_phase(const Frame& F, CArgs* A) {
    LAS unsigned char* lds = F.lds; const int tid = F.tid, lane = F.lane, wave = F.wave, i = lane & 15, g = lane >> 4;
    GlaRegs cur; if (F.bid < NBATCH * 64 * 4) cur = gla_load(F, (size_t)(F.bid >> 2) * 64, F.bid & 3);
    f32x4 gw[4];
#pragma unroll
    for (int k = 0; k < 4; ++k) gw[k] = *(const f32x4*)(A->in[12] + ((wave >> 2) * 4 + k) * 16 + 4 * g);
    for (int it = F.bid; it < NBATCH * 64 * 4; it += F.G) {
        const int h = it & 3, bn = it >> 2, b = bn >> 6, n = bn & 63; const size_t prow = (size_t)b * SEQ + n * 64;
        GlaRegs nxt = cur; { const int itn = it + F.G; if (itn < NBATCH * 64 * 4) nxt = gla_load(F, (size_t)(itn >> 2) * 64, itn & 3); }
        v4u qw, kw; { const int t = tid >> 3, d0 = (tid & 7) * 8; qw = *(const v4u*)(((bf16*)(F.ws + WS_P)) + (prow + t) * PW + CQ + h * 64 + d0); kw = *(const v4u*)(((bf16*)(F.ws + WS_P)) + (prow + t) * PW + CK + h * 64 + d0); }
        gla_prep(F, A, cur, h); cur = nxt;
        bf16x8 sfr[4][2][2]; v2u rwv[4];
        { const int tt = wave & 3, vh = wave >> 2, t = tt * 16 + i;
#pragma unroll
          for (int k = 0; k < 4; ++k) { const int vt = vh * 4 + k;
#pragma unroll
              for (int dir = 0; dir < 2; ++dir) { const bf16* sp = ((bf16*)(F.ws + WS_S)) + ((((size_t)dir * NBATCH + b) * 64 + n) * 4 + h) * 8192 + (size_t)(vt * 16 + i) * 64 + 8 * g;
                  sfr[k][dir][0] = *(const bf16x8*)sp; sfr[k][dir][1] = *(const bf16x8*)(sp + 32); }
              rwv[k] = *(const v2u*)(((bf16*)(F.ws + WS_P)) + (prow + t) * PW + CR + h * 128 + vt * 16 + 4 * g); } }
        { const int t = tid >> 3, d0 = (tid & 7) * 8;
          const float q[8] = {bflo(qw.x), bfhi(qw.x), bflo(qw.y), bfhi(qw.y), bflo(qw.z), bfhi(qw.z), bflo(qw.w), bfhi(qw.w)};
          const float k[8] = {bflo(kw.x), bfhi(kw.x), bflo(kw.y), bfhi(kw.y), bflo(kw.z), bfhi(kw.z), bflo(kw.w), bfhi(kw.w)};
#pragma unroll
          for (int dir = 0; dir < 2; ++dir) { const LAS float* bp = (const LAS float*)(lds + GL_BC) + dir * 4096 + t * 64 + d0;
              const f32x4 b0 = *(const LAS f32x4*)bp, b1 = *(const LAS f32x4*)(bp + 4); const float bb[8] = {b0[0], b0[1], b0[2], b0[3], b1[0], b1[1], b1[2], b1[3]};
              float qd[8], ki[8];
#pragma unroll
              for (int j = 0; j < 8; ++j) { qd[j] = q[j] * __expf(bb[j]) * 0.125f; ki[j] = k[j] * __expf(-bb[j]); }
              v4u w; w.x = pk2(qd[0], qd[1]); w.y = pk2(qd[2], qd[3]); w.z = pk2(qd[4], qd[5]); w.w = pk2(qd[6], qd[7]);
              *(LAS v4u*)(lds + GL_A + ((dir * 64 + t) * 72 + d0) * 2) = w;
              w.x = pk2(ki[0], ki[1]); w.y = pk2(ki[2], ki[3]); w.z = pk2(ki[4], ki[5]); w.w = pk2(ki[6], ki[7]);
              *(LAS v4u*)(lds + GL_B + ((dir * 64 + t) * 72 + d0) * 2) = w; } }
        __syncthreads();
#pragma unroll
        for (int kk = 0; kk < 2; ++kk) { const int pi = wave * 2 + kk, tt = pi >> 2, st = pi & 3;
            f32x4 aF = {0.f, 0.f, 0.f, 0.f}, aB = {0.f, 0.f, 0.f, 0.f};
            if (st <= tt) {
#pragma unroll
                for (int ks = 0; ks < 2; ++ks) { const bf16x8 kf = *(const LAS bf16x8*)(lds + GL_B + ((st * 16 + i) * 72 + 32 * ks + 8 * g) * 2), qf = *(const LAS bf16x8*)(lds + GL_A + ((tt * 16 + i) * 72 + 32 * ks + 8 * g) * 2);
                    aF = __builtin_amdgcn_mfma_f32_16x16x32_bf16(kf, qf, aF, 0, 0, 0); } }
            if (st >= tt) {
#pragma unroll
                for (int ks = 0; ks < 2; ++ks) { const bf16x8 kf = *(const LAS bf16x8*)(lds + GL_B + ((64 + st * 16 + i) * 72 + 32 * ks + 8 * g) * 2), qf = *(const LAS bf16x8*)(lds + GL_A + ((64 + tt * 16 + i) * 72 + 32 * ks + 8 * g) * 2);
                    aB = __builtin_amdgcn_mfma_f32_16x16x32_bf16(kf, qf, aB, 0, 0, 0); } }
            const int t = tt * 16 + i, s0 = st * 16 + 4 * g; float p[4];
#pragma unroll
            for (int r = 0; r < 4; ++r) p[r] = ((s0 + r <= t) ? aF[r] : 0.f) + ((s0 + r >= t) ? aB[r] : 0.f);
            v2u w; w.x = pk2(p[0], p[1]); w.y = pk2(p[2], p[3]);
            *(LAS v2u*)(lds + GL_P + (t * 72 + s0) * 2) = w; }
        __syncthreads();
        { const int tt = wave & 3, vh = wave >> 2; const int t = tt * 16 + i;
          bf16x8 pf[2], qf[2][2];
#pragma unroll
          for (int ks = 0; ks < 2; ++ks) { pf[ks] = *(const LAS bf16x8*)(lds + GL_P + (t * 72 + 32 * ks + 8 * g) * 2);
              qf[0][ks] = *(const LAS bf16x8*)(lds + GL_A + (t * 72 + 32 * ks + 8 * g) * 2); qf[1][ks] = *(const LAS bf16x8*)(lds + GL_A + ((64 + t) * 72 + 32 * ks + 8 * g) * 2); }
          f32x4 acc[4]; float ss = 0.f;
#pragma unroll
          for (int k = 0; k < 4; ++k) { const int vt = vh * 4 + k; f32x4 a = {0.f, 0.f, 0.f, 0.f};
              { bf16x8 vf0, vf1; v_frag2(lds, vt * 16, lane, vf0, vf1); a = __builtin_amdgcn_mfma_f32_16x16x32_bf16(vf0, pf[0], a, 0, 0, 0); a = __builtin_amdgcn_mfma_f32_16x16x32_bf16(vf1, pf[1], a, 0, 0, 0); }
#pragma unroll
              for (int dir = 0; dir < 2; ++dir)
#pragma unroll
                  for (int ks = 0; ks < 2; ++ks) a = __builtin_amdgcn_mfma_f32_16x16x32_bf16(sfr[k][dir][ks], qf[dir][ks], a, 0, 0, 0);
              acc[k] = a; ss += (a[0] * a[0] + a[1] * a[1]) + (a[2] * a[2] + a[3] * a[3]); }
          ss += __shfl_xor(ss, 16); ss += __shfl_xor(ss, 32);
          if (g == 0) ((LAS float*)(lds + GL_SS))[vh * 64 + t] = ss;
          __syncthreads();
          const float tot = ((const LAS float*)(lds + GL_SS))[t] + ((const LAS float*)(lds + GL_SS))[64 + t];
          const float rstd = 1.0f / sqrtf(tot * (1.0f / 128.0f) + EPS);
#pragma unroll
          for (int k = 0; k < 4; ++k) { const int v = (vh * 4 + k) * 16 + 4 * g;
              const v2u rw = rwv[k];
              const float r[4] = {bflo(rw.x), bfhi(rw.x), bflo(rw.y), bfhi(rw.y)}; float y[4];
#pragma unroll
              for (int j = 0; j < 4; ++j) y[j] = acc[k][j] * rstd * gw[k][j] * (r[j] * __builtin_amdgcn_rcpf(1.0f + __expf(-r[j])));
              v2u w; w.x = pk2(y[0], y[1]); w.y = pk2(y[2], y[3]);
              *(v2u*)(((bf16*)(F.ws + WS_YMIX)) + (prow + t) * D + h * 128 + v) = w; } }
        __syncthreads();
    }
    for (int it = F.bid; it < NBATCH * 64; it += F.G) {
        const size_t prow = (size_t)it * 64;
#pragma unroll 1
        for (int rep = 0; rep < 8; ++rep) { const int idx = tid + rep * NTHREADS, t = idx >> 6, c0 = (idx & 63) * 8;
            float cv[8];
#pragma unroll
            for (int j = 0; j < 8; ++j) cv[j] = 0.f;
#pragma unroll
            for (int dt = -1; dt <= 1; ++dt) { const int tt = t + dt; if (tt >= 0 && tt < 64) {
                const v4u cw = *(const v4u*)(((bf16*)(F.ws + WS_P)) + (prow + tt) * PW + CPC + c0), xw = *(const v4u*)(((bf16*)(F.ws + WS_P)) + (prow + tt) * PW + CPX + c0);
                const f32x4 w0 = *(const f32x4*)(A->in[13] + (dt + 1) * 512 + c0), w1 = *(const f32x4*)(A->in[13] + (dt + 1) * 512 + c0 + 4);
                cv[0] += w0[0] * bflo(cw.x) * bflo(xw.x); cv[1] += w0[1] * bfhi(cw.x) * bfhi(xw.x); cv[2] += w0[2] * bflo(cw.y) * bflo(xw.y); cv[3] += w0[3] * bfhi(cw.y) * bfhi(xw.y);
                cv[4] += w1[0] * bflo(cw.z) * bflo(xw.z); cv[5] += w1[1] * bfhi(cw.z) * bfhi(xw.z); cv[6] += w1[2] * bflo(cw.w) * bflo(xw.w); cv[7] += w1[3] * bfhi(cw.w) * bfhi(xw.w); } }
            const v4u bw = *(const v4u*)(((bf16*)(F.ws + WS_P)) + (prow + t) * PW + CPB + c0);
            v4u w; w.x = pk2(cv[0] * bflo(bw.x), cv[1] * bfhi(bw.x)); w.y = pk2(cv[2] * bflo(bw.y), cv[3] * bfhi(bw.y)); w.z = pk2(cv[4] * bflo(bw.z), cv[5] * bfhi(bw.z)); w.w = pk2(cv[6] * bflo(bw.w), cv[7] * bfhi(bw.w));
            *(v4u*)(((bf16*)(F.ws + WS_YMIX)) + (prow + t) * D + 512 + c0) = w; }
    }
}

constexpr int RT_W = 0;
constexpr int RT_LG = 32 * 1032 * 2;
constexpr int RT_HIST = RT_LG + 128 * 33 * 4;
constexpr int RT_WC = RT_HIST + 256;
__device__ __forceinline__ void p5c_phase(const Frame& F, CArgs* A) {
    LAS unsigned char* lds = F.lds; const int tid = F.tid, lane = F.lane, wave = F.wave, i = lane & 15, g = lane >> 4;
#pragma unroll 1
    for (int i0 = 0; i0 < 32768; i0 += 16 * NTHREADS) { float rv[16];
#pragma unroll
        for (int q = 0; q < 16; ++q) rv[q] = A->in[16][i0 + q * NTHREADS + tid];
#pragma unroll
        for (int q = 0; q < 16; ++q) { const int idx = i0 + q * NTHREADS + tid, k = idx >> 5, e = idx & 31; *(LAS bf16*)(lds + RT_W + (e * 1032 + k) * 2) = (bf16)f2bf(rv[q]); } }
    LAS int* hist = (LAS int*)(lds + RT_HIST); LAS float* lg = (LAS float*)(lds + RT_LG);
    unsigned* gcnt = ((unsigned*)(F.ws + WS_CTL)) + CW_CNT;
    __syncthreads();
#pragma unroll 1
    for (int it = F.bid; it < NLAT / 128; it += F.G) {
        const int R = it * 128 + wave * 16 + i, b = it >> 5;
        const bf16* yg = ((const bf16*)(F.ws + WS_Y1)) + (size_t)R * D + 8 * g;
        unsigned char* hn2g = (unsigned char*)F.out + DO_HN2 + (size_t)R * D + 8 * g;
        const LAS unsigned char* rw0 = lds + RT_W + (i * 1032 + 8 * g) * 2; const LAS unsigned char* rw1 = rw0 + 16 * 1032 * 2;
        if (tid < 32) hist[tid] = 0;
        { const int c0 = 2 * tid; const f32x2 w_ = *(const f32x2*)(A->in[15] + c0), c_ = *(const f32x2*)(((float*)(F.ws + WS_MOD)) + (size_t)b * 6144 + 4096 + c0), s_ = *(const f32x2*)(((float*)(F.ws + WS_MOD)) + (size_t)b * 6144 + 3072 + c0);
          *(LAS f32x2*)(lds + RT_WC + c0 * 4) = w_ * (c_ + 1.0f); *(LAS f32x2*)(lds + RT_WC + 4096 + c0 * 4) = s_; }
        v4u yv[32];
#pragma unroll
        for (int ks = 0; ks < 32; ++ks) yv[ks] = *(const v4u*)(yg + 32 * ks);
        float ss = 0.f;
#pragma unroll
        for (int ks = 0; ks < 32; ++ks) { const v4u yw = yv[ks];
            const float h0 = bflo(yw.x), h1 = bfhi(yw.x), h2 = bflo(yw.y), h3 = bfhi(yw.y), h4 = bflo(yw.z), h5 = bfhi(yw.z), h6 = bflo(yw.w), h7 = bfhi(yw.w);
            ss += (h0 * h0 + h1 * h1) + (h2 * h2 + h3 * h3) + (h4 * h4 + h5 * h5) + (h6 * h6 + h7 * h7); }
        ss += __shfl_xor(ss, 16); ss += __shfl_xor(ss, 32);
        const float rstd = 1.0f / sqrtf(ss * (1.f / D) + EPS);
#pragma unroll
        for (int ks = 0; ks < 32; ++ks) asm volatile("" : "+v"(yv[ks]));
        LDS_BARRIER();
        f32x4 l0 = {0.f, 0.f, 0.f, 0.f}, l1 = {0.f, 0.f, 0.f, 0.f};
        const LAS unsigned char* wcg = lds + RT_WC + 32 * g;
#pragma unroll
        for (int ks = 0; ks < 32; ++ks) {
            const v4u yw = yv[ks];
            const f32x4 a0 = {bflo(yw.x), bfhi(yw.x), bflo(yw.y), bfhi(yw.y)}, a1 = {bflo(yw.z), bfhi(yw.z), bflo(yw.w), bfhi(yw.w)};
            const f32x4 c0 = *(const LAS f32x4*)(wcg + 128 * ks), c1 = *(const LAS f32x4*)(wcg + 128 * ks + 16), s0 = *(const LAS f32x4*)(wcg + 4096 + 128 * ks), s1 = *(const LAS f32x4*)(wcg + 4096 + 128 * ks + 16);
            const f32x4 y0 = (a0 * rstd) * c0 + s0, y1 = (a1 * rstd) * c1 + s1;
            v4u w; w.x = pk2(y0[0], y0[1]); w.y = pk2(y0[2], y0[3]); w.z = pk2(y1[0], y1[1]); w.w = pk2(y1[2], y1[3]);
            { v2u w8; w8.x = pk4_fp8(y0[0], y0[1], y0[2], y0[3]); w8.y = pk4_fp8(y1[0], y1[1], y1[2], y1[3]); *(v2u*)(hn2g + 32 * ks) = w8; }
            const bf16x8 af = __builtin_bit_cast(bf16x8, w);
            const bf16x8 r0 = *(const LAS bf16x8*)(rw0 + 64 * ks), r1 = *(const LAS bf16x8*)(rw1 + 64 * ks);
            l0 = __builtin_amdgcn_mfma_f32_16x16x32_bf16(af, r0, l0, 0, 0, 0); l1 = __builtin_amdgcn_mfma_f32_16x16x32_bf16(af, r1, l1, 0, 0, 0);
            asm volatile("" : "+v"(l0), "+v"(l1) :: "memory"); }
        { const float rb0 = A->in[17][i], rb1 = A->in[17][16 + i];
#pragma unroll
          for (int r = 0; r < 4; ++r) { lg[(wave * 16 + 4 * g + r) * 33 + i] = l0[r] + rb0; lg[(wave * 16 + 4 * g + r) * 33 + 16 + i] = l1[r] + rb1; } }
        __syncthreads();
        int te[4] = {0, 0, 0, 0}; float tv[4] = {-3.0e38f, -3.0e38f, -3.0e38f, -3.0e38f}; int lp[4] = {0, 0, 0, 0};
        if (lane < 16) { const LAS float* lr = lg + (wave * 16 + lane) * 33;
            for (int e = 0; e < 32; ++e) { const float x = lr[e];
                if (x > tv[3]) { if (x > tv[2]) { tv[3] = tv[2]; te[3] = te[2]; if (x > tv[1]) { tv[2] = tv[1]; te[2] = te[1]; if (x > tv[0]) { tv[1] = tv[0]; te[1] = te[0]; tv[0] = x; te[0] = e; } else { tv[1] = x; te[1] = e; } } else { tv[2] = x; te[2] = e; } } else { tv[3] = x; te[3] = e; } } }
            const float e1 = __expf(tv[1] - tv[0]), e2 = __expf(tv[2] - tv[0]), e3 = __expf(tv[3] - tv[0]), inv = 1.0f / (1.0f + e1 + e2 + e3);
            tv[0] = inv; tv[1] = e1 * inv; tv[2] = e2 * inv; tv[3] = e3 * inv;
#pragma unroll
            for (int k = 0; k < 4; ++k) lp[k] = __hip_atomic_fetch_add(&hist[te[k]], 1, __ATOMIC_RELAXED, __HIP_MEMORY_SCOPE_WORKGROUP); }
        __syncthreads();
        if (tid < 32) { const int c = hist[tid]; hist[32 + tid] = c ? (int)__hip_atomic_fetch_add(gcnt + tid, (unsigned)c, RLX_AGENT) : 0; }
        __syncthreads();
        if (lane < 16) { const int Rt = it * 128 + wave * 16 + lane;
#pragma unroll
            for (int k = 0; k < 4; ++k) { const size_t pos = (size_t)te[k] * LISTCAP + hist[32 + te[k]] + lp[k]; ((int*)((unsigned char*)F.out + DO_LAID))[pos] = Rt * 4 + k;
                ((int*)(F.ws + WS_TSLOT))[Rt * 4 + k] = (te[k] << 20) | (hist[32 + te[k]] + lp[k]); ((float*)(F.ws + WS_TW))[Rt * 4 + k] = tv[k]; } }
        __syncthreads();
    }
}

__device__ __forceinline__ void p8_phase(const Frame& F, CArgs* A, const LAS int* TS) {
    const int gw = F.bid * NWAVES + F.wave, NGW = F.G * NWAVES;
    for (int r0 = gw; r0 < NLAT; r0 += 2 * NGW) {
        const int r1 = (r0 + NGW < NLAT) ? r0 + NGW : r0; const bool two = r0 + NGW < NLAT;
        int ep[2][4]; float wk[2][4];
#pragma unroll
        for (int a = 0; a < 2; ++a) { const int r = a ? r1 : r0;
#pragma unroll
            for (int k = 0; k < 4; ++k) { ep[a][k] = ((const int*)(F.ws + WS_TSLOT))[r * 4 + k]; wk[a][k] = ((const float*)(F.ws + WS_TW))[r * 4 + k]; } }
        int yw8[2][4][4]; v2u hw[2][4];
#pragma unroll
        for (int a = 0; a < 2; ++a) { const int r = a ? r1 : r0; const bf16* yr = ((const bf16*)(F.ws + WS_Y1)) + (size_t)r * D;
#pragma unroll
            for (int k = 0; k < 4; ++k) { const int* ys = (const int*)((const unsigned char*)(F.ws + WS_YA) + ((size_t)TS[ep[a][k] >> 20] * 256 + (ep[a][k] & 0xFFFFF)) * D);
#pragma unroll
                for (int j = 0; j < 4; ++j) yw8[a][k][j] = ys[F.lane + 64 * j]; }
#pragma unroll
            for (int j = 0; j < 4; ++j) hw[a][j] = ((const v2u*)yr)[F.lane + 64 * j]; }
#pragma unroll
        for (int a = 0; a < 2; ++a) { if (a == 1 && !two) break;
            const int r = a ? r1 : r0; float* hr = F.out + (size_t)r * D; const float* g2 = ((float*)(F.ws + WS_MOD)) + (size_t)(r >> 12) * 6144 + 5120;
            f32x4 v[4]; float s = 0.f;
#pragma unroll
            for (int j = 0; j < 4; ++j) { const int c4 = F.lane + 64 * j; f32x4 y = {0.f, 0.f, 0.f, 0.f};
#pragma unroll
                for (int k = 0; k < 4; ++k) { const int w = yw8[a][k][j]; const f32x2 lo = __builtin_amdgcn_cvt_pk_f32_fp8(w, false), hi = __builtin_amdgcn_cvt_pk_f32_fp8(w, true);
                    y[0] += wk[a][k] * lo[0]; y[1] += wk[a][k] * lo[1]; y[2] += wk[a][k] * hi[0]; y[3] += wk[a][k] * hi[1]; }
                const v2u yw = hw[a][j]; const f32x4 y1 = {bflo(yw.x), bfhi(yw.x), bflo(yw.y), bfhi(yw.y)};
                v[j] = y1 + ((const f32x4*)g2)[c4] * y;
                s += (v[j].x * v[j].x + v[j].y * v[j].y) + (v[j].z * v[j].z + v[j].w * v[j].w); }
            const float rstd = 1.0f / sqrtf(wave_sum(s) * (1.f / D) + EPS);
#pragma unroll
            for (int j = 0; j < 4; ++j) { const int c4 = F.lane + 64 * j; ((f32x4*)hr)[c4] = (v[j] * rstd) * ((const f32x4*)A->in[22])[c4]; } }
    }
}

constexpr int NPHASES = 11;
__global__ void __launch_bounds__(NTHREADS, 2) fwd_kernel(Args args) {
    extern __shared__ __attribute__((aligned(16))) unsigned char lds_raw[];
    Frame F;
    F.lds = (LAS unsigned char*)lds_raw;
    F.tid = threadIdx.x; F.lane = F.tid & 63; F.wave = __builtin_amdgcn_readfirstlane(F.tid >> 6); F.G = gridDim.x; F.bid = blockIdx.x;
    F.out = args.out; F.ws = args.ws;
        for (int u = F.tid; u < (LDS_BYTES - MISC_OFF) / 4; u += NTHREADS) ((LAS unsigned*)(F.lds + MISC_OFF))[u] = 0u;
    __syncthreads();
    volatile LAS unsigned* MISC = (volatile LAS unsigned*)(F.lds + MISC_OFF);
    LAS int* TS = (LAS int*)(F.lds + MISC_OFF + 256);
    const int lo = args.ph_lo, hi = args.ph_hi;
    const bool multi = (hi - lo) > 1;
    XcdBarrier bar; bar.bar = (unsigned*)((unsigned*)(F.ws + WS_CTL)) + CW_BAR; bar.x = 0; bar.st = nullptr;
    if (multi) bar = xcd_barrier_post((unsigned*)((unsigned*)(F.ws + WS_CTL)) + CW_BAR, MISC + 8);
#ifndef PHMASK
#define PHMASK 0x7ff
#endif
#define IN(k) (((PHMASK >> (k)) & 1) && lo <= (k) && (k) < hi)
#define BUILD_TS() do { if (F.tid < NEXP) TS[33 + F.tid] = (int)__hip_atomic_load(((unsigned*)(F.ws + WS_CTL)) + CW_CNT + F.tid, RLX_AGENT);     \
        __syncthreads(); \
        if (F.tid == 0) { int acc_ = 0; for (int e = 0; e < NEXP; ++e) { TS[e] = acc_; acc_ += (TS[33 + e] + 255) >> 8; } TS[32] = acc_; } __syncthreads(); \
        for (int t_ = F.tid; t_ < TS[32]; t_ += NTHREADS) { int e_ = 0; for (int k_ = 1; k_ < NEXP; ++k_) e_ = (TS[k_] <= t_) ? k_ : e_; ((LAS unsigned char*)(TS + 72))[t_] = (unsigned char)e_; } \
        __syncthreads(); } while (0)
#define SEAM(k) do { if (IN(k) && IN((k) + 1)) xcd_barrier(bar); } while (0)
#ifndef PROBE_DUP
#define PROBE_DUP 0
#endif
#define REPS(k) for (int rep_ = 0; rep_ < (((PROBE_DUP >> (k)) & 1) ? 2 : 1); ++rep_)

    if (IN(0)) REPS(0) { p0_phase(F, opaque_args()); } SEAM(0);
    if (IN(1)) REPS(1) { p1_phase(F, opaque_args()); } SEAM(1);
    if (IN(2)) REPS(2) { DenseSched S; S.init(NROWS, PWP, F.G, F.bid, ((bf16*)(F.ws + WS_WIN))); S.build((LAS int*)(TS + 400), F.tid); EpiProj E{((bf16*)(F.ws + WS_P))};
        pg8::gemm_phase<EpiProj, DenseSched, true, false>(F.lds, (const char*)((bf16*)(F.ws + WS_HN)), S, E);
#ifdef PROBE_INNULL
        { EpiNull E0; pg8::gemm_phase<EpiNull, DenseSched, true, false>(F.lds, (const char*)((bf16*)(F.ws + WS_HN)), S, E0); }
#endif
    } SEAM(2);
    if (IN(3)) { p3v3_phase<0>(F, opaque_args());
#ifdef PROBE_P3
        p3v3_phase<PROBE_P3>(F, opaque_args());
#endif
    } SEAM(3);
    if (IN(4)) REPS(4) { p4_phase(F, opaque_args()); } SEAM(4);
    if (IN(5)) {
#ifdef PROBE_P5
        p5a_phase(F, opaque_args()); p5av3_phase<PROBE_P5>(F, opaque_args());
#else
        p5av3_phase<0>(F, opaque_args());
#endif
    } SEAM(5);
    if (IN(6)) REPS(6) { DenseSched S; S.init(NLAT, D, F.G, F.bid, ((bf16*)(F.ws + WS_WOUT))); S.kb = OUTPROJ_F8 ? 1024 : 2048; S.build((LAS int*)(TS + 400), F.tid); EpiOut E{opaque_args()->in[0], ((float*)(F.ws + WS_MOD)), ((bf16*)(F.ws + WS_Y1)), OUTPROJ_F8 ? 1.0f / WSCALE : 1.0f};
        pg8::gemm_phase<EpiOut, DenseSched, true, OUTPROJ_F8 != 0>(F.lds, (const char*)((bf16*)(F.ws + WS_YMIX)), S, E); } SEAM(6);
    if (IN(7)) { p5c_phase(F, opaque_args()); } SEAM(7);
#pragma unroll 1
    for (int ph = 8; ph < 10; ++ph) {
        if (IN(ph)) {
            const bool gu = (ph == 8);
            BUILD_TS();
            const int ntr = TS[32];
            REPS(ph) {
                if (gu) { MoeSched<true> S; S.TS = TS; S.ntr = ntr; S.G = F.G; S.c = F.bid; S.laid = ((int*)((unsigned char*)F.out + DO_LAID)); S.W = (const char*)F.out + DO_WGU;
                    EpiGU E{(unsigned char*)(F.ws + WS_ACT), opaque_args()->in[19]}; pg8::gemm_phase<EpiGU, MoeSched<true>, true, true>(F.lds, (const char*)((unsigned char*)F.out + DO_HN2), S, E);
#ifdef PROBE_GUNULL
                    { EpiNull E0; pg8::gemm_phase<EpiNull, MoeSched<true>, true, true>(F.lds, (const char*)((unsigned char*)F.out + DO_HN2), S, E0); }
#endif
                }
                else { MoeSched<false> S; S.TS = TS; S.ntr = ntr; S.G = F.G; S.c = F.bid; S.laid = nullptr; S.W = (const char*)F.out + DO_WDN;
                    EpiDN E{(unsigned char*)(F.ws + WS_YA), opaque_args()->in[21], TS}; pg8::gemm_phase<EpiDN, MoeSched<false>, true, true>(F.lds, (const char*)(F.ws + WS_ACT), S, E); }
            }
        }
        SEAM(ph);
    }
    if (IN(10)) { BUILD_TS(); p8_phase(F, opaque_args(), TS); }
#undef IN
#undef SEAM
}

extern "C" void kernel_launch(void* const* d_in, const int* in_sizes, int n_in, void* d_out, int out_size, void* d_ws, size_t ws_size, hipStream_t stream) {
    static int grid = 0;
    if (grid == 0) {
        if (n_in != 23 || in_sizes[0] != NLAT * D || out_size != NLAT * D || ws_size < WS_TOTAL) {
            fprintf(stderr, "kernel_launch: unexpected shapes: n_in %d, in0 %d, out %d, ws %zu (need %zu); nothing launched\n", n_in, n_in > 0 ? in_sizes[0] : -1, out_size, ws_size, (size_t)WS_TOTAL); grid = -1; return; }
        int dev = 0, cus = 0, per_cu = 0;
        if (hipGetDevice(&dev) != hipSuccess || hipDeviceGetAttribute(&cus, hipDeviceAttributeMultiprocessorCount, dev) != hipSuccess) { fprintf(stderr, "kernel_launch: device query failed\n"); grid = -1; return; }
        if (hipFuncSetAttribute((const void*)fwd_kernel, hipFuncAttributeMaxDynamicSharedMemorySize, LDS_BYTES) != hipSuccess) { fprintf(stderr, "kernel_launch: hipFuncSetAttribute failed\n"); grid = -1; return; }
        if (hipOccupancyMaxActiveBlocksPerMultiprocessor(&per_cu, (const void*)fwd_kernel, NTHREADS, LDS_BYTES) != hipSuccess || per_cu < 1) {
            fprintf(stderr, "kernel_launch: occupancy query reports %d workgroups per CU; nothing launched\n", per_cu); (void)hipGetLastError(); grid = -1; return; }
        grid = cus;
        if (grid > 256) grid = 256;
    }
    if (grid < 0) return;
    if (hipMemsetAsync((char*)d_ws + WS_CTL, 0, CTL_ZERO_BYTES, stream) != hipSuccess) { fprintf(stderr, "kernel_launch: hipMemsetAsync failed\n"); return; }
    Args a{};
    for (int i = 0; i < 23; ++i) a.in[i] = (const float*)d_in[i];
    a.out = (float*)d_out; a.ws = (unsigned char*)d_ws;
#if MK_N_LAUNCHES == 1
    a.ph_lo = 0; a.ph_hi = NPHASES;
    hipLaunchKernelGGL(fwd_kernel, dim3(grid), dim3(NTHREADS), LDS_BYTES, stream, a);
#else
    for (int p = 0; p < NPHASES; ++p) { a.ph_lo = p; a.ph_hi = p + 1; hipLaunchKernelGGL(fwd_kernel, dim3(grid), dim3(NTHREADS), LDS_BYTES, stream, a); }
#endif
    const hipError_t le = hipPeekAtLastError();
    if (le != hipSuccess) fprintf(stderr, "kernel_launch: launch failed: %s\n", hipGetErrorName(le));
}
```

```cpp
#include <hip/hip_runtime.h>
#include <cstdio>
#include <cstdint>

#ifndef MK_N_LAUNCHES
#define MK_N_LAUNCHES 1
#endif

#define GAS __attribute__((address_space(1)))
#define LAS __attribute__((address_space(3)))
typedef unsigned short bf16;
typedef unsigned v4u __attribute__((ext_vector_type(4)));
typedef unsigned v2u __attribute__((ext_vector_type(2)));
typedef float f32x4 __attribute__((ext_vector_type(4)));
typedef float f32x2 __attribute__((ext_vector_type(2)));
typedef short bf16x8 __attribute__((ext_vector_type(8)));
typedef short s16x4 __attribute__((ext_vector_type(4)));
#define RLX_AGENT __ATOMIC_RELAXED, __HIP_MEMORY_SCOPE_AGENT
#define LDS_WAIT() asm volatile("s_waitcnt lgkmcnt(0)" ::: "memory")
#define VM_WAIT() asm volatile("s_waitcnt vmcnt(0)" ::: "memory")
#define LDS_BARRIER() do { asm volatile("s_waitcnt lgkmcnt(0)" ::: "memory"); __builtin_amdgcn_s_barrier(); asm volatile("" ::: "memory"); } while (0)

typedef __bf16 bf16x2_t __attribute__((ext_vector_type(2)));
__device__ __forceinline__ unsigned pk2(float lo, float hi) { const f32x2 v = {lo, hi}; return __builtin_bit_cast(unsigned, __builtin_convertvector(v, bf16x2_t)); }
__device__ __forceinline__ unsigned f2bf(float f) { return (unsigned)__builtin_bit_cast(unsigned short, (__bf16)f); }
__device__ __forceinline__ unsigned pk4_fp8(float a, float b, float c, float d) { int w = __builtin_amdgcn_cvt_pk_fp8_f32(a, b, 0, false); w = __builtin_amdgcn_cvt_pk_fp8_f32(c, d, w, true); return (unsigned)w; }
__device__ __forceinline__ float bflo(unsigned w) { return __builtin_bit_cast(float, w << 16); }
__device__ __forceinline__ float bfhi(unsigned w) { return __builtin_bit_cast(float, w & 0xffff0000u); }
__device__ __forceinline__ float bf2f(bf16 b) { return __builtin_bit_cast(float, ((unsigned)b) << 16); }
__device__ __forceinline__ float fexp(float x) { return __builtin_amdgcn_exp2f(x * 1.4426950408889634f); }
__device__ __forceinline__ float wave_sum(float v) {
#pragma unroll
    for (int o = 1; o < 64; o <<= 1) v += __shfl_xor(v, o);
    return v;
}

constexpr int D = 1024, NBATCH = 16, SEQ = 4096, CTXL = 256;
constexpr int NLAT = NBATCH * SEQ;
constexpr int NCTXR = NBATCH * CTXL;
constexpr int NROWS = NLAT + NCTXR;
constexpr int PW = 3104, PWP = 3328;
constexpr int CQ = 0, CK = 256, CV = 512, CR = 1024, CAF = 1536, CAB = 1552, CPB = 1568, CPC = 2080, CPX = 2592;
constexpr int NCC = 68;
constexpr int NEXP = 32, DFF = 1024;
constexpr float EPS = 1e-6f;
constexpr int LISTCAP = 65536;
constexpr float WSCALE = 32.0f, WSCALE_INV = 1.0f / 32.0f;

#ifndef OUTPROJ_F8
#define OUTPROJ_F8 1
#endif
constexpr size_t MiB = 1u << 20;
constexpr size_t WS_CTL = 0, CTL_ZERO_BYTES = 32768;
constexpr size_t WS_MOD = 1 * MiB;
constexpr size_t WS_DECAY = 2 * MiB;
constexpr size_t WS_WIN = 6 * MiB;
constexpr size_t WS_WOUT = 13 * MiB;
constexpr size_t WS_HN = 16 * MiB;
constexpr size_t WS_KV = 16 * MiB;
constexpr size_t WS_P = 152 * MiB;
constexpr size_t WS_S = 565 * MiB;
constexpr size_t WS_YMIX = 693 * MiB;
constexpr size_t WS_Y1 = 821 * MiB;
constexpr size_t WS_ACT = 16 * MiB;
constexpr size_t WS_YA = 280 * MiB;
constexpr size_t WS_VT = 949 * MiB;
constexpr size_t WS_END = 1013 * MiB;
constexpr size_t WS_TSLOT = 1013 * MiB;
constexpr size_t WS_TW = 1015 * MiB;
constexpr size_t WS_TOTAL = 1017 * MiB;
constexpr size_t DO_WDN = 0;
constexpr size_t DO_WGU = 32 * MiB;
constexpr size_t DO_HN2 = 96 * MiB;
constexpr size_t DO_LAID = 160 * MiB;
constexpr size_t DO_LW = 168 * MiB;
static_assert(WS_P + (size_t)NROWS * PW * 2 <= WS_S && WS_YMIX + (size_t)NLAT * D * 2 <= WS_Y1 && WS_YA + (size_t)1056 * 256 * D <= WS_Y1 && WS_Y1 + (size_t)NLAT * D * 2 <= WS_VT && WS_VT + (size_t)NLAT * 512 * 2 <= WS_END, "ws map");
static_assert(WS_HN + (size_t)NROWS * D * 2 <= WS_P && WS_ACT + (size_t)1056 * 256 * 1024 <= WS_YA && DO_LW + (size_t)NEXP * LISTCAP * 4 <= (size_t)NLAT * D * 4, "ws map 2");
constexpr int CW_CNT = 64;
constexpr int CW_BAR = 4096;

constexpr int RING_BYTES = 131072;
constexpr int MISC_OFF = RING_BYTES;
constexpr int LDS_BYTES = 147456;
constexpr int NWAVES = 8, NTHREADS = 512;

namespace pg8 {
constexpr int BM = 256, BK = 64, HALF = 128, HTB = HALF * BK * 2, STAGE_BYTES = 8 * HTB;
__host__ __device__ __forceinline__ int lds_byte(int r, int c) { const int st = (r >> 4) * 2 + (c >> 5), rr = r & 15, cc = c & 31, ob = rr * 64 + cc * 2; return st * 1024 + (ob ^ (((ob >> 9) & 1) << 5)); }
__host__ __device__ __forceinline__ void stage_rc(int b, int& R, int& C) { const int st = b / 1024, sb = b % 1024, swz = sb ^ (((sb >> 9) & 1) << 5); R = (st >> 1) * 16 + swz / 64; C = (st & 1) * 32 + (swz % 64) / 2; }
__host__ __device__ __forceinline__ int perm32(int rho) { const int n = rho >> 4, i = rho & 15; return 8 * (i >> 2) + 4 * n + (i & 3); }

typedef int v8i __attribute__((ext_vector_type(8)));
typedef int v4i __attribute__((ext_vector_type(4)));
__device__ __forceinline__ v8i cat8(bf16x8 lo, bf16x8 hi) { return __builtin_shufflevector(__builtin_bit_cast(v4i, lo), __builtin_bit_cast(v4i, hi), 0, 1, 2, 3, 4, 5, 6, 7); }
struct Unit { int pm, pn, e, lt; };
__device__ __forceinline__ unsigned cvt_pk_bf16(float lo, float hi) { unsigned r; asm volatile("v_cvt_pk_bf16_f32 %0, %1, %2" : "=v"(r) : "v"(lo), "v"(hi)); return r; }

template <class Epi, class Sched, bool ALIGN_EPI, bool F8>
__device__ __forceinline__ void gemm_phase(LAS unsigned char* lds, const char* Abase, const Sched& S, const Epi& E) {
    int tid_ = threadIdx.x; asm volatile("" : "+v"(tid_));
    const int tid = tid_, wid = __builtin_amdgcn_readfirstlane(tid >> 6), lane = tid & 63, wr = wid >> 2, wc = wid & 3, fr = lane & 15, fq = lane >> 4;
    constexpr int KB = F8 ? 1024 : 2048, NT = KB / 128;
    unsigned voffB[2];
#pragma unroll
    for (int i = 0; i < 2; ++i) { int R, C; stage_rc(tid * 16 + i * 8192, R, C); const int Rb = Epi::PERM ? ((R & ~31) + perm32(R & 31)) : R; voffB[i] = (unsigned)(Rb * KB + C * 2); }
#define PG8_AROWS(u_, dst_) do { _Pragma("unroll") for (int h_ = 0; h_ < 2; ++h_) _Pragma("unroll") for (int i_ = 0; i_ < 2; ++i_) { int R_, C_; stage_rc(tid * 16 + i_ * 8192, R_, C_); \
        dst_[h_][i_] = (unsigned)S.arow(u_, h_ * HALF + R_); } } while (0)
#define PG8_AOFF2(dst_) do { _Pragma("unroll") for (int h_ = 0; h_ < 2; ++h_) _Pragma("unroll") for (int i_ = 0; i_ < 2; ++i_) { int R_, C_; stage_rc(tid * 16 + i_ * 8192, R_, C_); \
        dst_[h_][i_] = dst_[h_][i_] * (unsigned)KB + (unsigned)C_ * 2u; } } while (0)
    const size_t kstep = (size_t)(BK * 2);
    const size_t hstep = (size_t)HALF * KB;
    const unsigned ldsw = (unsigned)wid * 1024u;
    const int aoff = lds_byte(wr * 64 + fr, fq * 8), boff = lds_byte(wc * 32 + fr, fq * 8);
#define PG8_SA(b, h) (((b) * 2 + (h)) * HTB)
#define PG8_SB(b, h) ((4 + (b) * 2 + (h)) * HTB)
#define PG8_STAGE(bufoff, gbase, voff) do { _Pragma("unroll") for (int _i = 0; _i < 2; ++_i) \
        __builtin_amdgcn_global_load_lds((const unsigned*)((const char*)(gbase) + (voff)[_i]), (LAS unsigned*)(lds + (bufoff) + ldsw + _i * 8192), 16, 0, 0); } while (0)
#define PG8_LDA(dst, b, h) do { _Pragma("unroll") for (int m = 0; m < 4; ++m) _Pragma("unroll") for (int k = 0; k < 2; ++k) dst[m][k] = *(const LAS bf16x8*)(lds + PG8_SA(b, h) + aoff + m * 2048 + k * 1024); } while (0)
#define PG8_LDB(dst, b, h) do { _Pragma("unroll") for (int n = 0; n < 2; ++n) _Pragma("unroll") for (int k = 0; k < 2; ++k) dst[n][k] = *(const LAS bf16x8*)(lds + PG8_SB(b, h) + boff + n * 2048 + k * 1024); } while (0)
#define PG8_MMA(ai, bj, At, Bt) do { if (skipmma && ((bj) == 1 || wc > 0)) break; __builtin_amdgcn_s_setprio(1); _Pragma("unroll") for (int m = 0; m < 4; ++m) _Pragma("unroll") for (int n = 0; n < 2; ++n) { \
        if constexpr (F8) { asm volatile("v_mfma_f32_16x16x128_f8f6f4 %0, %1, %2, %0" : "+v"(acc[ai][bj][m][n]) : "v"(cat8(Bt[n][0], Bt[n][1])), "v"(cat8(At[m][0], At[m][1]))); } \
        else { _Pragma("unroll") for (int k = 0; k < 2; ++k) acc[ai][bj][m][n] = __builtin_amdgcn_mfma_f32_16x16x32_bf16(Bt[n][k], At[m][k], acc[ai][bj][m][n], 0, 0, 0); } } \
        __builtin_amdgcn_s_setprio(0); } while (0)
#define PG8_WAIT_V(n) asm volatile("s_waitcnt vmcnt(" #n ")" ::: "memory")
#define PG8_WAIT_L(n) asm volatile("s_waitcnt lgkmcnt(" #n ")" ::: "memory")
#define PG8_BAR __builtin_amdgcn_s_barrier()
#define PG8_SCHED __builtin_amdgcn_sched_barrier(0)
    Unit cur, nxt; int ui = 0;
    if (!S.next(0, cur)) return;
    f32x4 acc[2][2][4][2];
#pragma unroll
    for (int a = 0; a < 2; ++a)
#pragma unroll
        for (int b = 0; b < 2; ++b)
#pragma unroll
            for (int m = 0; m < 4; ++m)
#pragma unroll
                for (int n = 0; n < 2; ++n) acc[a][b][m][n] = (f32x4){0.f, 0.f, 0.f, 0.f};
    bf16x8 At[4][2], B0[2][2], B1[2][2];
    unsigned oC[2][2];
    PG8_AROWS(cur, oC); PG8_AOFF2(oC);
    unsigned rN[2] = {0u, 0u};
    const char* cB = S.bptr(cur);
    PG8_STAGE(PG8_SB(0, 0), cB, voffB); PG8_STAGE(PG8_SB(0, 1), cB + hstep, voffB); PG8_STAGE(PG8_SA(0, 0), Abase, oC[0]); PG8_STAGE(PG8_SA(0, 1), Abase, oC[1]);
    if (wr == 1) PG8_BAR;
    PG8_WAIT_V(2); PG8_BAR;
    PG8_STAGE(PG8_SB(1, 0), cB + kstep, voffB); PG8_STAGE(PG8_SA(1, 0), Abase + kstep, oC[0]); PG8_STAGE(PG8_SB(1, 1), cB + hstep + kstep, voffB);
    PG8_WAIT_V(6); PG8_BAR;
    for (;;) {
        const bool skipmma = S.mostly_padding(cur);
        const bool has_next = S.next(ui + 1, nxt);
        if (!has_next) nxt = cur;
        const char* nB = S.bptr(nxt);
        for (int t = 0; t < NT; t += 2) {
            const bool last = (t == NT - 2);
            const char* ka1 = Abase + (size_t)(t + 1) * kstep;
            const char* ka2 = last ? Abase : Abase + (size_t)(t + 2) * kstep; const char* b2 = last ? nB : cB + (size_t)(t + 2) * kstep;
            const char* ka3 = ka2 + kstep; const char* b3 = b2 + kstep;
            PG8_LDB(B0, 0, 0); PG8_LDB(B1, 0, 1); PG8_SCHED; PG8_LDA(At, 0, 0); PG8_STAGE(PG8_SA(1, 1), ka1, oC[1]);
            PG8_WAIT_V(8); PG8_WAIT_L(0); PG8_BAR; PG8_MMA(0, 0, At, B0); PG8_MMA(0, 1, At, B1); PG8_BAR; PG8_SCHED;
            if constexpr (Sched::GATHER) { if (t == NT - 4) { unsigned r4[2][2]; PG8_AROWS(nxt, r4); rN[0] = r4[0][0] | (r4[0][1] << 16); rN[1] = r4[1][0] | (r4[1][1] << 16); } }
            if (last) {
                if constexpr (Sched::GATHER) { oC[0][0] = rN[0] & 0xffffu; oC[0][1] = rN[0] >> 16; oC[1][0] = rN[1] & 0xffffu; oC[1][1] = rN[1] >> 16; }
                else { PG8_AROWS(nxt, oC); }
                PG8_AOFF2(oC); }
            PG8_LDA(At, 0, 1); PG8_STAGE(PG8_SB(0, 0), b2, voffB); PG8_STAGE(PG8_SB(0, 1), b2 + hstep, voffB); PG8_STAGE(PG8_SA(0, 0), ka2, oC[0]);
            PG8_WAIT_V(8); PG8_WAIT_L(0); PG8_BAR; PG8_MMA(1, 0, At, B0); PG8_MMA(1, 1, At, B1); PG8_BAR; PG8_SCHED;
            PG8_LDB(B0, 1, 0); PG8_LDB(B1, 1, 1); PG8_SCHED; PG8_LDA(At, 1, 0); PG8_STAGE(PG8_SA(0, 1), ka2, oC[1]);
            PG8_WAIT_V(8); PG8_WAIT_L(0); PG8_BAR; PG8_MMA(0, 0, At, B0); PG8_MMA(0, 1, At, B1); PG8_BAR; PG8_SCHED;
            PG8_LDA(At, 1, 1); PG8_STAGE(PG8_SB(1, 0), b3, voffB); PG8_STAGE(PG8_SB(1, 1), b3 + hstep, voffB); PG8_STAGE(PG8_SA(1, 0), ka3, oC[0]);
            PG8_WAIT_V(8); PG8_WAIT_L(0); PG8_BAR; PG8_MMA(1, 0, At, B0); PG8_MMA(1, 1, At, B1); PG8_BAR; PG8_SCHED;
        }
        if constexpr (ALIGN_EPI) { if (wr == 0) PG8_BAR; }
        if constexpr (F8) asm volatile("s_nop 15\n\ts_nop 7" ::: "memory");
        { int fr_o = fr, fq_o = fq; asm volatile("" : "+v"(fr_o), "+v"(fq_o));
          E(acc, cur, wr, wc, fr_o, fq_o); }
        if (!has_next) break;
#pragma unroll
        for (int a = 0; a < 2; ++a)
#pragma unroll
            for (int b = 0; b < 2; ++b)
#pragma unroll
                for (int m = 0; m < 4; ++m)
#pragma unroll
                    for (int n = 0; n < 2; ++n) acc[a][b][m][n] = (f32x4){0.f, 0.f, 0.f, 0.f};
        cur = nxt; cB = nB; ++ui;
        if constexpr (ALIGN_EPI) { if (wr == 1) PG8_BAR; }
    }
    PG8_WAIT_V(0);
    if constexpr (!ALIGN_EPI) { if (wr == 0) PG8_BAR; }
    PG8_BAR;
#undef PG8_AROWS
#undef PG8_AOFF2
#undef PG8_SA
#undef PG8_SB
#undef PG8_STAGE
#undef PG8_LDA
#undef PG8_LDB
#undef PG8_MMA
#undef PG8_WAIT_V
#undef PG8_WAIT_L
#undef PG8_BAR
#undef PG8_SCHED
}
}

#define XB_TMO      128
#define XB_XCNT(j)  (256  + 64 * (j))
#define XB_XSUB(j)  (1280 + 64 * (j))
#define XB_XGEN(j)  (2304 + 64 * (j))
#define XB_TOP      3328
#define XB_TOPGEN   3392
#define XCD_BAR_WORDS 3456
#define XB_SPIN_CAP (1u << 22)
__device__ __forceinline__ unsigned xb_ld(unsigned* p)              { return __hip_atomic_load(p, __ATOMIC_RELAXED, __HIP_MEMORY_SCOPE_AGENT); }
__device__ __forceinline__ unsigned xb_add(unsigned* p, unsigned v) { return __hip_atomic_fetch_add(p, v, __ATOMIC_RELAXED, __HIP_MEMORY_SCOPE_AGENT); }
__device__ __forceinline__ unsigned xb_xcc_id() { return (unsigned)__builtin_amdgcn_s_getreg((3 << 11) | 20) & 0xFu; }
#define XB_SPIN(cond, bar) do { unsigned _sp = 0; while (cond) { __builtin_amdgcn_s_sleep(1); \
    if ((++_sp & 255u) == 0u) { if (xb_ld(&(bar)[XB_TMO])) break; if (_sp > XB_SPIN_CAP) { atomicAdd(&(bar)[XB_TMO], 1u); break; } } } } while (0)
struct XcdBarrier { unsigned* bar; unsigned x; volatile LAS unsigned* st; };
__device__ __forceinline__ XcdBarrier xcd_barrier_post(unsigned* bar, volatile LAS unsigned* st) {
    XcdBarrier b; b.bar = bar; b.x = xb_xcc_id(); b.st = st;
    if (threadIdx.x == 0) (void)xb_add(&bar[XB_XCNT(b.x)], 1u);
    return b;
}
__device__ __forceinline__ void xcd_barrier_complete(unsigned* bar, unsigned x, unsigned& nloc, unsigned& nx) {
    const unsigned G = gridDim.x * gridDim.y * gridDim.z;
    unsigned sum, cnt, mine, sp = 0u;
    for (;;) {
        sum = 0u; cnt = 0u; mine = 0u;
#pragma unroll 1
        for (unsigned j = 0; j < 16; ++j) { const unsigned c = xb_ld(&bar[XB_XCNT(j)]); sum += c; cnt += (c > 0u) ? 1u : 0u; mine = (j == x) ? c : mine; }
        if (sum == G) break;
        __builtin_amdgcn_s_sleep(1);
        if ((++sp & 255u) == 0u) { if (xb_ld(&bar[XB_TMO])) break; if (sp > XB_SPIN_CAP) { atomicAdd(&bar[XB_TMO], 1u); break; } }
    }
    nloc = mine > 0u ? mine : 1u; nx = cnt > 0u ? cnt : 1u;
}
__device__ __forceinline__ void xcd_barrier(const XcdBarrier& b) {
    asm volatile("s_waitcnt vmcnt(0)" ::: "memory");
    __syncthreads();
    if (threadIdx.x == 0) {
        unsigned* bar = b.bar;
        __builtin_amdgcn_s_waitcnt(0);
        unsigned nloc = b.st[0], nx = b.st[1];
        if (nloc == 0u) { xcd_barrier_complete(bar, b.x, nloc, nx); b.st[0] = nloc; b.st[1] = nx; }
        const unsigned old = xb_add(&bar[XB_XSUB(b.x)], 1u);
        const unsigned gen = old / nloc;
        if (old + 1u == (gen + 1u) * nloc) {
            __builtin_amdgcn_fence(__ATOMIC_RELEASE, "agent");
            asm volatile("s_waitcnt vmcnt(0)" ::: "memory");
            const unsigned og = xb_add(&bar[XB_TOP], 1u);
            const unsigned tg = og / nx;
            if (og + 1u == (tg + 1u) * nx) xb_add(&bar[XB_TOPGEN], 1u);
            else XB_SPIN(xb_ld(&bar[XB_TOPGEN]) == tg, bar);
            __builtin_amdgcn_fence(__ATOMIC_ACQUIRE, "agent");
            xb_add(&bar[XB_XGEN(b.x)], 1u);
            asm volatile("s_waitcnt vmcnt(0)" ::: "memory");
        } else {
            XB_SPIN(xb_ld(&bar[XB_XGEN(b.x)]) == gen, bar);
            __builtin_amdgcn_fence(__ATOMIC_ACQUIRE, "agent");
            asm volatile("s_waitcnt vmcnt(0)" ::: "memory");
        }
    }
    __syncthreads();
}

struct Args { const float* in[23]; float* out; unsigned char* ws; int ph_lo, ph_hi; };
typedef const Args __attribute__((address_space(4))) CArgs;
__device__ __forceinline__ CArgs* opaque_args() { CArgs* p = (CArgs*)__builtin_amdgcn_kernarg_segment_ptr(); asm volatile("" : "+s"(p)); return p; }
struct Frame {
    LAS unsigned char* lds;
    int tid, lane, wave, G, bid;
    float* out; unsigned char* ws;
};

struct EpiNull {
    static constexpr bool PERM = true;
    __device__ __forceinline__ void operator()(const f32x4 (&acc)[2][2][4][2], const pg8::Unit&, int, int, int, int) const {
#pragma unroll
        for (int a = 0; a < 2; ++a)
#pragma unroll
            for (int b = 0; b < 2; ++b)
#pragma unroll
                for (int m = 0; m < 4; ++m)
#pragma unroll
                    for (int n = 0; n < 2; ++n) asm volatile("" :: "v"(acc[a][b][m][n]));
    }
};
struct DenseSched {
    static constexpr bool GATHER = false;
    int nM, nN, nwg, G, c, kb; const char* Bt; const LAS int* UT;
    __device__ __forceinline__ void init(int M, int N, int G_, int c_, const void* Bt_) { nM = M / 256; nN = N / 256; nwg = nM * nN; G = G_; c = c_; Bt = (const char*)Bt_; UT = nullptr; kb = 2048; }
    __device__ __forceinline__ void build(LAS int* ut, int tid) { if (tid < 32) { pg8::Unit u; ut[tid] = next_calc(tid, u) ? (u.pm | (u.pn << 16)) : -1; } UT = ut; __syncthreads(); }
    __device__ __forceinline__ bool next(int i, pg8::Unit& u) const { const int w = (i < 32) ? UT[i] : -1; if (w < 0) return false; u.pm = w & 0xffff; u.pn = w >> 16; u.e = 0; u.lt = 0; return true; }
    __device__ __forceinline__ bool next_calc(int i, pg8::Unit& u) const {
        const long L = (long)i * G + c; if (L >= nwg) return false;
        int wgid = (int)L; { const int q = nwg / 8, r = nwg % 8, xcd = wgid % 8, off = wgid / 8; wgid = (xcd < r ? xcd * (q + 1) : r * (q + 1) + (xcd - r) * q) + off; }
        const int nig = 8 * nN, gid = wgid / nig, fm = gid * 8, gsz = (nM - fm) < 8 ? (nM - fm) : 8;
        u.pm = fm + ((wgid % nig) % gsz); u.pn = (wgid % nig) / gsz; u.e = 0; u.lt = 0; return true;
    }
    __device__ __forceinline__ int arow(const pg8::Unit& u, int r) const { return u.pm * 256 + r; }
    __device__ __forceinline__ bool mostly_padding(const pg8::Unit& u) const { return nN == PWP / 256 && u.pn == nN - 1; }
    __device__ __forceinline__ const char* bptr(const pg8::Unit& u) const { return Bt + (size_t)u.pn * 256 * kb; }
};
struct EpiProj {
    static constexpr bool PERM = true;
    bf16* O;
    __device__ __forceinline__ void operator()(const f32x4 (&acc)[2][2][4][2], const pg8::Unit& u, int wr, int wc, int fr, int fq) const {
        const int row0 = u.pm * 256 + wr * 64 + fr, col0 = u.pn * 256 + wc * 32 + 8 * fq;
#pragma unroll
        for (int ai = 0; ai < 2; ++ai)
#pragma unroll
            for (int m = 0; m < 4; ++m) { bf16* rowp = O + (size_t)(row0 + ai * 128 + m * 16) * PW + col0;
#pragma unroll
                for (int bj = 0; bj < 2; ++bj) { if (col0 + bj * 128 < PW) { const f32x4 v0 = acc[ai][bj][m][0], v1 = acc[ai][bj][m][1];
                    v4u w; w.x = pk2(v0[0], v0[1]); w.y = pk2(v0[2], v0[3]); w.z = pk2(v1[0], v1[1]); w.w = pk2(v1[2], v1[3]);
                    *(v4u*)(rowp + bj * 128) = w; } } }
    }
};
struct EpiOut {
    static constexpr bool PERM = true;
    const float* x; const float* mod; bf16* Y1; float sc;
    __device__ __forceinline__ void operator()(const f32x4 (&acc)[2][2][4][2], const pg8::Unit& u, int wr, int wc, int fr, int fq) const {
        const int row0 = u.pm * 256 + wr * 64 + fr, col0 = u.pn * 256 + wc * 32 + 8 * fq;
        const float* g1 = mod + (size_t)(u.pm >> 4) * 6144 + 2048;
        f32x4 gv[2][2];
#pragma unroll
        for (int bj = 0; bj < 2; ++bj)
#pragma unroll
            for (int n = 0; n < 2; ++n) gv[bj][n] = *(const f32x4*)(g1 + col0 + bj * 128 + 4 * n) * sc;
#pragma unroll
        for (int ai = 0; ai < 2; ++ai)
#pragma unroll
            for (int m = 0; m < 4; ++m) { const size_t off = (size_t)(row0 + ai * 128 + m * 16) * D + col0; bf16* rowp = Y1 + off;
#pragma unroll
                for (int bj = 0; bj < 2; ++bj) { const f32x4 x0 = *(const f32x4*)(x + off + bj * 128), x1 = *(const f32x4*)(x + off + bj * 128 + 4);
                    const f32x4 v0 = x0 + acc[ai][bj][m][0] * gv[bj][0], v1 = x1 + acc[ai][bj][m][1] * gv[bj][1];
                    v4u w; w.x = pk2(v0[0], v0[1]); w.y = pk2(v0[2], v0[3]); w.z = pk2(v1[0], v1[1]); w.w = pk2(v1[2], v1[3]);
                    *(v4u*)(rowp + bj * 128) = w; } }
    }
};
template <bool GU> struct MoeSched {
    static constexpr bool GATHER = GU;
    static constexpr bool gu = GU;
    const LAS int* TS; int ntr, G, c; const int* laid; const char* W;
    __device__ __forceinline__ bool next(int i, pg8::Unit& u) const {
        const int x = c & 7, j = c >> 3; int tl, pn;
        if (G != 256) { const int L = i * G + c, npn = gu ? 8 : 4; tl = L / npn; pn = L % npn; }
        else if (gu) { tl = (i * 8 + x) * 4 + (j >> 3); pn = j & 7; } else { tl = (i * 8 + x) * 8 + (j >> 2); pn = j & 3; }
        if (tl >= ntr) return false;
        const int tau = tl; const int e = ((const LAS unsigned char*)(TS + 72))[tau];
        u.pm = tl; u.pn = pn; u.e = e; u.lt = tau - TS[e]; return true;
    }
    __device__ __forceinline__ bool mostly_padding(const pg8::Unit&) const { return false; }
    __device__ __forceinline__ int arow(const pg8::Unit& u, int r) const {
        if (!gu) return u.pm * 256 + r;
        const int pos = u.lt * 256 + r, cnt = TS[33 + u.e];
        return pos < cnt ? (laid[(size_t)u.e * LISTCAP + pos] >> 2) : 0;
    }
    __device__ __forceinline__ const char* bptr(const pg8::Unit& u) const { return W + ((size_t)u.e * (gu ? 2048 : 1024) + (size_t)u.pn * 256) * 1024; }
};
struct EpiGU {
    static constexpr bool PERM = true;
    unsigned char* ACT; const float* b_gu;
    __device__ __forceinline__ void operator()(const f32x4 (&acc)[2][2][4][2], const pg8::Unit& u, int wr, int wc, int fr, int fq) const {
        const int row0 = u.pm * 256 + wr * 64 + fr, j0 = u.pn * 128 + wc * 32 + 8 * fq;
        const float* bp = b_gu + (size_t)u.e * 2048 + 2 * j0;
        f32x4 bv[4];
#pragma unroll
        for (int q = 0; q < 4; ++q) bv[q] = *(const f32x4*)(bp + 4 * q);
        f32x2 bg[4], bu[4];
#pragma unroll
        for (int q = 0; q < 4; ++q) { bg[q] = (f32x2){bv[q][0], bv[q][2]}; bu[q] = (f32x2){bv[q][1], bv[q][3]}; }
#pragma unroll
        for (int ai = 0; ai < 2; ++ai)
#pragma unroll
            for (int m = 0; m < 4; ++m) { unsigned char* rowp = ACT + (size_t)(row0 + ai * 128 + m * 16) * DFF + j0; f32x2 a[4];
#pragma unroll
                for (int n = 0; n < 2; ++n)
#pragma unroll
                    for (int p = 0; p < 2; ++p) { const int q = 2 * n + p;
                        const f32x4 ag = acc[ai][0][m][n], au = acc[ai][1][m][n];
                        f32x2 g = (f32x2){ag[2 * p], ag[2 * p + 1]} * WSCALE_INV + bg[q], up = (f32x2){au[2 * p], au[2 * p + 1]} * WSCALE_INV + bu[q];
                        g.x = fminf(g.x, 7.0f); g.y = fminf(g.y, 7.0f); up.x = __builtin_amdgcn_fmed3f(up.x, -7.0f, 7.0f); up.y = __builtin_amdgcn_fmed3f(up.y, -7.0f, 7.0f);
                        const f32x2 t = g * (-1.702f * 1.4426950408889634f); f32x2 e; e.x = __builtin_amdgcn_exp2f(t.x); e.y = __builtin_amdgcn_exp2f(t.y);
                        const f32x2 d = e + 1.0f; f32x2 sg; sg.x = __builtin_amdgcn_rcpf(d.x); sg.y = __builtin_amdgcn_rcpf(d.y);
                        a[q] = ((up + 1.0f) * g) * sg; }
                v2u w; w.x = pk4_fp8(a[0].x, a[0].y, a[1].x, a[1].y); w.y = pk4_fp8(a[2].x, a[2].y, a[3].x, a[3].y);
                *(v2u*)rowp = w; }
    }
};
struct EpiDN {
    static constexpr bool PERM = true;
    unsigned char* YA; const float* b_dn; const LAS int* TS;
    __device__ __forceinline__ void operator()(const f32x4 (&acc)[2][2][4][2], const pg8::Unit& u, int wr, int wc, int fr, int fq) const {
        const int col0 = u.pn * 256 + wc * 32 + 8 * fq, cnt = TS[33 + u.e];
        f32x4 bv[2][2];
#pragma unroll
        for (int bj = 0; bj < 2; ++bj)
#pragma unroll
            for (int n = 0; n < 2; ++n) bv[bj][n] = *(const f32x4*)(b_dn + (size_t)u.e * D + col0 + bj * 128 + 4 * n);
#pragma unroll
        for (int ai = 0; ai < 2; ++ai)
#pragma unroll
            for (int m = 0; m < 4; ++m) { const int r = ai * 128 + wr * 64 + m * 16 + fr;
                if (u.lt * 256 + r < cnt) { unsigned char* rowp = YA + ((size_t)u.pm * 256 + r) * D + col0;
#pragma unroll
                    for (int bj = 0; bj < 2; ++bj) { const f32x4 v0 = acc[ai][bj][m][0] * WSCALE_INV + bv[bj][0], v1 = acc[ai][bj][m][1] * WSCALE_INV + bv[bj][1];
                        v2u w; w.x = pk4_fp8(v0[0], v0[1], v0[2], v0[3]); w.y = pk4_fp8(v1[0], v1[1], v1[2], v1[3]);
                        *(v2u*)(rowp + bj * 128) = w; } }
                asm volatile("" ::: "memory"); }
    }
};

template <bool MAPGU>
__device__ __forceinline__ void p0_transpose_item(const float* W, int N, bf16* WT, LAS float* scr, int item, int lane) {
    const int nblk = N / 32, kb = item / nblk, nb = item % nblk, k0 = 64 * kb, n0 = 32 * nb;
#pragma unroll
    for (int i = 0; i < 32; ++i) { const int kk = 2 * i + (lane >> 5); scr[kk * 33 + (lane & 31)] = W[(size_t)(k0 + kk) * N + n0 + (lane & 31)]; }
    LDS_WAIT(); asm volatile("" ::: "memory");
    const int c = lane & 7;
#pragma unroll
    for (int j = 0; j < 4; ++j) { const int n = (lane >> 3) + 8 * j; const LAS float* s = scr + (8 * c) * 33 + n;
        v4u o; o.x = pk2(s[0 * 33], s[1 * 33]); o.y = pk2(s[2 * 33], s[3 * 33]); o.z = pk2(s[4 * 33], s[5 * 33]); o.w = pk2(s[6 * 33], s[7 * 33]);
        int row = n0 + n;
        if (MAPGU) { const int jj = row >> 1; row = (jj >> 7) * 256 + (row & 1) * 128 + (jj & 127); }
        *(v4u*)(WT + (size_t)row * D + k0 + 8 * c) = o; }
    LDS_WAIT(); asm volatile("" ::: "memory");
}
template <bool MAPGU>
__device__ __forceinline__ void p0_transpose_item_f8(const float* W, int N, unsigned char* WT, LAS float* scr, int item, int lane) {
    const int nblk = N / 32, kb = item / nblk, nb = item % nblk, k0 = 64 * kb, n0 = 32 * nb;
#pragma unroll
    for (int i = 0; i < 32; ++i) { const int kk = 2 * i + (lane >> 5); scr[kk * 33 + (lane & 31)] = W[(size_t)(k0 + kk) * N + n0 + (lane & 31)] * WSCALE; }
    LDS_WAIT(); asm volatile("" ::: "memory");
    const int c = lane & 3;
#pragma unroll
    for (int j = 0; j < 2; ++j) { const int n = (lane >> 2) + 16 * j; const LAS float* s = scr + (16 * c) * 33 + n;
        v4u o; o.x = pk4_fp8(s[0 * 33], s[1 * 33], s[2 * 33], s[3 * 33]); o.y = pk4_fp8(s[4 * 33], s[5 * 33], s[6 * 33], s[7 * 33]);
        o.z = pk4_fp8(s[8 * 33], s[9 * 33], s[10 * 33], s[11 * 33]); o.w = pk4_fp8(s[12 * 33], s[13 * 33], s[14 * 33], s[15 * 33]);
        int row = n0 + n;
        if (MAPGU) { const int jj = row >> 1; row = (jj >> 7) * 256 + (row & 1) * 128 + (jj & 127); }
        *(v4u*)(WT + (size_t)row * D + k0 + 16 * c) = o; }
    LDS_WAIT(); asm volatile("" ::: "memory");
}
constexpr int P0_TS = 144;
struct P0Item { const float* W; void* O; int N, k0, n0, kind; };
__device__ __forceinline__ P0Item p0_item(const Frame& F, CArgs* A, int it) {
    constexpr int I_IN = 8 * 25, I_OUT = 8 * 8, I_GU = 8 * 16, I_DN = 8 * 8;
    P0Item r; int x = it;
    if (x < I_IN) { r.W = A->in[7]; r.O = (void*)(F.ws + WS_WIN); r.N = PW; r.k0 = (x / 25) * 128; r.n0 = (x % 25) * 128; r.kind = 0; return r; } x -= I_IN;
    if (x < I_OUT) { r.W = A->in[14]; r.O = (void*)(F.ws + WS_WOUT); r.N = D; r.k0 = (x >> 3) * 128; r.n0 = (x & 7) * 128; r.kind = OUTPROJ_F8 ? 1 : 0; return r; } x -= I_OUT;
    if (x < NEXP * I_GU) { const int e = x / I_GU, y = x % I_GU; r.W = A->in[18] + (size_t)e * D * 2048; r.O = (void*)((unsigned char*)F.out + DO_WGU + (size_t)e * 2048 * D); r.N = 2048; r.k0 = (y >> 4) * 128; r.n0 = (y & 15) * 128; r.kind = 2; return r; } x -= NEXP * I_GU;
    { const int e = x / I_DN, y = x % I_DN; r.W = A->in[20] + (size_t)e * D * D; r.O = (void*)((unsigned char*)F.out + DO_WDN + (size_t)e * D * D); r.N = D; r.k0 = (y >> 3) * 128; r.n0 = (y & 7) * 128; r.kind = 1; return r; }
}
__device__ __forceinline__ void p0_load(const P0Item& I, int tid, f32x4 (&v)[8]) {
#pragma unroll
    for (int q = 0; q < 8; ++q) { const int idx = tid + NTHREADS * q, k = idx >> 5, col = I.n0 + 4 * (idx & 31);
        v[q] = (col < I.N) ? *(const f32x4*)(I.W + (size_t)(I.k0 + k) * I.N + col) : (f32x4){0.f, 0.f, 0.f, 0.f}; }
}
__device__ __forceinline__ void p0_emit(const P0Item& I, LAS unsigned char* lds, int wave, int i, int g) {
    const unsigned a0 = (unsigned)(uintptr_t)lds + (unsigned)(((32 * g + (i >> 2)) * P0_TS + 16 * wave + 4 * (i & 3)) * 2);
    s16x4 r[8];
    asm volatile("ds_read_b64_tr_b16 %0, %8\n\tds_read_b64_tr_b16 %1, %8 offset:1152\n\tds_read_b64_tr_b16 %2, %8 offset:2304\n\tds_read_b64_tr_b16 %3, %8 offset:3456\n\t"
                 "ds_read_b64_tr_b16 %4, %8 offset:4608\n\tds_read_b64_tr_b16 %5, %8 offset:5760\n\tds_read_b64_tr_b16 %6, %8 offset:6912\n\tds_read_b64_tr_b16 %7, %8 offset:8064\n\ts_waitcnt lgkmcnt(0)"
                 : "=&v"(r[0]), "=&v"(r[1]), "=&v"(r[2]), "=&v"(r[3]), "=&v"(r[4]), "=&v"(r[5]), "=&v"(r[6]), "=&v"(r[7]) : "v"(a0) : "memory");
    const int n = I.n0 + 16 * wave + i;
    if (n < I.N) {
        if (I.kind == 0) { bf16* op = (bf16*)I.O + (size_t)n * D + I.k0 + 32 * g;
#pragma unroll
            for (int q = 0; q < 4; ++q) { v4u w; w.x = (unsigned)(unsigned short)r[2 * q][0] | ((unsigned)(unsigned short)r[2 * q][1] << 16); w.y = (unsigned)(unsigned short)r[2 * q][2] | ((unsigned)(unsigned short)r[2 * q][3] << 16);
                w.z = (unsigned)(unsigned short)r[2 * q + 1][0] | ((unsigned)(unsigned short)r[2 * q + 1][1] << 16); w.w = (unsigned)(unsigned short)r[2 * q + 1][2] | ((unsigned)(unsigned short)r[2 * q + 1][3] << 16);
                *(v4u*)(op + 8 * q) = w; } }
        else { int row = n; if (I.kind == 2) { const int jj = n >> 1; row = (jj >> 7) * 256 + (n & 1) * 128 + (jj & 127); }
            unsigned char* op = (unsigned char*)I.O + (size_t)row * D + I.k0 + 32 * g;
#pragma unroll
            for (int q = 0; q < 2; ++q) { v4u w; unsigned* wp = (unsigned*)&w;
#pragma unroll
                for (int j = 0; j < 4; ++j) { const s16x4 x = r[4 * q + j]; wp[j] = pk4_fp8(bf2f((bf16)x[0]) * WSCALE, bf2f((bf16)x[1]) * WSCALE, bf2f((bf16)x[2]) * WSCALE, bf2f((bf16)x[3]) * WSCALE); }
                *(v4u*)(op + 16 * q) = w; } } }
}
__device__ __forceinline__ void p0_phase(const Frame& F, CArgs* A) {
    LAS unsigned char* lds = F.lds; const int tid = F.tid, lane = F.lane, wave = F.wave, i = lane & 15, g = lane >> 4;
    constexpr int NITEMS = 8 * 25 + 8 * 8 + NEXP * 8 * 16 + NEXP * 8 * 8;
    { v4u z = {0u, 0u, 0u, 0u}; v4u* p = (v4u*)(((bf16*)(F.ws + WS_WIN)) + (size_t)PW * D); const int n16 = (PWP - PW) * D * 2 / 16;
      for (int i = F.bid * NTHREADS + F.tid; i < n16; i += F.G * NTHREADS) p[i] = z; }
    __syncthreads();
    LAS float* sl = (LAS float*)F.lds;
    LAS float* red = (LAS float*)(F.lds + 1024 * 20 * 4);
    bool filled = false;
    for (int it = F.bid; it < 6144 / 64; it += F.G) {
        if (!filled) {
            for (int i = F.tid; i < 17 * 1024; i += NTHREADS) { const int m = i >> 10, k = i & 1023; const float v = (m < 16) ? A->in[1][m * 1024 + k] : A->in[3][k]; sl[k * 20 + m] = v * __builtin_amdgcn_rcpf(1.0f + fexp(-v)); }
            filled = true; __syncthreads();
        }
        float a[17];
#pragma unroll
        for (int m = 0; m < 17; ++m) a[m] = 0.f;
        const int j = it * 64 + F.lane;
#pragma unroll 1
        for (int kb = 0; kb < 128; kb += 16) { float wv[16];
#pragma unroll
          for (int q = 0; q < 16; ++q) wv[q] = A->in[4][(size_t)(F.wave * 128 + kb + q) * 6144 + j];
#pragma unroll
          for (int q = 0; q < 16; ++q) { const int k = F.wave * 128 + kb + q; const float w = wv[q];
            const LAS float* sp = sl + k * 20;
            const f32x4 s0 = *(const LAS f32x4*)sp, s1 = *(const LAS f32x4*)(sp + 4), s2 = *(const LAS f32x4*)(sp + 8), s3 = *(const LAS f32x4*)(sp + 12); const float s4 = sp[16];
            a[0] += s0[0] * w; a[1] += s0[1] * w; a[2] += s0[2] * w; a[3] += s0[3] * w; a[4] += s1[0] * w; a[5] += s1[1] * w; a[6] += s1[2] * w; a[7] += s1[3] * w;
            a[8] += s2[0] * w; a[9] += s2[1] * w; a[10] += s2[2] * w; a[11] += s2[3] * w; a[12] += s3[0] * w; a[13] += s3[1] * w; a[14] += s3[2] * w; a[15] += s3[3] * w; a[16] += s4 * w; } }
#pragma unroll
        for (int m = 0; m < 17; ++m) red[(F.wave * 17 + m) * 64 + F.lane] = a[m];
        __syncthreads();
        for (int i = F.tid; i < 17 * 64; i += NTHREADS) { const int m = i >> 6, l = i & 63; float s = 0.f;
#pragma unroll
            for (int w = 0; w < 8; ++w) s += red[(w * 17 + m) * 64 + l];
            ((float*)(F.ws + WS_MOD))[(size_t)m * 6144 + it * 64 + l] = s + A->in[5][it * 64 + l]; }
        __syncthreads();
    }
    __syncthreads();
    int first = F.bid, stride = F.G, cnt = (NITEMS + F.G - 1) / F.G;
    if (F.G == 256) { if (F.bid >= 96) { first = F.bid - 96; stride = 160; cnt = 26; } else { first = 160 * 26 + F.bid; stride = 96; cnt = 24; } }
    static_assert(160 * 26 + 96 * 24 >= NITEMS, "P0 item split");
    f32x4 va[8], vb[8];
    if (first < NITEMS) { const P0Item I0 = p0_item(F, A, first); p0_load(I0, tid, va); }
    if (cnt > 1 && first + stride < NITEMS) { const P0Item I1 = p0_item(F, A, first + stride); p0_load(I1, tid, vb); }
#define P0_STEP(VCUR, k_) do { const int it_ = first + (k_) * stride; const P0Item I = p0_item(F, A, it_); \
        _Pragma("unroll") for (int q = 0; q < 8; ++q) { const int idx = tid + NTHREADS * q, k = idx >> 5, p = idx & 31; v2u w; w.x = pk2(VCUR[q][0], VCUR[q][1]); w.y = pk2(VCUR[q][2], VCUR[q][3]); \
            *(LAS v2u*)(lds + (k * P0_TS + 4 * p) * 2) = w; } \
        if ((k_) + 2 < cnt && it_ + 2 * stride < NITEMS) { const P0Item In = p0_item(F, A, it_ + 2 * stride); p0_load(In, tid, VCUR); } \
        LDS_BARRIER(); \
        p0_emit(I, lds, wave, i, g); \
        LDS_BARRIER(); } while (0)
#pragma unroll 1
    for (int k = 0; k < cnt && first + k * stride < NITEMS; k += 2) {
        P0_STEP(va, k);
        if (k + 1 < cnt && first + (k + 1) * stride < NITEMS) P0_STEP(vb, k + 1);
    }
#undef P0_STEP
}

__device__ __forceinline__ void p1_phase(const Frame& F, CArgs* A) {
    const int gw = F.bid * NWAVES + F.wave, NGW = F.G * NWAVES;
    for (int r0 = gw; r0 < NROWS; r0 += 2 * NGW) {
        const int r1 = r0 + NGW; const bool two = r1 < NROWS;
        const float* xa = (r0 < NLAT) ? A->in[0] + (size_t)r0 * D : A->in[2] + (size_t)(r0 - NLAT) * D;
        const float* xb = !two ? xa : ((r1 < NLAT) ? A->in[0] + (size_t)r1 * D : A->in[2] + (size_t)(r1 - NLAT) * D);
        f32x4 va[4], vb[4];
#pragma unroll
        for (int j = 0; j < 4; ++j) { va[j] = ((const f32x4*)xa)[F.lane + 64 * j]; vb[j] = ((const f32x4*)xb)[F.lane + 64 * j]; }
#pragma unroll
        for (int which = 0; which < 2; ++which) { if (which == 1 && !two) break;
            const int r = which ? r1 : r0; const int mrow = (r < NLAT) ? (r >> 12) : 16;
            const float* sh = ((float*)(F.ws + WS_MOD)) + (size_t)mrow * 6144; const float* sc = sh + 1024;
            float s = 0.f;
#pragma unroll
            for (int j = 0; j < 4; ++j) { const f32x4 v = which ? vb[j] : va[j]; s += (v.x * v.x + v.y * v.y) + (v.z * v.z + v.w * v.w); }
            const float rstd = 1.0f / sqrtf(wave_sum(s) * (1.f / D) + EPS);
            unsigned long long* o8 = (unsigned long long*)(((bf16*)(F.ws + WS_HN)) + (size_t)r * D) + F.lane;
#pragma unroll
            for (int j = 0; j < 4; ++j) { const int c4 = F.lane + 64 * j; const f32x4 v = which ? vb[j] : va[j]; const f32x4 w = ((const f32x4*)A->in[6])[c4], a = ((const f32x4*)sc)[c4], b = ((const f32x4*)sh)[c4];
                const f32x4 y = (v * rstd) * w * (a + 1.0f) + b;
                o8[64 * j] = (unsigned long long)pk2(y.x, y.y) | ((unsigned long long)pk2(y.z, y.w) << 32); } }
    }
}

constexpr int GL_ZL = 0;
constexpr int GL_BC = 8192;
constexpr int GL_TOT = GL_BC + 32768;
constexpr int GL_V = GL_TOT + 512;
constexpr int GL_A = GL_V + 64 * 136 * 2;
constexpr int GL_B = GL_A + 2 * 64 * 72 * 2;
constexpr int GL_P = GL_B + 2 * 64 * 72 * 2;
constexpr int GL_SS = GL_P + 64 * 72 * 2;
constexpr int GL_SEG = GL_SS + 512;
constexpr int GL_END = GL_SEG + 2048;
static_assert(GL_END <= RING_BYTES && (GL_V % 16) == 0 && (GL_A % 16) == 0 && (GL_B % 16) == 0 && (GL_P % 16) == 0, "GLA LDS map");

__device__ __forceinline__ s16x4 tr_read(unsigned lds_addr) { s16x4 r; asm volatile("ds_read_b64_tr_b16 %0, %1\n\ts_waitcnt lgkmcnt(0)" : "=&v"(r) : "v"(lds_addr) : "memory"); return r; }
__device__ __forceinline__ void v_frag2(LAS unsigned char* lds, int v0, int lane, bf16x8& f0, bf16x8& f1) {
    const int i = lane & 15, g = lane >> 4;
    const unsigned a0 = (unsigned)(uintptr_t)(lds + GL_V) + (unsigned)(((8 * g + (i >> 2)) * 136 + v0 + 4 * (i & 3)) * 2);
    s16x4 r0, r1, r2, r3;
    asm volatile("ds_read_b64_tr_b16 %0, %4\n\tds_read_b64_tr_b16 %1, %4 offset:1088\n\tds_read_b64_tr_b16 %2, %4 offset:8704\n\tds_read_b64_tr_b16 %3, %4 offset:9792\n\ts_waitcnt lgkmcnt(0)"
                 : "=&v"(r0), "=&v"(r1), "=&v"(r2), "=&v"(r3) : "v"(a0) : "memory");
    f0[0] = r0[0]; f0[1] = r0[1]; f0[2] = r0[2]; f0[3] = r0[3]; f0[4] = r1[0]; f0[5] = r1[1]; f0[6] = r1[2]; f0[7] = r1[3];
    f1[0] = r2[0]; f1[1] = r2[1]; f1[2] = r2[2]; f1[3] = r2[3]; f1[4] = r3[0]; f1[5] = r3[1]; f1[6] = r3[2]; f1[7] = r3[3];
}
__device__ __forceinline__ bf16x8 v_frag(LAS unsigned char* lds, int ks, int v0, int lane) {
    const int i = lane & 15, g = lane >> 4;
    const unsigned a0 = (unsigned)(uintptr_t)(lds + GL_V) + (unsigned)(((32 * ks + 8 * g + (i >> 2)) * 136 + v0 + 4 * (i & 3)) * 2);
    const s16x4 lo = tr_read(a0), hi = tr_read(a0 + 4 * 136 * 2);
    bf16x8 r; r[0] = lo[0]; r[1] = lo[1]; r[2] = lo[2]; r[3] = lo[3]; r[4] = hi[0]; r[5] = hi[1]; r[6] = hi[2]; r[7] = hi[3]; return r;
}
struct GlaRegs { v4u zw, vw[2]; };
__device__ __forceinline__ GlaRegs gla_load(const Frame& F, size_t prow, int h) {
    GlaRegs r; const int tid = F.tid; const bf16* P = (const bf16*)(F.ws + WS_P);
    { const int t = (tid & 255) >> 2, q = tid & 3; r.zw = *(const v4u*)(P + (prow + t) * PW + CAF + 8 * q); }
#pragma unroll
    for (int i = 0; i < 2; ++i) { const int pc = tid + i * NTHREADS, t = pc >> 4, c = pc & 15; r.vw[i] = *(const v4u*)(P + (prow + t) * PW + CV + h * 128 + c * 8); }
    return r;
}
__device__ __forceinline__ void gla_prep(const Frame& F, CArgs* A, const GlaRegs& R, int h) {
    LAS unsigned char* lds = F.lds; const int tid = F.tid;
    if (tid < 256) { const int t = tid >> 2, q = tid & 3; const v4u w = R.zw;
        LAS float* z = (LAS float*)(lds + GL_ZL) + (q >> 1) * 1024 + t * 16 + (q & 1) * 8;
        *(LAS f32x4*)z = (f32x4){bflo(w.x), bfhi(w.x), bflo(w.y), bfhi(w.y)}; *(LAS f32x4*)(z + 4) = (f32x4){bflo(w.z), bfhi(w.z), bflo(w.w), bfhi(w.w)}; }
#pragma unroll
    for (int i = 0; i < 2; ++i) { const int pc = tid + i * NTHREADS, t = pc >> 4, c = pc & 15; *(LAS v4u*)(lds + GL_V + (t * 136 + c * 8) * 2) = R.vw[i]; }
    __syncthreads();
    { const int dir = tid >> 8, seg = (tid >> 6) & 3, d = tid & 63;
      const float* up = dir ? A->in[10] : A->in[8]; const float bias = (dir ? A->in[11] : A->in[9])[h * 64 + d];
      float u[16];
#pragma unroll
      for (int r = 0; r < 16; ++r) u[r] = up[r * 256 + h * 64 + d];
      const LAS float* zl = (const LAS float*)(lds + GL_ZL) + dir * 1024; LAS float* bc = (LAS float*)(lds + GL_BC) + dir * 4096 + d;
      LAS float* sg = (LAS float*)(lds + GL_SEG) + dir * 256 + d;
      float c[16]; float cum = 0.f;
#pragma unroll
      for (int i = 0; i < 16; ++i) { const int t = seg * 16 + (dir ? 15 - i : i); const LAS float* zp = zl + t * 16;
          const f32x4 z0 = *(const LAS f32x4*)zp, z1 = *(const LAS f32x4*)(zp + 4), z2 = *(const LAS f32x4*)(zp + 8), z3 = *(const LAS f32x4*)(zp + 12);
          float z = bias + z0[0] * u[0] + z0[1] * u[1] + z0[2] * u[2] + z0[3] * u[3] + z1[0] * u[4] + z1[1] * u[5] + z1[2] * u[6] + z1[3] * u[7]
                         + z2[0] * u[8] + z2[1] * u[9] + z2[2] * u[10] + z2[3] * u[11] + z3[0] * u[12] + z3[1] * u[13] + z3[2] * u[14] + z3[3] * u[15];
          const float ls = fminf(z, 0.f) - __logf(1.0f + __expf(-fabsf(z)));
          cum += ls * (1.0f / 16.0f); c[i] = cum; }
      sg[seg * 64] = cum;
      __syncthreads();
      float off = 0.f, tot = 0.f;
#pragma unroll
      for (int s2 = 0; s2 < 4; ++s2) { const float v = sg[s2 * 64]; tot += v; off += (dir ? (s2 > seg) : (s2 < seg)) ? v : 0.f; }
#pragma unroll
      for (int i = 0; i < 16; ++i) { const int t = seg * 16 + (dir ? 15 - i : i); bc[t * 64] = off + c[i]; }
      if (seg == 0) ((LAS float*)(lds + GL_TOT))[dir * 64 + d] = tot; }
    __syncthreads();
}

__device__ __forceinline__ size_t chunk_row(int b, int cc) { return cc < 4 ? (size_t)NLAT + b * CTXL + cc * 64 : (size_t)b * SEQ + (cc - 4) * 64; }
__device__ __forceinline__ void p3_phase(const Frame& F, CArgs* A) {
    LAS unsigned char* lds = F.lds; const int tid = F.tid, lane = F.lane, wave = F.wave;
    GlaRegs cur; if (F.bid < NBATCH * NCC * 4) { const int bc0 = F.bid >> 2; cur = gla_load(F, chunk_row(bc0 / NCC, bc0 % NCC), F.bid & 3); }
    for (int it = F.bid; it < NBATCH * NCC * 4; it += F.G) {
        const int h = it & 3, bc = it >> 2, b = bc / NCC, cc = bc % NCC; const size_t prow = chunk_row(b, cc);
        GlaRegs nxt = cur; { const int itn = it + F.G; if (itn < NBATCH * NCC * 4) { const int bcn = itn >> 2; nxt = gla_load(F, chunk_row(bcn / NCC, bcn % NCC), itn & 3); } }
        float kf[8];
        { const int d = tid & 63, tg = tid >> 6;
#pragma unroll
          for (int j = 0; j < 8; ++j) kf[j] = bf2f(((bf16*)(F.ws + WS_P))[(prow + tg * 8 + j) * PW + CK + h * 64 + d]); }
        gla_prep(F, A, cur, h); cur = nxt;
        if (tid < 128) { const int dir = tid >> 6, d = tid & 63; ((float*)(F.ws + WS_DECAY))[(((size_t)dir * NBATCH + b) * NCC + cc) * 256 + h * 64 + d] = __expf(((const LAS float*)(lds + GL_TOT))[dir * 64 + d]); }
        { const int d = tid & 63, tg = tid >> 6;
#pragma unroll
          for (int dir = 0; dir < 2; ++dir) { const float tot = ((const LAS float*)(lds + GL_TOT))[dir * 64 + d]; const LAS float* bcp = (const LAS float*)(lds + GL_BC) + dir * 4096 + (tg * 8) * 64 + d; float s[8];
#pragma unroll
              for (int j = 0; j < 8; ++j) s[j] = kf[j] * __expf(tot - bcp[j * 64]);
              v4u w; w.x = pk2(s[0], s[1]); w.y = pk2(s[2], s[3]); w.z = pk2(s[4], s[5]); w.w = pk2(s[6], s[7]);
              *(LAS v4u*)(lds + GL_A + ((dir * 64 + d) * 72 + tg * 8) * 2) = w; } }
        __syncthreads();
        { const int dir = wave & 1, dt = wave >> 1, i = lane & 15, g = lane >> 4;
          bf16x8 af[2];
#pragma unroll
          for (int ks = 0; ks < 2; ++ks) af[ks] = *(const LAS bf16x8*)(lds + GL_A + ((dir * 64 + dt * 16 + i) * 72 + 32 * ks + 8 * g) * 2);
          bf16* kvp = ((bf16*)(F.ws + WS_KV)) + ((((size_t)dir * NBATCH + b) * NCC + cc) * 4 + h) * 8192;
#pragma unroll 2
          for (int vt = 0; vt < 8; ++vt) { f32x4 acc = {0.f, 0.f, 0.f, 0.f}; bf16x8 vf0, vf1; v_frag2(lds, vt * 16, lane, vf0, vf1);
              acc = __builtin_amdgcn_mfma_f32_16x16x32_bf16(af[0], vf0, acc, 0, 0, 0); acc = __builtin_amdgcn_mfma_f32_16x16x32_bf16(af[1], vf1, acc, 0, 0, 0);
              v2u w; w.x = pk2(acc[0], acc[1]); w.y = pk2(acc[2], acc[3]);
              *(v2u*)(kvp + (size_t)(vt * 16 + i) * 64 + dt * 16 + 4 * g) = w; } }
        __syncthreads();
    }
}

constexpr int G2_ZL = 0;
constexpr int G2_HT = 8192;
constexpr int G2_TOT = G2_HT + 4096;
constexpr int G2_A = G2_TOT + 1024;
constexpr int G2_B = G2_A + 256 * 72 * 2;
constexpr int G2_VS = 528;
static_assert(G2_B + 64 * G2_VS * 2 <= RING_BYTES && G2_B + 256 * 72 * 2 <= RING_BYTES && (G2_A % 16) == 0 && (G2_B % 16) == 0, "GLA v2 LDS map");
__device__ __forceinline__ void tr_frag2(unsigned tile_addr, int c0, int lane, bf16x8& f0, bf16x8& f1) {
    const int i = lane & 15, g = lane >> 4;
    const unsigned a0 = tile_addr + (unsigned)(((8 * g + (i >> 2)) * G2_VS + c0 + 4 * (i & 3)) * 2);
    s16x4 r0, r1, r2, r3;
    asm volatile("ds_read_b64_tr_b16 %0, %4\n\tds_read_b64_tr_b16 %1, %4 offset:4224\n\tds_read_b64_tr_b16 %2, %4 offset:33792\n\tds_read_b64_tr_b16 %3, %4 offset:38016\n\ts_waitcnt lgkmcnt(0)"
                 : "=&v"(r0), "=&v"(r1), "=&v"(r2), "=&v"(r3) : "v"(a0) : "memory");
    f0[0] = r0[0]; f0[1] = r0[1]; f0[2] = r0[2]; f0[3] = r0[3]; f0[4] = r1[0]; f0[5] = r1[1]; f0[6] = r1[2]; f0[7] = r1[3];
    f1[0] = r2[0]; f1[1] = r2[1]; f1[2] = r2[2]; f1[3] = r2[3]; f1[4] = r3[0]; f1[5] = r3[1]; f1[6] = r3[2]; f1[7] = r3[3];
}
static_assert(4 * G2_VS * 2 == 4224 && 32 * G2_VS * 2 == 33792 && 36 * G2_VS * 2 == 38016, "tr_frag2 offsets");
__device__ __forceinline__ float log_sigmoid16(float z) { return (fminf(z, 0.f) - __logf(1.0f + __expf(-fabsf(z)))) * (1.0f / 16.0f); }

__device__ __forceinline__ void p3v2_phase(const Frame& F, CArgs* A) {
    LAS unsigned char* lds = F.lds; const int tid = F.tid, lane = F.lane, wave = F.wave, i = lane & 15, g = lane >> 4;
    const int c = tid & 255, th = tid >> 8;
    const bf16* P = (const bf16*)(F.ws + WS_P);
#pragma unroll 1
    for (int it = F.bid; it < NBATCH * NCC; it += F.G) {
        const int b = it / NCC, cc = it % NCC; const size_t prow = chunk_row(b, cc);
        if (tid < 256) { const int t = tid >> 2, q = tid & 3; const v4u w = *(const v4u*)(P + (prow + t) * PW + CAF + 8 * q);
            LAS float* z = (LAS float*)(lds + G2_ZL) + (q >> 1) * 1024 + t * 16 + (q & 1) * 8;
            *(LAS f32x4*)z = (f32x4){bflo(w.x), bfhi(w.x), bflo(w.y), bfhi(w.y)}; *(LAS f32x4*)(z + 4) = (f32x4){bflo(w.z), bfhi(w.z), bflo(w.w), bfhi(w.w)}; }
#pragma unroll
        for (int j = 0; j < 8; ++j) { const int pc = tid + j * NTHREADS, t = pc >> 6, cv = pc & 63;
            *(LAS v4u*)(lds + G2_B + (t * G2_VS + cv * 8) * 2) = *(const v4u*)(P + (prow + t) * PW + CV + cv * 8); }
        float kk[32];
#pragma unroll
        for (int tl = 0; tl < 32; ++tl) kk[tl] = bf2f(P[(prow + th * 32 + tl) * PW + CK + c]);
        __syncthreads();
#pragma unroll
        for (int dir = 0; dir < 2; ++dir) {
            { const float* up = dir ? A->in[10] : A->in[8]; const float bias = (dir ? A->in[11] : A->in[9])[c];
              float u[16];
#pragma unroll
              for (int r = 0; r < 16; ++r) u[r] = up[r * 256 + c];
              const LAS float* zl = (const LAS float*)(lds + G2_ZL) + dir * 1024 + th * 512;
              float cl[32]; float cum = 0.f;
#pragma unroll
              for (int ii = 0; ii < 32; ++ii) { const int tl = dir ? 31 - ii : ii; const LAS float* zp = zl + tl * 16;
                  const f32x4 z0 = *(const LAS f32x4*)zp, z1 = *(const LAS f32x4*)(zp + 4), z2 = *(const LAS f32x4*)(zp + 8), z3 = *(const LAS f32x4*)(zp + 12);
                  const float z = bias + z0[0] * u[0] + z0[1] * u[1] + z0[2] * u[2] + z0[3] * u[3] + z1[0] * u[4] + z1[1] * u[5] + z1[2] * u[6] + z1[3] * u[7]
                                       + z2[0] * u[8] + z2[1] * u[9] + z2[2] * u[10] + z2[3] * u[11] + z3[0] * u[12] + z3[1] * u[13] + z3[2] * u[14] + z3[3] * u[15];
                  cum += log_sigmoid16(z); cl[tl] = cum; }
              LAS float* ht = (LAS float*)(lds + G2_HT) + dir * 512;
              ht[th * 256 + c] = cum;
              __syncthreads();
              const float other = ht[(1 - th) * 256 + c], tot = cum + other;
              const float off = (dir == 0) ? (th ? other : 0.f) : (th ? 0.f : other);
              if (th == 0) { ((LAS float*)(lds + G2_TOT))[c] = tot; ((float*)(F.ws + WS_DECAY))[(((size_t)dir * NBATCH + b) * NCC + cc) * 256 + c] = __expf(tot); }
#pragma unroll
              for (int j = 0; j < 4; ++j) { float e[8];
#pragma unroll
                  for (int q = 0; q < 8; ++q) e[q] = kk[8 * j + q] * __expf(-(off + cl[8 * j + q]));
                  v4u w; w.x = pk2(e[0], e[1]); w.y = pk2(e[2], e[3]); w.z = pk2(e[4], e[5]); w.w = pk2(e[6], e[7]);
                  *(LAS v4u*)(lds + G2_A + (c * 72 + th * 32 + 8 * j) * 2) = w; } }
            __syncthreads();
            { const int h = wave >> 1, vh = wave & 1;
              bf16x8 af[4][2];
#pragma unroll
              for (int dt = 0; dt < 4; ++dt)
#pragma unroll
                  for (int ks = 0; ks < 2; ++ks) af[dt][ks] = *(const LAS bf16x8*)(lds + G2_A + ((h * 64 + dt * 16 + i) * 72 + 32 * ks + 8 * g) * 2);
              f32x4 et[4];
#pragma unroll
              for (int dt = 0; dt < 4; ++dt) { const f32x4 tv = *(const LAS f32x4*)(lds + G2_TOT + (h * 64 + dt * 16 + 4 * g) * 4); et[dt] = (f32x4){__expf(tv[0]), __expf(tv[1]), __expf(tv[2]), __expf(tv[3])}; }
              bf16* kvp = ((bf16*)(F.ws + WS_KV)) + ((((size_t)dir * NBATCH + b) * NCC + cc) * 4 + h) * 8192;
              bf16* vtp = ((bf16*)(F.ws + WS_VT)) + (((size_t)b * 64 + (cc - 4)) * 4 + h) * 8192;
#pragma unroll
              for (int vt = 0; vt < 4; ++vt) { const int v0 = vh * 64 + vt * 16; bf16x8 vf0, vf1; tr_frag2((unsigned)(uintptr_t)(lds + G2_B), h * 128 + v0, lane, vf0, vf1);
                  if (dir == 0 && cc >= 4) { *(bf16x8*)(vtp + (size_t)(v0 + i) * 64 + 8 * g) = vf0; *(bf16x8*)(vtp + (size_t)(v0 + i) * 64 + 32 + 8 * g) = vf1; }
#pragma unroll
                  for (int dt = 0; dt < 4; ++dt) { f32x4 acc = {0.f, 0.f, 0.f, 0.f};
                      acc = __builtin_amdgcn_mfma_f32_16x16x32_bf16(af[dt][0], vf0, acc, 0, 0, 0); acc = __builtin_amdgcn_mfma_f32_16x16x32_bf16(af[dt][1], vf1, acc, 0, 0, 0);
                      acc = acc * et[dt];
                      v2u w; w.x = pk2(acc[0], acc[1]); w.y = pk2(acc[2], acc[3]);
                      *(v2u*)(kvp + (size_t)(v0 + i) * 64 + dt * 16 + 4 * g) = w; } } }
            __syncthreads();
        }
    }
}

struct GateConst { bf16x8 bw[2][2]; float bias[2][2]; };
__device__ __forceinline__ GateConst gate_setup(CArgs* A, int wave, int lane) {
    GateConst G; const int i = lane & 15, g = lane >> 4;
#pragma unroll
    for (int dir = 0; dir < 2; ++dir)
#pragma unroll
        for (int cti = 0; cti < 2; ++cti) { const int c = 32 * wave + 16 * cti + i; const float* up = dir ? A->in[10] : A->in[8];
            G.bias[dir][cti] = (dir ? A->in[11] : A->in[9])[c];
#pragma unroll
            for (int jj = 0; jj < 8; ++jj) { const float v = up[(8 * (g & 1) + jj) * 256 + c]; const unsigned hi = f2bf(v); const float rem = v - __builtin_bit_cast(float, hi << 16);
                G.bw[dir][cti][jj] = (short)((g < 2) ? hi : f2bf(rem)); } }
    return G;
}
__device__ __forceinline__ float log_sigmoid16_fast(float z) { const float e = __builtin_amdgcn_exp2f(fabsf(z) * -1.4426950409f); return (fminf(z, 0.f) - __builtin_amdgcn_logf(1.0f + e) * 0.6931471806f) * 0.0625f; }
__device__ __forceinline__ void gate_b(const GateConst& G, const bf16* P, size_t prow, int lane, f32x4 (&bv)[2][2][4], float (&tot)[2][2]) {
    const int i = lane & 15, g = lane >> 4;
    bf16x8 za[2][4];
#pragma unroll
    for (int dir = 0; dir < 2; ++dir)
#pragma unroll
        for (int tt = 0; tt < 4; ++tt) za[dir][tt] = *(const bf16x8*)(P + (prow + 16 * tt + i) * PW + CAF + 16 * dir + 8 * (g & 1));
#pragma unroll
    for (int dir = 0; dir < 2; ++dir)
#pragma unroll
        for (int cti = 0; cti < 2; ++cti) { float carry = 0.f;
#pragma unroll
            for (int q = 0; q < 4; ++q) { const int tt = dir ? 3 - q : q;
                f32x4 z = {0.f, 0.f, 0.f, 0.f}; z = __builtin_amdgcn_mfma_f32_16x16x32_bf16(za[dir][tt], G.bw[dir][cti], z, 0, 0, 0);
                float la[4];
#pragma unroll
                for (int r = 0; r < 4; ++r) la[r] = log_sigmoid16_fast(z[r] + G.bias[dir][cti]);
                float p[4];
                if (dir == 0) { p[0] = la[0]; p[1] = p[0] + la[1]; p[2] = p[1] + la[2]; p[3] = p[2] + la[3];
                    const float s = p[3]; float incl = s; const float t1 = __shfl_up(incl, 16); if (g >= 1) incl += t1; const float t2 = __shfl_up(incl, 32); if (g >= 2) incl += t2;
                    const float base = carry + (incl - s); carry += __shfl(incl, 48 + i);
                    bv[dir][cti][tt] = (f32x4){base + p[0], base + p[1], base + p[2], base + p[3]}; }
                else { p[3] = la[3]; p[2] = p[3] + la[2]; p[1] = p[2] + la[1]; p[0] = p[1] + la[0];
                    const float s = p[0]; float incl = s; const float t1 = __shfl_down(incl, 16); if (g <= 2) incl += t1; const float t2 = __shfl_down(incl, 32); if (g <= 1) incl += t2;
                    const float base = carry + (incl - s); carry += __shfl(incl, i);
                    bv[dir][cti][tt] = (f32x4){base + p[0], base + p[1], base + p[2], base + p[3]}; } }
            tot[dir][cti] = carry; }
}

constexpr int G3_ST = 0;
constexpr int G3_TOT = 8 * 16 * 144;
constexpr int G3_A = G3_TOT + 1024;
constexpr int G3_B = G3_A + 256 * 72 * 2;
static_assert(G3_B + 64 * G2_VS * 2 <= RING_BYTES && (G3_A % 16) == 0 && (G3_B % 16) == 0, "P3 LDS map");
template <int MODE>
__device__ __forceinline__ void p3v3_phase(const Frame& F, CArgs* A) {
    int tid_ = F.tid; asm volatile("" : "+v"(tid_));
    LAS unsigned char* lds = F.lds; const int tid = tid_, lane = tid & 63, wave = __builtin_amdgcn_readfirstlane(tid >> 6), i = lane & 15, g = lane >> 4;
    const bf16* P = (const bf16*)(F.ws + WS_P);
    const GateConst G = gate_setup(A, wave, lane);
    LAS unsigned char* st = lds + G3_ST + wave * (16 * 144);
#pragma unroll 1
    for (int it = F.bid; it < NBATCH * NCC; it += F.G) {
        const int b = it / NCC, cc = it % NCC; const size_t prow = chunk_row(b, cc);
        unsigned pf0 = 0u, pf1 = 0u;
#pragma unroll
        for (int j = 0; j < 8; ++j) { const int pc = tid + j * NTHREADS, t = pc >> 6, cv = pc & 63;
            *(LAS v4u*)(lds + G3_B + (t * G2_VS + cv * 8) * 2) = *(const v4u*)(P + (prow + t) * PW + CV + cv * 8); }
        unsigned kk[2][4][2];
#pragma unroll
        for (int cti = 0; cti < 2; ++cti)
#pragma unroll
            for (int tt = 0; tt < 4; ++tt)
#pragma unroll
                for (int r = 0; r < 4; r += 2) { const bf16* kp = P + (prow + 16 * tt + 4 * g + r) * PW + CK + 32 * wave + 16 * cti + i; kk[cti][tt][r >> 1] = (unsigned)kp[0] | ((unsigned)kp[PW] << 16); }
        f32x4 bv[2][2][4]; float tot[2][2];
        if (MODE < 4) gate_b(G, P, prow, lane, bv, tot); else {
#pragma unroll
            for (int a_ = 0; a_ < 2; ++a_)
#pragma unroll
                for (int b_ = 0; b_ < 2; ++b_) { tot[a_][b_] = 0.f;
#pragma unroll
                    for (int c_ = 0; c_ < 4; ++c_) bv[a_][b_][c_] = (f32x4){0.f, 0.f, 0.f, 0.f}; } }
#pragma unroll
        for (int dir = 0; dir < 2; ++dir) {
#pragma unroll
            for (int cti = 0; cti < 2; ++cti) { const int c = 32 * wave + 16 * cti + i;
#pragma unroll
                for (int tt = 0; tt < 4; ++tt) { float e[4];
#pragma unroll
                    for (int r = 0; r < 4; ++r) e[r] = ((r & 1) ? bfhi(kk[cti][tt][r >> 1]) : bflo(kk[cti][tt][r >> 1])) * __builtin_amdgcn_exp2f(bv[dir][cti][tt][r] * -1.4426950409f);
                    v2u w; w.x = pk2(e[0], e[1]); w.y = pk2(e[2], e[3]);
                    *(LAS v2u*)(lds + G3_A + (c * 72 + 16 * tt + 4 * g) * 2) = w; }
                if (g == 0) { ((LAS float*)(lds + G3_TOT))[c] = tot[dir][cti]; if (!MODE) ((float*)(F.ws + WS_DECAY))[(((size_t)dir * NBATCH + b) * NCC + cc) * 256 + c] = __expf(tot[dir][cti]); } }
            LDS_BARRIER();
            if (dir == 0) {
                const int itn = it + F.G; if (itn < NBATCH * NCC) { const char* pr = (const char*)(P + (chunk_row(itn / NCC, itn % NCC) + (tid >> 3)) * PW); const int j = tid & 7;
                    pf0 = *(const unsigned*)(pr + 512 + 128 * j); pf1 = *(const unsigned*)(pr + (j < 5 ? 512 + 128 * (8 + j) : 3072 + 32 * (j - 5))); } }
            if (MODE < 3) { const int h = wave >> 1, vh = wave & 1;
              bf16x8 af[4][2];
#pragma unroll
              for (int dt = 0; dt < 4; ++dt)
#pragma unroll
                  for (int ks = 0; ks < 2; ++ks) af[dt][ks] = *(const LAS bf16x8*)(lds + G3_A + ((h * 64 + dt * 16 + i) * 72 + 32 * ks + 8 * g) * 2);
              bf16* kvp = ((bf16*)(F.ws + WS_KV)) + ((((size_t)dir * NBATCH + b) * NCC + cc) * 4 + h) * 8192;
              bf16* vtp = ((bf16*)(F.ws + WS_VT)) + (((size_t)b * 64 + (cc - 4)) * 4 + h) * 8192;
              if (MODE) { kvp = ((bf16*)(F.ws + WS_TOTAL)) + (size_t)(F.bid * 8 + wave) * 512; vtp = kvp + 1024 * 1024; }
#pragma unroll
              for (int vt = 0; vt < 4; ++vt) { const int v0 = vh * 64 + vt * 16; bf16x8 vf0, vf1; tr_frag2((unsigned)(uintptr_t)(lds + G3_B), h * 128 + v0, lane, vf0, vf1);
                  if (dir == 0 && cc >= 4) {
                      *(LAS bf16x8*)(st + i * 144 + 16 * g) = vf0; *(LAS bf16x8*)(st + i * 144 + 64 + 16 * g) = vf1;
                      LDS_WAIT();
#pragma unroll
                      for (int j = 0; j < 2; ++j) { const int pc = lane + 64 * j, row = pc >> 3, ch = pc & 7; const v4u x_ = *(const LAS v4u*)(st + row * 144 + ch * 16); if (MODE == 2) asm volatile("" :: "v"(x_)); else *(v4u*)(vtp + (size_t)((MODE ? 0 : v0) + row) * 64 + ch * 8) = x_; }
                      LDS_WAIT(); }
#pragma unroll
                  for (int dt = 0; dt < 4; ++dt) { f32x4 acc = {0.f, 0.f, 0.f, 0.f};
                      acc = __builtin_amdgcn_mfma_f32_16x16x32_bf16(af[dt][0], vf0, acc, 0, 0, 0); acc = __builtin_amdgcn_mfma_f32_16x16x32_bf16(af[dt][1], vf1, acc, 0, 0, 0);
                      { const f32x4 tv = *(const LAS f32x4*)(lds + G3_TOT + (h * 64 + dt * 16 + 4 * g) * 4);
                        acc = acc * (f32x4){__builtin_amdgcn_exp2f(tv[0] * 1.4426950409f), __builtin_amdgcn_exp2f(tv[1] * 1.4426950409f), __builtin_amdgcn_exp2f(tv[2] * 1.4426950409f), __builtin_amdgcn_exp2f(tv[3] * 1.4426950409f)}; }
                      v2u w; w.x = pk2(acc[0], acc[1]); w.y = pk2(acc[2], acc[3]);
                      *(LAS v2u*)(st + i * 144 + (16 * dt + 4 * g) * 2) = w; }
                  LDS_WAIT();
#pragma unroll
                  for (int j = 0; j < 2; ++j) { const int pc = lane + 64 * j, row = pc >> 3, ch = pc & 7; const v4u x_ = *(const LAS v4u*)(st + row * 144 + ch * 16); if (MODE == 2) asm volatile("" :: "v"(x_)); else *(v4u*)(kvp + (size_t)((MODE ? 0 : v0) + row) * 64 + ch * 8) = x_; }
                  LDS_WAIT(); } }
            LDS_BARRIER();
        }
        asm volatile("" :: "v"(pf0), "v"(pf1));
    }
}

struct ConvRegs { v4u cw[6], xw[6], bw[4]; };
__device__ __forceinline__ void conv_load(const bf16* P, int u, int t, ConvRegs& R) {
    const int item = u >> 1, b = item >> 6, n = item & 63; const size_t prow = (size_t)b * SEQ + n * 64; const int t0 = (u & 1) * 32 + (t >> 6) * 4, c0 = (t & 63) * 8;
#pragma unroll
    for (int q = 0; q < 6; ++q) { const int tt = t0 - 1 + q, tc = tt < 0 ? 0 : (tt > 63 ? 63 : tt);
        R.cw[q] = *(const v4u*)(P + (prow + tc) * PW + CPC + c0); R.xw[q] = *(const v4u*)(P + (prow + tc) * PW + CPX + c0); }
#pragma unroll
    for (int q = 0; q < 4; ++q) R.bw[q] = *(const v4u*)(P + (prow + t0 + q) * PW + CPB + c0);
}
__device__ __forceinline__ void conv_pin(ConvRegs& R) {
    asm volatile("" ::: "memory");
#pragma unroll
    for (int q = 0; q < 6; ++q) { asm volatile("" : "+v"(R.cw[q])); asm volatile("" : "+v"(R.xw[q])); }
#pragma unroll
    for (int q = 0; q < 4; ++q) asm volatile("" : "+v"(R.bw[q]));
}
__device__ __forceinline__ void conv_emit(unsigned char* ws, const f32x2 (&w2)[3][4], int u, int t, const ConvRegs& R) {
    const int item = u >> 1, b = item >> 6, n = item & 63; const size_t prow = (size_t)b * SEQ + n * 64; const int t0 = (u & 1) * 32 + (t >> 6) * 4, c0 = (t & 63) * 8;
    f32x2 ov[4][4];
#pragma unroll
    for (int j = 0; j < 4; ++j)
#pragma unroll
        for (int p = 0; p < 4; ++p) ov[j][p] = (f32x2){0.f, 0.f};
#pragma unroll
    for (int q = 0; q < 6; ++q) { const int tt = t0 - 1 + q; const bool in = tt >= 0 && tt < 64; v4u c_ = R.cw[q]; const v4u x_ = R.xw[q]; f32x2 uu[4];
        c_.x = in ? c_.x : 0u; c_.y = in ? c_.y : 0u; c_.z = in ? c_.z : 0u; c_.w = in ? c_.w : 0u;
        uu[0] = (f32x2){bflo(c_.x), bfhi(c_.x)} * (f32x2){bflo(x_.x), bfhi(x_.x)}; uu[1] = (f32x2){bflo(c_.y), bfhi(c_.y)} * (f32x2){bflo(x_.y), bfhi(x_.y)};
        uu[2] = (f32x2){bflo(c_.z), bfhi(c_.z)} * (f32x2){bflo(x_.z), bfhi(x_.z)}; uu[3] = (f32x2){bflo(c_.w), bfhi(c_.w)} * (f32x2){bflo(x_.w), bfhi(x_.w)};
#pragma unroll
        for (int dt = 0; dt < 3; ++dt) { const int j = q - dt;
            if (j >= 0 && j < 4) {
#pragma unroll
                for (int p = 0; p < 4; ++p) ov[j][p] += w2[dt][p] * uu[p]; } } }
#pragma unroll
    for (int q = 0; q < 4; ++q) { const v4u b_ = R.bw[q];
        const f32x2 y0 = ov[q][0] * (f32x2){bflo(b_.x), bfhi(b_.x)}, y1 = ov[q][1] * (f32x2){bflo(b_.y), bfhi(b_.y)}, y2 = ov[q][2] * (f32x2){bflo(b_.z), bfhi(b_.z)}, y3 = ov[q][3] * (f32x2){bflo(b_.w), bfhi(b_.w)};
        if (OUTPROJ_F8) { v2u w; w.x = pk4_fp8(y0.x, y0.y, y1.x, y1.y); w.y = pk4_fp8(y2.x, y2.y, y3.x, y3.y);
            *(v2u*)(ws + WS_YMIX + (prow + t0 + q) * D + 512 + c0) = w; }
        else { v4u w; w.x = pk2(y0.x, y0.y); w.y = pk2(y1.x, y1.y); w.z = pk2(y2.x, y2.y); w.w = pk2(y3.x, y3.y);
            *(v4u*)(((bf16*)(ws + WS_YMIX)) + (prow + t0 + q) * D + 512 + c0) = w; } }
}
__device__ __forceinline__ void conv_stream(const Frame& F, CArgs* A, int t) {
    const bf16* P = (const bf16*)(F.ws + WS_P);
    constexpr int NU = NBATCH * 64 * 2;
    f32x2 w2[3][4];
    { const int c0 = (t & 63) * 8;
#pragma unroll
      for (int dt = 0; dt < 3; ++dt) { const f32x4 a = *(const f32x4*)(A->in[13] + dt * 512 + c0), b = *(const f32x4*)(A->in[13] + dt * 512 + c0 + 4);
          w2[dt][0] = (f32x2){a[0], a[1]}; w2[dt][1] = (f32x2){a[2], a[3]}; w2[dt][2] = (f32x2){b[0], b[1]}; w2[dt][3] = (f32x2){b[2], b[3]}; } }
    ConvRegs Ra, Rb;
    int u = F.bid;
    if (u < NU) conv_load(P, u, t, Ra);
#pragma unroll 1
    for (; u < NU; u += 2 * F.G) {
        const int un = (u + F.G < NU) ? u + F.G : u, un2 = (u + 2 * F.G < NU) ? u + 2 * F.G : u;
        conv_load(P, un, t, Rb); conv_pin(Ra);
        conv_emit(F.ws, w2, u, t, Ra);
        conv_load(P, un2, t, Ra); conv_pin(Rb);
        conv_emit(F.ws, w2, un, t, Rb);
    }
}

__device__ __forceinline__ void gate_b_dir(const GateConst& G, const bf16* P, size_t prow, int lane, int dir, f32x4 (&bv)[2][4]) {
    const int i = lane & 15, g = lane >> 4;
    bf16x8 za[4];
#pragma unroll
    for (int tt = 0; tt < 4; ++tt) za[tt] = *(const bf16x8*)(P + (prow + 16 * tt + i) * PW + CAF + 16 * dir + 8 * (g & 1));
#pragma unroll
    for (int cti = 0; cti < 2; ++cti) { float carry = 0.f;
#pragma unroll
        for (int q = 0; q < 4; ++q) { const int tt = dir ? 3 - q : q;
            f32x4 z = {0.f, 0.f, 0.f, 0.f}; z = __builtin_amdgcn_mfma_f32_16x16x32_bf16(za[tt], G.bw[dir][cti], z, 0, 0, 0);
            float la[4];
#pragma unroll
            for (int r = 0; r < 4; ++r) la[r] = log_sigmoid16_fast(z[r] + G.bias[dir][cti]);
            float p[4];
            if (dir == 0) { p[0] = la[0]; p[1] = p[0] + la[1]; p[2] = p[1] + la[2]; p[3] = p[2] + la[3];
                const float s = p[3]; float incl = s; const float t1 = __shfl_up(incl, 16); if (g >= 1) incl += t1; const float t2 = __shfl_up(incl, 32); if (g >= 2) incl += t2;
                const float base = carry + (incl - s); carry += __shfl(incl, 48 + i);
                bv[cti][tt] = (f32x4){base + p[0], base + p[1], base + p[2], base + p[3]}; }
            else { p[3] = la[3]; p[2] = p[3] + la[2]; p[1] = p[2] + la[1]; p[0] = p[1] + la[0];
                const float s = p[0]; float incl = s; const float t1 = __shfl_down(incl, 16); if (g <= 2) incl += t1; const float t2 = __shfl_down(incl, 32); if (g <= 1) incl += t2;
                const float base = carry + (incl - s); carry += __shfl(incl, i);
                bv[cti][tt] = (f32x4){base + p[0], base + p[1], base + p[2], base + p[3]}; } } }
}

constexpr int G5_Q = 0;
constexpr int G5_K = 4 * 64 * 72 * 2;
constexpr int G5_P = 2 * G5_K;
static_assert(G5_P + 4 * 64 * 72 * 2 <= RING_BYTES && 8 * 16 * 272 <= G5_K, "P5 LDS map");
template <int MODE>
__device__ __forceinline__ void p5av3_phase(const Frame& F, CArgs* A) {
    LAS unsigned char* lds = F.lds;
    const bf16* P = (const bf16*)(F.ws + WS_P);
    const GateConst G = gate_setup(A, F.wave, F.lane);
#pragma unroll 1
    for (int it = F.bid; it < NBATCH * 64; it += F.G) {
        int tid_ = F.tid; asm volatile("" : "+v"(tid_));
        const int tid = tid_, lane = tid & 63, wave = __builtin_amdgcn_readfirstlane(tid >> 6), i = lane & 15, g = lane >> 4;
        const int h = wave >> 1, half = wave & 1;
        LAS unsigned char* st = lds + G5_Q + wave * (16 * 272);
        const int b = it >> 6, n = it & 63; const size_t prow = (size_t)b * SEQ + n * 64;
        unsigned pfv[9];
#pragma unroll
        for (int q = 0; q < 9; ++q) pfv[q] = 0u;
        const int dh = 32 * half + i;
        f32x4 pdiag[2], oacc[2][8];
#pragma unroll
        for (int a = 0; a < 2; ++a) { pdiag[a] = (f32x4){0.f, 0.f, 0.f, 0.f};
#pragma unroll
            for (int q = 0; q < 8; ++q) oacc[a][q] = (f32x4){0.f, 0.f, 0.f, 0.f}; }
#pragma unroll
        for (int dir = 0; dir < (MODE >= 4 ? 0 : 2); ++dir) {
            { unsigned qk[2][4][4];
#pragma unroll
              for (int cti = 0; cti < 2; ++cti)
#pragma unroll
                  for (int tt = 0; tt < 4; ++tt)
#pragma unroll
                      for (int r = 0; r < 4; ++r) { const bf16* rp = P + (prow + 16 * tt + 4 * g + r) * PW + h * 64 + dh + 16 * cti; qk[cti][tt][r] = (unsigned)rp[CQ] | ((unsigned)rp[CK] << 16); }
              f32x4 bv[2][4]; gate_b_dir(G, P, prow, lane, dir, bv);
#pragma unroll
              for (int cti = 0; cti < 2; ++cti)
#pragma unroll
                  for (int tt = 0; tt < 4; ++tt)
#pragma unroll
                      for (int r = 0; r < 4; ++r) { const float e = __builtin_amdgcn_exp2f(bv[cti][tt][r] * 1.4426950409f); const unsigned w = qk[cti][tt][r];
                          const int off = ((h * 64 + 16 * tt + 4 * g + r) * 72 + dh + 16 * cti) * 2;
                          *(LAS bf16*)(lds + G5_Q + off) = (bf16)f2bf(bflo(w) * e * 0.125f); *(LAS bf16*)(lds + G5_K + off) = (bf16)f2bf(bfhi(w) * __builtin_amdgcn_rcpf(e)); } }
            LDS_BARRIER();
            if (MODE < 3) { bf16x8 qf[2][2];
#pragma unroll
              for (int tti = 0; tti < 2; ++tti)
#pragma unroll
                  for (int ks = 0; ks < 2; ++ks) qf[tti][ks] = *(const LAS bf16x8*)(lds + G5_Q + ((h * 64 + (2 * half + tti) * 16 + i) * 72 + 32 * ks + 8 * g) * 2);
              const bf16* sp = ((const bf16*)(F.ws + WS_S)) + ((((size_t)dir * NBATCH + b) * 64 + n) * 4 + h) * 8192 + (size_t)i * 64 + 8 * g;
#pragma unroll
              for (int st_ = 0; st_ < 4; ++st_) { const bf16x8 kf0 = *(const LAS bf16x8*)(lds + G5_K + ((h * 64 + st_ * 16 + i) * 72 + 8 * g) * 2), kf1 = *(const LAS bf16x8*)(lds + G5_K + ((h * 64 + st_ * 16 + i) * 72 + 32 + 8 * g) * 2);
#pragma unroll
                  for (int tti = 0; tti < 2; ++tti) { const int tt = 2 * half + tti;
                      if (dir == 0 ? (st_ <= tt) : (st_ >= tt)) { f32x4 a = {0.f, 0.f, 0.f, 0.f};
                          a = __builtin_amdgcn_mfma_f32_16x16x32_bf16(kf0, qf[tti][0], a, 0, 0, 0); a = __builtin_amdgcn_mfma_f32_16x16x32_bf16(kf1, qf[tti][1], a, 0, 0, 0);
                          const int t = tt * 16 + i, s0 = st_ * 16 + 4 * g;
                          if (st_ == tt) {
#pragma unroll
                              for (int r = 0; r < 4; ++r) pdiag[tti][r] += (dir == 0 ? (s0 + r <= t) : (s0 + r >= t)) ? a[r] : 0.f;
                              a = pdiag[tti]; }
                          if (st_ != tt || dir == 1) { v2u w; w.x = pk2(a[0], a[1]); w.y = pk2(a[2], a[3]);
                              *(LAS v2u*)(lds + G5_P + ((h * 64 + t) * 72 + s0) * 2) = w; } } } }
              bf16x8 sfr[4][2];
#pragma unroll
              for (int vt = 0; vt < 4; ++vt) { sfr[vt][0] = *(const bf16x8*)(sp + (size_t)vt * 1024); sfr[vt][1] = *(const bf16x8*)(sp + (size_t)vt * 1024 + 32); }
#pragma unroll
              for (int vt = 0; vt < 8; ++vt) {
#pragma unroll
                  for (int tti = 0; tti < 2; ++tti) { oacc[tti][vt] = __builtin_amdgcn_mfma_f32_16x16x32_bf16(sfr[vt & 3][0], qf[tti][0], oacc[tti][vt], 0, 0, 0); oacc[tti][vt] = __builtin_amdgcn_mfma_f32_16x16x32_bf16(sfr[vt & 3][1], qf[tti][1], oacc[tti][vt], 0, 0, 0); }
                  asm volatile("" : "+v"(oacc[0][vt]), "+v"(oacc[1][vt]) :: "memory");
                  if (vt < 4) { sfr[vt][0] = *(const bf16x8*)(sp + (size_t)(vt + 4) * 1024); sfr[vt][1] = *(const bf16x8*)(sp + (size_t)(vt + 4) * 1024 + 32); } } }
            LDS_BARRIER();
        }
        LDS_WAIT();
        if (MODE < 2) { bf16x8 pfr[2][2];
#pragma unroll
          for (int tti = 0; tti < 2; ++tti)
#pragma unroll
              for (int ks = 0; ks < 2; ++ks) pfr[tti][ks] = *(const LAS bf16x8*)(lds + G5_P + ((h * 64 + (2 * half + tti) * 16 + i) * 72 + 32 * ks + 8 * g) * 2);
          const bf16* vp = ((const bf16*)(F.ws + WS_VT)) + (((size_t)b * 64 + n) * 4 + h) * 8192 + (size_t)i * 64 + 8 * g;
          bf16x8 vfr[8][2];
#pragma unroll
          for (int vt = 0; vt < 8; ++vt) { vfr[vt][0] = *(const bf16x8*)(vp + (size_t)vt * 1024); vfr[vt][1] = *(const bf16x8*)(vp + (size_t)vt * 1024 + 32); }
          { const int itn = it + F.G; if (itn < NBATCH * 64) { const int bn_ = itn >> 6, nn_ = itn & 63; const char* pr = (const char*)(P + ((size_t)bn_ * SEQ + nn_ * 64 + (tid >> 3)) * PW); const int j = tid & 7;
                pfv[0] = *(const unsigned*)(pr + 128 * j); pfv[1] = *(const unsigned*)(pr + 2048 + 128 * j); if (j == 0) pfv[2] = *(const unsigned*)(pr + 3072);
                const char* sb = (const char*)(((const bf16*)(F.ws + WS_S)) + (((size_t)bn_ * 64 + nn_) * 4) * 8192) + (size_t)tid * 128;
                pfv[6] = *(const unsigned*)sb; pfv[7] = *(const unsigned*)(sb + (size_t)NBATCH * 64 * 4 * 8192 * 2);
                pfv[8] = *(const unsigned*)((const char*)(((const bf16*)(F.ws + WS_VT)) + (((size_t)bn_ * 64 + nn_) * 4) * 8192) + (size_t)tid * 128); } }
#pragma unroll
          for (int vt = 0; vt < 8; ++vt)
#pragma unroll
              for (int tti = 0; tti < 2; ++tti) { oacc[tti][vt] = __builtin_amdgcn_mfma_f32_16x16x32_bf16(vfr[vt][0], pfr[tti][0], oacc[tti][vt], 0, 0, 0); oacc[tti][vt] = __builtin_amdgcn_mfma_f32_16x16x32_bf16(vfr[vt][1], pfr[tti][1], oacc[tti][vt], 0, 0, 0); } }
#pragma unroll
        for (int tti = 0; tti < (MODE >= 2 ? 0 : 2); ++tti) { const int t = (2 * half + tti) * 16 + i; float ss = 0.f;
#pragma unroll
            for (int vt = 0; vt < 8; ++vt) { const f32x4 a = oacc[tti][vt]; ss += (a[0] * a[0] + a[1] * a[1]) + (a[2] * a[2] + a[3] * a[3]); }
            ss += __shfl_xor(ss, 16); ss += __shfl_xor(ss, 32);
            const float rstd = 1.0f / sqrtf(ss * (1.0f / 128.0f) + EPS);
#pragma unroll
            for (int vt = 0; vt < 8; ++vt) { const int v = vt * 16 + 4 * g; const f32x4 gw = *(const f32x4*)(A->in[12] + v); const v2u rw = *(const v2u*)(P + (prow + t) * PW + CR + h * 128 + v);
                const float r[4] = {bflo(rw.x), bfhi(rw.x), bflo(rw.y), bfhi(rw.y)}; float y[4];
#pragma unroll
                for (int j = 0; j < 4; ++j) y[j] = oacc[tti][vt][j] * rstd * gw[j] * (r[j] * __builtin_amdgcn_rcpf(1.0f + __builtin_amdgcn_exp2f(r[j] * -1.4426950409f)));
                if (OUTPROJ_F8) *(LAS unsigned*)(st + i * 144 + v) = pk4_fp8(y[0], y[1], y[2], y[3]);
                else { v2u w; w.x = pk2(y[0], y[1]); w.y = pk2(y[2], y[3]);
                    *(LAS v2u*)(st + i * 272 + v * 2) = w; }
                if ((vt & 3) == 3) asm volatile("" ::: "memory"); }
            LDS_WAIT();
            if (OUTPROJ_F8) {
#pragma unroll
                for (int j = 0; j < 2; ++j) { const int pc = lane + 64 * j, row = pc >> 3, ch = pc & 7;
                    *(v4u*)(F.ws + WS_YMIX + (prow + (2 * half + tti) * 16 + row) * D + h * 128 + ch * 16) = *(const LAS v4u*)(st + row * 144 + ch * 16); } }
            else {
#pragma unroll
                for (int j = 0; j < 4; ++j) { const int pc = lane + 64 * j, row = pc >> 4, ch = pc & 15;
                    *(v4u*)(((bf16*)(F.ws + WS_YMIX)) + (prow + (2 * half + tti) * 16 + row) * D + h * 128 + ch * 8) = *(const LAS v4u*)(st + row * 272 + ch * 16); } }
            LDS_WAIT(); }
#pragma unroll
        for (int q = 0; q < 9; ++q) asm volatile("" :: "v"(pfv[q]));
        LDS_BARRIER();
    }
    if (MODE < 1) { int tc_ = F.tid; asm volatile("" : "+v"(tc_)); conv_stream(F, A, tc_); }
}

__device__ __forceinline__ void p4_phase(const Frame& F, CArgs* A) {
    int tid_ = threadIdx.x; asm volatile("" : "+v"(tid_));
    const int tid = tid_;
    for (int idx = F.bid * NTHREADS + tid; idx < 2 * NBATCH * 4 * 1024; idx += F.G * NTHREADS) {
        const int e8 = idx & 1023, ch = idx >> 10, h = ch & 3, b = (ch >> 2) & 15, dir = ch >> 6; const int d0 = (e8 & 7) * 8;
        float s[8];
#pragma unroll
        for (int j = 0; j < 8; ++j) s[j] = 0.f;
#pragma unroll 17
        for (int st = 0; st < NCC; ++st) {
            const int cc = dir ? (st < 4 ? 3 - st : 71 - st) : st;
            const size_t ci = ((size_t)dir * NBATCH + b) * NCC + cc;
            const v4u kv = *(const v4u*)(((bf16*)(F.ws + WS_KV)) + (ci * 4 + h) * 8192 + (size_t)e8 * 8);
            const f32x4 dc0 = *(const f32x4*)(((float*)(F.ws + WS_DECAY)) + ci * 256 + h * 64 + d0), dc1 = *(const f32x4*)(((float*)(F.ws + WS_DECAY)) + ci * 256 + h * 64 + d0 + 4);
            if (cc >= 4) { v4u w; w.x = pk2(s[0], s[1]); w.y = pk2(s[2], s[3]); w.z = pk2(s[4], s[5]); w.w = pk2(s[6], s[7]);
                *(v4u*)(((bf16*)(F.ws + WS_S)) + ((((size_t)dir * NBATCH + b) * 64 + (cc - 4)) * 4 + h) * 8192 + (size_t)e8 * 8) = w; }
            s[0] = s[0] * dc0[0] + bflo(kv.x); s[1] = s[1] * dc0[1] + bfhi(kv.x); s[2] = s[2] * dc0[2] + bflo(kv.y); s[3] = s[3] * dc0[3] + bfhi(kv.y);
            s[4] = s[4] * dc1[0] + bflo(kv.z); s[5] = s[5] * dc1[1] + bfhi(kv.z); s[6] = s[6] * dc1[2] + bflo(kv.w); s[7] = s[7] * dc1[3] + bfhi(kv.w);
        }
    }
}

__device__ __forceinline__ void p5a_phase(const Frame& F, CArgs* A) {
    LAS unsigned char* lds = F.lds; const int tid = F.tid, lane = F.lane, wave = F.wave, i = lane & 15, g = lane >> 4;
    GlaRegs cur; if (F.bid < NBATCH * 64 * 4) cur = gla_load(F, (size_t)(F.bid >> 2) * 64, F.bid & 3);
    f32x4 gw[4];
#pragma unroll
    for (int k = 0; k < 4; ++k) gw[k] = *(const f32x4*)(A->in[12] + ((wave >> 2) * 4 + k) * 16 + 4 * g);
    for (int it = F.bid; it < NBATCH * 64 * 4; it += F.G) {
        const int h = it & 3, bn = it >> 2, b = bn >> 6, n = bn & 63; const size_t prow = (size_t)b * SEQ + n * 64;
        GlaRegs nxt = cur; { const int itn = it + F.G; if (itn < NBATCH * 64 * 4) nxt = gla_load(F, (size_t)(itn >> 2) * 64, itn & 3); }
        v4u qw, kw; { const int t = tid >> 3, d0 = (tid & 7) * 8; qw = *(const v4u*)(((bf16*)(F.ws + WS_P)) + (prow + t) * PW + CQ + h * 64 + d0); kw = *(const v4u*)(((bf16*)(F.ws + WS_P)) + (prow + t) * PW + CK + h * 64 + d0); }
        gla_prep(F, A, cur, h); cur = nxt;
        bf16x8 sfr[4][2][2]; v2u rwv[4];
        { const int tt = wave & 3, vh = wave >> 2, t = tt * 16 + i;
#pragma unroll
          for (int k = 0; k < 4; ++k) { const int vt = vh * 4 + k;
#pragma unroll
              for (int dir = 0; dir < 2; ++dir) { const bf16* sp = ((bf16*)(F.ws + WS_S)) + ((((size_t)dir * NBATCH + b) * 64 + n) * 4 + h) * 8192 + (size_t)(vt * 16 + i) * 64 + 8 * g;
                  sfr[k][dir][0] = *(const bf16x8*)sp; sfr[k][dir][1] = *(const bf16x8*)(sp + 32); }
              rwv[k] = *(const v2u*)(((bf16*)(F.ws + WS_P)) + (prow + t) * PW + CR + h * 128 + vt * 16 + 4 * g); } }
        { const int t = tid >> 3, d0 = (tid & 7) * 8;
          const float q[8] = {bflo(qw.x), bfhi(qw.x), bflo(qw.y), bfhi(qw.y), bflo(qw.z), bfhi(qw.z), bflo(qw.w), bfhi(qw.w)};
          const float k[8] = {bflo(kw.x), bfhi(kw.x), bflo(kw.y), bfhi(kw.y), bflo(kw.z), bfhi(kw.z), bflo(kw.w), bfhi(kw.w)};
#pragma unroll
          for (int dir = 0; dir < 2; ++dir) { const LAS float* bp = (const LAS float*)(lds + GL_BC) + dir * 4096 + t * 64 + d0;
              const f32x4 b0 = *(const LAS f32x4*)bp, b1 = *(const LAS f32x4*)(bp + 4); const float bb[8] = {b0[0], b0[1], b0[2], b0[3], b1[0], b1[1], b1[2], b1[3]};
              float qd[8], ki[8];
#pragma unroll
              for (int j = 0; j < 8; ++j) { qd[j] = q[j] * __expf(bb[j]) * 0.125f; ki[j] = k[j] * __expf(-bb[j]); }
              v4u w; w.x = pk2(qd[0], qd[1]); w.y = pk2(qd[2], qd[3]); w.z = pk2(qd[4], qd[5]); w.w = pk2(qd[6], qd[7]);
              *(LAS v4u*)(lds + GL_A + ((dir * 64 + t) * 72 + d0) * 2) = w;
              w.x = pk2(ki[0], ki[1]); w.y = pk2(ki[2], ki[3]); w.z = pk2(ki[4], ki[5]); w.w = pk2(ki[6], ki[7]);
              *(LAS v4u*)(lds + GL_B + ((dir * 64 + t) * 72 + d0) * 2) = w; } }
        __syncthreads();
#pragma unroll
        for (int kk = 0; kk < 2; ++kk) { const int pi = wave * 2 + kk, tt = pi >> 2, st = pi & 3;
            f32x4 aF = {0.f, 0.f, 0.f, 0.f}, aB = {0.f, 0.f, 0.f, 0.f};
            if (st <= tt) {
#pragma unroll
                for (int ks = 0; ks < 2; ++ks) { const bf16x8 kf = *(const LAS bf16x8*)(lds + GL_B + ((st * 16 + i) * 72 + 32 * ks + 8 * g) * 2), qf = *(const LAS bf16x8*)(lds + GL_A + ((tt * 16 + i) * 72 + 32 * ks + 8 * g) * 2);
                    aF = __builtin_amdgcn_mfma_f32_16x16x32_bf16(kf, qf, aF, 0, 0, 0); } }
            if (st >= tt) {
#pragma unroll
                for (int ks = 0; ks < 2; ++ks) { const bf16x8 kf = *(const LAS bf16x8*)(lds + GL_B + ((64 + st * 16 + i) * 72 + 32 * ks + 8 * g) * 2), qf = *(const LAS bf16x8*)(lds + GL_A + ((64 + tt * 16 + i) * 72 + 32 * ks + 8 * g) * 2);
                    aB = __builtin_amdgcn_mfma_f32_16x16x32_bf16(kf, qf, aB, 0, 0, 0); } }
            const int t = tt * 16 + i, s0 = st * 16 + 4 * g; float p[4];
#pragma unroll
            for (int r = 0; r < 4; ++r) p[r] = ((s0 + r <= t) ? aF[r] : 0.f) + ((s0 + r >= t) ? aB[r] : 0.f);
            v2u w; w.x = pk2(p[0], p[1]); w.y = pk2(p[2], p[3]);
            *(LAS v2u*)(lds + GL_P + (t * 72 + s0) * 2) = w; }
        __syncthreads();
        { const int tt = wave & 3, vh = wave >> 2; const int t = tt * 16 + i;
          bf16x8 pf[2], qf[2][2];
#pragma unroll
          for (int ks = 0; ks < 2; ++ks) { pf[ks] = *(const LAS bf16x8*)(lds + GL_P + (t * 72 + 32 * ks + 8 * g) * 2);
              qf[0][ks] = *(const LAS bf16x8*)(lds + GL_A + (t * 72 + 32 * ks + 8 * g) * 2); qf[1][ks] = *(const LAS bf16x8*)(lds + GL_A + ((64 + t) * 72 + 32 * ks + 8 * g) * 2); }
          f32x4 acc[4]; float ss = 0.f;
#pragma unroll
          for (int k = 0; k < 4; ++k) { const int vt = vh * 4 + k; f32x4 a = {0.f, 0.f, 0.f, 0.f};
              { bf16x8 vf0, vf1; v_frag2(lds, vt * 16, lane, vf0, vf1); a = __builtin_amdgcn_mfma_f32_16x16x32_bf16(vf0, pf[0], a, 0, 0, 0); a = __builtin_amdgcn_mfma_f32_16x16x32_bf16(vf1, pf[1], a, 0, 0, 0); }
#pragma unroll
              for (int dir = 0; dir < 2; ++dir)
#pragma unroll
                  for (int ks = 0; ks < 2; ++ks) a = __builtin_amdgcn_mfma_f32_16x16x32_bf16(sfr[k][dir][ks], qf[dir][ks], a, 0, 0, 0);
              acc[k] = a; ss += (a[0] * a[0] + a[1] * a[1]) + (a[2] * a[2] + a[3] * a[3]); }
          ss += __shfl_xor(ss, 16); ss += __shfl_xor(ss, 32);
          if (g == 0) ((LAS float*)(lds + GL_SS))[vh * 64 + t] = ss;
          __syncthreads();
          const float tot = ((const LAS float*)(lds + GL_SS))[t] + ((const LAS float*)(lds + GL_SS))[64 + t];
          const float rstd = 1.0f / sqrtf(tot * (1.0f / 128.0f) + EPS);
#pragma unroll
          for (int k = 0; k < 4; ++k) { const int v = (vh * 4 + k) * 16 + 4 * g;
              const v2u rw = rwv[k];
              const float r[4] = {bflo(rw.x), bfhi(rw.x), bflo(rw.y), bfhi(rw.y)}; float y[4];
#pragma unroll
              for (int j = 0; j < 4; ++j) y[j] = acc[k][j] * rstd * gw[k][j] * (r[j] * __builtin_amdgcn_rcpf(1.0f + __expf(-r[j])));
              v2u w; w.x = pk2(y[0], y[1]); w.y = pk2(y[2], y[3]);
              *(v2u*)(((bf16*)(F.ws + WS_YMIX)) + (prow + t) * D + h * 128 + v) = w; } }
        __syncthreads();
    }
    for (int it = F.bid; it < NBATCH * 64; it += F.G) {
        const size_t prow = (size_t)it * 64;
#pragma unroll 1
        for (int rep = 0; rep < 8; ++rep) { const int idx = tid + rep * NTHREADS, t = idx >> 6, c0 = (idx & 63) * 8;
            float cv[8];
#pragma unroll
            for (int j = 0; j < 8; ++j) cv[j] = 0.f;
#pragma unroll
            for (int dt = -1; dt <= 1; ++dt) { const int tt = t + dt; if (tt >= 0 && tt < 64) {
                const v4u cw = *(const v4u*)(((bf16*)(F.ws + WS_P)) + (prow + tt) * PW + CPC + c0), xw = *(const v4u*)(((bf16*)(F.ws + WS_P)) + (prow + tt) * PW + CPX + c0);
                const f32x4 w0 = *(const f32x4*)(A->in[13] + (dt + 1) * 512 + c0), w1 = *(const f32x4*)(A->in[13] + (dt + 1) * 512 + c0 + 4);
                cv[0] += w0[0] * bflo(cw.x) * bflo(xw.x); cv[1] += w0[1] * bfhi(cw.x) * bfhi(xw.x); cv[2] += w0[2] * bflo(cw.y) * bflo(xw.y); cv[3] += w0[3] * bfhi(cw.y) * bfhi(xw.y);
                cv[4] += w1[0] * bflo(cw.z) * bflo(xw.z); cv[5] += w1[1] * bfhi(cw.z) * bfhi(xw.z); cv[6] += w1[2] * bflo(cw.w) * bflo(xw.w); cv[7] += w1[3] * bfhi(cw.w) * bfhi(xw.w); } }
            const v4u bw = *(const v4u*)(((bf16*)(F.ws + WS_P)) + (prow + t) * PW + CPB + c0);
            v4u w; w.x = pk2(cv[0] * bflo(bw.x), cv[1] * bfhi(bw.x)); w.y = pk2(cv[2] * bflo(bw.y), cv[3] * bfhi(bw.y)); w.z = pk2(cv[4] * bflo(bw.z), cv[5] * bfhi(bw.z)); w.w = pk2(cv[6] * bflo(bw.w), cv[7] * bfhi(bw.w));
            *(v4u*)(((bf16*)(F.ws + WS_YMIX)) + (prow + t) * D + 512 + c0) = w; }
    }
}

constexpr int RT_W = 0;
constexpr int RT_LG = 32 * 1032 * 2;
constexpr int RT_HIST = RT_LG + 128 * 33 * 4;
constexpr int RT_WC = RT_HIST + 256;
__device__ __forceinline__ void p5c_phase(const Frame& F, CArgs* A) {
    LAS unsigned char* lds = F.lds; const int tid = F.tid, lane = F.lane, wave = F.wave, i = lane & 15, g = lane >> 4;
#pragma unroll 1
    for (int i0 = 0; i0 < 32768; i0 += 16 * NTHREADS) { float rv[16];
#pragma unroll
        for (int q = 0; q < 16; ++q) rv[q] = A->in[16][i0 + q * NTHREADS + tid];
#pragma unroll
        for (int q = 0; q < 16; ++q) { const int idx = i0 + q * NTHREADS + tid, k = idx >> 5, e = idx & 31; *(LAS bf16*)(lds + RT_W + (e * 1032 + k) * 2) = (bf16)f2bf(rv[q]); } }
    LAS int* hist = (LAS int*)(lds + RT_HIST); LAS float* lg = (LAS float*)(lds + RT_LG);
    unsigned* gcnt = ((unsigned*)(F.ws + WS_CTL)) + CW_CNT;
    __syncthreads();
#pragma unroll 1
    for (int it = F.bid; it < NLAT / 128; it += F.G) {
        const int R = it * 128 + wave * 16 + i, b = it >> 5;
        const bf16* yg = ((const bf16*)(F.ws + WS_Y1)) + (size_t)R * D + 8 * g;
        unsigned char* hn2g = (unsigned char*)F.out + DO_HN2 + (size_t)R * D + 8 * g;
        const LAS unsigned char* rw0 = lds + RT_W + (i * 1032 + 8 * g) * 2; const LAS unsigned char* rw1 = rw0 + 16 * 1032 * 2;
        if (tid < 32) hist[tid] = 0;
        { const int c0 = 2 * tid; const f32x2 w_ = *(const f32x2*)(A->in[15] + c0), c_ = *(const f32x2*)(((float*)(F.ws + WS_MOD)) + (size_t)b * 6144 + 4096 + c0), s_ = *(const f32x2*)(((float*)(F.ws + WS_MOD)) + (size_t)b * 6144 + 3072 + c0);
          *(LAS f32x2*)(lds + RT_WC + c0 * 4) = w_ * (c_ + 1.0f); *(LAS f32x2*)(lds + RT_WC + 4096 + c0 * 4) = s_; }
        v4u yv[32];
#pragma unroll
        for (int ks = 0; ks < 32; ++ks) yv[ks] = *(const v4u*)(yg + 32 * ks);
        float ss = 0.f;
#pragma unroll
        for (int ks = 0; ks < 32; ++ks) { const v4u yw = yv[ks];
            const float h0 = bflo(yw.x), h1 = bfhi(yw.x), h2 = bflo(yw.y), h3 = bfhi(yw.y), h4 = bflo(yw.z), h5 = bfhi(yw.z), h6 = bflo(yw.w), h7 = bfhi(yw.w);
            ss += (h0 * h0 + h1 * h1) + (h2 * h2 + h3 * h3) + (h4 * h4 + h5 * h5) + (h6 * h6 + h7 * h7); }
        ss += __shfl_xor(ss, 16); ss += __shfl_xor(ss, 32);
        const float rstd = 1.0f / sqrtf(ss * (1.f / D) + EPS);
#pragma unroll
        for (int ks = 0; ks < 32; ++ks) asm volatile("" : "+v"(yv[ks]));
        LDS_BARRIER();
        f32x4 l0 = {0.f, 0.f, 0.f, 0.f}, l1 = {0.f, 0.f, 0.f, 0.f};
        const LAS unsigned char* wcg = lds + RT_WC + 32 * g;
#pragma unroll
        for (int ks = 0; ks < 32; ++ks) {
            const v4u yw = yv[ks];
            const f32x4 a0 = {bflo(yw.x), bfhi(yw.x), bflo(yw.y), bfhi(yw.y)}, a1 = {bflo(yw.z), bfhi(yw.z), bflo(yw.w), bfhi(yw.w)};
            const f32x4 c0 = *(const LAS f32x4*)(wcg + 128 * ks), c1 = *(const LAS f32x4*)(wcg + 128 * ks + 16), s0 = *(const LAS f32x4*)(wcg + 4096 + 128 * ks), s1 = *(const LAS f32x4*)(wcg + 4096 + 128 * ks + 16);
            const f32x4 y0 = (a0 * rstd) * c0 + s0, y1 = (a1 * rstd) * c1 + s1;
            v4u w; w.x = pk2(y0[0], y0[1]); w.y = pk2(y0[2], y0[3]); w.z = pk2(y1[0], y1[1]); w.w = pk2(y1[2], y1[3]);
            { v2u w8; w8.x = pk4_fp8(y0[0], y0[1], y0[2], y0[3]); w8.y = pk4_fp8(y1[0], y1[1], y1[2], y1[3]); *(v2u*)(hn2g + 32 * ks) = w8; }
            const bf16x8 af = __builtin_bit_cast(bf16x8, w);
            const bf16x8 r0 = *(const LAS bf16x8*)(rw0 + 64 * ks), r1 = *(const LAS bf16x8*)(rw1 + 64 * ks);
            l0 = __builtin_amdgcn_mfma_f32_16x16x32_bf16(af, r0, l0, 0, 0, 0); l1 = __builtin_amdgcn_mfma_f32_16x16x32_bf16(af, r1, l1, 0, 0, 0);
            asm volatile("" : "+v"(l0), "+v"(l1) :: "memory"); }
        { const float rb0 = A->in[17][i], rb1 = A->in[17][16 + i];
#pragma unroll
          for (int r = 0; r < 4; ++r) { lg[(wave * 16 + 4 * g + r) * 33 + i] = l0[r] + rb0; lg[(wave * 16 + 4 * g + r) * 33 + 16 + i] = l1[r] + rb1; } }
        __syncthreads();
        int te[4] = {0, 0, 0, 0}; float tv[4] = {-3.0e38f, -3.0e38f, -3.0e38f, -3.0e38f}; int lp[4] = {0, 0, 0, 0};
        if (lane < 16) { const LAS float* lr = lg + (wave * 16 + lane) * 33;
            for (int e = 0; e < 32; ++e) { const float x = lr[e];
                if (x > tv[3]) { if (x > tv[2]) { tv[3] = tv[2]; te[3] = te[2]; if (x > tv[1]) { tv[2] = tv[1]; te[2] = te[1]; if (x > tv[0]) { tv[1] = tv[0]; te[1] = te[0]; tv[0] = x; te[0] = e; } else { tv[1] = x; te[1] = e; } } else { tv[2] = x; te[2] = e; } } else { tv[3] = x; te[3] = e; } } }
            const float e1 = __expf(tv[1] - tv[0]), e2 = __expf(tv[2] - tv[0]), e3 = __expf(tv[3] - tv[0]), inv = 1.0f / (1.0f + e1 + e2 + e3);
            tv[0] = inv; tv[1] = e1 * inv; tv[2] = e2 * inv; tv[3] = e3 * inv;
#pragma unroll
            for (int k = 0; k < 4; ++k) lp[k] = __hip_atomic_fetch_add(&hist[te[k]], 1, __ATOMIC_RELAXED, __HIP_MEMORY_SCOPE_WORKGROUP); }
        __syncthreads();
        if (tid < 32) { const int c = hist[tid]; hist[32 + tid] = c ? (int)__hip_atomic_fetch_add(gcnt + tid, (unsigned)c, RLX_AGENT) : 0; }
        __syncthreads();
        if (lane < 16) { const int Rt = it * 128 + wave * 16 + lane;
#pragma unroll
            for (int k = 0; k < 4; ++k) { const size_t pos = (size_t)te[k] * LISTCAP + hist[32 + te[k]] + lp[k]; ((int*)((unsigned char*)F.out + DO_LAID))[pos] = Rt * 4 + k;
                ((int*)(F.ws + WS_TSLOT))[Rt * 4 + k] = (te[k] << 20) | (hist[32 + te[k]] + lp[k]); ((float*)(F.ws + WS_TW))[Rt * 4 + k] = tv[k]; } }
        __syncthreads();
    }
}

constexpr int P8NR = 1;
struct P8Slots { int ep[P8NR][4]; float wk[P8NR][4]; };
struct P8Rows { int yw8[P8NR][4][4]; v2u hw[P8NR][4]; float wk[P8NR][4]; f32x4 g2v[4]; };
__device__ __forceinline__ int p8_row(int gw, int NGW, int k, int a) { const int r = P8NR * (gw + k * NGW) + a; return r < NLAT ? r : P8NR * gw + a; }
__device__ __forceinline__ void p8_slots(const Frame& F, int gw, int NGW, int k, P8Slots& S) {
#pragma unroll
    for (int a = 0; a < P8NR; ++a) { const int r = p8_row(gw, NGW, k, a);
#pragma unroll
        for (int q = 0; q < 4; ++q) { S.ep[a][q] = ((const int*)(F.ws + WS_TSLOT))[r * 4 + q]; S.wk[a][q] = ((const float*)(F.ws + WS_TW))[r * 4 + q]; } }
}
__device__ __forceinline__ void p8_rows(const Frame& F, const LAS int* TS, int lane, int gw, int NGW, int k, const P8Slots& S, P8Rows& R) {
#pragma unroll
    for (int a = 0; a < P8NR; ++a) { const int r = p8_row(gw, NGW, k, a); const bf16* yr = ((const bf16*)(F.ws + WS_Y1)) + (size_t)r * D;
#pragma unroll
        for (int q = 0; q < 4; ++q) { const int* ys = (const int*)((const unsigned char*)(F.ws + WS_YA) + ((size_t)TS[S.ep[a][q] >> 20] * 256 + (S.ep[a][q] & 0xFFFFF)) * D); R.wk[a][q] = S.wk[a][q];
#pragma unroll
            for (int j = 0; j < 4; ++j) R.yw8[a][q][j] = ys[lane + 64 * j]; }
#pragma unroll
        for (int j = 0; j < 4; ++j) R.hw[a][j] = ((const v2u*)yr)[lane + 64 * j]; }
    { const float* g2 = ((float*)(F.ws + WS_MOD)) + (size_t)(p8_row(gw, NGW, k, 0) >> 12) * 6144 + 5120;
#pragma unroll
      for (int j = 0; j < 4; ++j) R.g2v[j] = ((const f32x4*)g2)[lane + 64 * j]; }
}
__device__ __forceinline__ void p8_pin(P8Rows& R) {
    asm volatile("" ::: "memory");
#pragma unroll
    for (int a = 0; a < P8NR; ++a) {
#pragma unroll
        for (int q = 0; q < 4; ++q) { asm volatile("" : "+v"(R.wk[a][q]));
#pragma unroll
            for (int j = 0; j < 4; ++j) asm volatile("" : "+v"(R.yw8[a][q][j])); }
#pragma unroll
        for (int j = 0; j < 4; ++j) asm volatile("" : "+v"(R.hw[a][j])); }
#pragma unroll
    for (int j = 0; j < 4; ++j) asm volatile("" : "+v"(R.g2v[j]));
}
__device__ __forceinline__ void p8_emit(const Frame& F, const f32x4 (&fw)[4], int lane, int gw, int NGW, int k, const P8Rows& R) {
#pragma unroll
    for (int a = 0; a < P8NR; ++a) { const int r = p8_row(gw, NGW, k, a); float* hr = F.out + (size_t)r * D;
        f32x4 v[4]; float s = 0.f;
#pragma unroll
        for (int j = 0; j < 4; ++j) { const int c4 = lane + 64 * j; f32x4 y = {0.f, 0.f, 0.f, 0.f};
#pragma unroll
            for (int q = 0; q < 4; ++q) { const int w = R.yw8[a][q][j]; const f32x2 lo = __builtin_amdgcn_cvt_pk_f32_fp8(w, false), hi = __builtin_amdgcn_cvt_pk_f32_fp8(w, true);
                y[0] += R.wk[a][q] * lo[0]; y[1] += R.wk[a][q] * lo[1]; y[2] += R.wk[a][q] * hi[0]; y[3] += R.wk[a][q] * hi[1]; }
            const v2u yw = R.hw[a][j]; const f32x4 y1 = {bflo(yw.x), bfhi(yw.x), bflo(yw.y), bfhi(yw.y)};
            v[j] = y1 + R.g2v[j] * y;
            s += (v[j].x * v[j].x + v[j].y * v[j].y) + (v[j].z * v[j].z + v[j].w * v[j].w); }
        const float rstd = 1.0f / sqrtf(wave_sum(s) * (1.f / D) + EPS);
#pragma unroll
        for (int j = 0; j < 4; ++j) { const int c4 = lane + 64 * j; ((f32x4*)hr)[c4] = (v[j] * rstd) * fw[j]; } }
}
__device__ __forceinline__ void p8_phase(const Frame& F, CArgs* A, const LAS int* TS) {
    int tid_ = threadIdx.x; asm volatile("" : "+v"(tid_));
    const int lane = tid_ & 63;
    const int gw = F.bid * NWAVES + F.wave, NGW = F.G * NWAVES;
    if (P8NR * gw >= NLAT) return;
    const int K = (NLAT / P8NR - gw + NGW - 1) / NGW;
    f32x4 fw[4];
#pragma unroll
    for (int j = 0; j < 4; ++j) fw[j] = ((const f32x4*)A->in[22])[lane + 64 * j];
    P8Slots Sa, Sb; P8Rows Ra, Rb;
    p8_slots(F, gw, NGW, 0, Sa); p8_rows(F, TS, lane, gw, NGW, 0, Sa, Ra); p8_slots(F, gw, NGW, 1, Sb);
#pragma unroll 1
    for (int k = 0; k < K; k += 2) {
        int l_ = threadIdx.x; asm volatile("" : "+v"(l_)); l_ &= 63;
        p8_slots(F, gw, NGW, k + 2, Sa); p8_rows(F, TS, l_, gw, NGW, k + 1, Sb, Rb); p8_pin(Ra);
        p8_emit(F, fw, l_, gw, NGW, k, Ra);
        p8_slots(F, gw, NGW, k + 3, Sb); p8_rows(F, TS, l_, gw, NGW, k + 2, Sa, Ra); p8_pin(Rb);
        p8_emit(F, fw, l_, gw, NGW, k + 1, Rb);
    }
}

constexpr int NPHASES = 11;
__global__ void __launch_bounds__(NTHREADS, 2) fwd_kernel(Args args) {
    extern __shared__ __attribute__((aligned(16))) unsigned char lds_raw[];
    Frame F;
    F.lds = (LAS unsigned char*)lds_raw;
    F.tid = threadIdx.x; F.lane = F.tid & 63; F.wave = __builtin_amdgcn_readfirstlane(F.tid >> 6); F.G = gridDim.x; F.bid = blockIdx.x;
    F.out = args.out; F.ws = args.ws;
        for (int u = F.tid; u < (LDS_BYTES - MISC_OFF) / 4; u += NTHREADS) ((LAS unsigned*)(F.lds + MISC_OFF))[u] = 0u;
    __syncthreads();
    volatile LAS unsigned* MISC = (volatile LAS unsigned*)(F.lds + MISC_OFF);
    LAS int* TS = (LAS int*)(F.lds + MISC_OFF + 256);
    const int lo = args.ph_lo, hi = args.ph_hi;
    const bool multi = (hi - lo) > 1;
    XcdBarrier bar; bar.bar = (unsigned*)((unsigned*)(F.ws + WS_CTL)) + CW_BAR; bar.x = 0; bar.st = nullptr;
    if (multi) bar = xcd_barrier_post((unsigned*)((unsigned*)(F.ws + WS_CTL)) + CW_BAR, MISC + 8);
#ifndef PHMASK
#define PHMASK 0x7ff
#endif
#define IN(k) (((PHMASK >> (k)) & 1) && lo <= (k) && (k) < hi)
#define BUILD_TS() do { if (F.tid < NEXP) TS[33 + F.tid] = (int)__hip_atomic_load(((unsigned*)(F.ws + WS_CTL)) + CW_CNT + F.tid, RLX_AGENT);     \
        __syncthreads(); \
        if (F.tid == 0) { int acc_ = 0; for (int e = 0; e < NEXP; ++e) { TS[e] = acc_; acc_ += (TS[33 + e] + 255) >> 8; } TS[32] = acc_; } __syncthreads(); \
        for (int t_ = F.tid; t_ < TS[32]; t_ += NTHREADS) { int e_ = 0; for (int k_ = 1; k_ < NEXP; ++k_) e_ = (TS[k_] <= t_) ? k_ : e_; ((LAS unsigned char*)(TS + 72))[t_] = (unsigned char)e_; } \
        __syncthreads(); } while (0)
#define SEAM(k) do { if (IN(k) && IN((k) + 1)) xcd_barrier(bar); } while (0)
#ifndef PROBE_DUP
#define PROBE_DUP 0
#endif
#define REPS(k) for (int rep_ = 0; rep_ < (((PROBE_DUP >> (k)) & 1) ? 2 : 1); ++rep_)

    if (IN(0)) REPS(0) { p0_phase(F, opaque_args()); } SEAM(0);
    if (IN(1)) REPS(1) { p1_phase(F, opaque_args()); } SEAM(1);
    if (IN(2)) REPS(2) { DenseSched S; S.init(NROWS, PWP, F.G, F.bid, ((bf16*)(F.ws + WS_WIN))); S.build((LAS int*)(TS + 400), F.tid); EpiProj E{((bf16*)(F.ws + WS_P))};
        pg8::gemm_phase<EpiProj, DenseSched, true, false>(F.lds, (const char*)((bf16*)(F.ws + WS_HN)), S, E);
#ifdef PROBE_INNULL
        { EpiNull E0; pg8::gemm_phase<EpiNull, DenseSched, true, false>(F.lds, (const char*)((bf16*)(F.ws + WS_HN)), S, E0); }
#endif
    } SEAM(2);
    if (IN(3)) { p3v3_phase<0>(F, opaque_args());
#ifdef PROBE_P3
        p3v3_phase<PROBE_P3>(F, opaque_args());
#endif
    } SEAM(3);
    if (IN(4)) REPS(4) { p4_phase(F, opaque_args()); } SEAM(4);
    if (IN(5)) {
#ifdef PROBE_P5
        p5a_phase(F, opaque_args()); p5av3_phase<PROBE_P5>(F, opaque_args());
#else
        p5av3_phase<0>(F, opaque_args());
#endif
    } SEAM(5);
    if (IN(6)) REPS(6) { DenseSched S; S.init(NLAT, D, F.G, F.bid, ((bf16*)(F.ws + WS_WOUT))); S.kb = OUTPROJ_F8 ? 1024 : 2048; S.build((LAS int*)(TS + 400), F.tid); EpiOut E{opaque_args()->in[0], ((float*)(F.ws + WS_MOD)), ((bf16*)(F.ws + WS_Y1)), OUTPROJ_F8 ? 1.0f / WSCALE : 1.0f};
        pg8::gemm_phase<EpiOut, DenseSched, true, OUTPROJ_F8 != 0>(F.lds, (const char*)((bf16*)(F.ws + WS_YMIX)), S, E); } SEAM(6);
    if (IN(7)) { p5c_phase(F, opaque_args()); } SEAM(7);
#pragma unroll 1
    for (int ph = 8; ph < 10; ++ph) {
        if (IN(ph)) {
            const bool gu = (ph == 8);
            BUILD_TS();
            const int ntr = TS[32];
            REPS(ph) {
                if (gu) { MoeSched<true> S; S.TS = TS; S.ntr = ntr; S.G = F.G; S.c = F.bid; S.laid = ((int*)((unsigned char*)F.out + DO_LAID)); S.W = (const char*)F.out + DO_WGU;
                    EpiGU E{(unsigned char*)(F.ws + WS_ACT), opaque_args()->in[19]}; pg8::gemm_phase<EpiGU, MoeSched<true>, true, true>(F.lds, (const char*)((unsigned char*)F.out + DO_HN2), S, E);
#ifdef PROBE_GUNULL
                    { EpiNull E0; pg8::gemm_phase<EpiNull, MoeSched<true>, true, true>(F.lds, (const char*)((unsigned char*)F.out + DO_HN2), S, E0); }
#endif
                }
                else { MoeSched<false> S; S.TS = TS; S.ntr = ntr; S.G = F.G; S.c = F.bid; S.laid = nullptr; S.W = (const char*)F.out + DO_WDN;
                    EpiDN E{(unsigned char*)(F.ws + WS_YA), opaque_args()->in[21], TS}; pg8::gemm_phase<EpiDN, MoeSched<false>, true, true>(F.lds, (const char*)(F.ws + WS_ACT), S, E); }
            }
        }
        SEAM(ph);
    }
    if (IN(10)) { BUILD_TS(); p8_phase(F, opaque_args(), TS); }
#undef IN
#undef SEAM
}

extern "C" void kernel_launch(void* const* d_in, const int* in_sizes, int n_in, void* d_out, int out_size, void* d_ws, size_t ws_size, hipStream_t stream) {
    static int grid = 0;
    if (grid == 0) {
        if (n_in != 23 || in_sizes[0] != NLAT * D || out_size != NLAT * D || ws_size < WS_TOTAL) {
            fprintf(stderr, "kernel_launch: unexpected shapes: n_in %d, in0 %d, out %d, ws %zu (need %zu); nothing launched\n", n_in, n_in > 0 ? in_sizes[0] : -1, out_size, ws_size, (size_t)WS_TOTAL); grid = -1; return; }
        int dev = 0, cus = 0, per_cu = 0;
        if (hipGetDevice(&dev) != hipSuccess || hipDeviceGetAttribute(&cus, hipDeviceAttributeMultiprocessorCount, dev) != hipSuccess) { fprintf(stderr, "kernel_launch: device query failed\n"); grid = -1; return; }
        if (hipFuncSetAttribute((const void*)fwd_kernel, hipFuncAttributeMaxDynamicSharedMemorySize, LDS_BYTES) != hipSuccess) { fprintf(stderr, "kernel_launch: hipFuncSetAttribute failed\n"); grid = -1; return; }
        if (hipOccupancyMaxActiveBlocksPerMultiprocessor(&per_cu, (const void*)fwd_kernel, NTHREADS, LDS_BYTES) != hipSuccess || per_cu < 1) {
            fprintf(stderr, "kernel_launch: occupancy query reports %d workgroups per CU; nothing launched\n", per_cu); (void)hipGetLastError(); grid = -1; return; }
        grid = cus;
        if (grid > 256) grid = 256;
    }
    if (grid < 0) return;
    if (hipMemsetAsync((char*)d_ws + WS_CTL, 0, CTL_ZERO_BYTES, stream) != hipSuccess) { fprintf(stderr, "kernel_launch: hipMemsetAsync failed\n"); return; }
    Args a{};
    for (int i = 0; i < 23; ++i) a.in[i] = (const float*)d_in[i];
    a.out = (float*)d_out; a.ws = (unsigned char*)d_ws;
#if MK_N_LAUNCHES == 1
    a.ph_lo = 0; a.ph_hi = NPHASES;
    hipLaunchKernelGGL(fwd_kernel, dim3(grid), dim3(NTHREADS), LDS_BYTES, stream, a);
#else
    for (int p = 0; p < NPHASES; ++p) { a.ph_lo = p; a.ph_hi = p + 1; hipLaunchKernelGGL(fwd_kernel, dim3(grid), dim3(NTHREADS), LDS_BYTES, stream, a); }
#endif
    const hipError_t le = hipPeekAtLastError();
    if (le != hipSuccess) fprintf(stderr, "kernel_launch: launch failed: %s\n", hipGetErrorName(le));
}
```

```cpp
#include <hip/hip_runtime.h>
#include <cstdio>
#include <cstdint>

#ifndef MK_N_LAUNCHES
#define MK_N_LAUNCHES 1
#endif

#define GAS __attribute__((address_space(1)))
#define LAS __attribute__((address_space(3)))
typedef unsigned short bf16;
typedef unsigned v4u __attribute__((ext_vector_type(4)));
typedef unsigned v2u __attribute__((ext_vector_type(2)));
typedef float f32x4 __attribute__((ext_vector_type(4)));
typedef float f32x2 __attribute__((ext_vector_type(2)));
typedef short bf16x8 __attribute__((ext_vector_type(8)));
typedef short s16x4 __attribute__((ext_vector_type(4)));
#define RLX_AGENT __ATOMIC_RELAXED, __HIP_MEMORY_SCOPE_AGENT
#define LDS_WAIT() asm volatile("s_waitcnt lgkmcnt(0)" ::: "memory")
#define VM_WAIT() asm volatile("s_waitcnt vmcnt(0)" ::: "memory")
#define LDS_BARRIER() do { asm volatile("s_waitcnt lgkmcnt(0)" ::: "memory"); __builtin_amdgcn_s_barrier(); asm volatile("" ::: "memory"); } while (0)

typedef __bf16 bf16x2_t __attribute__((ext_vector_type(2)));
__device__ __forceinline__ unsigned pk2(float lo, float hi) { const f32x2 v = {lo, hi}; return __builtin_bit_cast(unsigned, __builtin_convertvector(v, bf16x2_t)); }
__device__ __forceinline__ unsigned f2bf(float f) { return (unsigned)__builtin_bit_cast(unsigned short, (__bf16)f); }
__device__ __forceinline__ unsigned pk4_fp8(float a, float b, float c, float d) { int w = __builtin_amdgcn_cvt_pk_fp8_f32(a, b, 0, false); w = __builtin_amdgcn_cvt_pk_fp8_f32(c, d, w, true); return (unsigned)w; }
__device__ __forceinline__ float bflo(unsigned w) { return __builtin_bit_cast(float, w << 16); }
__device__ __forceinline__ float bfhi(unsigned w) { return __builtin_bit_cast(float, w & 0xffff0000u); }
__device__ __forceinline__ float bf2f(bf16 b) { return __builtin_bit_cast(float, ((unsigned)b) << 16); }
__device__ __forceinline__ float fexp(float x) { return __builtin_amdgcn_exp2f(x * 1.4426950408889634f); }
__device__ __forceinline__ float wave_sum(float v) {
#pragma unroll
    for (int o = 1; o < 64; o <<= 1) v += __shfl_xor(v, o);
    return v;
}

constexpr int D = 1024, NBATCH = 16, SEQ = 4096, CTXL = 256;
constexpr int NLAT = NBATCH * SEQ;
constexpr int NCTXR = NBATCH * CTXL;
constexpr int NROWS = NLAT + NCTXR;
constexpr int PW = 3104, PWP = 3328;
constexpr int CQ = 0, CK = 256, CV = 512, CR = 1024, CAF = 1536, CAB = 1552, CPB = 1568, CPC = 2080, CPX = 2592;
constexpr int NCC = 68;
constexpr int NEXP = 32, DFF = 1024;
constexpr float EPS = 1e-6f;
constexpr int LISTCAP = 65536;
constexpr float WSCALE = 32.0f, WSCALE_INV = 1.0f / 32.0f;

#ifndef OUTPROJ_F8
#define OUTPROJ_F8 1
#endif
constexpr size_t MiB = 1u << 20;
constexpr size_t WS_CTL = 0, CTL_ZERO_BYTES = 32768;
constexpr size_t WS_MOD = 1 * MiB;
constexpr size_t WS_DECAY = 2 * MiB;
constexpr size_t WS_WIN = 6 * MiB;
constexpr size_t WS_WOUT = 13 * MiB;
constexpr size_t WS_HN = 16 * MiB;
constexpr size_t WS_KV = 16 * MiB;
constexpr size_t WS_P = 152 * MiB;
constexpr size_t WS_S = 565 * MiB;
constexpr size_t WS_YMIX = 693 * MiB;
constexpr size_t WS_Y1 = 821 * MiB;
constexpr size_t WS_ACT = 16 * MiB;
constexpr size_t WS_YA = 280 * MiB;
constexpr size_t WS_VT = 949 * MiB;
constexpr size_t WS_END = 1013 * MiB;
constexpr size_t WS_TSLOT = 1013 * MiB;
constexpr size_t WS_TW = 1015 * MiB;
constexpr size_t WS_TOTAL = 1017 * MiB;
constexpr size_t DO_WDN = 0;
constexpr size_t DO_WGU = 32 * MiB;
constexpr size_t DO_HN2 = 96 * MiB;
constexpr size_t DO_LAID = 160 * MiB;
constexpr size_t DO_LW = 168 * MiB;
static_assert(WS_P + (size_t)NROWS * PW * 2 <= WS_S && WS_YMIX + (size_t)NLAT * D * 2 <= WS_Y1 && WS_YA + (size_t)1056 * 256 * D <= WS_Y1 && WS_Y1 + (size_t)NLAT * D * 2 <= WS_VT && WS_VT + (size_t)NLAT * 512 * 2 <= WS_END, "ws map");
static_assert(WS_HN + (size_t)NROWS * D * 2 <= WS_P && WS_ACT + (size_t)1056 * 256 * 1024 <= WS_YA && DO_LW + (size_t)NEXP * LISTCAP * 4 <= (size_t)NLAT * D * 4, "ws map 2");
constexpr int CW_CNT = 64;
constexpr int CW_BAR = 4096;

constexpr int RING_BYTES = 131072;
constexpr int MISC_OFF = RING_BYTES;
constexpr int LDS_BYTES = 147456;
constexpr int NWAVES = 8, NTHREADS = 512;

namespace pg8 {
constexpr int BM = 256, BK = 64, HALF = 128, HTB = HALF * BK * 2, STAGE_BYTES = 8 * HTB;
constexpr int BIAS_OFF = 131072 + 8192;
__host__ __device__ __forceinline__ int lds_byte(int r, int c) { const int st = (r >> 4) * 2 + (c >> 5), rr = r & 15, cc = c & 31, ob = rr * 64 + cc * 2; return st * 1024 + (ob ^ (((ob >> 9) & 1) << 5)); }
__host__ __device__ __forceinline__ void stage_rc(int b, int& R, int& C) { const int st = b / 1024, sb = b % 1024, swz = sb ^ (((sb >> 9) & 1) << 5); R = (st >> 1) * 16 + swz / 64; C = (st & 1) * 32 + (swz % 64) / 2; }
__host__ __device__ __forceinline__ int perm32(int rho) { const int n = rho >> 4, i = rho & 15; return 8 * (i >> 2) + 4 * n + (i & 3); }

typedef int v8i __attribute__((ext_vector_type(8)));
typedef int v4i __attribute__((ext_vector_type(4)));
__device__ __forceinline__ v8i cat8(bf16x8 lo, bf16x8 hi) { return __builtin_shufflevector(__builtin_bit_cast(v4i, lo), __builtin_bit_cast(v4i, hi), 0, 1, 2, 3, 4, 5, 6, 7); }
struct Unit { int pm, pn, e, lt; };
__device__ __forceinline__ unsigned cvt_pk_bf16(float lo, float hi) { unsigned r; asm volatile("v_cvt_pk_bf16_f32 %0, %1, %2" : "=v"(r) : "v"(lo), "v"(hi)); return r; }

template <class Epi, class Sched, bool ALIGN_EPI, bool F8>
__device__ __forceinline__ void gemm_phase(LAS unsigned char* lds, const char* Abase, const Sched& S, const Epi& E) {
    int tid_ = threadIdx.x; asm volatile("" : "+v"(tid_));
    const int tid = tid_, wid = __builtin_amdgcn_readfirstlane(tid >> 6), lane = tid & 63, wr = wid >> 2, wc = wid & 3, fr = lane & 15, fq = lane >> 4;
    constexpr int KB = F8 ? 1024 : 2048, NT = KB / 128;
    unsigned voffB[2];
#pragma unroll
    for (int i = 0; i < 2; ++i) { int R, C; stage_rc(tid * 16 + i * 8192, R, C); const int Rb = Epi::PERM ? ((R & ~31) + perm32(R & 31)) : R; voffB[i] = (unsigned)(Rb * KB + C * 2); }
#define PG8_AROWS(u_, dst_) do { _Pragma("unroll") for (int h_ = 0; h_ < 2; ++h_) _Pragma("unroll") for (int i_ = 0; i_ < 2; ++i_) { int R_, C_; stage_rc(tid * 16 + i_ * 8192, R_, C_); \
        dst_[h_][i_] = (unsigned)S.arow(u_, h_ * HALF + R_); } } while (0)
#define PG8_AOFF2(dst_) do { _Pragma("unroll") for (int h_ = 0; h_ < 2; ++h_) _Pragma("unroll") for (int i_ = 0; i_ < 2; ++i_) { int R_, C_; stage_rc(tid * 16 + i_ * 8192, R_, C_); \
        dst_[h_][i_] = dst_[h_][i_] * (unsigned)KB + (unsigned)C_ * 2u; } } while (0)
    const size_t kstep = (size_t)(BK * 2);
    const size_t hstep = (size_t)HALF * KB;
    const unsigned ldsw = (unsigned)wid * 1024u;
    const int aoff = lds_byte(wr * 64 + fr, fq * 8), boff = lds_byte(wc * 32 + fr, fq * 8);
#define PG8_SA(b, h) (((b) * 2 + (h)) * HTB)
#define PG8_SB(b, h) ((4 + (b) * 2 + (h)) * HTB)
#define PG8_STAGE(bufoff, gbase, voff) do { _Pragma("unroll") for (int _i = 0; _i < 2; ++_i) \
        __builtin_amdgcn_global_load_lds((const unsigned*)((const char*)(gbase) + (voff)[_i]), (LAS unsigned*)(lds + (bufoff) + ldsw + _i * 8192), 16, 0, 0); } while (0)
#define PG8_LDA(dst, b, h) do { _Pragma("unroll") for (int m = 0; m < 4; ++m) _Pragma("unroll") for (int k = 0; k < 2; ++k) dst[m][k] = *(const LAS bf16x8*)(lds + PG8_SA(b, h) + aoff + m * 2048 + k * 1024); } while (0)
#define PG8_LDB(dst, b, h) do { _Pragma("unroll") for (int n = 0; n < 2; ++n) _Pragma("unroll") for (int k = 0; k < 2; ++k) dst[n][k] = *(const LAS bf16x8*)(lds + PG8_SB(b, h) + boff + n * 2048 + k * 1024); } while (0)
#define PG8_MMA(ai, bj, At, Bt) do { if (skipmma && ((bj) == 1 || wc > 0)) break; __builtin_amdgcn_s_setprio(1); _Pragma("unroll") for (int m = 0; m < 4; ++m) _Pragma("unroll") for (int n = 0; n < 2; ++n) { \
        if constexpr (F8) { asm volatile("v_mfma_f32_16x16x128_f8f6f4 %0, %1, %2, %0" : "+v"(acc[ai][bj][m][n]) : "v"(cat8(Bt[n][0], Bt[n][1])), "v"(cat8(At[m][0], At[m][1]))); } \
        else { _Pragma("unroll") for (int k = 0; k < 2; ++k) acc[ai][bj][m][n] = __builtin_amdgcn_mfma_f32_16x16x32_bf16(Bt[n][k], At[m][k], acc[ai][bj][m][n], 0, 0, 0); } } \
        __builtin_amdgcn_s_setprio(0); } while (0)
#define PG8_WAIT_V(n) asm volatile("s_waitcnt vmcnt(" #n ")" ::: "memory")
#define PG8_WAIT_L(n) asm volatile("s_waitcnt lgkmcnt(" #n ")" ::: "memory")
#define PG8_BAR __builtin_amdgcn_s_barrier()
#define PG8_SCHED __builtin_amdgcn_sched_barrier(0)
    Unit cur, nxt; int ui = 0;
    if (!S.next(0, cur)) return;
    f32x4 acc[2][2][4][2];
#pragma unroll
    for (int a = 0; a < 2; ++a)
#pragma unroll
        for (int b = 0; b < 2; ++b)
#pragma unroll
            for (int m = 0; m < 4; ++m)
#pragma unroll
                for (int n = 0; n < 2; ++n) acc[a][b][m][n] = (f32x4){0.f, 0.f, 0.f, 0.f};
    bf16x8 At[4][2], B0[2][2], B1[2][2];
    unsigned oC[2][2];
    PG8_AROWS(cur, oC); PG8_AOFF2(oC);
    unsigned rN[2] = {0u, 0u};
    const char* cB = S.bptr(cur);
    PG8_STAGE(PG8_SB(0, 0), cB, voffB); PG8_STAGE(PG8_SB(0, 1), cB + hstep, voffB); PG8_STAGE(PG8_SA(0, 0), Abase, oC[0]); PG8_STAGE(PG8_SA(0, 1), Abase, oC[1]);
    if (wr == 1) PG8_BAR;
    PG8_WAIT_V(2); PG8_BAR;
    PG8_STAGE(PG8_SB(1, 0), cB + kstep, voffB); PG8_STAGE(PG8_SA(1, 0), Abase + kstep, oC[0]); PG8_STAGE(PG8_SB(1, 1), cB + hstep + kstep, voffB);
    PG8_WAIT_V(6); PG8_BAR;
    for (;;) {
        const bool skipmma = S.mostly_padding(cur);
        const bool has_next = S.next(ui + 1, nxt);
        if (!has_next) nxt = cur;
        if constexpr (Epi::LBIAS) { if (wid == 0) __builtin_amdgcn_global_load_lds((const unsigned*)(E.bias_src(cur) + lane * 16), (LAS unsigned*)(lds + BIAS_OFF + (ui & 1) * 1024), 16, 0, 0); }
        const char* nB = S.bptr(nxt);
        for (int t = 0; t < NT; t += 2) {
            const bool last = (t == NT - 2);
            const char* ka1 = Abase + (size_t)(t + 1) * kstep;
            const char* ka2 = last ? Abase : Abase + (size_t)(t + 2) * kstep; const char* b2 = last ? nB : cB + (size_t)(t + 2) * kstep;
            const char* ka3 = ka2 + kstep; const char* b3 = b2 + kstep;
            PG8_LDB(B0, 0, 0); PG8_LDB(B1, 0, 1); PG8_SCHED; PG8_LDA(At, 0, 0); PG8_STAGE(PG8_SA(1, 1), ka1, oC[1]);
            PG8_WAIT_V(8); PG8_WAIT_L(0); PG8_BAR; PG8_MMA(0, 0, At, B0); PG8_MMA(0, 1, At, B1); PG8_BAR; PG8_SCHED;
            if constexpr (Sched::GATHER) { if (t == NT - 4) { unsigned r4[2][2]; PG8_AROWS(nxt, r4); rN[0] = r4[0][0] | (r4[0][1] << 16); rN[1] = r4[1][0] | (r4[1][1] << 16); } }
            if (last) {
                if constexpr (Sched::GATHER) { oC[0][0] = rN[0] & 0xffffu; oC[0][1] = rN[0] >> 16; oC[1][0] = rN[1] & 0xffffu; oC[1][1] = rN[1] >> 16; }
                else { PG8_AROWS(nxt, oC); }
                PG8_AOFF2(oC); }
            PG8_LDA(At, 0, 1); PG8_STAGE(PG8_SB(0, 0), b2, voffB); PG8_STAGE(PG8_SB(0, 1), b2 + hstep, voffB); PG8_STAGE(PG8_SA(0, 0), ka2, oC[0]);
            PG8_WAIT_V(8); PG8_WAIT_L(0); PG8_BAR; PG8_MMA(1, 0, At, B0); PG8_MMA(1, 1, At, B1); PG8_BAR; PG8_SCHED;
            PG8_LDB(B0, 1, 0); PG8_LDB(B1, 1, 1); PG8_SCHED; PG8_LDA(At, 1, 0); PG8_STAGE(PG8_SA(0, 1), ka2, oC[1]);
            PG8_WAIT_V(8); PG8_WAIT_L(0); PG8_BAR; PG8_MMA(0, 0, At, B0); PG8_MMA(0, 1, At, B1); PG8_BAR; PG8_SCHED;
            PG8_LDA(At, 1, 1); PG8_STAGE(PG8_SB(1, 0), b3, voffB); PG8_STAGE(PG8_SB(1, 1), b3 + hstep, voffB); PG8_STAGE(PG8_SA(1, 0), ka3, oC[0]);
            PG8_WAIT_V(8); PG8_WAIT_L(0); PG8_BAR; PG8_MMA(1, 0, At, B0); PG8_MMA(1, 1, At, B1); PG8_BAR; PG8_SCHED;
        }
        if constexpr (ALIGN_EPI) { if (wr == 0) PG8_BAR; }
        if constexpr (F8) asm volatile("s_nop 15\n\ts_nop 7" ::: "memory");
        { int fr_o = fr, fq_o = fq; asm volatile("" : "+v"(fr_o), "+v"(fq_o));
          E(acc, cur, wr, wc, fr_o, fq_o, (const LAS float*)(lds + BIAS_OFF + (ui & 1) * 1024)); }
        if (!has_next) break;
#pragma unroll
        for (int a = 0; a < 2; ++a)
#pragma unroll
            for (int b = 0; b < 2; ++b)
#pragma unroll
                for (int m = 0; m < 4; ++m)
#pragma unroll
                    for (int n = 0; n < 2; ++n) acc[a][b][m][n] = (f32x4){0.f, 0.f, 0.f, 0.f};
        cur = nxt; cB = nB; ++ui;
        if constexpr (ALIGN_EPI) { if (wr == 1) PG8_BAR; }
    }
    PG8_WAIT_V(0);
    if constexpr (!ALIGN_EPI) { if (wr == 0) PG8_BAR; }
    PG8_BAR;
#undef PG8_AROWS
#undef PG8_AOFF2
#undef PG8_SA
#undef PG8_SB
#undef PG8_STAGE
#undef PG8_LDA
#undef PG8_LDB
#undef PG8_MMA
#undef PG8_WAIT_V
#undef PG8_WAIT_L
#undef PG8_BAR
#undef PG8_SCHED
}
}

#define XB_TMO      128
#define XB_XCNT(j)  (256  + 64 * (j))
#define XB_XSUB(j)  (1280 + 64 * (j))
#define XB_XGEN(j)  (2304 + 64 * (j))
#define XB_TOP      3328
#define XB_TOPGEN   3392
#define XCD_BAR_WORDS 3456
#define XB_SPIN_CAP (1u << 22)
__device__ __forceinline__ unsigned xb_ld(unsigned* p)              { return __hip_atomic_load(p, __ATOMIC_RELAXED, __HIP_MEMORY_SCOPE_AGENT); }
__device__ __forceinline__ unsigned xb_add(unsigned* p, unsigned v) { return __hip_atomic_fetch_add(p, v, __ATOMIC_RELAXED, __HIP_MEMORY_SCOPE_AGENT); }
__device__ __forceinline__ unsigned xb_xcc_id() { return (unsigned)__builtin_amdgcn_s_getreg((3 << 11) | 20) & 0xFu; }
#define XB_SPIN(cond, bar) do { unsigned _sp = 0; while (cond) { __builtin_amdgcn_s_sleep(1); \
    if ((++_sp & 255u) == 0u) { if (xb_ld(&(bar)[XB_TMO])) break; if (_sp > XB_SPIN_CAP) { atomicAdd(&(bar)[XB_TMO], 1u); break; } } } } while (0)
struct XcdBarrier { unsigned* bar; unsigned x; volatile LAS unsigned* st; };
__device__ __forceinline__ XcdBarrier xcd_barrier_post(unsigned* bar, volatile LAS unsigned* st) {
    XcdBarrier b; b.bar = bar; b.x = xb_xcc_id(); b.st = st;
    if (threadIdx.x == 0) (void)xb_add(&bar[XB_XCNT(b.x)], 1u);
    return b;
}
__device__ __forceinline__ void xcd_barrier_complete(unsigned* bar, unsigned x, unsigned& nloc, unsigned& nx) {
    const unsigned G = gridDim.x * gridDim.y * gridDim.z;
    unsigned sum, cnt, mine, sp = 0u;
    for (;;) {
        sum = 0u; cnt = 0u; mine = 0u;
#pragma unroll 1
        for (unsigned j = 0; j < 16; ++j) { const unsigned c = xb_ld(&bar[XB_XCNT(j)]); sum += c; cnt += (c > 0u) ? 1u : 0u; mine = (j == x) ? c : mine; }
        if (sum == G) break;
        __builtin_amdgcn_s_sleep(1);
        if ((++sp & 255u) == 0u) { if (xb_ld(&bar[XB_TMO])) break; if (sp > XB_SPIN_CAP) { atomicAdd(&bar[XB_TMO], 1u); break; } }
    }
    nloc = mine > 0u ? mine : 1u; nx = cnt > 0u ? cnt : 1u;
}
__device__ __forceinline__ void xcd_barrier(const XcdBarrier& b) {
    asm volatile("s_waitcnt vmcnt(0)" ::: "memory");
    __syncthreads();
    if (threadIdx.x == 0) {
        unsigned* bar = b.bar;
        __builtin_amdgcn_s_waitcnt(0);
        unsigned nloc = b.st[0], nx = b.st[1];
        if (nloc == 0u) { xcd_barrier_complete(bar, b.x, nloc, nx); b.st[0] = nloc; b.st[1] = nx; }
        const unsigned old = xb_add(&bar[XB_XSUB(b.x)], 1u);
        const unsigned gen = old / nloc;
        if (old + 1u == (gen + 1u) * nloc) {
            __builtin_amdgcn_fence(__ATOMIC_RELEASE, "agent");
            asm volatile("s_waitcnt vmcnt(0)" ::: "memory");
            const unsigned og = xb_add(&bar[XB_TOP], 1u);
            const unsigned tg = og / nx;
            if (og + 1u == (tg + 1u) * nx) xb_add(&bar[XB_TOPGEN], 1u);
            else XB_SPIN(xb_ld(&bar[XB_TOPGEN]) == tg, bar);
            __builtin_amdgcn_fence(__ATOMIC_ACQUIRE, "agent");
            xb_add(&bar[XB_XGEN(b.x)], 1u);
            asm volatile("s_waitcnt vmcnt(0)" ::: "memory");
        } else {
            XB_SPIN(xb_ld(&bar[XB_XGEN(b.x)]) == gen, bar);
            __builtin_amdgcn_fence(__ATOMIC_ACQUIRE, "agent");
            asm volatile("s_waitcnt vmcnt(0)" ::: "memory");
        }
    }
    __syncthreads();
}

struct Args { const float* in[23]; float* out; unsigned char* ws; int ph_lo, ph_hi; };
typedef const Args __attribute__((address_space(4))) CArgs;
__device__ __forceinline__ CArgs* opaque_args() { CArgs* p = (CArgs*)__builtin_amdgcn_kernarg_segment_ptr(); asm volatile("" : "+s"(p)); return p; }
struct Frame {
    LAS unsigned char* lds;
    int tid, lane, wave, G, bid;
    float* out; unsigned char* ws;
};

struct EpiNull {
    static constexpr bool PERM = true, LBIAS = false;
    __device__ __forceinline__ void operator()(const f32x4 (&acc)[2][2][4][2], const pg8::Unit&, int, int, int, int, const LAS float*) const {
#pragma unroll
        for (int a = 0; a < 2; ++a)
#pragma unroll
            for (int b = 0; b < 2; ++b)
#pragma unroll
                for (int m = 0; m < 4; ++m)
#pragma unroll
                    for (int n = 0; n < 2; ++n) asm volatile("" :: "v"(acc[a][b][m][n]));
    }
};
struct DenseSched {
    static constexpr bool GATHER = false;
    int nM, nN, nwg, G, c, kb; const char* Bt; const LAS int* UT;
    __device__ __forceinline__ void init(int M, int N, int G_, int c_, const void* Bt_) { nM = M / 256; nN = N / 256; nwg = nM * nN; G = G_; c = c_; Bt = (const char*)Bt_; UT = nullptr; kb = 2048; }
    __device__ __forceinline__ void build(LAS int* ut, int tid) { if (tid < 32) { pg8::Unit u; ut[tid] = next_calc(tid, u) ? (u.pm | (u.pn << 16)) : -1; } UT = ut; __syncthreads(); }
    __device__ __forceinline__ bool next(int i, pg8::Unit& u) const { const int w = (i < 32) ? UT[i] : -1; if (w < 0) return false; u.pm = w & 0xffff; u.pn = w >> 16; u.e = 0; u.lt = 0; return true; }
    __device__ __forceinline__ bool next_calc(int i, pg8::Unit& u) const {
        const long L = (long)i * G + c; if (L >= nwg) return false;
        int wgid = (int)L; { const int q = nwg / 8, r = nwg % 8, xcd = wgid % 8, off = wgid / 8; wgid = (xcd < r ? xcd * (q + 1) : r * (q + 1) + (xcd - r) * q) + off; }
        const int nig = 8 * nN, gid = wgid / nig, fm = gid * 8, gsz = (nM - fm) < 8 ? (nM - fm) : 8;
        u.pm = fm + ((wgid % nig) % gsz); u.pn = (wgid % nig) / gsz; u.e = 0; u.lt = 0; return true;
    }
    __device__ __forceinline__ int arow(const pg8::Unit& u, int r) const { return u.pm * 256 + r; }
    __device__ __forceinline__ bool mostly_padding(const pg8::Unit& u) const { return nN == PWP / 256 && u.pn == nN - 1; }
    __device__ __forceinline__ const char* bptr(const pg8::Unit& u) const { return Bt + (size_t)u.pn * 256 * kb; }
};
struct EpiProj {
    static constexpr bool PERM = true, LBIAS = false;
    bf16* O;
    __device__ __forceinline__ void operator()(const f32x4 (&acc)[2][2][4][2], const pg8::Unit& u, int wr, int wc, int fr, int fq, const LAS float*) const {
        const int row0 = u.pm * 256 + wr * 64 + fr, col0 = u.pn * 256 + wc * 32 + 8 * fq;
#pragma unroll
        for (int ai = 0; ai < 2; ++ai)
#pragma unroll
            for (int m = 0; m < 4; ++m) { bf16* rowp = O + (size_t)(row0 + ai * 128 + m * 16) * PW + col0;
#pragma unroll
                for (int bj = 0; bj < 2; ++bj) { if (col0 + bj * 128 < PW) { const f32x4 v0 = acc[ai][bj][m][0], v1 = acc[ai][bj][m][1];
                    v4u w; w.x = pk2(v0[0], v0[1]); w.y = pk2(v0[2], v0[3]); w.z = pk2(v1[0], v1[1]); w.w = pk2(v1[2], v1[3]);
                    *(v4u*)(rowp + bj * 128) = w; } } }
    }
};
struct EpiOut {
    static constexpr bool PERM = true, LBIAS = true;
    const float* x; const float* mod; bf16* Y1; float sc;
    __device__ __forceinline__ const char* bias_src(const pg8::Unit& u) const { return (const char*)(mod + (size_t)(u.pm >> 4) * 6144 + 2048 + u.pn * 256); }
    __device__ __forceinline__ void operator()(const f32x4 (&acc)[2][2][4][2], const pg8::Unit& u, int wr, int wc, int fr, int fq, const LAS float* bl) const {
        const int row0 = u.pm * 256 + wr * 64 + fr, col0 = u.pn * 256 + wc * 32 + 8 * fq;
        f32x4 gv[2][2];
#pragma unroll
        for (int bj = 0; bj < 2; ++bj)
#pragma unroll
            for (int n = 0; n < 2; ++n) gv[bj][n] = *(const LAS f32x4*)(bl + wc * 32 + 8 * fq + bj * 128 + 4 * n) * sc;
#pragma unroll
        for (int ai = 0; ai < 2; ++ai)
#pragma unroll
            for (int m = 0; m < 4; ++m) { const size_t off = (size_t)(row0 + ai * 128 + m * 16) * D + col0; bf16* rowp = Y1 + off;
#pragma unroll
                for (int bj = 0; bj < 2; ++bj) { const f32x4 x0 = *(const f32x4*)(x + off + bj * 128), x1 = *(const f32x4*)(x + off + bj * 128 + 4);
                    const f32x4 v0 = x0 + acc[ai][bj][m][0] * gv[bj][0], v1 = x1 + acc[ai][bj][m][1] * gv[bj][1];
                    v4u w; w.x = pk2(v0[0], v0[1]); w.y = pk2(v0[2], v0[3]); w.z = pk2(v1[0], v1[1]); w.w = pk2(v1[2], v1[3]);
                    *(v4u*)(rowp + bj * 128) = w; } }
    }
};
template <bool GU> struct MoeSched {
    static constexpr bool GATHER = GU;
    static constexpr bool gu = GU;
    const LAS int* TS; int ntr, G, c; const int* laid; const char* W;
    __device__ __forceinline__ bool next(int i, pg8::Unit& u) const {
        const int x = c & 7, j = c >> 3; int tl, pn;
        if (G != 256) { const int L = i * G + c, npn = gu ? 8 : 4; tl = L / npn; pn = L % npn; }
        else if (gu) { tl = (i * 8 + x) * 4 + (j >> 3); pn = j & 7; } else { tl = (i * 8 + x) * 8 + (j >> 2); pn = j & 3; }
        if (tl >= ntr) return false;
        const int tau = tl; const int e = ((const LAS unsigned char*)(TS + 72))[tau];
        u.pm = tl; u.pn = pn; u.e = e; u.lt = tau - TS[e]; return true;
    }
    __device__ __forceinline__ bool mostly_padding(const pg8::Unit&) const { return false; }
    __device__ __forceinline__ int arow(const pg8::Unit& u, int r) const {
        if (!gu) return u.pm * 256 + r;
        const int pos = u.lt * 256 + r, cnt = TS[33 + u.e];
        return pos < cnt ? (laid[(size_t)u.e * LISTCAP + pos] >> 2) : 0;
    }
    __device__ __forceinline__ const char* bptr(const pg8::Unit& u) const { return W + ((size_t)u.e * (gu ? 2048 : 1024) + (size_t)u.pn * 256) * 1024; }
};
struct EpiGU {
    static constexpr bool PERM = true, LBIAS = true;
    unsigned char* ACT; const float* b_gu;
    __device__ __forceinline__ const char* bias_src(const pg8::Unit& u) const { return (const char*)(b_gu + (size_t)u.e * 2048 + u.pn * 256); }
    __device__ __forceinline__ void operator()(const f32x4 (&acc)[2][2][4][2], const pg8::Unit& u, int wr, int wc, int fr, int fq, const LAS float* bl) const {
        const int row0 = u.pm * 256 + wr * 64 + fr, j0 = u.pn * 128 + wc * 32 + 8 * fq;
        const LAS float* bp = bl + 2 * (wc * 32 + 8 * fq);
        f32x4 bv[4];
#pragma unroll
        for (int q = 0; q < 4; ++q) bv[q] = *(const LAS f32x4*)(bp + 4 * q);
        f32x2 bg[4], bu[4];
#pragma unroll
        for (int q = 0; q < 4; ++q) { bg[q] = (f32x2){bv[q][0], bv[q][2]}; bu[q] = (f32x2){bv[q][1], bv[q][3]}; }
#pragma unroll
        for (int ai = 0; ai < 2; ++ai)
#pragma unroll
            for (int m = 0; m < 4; ++m) { unsigned char* rowp = ACT + (size_t)(row0 + ai * 128 + m * 16) * DFF + j0; f32x2 a[4];
#pragma unroll
                for (int n = 0; n < 2; ++n)
#pragma unroll
                    for (int p = 0; p < 2; ++p) { const int q = 2 * n + p;
                        const f32x4 ag = acc[ai][0][m][n], au = acc[ai][1][m][n];
                        f32x2 g = (f32x2){ag[2 * p], ag[2 * p + 1]} * WSCALE_INV + bg[q], up = (f32x2){au[2 * p], au[2 * p + 1]} * WSCALE_INV + bu[q];
                        g.x = fminf(g.x, 7.0f); g.y = fminf(g.y, 7.0f); up.x = __builtin_amdgcn_fmed3f(up.x, -7.0f, 7.0f); up.y = __builtin_amdgcn_fmed3f(up.y, -7.0f, 7.0f);
                        const f32x2 t = g * (-1.702f * 1.4426950408889634f); f32x2 e; e.x = __builtin_amdgcn_exp2f(t.x); e.y = __builtin_amdgcn_exp2f(t.y);
                        const f32x2 d = e + 1.0f; f32x2 sg; sg.x = __builtin_amdgcn_rcpf(d.x); sg.y = __builtin_amdgcn_rcpf(d.y);
                        a[q] = ((up + 1.0f) * g) * sg; }
                v2u w; w.x = pk4_fp8(a[0].x, a[0].y, a[1].x, a[1].y); w.y = pk4_fp8(a[2].x, a[2].y, a[3].x, a[3].y);
                *(v2u*)rowp = w; }
    }
};
struct EpiDN {
    static constexpr bool PERM = true, LBIAS = true;
    unsigned char* YA; const float* b_dn; const LAS int* TS;
    __device__ __forceinline__ const char* bias_src(const pg8::Unit& u) const { return (const char*)(b_dn + (size_t)u.e * D + u.pn * 256); }
    __device__ __forceinline__ void operator()(const f32x4 (&acc)[2][2][4][2], const pg8::Unit& u, int wr, int wc, int fr, int fq, const LAS float* bl) const {
        const int col0 = u.pn * 256 + wc * 32 + 8 * fq, cnt = TS[33 + u.e];
        f32x4 bv[2][2];
#pragma unroll
        for (int bj = 0; bj < 2; ++bj)
#pragma unroll
            for (int n = 0; n < 2; ++n) bv[bj][n] = *(const LAS f32x4*)(bl + wc * 32 + 8 * fq + bj * 128 + 4 * n);
#pragma unroll
        for (int ai = 0; ai < 2; ++ai)
#pragma unroll
            for (int m = 0; m < 4; ++m) { const int r = ai * 128 + wr * 64 + m * 16 + fr;
                if (u.lt * 256 + r < cnt) { unsigned char* rowp = YA + ((size_t)u.pm * 256 + r) * D + col0;
#pragma unroll
                    for (int bj = 0; bj < 2; ++bj) { const f32x4 v0 = acc[ai][bj][m][0] * WSCALE_INV + bv[bj][0], v1 = acc[ai][bj][m][1] * WSCALE_INV + bv[bj][1];
                        v2u w; w.x = pk4_fp8(v0[0], v0[1], v0[2], v0[3]); w.y = pk4_fp8(v1[0], v1[1], v1[2], v1[3]);
                        *(v2u*)(rowp + bj * 128) = w; } }
                asm volatile("" ::: "memory"); }
    }
};

template <bool MAPGU>
__device__ __forceinline__ void p0_transpose_item(const float* W, int N, bf16* WT, LAS float* scr, int item, int lane) {
    const int nblk = N / 32, kb = item / nblk, nb = item % nblk, k0 = 64 * kb, n0 = 32 * nb;
#pragma unroll
    for (int i = 0; i < 32; ++i) { const int kk = 2 * i + (lane >> 5); scr[kk * 33 + (lane & 31)] = W[(size_t)(k0 + kk) * N + n0 + (lane & 31)]; }
    LDS_WAIT(); asm volatile("" ::: "memory");
    const int c = lane & 7;
#pragma unroll
    for (int j = 0; j < 4; ++j) { const int n = (lane >> 3) + 8 * j; const LAS float* s = scr + (8 * c) * 33 + n;
        v4u o; o.x = pk2(s[0 * 33], s[1 * 33]); o.y = pk2(s[2 * 33], s[3 * 33]); o.z = pk2(s[4 * 33], s[5 * 33]); o.w = pk2(s[6 * 33], s[7 * 33]);
        int row = n0 + n;
        if (MAPGU) { const int jj = row >> 1; row = (jj >> 7) * 256 + (row & 1) * 128 + (jj & 127); }
        *(v4u*)(WT + (size_t)row * D + k0 + 8 * c) = o; }
    LDS_WAIT(); asm volatile("" ::: "memory");
}
template <bool MAPGU>
__device__ __forceinline__ void p0_transpose_item_f8(const float* W, int N, unsigned char* WT, LAS float* scr, int item, int lane) {
    const int nblk = N / 32, kb = item / nblk, nb = item % nblk, k0 = 64 * kb, n0 = 32 * nb;
#pragma unroll
    for (int i = 0; i < 32; ++i) { const int kk = 2 * i + (lane >> 5); scr[kk * 33 + (lane & 31)] = W[(size_t)(k0 + kk) * N + n0 + (lane & 31)] * WSCALE; }
    LDS_WAIT(); asm volatile("" ::: "memory");
    const int c = lane & 3;
#pragma unroll
    for (int j = 0; j < 2; ++j) { const int n = (lane >> 2) + 16 * j; const LAS float* s = scr + (16 * c) * 33 + n;
        v4u o; o.x = pk4_fp8(s[0 * 33], s[1 * 33], s[2 * 33], s[3 * 33]); o.y = pk4_fp8(s[4 * 33], s[5 * 33], s[6 * 33], s[7 * 33]);
        o.z = pk4_fp8(s[8 * 33], s[9 * 33], s[10 * 33], s[11 * 33]); o.w = pk4_fp8(s[12 * 33], s[13 * 33], s[14 * 33], s[15 * 33]);
        int row = n0 + n;
        if (MAPGU) { const int jj = row >> 1; row = (jj >> 7) * 256 + (row & 1) * 128 + (jj & 127); }
        *(v4u*)(WT + (size_t)row * D + k0 + 16 * c) = o; }
    LDS_WAIT(); asm volatile("" ::: "memory");
}
constexpr int P0_TS = 144;
struct P0Item { const float* W; void* O; int N, k0, n0, kind; };
__device__ __forceinline__ P0Item p0_item(const Frame& F, CArgs* A, int it) {
    constexpr int I_IN = 8 * 25, I_OUT = 8 * 8, I_GU = 8 * 16, I_DN = 8 * 8;
    P0Item r; int x = it;
    if (x < I_IN) { r.W = A->in[7]; r.O = (void*)(F.ws + WS_WIN); r.N = PW; r.k0 = (x / 25) * 128; r.n0 = (x % 25) * 128; r.kind = 0; return r; } x -= I_IN;
    if (x < I_OUT) { r.W = A->in[14]; r.O = (void*)(F.ws + WS_WOUT); r.N = D; r.k0 = (x >> 3) * 128; r.n0 = (x & 7) * 128; r.kind = OUTPROJ_F8 ? 1 : 0; return r; } x -= I_OUT;
    if (x < NEXP * I_GU) { const int e = x / I_GU, y = x % I_GU; r.W = A->in[18] + (size_t)e * D * 2048; r.O = (void*)((unsigned char*)F.out + DO_WGU + (size_t)e * 2048 * D); r.N = 2048; r.k0 = (y >> 4) * 128; r.n0 = (y & 15) * 128; r.kind = 2; return r; } x -= NEXP * I_GU;
    { const int e = x / I_DN, y = x % I_DN; r.W = A->in[20] + (size_t)e * D * D; r.O = (void*)((unsigned char*)F.out + DO_WDN + (size_t)e * D * D); r.N = D; r.k0 = (y >> 3) * 128; r.n0 = (y & 7) * 128; r.kind = 1; return r; }
}
__device__ __forceinline__ void p0_load(const P0Item& I, int tid, f32x4 (&v)[8]) {
#pragma unroll
    for (int q = 0; q < 8; ++q) { const int idx = tid + NTHREADS * q, k = idx >> 5, col = I.n0 + 4 * (idx & 31);
        v[q] = (col < I.N) ? *(const f32x4*)(I.W + (size_t)(I.k0 + k) * I.N + col) : (f32x4){0.f, 0.f, 0.f, 0.f}; }
}
__device__ __forceinline__ void p0_emit(const P0Item& I, LAS unsigned char* lds, int wave, int i, int g) {
    const unsigned a0 = (unsigned)(uintptr_t)lds + (unsigned)(((32 * g + (i >> 2)) * P0_TS + 16 * wave + 4 * (i & 3)) * 2);
    s16x4 r[8];
    asm volatile("ds_read_b64_tr_b16 %0, %8\n\tds_read_b64_tr_b16 %1, %8 offset:1152\n\tds_read_b64_tr_b16 %2, %8 offset:2304\n\tds_read_b64_tr_b16 %3, %8 offset:3456\n\t"
                 "ds_read_b64_tr_b16 %4, %8 offset:4608\n\tds_read_b64_tr_b16 %5, %8 offset:5760\n\tds_read_b64_tr_b16 %6, %8 offset:6912\n\tds_read_b64_tr_b16 %7, %8 offset:8064\n\ts_waitcnt lgkmcnt(0)"
                 : "=&v"(r[0]), "=&v"(r[1]), "=&v"(r[2]), "=&v"(r[3]), "=&v"(r[4]), "=&v"(r[5]), "=&v"(r[6]), "=&v"(r[7]) : "v"(a0) : "memory");
    const int n = I.n0 + 16 * wave + i;
    if (n < I.N) {
        if (I.kind == 0) { bf16* op = (bf16*)I.O + (size_t)n * D + I.k0 + 32 * g;
#pragma unroll
            for (int q = 0; q < 4; ++q) { v4u w; w.x = (unsigned)(unsigned short)r[2 * q][0] | ((unsigned)(unsigned short)r[2 * q][1] << 16); w.y = (unsigned)(unsigned short)r[2 * q][2] | ((unsigned)(unsigned short)r[2 * q][3] << 16);
                w.z = (unsigned)(unsigned short)r[2 * q + 1][0] | ((unsigned)(unsigned short)r[2 * q + 1][1] << 16); w.w = (unsigned)(unsigned short)r[2 * q + 1][2] | ((unsigned)(unsigned short)r[2 * q + 1][3] << 16);
                *(v4u*)(op + 8 * q) = w; } }
        else { int row = n; if (I.kind == 2) { const int jj = n >> 1; row = (jj >> 7) * 256 + (n & 1) * 128 + (jj & 127); }
            unsigned char* op = (unsigned char*)I.O + (size_t)row * D + I.k0 + 32 * g;
#pragma unroll
            for (int q = 0; q < 2; ++q) { v4u w; unsigned* wp = (unsigned*)&w;
#pragma unroll
                for (int j = 0; j < 4; ++j) { const s16x4 x = r[4 * q + j]; wp[j] = pk4_fp8(bf2f((bf16)x[0]) * WSCALE, bf2f((bf16)x[1]) * WSCALE, bf2f((bf16)x[2]) * WSCALE, bf2f((bf16)x[3]) * WSCALE); }
                *(v4u*)(op + 16 * q) = w; } } }
}
__device__ __forceinline__ void p0_phase(const Frame& F, CArgs* A) {
    LAS unsigned char* lds = F.lds; const int tid = F.tid, lane = F.lane, wave = F.wave, i = lane & 15, g = lane >> 4;
    constexpr int NITEMS = 8 * 25 + 8 * 8 + NEXP * 8 * 16 + NEXP * 8 * 8;
    { v4u z = {0u, 0u, 0u, 0u}; v4u* p = (v4u*)(((bf16*)(F.ws + WS_WIN)) + (size_t)PW * D); const int n16 = (PWP - PW) * D * 2 / 16;
      for (int i = F.bid * NTHREADS + F.tid; i < n16; i += F.G * NTHREADS) p[i] = z; }
    __syncthreads();
    LAS float* sl = (LAS float*)F.lds;
    LAS float* red = (LAS float*)(F.lds + 1024 * 20 * 4);
    bool filled = false;
    for (int it = F.bid; it < 6144 / 64; it += F.G) {
        if (!filled) {
            for (int i = F.tid; i < 17 * 1024; i += NTHREADS) { const int m = i >> 10, k = i & 1023; const float v = (m < 16) ? A->in[1][m * 1024 + k] : A->in[3][k]; sl[k * 20 + m] = v * __builtin_amdgcn_rcpf(1.0f + fexp(-v)); }
            filled = true; __syncthreads();
        }
        float a[17];
#pragma unroll
        for (int m = 0; m < 17; ++m) a[m] = 0.f;
        const int j = it * 64 + F.lane;
#pragma unroll 1
        for (int kb = 0; kb < 128; kb += 16) { float wv[16];
#pragma unroll
          for (int q = 0; q < 16; ++q) wv[q] = A->in[4][(size_t)(F.wave * 128 + kb + q) * 6144 + j];
#pragma unroll
          for (int q = 0; q < 16; ++q) { const int k = F.wave * 128 + kb + q; const float w = wv[q];
            const LAS float* sp = sl + k * 20;
            const f32x4 s0 = *(const LAS f32x4*)sp, s1 = *(const LAS f32x4*)(sp + 4), s2 = *(const LAS f32x4*)(sp + 8), s3 = *(const LAS f32x4*)(sp + 12); const float s4 = sp[16];
            a[0] += s0[0] * w; a[1] += s0[1] * w; a[2] += s0[2] * w; a[3] += s0[3] * w; a[4] += s1[0] * w; a[5] += s1[1] * w; a[6] += s1[2] * w; a[7] += s1[3] * w;
            a[8] += s2[0] * w; a[9] += s2[1] * w; a[10] += s2[2] * w; a[11] += s2[3] * w; a[12] += s3[0] * w; a[13] += s3[1] * w; a[14] += s3[2] * w; a[15] += s3[3] * w; a[16] += s4 * w; } }
#pragma unroll
        for (int m = 0; m < 17; ++m) red[(F.wave * 17 + m) * 64 + F.lane] = a[m];
        __syncthreads();
        for (int i = F.tid; i < 17 * 64; i += NTHREADS) { const int m = i >> 6, l = i & 63; float s = 0.f;
#pragma unroll
            for (int w = 0; w < 8; ++w) s += red[(w * 17 + m) * 64 + l];
            ((float*)(F.ws + WS_MOD))[(size_t)m * 6144 + it * 64 + l] = s + A->in[5][it * 64 + l]; }
        __syncthreads();
    }
    __syncthreads();
    int first = F.bid, stride = F.G, cnt = (NITEMS + F.G - 1) / F.G;
    if (F.G == 256) { if (F.bid >= 96) { first = F.bid - 96; stride = 160; cnt = 26; } else { first = 160 * 26 + F.bid; stride = 96; cnt = 24; } }
    static_assert(160 * 26 + 96 * 24 >= NITEMS, "P0 item split");
    f32x4 va[8], vb[8];
    if (first < NITEMS) { const P0Item I0 = p0_item(F, A, first); p0_load(I0, tid, va); }
    if (cnt > 1 && first + stride < NITEMS) { const P0Item I1 = p0_item(F, A, first + stride); p0_load(I1, tid, vb); }
#define P0_STEP(VCUR, k_) do { const int it_ = first + (k_) * stride; const P0Item I = p0_item(F, A, it_); \
        _Pragma("unroll") for (int q = 0; q < 8; ++q) { const int idx = tid + NTHREADS * q, k = idx >> 5, p = idx & 31; v2u w; w.x = pk2(VCUR[q][0], VCUR[q][1]); w.y = pk2(VCUR[q][2], VCUR[q][3]); \
            *(LAS v2u*)(lds + (k * P0_TS + 4 * p) * 2) = w; } \
        if ((k_) + 2 < cnt && it_ + 2 * stride < NITEMS) { const P0Item In = p0_item(F, A, it_ + 2 * stride); p0_load(In, tid, VCUR); } \
        LDS_BARRIER(); \
        p0_emit(I, lds, wave, i, g); \
        LDS_BARRIER(); } while (0)
#pragma unroll 1
    for (int k = 0; k < cnt && first + k * stride < NITEMS; k += 2) {
        P0_STEP(va, k);
        if (k + 1 < cnt && first + (k + 1) * stride < NITEMS) P0_STEP(vb, k + 1);
    }
#undef P0_STEP
}

__device__ __forceinline__ void p1_phase(const Frame& F, CArgs* A) {
    const int gw = F.bid * NWAVES + F.wave, NGW = F.G * NWAVES;
    for (int r0 = gw; r0 < NROWS; r0 += 2 * NGW) {
        const int r1 = r0 + NGW; const bool two = r1 < NROWS;
        const float* xa = (r0 < NLAT) ? A->in[0] + (size_t)r0 * D : A->in[2] + (size_t)(r0 - NLAT) * D;
        const float* xb = !two ? xa : ((r1 < NLAT) ? A->in[0] + (size_t)r1 * D : A->in[2] + (size_t)(r1 - NLAT) * D);
        f32x4 va[4], vb[4];
#pragma unroll
        for (int j = 0; j < 4; ++j) { va[j] = ((const f32x4*)xa)[F.lane + 64 * j]; vb[j] = ((const f32x4*)xb)[F.lane + 64 * j]; }
#pragma unroll
        for (int which = 0; which < 2; ++which) { if (which == 1 && !two) break;
            const int r = which ? r1 : r0; const int mrow = (r < NLAT) ? (r >> 12) : 16;
            const float* sh = ((float*)(F.ws + WS_MOD)) + (size_t)mrow * 6144; const float* sc = sh + 1024;
            float s = 0.f;
#pragma unroll
            for (int j = 0; j < 4; ++j) { const f32x4 v = which ? vb[j] : va[j]; s += (v.x * v.x + v.y * v.y) + (v.z * v.z + v.w * v.w); }
            const float rstd = 1.0f / sqrtf(wave_sum(s) * (1.f / D) + EPS);
            unsigned long long* o8 = (unsigned long long*)(((bf16*)(F.ws + WS_HN)) + (size_t)r * D) + F.lane;
#pragma unroll
            for (int j = 0; j < 4; ++j) { const int c4 = F.lane + 64 * j; const f32x4 v = which ? vb[j] : va[j]; const f32x4 w = ((const f32x4*)A->in[6])[c4], a = ((const f32x4*)sc)[c4], b = ((const f32x4*)sh)[c4];
                const f32x4 y = (v * rstd) * w * (a + 1.0f) + b;
                o8[64 * j] = (unsigned long long)pk2(y.x, y.y) | ((unsigned long long)pk2(y.z, y.w) << 32); } }
    }
}

constexpr int GL_ZL = 0;
constexpr int GL_BC = 8192;
constexpr int GL_TOT = GL_BC + 32768;
constexpr int GL_V = GL_TOT + 512;
constexpr int GL_A = GL_V + 64 * 136 * 2;
constexpr int GL_B = GL_A + 2 * 64 * 72 * 2;
constexpr int GL_P = GL_B + 2 * 64 * 72 * 2;
constexpr int GL_SS = GL_P + 64 * 72 * 2;
constexpr int GL_SEG = GL_SS + 512;
constexpr int GL_END = GL_SEG + 2048;
static_assert(GL_END <= RING_BYTES && (GL_V % 16) == 0 && (GL_A % 16) == 0 && (GL_B % 16) == 0 && (GL_P % 16) == 0, "GLA LDS map");

__device__ __forceinline__ s16x4 tr_read(unsigned lds_addr) { s16x4 r; asm volatile("ds_read_b64_tr_b16 %0, %1\n\ts_waitcnt lgkmcnt(0)" : "=&v"(r) : "v"(lds_addr) : "memory"); return r; }
__device__ __forceinline__ void v_frag2(LAS unsigned char* lds, int v0, int lane, bf16x8& f0, bf16x8& f1) {
    const int i = lane & 15, g = lane >> 4;
    const unsigned a0 = (unsigned)(uintptr_t)(lds + GL_V) + (unsigned)(((8 * g + (i >> 2)) * 136 + v0 + 4 * (i & 3)) * 2);
    s16x4 r0, r1, r2, r3;
    asm volatile("ds_read_b64_tr_b16 %0, %4\n\tds_read_b64_tr_b16 %1, %4 offset:1088\n\tds_read_b64_tr_b16 %2, %4 offset:8704\n\tds_read_b64_tr_b16 %3, %4 offset:9792\n\ts_waitcnt lgkmcnt(0)"
                 : "=&v"(r0), "=&v"(r1), "=&v"(r2), "=&v"(r3) : "v"(a0) : "memory");
    f0[0] = r0[0]; f0[1] = r0[1]; f0[2] = r0[2]; f0[3] = r0[3]; f0[4] = r1[0]; f0[5] = r1[1]; f0[6] = r1[2]; f0[7] = r1[3];
    f1[0] = r2[0]; f1[1] = r2[1]; f1[2] = r2[2]; f1[3] = r2[3]; f1[4] = r3[0]; f1[5] = r3[1]; f1[6] = r3[2]; f1[7] = r3[3];
}
__device__ __forceinline__ bf16x8 v_frag(LAS unsigned char* lds, int ks, int v0, int lane) {
    const int i = lane & 15, g = lane >> 4;
    const unsigned a0 = (unsigned)(uintptr_t)(lds + GL_V) + (unsigned)(((32 * ks + 8 * g + (i >> 2)) * 136 + v0 + 4 * (i & 3)) * 2);
    const s16x4 lo = tr_read(a0), hi = tr_read(a0 + 4 * 136 * 2);
    bf16x8 r; r[0] = lo[0]; r[1] = lo[1]; r[2] = lo[2]; r[3] = lo[3]; r[4] = hi[0]; r[5] = hi[1]; r[6] = hi[2]; r[7] = hi[3]; return r;
}
struct GlaRegs { v4u zw, vw[2]; };
__device__ __forceinline__ GlaRegs gla_load(const Frame& F, size_t prow, int h) {
    GlaRegs r; const int tid = F.tid; const bf16* P = (const bf16*)(F.ws + WS_P);
    { const int t = (tid & 255) >> 2, q = tid & 3; r.zw = *(const v4u*)(P + (prow + t) * PW + CAF + 8 * q); }
#pragma unroll
    for (int i = 0; i < 2; ++i) { const int pc = tid + i * NTHREADS, t = pc >> 4, c = pc & 15; r.vw[i] = *(const v4u*)(P + (prow + t) * PW + CV + h * 128 + c * 8); }
    return r;
}
__device__ __forceinline__ void gla_prep(const Frame& F, CArgs* A, const GlaRegs& R, int h) {
    LAS unsigned char* lds = F.lds; const int tid = F.tid;
    if (tid < 256) { const int t = tid >> 2, q = tid & 3; const v4u w = R.zw;
        LAS float* z = (LAS float*)(lds + GL_ZL) + (q >> 1) * 1024 + t * 16 + (q & 1) * 8;
        *(LAS f32x4*)z = (f32x4){bflo(w.x), bfhi(w.x), bflo(w.y), bfhi(w.y)}; *(LAS f32x4*)(z + 4) = (f32x4){bflo(w.z), bfhi(w.z), bflo(w.w), bfhi(w.w)}; }
#pragma unroll
    for (int i = 0; i < 2; ++i) { const int pc = tid + i * NTHREADS, t = pc >> 4, c = pc & 15; *(LAS v4u*)(lds + GL_V + (t * 136 + c * 8) * 2) = R.vw[i]; }
    __syncthreads();
    { const int dir = tid >> 8, seg = (tid >> 6) & 3, d = tid & 63;
      const float* up = dir ? A->in[10] : A->in[8]; const float bias = (dir ? A->in[11] : A->in[9])[h * 64 + d];
      float u[16];
#pragma unroll
      for (int r = 0; r < 16; ++r) u[r] = up[r * 256 + h * 64 + d];
      const LAS float* zl = (const LAS float*)(lds + GL_ZL) + dir * 1024; LAS float* bc = (LAS float*)(lds + GL_BC) + dir * 4096 + d;
      LAS float* sg = (LAS float*)(lds + GL_SEG) + dir * 256 + d;
      float c[16]; float cum = 0.f;
#pragma unroll
      for (int i = 0; i < 16; ++i) { const int t = seg * 16 + (dir ? 15 - i : i); const LAS float* zp = zl + t * 16;
          const f32x4 z0 = *(const LAS f32x4*)zp, z1 = *(const LAS f32x4*)(zp + 4), z2 = *(const LAS f32x4*)(zp + 8), z3 = *(const LAS f32x4*)(zp + 12);
          float z = bias + z0[0] * u[0] + z0[1] * u[1] + z0[2] * u[2] + z0[3] * u[3] + z1[0] * u[4] + z1[1] * u[5] + z1[2] * u[6] + z1[3] * u[7]
                         + z2[0] * u[8] + z2[1] * u[9] + z2[2] * u[10] + z2[3] * u[11] + z3[0] * u[12] + z3[1] * u[13] + z3[2] * u[14] + z3[3] * u[15];
          const float ls = fminf(z, 0.f) - __logf(1.0f + __expf(-fabsf(z)));
          cum += ls * (1.0f / 16.0f); c[i] = cum; }
      sg[seg * 64] = cum;
      __syncthreads();
      float off = 0.f, tot = 0.f;
#pragma unroll
      for (int s2 = 0; s2 < 4; ++s2) { const float v = sg[s2 * 64]; tot += v; off += (dir ? (s2 > seg) : (s2 < seg)) ? v : 0.f; }
#pragma unroll
      for (int i = 0; i < 16; ++i) { const int t = seg * 16 + (dir ? 15 - i : i); bc[t * 64] = off + c[i]; }
      if (seg == 0) ((LAS float*)(lds + GL_TOT))[dir * 64 + d] = tot; }
    __syncthreads();
}

__device__ __forceinline__ size_t chunk_row(int b, int cc) { return cc < 4 ? (size_t)NLAT + b * CTXL + cc * 64 : (size_t)b * SEQ + (cc - 4) * 64; }
__device__ __forceinline__ void p3_phase(const Frame& F, CArgs* A) {
    LAS unsigned char* lds = F.lds; const int tid = F.tid, lane = F.lane, wave = F.wave;
    GlaRegs cur; if (F.bid < NBATCH * NCC * 4) { const int bc0 = F.bid >> 2; cur = gla_load(F, chunk_row(bc0 / NCC, bc0 % NCC), F.bid & 3); }
    for (int it = F.bid; it < NBATCH * NCC * 4; it += F.G) {
        const int h = it & 3, bc = it >> 2, b = bc / NCC, cc = bc % NCC; const size_t prow = chunk_row(b, cc);
        GlaRegs nxt = cur; { const int itn = it + F.G; if (itn < NBATCH * NCC * 4) { const int bcn = itn >> 2; nxt = gla_load(F, chunk_row(bcn / NCC, bcn % NCC), itn & 3); } }
        float kf[8];
        { const int d = tid & 63, tg = tid >> 6;
#pragma unroll
          for (int j = 0; j < 8; ++j) kf[j] = bf2f(((bf16*)(F.ws + WS_P))[(prow + tg * 8 + j) * PW + CK + h * 64 + d]); }
        gla_prep(F, A, cur, h); cur = nxt;
        if (tid < 128) { const int dir = tid >> 6, d = tid & 63; ((float*)(F.ws + WS_DECAY))[(((size_t)dir * NBATCH + b) * NCC + cc) * 256 + h * 64 + d] = __expf(((const LAS float*)(lds + GL_TOT))[dir * 64 + d]); }
        { const int d = tid & 63, tg = tid >> 6;
#pragma unroll
          for (int dir = 0; dir < 2; ++dir) { const float tot = ((const LAS float*)(lds + GL_TOT))[dir * 64 + d]; const LAS float* bcp = (const LAS float*)(lds + GL_BC) + dir * 4096 + (tg * 8) * 64 + d; float s[8];
#pragma unroll
              for (int j = 0; j < 8; ++j) s[j] = kf[j] * __expf(tot - bcp[j * 64]);
              v4u w; w.x = pk2(s[0], s[1]); w.y = pk2(s[2], s[3]); w.z = pk2(s[4], s[5]); w.w = pk2(s[6], s[7]);
              *(LAS v4u*)(lds + GL_A + ((dir * 64 + d) * 72 + tg * 8) * 2) = w; } }
        __syncthreads();
        { const int dir = wave & 1, dt = wave >> 1, i = lane & 15, g = lane >> 4;
          bf16x8 af[2];
#pragma unroll
          for (int ks = 0; ks < 2; ++ks) af[ks] = *(const LAS bf16x8*)(lds + GL_A + ((dir * 64 + dt * 16 + i) * 72 + 32 * ks + 8 * g) * 2);
          bf16* kvp = ((bf16*)(F.ws + WS_KV)) + ((((size_t)dir * NBATCH + b) * NCC + cc) * 4 + h) * 8192;
#pragma unroll 2
          for (int vt = 0; vt < 8; ++vt) { f32x4 acc = {0.f, 0.f, 0.f, 0.f}; bf16x8 vf0, vf1; v_frag2(lds, vt * 16, lane, vf0, vf1);
              acc = __builtin_amdgcn_mfma_f32_16x16x32_bf16(af[0], vf0, acc, 0, 0, 0); acc = __builtin_amdgcn_mfma_f32_16x16x32_bf16(af[1], vf1, acc, 0, 0, 0);
              v2u w; w.x = pk2(acc[0], acc[1]); w.y = pk2(acc[2], acc[3]);
              *(v2u*)(kvp + (size_t)(vt * 16 + i) * 64 + dt * 16 + 4 * g) = w; } }
        __syncthreads();
    }
}

constexpr int G2_ZL = 0;
constexpr int G2_HT = 8192;
constexpr int G2_TOT = G2_HT + 4096;
constexpr int G2_A = G2_TOT + 1024;
constexpr int G2_B = G2_A + 256 * 72 * 2;
constexpr int G2_VS = 528;
static_assert(G2_B + 64 * G2_VS * 2 <= RING_BYTES && G2_B + 256 * 72 * 2 <= RING_BYTES && (G2_A % 16) == 0 && (G2_B % 16) == 0, "GLA v2 LDS map");
__device__ __forceinline__ void tr_frag2(unsigned tile_addr, int c0, int lane, bf16x8& f0, bf16x8& f1) {
    const int i = lane & 15, g = lane >> 4;
    const unsigned a0 = tile_addr + (unsigned)(((8 * g + (i >> 2)) * G2_VS + c0 + 4 * (i & 3)) * 2);
    s16x4 r0, r1, r2, r3;
    asm volatile("ds_read_b64_tr_b16 %0, %4\n\tds_read_b64_tr_b16 %1, %4 offset:4224\n\tds_read_b64_tr_b16 %2, %4 offset:33792\n\tds_read_b64_tr_b16 %3, %4 offset:38016\n\ts_waitcnt lgkmcnt(0)"
                 : "=&v"(r0), "=&v"(r1), "=&v"(r2), "=&v"(r3) : "v"(a0) : "memory");
    f0[0] = r0[0]; f0[1] = r0[1]; f0[2] = r0[2]; f0[3] = r0[3]; f0[4] = r1[0]; f0[5] = r1[1]; f0[6] = r1[2]; f0[7] = r1[3];
    f1[0] = r2[0]; f1[1] = r2[1]; f1[2] = r2[2]; f1[3] = r2[3]; f1[4] = r3[0]; f1[5] = r3[1]; f1[6] = r3[2]; f1[7] = r3[3];
}
static_assert(4 * G2_VS * 2 == 4224 && 32 * G2_VS * 2 == 33792 && 36 * G2_VS * 2 == 38016, "tr_frag2 offsets");
__device__ __forceinline__ float log_sigmoid16(float z) { return (fminf(z, 0.f) - __logf(1.0f + __expf(-fabsf(z)))) * (1.0f / 16.0f); }

__device__ __forceinline__ void p3v2_phase(const Frame& F, CArgs* A) {
    LAS unsigned char* lds = F.lds; const int tid = F.tid, lane = F.lane, wave = F.wave, i = lane & 15, g = lane >> 4;
    const int c = tid & 255, th = tid >> 8;
    const bf16* P = (const bf16*)(F.ws + WS_P);
#pragma unroll 1
    for (int it = F.bid; it < NBATCH * NCC; it += F.G) {
        const int b = it / NCC, cc = it % NCC; const size_t prow = chunk_row(b, cc);
        if (tid < 256) { const int t = tid >> 2, q = tid & 3; const v4u w = *(const v4u*)(P + (prow + t) * PW + CAF + 8 * q);
            LAS float* z = (LAS float*)(lds + G2_ZL) + (q >> 1) * 1024 + t * 16 + (q & 1) * 8;
            *(LAS f32x4*)z = (f32x4){bflo(w.x), bfhi(w.x), bflo(w.y), bfhi(w.y)}; *(LAS f32x4*)(z + 4) = (f32x4){bflo(w.z), bfhi(w.z), bflo(w.w), bfhi(w.w)}; }
#pragma unroll
        for (int j = 0; j < 8; ++j) { const int pc = tid + j * NTHREADS, t = pc >> 6, cv = pc & 63;
            *(LAS v4u*)(lds + G2_B + (t * G2_VS + cv * 8) * 2) = *(const v4u*)(P + (prow + t) * PW + CV + cv * 8); }
        float kk[32];
#pragma unroll
        for (int tl = 0; tl < 32; ++tl) kk[tl] = bf2f(P[(prow + th * 32 + tl) * PW + CK + c]);
        __syncthreads();
#pragma unroll
        for (int dir = 0; dir < 2; ++dir) {
            { const float* up = dir ? A->in[10] : A->in[8]; const float bias = (dir ? A->in[11] : A->in[9])[c];
              float u[16];
#pragma unroll
              for (int r = 0; r < 16; ++r) u[r] = up[r * 256 + c];
              const LAS float* zl = (const LAS float*)(lds + G2_ZL) + dir * 1024 + th * 512;
              float cl[32]; float cum = 0.f;
#pragma unroll
              for (int ii = 0; ii < 32; ++ii) { const int tl = dir ? 31 - ii : ii; const LAS float* zp = zl + tl * 16;
                  const f32x4 z0 = *(const LAS f32x4*)zp, z1 = *(const LAS f32x4*)(zp + 4), z2 = *(const LAS f32x4*)(zp + 8), z3 = *(const LAS f32x4*)(zp + 12);
                  const float z = bias + z0[0] * u[0] + z0[1] * u[1] + z0[2] * u[2] + z0[3] * u[3] + z1[0] * u[4] + z1[1] * u[5] + z1[2] * u[6] + z1[3] * u[7]
                                       + z2[0] * u[8] + z2[1] * u[9] + z2[2] * u[10] + z2[3] * u[11] + z3[0] * u[12] + z3[1] * u[13] + z3[2] * u[14] + z3[3] * u[15];
                  cum += log_sigmoid16(z); cl[tl] = cum; }
              LAS float* ht = (LAS float*)(lds + G2_HT) + dir * 512;
              ht[th * 256 + c] = cum;
              __syncthreads();
              const float other = ht[(1 - th) * 256 + c], tot = cum + other;
              const float off = (dir == 0) ? (th ? other : 0.f) : (th ? 0.f : other);
              if (th == 0) { ((LAS float*)(lds + G2_TOT))[c] = tot; ((float*)(F.ws + WS_DECAY))[(((size_t)dir * NBATCH + b) * NCC + cc) * 256 + c] = __expf(tot); }
#pragma unroll
              for (int j = 0; j < 4; ++j) { float e[8];
#pragma unroll
                  for (int q = 0; q < 8; ++q) e[q] = kk[8 * j + q] * __expf(-(off + cl[8 * j + q]));
                  v4u w; w.x = pk2(e[0], e[1]); w.y = pk2(e[2], e[3]); w.z = pk2(e[4], e[5]); w.w = pk2(e[6], e[7]);
                  *(LAS v4u*)(lds + G2_A + (c * 72 + th * 32 + 8 * j) * 2) = w; } }
            __syncthreads();
            { const int h = wave >> 1, vh = wave & 1;
              bf16x8 af[4][2];
#pragma unroll
              for (int dt = 0; dt < 4; ++dt)
#pragma unroll
                  for (int ks = 0; ks < 2; ++ks) af[dt][ks] = *(const LAS bf16x8*)(lds + G2_A + ((h * 64 + dt * 16 + i) * 72 + 32 * ks + 8 * g) * 2);
              f32x4 et[4];
#pragma unroll
              for (int dt = 0; dt < 4; ++dt) { const f32x4 tv = *(const LAS f32x4*)(lds + G2_TOT + (h * 64 + dt * 16 + 4 * g) * 4); et[dt] = (f32x4){__expf(tv[0]), __expf(tv[1]), __expf(tv[2]), __expf(tv[3])}; }
              bf16* kvp = ((bf16*)(F.ws + WS_KV)) + ((((size_t)dir * NBATCH + b) * NCC + cc) * 4 + h) * 8192;
              bf16* vtp = ((bf16*)(F.ws + WS_VT)) + (((size_t)b * 64 + (cc - 4)) * 4 + h) * 8192;
#pragma unroll
              for (int vt = 0; vt < 4; ++vt) { const int v0 = vh * 64 + vt * 16; bf16x8 vf0, vf1; tr_frag2((unsigned)(uintptr_t)(lds + G2_B), h * 128 + v0, lane, vf0, vf1);
                  if (dir == 0 && cc >= 4) { *(bf16x8*)(vtp + (size_t)(v0 + i) * 64 + 8 * g) = vf0; *(bf16x8*)(vtp + (size_t)(v0 + i) * 64 + 32 + 8 * g) = vf1; }
#pragma unroll
                  for (int dt = 0; dt < 4; ++dt) { f32x4 acc = {0.f, 0.f, 0.f, 0.f};
                      acc = __builtin_amdgcn_mfma_f32_16x16x32_bf16(af[dt][0], vf0, acc, 0, 0, 0); acc = __builtin_amdgcn_mfma_f32_16x16x32_bf16(af[dt][1], vf1, acc, 0, 0, 0);
                      acc = acc * et[dt];
                      v2u w; w.x = pk2(acc[0], acc[1]); w.y = pk2(acc[2], acc[3]);
                      *(v2u*)(kvp + (size_t)(v0 + i) * 64 + dt * 16 + 4 * g) = w; } } }
            __syncthreads();
        }
    }
}

struct GateConst { bf16x8 bw[2][2]; float bias[2][2]; };
__device__ __forceinline__ GateConst gate_setup(CArgs* A, int wave, int lane) {
    GateConst G; const int i = lane & 15, g = lane >> 4;
#pragma unroll
    for (int dir = 0; dir < 2; ++dir)
#pragma unroll
        for (int cti = 0; cti < 2; ++cti) { const int c = 32 * wave + 16 * cti + i; const float* up = dir ? A->in[10] : A->in[8];
            G.bias[dir][cti] = (dir ? A->in[11] : A->in[9])[c];
#pragma unroll
            for (int jj = 0; jj < 8; ++jj) { const float v = up[(8 * (g & 1) + jj) * 256 + c]; const unsigned hi = f2bf(v); const float rem = v - __builtin_bit_cast(float, hi << 16);
                G.bw[dir][cti][jj] = (short)((g < 2) ? hi : f2bf(rem)); } }
    return G;
}
__device__ __forceinline__ float log_sigmoid16_fast(float z) { const float e = __builtin_amdgcn_exp2f(fabsf(z) * -1.4426950409f); return (fminf(z, 0.f) - __builtin_amdgcn_logf(1.0f + e) * 0.6931471806f) * 0.0625f; }
__device__ __forceinline__ void gate_b(const GateConst& G, const bf16* P, size_t prow, int lane, f32x4 (&bv)[2][2][4], float (&tot)[2][2]) {
    const int i = lane & 15, g = lane >> 4;
    bf16x8 za[2][4];
#pragma unroll
    for (int dir = 0; dir < 2; ++dir)
#pragma unroll
        for (int tt = 0; tt < 4; ++tt) za[dir][tt] = *(const bf16x8*)(P + (prow + 16 * tt + i) * PW + CAF + 16 * dir + 8 * (g & 1));
#pragma unroll
    for (int dir = 0; dir < 2; ++dir)
#pragma unroll
        for (int cti = 0; cti < 2; ++cti) { float carry = 0.f;
#pragma unroll
            for (int q = 0; q < 4; ++q) { const int tt = dir ? 3 - q : q;
                f32x4 z = {0.f, 0.f, 0.f, 0.f}; z = __builtin_amdgcn_mfma_f32_16x16x32_bf16(za[dir][tt], G.bw[dir][cti], z, 0, 0, 0);
                float la[4];
#pragma unroll
                for (int r = 0; r < 4; ++r) la[r] = log_sigmoid16_fast(z[r] + G.bias[dir][cti]);
                float p[4];
                if (dir == 0) { p[0] = la[0]; p[1] = p[0] + la[1]; p[2] = p[1] + la[2]; p[3] = p[2] + la[3];
                    const float s = p[3]; float incl = s; const float t1 = __shfl_up(incl, 16); if (g >= 1) incl += t1; const float t2 = __shfl_up(incl, 32); if (g >= 2) incl += t2;
                    const float base = carry + (incl - s); carry += __shfl(incl, 48 + i);
                    bv[dir][cti][tt] = (f32x4){base + p[0], base + p[1], base + p[2], base + p[3]}; }
                else { p[3] = la[3]; p[2] = p[3] + la[2]; p[1] = p[2] + la[1]; p[0] = p[1] + la[0];
                    const float s = p[0]; float incl = s; const float t1 = __shfl_down(incl, 16); if (g <= 2) incl += t1; const float t2 = __shfl_down(incl, 32); if (g <= 1) incl += t2;
                    const float base = carry + (incl - s); carry += __shfl(incl, i);
                    bv[dir][cti][tt] = (f32x4){base + p[0], base + p[1], base + p[2], base + p[3]}; } }
            tot[dir][cti] = carry; }
}

constexpr int G3_ST = 0;
constexpr int G3_TOT = 8 * 16 * 144;
constexpr int G3_A = G3_TOT + 1024;
constexpr int G3_B = G3_A + 256 * 72 * 2;
static_assert(G3_B + 64 * G2_VS * 2 <= RING_BYTES && (G3_A % 16) == 0 && (G3_B % 16) == 0, "P3 LDS map");
template <int MODE>
__device__ __forceinline__ void p3v3_phase(const Frame& F, CArgs* A) {
    int tid_ = F.tid; asm volatile("" : "+v"(tid_));
    LAS unsigned char* lds = F.lds; const int tid = tid_, lane = tid & 63, wave = __builtin_amdgcn_readfirstlane(tid >> 6), i = lane & 15, g = lane >> 4;
    const bf16* P = (const bf16*)(F.ws + WS_P);
    const GateConst G = gate_setup(A, wave, lane);
    LAS unsigned char* st = lds + G3_ST + wave * (16 * 144);
#pragma unroll 1
    for (int it = F.bid; it < NBATCH * NCC; it += F.G) {
        const int b = it / NCC, cc = it % NCC; const size_t prow = chunk_row(b, cc);
        unsigned pf0 = 0u, pf1 = 0u;
#pragma unroll
        for (int j = 0; j < 8; ++j) { const int pc = tid + j * NTHREADS, t = pc >> 6, cv = pc & 63;
            *(LAS v4u*)(lds + G3_B + (t * G2_VS + cv * 8) * 2) = *(const v4u*)(P + (prow + t) * PW + CV + cv * 8); }
        unsigned kk[2][4][2];
#pragma unroll
        for (int cti = 0; cti < 2; ++cti)
#pragma unroll
            for (int tt = 0; tt < 4; ++tt)
#pragma unroll
                for (int r = 0; r < 4; r += 2) { const bf16* kp = P + (prow + 16 * tt + 4 * g + r) * PW + CK + 32 * wave + 16 * cti + i; kk[cti][tt][r >> 1] = (unsigned)kp[0] | ((unsigned)kp[PW] << 16); }
        f32x4 bv[2][2][4]; float tot[2][2];
        if (MODE < 4) gate_b(G, P, prow, lane, bv, tot); else {
#pragma unroll
            for (int a_ = 0; a_ < 2; ++a_)
#pragma unroll
                for (int b_ = 0; b_ < 2; ++b_) { tot[a_][b_] = 0.f;
#pragma unroll
                    for (int c_ = 0; c_ < 4; ++c_) bv[a_][b_][c_] = (f32x4){0.f, 0.f, 0.f, 0.f}; } }
#pragma unroll
        for (int dir = 0; dir < 2; ++dir) {
#pragma unroll
            for (int cti = 0; cti < 2; ++cti) { const int c = 32 * wave + 16 * cti + i;
#pragma unroll
                for (int tt = 0; tt < 4; ++tt) { float e[4];
#pragma unroll
                    for (int r = 0; r < 4; ++r) e[r] = ((r & 1) ? bfhi(kk[cti][tt][r >> 1]) : bflo(kk[cti][tt][r >> 1])) * __builtin_amdgcn_exp2f(bv[dir][cti][tt][r] * -1.4426950409f);
                    v2u w; w.x = pk2(e[0], e[1]); w.y = pk2(e[2], e[3]);
                    *(LAS v2u*)(lds + G3_A + (c * 72 + 16 * tt + 4 * g) * 2) = w; }
                if (g == 0) { ((LAS float*)(lds + G3_TOT))[c] = tot[dir][cti]; if (!MODE) ((float*)(F.ws + WS_DECAY))[(((size_t)dir * NBATCH + b) * NCC + cc) * 256 + c] = __expf(tot[dir][cti]); } }
            LDS_BARRIER();
            if (dir == 0) {
                const int itn = it + F.G; if (itn < NBATCH * NCC) { const char* pr = (const char*)(P + (chunk_row(itn / NCC, itn % NCC) + (tid >> 3)) * PW); const int j = tid & 7;
                    pf0 = *(const unsigned*)(pr + 512 + 128 * j); pf1 = *(const unsigned*)(pr + (j < 5 ? 512 + 128 * (8 + j) : 3072 + 32 * (j - 5))); } }
            if (MODE < 3) { const int h = wave >> 1, vh = wave & 1;
              bf16x8 af[4][2];
#pragma unroll
              for (int dt = 0; dt < 4; ++dt)
#pragma unroll
                  for (int ks = 0; ks < 2; ++ks) af[dt][ks] = *(const LAS bf16x8*)(lds + G3_A + ((h * 64 + dt * 16 + i) * 72 + 32 * ks + 8 * g) * 2);
              bf16* kvp = ((bf16*)(F.ws + WS_KV)) + ((((size_t)dir * NBATCH + b) * NCC + cc) * 4 + h) * 8192;
              bf16* vtp = ((bf16*)(F.ws + WS_VT)) + (((size_t)b * 64 + (cc - 4)) * 4 + h) * 8192;
              if (MODE) { kvp = ((bf16*)(F.ws + WS_TOTAL)) + (size_t)(F.bid * 8 + wave) * 512; vtp = kvp + 1024 * 1024; }
#pragma unroll
              for (int vt = 0; vt < 4; ++vt) { const int v0 = vh * 64 + vt * 16; bf16x8 vf0, vf1; tr_frag2((unsigned)(uintptr_t)(lds + G3_B), h * 128 + v0, lane, vf0, vf1);
                  if (dir == 0 && cc >= 4) {
                      *(LAS bf16x8*)(st + i * 144 + 16 * g) = vf0; *(LAS bf16x8*)(st + i * 144 + 64 + 16 * g) = vf1;
                      LDS_WAIT();
#pragma unroll
                      for (int j = 0; j < 2; ++j) { const int pc = lane + 64 * j, row = pc >> 3, ch = pc & 7; const v4u x_ = *(const LAS v4u*)(st + row * 144 + ch * 16); if (MODE == 2) asm volatile("" :: "v"(x_)); else *(v4u*)(vtp + (size_t)((MODE ? 0 : v0) + row) * 64 + ch * 8) = x_; }
                      LDS_WAIT(); }
#pragma unroll
                  for (int dt = 0; dt < 4; ++dt) { f32x4 acc = {0.f, 0.f, 0.f, 0.f};
                      acc = __builtin_amdgcn_mfma_f32_16x16x32_bf16(af[dt][0], vf0, acc, 0, 0, 0); acc = __builtin_amdgcn_mfma_f32_16x16x32_bf16(af[dt][1], vf1, acc, 0, 0, 0);
                      { const f32x4 tv = *(const LAS f32x4*)(lds + G3_TOT + (h * 64 + dt * 16 + 4 * g) * 4);
                        acc = acc * (f32x4){__builtin_amdgcn_exp2f(tv[0] * 1.4426950409f), __builtin_amdgcn_exp2f(tv[1] * 1.4426950409f), __builtin_amdgcn_exp2f(tv[2] * 1.4426950409f), __builtin_amdgcn_exp2f(tv[3] * 1.4426950409f)}; }
                      v2u w; w.x = pk2(acc[0], acc[1]); w.y = pk2(acc[2], acc[3]);
                      *(LAS v2u*)(st + i * 144 + (16 * dt + 4 * g) * 2) = w; }
                  LDS_WAIT();
#pragma unroll
                  for (int j = 0; j < 2; ++j) { const int pc = lane + 64 * j, row = pc >> 3, ch = pc & 7; const v4u x_ = *(const LAS v4u*)(st + row * 144 + ch * 16); if (MODE == 2) asm volatile("" :: "v"(x_)); else *(v4u*)(kvp + (size_t)((MODE ? 0 : v0) + row) * 64 + ch * 8) = x_; }
                  LDS_WAIT(); } }
            LDS_BARRIER();
        }
        asm volatile("" :: "v"(pf0), "v"(pf1));
    }
}

struct ConvRegs { v4u cw[6], xw[6], bw[4]; };
__device__ __forceinline__ void conv_load(const bf16* P, int u, int t, ConvRegs& R) {
    const int item = u >> 1, b = item >> 6, n = item & 63; const size_t prow = (size_t)b * SEQ + n * 64; const int t0 = (u & 1) * 32 + (t >> 6) * 4, c0 = (t & 63) * 8;
#pragma unroll
    for (int q = 0; q < 6; ++q) { const int tt = t0 - 1 + q, tc = tt < 0 ? 0 : (tt > 63 ? 63 : tt);
        R.cw[q] = *(const v4u*)(P + (prow + tc) * PW + CPC + c0); R.xw[q] = *(const v4u*)(P + (prow + tc) * PW + CPX + c0); }
#pragma unroll
    for (int q = 0; q < 4; ++q) R.bw[q] = *(const v4u*)(P + (prow + t0 + q) * PW + CPB + c0);
}
__device__ __forceinline__ void conv_pin(ConvRegs& R) {
    asm volatile("" ::: "memory");
#pragma unroll
    for (int q = 0; q < 6; ++q) { asm volatile("" : "+v"(R.cw[q])); asm volatile("" : "+v"(R.xw[q])); }
#pragma unroll
    for (int q = 0; q < 4; ++q) asm volatile("" : "+v"(R.bw[q]));
}
__device__ __forceinline__ void conv_emit(unsigned char* ws, const f32x2 (&w2)[3][4], int u, int t, const ConvRegs& R) {
    const int item = u >> 1, b = item >> 6, n = item & 63; const size_t prow = (size_t)b * SEQ + n * 64; const int t0 = (u & 1) * 32 + (t >> 6) * 4, c0 = (t & 63) * 8;
    f32x2 ov[4][4];
#pragma unroll
    for (int j = 0; j < 4; ++j)
#pragma unroll
        for (int p = 0; p < 4; ++p) ov[j][p] = (f32x2){0.f, 0.f};
#pragma unroll
    for (int q = 0; q < 6; ++q) { const int tt = t0 - 1 + q; const bool in = tt >= 0 && tt < 64; v4u c_ = R.cw[q]; const v4u x_ = R.xw[q]; f32x2 uu[4];
        c_.x = in ? c_.x : 0u; c_.y = in ? c_.y : 0u; c_.z = in ? c_.z : 0u; c_.w = in ? c_.w : 0u;
        uu[0] = (f32x2){bflo(c_.x), bfhi(c_.x)} * (f32x2){bflo(x_.x), bfhi(x_.x)}; uu[1] = (f32x2){bflo(c_.y), bfhi(c_.y)} * (f32x2){bflo(x_.y), bfhi(x_.y)};
        uu[2] = (f32x2){bflo(c_.z), bfhi(c_.z)} * (f32x2){bflo(x_.z), bfhi(x_.z)}; uu[3] = (f32x2){bflo(c_.w), bfhi(c_.w)} * (f32x2){bflo(x_.w), bfhi(x_.w)};
#pragma unroll
        for (int dt = 0; dt < 3; ++dt) { const int j = q - dt;
            if (j >= 0 && j < 4) {
#pragma unroll
                for (int p = 0; p < 4; ++p) ov[j][p] += w2[dt][p] * uu[p]; } } }
#pragma unroll
    for (int q = 0; q < 4; ++q) { const v4u b_ = R.bw[q];
        const f32x2 y0 = ov[q][0] * (f32x2){bflo(b_.x), bfhi(b_.x)}, y1 = ov[q][1] * (f32x2){bflo(b_.y), bfhi(b_.y)}, y2 = ov[q][2] * (f32x2){bflo(b_.z), bfhi(b_.z)}, y3 = ov[q][3] * (f32x2){bflo(b_.w), bfhi(b_.w)};
        if (OUTPROJ_F8) { v2u w; w.x = pk4_fp8(y0.x, y0.y, y1.x, y1.y); w.y = pk4_fp8(y2.x, y2.y, y3.x, y3.y);
            *(v2u*)(ws + WS_YMIX + (prow + t0 + q) * D + 512 + c0) = w; }
        else { v4u w; w.x = pk2(y0.x, y0.y); w.y = pk2(y1.x, y1.y); w.z = pk2(y2.x, y2.y); w.w = pk2(y3.x, y3.y);
            *(v4u*)(((bf16*)(ws + WS_YMIX)) + (prow + t0 + q) * D + 512 + c0) = w; } }
}
__device__ __forceinline__ void conv_stream(const Frame& F, CArgs* A, int t) {
    const bf16* P = (const bf16*)(F.ws + WS_P);
    constexpr int NU = NBATCH * 64 * 2;
    f32x2 w2[3][4];
    { const int c0 = (t & 63) * 8;
#pragma unroll
      for (int dt = 0; dt < 3; ++dt) { const f32x4 a = *(const f32x4*)(A->in[13] + dt * 512 + c0), b = *(const f32x4*)(A->in[13] + dt * 512 + c0 + 4);
          w2[dt][0] = (f32x2){a[0], a[1]}; w2[dt][1] = (f32x2){a[2], a[3]}; w2[dt][2] = (f32x2){b[0], b[1]}; w2[dt][3] = (f32x2){b[2], b[3]}; } }
    ConvRegs Ra, Rb;
    int u = F.bid;
    if (u < NU) conv_load(P, u, t, Ra);
#pragma unroll 1
    for (; u < NU; u += 2 * F.G) {
        const int un = (u + F.G < NU) ? u + F.G : u, un2 = (u + 2 * F.G < NU) ? u + 2 * F.G : u;
        conv_load(P, un, t, Rb); conv_pin(Ra);
        conv_emit(F.ws, w2, u, t, Ra);
        conv_load(P, un2, t, Ra); conv_pin(Rb);
        conv_emit(F.ws, w2, un, t, Rb);
    }
}

__device__ __forceinline__ void gate_b_dir(const GateConst& G, const bf16* P, size_t prow, int lane, int dir, f32x4 (&bv)[2][4]) {
    const int i = lane & 15, g = lane >> 4;
    bf16x8 za[4];
#pragma unroll
    for (int tt = 0; tt < 4; ++tt) za[tt] = *(const bf16x8*)(P + (prow + 16 * tt + i) * PW + CAF + 16 * dir + 8 * (g & 1));
#pragma unroll
    for (int cti = 0; cti < 2; ++cti) { float carry = 0.f;
#pragma unroll
        for (int q = 0; q < 4; ++q) { const int tt = dir ? 3 - q : q;
            f32x4 z = {0.f, 0.f, 0.f, 0.f}; z = __builtin_amdgcn_mfma_f32_16x16x32_bf16(za[tt], G.bw[dir][cti], z, 0, 0, 0);
            float la[4];
#pragma unroll
            for (int r = 0; r < 4; ++r) la[r] = log_sigmoid16_fast(z[r] + G.bias[dir][cti]);
            float p[4];
            if (dir == 0) { p[0] = la[0]; p[1] = p[0] + la[1]; p[2] = p[1] + la[2]; p[3] = p[2] + la[3];
                const float s = p[3]; float incl = s; const float t1 = __shfl_up(incl, 16); if (g >= 1) incl += t1; const float t2 = __shfl_up(incl, 32); if (g >= 2) incl += t2;
                const float base = carry + (incl - s); carry += __shfl(incl, 48 + i);
                bv[cti][tt] = (f32x4){base + p[0], base + p[1], base + p[2], base + p[3]}; }
            else { p[3] = la[3]; p[2] = p[3] + la[2]; p[1] = p[2] + la[1]; p[0] = p[1] + la[0];
                const float s = p[0]; float incl = s; const float t1 = __shfl_down(incl, 16); if (g <= 2) incl += t1; const float t2 = __shfl_down(incl, 32); if (g <= 1) incl += t2;
                const float base = carry + (incl - s); carry += __shfl(incl, i);
                bv[cti][tt] = (f32x4){base + p[0], base + p[1], base + p[2], base + p[3]}; } } }
}

constexpr int G5_Q = 0;
constexpr int G5_K = 4 * 64 * 72 * 2;
constexpr int G5_P = 2 * G5_K;
static_assert(G5_P + 4 * 64 * 72 * 2 <= RING_BYTES && 8 * 16 * 272 <= G5_K, "P5 LDS map");
template <int MODE>
__device__ __forceinline__ void p5av3_phase(const Frame& F, CArgs* A) {
    LAS unsigned char* lds = F.lds;
    const bf16* P = (const bf16*)(F.ws + WS_P);
    const GateConst G = gate_setup(A, F.wave, F.lane);
#pragma unroll 1
    for (int it = F.bid; it < NBATCH * 64; it += F.G) {
        int tid_ = F.tid; asm volatile("" : "+v"(tid_));
        const int tid = tid_, lane = tid & 63, wave = __builtin_amdgcn_readfirstlane(tid >> 6), i = lane & 15, g = lane >> 4;
        const int h = wave >> 1, half = wave & 1;
        LAS unsigned char* st = lds + G5_Q + wave * (16 * 272);
        const int b = it >> 6, n = it & 63; const size_t prow = (size_t)b * SEQ + n * 64;
        unsigned pfv[9];
#pragma unroll
        for (int q = 0; q < 9; ++q) pfv[q] = 0u;
        const int dh = 32 * half + i;
        f32x4 pdiag[2], oacc[2][8];
#pragma unroll
        for (int a = 0; a < 2; ++a) { pdiag[a] = (f32x4){0.f, 0.f, 0.f, 0.f};
#pragma unroll
            for (int q = 0; q < 8; ++q) oacc[a][q] = (f32x4){0.f, 0.f, 0.f, 0.f}; }
#pragma unroll
        for (int dir = 0; dir < (MODE >= 4 ? 0 : 2); ++dir) {
            { unsigned qk[2][4][4];
#pragma unroll
              for (int cti = 0; cti < 2; ++cti)
#pragma unroll
                  for (int tt = 0; tt < 4; ++tt)
#pragma unroll
                      for (int r = 0; r < 4; ++r) { const bf16* rp = P + (prow + 16 * tt + 4 * g + r) * PW + h * 64 + dh + 16 * cti; qk[cti][tt][r] = (unsigned)rp[CQ] | ((unsigned)rp[CK] << 16); }
              f32x4 bv[2][4]; gate_b_dir(G, P, prow, lane, dir, bv);
#pragma unroll
              for (int cti = 0; cti < 2; ++cti)
#pragma unroll
                  for (int tt = 0; tt < 4; ++tt)
#pragma unroll
                      for (int r = 0; r < 4; ++r) { const float e = __builtin_amdgcn_exp2f(bv[cti][tt][r] * 1.4426950409f); const unsigned w = qk[cti][tt][r];
                          const int off = ((h * 64 + 16 * tt + 4 * g + r) * 72 + dh + 16 * cti) * 2;
                          *(LAS bf16*)(lds + G5_Q + off) = (bf16)f2bf(bflo(w) * e * 0.125f); *(LAS bf16*)(lds + G5_K + off) = (bf16)f2bf(bfhi(w) * __builtin_amdgcn_rcpf(e)); } }
            LDS_BARRIER();
            if (MODE < 3) { bf16x8 qf[2][2];
#pragma unroll
              for (int tti = 0; tti < 2; ++tti)
#pragma unroll
                  for (int ks = 0; ks < 2; ++ks) qf[tti][ks] = *(const LAS bf16x8*)(lds + G5_Q + ((h * 64 + (2 * half + tti) * 16 + i) * 72 + 32 * ks + 8 * g) * 2);
              const bf16* sp = ((const bf16*)(F.ws + WS_S)) + ((((size_t)dir * NBATCH + b) * 64 + n) * 4 + h) * 8192 + (size_t)i * 64 + 8 * g;
#pragma unroll
              for (int st_ = 0; st_ < 4; ++st_) { const bf16x8 kf0 = *(const LAS bf16x8*)(lds + G5_K + ((h * 64 + st_ * 16 + i) * 72 + 8 * g) * 2), kf1 = *(const LAS bf16x8*)(lds + G5_K + ((h * 64 + st_ * 16 + i) * 72 + 32 + 8 * g) * 2);
#pragma unroll
                  for (int tti = 0; tti < 2; ++tti) { const int tt = 2 * half + tti;
                      if (dir == 0 ? (st_ <= tt) : (st_ >= tt)) { f32x4 a = {0.f, 0.f, 0.f, 0.f};
                          a = __builtin_amdgcn_mfma_f32_16x16x32_bf16(kf0, qf[tti][0], a, 0, 0, 0); a = __builtin_amdgcn_mfma_f32_16x16x32_bf16(kf1, qf[tti][1], a, 0, 0, 0);
                          const int t = tt * 16 + i, s0 = st_ * 16 + 4 * g;
                          if (st_ == tt) {
#pragma unroll
                              for (int r = 0; r < 4; ++r) pdiag[tti][r] += (dir == 0 ? (s0 + r <= t) : (s0 + r >= t)) ? a[r] : 0.f;
                              a = pdiag[tti]; }
                          if (st_ != tt || dir == 1) { v2u w; w.x = pk2(a[0], a[1]); w.y = pk2(a[2], a[3]);
                              *(LAS v2u*)(lds + G5_P + ((h * 64 + t) * 72 + s0) * 2) = w; } } } }
              bf16x8 sfr[4][2];
#pragma unroll
              for (int vt = 0; vt < 4; ++vt) { sfr[vt][0] = *(const bf16x8*)(sp + (size_t)vt * 1024); sfr[vt][1] = *(const bf16x8*)(sp + (size_t)vt * 1024 + 32); }
#pragma unroll
              for (int vt = 0; vt < 8; ++vt) {
#pragma unroll
                  for (int tti = 0; tti < 2; ++tti) { oacc[tti][vt] = __builtin_amdgcn_mfma_f32_16x16x32_bf16(sfr[vt & 3][0], qf[tti][0], oacc[tti][vt], 0, 0, 0); oacc[tti][vt] = __builtin_amdgcn_mfma_f32_16x16x32_bf16(sfr[vt & 3][1], qf[tti][1], oacc[tti][vt], 0, 0, 0); }
                  asm volatile("" : "+v"(oacc[0][vt]), "+v"(oacc[1][vt]) :: "memory");
                  if (vt < 4) { sfr[vt][0] = *(const bf16x8*)(sp + (size_t)(vt + 4) * 1024); sfr[vt][1] = *(const bf16x8*)(sp + (size_t)(vt + 4) * 1024 + 32); } } }
            LDS_BARRIER();
        }
        LDS_WAIT();
        if (MODE < 2) { bf16x8 pfr[2][2];
#pragma unroll
          for (int tti = 0; tti < 2; ++tti)
#pragma unroll
              for (int ks = 0; ks < 2; ++ks) pfr[tti][ks] = *(const LAS bf16x8*)(lds + G5_P + ((h * 64 + (2 * half + tti) * 16 + i) * 72 + 32 * ks + 8 * g) * 2);
          const bf16* vp = ((const bf16*)(F.ws + WS_VT)) + (((size_t)b * 64 + n) * 4 + h) * 8192 + (size_t)i * 64 + 8 * g;
          bf16x8 vfr[8][2];
#pragma unroll
          for (int vt = 0; vt < 8; ++vt) { vfr[vt][0] = *(const bf16x8*)(vp + (size_t)vt * 1024); vfr[vt][1] = *(const bf16x8*)(vp + (size_t)vt * 1024 + 32); }
          { const int itn = it + F.G; if (itn < NBATCH * 64) { const int bn_ = itn >> 6, nn_ = itn & 63; const char* pr = (const char*)(P + ((size_t)bn_ * SEQ + nn_ * 64 + (tid >> 3)) * PW); const int j = tid & 7;
                pfv[0] = *(const unsigned*)(pr + 128 * j); pfv[1] = *(const unsigned*)(pr + 2048 + 128 * j); if (j == 0) pfv[2] = *(const unsigned*)(pr + 3072);
                const char* sb = (const char*)(((const bf16*)(F.ws + WS_S)) + (((size_t)bn_ * 64 + nn_) * 4) * 8192) + (size_t)tid * 128;
                pfv[6] = *(const unsigned*)sb; pfv[7] = *(const unsigned*)(sb + (size_t)NBATCH * 64 * 4 * 8192 * 2);
                pfv[8] = *(const unsigned*)((const char*)(((const bf16*)(F.ws + WS_VT)) + (((size_t)bn_ * 64 + nn_) * 4) * 8192) + (size_t)tid * 128); } }
#pragma unroll
          for (int vt = 0; vt < 8; ++vt)
#pragma unroll
              for (int tti = 0; tti < 2; ++tti) { oacc[tti][vt] = __builtin_amdgcn_mfma_f32_16x16x32_bf16(vfr[vt][0], pfr[tti][0], oacc[tti][vt], 0, 0, 0); oacc[tti][vt] = __builtin_amdgcn_mfma_f32_16x16x32_bf16(vfr[vt][1], pfr[tti][1], oacc[tti][vt], 0, 0, 0); } }
#pragma unroll
        for (int tti = 0; tti < (MODE >= 2 ? 0 : 2); ++tti) { const int t = (2 * half + tti) * 16 + i; float ss = 0.f;
#pragma unroll
            for (int vt = 0; vt < 8; ++vt) { const f32x4 a = oacc[tti][vt]; ss += (a[0] * a[0] + a[1] * a[1]) + (a[2] * a[2] + a[3] * a[3]); }
            ss += __shfl_xor(ss, 16); ss += __shfl_xor(ss, 32);
            const float rstd = 1.0f / sqrtf(ss * (1.0f / 128.0f) + EPS);
#pragma unroll
            for (int vt = 0; vt < 8; ++vt) { const int v = vt * 16 + 4 * g; const f32x4 gw = *(const f32x4*)(A->in[12] + v); const v2u rw = *(const v2u*)(P + (prow + t) * PW + CR + h * 128 + v);
                const float r[4] = {bflo(rw.x), bfhi(rw.x), bflo(rw.y), bfhi(rw.y)}; float y[4];
#pragma unroll
                for (int j = 0; j < 4; ++j) y[j] = oacc[tti][vt][j] * rstd * gw[j] * (r[j] * __builtin_amdgcn_rcpf(1.0f + __builtin_amdgcn_exp2f(r[j] * -1.4426950409f)));
                if (OUTPROJ_F8) *(LAS unsigned*)(st + i * 144 + v) = pk4_fp8(y[0], y[1], y[2], y[3]);
                else { v2u w; w.x = pk2(y[0], y[1]); w.y = pk2(y[2], y[3]);
                    *(LAS v2u*)(st + i * 272 + v * 2) = w; }
                if ((vt & 3) == 3) asm volatile("" ::: "memory"); }
            LDS_WAIT();
            if (OUTPROJ_F8) {
#pragma unroll
                for (int j = 0; j < 2; ++j) { const int pc = lane + 64 * j, row = pc >> 3, ch = pc & 7;
                    *(v4u*)(F.ws + WS_YMIX + (prow + (2 * half + tti) * 16 + row) * D + h * 128 + ch * 16) = *(const LAS v4u*)(st + row * 144 + ch * 16); } }
            else {
#pragma unroll
                for (int j = 0; j < 4; ++j) { const int pc = lane + 64 * j, row = pc >> 4, ch = pc & 15;
                    *(v4u*)(((bf16*)(F.ws + WS_YMIX)) + (prow + (2 * half + tti) * 16 + row) * D + h * 128 + ch * 8) = *(const LAS v4u*)(st + row * 272 + ch * 16); } }
            LDS_WAIT(); }
#pragma unroll
        for (int q = 0; q < 9; ++q) asm volatile("" :: "v"(pfv[q]));
        LDS_BARRIER();
    }
    if (MODE < 1) { int tc_ = F.tid; asm volatile("" : "+v"(tc_)); conv_stream(F, A, tc_); }
}

__device__ __forceinline__ void p4_phase(const Frame& F, CArgs* A) {
    int tid_ = threadIdx.x; asm volatile("" : "+v"(tid_));
    const int tid = tid_;
    for (int idx = F.bid * NTHREADS + tid; idx < 2 * NBATCH * 4 * 1024; idx += F.G * NTHREADS) {
        const int e8 = idx & 1023, ch = idx >> 10, h = ch & 3, b = (ch >> 2) & 15, dir = ch >> 6; const int d0 = (e8 & 7) * 8;
        float s[8];
#pragma unroll
        for (int j = 0; j < 8; ++j) s[j] = 0.f;
#pragma unroll 17
        for (int st = 0; st < NCC; ++st) {
            const int cc = dir ? (st < 4 ? 3 - st : 71 - st) : st;
            const size_t ci = ((size_t)dir * NBATCH + b) * NCC + cc;
            const v4u kv = *(const v4u*)(((bf16*)(F.ws + WS_KV)) + (ci * 4 + h) * 8192 + (size_t)e8 * 8);
            const f32x4 dc0 = *(const f32x4*)(((float*)(F.ws + WS_DECAY)) + ci * 256 + h * 64 + d0), dc1 = *(const f32x4*)(((float*)(F.ws + WS_DECAY)) + ci * 256 + h * 64 + d0 + 4);
            if (cc >= 4) { v4u w; w.x = pk2(s[0], s[1]); w.y = pk2(s[2], s[3]); w.z = pk2(s[4], s[5]); w.w = pk2(s[6], s[7]);
                *(v4u*)(((bf16*)(F.ws + WS_S)) + ((((size_t)dir * NBATCH + b) * 64 + (cc - 4)) * 4 + h) * 8192 + (size_t)e8 * 8) = w; }
            s[0] = s[0] * dc0[0] + bflo(kv.x); s[1] = s[1] * dc0[1] + bfhi(kv.x); s[2] = s[2] * dc0[2] + bflo(kv.y); s[3] = s[3] * dc0[3] + bfhi(kv.y);
            s[4] = s[4] * dc1[0] + bflo(kv.z); s[5] = s[5] * dc1[1] + bfhi(kv.z); s[6] = s[6] * dc1[2] + bflo(kv.w); s[7] = s[7] * dc1[3] + bfhi(kv.w);
        }
    }
}

__device__ __forceinline__ void p5a_phase(const Frame& F, CArgs* A) {
    LAS unsigned char* lds = F.lds; const int tid = F.tid, lane = F.lane, wave = F.wave, i = lane & 15, g = lane >> 4;
    GlaRegs cur; if (F.bid < NBATCH * 64 * 4) cur = gla_load(F, (size_t)(F.bid >> 2) * 64, F.bid & 3);
    f32x4 gw[4];
#pragma unroll
    for (int k = 0; k < 4; ++k) gw[k] = *(const f32x4*)(A->in[12] + ((wave >> 2) * 4 + k) * 16 + 4 * g);
    for (int it = F.bid; it < NBATCH * 64 * 4; it += F.G) {
        const int h = it & 3, bn = it >> 2, b = bn >> 6, n = bn & 63; const size_t prow = (size_t)b * SEQ + n * 64;
        GlaRegs nxt = cur; { const int itn = it + F.G; if (itn < NBATCH * 64 * 4) nxt = gla_load(F, (size_t)(itn >> 2) * 64, itn & 3); }
        v4u qw, kw; { const int t = tid >> 3, d0 = (tid & 7) * 8; qw = *(const v4u*)(((bf16*)(F.ws + WS_P)) + (prow + t) * PW + CQ + h * 64 + d0); kw = *(const v4u*)(((bf16*)(F.ws + WS_P)) + (prow + t) * PW + CK + h * 64 + d0); }
        gla_prep(F, A, cur, h); cur = nxt;
        bf16x8 sfr[4][2][2]; v2u rwv[4];
        { const int tt = wave & 3, vh = wave >> 2, t = tt * 16 + i;
#pragma unroll
          for (int k = 0; k < 4; ++k) { const int vt = vh * 4 + k;
#pragma unroll
              for (int dir = 0; dir < 2; ++dir) { const bf16* sp = ((bf16*)(F.ws + WS_S)) + ((((size_t)dir * NBATCH + b) * 64 + n) * 4 + h) * 8192 + (size_t)(vt * 16 + i) * 64 + 8 * g;
                  sfr[k][dir][0] = *(const bf16x8*)sp; sfr[k][dir][1] = *(const bf16x8*)(sp + 32); }
              rwv[k] = *(const v2u*)(((bf16*)(F.ws + WS_P)) + (prow + t) * PW + CR + h * 128 + vt * 16 + 4 * g); } }
        { const int t = tid >> 3, d0 = (tid & 7) * 8;
          const float q[8] = {bflo(qw.x), bfhi(qw.x), bflo(qw.y), bfhi(qw.y), bflo(qw.z), bfhi(qw.z), bflo(qw.w), bfhi(qw.w)};
          const float k[8] = {bflo(kw.x), bfhi(kw.x), bflo(kw.y), bfhi(kw.y), bflo(kw.z), bfhi(kw.z), bflo(kw.w), bfhi(kw.w)};
#pragma unroll
          for (int dir = 0; dir < 2; ++dir) { const LAS float* bp = (const LAS float*)(lds + GL_BC) + dir * 4096 + t * 64 + d0;
              const f32x4 b0 = *(const LAS f32x4*)bp, b1 = *(const LAS f32x4*)(bp + 4); const float bb[8] = {b0[0], b0[1], b0[2], b0[3], b1[0], b1[1], b1[2], b1[3]};
              float qd[8], ki[8];
#pragma unroll
              for (int j = 0; j < 8; ++j) { qd[j] = q[j] * __expf(bb[j]) * 0.125f; ki[j] = k[j] * __expf(-bb[j]); }
              v4u w; w.x = pk2(qd[0], qd[1]); w.y = pk2(qd[2], qd[3]); w.z = pk2(qd[4], qd[5]); w.w = pk2(qd[6], qd[7]);
              *(LAS v4u*)(lds + GL_A + ((dir * 64 + t) * 72 + d0) * 2) = w;
              w.x = pk2(ki[0], ki[1]); w.y = pk2(ki[2], ki[3]); w.z = pk2(ki[4], ki[5]); w.w = pk2(ki[6], ki[7]);
              *(LAS v4u*)(lds + GL_B + ((dir * 64 + t) * 72 + d0) * 2) = w; } }
        __syncthreads();
#pragma unroll
        for (int kk = 0; kk < 2; ++kk) { const int pi = wave * 2 + kk, tt = pi >> 2, st = pi & 3;
            f32x4 aF = {0.f, 0.f, 0.f, 0.f}, aB = {0.f, 0.f, 0.f, 0.f};
            if (st <= tt) {
#pragma unroll
                for (int ks = 0; ks < 2; ++ks) { const bf16x8 kf = *(const LAS bf16x8*)(lds + GL_B + ((st * 16 + i) * 72 + 32 * ks + 8 * g) * 2), qf = *(const LAS bf16x8*)(lds + GL_A + ((tt * 16 + i) * 72 + 32 * ks + 8 * g) * 2);
                    aF = __builtin_amdgcn_mfma_f32_16x16x32_bf16(kf, qf, aF, 0, 0, 0); } }
            if (st >= tt) {
#pragma unroll
                for (int ks = 0; ks < 2; ++ks) { const bf16x8 kf = *(const LAS bf16x8*)(lds + GL_B + ((64 + st * 16 + i) * 72 + 32 * ks + 8 * g) * 2), qf = *(const LAS bf16x8*)(lds + GL_A + ((64 + tt * 16 + i) * 72 + 32 * ks + 8 * g) * 2);
                    aB = __builtin_amdgcn_mfma_f32_16x16x32_bf16(kf, qf, aB, 0, 0, 0); } }
            const int t = tt * 16 + i, s0 = st * 16 + 4 * g; float p[4];
#pragma unroll
            for (int r = 0; r < 4; ++r) p[r] = ((s0 + r <= t) ? aF[r] : 0.f) + ((s0 + r >= t) ? aB[r] : 0.f);
            v2u w; w.x = pk2(p[0], p[1]); w.y = pk2(p[2], p[3]);
            *(LAS v2u*)(lds + GL_P + (t * 72 + s0) * 2) = w; }
        __syncthreads();
        { const int tt = wave & 3, vh = wave >> 2; const int t = tt * 16 + i;
          bf16x8 pf[2], qf[2][2];
#pragma unroll
          for (int ks = 0; ks < 2; ++ks) { pf[ks] = *(const LAS bf16x8*)(lds + GL_P + (t * 72 + 32 * ks + 8 * g) * 2);
              qf[0][ks] = *(const LAS bf16x8*)(lds + GL_A + (t * 72 + 32 * ks + 8 * g) * 2); qf[1][ks] = *(const LAS bf16x8*)(lds + GL_A + ((64 + t) * 72 + 32 * ks + 8 * g) * 2); }
          f32x4 acc[4]; float ss = 0.f;
#pragma unroll
          for (int k = 0; k < 4; ++k) { const int vt = vh * 4 + k; f32x4 a = {0.f, 0.f, 0.f, 0.f};
              { bf16x8 vf0, vf1; v_frag2(lds, vt * 16, lane, vf0, vf1); a = __builtin_amdgcn_mfma_f32_16x16x32_bf16(vf0, pf[0], a, 0, 0, 0); a = __builtin_amdgcn_mfma_f32_16x16x32_bf16(vf1, pf[1], a, 0, 0, 0); }
#pragma unroll
              for (int dir = 0; dir < 2; ++dir)
#pragma unroll
                  for (int ks = 0; ks < 2; ++ks) a = __builtin_amdgcn_mfma_f32_16x16x32_bf16(sfr[k][dir][ks], qf[dir][ks], a, 0, 0, 0);
              acc[k] = a; ss += (a[0] * a[0] + a[1] * a[1]) + (a[2] * a[2] + a[3] * a[3]); }
          ss += __shfl_xor(ss, 16); ss += __shfl_xor(ss, 32);
          if (g == 0) ((LAS float*)(lds + GL_SS))[vh * 64 + t] = ss;
          __syncthreads();
          const float tot = ((const LAS float*)(lds + GL_SS))[t] + ((const LAS float*)(lds + GL_SS))[64 + t];
          const float rstd = 1.0f / sqrtf(tot * (1.0f / 128.0f) + EPS);
#pragma unroll
          for (int k = 0; k < 4; ++k) { const int v = (vh * 4 + k) * 16 + 4 * g;
              const v2u rw = rwv[k];
              const float r[4] = {bflo(rw.x), bfhi(rw.x), bflo(rw.y), bfhi(rw.y)}; float y[4];
#pragma unroll
              for (int j = 0; j < 4; ++j) y[j] = acc[k][j] * rstd * gw[k][j] * (r[j] * __builtin_amdgcn_rcpf(1.0f + __expf(-r[j])));
              v2u w; w.x = pk2(y[0], y[1]); w.y = pk2(y[2], y[3]);
              *(v2u*)(((bf16*)(F.ws + WS_YMIX)) + (prow + t) * D + h * 128 + v) = w; } }
        __syncthreads();
    }
    for (int it = F.bid; it < NBATCH * 64; it += F.G) {
        const size_t prow = (size_t)it * 64;
#pragma unroll 1
        for (int rep = 0; rep < 8; ++rep) { const int idx = tid + rep * NTHREADS, t = idx >> 6, c0 = (idx & 63) * 8;
            float cv[8];
#pragma unroll
            for (int j = 0; j < 8; ++j) cv[j] = 0.f;
#pragma unroll
            for (int dt = -1; dt <= 1; ++dt) { const int tt = t + dt; if (tt >= 0 && tt < 64) {
                const v4u cw = *(const v4u*)(((bf16*)(F.ws + WS_P)) + (prow + tt) * PW + CPC + c0), xw = *(const v4u*)(((bf16*)(F.ws + WS_P)) + (prow + tt) * PW + CPX + c0);
                const f32x4 w0 = *(const f32x4*)(A->in[13] + (dt + 1) * 512 + c0), w1 = *(const f32x4*)(A->in[13] + (dt + 1) * 512 + c0 + 4);
                cv[0] += w0[0] * bflo(cw.x) * bflo(xw.x); cv[1] += w0[1] * bfhi(cw.x) * bfhi(xw.x); cv[2] += w0[2] * bflo(cw.y) * bflo(xw.y); cv[3] += w0[3] * bfhi(cw.y) * bfhi(xw.y);
                cv[4] += w1[0] * bflo(cw.z) * bflo(xw.z); cv[5] += w1[1] * bfhi(cw.z) * bfhi(xw.z); cv[6] += w1[2] * bflo(cw.w) * bflo(xw.w); cv[7] += w1[3] * bfhi(cw.w) * bfhi(xw.w); } }
            const v4u bw = *(const v4u*)(((bf16*)(F.ws + WS_P)) + (prow + t) * PW + CPB + c0);
            v4u w; w.x = pk2(cv[0] * bflo(bw.x), cv[1] * bfhi(bw.x)); w.y = pk2(cv[2] * bflo(bw.y), cv[3] * bfhi(bw.y)); w.z = pk2(cv[4] * bflo(bw.z), cv[5] * bfhi(bw.z)); w.w = pk2(cv[6] * bflo(bw.w), cv[7] * bfhi(bw.w));
            *(v4u*)(((bf16*)(F.ws + WS_YMIX)) + (prow + t) * D + 512 + c0) = w; }
    }
}

constexpr int RT_W = 0;
constexpr int RT_LG = 32 * 1032 * 2;
constexpr int RT_HIST = RT_LG + 128 * 33 * 4;
constexpr int RT_WC = RT_HIST + 256;
__device__ __forceinline__ void p5c_phase(const Frame& F, CArgs* A) {
    LAS unsigned char* lds = F.lds; const int tid = F.tid, lane = F.lane, wave = F.wave, i = lane & 15, g = lane >> 4;
#pragma unroll 1
    for (int i0 = 0; i0 < 32768; i0 += 16 * NTHREADS) { float rv[16];
#pragma unroll
        for (int q = 0; q < 16; ++q) rv[q] = A->in[16][i0 + q * NTHREADS + tid];
#pragma unroll
        for (int q = 0; q < 16; ++q) { const int idx = i0 + q * NTHREADS + tid, k = idx >> 5, e = idx & 31; *(LAS bf16*)(lds + RT_W + (e * 1032 + k) * 2) = (bf16)f2bf(rv[q]); } }
    LAS int* hist = (LAS int*)(lds + RT_HIST); LAS float* lg = (LAS float*)(lds + RT_LG);
    unsigned* gcnt = ((unsigned*)(F.ws + WS_CTL)) + CW_CNT;
    __syncthreads();
#pragma unroll 1
    for (int it = F.bid; it < NLAT / 128; it += F.G) {
        const int R = it * 128 + wave * 16 + i, b = it >> 5;
        const bf16* yg = ((const bf16*)(F.ws + WS_Y1)) + (size_t)R * D + 8 * g;
        unsigned char* hn2g = (unsigned char*)F.out + DO_HN2 + (size_t)R * D + 8 * g;
        const LAS unsigned char* rw0 = lds + RT_W + (i * 1032 + 8 * g) * 2; const LAS unsigned char* rw1 = rw0 + 16 * 1032 * 2;
        if (tid < 32) hist[tid] = 0;
        { const int c0 = 2 * tid; const f32x2 w_ = *(const f32x2*)(A->in[15] + c0), c_ = *(const f32x2*)(((float*)(F.ws + WS_MOD)) + (size_t)b * 6144 + 4096 + c0), s_ = *(const f32x2*)(((float*)(F.ws + WS_MOD)) + (size_t)b * 6144 + 3072 + c0);
          *(LAS f32x2*)(lds + RT_WC + c0 * 4) = w_ * (c_ + 1.0f); *(LAS f32x2*)(lds + RT_WC + 4096 + c0 * 4) = s_; }
        v4u yv[32];
#pragma unroll
        for (int ks = 0; ks < 32; ++ks) yv[ks] = *(const v4u*)(yg + 32 * ks);
        float ss = 0.f;
#pragma unroll
        for (int ks = 0; ks < 32; ++ks) { const v4u yw = yv[ks];
            const float h0 = bflo(yw.x), h1 = bfhi(yw.x), h2 = bflo(yw.y), h3 = bfhi(yw.y), h4 = bflo(yw.z), h5 = bfhi(yw.z), h6 = bflo(yw.w), h7 = bfhi(yw.w);
            ss += (h0 * h0 + h1 * h1) + (h2 * h2 + h3 * h3) + (h4 * h4 + h5 * h5) + (h6 * h6 + h7 * h7); }
        ss += __shfl_xor(ss, 16); ss += __shfl_xor(ss, 32);
        const float rstd = 1.0f / sqrtf(ss * (1.f / D) + EPS);
#pragma unroll
        for (int ks = 0; ks < 32; ++ks) asm volatile("" : "+v"(yv[ks]));
        LDS_BARRIER();
        f32x4 l0 = {0.f, 0.f, 0.f, 0.f}, l1 = {0.f, 0.f, 0.f, 0.f};
        const LAS unsigned char* wcg = lds + RT_WC + 32 * g;
#pragma unroll
        for (int ks = 0; ks < 32; ++ks) {
            const v4u yw = yv[ks];
            const f32x4 a0 = {bflo(yw.x), bfhi(yw.x), bflo(yw.y), bfhi(yw.y)}, a1 = {bflo(yw.z), bfhi(yw.z), bflo(yw.w), bfhi(yw.w)};
            const f32x4 c0 = *(const LAS f32x4*)(wcg + 128 * ks), c1 = *(const LAS f32x4*)(wcg + 128 * ks + 16), s0 = *(const LAS f32x4*)(wcg + 4096 + 128 * ks), s1 = *(const LAS f32x4*)(wcg + 4096 + 128 * ks + 16);
            const f32x4 y0 = (a0 * rstd) * c0 + s0, y1 = (a1 * rstd) * c1 + s1;
            v4u w; w.x = pk2(y0[0], y0[1]); w.y = pk2(y0[2], y0[3]); w.z = pk2(y1[0], y1[1]); w.w = pk2(y1[2], y1[3]);
            { v2u w8; w8.x = pk4_fp8(y0[0], y0[1], y0[2], y0[3]); w8.y = pk4_fp8(y1[0], y1[1], y1[2], y1[3]); *(v2u*)(hn2g + 32 * ks) = w8; }
            const bf16x8 af = __builtin_bit_cast(bf16x8, w);
            const bf16x8 r0 = *(const LAS bf16x8*)(rw0 + 64 * ks), r1 = *(const LAS bf16x8*)(rw1 + 64 * ks);
            l0 = __builtin_amdgcn_mfma_f32_16x16x32_bf16(af, r0, l0, 0, 0, 0); l1 = __builtin_amdgcn_mfma_f32_16x16x32_bf16(af, r1, l1, 0, 0, 0);
            asm volatile("" : "+v"(l0), "+v"(l1) :: "memory"); }
        { const float rb0 = A->in[17][i], rb1 = A->in[17][16 + i];
#pragma unroll
          for (int r = 0; r < 4; ++r) { lg[(wave * 16 + 4 * g + r) * 33 + i] = l0[r] + rb0; lg[(wave * 16 + 4 * g + r) * 33 + 16 + i] = l1[r] + rb1; } }
        __syncthreads();
        int te[4] = {0, 0, 0, 0}; float tv[4] = {-3.0e38f, -3.0e38f, -3.0e38f, -3.0e38f}; int lp[4] = {0, 0, 0, 0};
        if (lane < 16) { const LAS float* lr = lg + (wave * 16 + lane) * 33;
            for (int e = 0; e < 32; ++e) { const float x = lr[e];
                if (x > tv[3]) { if (x > tv[2]) { tv[3] = tv[2]; te[3] = te[2]; if (x > tv[1]) { tv[2] = tv[1]; te[2] = te[1]; if (x > tv[0]) { tv[1] = tv[0]; te[1] = te[0]; tv[0] = x; te[0] = e; } else { tv[1] = x; te[1] = e; } } else { tv[2] = x; te[2] = e; } } else { tv[3] = x; te[3] = e; } } }
            const float e1 = __expf(tv[1] - tv[0]), e2 = __expf(tv[2] - tv[0]), e3 = __expf(tv[3] - tv[0]), inv = 1.0f / (1.0f + e1 + e2 + e3);
            tv[0] = inv; tv[1] = e1 * inv; tv[2] = e2 * inv; tv[3] = e3 * inv;
#pragma unroll
            for (int k = 0; k < 4; ++k) lp[k] = __hip_atomic_fetch_add(&hist[te[k]], 1, __ATOMIC_RELAXED, __HIP_MEMORY_SCOPE_WORKGROUP); }
        __syncthreads();
        if (tid < 32) { const int c = hist[tid]; hist[32 + tid] = c ? (int)__hip_atomic_fetch_add(gcnt + tid, (unsigned)c, RLX_AGENT) : 0; }
        __syncthreads();
        if (lane < 16) { const int Rt = it * 128 + wave * 16 + lane;
#pragma unroll
            for (int k = 0; k < 4; ++k) { const size_t pos = (size_t)te[k] * LISTCAP + hist[32 + te[k]] + lp[k]; ((int*)((unsigned char*)F.out + DO_LAID))[pos] = Rt * 4 + k;
                ((int*)(F.ws + WS_TSLOT))[Rt * 4 + k] = (te[k] << 20) | (hist[32 + te[k]] + lp[k]); ((float*)(F.ws + WS_TW))[Rt * 4 + k] = tv[k]; } }
        __syncthreads();
    }
}

constexpr int P8NR = 1;
struct P8Slots { int ep[P8NR][4]; float wk[P8NR][4]; };
struct P8Rows { int yw8[P8NR][4][4]; v2u hw[P8NR][4]; float wk[P8NR][4]; f32x4 g2v[4]; };
__device__ __forceinline__ int p8_row(int gw, int NGW, int k, int a) { const int r = P8NR * (gw + k * NGW) + a; return r < NLAT ? r : P8NR * gw + a; }
__device__ __forceinline__ void p8_slots(const Frame& F, int gw, int NGW, int k, P8Slots& S) {
#pragma unroll
    for (int a = 0; a < P8NR; ++a) { const int r = p8_row(gw, NGW, k, a);
#pragma unroll
        for (int q = 0; q < 4; ++q) { S.ep[a][q] = ((const int*)(F.ws + WS_TSLOT))[r * 4 + q]; S.wk[a][q] = ((const float*)(F.ws + WS_TW))[r * 4 + q]; } }
}
__device__ __forceinline__ void p8_rows(const Frame& F, const LAS int* TS, int lane, int gw, int NGW, int k, const P8Slots& S, P8Rows& R) {
#pragma unroll
    for (int a = 0; a < P8NR; ++a) { const int r = p8_row(gw, NGW, k, a); const bf16* yr = ((const bf16*)(F.ws + WS_Y1)) + (size_t)r * D;
#pragma unroll
        for (int q = 0; q < 4; ++q) { const int* ys = (const int*)((const unsigned char*)(F.ws + WS_YA) + ((size_t)TS[S.ep[a][q] >> 20] * 256 + (S.ep[a][q] & 0xFFFFF)) * D); R.wk[a][q] = S.wk[a][q];
#pragma unroll
            for (int j = 0; j < 4; ++j) R.yw8[a][q][j] = ys[lane + 64 * j]; }
#pragma unroll
        for (int j = 0; j < 4; ++j) R.hw[a][j] = ((const v2u*)yr)[lane + 64 * j]; }
    { const float* g2 = ((float*)(F.ws + WS_MOD)) + (size_t)(p8_row(gw, NGW, k, 0) >> 12) * 6144 + 5120;
#pragma unroll
      for (int j = 0; j < 4; ++j) R.g2v[j] = ((const f32x4*)g2)[lane + 64 * j]; }
}
__device__ __forceinline__ void p8_pin(P8Rows& R) {
    asm volatile("" ::: "memory");
#pragma unroll
    for (int a = 0; a < P8NR; ++a) {
#pragma unroll
        for (int q = 0; q < 4; ++q) { asm volatile("" : "+v"(R.wk[a][q]));
#pragma unroll
            for (int j = 0; j < 4; ++j) asm volatile("" : "+v"(R.yw8[a][q][j])); }
#pragma unroll
        for (int j = 0; j < 4; ++j) asm volatile("" : "+v"(R.hw[a][j])); }
#pragma unroll
    for (int j = 0; j < 4; ++j) asm volatile("" : "+v"(R.g2v[j]));
}
__device__ __forceinline__ void p8_emit(const Frame& F, const f32x4 (&fw)[4], int lane, int gw, int NGW, int k, const P8Rows& R) {
#pragma unroll
    for (int a = 0; a < P8NR; ++a) { const int r = p8_row(gw, NGW, k, a); float* hr = F.out + (size_t)r * D;
        f32x4 v[4]; float s = 0.f;
#pragma unroll
        for (int j = 0; j < 4; ++j) { const int c4 = lane + 64 * j; f32x4 y = {0.f, 0.f, 0.f, 0.f};
#pragma unroll
            for (int q = 0; q < 4; ++q) { const int w = R.yw8[a][q][j]; const f32x2 lo = __builtin_amdgcn_cvt_pk_f32_fp8(w, false), hi = __builtin_amdgcn_cvt_pk_f32_fp8(w, true);
                y[0] += R.wk[a][q] * lo[0]; y[1] += R.wk[a][q] * lo[1]; y[2] += R.wk[a][q] * hi[0]; y[3] += R.wk[a][q] * hi[1]; }
            const v2u yw = R.hw[a][j]; const f32x4 y1 = {bflo(yw.x), bfhi(yw.x), bflo(yw.y), bfhi(yw.y)};
            v[j] = y1 + R.g2v[j] * y;
            s += (v[j].x * v[j].x + v[j].y * v[j].y) + (v[j].z * v[j].z + v[j].w * v[j].w); }
        const float rstd = 1.0f / sqrtf(wave_sum(s) * (1.f / D) + EPS);
#pragma unroll
        for (int j = 0; j < 4; ++j) { const int c4 = lane + 64 * j; ((f32x4*)hr)[c4] = (v[j] * rstd) * fw[j]; } }
}
__device__ __forceinline__ void p8_phase(const Frame& F, CArgs* A, const LAS int* TS) {
    int tid_ = threadIdx.x; asm volatile("" : "+v"(tid_));
    const int lane = tid_ & 63;
    const int gw = F.bid * NWAVES + F.wave, NGW = F.G * NWAVES;
    if (P8NR * gw >= NLAT) return;
    const int K = (NLAT / P8NR - gw + NGW - 1) / NGW;
    f32x4 fw[4];
#pragma unroll
    for (int j = 0; j < 4; ++j) fw[j] = ((const f32x4*)A->in[22])[lane + 64 * j];
    P8Slots Sa, Sb; P8Rows Ra, Rb;
    p8_slots(F, gw, NGW, 0, Sa); p8_rows(F, TS, lane, gw, NGW, 0, Sa, Ra); p8_slots(F, gw, NGW, 1, Sb);
#pragma unroll 1
    for (int k = 0; k < K; k += 2) {
        int l_ = threadIdx.x; asm volatile("" : "+v"(l_)); l_ &= 63;
        p8_slots(F, gw, NGW, k + 2, Sa); p8_rows(F, TS, l_, gw, NGW, k + 1, Sb, Rb); p8_pin(Ra);
        p8_emit(F, fw, l_, gw, NGW, k, Ra);
        p8_slots(F, gw, NGW, k + 3, Sb); p8_rows(F, TS, l_, gw, NGW, k + 2, Sa, Ra); p8_pin(Rb);
        p8_emit(F, fw, l_, gw, NGW, k + 1, Rb);
    }
}

constexpr int NPHASES = 11;
__global__ void __launch_bounds__(NTHREADS, 2) fwd_kernel(Args args) {
    extern __shared__ __attribute__((aligned(16))) unsigned char lds_raw[];
    Frame F;
    F.lds = (LAS unsigned char*)lds_raw;
    F.tid = threadIdx.x; F.lane = F.tid & 63; F.wave = __builtin_amdgcn_readfirstlane(F.tid >> 6); F.G = gridDim.x; F.bid = blockIdx.x;
    F.out = args.out; F.ws = args.ws;
        for (int u = F.tid; u < (LDS_BYTES - MISC_OFF) / 4; u += NTHREADS) ((LAS unsigned*)(F.lds + MISC_OFF))[u] = 0u;
    __syncthreads();
    volatile LAS unsigned* MISC = (volatile LAS unsigned*)(F.lds + MISC_OFF);
    LAS int* TS = (LAS int*)(F.lds + MISC_OFF + 256);
    const int lo = args.ph_lo, hi = args.ph_hi;
    const bool multi = (hi - lo) > 1;
    XcdBarrier bar; bar.bar = (unsigned*)((unsigned*)(F.ws + WS_CTL)) + CW_BAR; bar.x = 0; bar.st = nullptr;
    if (multi) bar = xcd_barrier_post((unsigned*)((unsigned*)(F.ws + WS_CTL)) + CW_BAR, MISC + 8);
#ifndef PHMASK
#define PHMASK 0x7ff
#endif
#define IN(k) (((PHMASK >> (k)) & 1) && lo <= (k) && (k) < hi)
#define BUILD_TS() do { if (F.tid < NEXP) TS[33 + F.tid] = (int)__hip_atomic_load(((unsigned*)(F.ws + WS_CTL)) + CW_CNT + F.tid, RLX_AGENT);     \
        __syncthreads(); \
        if (F.tid == 0) { int acc_ = 0; for (int e = 0; e < NEXP; ++e) { TS[e] = acc_; acc_ += (TS[33 + e] + 255) >> 8; } TS[32] = acc_; } __syncthreads(); \
        for (int t_ = F.tid; t_ < TS[32]; t_ += NTHREADS) { int e_ = 0; for (int k_ = 1; k_ < NEXP; ++k_) e_ = (TS[k_] <= t_) ? k_ : e_; ((LAS unsigned char*)(TS + 72))[t_] = (unsigned char)e_; } \
        __syncthreads(); } while (0)
#define SEAM(k) do { if (IN(k) && IN((k) + 1)) xcd_barrier(bar); } while (0)
#ifndef PROBE_DUP
#define PROBE_DUP 0
#endif
#define REPS(k) for (int rep_ = 0; rep_ < (((PROBE_DUP >> (k)) & 1) ? 2 : 1); ++rep_)

    if (IN(0)) REPS(0) { p0_phase(F, opaque_args()); } SEAM(0);
    if (IN(1)) REPS(1) { p1_phase(F, opaque_args()); } SEAM(1);
    if (IN(2)) REPS(2) { DenseSched S; S.init(NROWS, PWP, F.G, F.bid, ((bf16*)(F.ws + WS_WIN))); S.build((LAS int*)(TS + 400), F.tid); EpiProj E{((bf16*)(F.ws + WS_P))};
        pg8::gemm_phase<EpiProj, DenseSched, true, false>(F.lds, (const char*)((bf16*)(F.ws + WS_HN)), S, E);
#ifdef PROBE_INNULL
        { EpiNull E0; pg8::gemm_phase<EpiNull, DenseSched, true, false>(F.lds, (const char*)((bf16*)(F.ws + WS_HN)), S, E0); }
#endif
    } SEAM(2);
    if (IN(3)) { p3v3_phase<0>(F, opaque_args());
#ifdef PROBE_P3
        p3v3_phase<PROBE_P3>(F, opaque_args());
#endif
    } SEAM(3);
    if (IN(4)) REPS(4) { p4_phase(F, opaque_args()); } SEAM(4);
    if (IN(5)) {
#ifdef PROBE_P5
        p5a_phase(F, opaque_args()); p5av3_phase<PROBE_P5>(F, opaque_args());
#else
        p5av3_phase<0>(F, opaque_args());
#endif
    } SEAM(5);
    if (IN(6)) REPS(6) { DenseSched S; S.init(NLAT, D, F.G, F.bid, ((bf16*)(F.ws + WS_WOUT))); S.kb = OUTPROJ_F8 ? 1024 : 2048; S.build((LAS int*)(TS + 400), F.tid); EpiOut E{opaque_args()->in[0], ((float*)(F.ws + WS_MOD)), ((bf16*)(F.ws + WS_Y1)), OUTPROJ_F8 ? 1.0f / WSCALE : 1.0f};
        pg8::gemm_phase<EpiOut, DenseSched, true, OUTPROJ_F8 != 0>(F.lds, (const char*)((bf16*)(F.ws + WS_YMIX)), S, E); } SEAM(6);
    if (IN(7)) { p5c_phase(F, opaque_args()); } SEAM(7);
#pragma unroll 1
    for (int ph = 8; ph < 10; ++ph) {
        if (IN(ph)) {
            const bool gu = (ph == 8);
            BUILD_TS();
            const int ntr = TS[32];
            REPS(ph) {
                if (gu) { MoeSched<true> S; S.TS = TS; S.ntr = ntr; S.G = F.G; S.c = F.bid; S.laid = ((int*)((unsigned char*)F.out + DO_LAID)); S.W = (const char*)F.out + DO_WGU;
                    EpiGU E{(unsigned char*)(F.ws + WS_ACT), opaque_args()->in[19]}; pg8::gemm_phase<EpiGU, MoeSched<true>, true, true>(F.lds, (const char*)((unsigned char*)F.out + DO_HN2), S, E);
#ifdef PROBE_GUNULL
                    { EpiNull E0; pg8::gemm_phase<EpiNull, MoeSched<true>, true, true>(F.lds, (const char*)((unsigned char*)F.out + DO_HN2), S, E0); }
#endif
                }
                else { MoeSched<false> S; S.TS = TS; S.ntr = ntr; S.G = F.G; S.c = F.bid; S.laid = nullptr; S.W = (const char*)F.out + DO_WDN;
                    EpiDN E{(unsigned char*)(F.ws + WS_YA), opaque_args()->in[21], TS}; pg8::gemm_phase<EpiDN, MoeSched<false>, true, true>(F.lds, (const char*)(F.ws + WS_ACT), S, E); }
            }
        }
        SEAM(ph);
    }
    if (IN(10)) { BUILD_TS(); p8_phase(F, opaque_args(), TS); }
#undef IN
#undef SEAM
}

extern "C" void kernel_launch(void* const* d_in, const int* in_sizes, int n_in, void* d_out, int out_size, void* d_ws, size_t ws_size, hipStream_t stream) {
    static int grid = 0;
    if (grid == 0) {
        if (n_in != 23 || in_sizes[0] != NLAT * D || out_size != NLAT * D || ws_size < WS_TOTAL) {
            fprintf(stderr, "kernel_launch: unexpected shapes: n_in %d, in0 %d, out %d, ws %zu (need %zu); nothing launched\n", n_in, n_in > 0 ? in_sizes[0] : -1, out_size, ws_size, (size_t)WS_TOTAL); grid = -1; return; }
        int dev = 0, cus = 0, per_cu = 0;
        if (hipGetDevice(&dev) != hipSuccess || hipDeviceGetAttribute(&cus, hipDeviceAttributeMultiprocessorCount, dev) != hipSuccess) { fprintf(stderr, "kernel_launch: device query failed\n"); grid = -1; return; }
        if (hipFuncSetAttribute((const void*)fwd_kernel, hipFuncAttributeMaxDynamicSharedMemorySize, LDS_BYTES) != hipSuccess) { fprintf(stderr, "kernel_launch: hipFuncSetAttribute failed\n"); grid = -1; return; }
        if (hipOccupancyMaxActiveBlocksPerMultiprocessor(&per_cu, (const void*)fwd_kernel, NTHREADS, LDS_BYTES) != hipSuccess || per_cu < 1) {
            fprintf(stderr, "kernel_launch: occupancy query reports %d workgroups per CU; nothing launched\n", per_cu); (void)hipGetLastError(); grid = -1; return; }
        grid = cus;
        if (grid > 256) grid = 256;
    }
    if (grid < 0) return;
    if (hipMemsetAsync((char*)d_ws + WS_CTL, 0, CTL_ZERO_BYTES, stream) != hipSuccess) { fprintf(stderr, "kernel_launch: hipMemsetAsync failed\n"); return; }
    Args a{};
    for (int i = 0; i < 23; ++i) a.in[i] = (const float*)d_in[i];
    a.out = (float*)d_out; a.ws = (unsigned char*)d_ws;
#if MK_N_LAUNCHES == 1
    a.ph_lo = 0; a.ph_hi = NPHASES;
    hipLaunchKernelGGL(fwd_kernel, dim3(grid), dim3(NTHREADS), LDS_BYTES, stream, a);
#else
    for (int p = 0; p < NPHASES; ++p) { a.ph_lo = p; a.ph_hi = p + 1; hipLaunchKernelGGL(fwd_kernel, dim3(grid), dim3(NTHREADS), LDS_BYTES, stream, a); }
#endif
    const hipError_t le = hipPeekAtLastError();
    if (le != hipSuccess) fprintf(stderr, "kernel_launch: launch failed: %s\n", hipGetErrorName(le));
}
```

```cpp
#include <hip/hip_runtime.h>
#include <cstdio>
#include <cstdint>

#ifndef MK_N_LAUNCHES
#define MK_N_LAUNCHES 1
#endif

#define GAS __attribute__((address_space(1)))
#define LAS __attribute__((address_space(3)))
typedef unsigned short bf16;
typedef unsigned v4u __attribute__((ext_vector_type(4)));
typedef unsigned v2u __attribute__((ext_vector_type(2)));
typedef float f32x4 __attribute__((ext_vector_type(4)));
typedef float f32x2 __attribute__((ext_vector_type(2)));
typedef short bf16x8 __attribute__((ext_vector_type(8)));
typedef short s16x4 __attribute__((ext_vector_type(4)));
#define RLX_AGENT __ATOMIC_RELAXED, __HIP_MEMORY_SCOPE_AGENT
#define LDS_WAIT() asm volatile("s_waitcnt lgkmcnt(0)" ::: "memory")
#define VM_WAIT() asm volatile("s_waitcnt vmcnt(0)" ::: "memory")
#define LDS_BARRIER() do { asm volatile("s_waitcnt lgkmcnt(0)" ::: "memory"); __builtin_amdgcn_s_barrier(); asm volatile("" ::: "memory"); } while (0)

typedef __bf16 bf16x2_t __attribute__((ext_vector_type(2)));
__device__ __forceinline__ unsigned pk2(float lo, float hi) { const f32x2 v = {lo, hi}; return __builtin_bit_cast(unsigned, __builtin_convertvector(v, bf16x2_t)); }
__device__ __forceinline__ unsigned f2bf(float f) { return (unsigned)__builtin_bit_cast(unsigned short, (__bf16)f); }
__device__ __forceinline__ unsigned pk4_fp8(float a, float b, float c, float d) { int w = __builtin_amdgcn_cvt_pk_fp8_f32(a, b, 0, false); w = __builtin_amdgcn_cvt_pk_fp8_f32(c, d, w, true); return (unsigned)w; }
__device__ __forceinline__ float bflo(unsigned w) { return __builtin_bit_cast(float, w << 16); }
__device__ __forceinline__ float bfhi(unsigned w) { return __builtin_bit_cast(float, w & 0xffff0000u); }
__device__ __forceinline__ float bf2f(bf16 b) { return __builtin_bit_cast(float, ((unsigned)b) << 16); }
__device__ __forceinline__ float fexp(float x) { return __builtin_amdgcn_exp2f(x * 1.4426950408889634f); }
__device__ __forceinline__ float wave_sum(float v) {
#pragma unroll
    for (int o = 1; o < 64; o <<= 1) v += __shfl_xor(v, o);
    return v;
}

constexpr int D = 1024, NBATCH = 16, SEQ = 4096, CTXL = 256;
constexpr int NLAT = NBATCH * SEQ;
constexpr int NCTXR = NBATCH * CTXL;
constexpr int NROWS = NLAT + NCTXR;
constexpr int PW = 3104, PWP = 3328;
constexpr int CQ = 0, CK = 256, CV = 512, CR = 1024, CAF = 1536, CAB = 1552, CPB = 1568, CPC = 2080, CPX = 2592;
constexpr int NCC = 68;
constexpr int NEXP = 32, DFF = 1024;
constexpr float EPS = 1e-6f;
constexpr int LISTCAP = 65536;
constexpr float WSCALE = 32.0f, WSCALE_INV = 1.0f / 32.0f;

#ifndef OUTPROJ_F8
#define OUTPROJ_F8 1
#endif
constexpr size_t MiB = 1u << 20;
constexpr size_t WS_CTL = 0, CTL_ZERO_BYTES = 32768;
constexpr size_t WS_MOD = 1 * MiB;
constexpr size_t WS_DECAY = 2 * MiB;
constexpr size_t WS_WIN = 6 * MiB;
constexpr size_t WS_WOUT = 13 * MiB;
constexpr size_t WS_HN = 16 * MiB;
constexpr size_t WS_KV = 16 * MiB;
constexpr size_t WS_P = 152 * MiB;
constexpr size_t WS_S = 565 * MiB;
constexpr size_t WS_YMIX = 693 * MiB;
constexpr size_t WS_Y1 = 821 * MiB;
constexpr size_t WS_ACT = 16 * MiB;
constexpr size_t WS_YA = 280 * MiB;
constexpr size_t WS_VT = 949 * MiB;
constexpr size_t WS_END = 1013 * MiB;
constexpr size_t WS_TSLOT = 1013 * MiB;
constexpr size_t WS_TW = 1015 * MiB;
constexpr size_t WS_TOTAL = 1017 * MiB;
constexpr size_t DO_WDN = 0;
constexpr size_t DO_WGU = 32 * MiB;
constexpr size_t DO_HN2 = 96 * MiB;
constexpr size_t DO_LAID = 160 * MiB;
constexpr size_t DO_LW = 168 * MiB;
static_assert(WS_P + (size_t)NROWS * PW * 2 <= WS_S && WS_YMIX + (size_t)NLAT * D * 2 <= WS_Y1 && WS_YA + (size_t)1056 * 256 * D <= WS_Y1 && WS_Y1 + (size_t)NLAT * D * 2 <= WS_VT && WS_VT + (size_t)NLAT * 512 * 2 <= WS_END, "ws map");
static_assert(WS_HN + (size_t)NROWS * D * 2 <= WS_P && WS_ACT + (size_t)1056 * 256 * 1024 <= WS_YA && DO_LW + (size_t)NEXP * LISTCAP * 4 <= (size_t)NLAT * D * 4, "ws map 2");
constexpr int CW_CNT = 64;
constexpr int CW_BAR = 4096;

constexpr int RING_BYTES = 131072;
constexpr int MISC_OFF = RING_BYTES;
constexpr int LDS_BYTES = 147456;
constexpr int NWAVES = 8, NTHREADS = 512;

namespace pg8 {
constexpr int BM = 256, BK = 64, HALF = 128, HTB = HALF * BK * 2, STAGE_BYTES = 8 * HTB;
constexpr int BIAS_OFF = 131072 + 8192;
__host__ __device__ __forceinline__ int lds_byte(int r, int c) { const int st = (r >> 4) * 2 + (c >> 5), rr = r & 15, cc = c & 31, ob = rr * 64 + cc * 2; return st * 1024 + (ob ^ (((ob >> 9) & 1) << 5)); }
__host__ __device__ __forceinline__ void stage_rc(int b, int& R, int& C) { const int st = b / 1024, sb = b % 1024, swz = sb ^ (((sb >> 9) & 1) << 5); R = (st >> 1) * 16 + swz / 64; C = (st & 1) * 32 + (swz % 64) / 2; }
__host__ __device__ __forceinline__ int perm32(int rho) { const int n = rho >> 4, i = rho & 15; return 8 * (i >> 2) + 4 * n + (i & 3); }

typedef int v8i __attribute__((ext_vector_type(8)));
typedef int v4i __attribute__((ext_vector_type(4)));
__device__ __forceinline__ v8i cat8(bf16x8 lo, bf16x8 hi) { return __builtin_shufflevector(__builtin_bit_cast(v4i, lo), __builtin_bit_cast(v4i, hi), 0, 1, 2, 3, 4, 5, 6, 7); }
struct Unit { int pm, pn, e, lt; };
__device__ __forceinline__ unsigned cvt_pk_bf16(float lo, float hi) { unsigned r; asm volatile("v_cvt_pk_bf16_f32 %0, %1, %2" : "=v"(r) : "v"(lo), "v"(hi)); return r; }

template <class Epi, class Sched, bool ALIGN_EPI, bool F8>
__device__ __forceinline__ void gemm_phase(LAS unsigned char* lds, const char* Abase, const Sched& S, const Epi& E) {
    int tid_ = threadIdx.x; asm volatile("" : "+v"(tid_));
    const int tid = tid_, wid = __builtin_amdgcn_readfirstlane(tid >> 6), lane = tid & 63, wr = wid >> 2, wc = wid & 3, fr = lane & 15, fq = lane >> 4;
    constexpr int KB = F8 ? 1024 : 2048, NT = KB / 128;
    unsigned voffB[2];
#pragma unroll
    for (int i = 0; i < 2; ++i) { int R, C; stage_rc(tid * 16 + i * 8192, R, C); const int Rb = Epi::PERM ? ((R & ~31) + perm32(R & 31)) : R; voffB[i] = (unsigned)(Rb * KB + C * 2); }
#define PG8_AROWS(u_, dst_) do { _Pragma("unroll") for (int h_ = 0; h_ < 2; ++h_) _Pragma("unroll") for (int i_ = 0; i_ < 2; ++i_) { int R_, C_; stage_rc(tid * 16 + i_ * 8192, R_, C_); \
        dst_[h_][i_] = (unsigned)S.arow(u_, h_ * HALF + R_); } } while (0)
#define PG8_AOFF2(dst_) do { _Pragma("unroll") for (int h_ = 0; h_ < 2; ++h_) _Pragma("unroll") for (int i_ = 0; i_ < 2; ++i_) { int R_, C_; stage_rc(tid * 16 + i_ * 8192, R_, C_); \
        dst_[h_][i_] = dst_[h_][i_] * (unsigned)KB + (unsigned)C_ * 2u; } } while (0)
    const size_t kstep = (size_t)(BK * 2);
    const size_t hstep = (size_t)HALF * KB;
    const unsigned ldsw = (unsigned)wid * 1024u;
    const int aoff = lds_byte(wr * 64 + fr, fq * 8), boff = lds_byte(wc * 32 + fr, fq * 8);
#define PG8_SA(b, h) (((b) * 2 + (h)) * HTB)
#define PG8_SB(b, h) ((4 + (b) * 2 + (h)) * HTB)
#define PG8_STAGE(bufoff, gbase, voff) do { _Pragma("unroll") for (int _i = 0; _i < 2; ++_i) \
        __builtin_amdgcn_global_load_lds((const unsigned*)((const char*)(gbase) + (voff)[_i]), (LAS unsigned*)(lds + (bufoff) + ldsw + _i * 8192), 16, 0, 0); } while (0)
#define PG8_LDA(dst, b, h) do { _Pragma("unroll") for (int m = 0; m < 4; ++m) _Pragma("unroll") for (int k = 0; k < 2; ++k) dst[m][k] = *(const LAS bf16x8*)(lds + PG8_SA(b, h) + aoff + m * 2048 + k * 1024); } while (0)
#define PG8_LDB(dst, b, h) do { _Pragma("unroll") for (int n = 0; n < 2; ++n) _Pragma("unroll") for (int k = 0; k < 2; ++k) dst[n][k] = *(const LAS bf16x8*)(lds + PG8_SB(b, h) + boff + n * 2048 + k * 1024); } while (0)
#define PG8_MMA(ai, bj, At, Bt) do { if (skipmma && ((bj) == 1 || wc > 0)) break; __builtin_amdgcn_s_setprio(1); _Pragma("unroll") for (int m = 0; m < 4; ++m) _Pragma("unroll") for (int n = 0; n < 2; ++n) { \
        if constexpr (F8) { asm volatile("v_mfma_f32_16x16x128_f8f6f4 %0, %1, %2, %0" : "+v"(acc[ai][bj][m][n]) : "v"(cat8(Bt[n][0], Bt[n][1])), "v"(cat8(At[m][0], At[m][1]))); } \
        else { _Pragma("unroll") for (int k = 0; k < 2; ++k) acc[ai][bj][m][n] = __builtin_amdgcn_mfma_f32_16x16x32_bf16(Bt[n][k], At[m][k], acc[ai][bj][m][n], 0, 0, 0); } } \
        __builtin_amdgcn_s_setprio(0); } while (0)
#define PG8_WAIT_V(n) asm volatile("s_waitcnt vmcnt(" #n ")" ::: "memory")
#define PG8_WAIT_L(n) asm volatile("s_waitcnt lgkmcnt(" #n ")" ::: "memory")
#define PG8_BAR __builtin_amdgcn_s_barrier()
#define PG8_SCHED __builtin_amdgcn_sched_barrier(0)
    Unit cur, nxt; int ui = 0;
    if (!S.next(0, cur)) return;
    f32x4 acc[2][2][4][2];
#pragma unroll
    for (int a = 0; a < 2; ++a)
#pragma unroll
        for (int b = 0; b < 2; ++b)
#pragma unroll
            for (int m = 0; m < 4; ++m)
#pragma unroll
                for (int n = 0; n < 2; ++n) acc[a][b][m][n] = (f32x4){0.f, 0.f, 0.f, 0.f};
    bf16x8 At[4][2], B0[2][2], B1[2][2];
    unsigned oC[2][2];
    PG8_AROWS(cur, oC); PG8_AOFF2(oC);
    unsigned rN[2] = {0u, 0u};
    const char* cB = S.bptr(cur);
    PG8_STAGE(PG8_SB(0, 0), cB, voffB); PG8_STAGE(PG8_SB(0, 1), cB + hstep, voffB); PG8_STAGE(PG8_SA(0, 0), Abase, oC[0]); PG8_STAGE(PG8_SA(0, 1), Abase, oC[1]);
    if (wr == 1) PG8_BAR;
    PG8_WAIT_V(2); PG8_BAR;
    PG8_STAGE(PG8_SB(1, 0), cB + kstep, voffB); PG8_STAGE(PG8_SA(1, 0), Abase + kstep, oC[0]); PG8_STAGE(PG8_SB(1, 1), cB + hstep + kstep, voffB);
    PG8_WAIT_V(6); PG8_BAR;
    for (;;) {
        const bool skipmma = S.mostly_padding(cur);
        const bool has_next = S.next(ui + 1, nxt);
        if (!has_next) nxt = cur;
        if constexpr (Epi::LBIAS) { if (wid == 0) __builtin_amdgcn_global_load_lds((const unsigned*)(E.bias_src(cur) + lane * 16), (LAS unsigned*)(lds + BIAS_OFF + (ui & 1) * 1024), 16, 0, 0); }
        const char* nB = S.bptr(nxt);
        for (int t = 0; t < NT; t += 2) {
            const bool last = (t == NT - 2);
            const char* ka1 = Abase + (size_t)(t + 1) * kstep;
            const char* ka2 = last ? Abase : Abase + (size_t)(t + 2) * kstep; const char* b2 = last ? nB : cB + (size_t)(t + 2) * kstep;
            const char* ka3 = ka2 + kstep; const char* b3 = b2 + kstep;
            PG8_LDB(B0, 0, 0); PG8_LDB(B1, 0, 1); PG8_SCHED; PG8_LDA(At, 0, 0); PG8_STAGE(PG8_SA(1, 1), ka1, oC[1]);
            PG8_WAIT_V(8); PG8_WAIT_L(0); PG8_BAR; PG8_MMA(0, 0, At, B0); PG8_MMA(0, 1, At, B1); PG8_BAR; PG8_SCHED;
            if constexpr (Sched::GATHER) { if (t == NT - 4) { unsigned r4[2][2]; PG8_AROWS(nxt, r4); rN[0] = r4[0][0] | (r4[0][1] << 16); rN[1] = r4[1][0] | (r4[1][1] << 16); } }
            if (last) {
                if constexpr (Sched::GATHER) { oC[0][0] = rN[0] & 0xffffu; oC[0][1] = rN[0] >> 16; oC[1][0] = rN[1] & 0xffffu; oC[1][1] = rN[1] >> 16; }
                else { PG8_AROWS(nxt, oC); }
                PG8_AOFF2(oC); }
            PG8_LDA(At, 0, 1); PG8_STAGE(PG8_SB(0, 0), b2, voffB); PG8_STAGE(PG8_SB(0, 1), b2 + hstep, voffB); PG8_STAGE(PG8_SA(0, 0), ka2, oC[0]);
            PG8_WAIT_V(8); PG8_WAIT_L(0); PG8_BAR; PG8_MMA(1, 0, At, B0); PG8_MMA(1, 1, At, B1); PG8_BAR; PG8_SCHED;
            PG8_LDB(B0, 1, 0); PG8_LDB(B1, 1, 1); PG8_SCHED; PG8_LDA(At, 1, 0); PG8_STAGE(PG8_SA(0, 1), ka2, oC[1]);
            PG8_WAIT_V(8); PG8_WAIT_L(0); PG8_BAR; PG8_MMA(0, 0, At, B0); PG8_MMA(0, 1, At, B1); PG8_BAR; PG8_SCHED;
            PG8_LDA(At, 1, 1); PG8_STAGE(PG8_SB(1, 0), b3, voffB); PG8_STAGE(PG8_SB(1, 1), b3 + hstep, voffB); PG8_STAGE(PG8_SA(1, 0), ka3, oC[0]);
            PG8_WAIT_V(8); PG8_WAIT_L(0); PG8_BAR; PG8_MMA(1, 0, At, B0); PG8_MMA(1, 1, At, B1); PG8_BAR; PG8_SCHED;
        }
        if constexpr (ALIGN_EPI) { if (wr == 0) PG8_BAR; }
        if constexpr (F8) asm volatile("s_nop 15\n\ts_nop 7" ::: "memory");
        { int fr_o = fr, fq_o = fq; asm volatile("" : "+v"(fr_o), "+v"(fq_o));
          E(acc, cur, wr, wc, fr_o, fq_o, (const LAS float*)(lds + BIAS_OFF + (ui & 1) * 1024)); }
        if (!has_next) break;
#pragma unroll
        for (int a = 0; a < 2; ++a)
#pragma unroll
            for (int b = 0; b < 2; ++b)
#pragma unroll
                for (int m = 0; m < 4; ++m)
#pragma unroll
                    for (int n = 0; n < 2; ++n) acc[a][b][m][n] = (f32x4){0.f, 0.f, 0.f, 0.f};
        cur = nxt; cB = nB; ++ui;
        if constexpr (ALIGN_EPI) { if (wr == 1) PG8_BAR; }
    }
    PG8_WAIT_V(0);
    if constexpr (!ALIGN_EPI) { if (wr == 0) PG8_BAR; }
    PG8_BAR;
#undef PG8_AROWS
#undef PG8_AOFF2
#undef PG8_SA
#undef PG8_SB
#undef PG8_STAGE
#undef PG8_LDA
#undef PG8_LDB
#undef PG8_MMA
#undef PG8_WAIT_V
#undef PG8_WAIT_L
#undef PG8_BAR
#undef PG8_SCHED
}
}

#define XB_TMO      128
#define XB_XCNT(j)  (256  + 64 * (j))
#define XB_XSUB(j)  (1280 + 64 * (j))
#define XB_XGEN(j)  (2304 + 64 * (j))
#define XB_TOP      3328
#define XB_TOPGEN   3392
#define XCD_BAR_WORDS 3456
#define XB_SPIN_CAP (1u << 22)
__device__ __forceinline__ unsigned xb_ld(unsigned* p)              { return __hip_atomic_load(p, __ATOMIC_RELAXED, __HIP_MEMORY_SCOPE_AGENT); }
__device__ __forceinline__ unsigned xb_add(unsigned* p, unsigned v) { return __hip_atomic_fetch_add(p, v, __ATOMIC_RELAXED, __HIP_MEMORY_SCOPE_AGENT); }
__device__ __forceinline__ unsigned xb_xcc_id() { return (unsigned)__builtin_amdgcn_s_getreg((3 << 11) | 20) & 0xFu; }
#define XB_SPIN(cond, bar) do { unsigned _sp = 0; while (cond) { __builtin_amdgcn_s_sleep(1); \
    if ((++_sp & 255u) == 0u) { if (xb_ld(&(bar)[XB_TMO])) break; if (_sp > XB_SPIN_CAP) { atomicAdd(&(bar)[XB_TMO], 1u); break; } } } } while (0)
struct XcdBarrier { unsigned* bar; unsigned x; volatile LAS unsigned* st; };
__device__ __forceinline__ XcdBarrier xcd_barrier_post(unsigned* bar, volatile LAS unsigned* st) {
    XcdBarrier b; b.bar = bar; b.x = xb_xcc_id(); b.st = st;
    if (threadIdx.x == 0) (void)xb_add(&bar[XB_XCNT(b.x)], 1u);
    return b;
}
__device__ __forceinline__ void xcd_barrier_complete(unsigned* bar, unsigned x, unsigned& nloc, unsigned& nx) {
    const unsigned G = gridDim.x * gridDim.y * gridDim.z;
    unsigned sum, cnt, mine, sp = 0u;
    for (;;) {
        sum = 0u; cnt = 0u; mine = 0u;
#pragma unroll 1
        for (unsigned j = 0; j < 16; ++j) { const unsigned c = xb_ld(&bar[XB_XCNT(j)]); sum += c; cnt += (c > 0u) ? 1u : 0u; mine = (j == x) ? c : mine; }
        if (sum == G) break;
        __builtin_amdgcn_s_sleep(1);
        if ((++sp & 255u) == 0u) { if (xb_ld(&bar[XB_TMO])) break; if (sp > XB_SPIN_CAP) { atomicAdd(&bar[XB_TMO], 1u); break; } }
    }
    nloc = mine > 0u ? mine : 1u; nx = cnt > 0u ? cnt : 1u;
}
__device__ __forceinline__ void xcd_barrier(const XcdBarrier& b) {
    asm volatile("s_waitcnt vmcnt(0)" ::: "memory");
    __syncthreads();
    if (threadIdx.x == 0) {
        unsigned* bar = b.bar;
        __builtin_amdgcn_s_waitcnt(0);
        unsigned nloc = b.st[0], nx = b.st[1];
        if (nloc == 0u) { xcd_barrier_complete(bar, b.x, nloc, nx); b.st[0] = nloc; b.st[1] = nx; }
        const unsigned old = xb_add(&bar[XB_XSUB(b.x)], 1u);
        const unsigned gen = old / nloc;
        if (old + 1u == (gen + 1u) * nloc) {
            __builtin_amdgcn_fence(__ATOMIC_RELEASE, "agent");
            asm volatile("s_waitcnt vmcnt(0)" ::: "memory");
            const unsigned og = xb_add(&bar[XB_TOP], 1u);
            const unsigned tg = og / nx;
            if (og + 1u == (tg + 1u) * nx) xb_add(&bar[XB_TOPGEN], 1u);
            else XB_SPIN(xb_ld(&bar[XB_TOPGEN]) == tg, bar);
            __builtin_amdgcn_fence(__ATOMIC_ACQUIRE, "agent");
            xb_add(&bar[XB_XGEN(b.x)], 1u);
            asm volatile("s_waitcnt vmcnt(0)" ::: "memory");
        } else {
            XB_SPIN(xb_ld(&bar[XB_XGEN(b.x)]) == gen, bar);
            __builtin_amdgcn_fence(__ATOMIC_ACQUIRE, "agent");
            asm volatile("s_waitcnt vmcnt(0)" ::: "memory");
        }
    }
    __syncthreads();
}

struct Args { const float* in[23]; float* out; unsigned char* ws; int ph_lo, ph_hi; };
typedef const Args __attribute__((address_space(4))) CArgs;
__device__ __forceinline__ CArgs* opaque_args() { CArgs* p = (CArgs*)__builtin_amdgcn_kernarg_segment_ptr(); asm volatile("" : "+s"(p)); return p; }
struct Frame {
    LAS unsigned char* lds;
    int tid, lane, wave, G, bid;
    float* out; unsigned char* ws;
};

struct EpiNull {
    static constexpr bool PERM = true, LBIAS = false;
    __device__ __forceinline__ void operator()(const f32x4 (&acc)[2][2][4][2], const pg8::Unit&, int, int, int, int, const LAS float*) const {
#pragma unroll
        for (int a = 0; a < 2; ++a)
#pragma unroll
            for (int b = 0; b < 2; ++b)
#pragma unroll
                for (int m = 0; m < 4; ++m)
#pragma unroll
                    for (int n = 0; n < 2; ++n) asm volatile("" :: "v"(acc[a][b][m][n]));
    }
};
struct DenseSched {
    static constexpr bool GATHER = false;
    int nM, nN, nwg, G, c, kb; const char* Bt; const LAS int* UT;
    __device__ __forceinline__ void init(int M, int N, int G_, int c_, const void* Bt_) { nM = M / 256; nN = N / 256; nwg = nM * nN; G = G_; c = c_; Bt = (const char*)Bt_; UT = nullptr; kb = 2048; }
    __device__ __forceinline__ void build(LAS int* ut, int tid) { if (tid < 32) { pg8::Unit u; ut[tid] = next_calc(tid, u) ? (u.pm | (u.pn << 16)) : -1; } UT = ut; __syncthreads(); }
    __device__ __forceinline__ bool next(int i, pg8::Unit& u) const { const int w = (i < 32) ? UT[i] : -1; if (w < 0) return false; u.pm = w & 0xffff; u.pn = w >> 16; u.e = 0; u.lt = 0; return true; }
    __device__ __forceinline__ bool next_calc(int i, pg8::Unit& u) const {
        const long L = (long)i * G + c; if (L >= nwg) return false;
        int wgid = (int)L; { const int q = nwg / 8, r = nwg % 8, xcd = wgid % 8, off = wgid / 8; wgid = (xcd < r ? xcd * (q + 1) : r * (q + 1) + (xcd - r) * q) + off; }
        const int nig = 8 * nN, gid = wgid / nig, fm = gid * 8, gsz = (nM - fm) < 8 ? (nM - fm) : 8;
        u.pm = fm + ((wgid % nig) % gsz); u.pn = (wgid % nig) / gsz; u.e = 0; u.lt = 0; return true;
    }
    __device__ __forceinline__ int arow(const pg8::Unit& u, int r) const { return u.pm * 256 + r; }
    __device__ __forceinline__ bool mostly_padding(const pg8::Unit& u) const { return nN == PWP / 256 && u.pn == nN - 1; }
    __device__ __forceinline__ const char* bptr(const pg8::Unit& u) const { return Bt + (size_t)u.pn * 256 * kb; }
};
struct EpiProj {
    static constexpr bool PERM = true, LBIAS = false;
    bf16* O;
    __device__ __forceinline__ void operator()(const f32x4 (&acc)[2][2][4][2], const pg8::Unit& u, int wr, int wc, int fr, int fq, const LAS float*) const {
        const int row0 = u.pm * 256 + wr * 64 + fr, col0 = u.pn * 256 + wc * 32 + 8 * fq;
#pragma unroll
        for (int ai = 0; ai < 2; ++ai)
#pragma unroll
            for (int m = 0; m < 4; ++m) { bf16* rowp = O + (size_t)(row0 + ai * 128 + m * 16) * PW + col0;
#pragma unroll
                for (int bj = 0; bj < 2; ++bj) { if (col0 + bj * 128 < PW) { const f32x4 v0 = acc[ai][bj][m][0], v1 = acc[ai][bj][m][1];
                    v4u w; w.x = pk2(v0[0], v0[1]); w.y = pk2(v0[2], v0[3]); w.z = pk2(v1[0], v1[1]); w.w = pk2(v1[2], v1[3]);
                    *(v4u*)(rowp + bj * 128) = w; } } }
    }
};
struct EpiOut {
    static constexpr bool PERM = true, LBIAS = true;
    const float* x; const float* mod; bf16* Y1; float sc;
    __device__ __forceinline__ const char* bias_src(const pg8::Unit& u) const { return (const char*)(mod + (size_t)(u.pm >> 4) * 6144 + 2048 + u.pn * 256); }
    __device__ __forceinline__ void operator()(const f32x4 (&acc)[2][2][4][2], const pg8::Unit& u, int wr, int wc, int fr, int fq, const LAS float* bl) const {
        const int row0 = u.pm * 256 + wr * 64 + fr, col0 = u.pn * 256 + wc * 32 + 8 * fq;
        f32x4 gv[2][2];
#pragma unroll
        for (int bj = 0; bj < 2; ++bj)
#pragma unroll
            for (int n = 0; n < 2; ++n) gv[bj][n] = *(const LAS f32x4*)(bl + wc * 32 + 8 * fq + bj * 128 + 4 * n) * sc;
#pragma unroll
        for (int ai = 0; ai < 2; ++ai)
#pragma unroll
            for (int m = 0; m < 4; ++m) { const size_t off = (size_t)(row0 + ai * 128 + m * 16) * D + col0; bf16* rowp = Y1 + off;
#pragma unroll
                for (int bj = 0; bj < 2; ++bj) { const f32x4 x0 = *(const f32x4*)(x + off + bj * 128), x1 = *(const f32x4*)(x + off + bj * 128 + 4);
                    const f32x4 v0 = x0 + acc[ai][bj][m][0] * gv[bj][0], v1 = x1 + acc[ai][bj][m][1] * gv[bj][1];
                    v4u w; w.x = pk2(v0[0], v0[1]); w.y = pk2(v0[2], v0[3]); w.z = pk2(v1[0], v1[1]); w.w = pk2(v1[2], v1[3]);
                    *(v4u*)(rowp + bj * 128) = w; } }
    }
};
template <bool GU> struct MoeSched {
    static constexpr bool GATHER = GU;
    static constexpr bool gu = GU;
    const LAS int* TS; int ntr, G, c; const int* laid; const char* W;
    __device__ __forceinline__ bool next(int i, pg8::Unit& u) const {
        const int x = c & 7, j = c >> 3; int tl, pn;
        if (G != 256) { const int L = i * G + c, npn = gu ? 8 : 4; tl = L / npn; pn = L % npn; }
        else if (gu) { tl = (i * 8 + x) * 4 + (j >> 3); pn = j & 7; } else { tl = (i * 8 + x) * 8 + (j >> 2); pn = j & 3; }
        if (tl >= ntr) return false;
        const int tau = tl; const int e = ((const LAS unsigned char*)(TS + 72))[tau];
        u.pm = tl; u.pn = pn; u.e = e; u.lt = tau - TS[e]; return true;
    }
    __device__ __forceinline__ bool mostly_padding(const pg8::Unit&) const { return false; }
    __device__ __forceinline__ int arow(const pg8::Unit& u, int r) const {
        if (!gu) return u.pm * 256 + r;
        const int pos = u.lt * 256 + r, cnt = TS[33 + u.e];
        return pos < cnt ? (laid[(size_t)u.e * LISTCAP + pos] >> 2) : 0;
    }
    __device__ __forceinline__ const char* bptr(const pg8::Unit& u) const { return W + ((size_t)u.e * (gu ? 2048 : 1024) + (size_t)u.pn * 256) * 1024; }
};
struct EpiGU {
    static constexpr bool PERM = true, LBIAS = true;
    unsigned char* ACT; const float* b_gu;
    __device__ __forceinline__ const char* bias_src(const pg8::Unit& u) const { return (const char*)(b_gu + (size_t)u.e * 2048 + u.pn * 256); }
    __device__ __forceinline__ void operator()(const f32x4 (&acc)[2][2][4][2], const pg8::Unit& u, int wr, int wc, int fr, int fq, const LAS float* bl) const {
        const int row0 = u.pm * 256 + wr * 64 + fr, j0 = u.pn * 128 + wc * 32 + 8 * fq;
        const LAS float* bp = bl + 2 * (wc * 32 + 8 * fq);
        f32x4 bv[4];
#pragma unroll
        for (int q = 0; q < 4; ++q) bv[q] = *(const LAS f32x4*)(bp + 4 * q);
        f32x2 bg[4], bu[4];
#pragma unroll
        for (int q = 0; q < 4; ++q) { bg[q] = (f32x2){bv[q][0], bv[q][2]}; bu[q] = (f32x2){bv[q][1], bv[q][3]}; }
#pragma unroll
        for (int ai = 0; ai < 2; ++ai)
#pragma unroll
            for (int m = 0; m < 4; ++m) { unsigned char* rowp = ACT + (size_t)(row0 + ai * 128 + m * 16) * DFF + j0; f32x2 a[4];
#pragma unroll
                for (int n = 0; n < 2; ++n)
#pragma unroll
                    for (int p = 0; p < 2; ++p) { const int q = 2 * n + p;
                        const f32x4 ag = acc[ai][0][m][n], au = acc[ai][1][m][n];
                        f32x2 g = (f32x2){ag[2 * p], ag[2 * p + 1]} * WSCALE_INV + bg[q], up = (f32x2){au[2 * p], au[2 * p + 1]} * WSCALE_INV + bu[q];
                        g.x = fminf(g.x, 7.0f); g.y = fminf(g.y, 7.0f); up.x = __builtin_amdgcn_fmed3f(up.x, -7.0f, 7.0f); up.y = __builtin_amdgcn_fmed3f(up.y, -7.0f, 7.0f);
                        const f32x2 t = g * (-1.702f * 1.4426950408889634f); f32x2 e; e.x = __builtin_amdgcn_exp2f(t.x); e.y = __builtin_amdgcn_exp2f(t.y);
                        const f32x2 d = e + 1.0f; f32x2 sg; sg.x = __builtin_amdgcn_rcpf(d.x); sg.y = __builtin_amdgcn_rcpf(d.y);
                        a[q] = ((up + 1.0f) * g) * sg; }
                v2u w; w.x = pk4_fp8(a[0].x, a[0].y, a[1].x, a[1].y); w.y = pk4_fp8(a[2].x, a[2].y, a[3].x, a[3].y);
                *(v2u*)rowp = w; }
    }
};
struct EpiDN {
    static constexpr bool PERM = true, LBIAS = true;
    unsigned char* YA; const float* b_dn; const LAS int* TS;
    __device__ __forceinline__ const char* bias_src(const pg8::Unit& u) const { return (const char*)(b_dn + (size_t)u.e * D + u.pn * 256); }
    __device__ __forceinline__ void operator()(const f32x4 (&acc)[2][2][4][2], const pg8::Unit& u, int wr, int wc, int fr, int fq, const LAS float* bl) const {
        const int col0 = u.pn * 256 + wc * 32 + 8 * fq, cnt = TS[33 + u.e];
        f32x4 bv[2][2];
#pragma unroll
        for (int bj = 0; bj < 2; ++bj)
#pragma unroll
            for (int n = 0; n < 2; ++n) bv[bj][n] = *(const LAS f32x4*)(bl + wc * 32 + 8 * fq + bj * 128 + 4 * n);
#pragma unroll
        for (int ai = 0; ai < 2; ++ai)
#pragma unroll
            for (int m = 0; m < 4; ++m) { const int r = ai * 128 + wr * 64 + m * 16 + fr;
                if (u.lt * 256 + r < cnt) { unsigned char* rowp = YA + ((size_t)u.pm * 256 + r) * D + col0;
#pragma unroll
                    for (int bj = 0; bj < 2; ++bj) { const f32x4 v0 = acc[ai][bj][m][0] * WSCALE_INV + bv[bj][0], v1 = acc[ai][bj][m][1] * WSCALE_INV + bv[bj][1];
                        v2u w; w.x = pk4_fp8(v0[0], v0[1], v0[2], v0[3]); w.y = pk4_fp8(v1[0], v1[1], v1[2], v1[3]);
                        *(v2u*)(rowp + bj * 128) = w; } }
                asm volatile("" ::: "memory"); }
    }
};

template <bool MAPGU>
__device__ __forceinline__ void p0_transpose_item(const float* W, int N, bf16* WT, LAS float* scr, int item, int lane) {
    const int nblk = N / 32, kb = item / nblk, nb = item % nblk, k0 = 64 * kb, n0 = 32 * nb;
#pragma unroll
    for (int i = 0; i < 32; ++i) { const int kk = 2 * i + (lane >> 5); scr[kk * 33 + (lane & 31)] = W[(size_t)(k0 + kk) * N + n0 + (lane & 31)]; }
    LDS_WAIT(); asm volatile("" ::: "memory");
    const int c = lane & 7;
#pragma unroll
    for (int j = 0; j < 4; ++j) { const int n = (lane >> 3) + 8 * j; const LAS float* s = scr + (8 * c) * 33 + n;
        v4u o; o.x = pk2(s[0 * 33], s[1 * 33]); o.y = pk2(s[2 * 33], s[3 * 33]); o.z = pk2(s[4 * 33], s[5 * 33]); o.w = pk2(s[6 * 33], s[7 * 33]);
        int row = n0 + n;
        if (MAPGU) { const int jj = row >> 1; row = (jj >> 7) * 256 + (row & 1) * 128 + (jj & 127); }
        *(v4u*)(WT + (size_t)row * D + k0 + 8 * c) = o; }
    LDS_WAIT(); asm volatile("" ::: "memory");
}
template <bool MAPGU>
__device__ __forceinline__ void p0_transpose_item_f8(const float* W, int N, unsigned char* WT, LAS float* scr, int item, int lane) {
    const int nblk = N / 32, kb = item / nblk, nb = item % nblk, k0 = 64 * kb, n0 = 32 * nb;
#pragma unroll
    for (int i = 0; i < 32; ++i) { const int kk = 2 * i + (lane >> 5); scr[kk * 33 + (lane & 31)] = W[(size_t)(k0 + kk) * N + n0 + (lane & 31)] * WSCALE; }
    LDS_WAIT(); asm volatile("" ::: "memory");
    const int c = lane & 3;
#pragma unroll
    for (int j = 0; j < 2; ++j) { const int n = (lane >> 2) + 16 * j; const LAS float* s = scr + (16 * c) * 33 + n;
        v4u o; o.x = pk4_fp8(s[0 * 33], s[1 * 33], s[2 * 33], s[3 * 33]); o.y = pk4_fp8(s[4 * 33], s[5 * 33], s[6 * 33], s[7 * 33]);
        o.z = pk4_fp8(s[8 * 33], s[9 * 33], s[10 * 33], s[11 * 33]); o.w = pk4_fp8(s[12 * 33], s[13 * 33], s[14 * 33], s[15 * 33]);
        int row = n0 + n;
        if (MAPGU) { const int jj = row >> 1; row = (jj >> 7) * 256 + (row & 1) * 128 + (jj & 127); }
        *(v4u*)(WT + (size_t)row * D + k0 + 16 * c) = o; }
    LDS_WAIT(); asm volatile("" ::: "memory");
}
constexpr int P0_TS = 144;
struct P0Item { const float* W; void* O; int N, k0, n0, kind; };
__device__ __forceinline__ P0Item p0_item(const Frame& F, CArgs* A, int it) {
    constexpr int I_IN = 8 * 25, I_OUT = 8 * 8, I_GU = 8 * 16, I_DN = 8 * 8;
    P0Item r; int x = it;
    if (x < I_IN) { r.W = A->in[7]; r.O = (void*)(F.ws + WS_WIN); r.N = PW; r.k0 = (x / 25) * 128; r.n0 = (x % 25) * 128; r.kind = 0; return r; } x -= I_IN;
    if (x < I_OUT) { r.W = A->in[14]; r.O = (void*)(F.ws + WS_WOUT); r.N = D; r.k0 = (x >> 3) * 128; r.n0 = (x & 7) * 128; r.kind = OUTPROJ_F8 ? 1 : 0; return r; } x -= I_OUT;
    if (x < NEXP * I_GU) { const int e = x / I_GU, y = x % I_GU; r.W = A->in[18] + (size_t)e * D * 2048; r.O = (void*)((unsigned char*)F.out + DO_WGU + (size_t)e * 2048 * D); r.N = 2048; r.k0 = (y >> 4) * 128; r.n0 = (y & 15) * 128; r.kind = 2; return r; } x -= NEXP * I_GU;
    { const int e = x / I_DN, y = x % I_DN; r.W = A->in[20] + (size_t)e * D * D; r.O = (void*)((unsigned char*)F.out + DO_WDN + (size_t)e * D * D); r.N = D; r.k0 = (y >> 3) * 128; r.n0 = (y & 7) * 128; r.kind = 1; return r; }
}
__device__ __forceinline__ void p0_load(const P0Item& I, int tid, f32x4 (&v)[8]) {
#pragma unroll
    for (int q = 0; q < 8; ++q) { const int idx = tid + NTHREADS * q, k = idx >> 5, col = I.n0 + 4 * (idx & 31);
        v[q] = (col < I.N) ? *(const f32x4*)(I.W + (size_t)(I.k0 + k) * I.N + col) : (f32x4){0.f, 0.f, 0.f, 0.f}; }
}
__device__ __forceinline__ void p0_emit(const P0Item& I, LAS unsigned char* lds, int wave, int i, int g) {
    const unsigned a0 = (unsigned)(uintptr_t)lds + (unsigned)(((32 * g + (i >> 2)) * P0_TS + 16 * wave + 4 * (i & 3)) * 2);
    s16x4 r[8];
    asm volatile("ds_read_b64_tr_b16 %0, %8\n\tds_read_b64_tr_b16 %1, %8 offset:1152\n\tds_read_b64_tr_b16 %2, %8 offset:2304\n\tds_read_b64_tr_b16 %3, %8 offset:3456\n\t"
                 "ds_read_b64_tr_b16 %4, %8 offset:4608\n\tds_read_b64_tr_b16 %5, %8 offset:5760\n\tds_read_b64_tr_b16 %6, %8 offset:6912\n\tds_read_b64_tr_b16 %7, %8 offset:8064\n\ts_waitcnt lgkmcnt(0)"
                 : "=&v"(r[0]), "=&v"(r[1]), "=&v"(r[2]), "=&v"(r[3]), "=&v"(r[4]), "=&v"(r[5]), "=&v"(r[6]), "=&v"(r[7]) : "v"(a0) : "memory");
    const int n = I.n0 + 16 * wave + i;
    if (n < I.N) {
        if (I.kind == 0) { bf16* op = (bf16*)I.O + (size_t)n * D + I.k0 + 32 * g;
#pragma unroll
            for (int q = 0; q < 4; ++q) { v4u w; w.x = (unsigned)(unsigned short)r[2 * q][0] | ((unsigned)(unsigned short)r[2 * q][1] << 16); w.y = (unsigned)(unsigned short)r[2 * q][2] | ((unsigned)(unsigned short)r[2 * q][3] << 16);
                w.z = (unsigned)(unsigned short)r[2 * q + 1][0] | ((unsigned)(unsigned short)r[2 * q + 1][1] << 16); w.w = (unsigned)(unsigned short)r[2 * q + 1][2] | ((unsigned)(unsigned short)r[2 * q + 1][3] << 16);
                *(v4u*)(op + 8 * q) = w; } }
        else { int row = n; if (I.kind == 2) { const int jj = n >> 1; row = (jj >> 7) * 256 + (n & 1) * 128 + (jj & 127); }
            unsigned char* op = (unsigned char*)I.O + (size_t)row * D + I.k0 + 32 * g;
#pragma unroll
            for (int q = 0; q < 2; ++q) { v4u w; unsigned* wp = (unsigned*)&w;
#pragma unroll
                for (int j = 0; j < 4; ++j) { const s16x4 x = r[4 * q + j]; wp[j] = pk4_fp8(bf2f((bf16)x[0]) * WSCALE, bf2f((bf16)x[1]) * WSCALE, bf2f((bf16)x[2]) * WSCALE, bf2f((bf16)x[3]) * WSCALE); }
                *(v4u*)(op + 16 * q) = w; } } }
}
__device__ __forceinline__ void p0_phase(const Frame& F, CArgs* A) {
    LAS unsigned char* lds = F.lds; const int tid = F.tid, lane = F.lane, wave = F.wave, i = lane & 15, g = lane >> 4;
    constexpr int NITEMS = 8 * 25 + 8 * 8 + NEXP * 8 * 16 + NEXP * 8 * 8;
    { v4u z = {0u, 0u, 0u, 0u}; v4u* p = (v4u*)(((bf16*)(F.ws + WS_WIN)) + (size_t)PW * D); const int n16 = (PWP - PW) * D * 2 / 16;
      for (int i = F.bid * NTHREADS + F.tid; i < n16; i += F.G * NTHREADS) p[i] = z; }
    __syncthreads();
    LAS float* sl = (LAS float*)F.lds;
    LAS float* red = (LAS float*)(F.lds + 1024 * 20 * 4);
    bool filled = false;
    for (int it = F.bid; it < 6144 / 64; it += F.G) {
        if (!filled) {
            for (int i = F.tid; i < 17 * 1024; i += NTHREADS) { const int m = i >> 10, k = i & 1023; const float v = (m < 16) ? A->in[1][m * 1024 + k] : A->in[3][k]; sl[k * 20 + m] = v * __builtin_amdgcn_rcpf(1.0f + fexp(-v)); }
            filled = true; __syncthreads();
        }
        float a[17];
#pragma unroll
        for (int m = 0; m < 17; ++m) a[m] = 0.f;
        const int j = it * 64 + F.lane;
#pragma unroll 1
        for (int kb = 0; kb < 128; kb += 16) { float wv[16];
#pragma unroll
          for (int q = 0; q < 16; ++q) wv[q] = A->in[4][(size_t)(F.wave * 128 + kb + q) * 6144 + j];
#pragma unroll
          for (int q = 0; q < 16; ++q) { const int k = F.wave * 128 + kb + q; const float w = wv[q];
            const LAS float* sp = sl + k * 20;
            const f32x4 s0 = *(const LAS f32x4*)sp, s1 = *(const LAS f32x4*)(sp + 4), s2 = *(const LAS f32x4*)(sp + 8), s3 = *(const LAS f32x4*)(sp + 12); const float s4 = sp[16];
            a[0] += s0[0] * w; a[1] += s0[1] * w; a[2] += s0[2] * w; a[3] += s0[3] * w; a[4] += s1[0] * w; a[5] += s1[1] * w; a[6] += s1[2] * w; a[7] += s1[3] * w;
            a[8] += s2[0] * w; a[9] += s2[1] * w; a[10] += s2[2] * w; a[11] += s2[3] * w; a[12] += s3[0] * w; a[13] += s3[1] * w; a[14] += s3[2] * w; a[15] += s3[3] * w; a[16] += s4 * w; } }
#pragma unroll
        for (int m = 0; m < 17; ++m) red[(F.wave * 17 + m) * 64 + F.lane] = a[m];
        __syncthreads();
        for (int i = F.tid; i < 17 * 64; i += NTHREADS) { const int m = i >> 6, l = i & 63; float s = 0.f;
#pragma unroll
            for (int w = 0; w < 8; ++w) s += red[(w * 17 + m) * 64 + l];
            ((float*)(F.ws + WS_MOD))[(size_t)m * 6144 + it * 64 + l] = s + A->in[5][it * 64 + l]; }
        __syncthreads();
    }
    __syncthreads();
    int first = F.bid, stride = F.G, cnt = (NITEMS + F.G - 1) / F.G;
    if (F.G == 256) { if (F.bid >= 96) { first = F.bid - 96; stride = 160; cnt = 26; } else { first = 160 * 26 + F.bid; stride = 96; cnt = 24; } }
    static_assert(160 * 26 + 96 * 24 >= NITEMS, "P0 item split");
    f32x4 va[8], vb[8];
    if (first < NITEMS) { const P0Item I0 = p0_item(F, A, first); p0_load(I0, tid, va); }
    if (cnt > 1 && first + stride < NITEMS) { const P0Item I1 = p0_item(F, A, first + stride); p0_load(I1, tid, vb); }
#define P0_STEP(VCUR, k_) do { const int it_ = first + (k_) * stride; const P0Item I = p0_item(F, A, it_); \
        _Pragma("unroll") for (int q = 0; q < 8; ++q) { const int idx = tid + NTHREADS * q, k = idx >> 5, p = idx & 31; v2u w; w.x = pk2(VCUR[q][0], VCUR[q][1]); w.y = pk2(VCUR[q][2], VCUR[q][3]); \
            *(LAS v2u*)(lds + (k * P0_TS + 4 * p) * 2) = w; } \
        if ((k_) + 2 < cnt && it_ + 2 * stride < NITEMS) { const P0Item In = p0_item(F, A, it_ + 2 * stride); p0_load(In, tid, VCUR); } \
        LDS_BARRIER(); \
        p0_emit(I, lds, wave, i, g); \
        LDS_BARRIER(); } while (0)
#pragma unroll 1
    for (int k = 0; k < cnt && first + k * stride < NITEMS; k += 2) {
        P0_STEP(va, k);
        if (k + 1 < cnt && first + (k + 1) * stride < NITEMS) P0_STEP(vb, k + 1);
    }
#undef P0_STEP
}

__device__ __forceinline__ void p1_phase(const Frame& F, CArgs* A) {
    const int gw = F.bid * NWAVES + F.wave, NGW = F.G * NWAVES;
    for (int r0 = gw; r0 < NROWS; r0 += 2 * NGW) {
        const int r1 = r0 + NGW; const bool two = r1 < NROWS;
        const float* xa = (r0 < NLAT) ? A->in[0] + (size_t)r0 * D : A->in[2] + (size_t)(r0 - NLAT) * D;
        const float* xb = !two ? xa : ((r1 < NLAT) ? A->in[0] + (size_t)r1 * D : A->in[2] + (size_t)(r1 - NLAT) * D);
        f32x4 va[4], vb[4];
#pragma unroll
        for (int j = 0; j < 4; ++j) { va[j] = ((const f32x4*)xa)[F.lane + 64 * j]; vb[j] = ((const f32x4*)xb)[F.lane + 64 * j]; }
#pragma unroll
        for (int which = 0; which < 2; ++which) { if (which == 1 && !two) break;
            const int r = which ? r1 : r0; const int mrow = (r < NLAT) ? (r >> 12) : 16;
            const float* sh = ((float*)(F.ws + WS_MOD)) + (size_t)mrow * 6144; const float* sc = sh + 1024;
            float s = 0.f;
#pragma unroll
            for (int j = 0; j < 4; ++j) { const f32x4 v = which ? vb[j] : va[j]; s += (v.x * v.x + v.y * v.y) + (v.z * v.z + v.w * v.w); }
            const float rstd = 1.0f / sqrtf(wave_sum(s) * (1.f / D) + EPS);
            unsigned long long* o8 = (unsigned long long*)(((bf16*)(F.ws + WS_HN)) + (size_t)r * D) + F.lane;
#pragma unroll
            for (int j = 0; j < 4; ++j) { const int c4 = F.lane + 64 * j; const f32x4 v = which ? vb[j] : va[j]; const f32x4 w = ((const f32x4*)A->in[6])[c4], a = ((const f32x4*)sc)[c4], b = ((const f32x4*)sh)[c4];
                const f32x4 y = (v * rstd) * w * (a + 1.0f) + b;
                o8[64 * j] = (unsigned long long)pk2(y.x, y.y) | ((unsigned long long)pk2(y.z, y.w) << 32); } }
    }
}

constexpr int GL_ZL = 0;
constexpr int GL_BC = 8192;
constexpr int GL_TOT = GL_BC + 32768;
constexpr int GL_V = GL_TOT + 512;
constexpr int GL_A = GL_V + 64 * 136 * 2;
constexpr int GL_B = GL_A + 2 * 64 * 72 * 2;
constexpr int GL_P = GL_B + 2 * 64 * 72 * 2;
constexpr int GL_SS = GL_P + 64 * 72 * 2;
constexpr int GL_SEG = GL_SS + 512;
constexpr int GL_END = GL_SEG + 2048;
static_assert(GL_END <= RING_BYTES && (GL_V % 16) == 0 && (GL_A % 16) == 0 && (GL_B % 16) == 0 && (GL_P % 16) == 0, "GLA LDS map");

__device__ __forceinline__ s16x4 tr_read(unsigned lds_addr) { s16x4 r; asm volatile("ds_read_b64_tr_b16 %0, %1\n\ts_waitcnt lgkmcnt(0)" : "=&v"(r) : "v"(lds_addr) : "memory"); return r; }
__device__ __forceinline__ void v_frag2(LAS unsigned char* lds, int v0, int lane, bf16x8& f0, bf16x8& f1) {
    const int i = lane & 15, g = lane >> 4;
    const unsigned a0 = (unsigned)(uintptr_t)(lds + GL_V) + (unsigned)(((8 * g + (i >> 2)) * 136 + v0 + 4 * (i & 3)) * 2);
    s16x4 r0, r1, r2, r3;
    asm volatile("ds_read_b64_tr_b16 %0, %4\n\tds_read_b64_tr_b16 %1, %4 offset:1088\n\tds_read_b64_tr_b16 %2, %4 offset:8704\n\tds_read_b64_tr_b16 %3, %4 offset:9792\n\ts_waitcnt lgkmcnt(0)"
                 : "=&v"(r0), "=&v"(r1), "=&v"(r2), "=&v"(r3) : "v"(a0) : "memory");
    f0[0] = r0[0]; f0[1] = r0[1]; f0[2] = r0[2]; f0[3] = r0[3]; f0[4] = r1[0]; f0[5] = r1[1]; f0[6] = r1[2]; f0[7] = r1[3];
    f1[0] = r2[0]; f1[1] = r2[1]; f1[2] = r2[2]; f1[3] = r2[3]; f1[4] = r3[0]; f1[5] = r3[1]; f1[6] = r3[2]; f1[7] = r3[3];
}
__device__ __forceinline__ bf16x8 v_frag(LAS unsigned char* lds, int ks, int v0, int lane) {
    const int i = lane & 15, g = lane >> 4;
    const unsigned a0 = (unsigned)(uintptr_t)(lds + GL_V) + (unsigned)(((32 * ks + 8 * g + (i >> 2)) * 136 + v0 + 4 * (i & 3)) * 2);
    const s16x4 lo = tr_read(a0), hi = tr_read(a0 + 4 * 136 * 2);
    bf16x8 r; r[0] = lo[0]; r[1] = lo[1]; r[2] = lo[2]; r[3] = lo[3]; r[4] = hi[0]; r[5] = hi[1]; r[6] = hi[2]; r[7] = hi[3]; return r;
}
struct GlaRegs { v4u zw, vw[2]; };
__device__ __forceinline__ GlaRegs gla_load(const Frame& F, size_t prow, int h) {
    GlaRegs r; const int tid = F.tid; const bf16* P = (const bf16*)(F.ws + WS_P);
    { const int t = (tid & 255) >> 2, q = tid & 3; r.zw = *(const v4u*)(P + (prow + t) * PW + CAF + 8 * q); }
#pragma unroll
    for (int i = 0; i < 2; ++i) { const int pc = tid + i * NTHREADS, t = pc >> 4, c = pc & 15; r.vw[i] = *(const v4u*)(P + (prow + t) * PW + CV + h * 128 + c * 8); }
    return r;
}
__device__ __forceinline__ void gla_prep(const Frame& F, CArgs* A, const GlaRegs& R, int h) {
    LAS unsigned char* lds = F.lds; const int tid = F.tid;
    if (tid < 256) { const int t = tid >> 2, q = tid & 3; const v4u w = R.zw;
        LAS float* z = (LAS float*)(lds + GL_ZL) + (q >> 1) * 1024 + t * 16 + (q & 1) * 8;
        *(LAS f32x4*)z = (f32x4){bflo(w.x), bfhi(w.x), bflo(w.y), bfhi(w.y)}; *(LAS f32x4*)(z + 4) = (f32x4){bflo(w.z), bfhi(w.z), bflo(w.w), bfhi(w.w)}; }
#pragma unroll
    for (int i = 0; i < 2; ++i) { const int pc = tid + i * NTHREADS, t = pc >> 4, c = pc & 15; *(LAS v4u*)(lds + GL_V + (t * 136 + c * 8) * 2) = R.vw[i]; }
    __syncthreads();
    { const int dir = tid >> 8, seg = (tid >> 6) & 3, d = tid & 63;
      const float* up = dir ? A->in[10] : A->in[8]; const float bias = (dir ? A->in[11] : A->in[9])[h * 64 + d];
      float u[16];
#pragma unroll
      for (int r = 0; r < 16; ++r) u[r] = up[r * 256 + h * 64 + d];
      const LAS float* zl = (const LAS float*)(lds + GL_ZL) + dir * 1024; LAS float* bc = (LAS float*)(lds + GL_BC) + dir * 4096 + d;
      LAS float* sg = (LAS float*)(lds + GL_SEG) + dir * 256 + d;
      float c[16]; float cum = 0.f;
#pragma unroll
      for (int i = 0; i < 16; ++i) { const int t = seg * 16 + (dir ? 15 - i : i); const LAS float* zp = zl + t * 16;
          const f32x4 z0 = *(const LAS f32x4*)zp, z1 = *(const LAS f32x4*)(zp + 4), z2 = *(const LAS f32x4*)(zp + 8), z3 = *(const LAS f32x4*)(zp + 12);
          float z = bias + z0[0] * u[0] + z0[1] * u[1] + z0[2] * u[2] + z0[3] * u[3] + z1[0] * u[4] + z1[1] * u[5] + z1[2] * u[6] + z1[3] * u[7]
                         + z2[0] * u[8] + z2[1] * u[9] + z2[2] * u[10] + z2[3] * u[11] + z3[0] * u[12] + z3[1] * u[13] + z3[2] * u[14] + z3[3] * u[15];
          const float ls = fminf(z, 0.f) - __logf(1.0f + __expf(-fabsf(z)));
          cum += ls * (1.0f / 16.0f); c[i] = cum; }
      sg[seg * 64] = cum;
      __syncthreads();
      float off = 0.f, tot = 0.f;
#pragma unroll
      for (int s2 = 0; s2 < 4; ++s2) { const float v = sg[s2 * 64]; tot += v; off += (dir ? (s2 > seg) : (s2 < seg)) ? v : 0.f; }
#pragma unroll
      for (int i = 0; i < 16; ++i) { const int t = seg * 16 + (dir ? 15 - i : i); bc[t * 64] = off + c[i]; }
      if (seg == 0) ((LAS float*)(lds + GL_TOT))[dir * 64 + d] = tot; }
    __syncthreads();
}

__device__ __forceinline__ size_t chunk_row(int b, int cc) { return cc < 4 ? (size_t)NLAT + b * CTXL + cc * 64 : (size_t)b * SEQ + (cc - 4) * 64; }
__device__ __forceinline__ void p3_phase(const Frame& F, CArgs* A) {
    LAS unsigned char* lds = F.lds; const int tid = F.tid, lane = F.lane, wave = F.wave;
    GlaRegs cur; if (F.bid < NBATCH * NCC * 4) { const int bc0 = F.bid >> 2; cur = gla_load(F, chunk_row(bc0 / NCC, bc0 % NCC), F.bid & 3); }
    for (int it = F.bid; it < NBATCH * NCC * 4; it += F.G) {
        const int h = it & 3, bc = it >> 2, b = bc / NCC, cc = bc % NCC; const size_t prow = chunk_row(b, cc);
        GlaRegs nxt = cur; { const int itn = it + F.G; if (itn < NBATCH * NCC * 4) { const int bcn = itn >> 2; nxt = gla_load(F, chunk_row(bcn / NCC, bcn % NCC), itn & 3); } }
        float kf[8];
        { const int d = tid & 63, tg = tid >> 6;
#pragma unroll
          for (int j = 0; j < 8; ++j) kf[j] = bf2f(((bf16*)(F.ws + WS_P))[(prow + tg * 8 + j) * PW + CK + h * 64 + d]); }
        gla_prep(F, A, cur, h); cur = nxt;
        if (tid < 128) { const int dir = tid >> 6, d = tid & 63; ((float*)(F.ws + WS_DECAY))[(((size_t)dir * NBATCH + b) * NCC + cc) * 256 + h * 64 + d] = __expf(((const LAS float*)(lds + GL_TOT))[dir * 64 + d]); }
        { const int d = tid & 63, tg = tid >> 6;
#pragma unroll
          for (int dir = 0; dir < 2; ++dir) { const float tot = ((const LAS float*)(lds + GL_TOT))[dir * 64 + d]; const LAS float* bcp = (const LAS float*)(lds + GL_BC) + dir * 4096 + (tg * 8) * 64 + d; float s[8];
#pragma unroll
              for (int j = 0; j < 8; ++j) s[j] = kf[j] * __expf(tot - bcp[j * 64]);
              v4u w; w.x = pk2(s[0], s[1]); w.y = pk2(s[2], s[3]); w.z = pk2(s[4], s[5]); w.w = pk2(s[6], s[7]);
              *(LAS v4u*)(lds + GL_A + ((dir * 64 + d) * 72 + tg * 8) * 2) = w; } }
        __syncthreads();
        { const int dir = wave & 1, dt = wave >> 1, i = lane & 15, g = lane >> 4;
          bf16x8 af[2];
#pragma unroll
          for (int ks = 0; ks < 2; ++ks) af[ks] = *(const LAS bf16x8*)(lds + GL_A + ((dir * 64 + dt * 16 + i) * 72 + 32 * ks + 8 * g) * 2);
          bf16* kvp = ((bf16*)(F.ws + WS_KV)) + ((((size_t)dir * NBATCH + b) * NCC + cc) * 4 + h) * 8192;
#pragma unroll 2
          for (int vt = 0; vt < 8; ++vt) { f32x4 acc = {0.f, 0.f, 0.f, 0.f}; bf16x8 vf0, vf1; v_frag2(lds, vt * 16, lane, vf0, vf1);
              acc = __builtin_amdgcn_mfma_f32_16x16x32_bf16(af[0], vf0, acc, 0, 0, 0); acc = __builtin_amdgcn_mfma_f32_16x16x32_bf16(af[1], vf1, acc, 0, 0, 0);
              v2u w; w.x = pk2(acc[0], acc[1]); w.y = pk2(acc[2], acc[3]);
              *(v2u*)(kvp + (size_t)(vt * 16 + i) * 64 + dt * 16 + 4 * g) = w; } }
        __syncthreads();
    }
}

constexpr int G2_ZL = 0;
constexpr int G2_HT = 8192;
constexpr int G2_TOT = G2_HT + 4096;
constexpr int G2_A = G2_TOT + 1024;
constexpr int G2_B = G2_A + 256 * 72 * 2;
constexpr int G2_VS = 528;
static_assert(G2_B + 64 * G2_VS * 2 <= RING_BYTES && G2_B + 256 * 72 * 2 <= RING_BYTES && (G2_A % 16) == 0 && (G2_B % 16) == 0, "GLA v2 LDS map");
__device__ __forceinline__ void tr_frag2(unsigned tile_addr, int c0, int lane, bf16x8& f0, bf16x8& f1) {
    const int i = lane & 15, g = lane >> 4;
    const unsigned a0 = tile_addr + (unsigned)(((8 * g + (i >> 2)) * G2_VS + c0 + 4 * (i & 3)) * 2);
    s16x4 r0, r1, r2, r3;
    asm volatile("ds_read_b64_tr_b16 %0, %4\n\tds_read_b64_tr_b16 %1, %4 offset:4224\n\tds_read_b64_tr_b16 %2, %4 offset:33792\n\tds_read_b64_tr_b16 %3, %4 offset:38016\n\ts_waitcnt lgkmcnt(0)"
                 : "=&v"(r0), "=&v"(r1), "=&v"(r2), "=&v"(r3) : "v"(a0) : "memory");
    f0[0] = r0[0]; f0[1] = r0[1]; f0[2] = r0[2]; f0[3] = r0[3]; f0[4] = r1[0]; f0[5] = r1[1]; f0[6] = r1[2]; f0[7] = r1[3];
    f1[0] = r2[0]; f1[1] = r2[1]; f1[2] = r2[2]; f1[3] = r2[3]; f1[4] = r3[0]; f1[5] = r3[1]; f1[6] = r3[2]; f1[7] = r3[3];
}
static_assert(4 * G2_VS * 2 == 4224 && 32 * G2_VS * 2 == 33792 && 36 * G2_VS * 2 == 38016, "tr_frag2 offsets");
__device__ __forceinline__ float log_sigmoid16(float z) { return (fminf(z, 0.f) - __logf(1.0f + __expf(-fabsf(z)))) * (1.0f / 16.0f); }

__device__ __forceinline__ void p3v2_phase(const Frame& F, CArgs* A) {
    LAS unsigned char* lds = F.lds; const int tid = F.tid, lane = F.lane, wave = F.wave, i = lane & 15, g = lane >> 4;
    const int c = tid & 255, th = tid >> 8;
    const bf16* P = (const bf16*)(F.ws + WS_P);
#pragma unroll 1
    for (int it = F.bid; it < NBATCH * NCC; it += F.G) {
        const int b = it / NCC, cc = it % NCC; const size_t prow = chunk_row(b, cc);
        if (tid < 256) { const int t = tid >> 2, q = tid & 3; const v4u w = *(const v4u*)(P + (prow + t) * PW + CAF + 8 * q);
            LAS float* z = (LAS float*)(lds + G2_ZL) + (q >> 1) * 1024 + t * 16 + (q & 1) * 8;
            *(LAS f32x4*)z = (f32x4){bflo(w.x), bfhi(w.x), bflo(w.y), bfhi(w.y)}; *(LAS f32x4*)(z + 4) = (f32x4){bflo(w.z), bfhi(w.z), bflo(w.w), bfhi(w.w)}; }
#pragma unroll
        for (int j = 0; j < 8; ++j) { const int pc = tid + j * NTHREADS, t = pc >> 6, cv = pc & 63;
            *(LAS v4u*)(lds + G2_B + (t * G2_VS + cv * 8) * 2) = *(const v4u*)(P + (prow + t) * PW + CV + cv * 8); }
        float kk[32];
#pragma unroll
        for (int tl = 0; tl < 32; ++tl) kk[tl] = bf2f(P[(prow + th * 32 + tl) * PW + CK + c]);
        __syncthreads();
#pragma unroll
        for (int dir = 0; dir < 2; ++dir) {
            { const float* up = dir ? A->in[10] : A->in[8]; const float bias = (dir ? A->in[11] : A->in[9])[c];
              float u[16];
#pragma unroll
              for (int r = 0; r < 16; ++r) u[r] = up[r * 256 + c];
              const LAS float* zl = (const LAS float*)(lds + G2_ZL) + dir * 1024 + th * 512;
              float cl[32]; float cum = 0.f;
#pragma unroll
              for (int ii = 0; ii < 32; ++ii) { const int tl = dir ? 31 - ii : ii; const LAS float* zp = zl + tl * 16;
                  const f32x4 z0 = *(const LAS f32x4*)zp, z1 = *(const LAS f32x4*)(zp + 4), z2 = *(const LAS f32x4*)(zp + 8), z3 = *(const LAS f32x4*)(zp + 12);
                  const float z = bias + z0[0] * u[0] + z0[1] * u[1] + z0[2] * u[2] + z0[3] * u[3] + z1[0] * u[4] + z1[1] * u[5] + z1[2] * u[6] + z1[3] * u[7]
                                       + z2[0] * u[8] + z2[1] * u[9] + z2[2] * u[10] + z2[3] * u[11] + z3[0] * u[12] + z3[1] * u[13] + z3[2] * u[14] + z3[3] * u[15];
                  cum += log_sigmoid16(z); cl[tl] = cum; }
              LAS float* ht = (LAS float*)(lds + G2_HT) + dir * 512;
              ht[th * 256 + c] = cum;
              __syncthreads();
              const float other = ht[(1 - th) * 256 + c], tot = cum + other;
              const float off = (dir == 0) ? (th ? other : 0.f) : (th ? 0.f : other);
              if (th == 0) { ((LAS float*)(lds + G2_TOT))[c] = tot; ((float*)(F.ws + WS_DECAY))[(((size_t)dir * NBATCH + b) * NCC + cc) * 256 + c] = __expf(tot); }
#pragma unroll
              for (int j = 0; j < 4; ++j) { float e[8];
#pragma unroll
                  for (int q = 0; q < 8; ++q) e[q] = kk[8 * j + q] * __expf(-(off + cl[8 * j + q]));
                  v4u w; w.x = pk2(e[0], e[1]); w.y = pk2(e[2], e[3]); w.z = pk2(e[4], e[5]); w.w = pk2(e[6], e[7]);
                  *(LAS v4u*)(lds + G2_A + (c * 72 + th * 32 + 8 * j) * 2) = w; } }
            __syncthreads();
            { const int h = wave >> 1, vh = wave & 1;
              bf16x8 af[4][2];
#pragma unroll
              for (int dt = 0; dt < 4; ++dt)
#pragma unroll
                  for (int ks = 0; ks < 2; ++ks) af[dt][ks] = *(const LAS bf16x8*)(lds + G2_A + ((h * 64 + dt * 16 + i) * 72 + 32 * ks + 8 * g) * 2);
              f32x4 et[4];
#pragma unroll
              for (int dt = 0; dt < 4; ++dt) { const f32x4 tv = *(const LAS f32x4*)(lds + G2_TOT + (h * 64 + dt * 16 + 4 * g) * 4); et[dt] = (f32x4){__expf(tv[0]), __expf(tv[1]), __expf(tv[2]), __expf(tv[3])}; }
              bf16* kvp = ((bf16*)(F.ws + WS_KV)) + ((((size_t)dir * NBATCH + b) * NCC + cc) * 4 + h) * 8192;
              bf16* vtp = ((bf16*)(F.ws + WS_VT)) + (((size_t)b * 64 + (cc - 4)) * 4 + h) * 8192;
#pragma unroll
              for (int vt = 0; vt < 4; ++vt) { const int v0 = vh * 64 + vt * 16; bf16x8 vf0, vf1; tr_frag2((unsigned)(uintptr_t)(lds + G2_B), h * 128 + v0, lane, vf0, vf1);
                  if (dir == 0 && cc >= 4) { *(bf16x8*)(vtp + (size_t)(v0 + i) * 64 + 8 * g) = vf0; *(bf16x8*)(vtp + (size_t)(v0 + i) * 64 + 32 + 8 * g) = vf1; }
#pragma unroll
                  for (int dt = 0; dt < 4; ++dt) { f32x4 acc = {0.f, 0.f, 0.f, 0.f};
                      acc = __builtin_amdgcn_mfma_f32_16x16x32_bf16(af[dt][0], vf0, acc, 0, 0, 0); acc = __builtin_amdgcn_mfma_f32_16x16x32_bf16(af[dt][1], vf1, acc, 0, 0, 0);
                      acc = acc * et[dt];
                      v2u w; w.x = pk2(acc[0], acc[1]); w.y = pk2(acc[2], acc[3]);
                      *(v2u*)(kvp + (size_t)(v0 + i) * 64 + dt * 16 + 4 * g) = w; } } }
            __syncthreads();
        }
    }
}

struct GateConst { bf16x8 bw[2][2]; float bias[2][2]; };
__device__ __forceinline__ GateConst gate_setup(CArgs* A, int wave, int lane) {
    GateConst G; const int i = lane & 15, g = lane >> 4;
#pragma unroll
    for (int dir = 0; dir < 2; ++dir)
#pragma unroll
        for (int cti = 0; cti < 2; ++cti) { const int c = 32 * wave + 16 * cti + i; const float* up = dir ? A->in[10] : A->in[8];
            G.bias[dir][cti] = (dir ? A->in[11] : A->in[9])[c];
#pragma unroll
            for (int jj = 0; jj < 8; ++jj) { const float v = up[(8 * (g & 1) + jj) * 256 + c]; const unsigned hi = f2bf(v); const float rem = v - __builtin_bit_cast(float, hi << 16);
                G.bw[dir][cti][jj] = (short)((g < 2) ? hi : f2bf(rem)); } }
    return G;
}
__device__ __forceinline__ float log_sigmoid16_fast(float z) { const float e = __builtin_amdgcn_exp2f(fabsf(z) * -1.4426950409f); return (fminf(z, 0.f) - __builtin_amdgcn_logf(1.0f + e) * 0.6931471806f) * 0.0625f; }
__device__ __forceinline__ void gate_b(const GateConst& G, const bf16* P, size_t prow, int lane, f32x4 (&bv)[2][2][4], float (&tot)[2][2]) {
    const int i = lane & 15, g = lane >> 4;
    bf16x8 za[2][4];
#pragma unroll
    for (int dir = 0; dir < 2; ++dir)
#pragma unroll
        for (int tt = 0; tt < 4; ++tt) za[dir][tt] = *(const bf16x8*)(P + (prow + 16 * tt + i) * PW + CAF + 16 * dir + 8 * (g & 1));
#pragma unroll
    for (int dir = 0; dir < 2; ++dir)
#pragma unroll
        for (int cti = 0; cti < 2; ++cti) { float carry = 0.f;
#pragma unroll
            for (int q = 0; q < 4; ++q) { const int tt = dir ? 3 - q : q;
                f32x4 z = {0.f, 0.f, 0.f, 0.f}; z = __builtin_amdgcn_mfma_f32_16x16x32_bf16(za[dir][tt], G.bw[dir][cti], z, 0, 0, 0);
                float la[4];
#pragma unroll
                for (int r = 0; r < 4; ++r) la[r] = log_sigmoid16_fast(z[r] + G.bias[dir][cti]);
                float p[4];
                if (dir == 0) { p[0] = la[0]; p[1] = p[0] + la[1]; p[2] = p[1] + la[2]; p[3] = p[2] + la[3];
                    const float s = p[3]; float incl = s; const float t1 = __shfl_up(incl, 16); if (g >= 1) incl += t1; const float t2 = __shfl_up(incl, 32); if (g >= 2) incl += t2;
                    const float base = carry + (incl - s); carry += __shfl(incl, 48 + i);
                    bv[dir][cti][tt] = (f32x4){base + p[0], base + p[1], base + p[2], base + p[3]}; }
                else { p[3] = la[3]; p[2] = p[3] + la[2]; p[1] = p[2] + la[1]; p[0] = p[1] + la[0];
                    const float s = p[0]; float incl = s; const float t1 = __shfl_down(incl, 16); if (g <= 2) incl += t1; const float t2 = __shfl_down(incl, 32); if (g <= 1) incl += t2;
                    const float base = carry + (incl - s); carry += __shfl(incl, i);
                    bv[dir][cti][tt] = (f32x4){base + p[0], base + p[1], base + p[2], base + p[3]}; } }
            tot[dir][cti] = carry; }
}

constexpr int G3_ST = 0;
constexpr int G3_TOT = 8 * 16 * 144;
constexpr int G3_A = G3_TOT + 1024;
constexpr int G3_B = G3_A + 256 * 72 * 2;
static_assert(G3_B + 64 * G2_VS * 2 <= RING_BYTES && (G3_A % 16) == 0 && (G3_B % 16) == 0, "P3 LDS map");
template <int MODE>
__device__ __forceinline__ void p3v3_phase(const Frame& F, CArgs* A) {
    int tid_ = F.tid; asm volatile("" : "+v"(tid_));
    LAS unsigned char* lds = F.lds; const int tid = tid_, lane = tid & 63, wave = __builtin_amdgcn_readfirstlane(tid >> 6), i = lane & 15, g = lane >> 4;
    const bf16* P = (const bf16*)(F.ws + WS_P);
    const GateConst G = gate_setup(A, wave, lane);
    LAS unsigned char* st = lds + G3_ST + wave * (16 * 144);
#pragma unroll 1
    for (int it = F.bid; it < NBATCH * NCC; it += F.G) {
        const int b = it / NCC, cc = it % NCC; const size_t prow = chunk_row(b, cc);
        unsigned pf0 = 0u, pf1 = 0u;
#pragma unroll
        for (int j = 0; j < 8; ++j) { const int pc = tid + j * NTHREADS, t = pc >> 6, cv = pc & 63;
            *(LAS v4u*)(lds + G3_B + (t * G2_VS + cv * 8) * 2) = *(const v4u*)(P + (prow + t) * PW + CV + cv * 8); }
        unsigned kk[2][4][2];
#pragma unroll
        for (int cti = 0; cti < 2; ++cti)
#pragma unroll
            for (int tt = 0; tt < 4; ++tt)
#pragma unroll
                for (int r = 0; r < 4; r += 2) { const bf16* kp = P + (prow + 16 * tt + 4 * g + r) * PW + CK + 32 * wave + 16 * cti + i; kk[cti][tt][r >> 1] = (unsigned)kp[0] | ((unsigned)kp[PW] << 16); }
        f32x4 bv[2][2][4]; float tot[2][2];
        if (MODE < 4) gate_b(G, P, prow, lane, bv, tot); else {
#pragma unroll
            for (int a_ = 0; a_ < 2; ++a_)
#pragma unroll
                for (int b_ = 0; b_ < 2; ++b_) { tot[a_][b_] = 0.f;
#pragma unroll
                    for (int c_ = 0; c_ < 4; ++c_) bv[a_][b_][c_] = (f32x4){0.f, 0.f, 0.f, 0.f}; } }
#pragma unroll
        for (int dir = 0; dir < 2; ++dir) {
#pragma unroll
            for (int cti = 0; cti < 2; ++cti) { const int c = 32 * wave + 16 * cti + i;
#pragma unroll
                for (int tt = 0; tt < 4; ++tt) { float e[4];
#pragma unroll
                    for (int r = 0; r < 4; ++r) e[r] = ((r & 1) ? bfhi(kk[cti][tt][r >> 1]) : bflo(kk[cti][tt][r >> 1])) * __builtin_amdgcn_exp2f(bv[dir][cti][tt][r] * -1.4426950409f);
                    v2u w; w.x = pk2(e[0], e[1]); w.y = pk2(e[2], e[3]);
                    *(LAS v2u*)(lds + G3_A + (c * 72 + 16 * tt + 4 * g) * 2) = w; }
                if (g == 0) { ((LAS float*)(lds + G3_TOT))[c] = tot[dir][cti]; if (!MODE) ((float*)(F.ws + WS_DECAY))[(((size_t)dir * NBATCH + b) * NCC + cc) * 256 + c] = __expf(tot[dir][cti]); } }
            LDS_BARRIER();
            if (dir == 0) {
                const int itn = it + F.G; if (itn < NBATCH * NCC) { const char* pr = (const char*)(P + (chunk_row(itn / NCC, itn % NCC) + (tid >> 3)) * PW); const int j = tid & 7;
                    pf0 = *(const unsigned*)(pr + 512 + 128 * j); pf1 = *(const unsigned*)(pr + (j < 5 ? 512 + 128 * (8 + j) : 3072 + 32 * (j - 5))); } }
            if (MODE < 3) { const int h = wave >> 1, vh = wave & 1;
              bf16x8 af[4][2];
#pragma unroll
              for (int dt = 0; dt < 4; ++dt)
#pragma unroll
                  for (int ks = 0; ks < 2; ++ks) af[dt][ks] = *(const LAS bf16x8*)(lds + G3_A + ((h * 64 + dt * 16 + i) * 72 + 32 * ks + 8 * g) * 2);
              bf16* kvp = ((bf16*)(F.ws + WS_KV)) + ((((size_t)dir * NBATCH + b) * NCC + cc) * 4 + h) * 8192;
              bf16* vtp = ((bf16*)(F.ws + WS_VT)) + (((size_t)b * 64 + (cc - 4)) * 4 + h) * 8192;
              if (MODE) { kvp = ((bf16*)(F.ws + WS_TOTAL)) + (size_t)(F.bid * 8 + wave) * 512; vtp = kvp + 1024 * 1024; }
#pragma unroll
              for (int vt = 0; vt < 4; ++vt) { const int v0 = vh * 64 + vt * 16; bf16x8 vf0, vf1; tr_frag2((unsigned)(uintptr_t)(lds + G3_B), h * 128 + v0, lane, vf0, vf1);
                  if (dir == 0 && cc >= 4) {
                      *(LAS bf16x8*)(st + i * 144 + 16 * g) = vf0; *(LAS bf16x8*)(st + i * 144 + 64 + 16 * g) = vf1;
                      LDS_WAIT();
#pragma unroll
                      for (int j = 0; j < 2; ++j) { const int pc = lane + 64 * j, row = pc >> 3, ch = pc & 7; const v4u x_ = *(const LAS v4u*)(st + row * 144 + ch * 16); if (MODE == 2) asm volatile("" :: "v"(x_)); else *(v4u*)(vtp + (size_t)((MODE ? 0 : v0) + row) * 64 + ch * 8) = x_; }
                      LDS_WAIT(); }
#pragma unroll
                  for (int dt = 0; dt < 4; ++dt) { f32x4 acc = {0.f, 0.f, 0.f, 0.f};
                      acc = __builtin_amdgcn_mfma_f32_16x16x32_bf16(af[dt][0], vf0, acc, 0, 0, 0); acc = __builtin_amdgcn_mfma_f32_16x16x32_bf16(af[dt][1], vf1, acc, 0, 0, 0);
                      { const f32x4 tv = *(const LAS f32x4*)(lds + G3_TOT + (h * 64 + dt * 16 + 4 * g) * 4);
                        acc = acc * (f32x4){__builtin_amdgcn_exp2f(tv[0] * 1.4426950409f), __builtin_amdgcn_exp2f(tv[1] * 1.4426950409f), __builtin_amdgcn_exp2f(tv[2] * 1.4426950409f), __builtin_amdgcn_exp2f(tv[3] * 1.4426950409f)}; }
                      v2u w; w.x = pk2(acc[0], acc[1]); w.y = pk2(acc[2], acc[3]);
                      *(LAS v2u*)(st + i * 144 + (16 * dt + 4 * g) * 2) = w; }
                  LDS_WAIT();
#pragma unroll
                  for (int j = 0; j < 2; ++j) { const int pc = lane + 64 * j, row = pc >> 3, ch = pc & 7; const v4u x_ = *(const LAS v4u*)(st + row * 144 + ch * 16); if (MODE == 2) asm volatile("" :: "v"(x_)); else *(v4u*)(kvp + (size_t)((MODE ? 0 : v0) + row) * 64 + ch * 8) = x_; }
                  LDS_WAIT(); } }
            LDS_BARRIER();
        }
        asm volatile("" :: "v"(pf0), "v"(pf1));
    }
}

struct ConvRegs { v4u cw[6], xw[6], bw[4]; };
__device__ __forceinline__ void conv_load(const bf16* P, int u, int t, ConvRegs& R) {
    const int item = u >> 1, b = item >> 6, n = item & 63; const size_t prow = (size_t)b * SEQ + n * 64; const int t0 = (u & 1) * 32 + (t >> 6) * 4, c0 = (t & 63) * 8;
#pragma unroll
    for (int q = 0; q < 6; ++q) { const int tt = t0 - 1 + q, tc = tt < 0 ? 0 : (tt > 63 ? 63 : tt);
        R.cw[q] = *(const v4u*)(P + (prow + tc) * PW + CPC + c0); R.xw[q] = *(const v4u*)(P + (prow + tc) * PW + CPX + c0); }
#pragma unroll
    for (int q = 0; q < 4; ++q) R.bw[q] = *(const v4u*)(P + (prow + t0 + q) * PW + CPB + c0);
}
__device__ __forceinline__ void conv_pin(ConvRegs& R) {
    asm volatile("" ::: "memory");
#pragma unroll
    for (int q = 0; q < 6; ++q) { asm volatile("" : "+v"(R.cw[q])); asm volatile("" : "+v"(R.xw[q])); }
#pragma unroll
    for (int q = 0; q < 4; ++q) asm volatile("" : "+v"(R.bw[q]));
}
__device__ __forceinline__ void conv_emit(unsigned char* ws, const f32x2 (&w2)[3][4], int u, int t, const ConvRegs& R) {
    const int item = u >> 1, b = item >> 6, n = item & 63; const size_t prow = (size_t)b * SEQ + n * 64; const int t0 = (u & 1) * 32 + (t >> 6) * 4, c0 = (t & 63) * 8;
    f32x2 ov[4][4];
#pragma unroll
    for (int j = 0; j < 4; ++j)
#pragma unroll
        for (int p = 0; p < 4; ++p) ov[j][p] = (f32x2){0.f, 0.f};
#pragma unroll
    for (int q = 0; q < 6; ++q) { const int tt = t0 - 1 + q; const bool in = tt >= 0 && tt < 64; v4u c_ = R.cw[q]; const v4u x_ = R.xw[q]; f32x2 uu[4];
        c_.x = in ? c_.x : 0u; c_.y = in ? c_.y : 0u; c_.z = in ? c_.z : 0u; c_.w = in ? c_.w : 0u;
        uu[0] = (f32x2){bflo(c_.x), bfhi(c_.x)} * (f32x2){bflo(x_.x), bfhi(x_.x)}; uu[1] = (f32x2){bflo(c_.y), bfhi(c_.y)} * (f32x2){bflo(x_.y), bfhi(x_.y)};
        uu[2] = (f32x2){bflo(c_.z), bfhi(c_.z)} * (f32x2){bflo(x_.z), bfhi(x_.z)}; uu[3] = (f32x2){bflo(c_.w), bfhi(c_.w)} * (f32x2){bflo(x_.w), bfhi(x_.w)};
#pragma unroll
        for (int dt = 0; dt < 3; ++dt) { const int j = q - dt;
            if (j >= 0 && j < 4) {
#pragma unroll
                for (int p = 0; p < 4; ++p) ov[j][p] += w2[dt][p] * uu[p]; } } }
#pragma unroll
    for (int q = 0; q < 4; ++q) { const v4u b_ = R.bw[q];
        const f32x2 y0 = ov[q][0] * (f32x2){bflo(b_.x), bfhi(b_.x)}, y1 = ov[q][1] * (f32x2){bflo(b_.y), bfhi(b_.y)}, y2 = ov[q][2] * (f32x2){bflo(b_.z), bfhi(b_.z)}, y3 = ov[q][3] * (f32x2){bflo(b_.w), bfhi(b_.w)};
        if (OUTPROJ_F8) { v2u w; w.x = pk4_fp8(y0.x, y0.y, y1.x, y1.y); w.y = pk4_fp8(y2.x, y2.y, y3.x, y3.y);
            *(v2u*)(ws + WS_YMIX + (prow + t0 + q) * D + 512 + c0) = w; }
        else { v4u w; w.x = pk2(y0.x, y0.y); w.y = pk2(y1.x, y1.y); w.z = pk2(y2.x, y2.y); w.w = pk2(y3.x, y3.y);
            *(v4u*)(((bf16*)(ws + WS_YMIX)) + (prow + t0 + q) * D + 512 + c0) = w; } }
}
__device__ __forceinline__ void conv_stream(const Frame& F, CArgs* A, int t) {
    const bf16* P = (const bf16*)(F.ws + WS_P);
    constexpr int NU = NBATCH * 64 * 2;
    f32x2 w2[3][4];
    { const int c0 = (t & 63) * 8;
#pragma unroll
      for (int dt = 0; dt < 3; ++dt) { const f32x4 a = *(const f32x4*)(A->in[13] + dt * 512 + c0), b = *(const f32x4*)(A->in[13] + dt * 512 + c0 + 4);
          w2[dt][0] = (f32x2){a[0], a[1]}; w2[dt][1] = (f32x2){a[2], a[3]}; w2[dt][2] = (f32x2){b[0], b[1]}; w2[dt][3] = (f32x2){b[2], b[3]}; } }
    ConvRegs Ra, Rb;
    int u = F.bid;
    if (u < NU) conv_load(P, u, t, Ra);
#pragma unroll 1
    for (; u < NU; u += 2 * F.G) {
        const int un = (u + F.G < NU) ? u + F.G : u, un2 = (u + 2 * F.G < NU) ? u + 2 * F.G : u;
        conv_load(P, un, t, Rb); conv_pin(Ra);
        conv_emit(F.ws, w2, u, t, Ra);
        conv_load(P, un2, t, Ra); conv_pin(Rb);
        conv_emit(F.ws, w2, un, t, Rb);
    }
}

__device__ __forceinline__ void gate_b_dir(const GateConst& G, const bf16* P, size_t prow, int lane, int dir, f32x4 (&bv)[2][4]) {
    const int i = lane & 15, g = lane >> 4;
    bf16x8 za[4];
#pragma unroll
    for (int tt = 0; tt < 4; ++tt) za[tt] = *(const bf16x8*)(P + (prow + 16 * tt + i) * PW + CAF + 16 * dir + 8 * (g & 1));
#pragma unroll
    for (int cti = 0; cti < 2; ++cti) { float carry = 0.f;
#pragma unroll
        for (int q = 0; q < 4; ++q) { const int tt = dir ? 3 - q : q;
            f32x4 z = {0.f, 0.f, 0.f, 0.f}; z = __builtin_amdgcn_mfma_f32_16x16x32_bf16(za[tt], G.bw[dir][cti], z, 0, 0, 0);
            float la[4];
#pragma unroll
            for (int r = 0; r < 4; ++r) la[r] = log_sigmoid16_fast(z[r] + G.bias[dir][cti]);
            float p[4];
            if (dir == 0) { p[0] = la[0]; p[1] = p[0] + la[1]; p[2] = p[1] + la[2]; p[3] = p[2] + la[3];
                const float s = p[3]; float incl = s; const float t1 = __shfl_up(incl, 16); if (g >= 1) incl += t1; const float t2 = __shfl_up(incl, 32); if (g >= 2) incl += t2;
                const float base = carry + (incl - s); carry += __shfl(incl, 48 + i);
                bv[cti][tt] = (f32x4){base + p[0], base + p[1], base + p[2], base + p[3]}; }
            else { p[3] = la[3]; p[2] = p[3] + la[2]; p[1] = p[2] + la[1]; p[0] = p[1] + la[0];
                const float s = p[0]; float incl = s; const float t1 = __shfl_down(incl, 16); if (g <= 2) incl += t1; const float t2 = __shfl_down(incl, 32); if (g <= 1) incl += t2;
                const float base = carry + (incl - s); carry += __shfl(incl, i);
                bv[cti][tt] = (f32x4){base + p[0], base + p[1], base + p[2], base + p[3]}; } } }
}

constexpr int G5_Q = 0;
constexpr int G5_K = 4 * 64 * 72 * 2;
constexpr int G5_P = 2 * G5_K;
constexpr int G5_GW = 131072 + 12288;
static_assert(G5_P + 4 * 64 * 72 * 2 <= RING_BYTES && 8 * 16 * 272 <= G5_K, "P5 LDS map");
template <int MODE>
__device__ __forceinline__ void p5av3_phase(const Frame& F, CArgs* A) {
    LAS unsigned char* lds = F.lds;
    const bf16* P = (const bf16*)(F.ws + WS_P);
    const GateConst G = gate_setup(A, F.wave, F.lane);
    if (F.tid < 32) *(LAS f32x4*)(lds + G5_GW + F.tid * 16) = *(const f32x4*)(A->in[12] + F.tid * 4);
    __syncthreads();
#pragma unroll 1
    for (int it = F.bid; it < NBATCH * 64; it += F.G) {
        int tid_ = F.tid; asm volatile("" : "+v"(tid_));
        const int tid = tid_, lane = tid & 63, wave = __builtin_amdgcn_readfirstlane(tid >> 6), i = lane & 15, g = lane >> 4;
        const int h = wave >> 1, half = wave & 1;
        LAS unsigned char* st = lds + G5_Q + wave * (16 * 272);
        const int b = it >> 6, n = it & 63; const size_t prow = (size_t)b * SEQ + n * 64;
        unsigned pfv[9];
#pragma unroll
        for (int q = 0; q < 9; ++q) pfv[q] = 0u;
        const int dh = 32 * half + i;
        f32x4 pdiag[2], oacc[2][8];
#pragma unroll
        for (int a = 0; a < 2; ++a) { pdiag[a] = (f32x4){0.f, 0.f, 0.f, 0.f};
#pragma unroll
            for (int q = 0; q < 8; ++q) oacc[a][q] = (f32x4){0.f, 0.f, 0.f, 0.f}; }
#pragma unroll
        for (int dir = 0; dir < (MODE >= 4 ? 0 : 2); ++dir) {
            { unsigned qk[2][4][4];
#pragma unroll
              for (int cti = 0; cti < 2; ++cti)
#pragma unroll
                  for (int tt = 0; tt < 4; ++tt)
#pragma unroll
                      for (int r = 0; r < 4; ++r) { const bf16* rp = P + (prow + 16 * tt + 4 * g + r) * PW + h * 64 + dh + 16 * cti; qk[cti][tt][r] = (unsigned)rp[CQ] | ((unsigned)rp[CK] << 16); }
              f32x4 bv[2][4]; gate_b_dir(G, P, prow, lane, dir, bv);
#pragma unroll
              for (int cti = 0; cti < 2; ++cti)
#pragma unroll
                  for (int tt = 0; tt < 4; ++tt)
#pragma unroll
                      for (int r = 0; r < 4; ++r) { const float e = __builtin_amdgcn_exp2f(bv[cti][tt][r] * 1.4426950409f); const unsigned w = qk[cti][tt][r];
                          const int off = ((h * 64 + 16 * tt + 4 * g + r) * 72 + dh + 16 * cti) * 2;
                          *(LAS bf16*)(lds + G5_Q + off) = (bf16)f2bf(bflo(w) * e * 0.125f); *(LAS bf16*)(lds + G5_K + off) = (bf16)f2bf(bfhi(w) * __builtin_amdgcn_rcpf(e)); } }
            LDS_BARRIER();
            if (MODE < 3) { bf16x8 qf[2][2];
#pragma unroll
              for (int tti = 0; tti < 2; ++tti)
#pragma unroll
                  for (int ks = 0; ks < 2; ++ks) qf[tti][ks] = *(const LAS bf16x8*)(lds + G5_Q + ((h * 64 + (2 * half + tti) * 16 + i) * 72 + 32 * ks + 8 * g) * 2);
              const bf16* sp = ((const bf16*)(F.ws + WS_S)) + ((((size_t)dir * NBATCH + b) * 64 + n) * 4 + h) * 8192 + (size_t)i * 64 + 8 * g;
#pragma unroll
              for (int st_ = 0; st_ < 4; ++st_) { const bf16x8 kf0 = *(const LAS bf16x8*)(lds + G5_K + ((h * 64 + st_ * 16 + i) * 72 + 8 * g) * 2), kf1 = *(const LAS bf16x8*)(lds + G5_K + ((h * 64 + st_ * 16 + i) * 72 + 32 + 8 * g) * 2);
#pragma unroll
                  for (int tti = 0; tti < 2; ++tti) { const int tt = 2 * half + tti;
                      if (dir == 0 ? (st_ <= tt) : (st_ >= tt)) { f32x4 a = {0.f, 0.f, 0.f, 0.f};
                          a = __builtin_amdgcn_mfma_f32_16x16x32_bf16(kf0, qf[tti][0], a, 0, 0, 0); a = __builtin_amdgcn_mfma_f32_16x16x32_bf16(kf1, qf[tti][1], a, 0, 0, 0);
                          const int t = tt * 16 + i, s0 = st_ * 16 + 4 * g;
                          if (st_ == tt) {
#pragma unroll
                              for (int r = 0; r < 4; ++r) pdiag[tti][r] += (dir == 0 ? (s0 + r <= t) : (s0 + r >= t)) ? a[r] : 0.f;
                              a = pdiag[tti]; }
                          if (st_ != tt || dir == 1) { v2u w; w.x = pk2(a[0], a[1]); w.y = pk2(a[2], a[3]);
                              *(LAS v2u*)(lds + G5_P + ((h * 64 + t) * 72 + s0) * 2) = w; } } } }
              bf16x8 sfr[4][2];
#pragma unroll
              for (int vt = 0; vt < 4; ++vt) { sfr[vt][0] = *(const bf16x8*)(sp + (size_t)vt * 1024); sfr[vt][1] = *(const bf16x8*)(sp + (size_t)vt * 1024 + 32); }
#pragma unroll
              for (int vt = 0; vt < 8; ++vt) {
#pragma unroll
                  for (int tti = 0; tti < 2; ++tti) { oacc[tti][vt] = __builtin_amdgcn_mfma_f32_16x16x32_bf16(sfr[vt & 3][0], qf[tti][0], oacc[tti][vt], 0, 0, 0); oacc[tti][vt] = __builtin_amdgcn_mfma_f32_16x16x32_bf16(sfr[vt & 3][1], qf[tti][1], oacc[tti][vt], 0, 0, 0); }
                  asm volatile("" : "+v"(oacc[0][vt]), "+v"(oacc[1][vt]) :: "memory");
                  if (vt < 4) { sfr[vt][0] = *(const bf16x8*)(sp + (size_t)(vt + 4) * 1024); sfr[vt][1] = *(const bf16x8*)(sp + (size_t)(vt + 4) * 1024 + 32); } } }
            LDS_BARRIER();
        }
        LDS_WAIT();
        v2u rwv[2][8];
        if (MODE < 2) {
#pragma unroll
            for (int tti = 0; tti < 2; ++tti)
#pragma unroll
                for (int vt = 0; vt < 8; ++vt) rwv[tti][vt] = *(const v2u*)(P + (prow + (2 * half + tti) * 16 + i) * PW + CR + h * 128 + vt * 16 + 4 * g); }
        if (MODE < 2) { bf16x8 pfr[2][2];
#pragma unroll
          for (int tti = 0; tti < 2; ++tti)
#pragma unroll
              for (int ks = 0; ks < 2; ++ks) pfr[tti][ks] = *(const LAS bf16x8*)(lds + G5_P + ((h * 64 + (2 * half + tti) * 16 + i) * 72 + 32 * ks + 8 * g) * 2);
          const bf16* vp = ((const bf16*)(F.ws + WS_VT)) + (((size_t)b * 64 + n) * 4 + h) * 8192 + (size_t)i * 64 + 8 * g;
          bf16x8 vfr[8][2];
#pragma unroll
          for (int vt = 0; vt < 8; ++vt) { vfr[vt][0] = *(const bf16x8*)(vp + (size_t)vt * 1024); vfr[vt][1] = *(const bf16x8*)(vp + (size_t)vt * 1024 + 32); }
          { const int itn = it + F.G; if (itn < NBATCH * 64) { const int bn_ = itn >> 6, nn_ = itn & 63; const char* pr = (const char*)(P + ((size_t)bn_ * SEQ + nn_ * 64 + (tid >> 3)) * PW); const int j = tid & 7;
                pfv[0] = *(const unsigned*)(pr + 128 * j); pfv[1] = *(const unsigned*)(pr + 2048 + 128 * j); if (j == 0) pfv[2] = *(const unsigned*)(pr + 3072);
                const char* sb = (const char*)(((const bf16*)(F.ws + WS_S)) + (((size_t)bn_ * 64 + nn_) * 4) * 8192) + (size_t)tid * 128;
                pfv[6] = *(const unsigned*)sb; pfv[7] = *(const unsigned*)(sb + (size_t)NBATCH * 64 * 4 * 8192 * 2);
                pfv[8] = *(const unsigned*)((const char*)(((const bf16*)(F.ws + WS_VT)) + (((size_t)bn_ * 64 + nn_) * 4) * 8192) + (size_t)tid * 128); } }
#pragma unroll
          for (int vt = 0; vt < 8; ++vt)
#pragma unroll
              for (int tti = 0; tti < 2; ++tti) { oacc[tti][vt] = __builtin_amdgcn_mfma_f32_16x16x32_bf16(vfr[vt][0], pfr[tti][0], oacc[tti][vt], 0, 0, 0); oacc[tti][vt] = __builtin_amdgcn_mfma_f32_16x16x32_bf16(vfr[vt][1], pfr[tti][1], oacc[tti][vt], 0, 0, 0); } }
#pragma unroll
        for (int tti = 0; tti < (MODE >= 2 ? 0 : 2); ++tti) { const int t = (2 * half + tti) * 16 + i; float ss = 0.f;
#pragma unroll
            for (int vt = 0; vt < 8; ++vt) { const f32x4 a = oacc[tti][vt]; ss += (a[0] * a[0] + a[1] * a[1]) + (a[2] * a[2] + a[3] * a[3]); }
            ss += __shfl_xor(ss, 16); ss += __shfl_xor(ss, 32);
            const float rstd = 1.0f / sqrtf(ss * (1.0f / 128.0f) + EPS);
#pragma unroll
            for (int vt = 0; vt < 8; ++vt) { const int v = vt * 16 + 4 * g; const f32x4 gw = *(const LAS f32x4*)(lds + G5_GW + v * 4); const v2u rw = rwv[tti][vt];
                const float r[4] = {bflo(rw.x), bfhi(rw.x), bflo(rw.y), bfhi(rw.y)}; float y[4];
#pragma unroll
                for (int j = 0; j < 4; ++j) y[j] = oacc[tti][vt][j] * rstd * gw[j] * (r[j] * __builtin_amdgcn_rcpf(1.0f + __builtin_amdgcn_exp2f(r[j] * -1.4426950409f)));
                if (OUTPROJ_F8) *(LAS unsigned*)(st + i * 144 + v) = pk4_fp8(y[0], y[1], y[2], y[3]);
                else { v2u w; w.x = pk2(y[0], y[1]); w.y = pk2(y[2], y[3]);
                    *(LAS v2u*)(st + i * 272 + v * 2) = w; }
                if ((vt & 3) == 3) asm volatile("" ::: "memory"); }
            LDS_WAIT();
            if (OUTPROJ_F8) {
#pragma unroll
                for (int j = 0; j < 2; ++j) { const int pc = lane + 64 * j, row = pc >> 3, ch = pc & 7;
                    *(v4u*)(F.ws + WS_YMIX + (prow + (2 * half + tti) * 16 + row) * D + h * 128 + ch * 16) = *(const LAS v4u*)(st + row * 144 + ch * 16); } }
            else {
#pragma unroll
                for (int j = 0; j < 4; ++j) { const int pc = lane + 64 * j, row = pc >> 4, ch = pc & 15;
                    *(v4u*)(((bf16*)(F.ws + WS_YMIX)) + (prow + (2 * half + tti) * 16 + row) * D + h * 128 + ch * 8) = *(const LAS v4u*)(st + row * 272 + ch * 16); } }
            LDS_WAIT(); }
#pragma unroll
        for (int q = 0; q < 9; ++q) asm volatile("" :: "v"(pfv[q]));
        LDS_BARRIER();
    }
    if (MODE < 1) { int tc_ = F.tid; asm volatile("" : "+v"(tc_)); conv_stream(F, A, tc_); }
}

__device__ __forceinline__ void p4_phase(const Frame& F, CArgs* A) {
    int tid_ = threadIdx.x; asm volatile("" : "+v"(tid_));
    const int tid = tid_;
    for (int idx = F.bid * NTHREADS + tid; idx < 2 * NBATCH * 4 * 1024; idx += F.G * NTHREADS) {
        const int e8 = idx & 1023, ch = idx >> 10, h = ch & 3, b = (ch >> 2) & 15, dir = ch >> 6; const int d0 = (e8 & 7) * 8;
        float s[8];
#pragma unroll
        for (int j = 0; j < 8; ++j) s[j] = 0.f;
#pragma unroll 17
        for (int st = 0; st < NCC; ++st) {
            const int cc = dir ? (st < 4 ? 3 - st : 71 - st) : st;
            const size_t ci = ((size_t)dir * NBATCH + b) * NCC + cc;
            const v4u kv = *(const v4u*)(((bf16*)(F.ws + WS_KV)) + (ci * 4 + h) * 8192 + (size_t)e8 * 8);
            const f32x4 dc0 = *(const f32x4*)(((float*)(F.ws + WS_DECAY)) + ci * 256 + h * 64 + d0), dc1 = *(const f32x4*)(((float*)(F.ws + WS_DECAY)) + ci * 256 + h * 64 + d0 + 4);
            if (cc >= 4) { v4u w; w.x = pk2(s[0], s[1]); w.y = pk2(s[2], s[3]); w.z = pk2(s[4], s[5]); w.w = pk2(s[6], s[7]);
                *(v4u*)(((bf16*)(F.ws + WS_S)) + ((((size_t)dir * NBATCH + b) * 64 + (cc - 4)) * 4 + h) * 8192 + (size_t)e8 * 8) = w; }
            s[0] = s[0] * dc0[0] + bflo(kv.x); s[1] = s[1] * dc0[1] + bfhi(kv.x); s[2] = s[2] * dc0[2] + bflo(kv.y); s[3] = s[3] * dc0[3] + bfhi(kv.y);
            s[4] = s[4] * dc1[0] + bflo(kv.z); s[5] = s[5] * dc1[1] + bfhi(kv.z); s[6] = s[6] * dc1[2] + bflo(kv.w); s[7] = s[7] * dc1[3] + bfhi(kv.w);
        }
    }
}

__device__ __forceinline__ void p5a_phase(const Frame& F, CArgs* A) {
    LAS unsigned char* lds = F.lds; const int tid = F.tid, lane = F.lane, wave = F.wave, i = lane & 15, g = lane >> 4;
    GlaRegs cur; if (F.bid < NBATCH * 64 * 4) cur = gla_load(F, (size_t)(F.bid >> 2) * 64, F.bid & 3);
    f32x4 gw[4];
#pragma unroll
    for (int k = 0; k < 4; ++k) gw[k] = *(const f32x4*)(A->in[12] + ((wave >> 2) * 4 + k) * 16 + 4 * g);
    for (int it = F.bid; it < NBATCH * 64 * 4; it += F.G) {
        const int h = it & 3, bn = it >> 2, b = bn >> 6, n = bn & 63; const size_t prow = (size_t)b * SEQ + n * 64;
        GlaRegs nxt = cur; { const int itn = it + F.G; if (itn < NBATCH * 64 * 4) nxt = gla_load(F, (size_t)(itn >> 2) * 64, itn & 3); }
        v4u qw, kw; { const int t = tid >> 3, d0 = (tid & 7) * 8; qw = *(const v4u*)(((bf16*)(F.ws + WS_P)) + (prow + t) * PW + CQ + h * 64 + d0); kw = *(const v4u*)(((bf16*)(F.ws + WS_P)) + (prow + t) * PW + CK + h * 64 + d0); }
        gla_prep(F, A, cur, h); cur = nxt;
        bf16x8 sfr[4][2][2]; v2u rwv[4];
        { const int tt = wave & 3, vh = wave >> 2, t = tt * 16 + i;
#pragma unroll
          for (int k = 0; k < 4; ++k) { const int vt = vh * 4 + k;
#pragma unroll
              for (int dir = 0; dir < 2; ++dir) { const bf16* sp = ((bf16*)(F.ws + WS_S)) + ((((size_t)dir * NBATCH + b) * 64 + n) * 4 + h) * 8192 + (size_t)(vt * 16 + i) * 64 + 8 * g;
                  sfr[k][dir][0] = *(const bf16x8*)sp; sfr[k][dir][1] = *(const bf16x8*)(sp + 32); }
              rwv[k] = *(const v2u*)(((bf16*)(F.ws + WS_P)) + (prow + t) * PW + CR + h * 128 + vt * 16 + 4 * g); } }
        { const int t = tid >> 3, d0 = (tid & 7) * 8;
          const float q[8] = {bflo(qw.x), bfhi(qw.x), bflo(qw.y), bfhi(qw.y), bflo(qw.z), bfhi(qw.z), bflo(qw.w), bfhi(qw.w)};
          const float k[8] = {bflo(kw.x), bfhi(kw.x), bflo(kw.y), bfhi(kw.y), bflo(kw.z), bfhi(kw.z), bflo(kw.w), bfhi(kw.w)};
#pragma unroll
          for (int dir = 0; dir < 2; ++dir) { const LAS float* bp = (const LAS float*)(lds + GL_BC) + dir * 4096 + t * 64 + d0;
              const f32x4 b0 = *(const LAS f32x4*)bp, b1 = *(const LAS f32x4*)(bp + 4); const float bb[8] = {b0[0], b0[1], b0[2], b0[3], b1[0], b1[1], b1[2], b1[3]};
              float qd[8], ki[8];
#pragma unroll
              for (int j = 0; j < 8; ++j) { qd[j] = q[j] * __expf(bb[j]) * 0.125f; ki[j] = k[j] * __expf(-bb[j]); }
              v4u w; w.x = pk2(qd[0], qd[1]); w.y = pk2(qd[2], qd[3]); w.z = pk2(qd[4], qd[5]); w.w = pk2(qd[6], qd[7]);
              *(LAS v4u*)(lds + GL_A + ((dir * 64 + t) * 72 + d0) * 2) = w;
              w.x = pk2(ki[0], ki[1]); w.y = pk2(ki[2], ki[3]); w.z = pk2(ki[4], ki[5]); w.w = pk2(ki[6], ki[7]);
              *(LAS v4u*)(lds + GL_B + ((dir * 64 + t) * 72 + d0) * 2) = w; } }
        __syncthreads();
#pragma unroll
        for (int kk = 0; kk < 2; ++kk) { const int pi = wave * 2 + kk, tt = pi >> 2, st = pi & 3;
            f32x4 aF = {0.f, 0.f, 0.f, 0.f}, aB = {0.f, 0.f, 0.f, 0.f};
            if (st <= tt) {
#pragma unroll
                for (int ks = 0; ks < 2; ++ks) { const bf16x8 kf = *(const LAS bf16x8*)(lds + GL_B + ((st * 16 + i) * 72 + 32 * ks + 8 * g) * 2), qf = *(const LAS bf16x8*)(lds + GL_A + ((tt * 16 + i) * 72 + 32 * ks + 8 * g) * 2);
                    aF = __builtin_amdgcn_mfma_f32_16x16x32_bf16(kf, qf, aF, 0, 0, 0); } }
            if (st >= tt) {
#pragma unroll
                for (int ks = 0; ks < 2; ++ks) { const bf16x8 kf = *(const LAS bf16x8*)(lds + GL_B + ((64 + st * 16 + i) * 72 + 32 * ks + 8 * g) * 2), qf = *(const LAS bf16x8*)(lds + GL_A + ((64 + tt * 16 + i) * 72 + 32 * ks + 8 * g) * 2);
                    aB = __builtin_amdgcn_mfma_f32_16x16x32_bf16(kf, qf, aB, 0, 0, 0); } }
            const int t = tt * 16 + i, s0 = st * 16 + 4 * g; float p[4];
#pragma unroll
            for (int r = 0; r < 4; ++r) p[r] = ((s0 + r <= t) ? aF[r] : 0.f) + ((s0 + r >= t) ? aB[r] : 0.f);
            v2u w; w.x = pk2(p[0], p[1]); w.y = pk2(p[2], p[3]);
            *(LAS v2u*)(lds + GL_P + (t * 72 + s0) * 2) = w; }
        __syncthreads();
        { const int tt = wave & 3, vh = wave >> 2; const int t = tt * 16 + i;
          bf16x8 pf[2], qf[2][2];
#pragma unroll
          for (int ks = 0; ks < 2; ++ks) { pf[ks] = *(const LAS bf16x8*)(lds + GL_P + (t * 72 + 32 * ks + 8 * g) * 2);
              qf[0][ks] = *(const LAS bf16x8*)(lds + GL_A + (t * 72 + 32 * ks + 8 * g) * 2); qf[1][ks] = *(const LAS bf16x8*)(lds + GL_A + ((64 + t) * 72 + 32 * ks + 8 * g) * 2); }
          f32x4 acc[4]; float ss = 0.f;
#pragma unroll
          for (int k = 0; k < 4; ++k) { const int vt = vh * 4 + k; f32x4 a = {0.f, 0.f, 0.f, 0.f};
              { bf16x8 vf0, vf1; v_frag2(lds, vt * 16, lane, vf0, vf1); a = __builtin_amdgcn_mfma_f32_16x16x32_bf16(vf0, pf[0], a, 0, 0, 0); a = __builtin_amdgcn_mfma_f32_16x16x32_bf16(vf1, pf[1], a, 0, 0, 0); }
#pragma unroll
              for (int dir = 0; dir < 2; ++dir)
#pragma unroll
                  for (int ks = 0; ks < 2; ++ks) a = __builtin_amdgcn_mfma_f32_16x16x32_bf16(sfr[k][dir][ks], qf[dir][ks], a, 0, 0, 0);
              acc[k] = a; ss += (a[0] * a[0] + a[1] * a[1]) + (a[2] * a[2] + a[3] * a[3]); }
          ss += __shfl_xor(ss, 16); ss += __shfl_xor(ss, 32);
          if (g == 0) ((LAS float*)(lds + GL_SS))[vh * 64 + t] = ss;
          __syncthreads();
          const float tot = ((const LAS float*)(lds + GL_SS))[t] + ((const LAS float*)(lds + GL_SS))[64 + t];
          const float rstd = 1.0f / sqrtf(tot * (1.0f / 128.0f) + EPS);
#pragma unroll
          for (int k = 0; k < 4; ++k) { const int v = (vh * 4 + k) * 16 + 4 * g;
              const v2u rw = rwv[k];
              const float r[4] = {bflo(rw.x), bfhi(rw.x), bflo(rw.y), bfhi(rw.y)}; float y[4];
#pragma unroll
              for (int j = 0; j < 4; ++j) y[j] = acc[k][j] * rstd * gw[k][j] * (r[j] * __builtin_amdgcn_rcpf(1.0f + __expf(-r[j])));
              v2u w; w.x = pk2(y[0], y[1]); w.y = pk2(y[2], y[3]);
              *(v2u*)(((bf16*)(F.ws + WS_YMIX)) + (prow + t) * D + h * 128 + v) = w; } }
        __syncthreads();
    }
    for (int it = F.bid; it < NBATCH * 64; it += F.G) {
        const size_t prow = (size_t)it * 64;
#pragma unroll 1
        for (int rep = 0; rep < 8; ++rep) { const int idx = tid + rep * NTHREADS, t = idx >> 6, c0 = (idx & 63) * 8;
            float cv[8];
#pragma unroll
            for (int j = 0; j < 8; ++j) cv[j] = 0.f;
#pragma unroll
            for (int dt = -1; dt <= 1; ++dt) { const int tt = t + dt; if (tt >= 0 && tt < 64) {
                const v4u cw = *(const v4u*)(((bf16*)(F.ws + WS_P)) + (prow + tt) * PW + CPC + c0), xw = *(const v4u*)(((bf16*)(F.ws + WS_P)) + (prow + tt) * PW + CPX + c0);
                const f32x4 w0 = *(const f32x4*)(A->in[13] + (dt + 1) * 512 + c0), w1 = *(const f32x4*)(A->in[13] + (dt + 1) * 512 + c0 + 4);
                cv[0] += w0[0] * bflo(cw.x) * bflo(xw.x); cv[1] += w0[1] * bfhi(cw.x) * bfhi(xw.x); cv[2] += w0[2] * bflo(cw.y) * bflo(xw.y); cv[3] += w0[3] * bfhi(cw.y) * bfhi(xw.y);
                cv[4] += w1[0] * bflo(cw.z) * bflo(xw.z); cv[5] += w1[1] * bfhi(cw.z) * bfhi(xw.z); cv[6] += w1[2] * bflo(cw.w) * bflo(xw.w); cv[7] += w1[3] * bfhi(cw.w) * bfhi(xw.w); } }
            const v4u bw = *(const v4u*)(((bf16*)(F.ws + WS_P)) + (prow + t) * PW + CPB + c0);
            v4u w; w.x = pk2(cv[0] * bflo(bw.x), cv[1] * bfhi(bw.x)); w.y = pk2(cv[2] * bflo(bw.y), cv[3] * bfhi(bw.y)); w.z = pk2(cv[4] * bflo(bw.z), cv[5] * bfhi(bw.z)); w.w = pk2(cv[6] * bflo(bw.w), cv[7] * bfhi(bw.w));
            *(v4u*)(((bf16*)(F.ws + WS_YMIX)) + (prow + t) * D + 512 + c0) = w; }
    }
}

constexpr int RT_W = 0;
constexpr int RT_LG = 32 * 1032 * 2;
constexpr int RT_HIST = RT_LG + 128 * 33 * 4;
constexpr int RT_WC = RT_HIST + 256;
__device__ __forceinline__ void p5c_phase(const Frame& F, CArgs* A) {
    LAS unsigned char* lds = F.lds; const int tid = F.tid, lane = F.lane, wave = F.wave, i = lane & 15, g = lane >> 4;
#pragma unroll 1
    for (int i0 = 0; i0 < 32768; i0 += 16 * NTHREADS) { float rv[16];
#pragma unroll
        for (int q = 0; q < 16; ++q) rv[q] = A->in[16][i0 + q * NTHREADS + tid];
#pragma unroll
        for (int q = 0; q < 16; ++q) { const int idx = i0 + q * NTHREADS + tid, k = idx >> 5, e = idx & 31; *(LAS bf16*)(lds + RT_W + (e * 1032 + k) * 2) = (bf16)f2bf(rv[q]); } }
    LAS int* hist = (LAS int*)(lds + RT_HIST); LAS float* lg = (LAS float*)(lds + RT_LG);
    unsigned* gcnt = ((unsigned*)(F.ws + WS_CTL)) + CW_CNT;
    __syncthreads();
#pragma unroll 1
    for (int it = F.bid; it < NLAT / 128; it += F.G) {
        const int R = it * 128 + wave * 16 + i, b = it >> 5;
        const bf16* yg = ((const bf16*)(F.ws + WS_Y1)) + (size_t)R * D + 8 * g;
        unsigned char* hn2g = (unsigned char*)F.out + DO_HN2 + (size_t)R * D + 8 * g;
        const LAS unsigned char* rw0 = lds + RT_W + (i * 1032 + 8 * g) * 2; const LAS unsigned char* rw1 = rw0 + 16 * 1032 * 2;
        if (tid < 32) hist[tid] = 0;
        { const int c0 = 2 * tid; const f32x2 w_ = *(const f32x2*)(A->in[15] + c0), c_ = *(const f32x2*)(((float*)(F.ws + WS_MOD)) + (size_t)b * 6144 + 4096 + c0), s_ = *(const f32x2*)(((float*)(F.ws + WS_MOD)) + (size_t)b * 6144 + 3072 + c0);
          *(LAS f32x2*)(lds + RT_WC + c0 * 4) = w_ * (c_ + 1.0f); *(LAS f32x2*)(lds + RT_WC + 4096 + c0 * 4) = s_; }
        v4u yv[32];
#pragma unroll
        for (int ks = 0; ks < 32; ++ks) yv[ks] = *(const v4u*)(yg + 32 * ks);
        float ss = 0.f;
#pragma unroll
        for (int ks = 0; ks < 32; ++ks) { const v4u yw = yv[ks];
            const float h0 = bflo(yw.x), h1 = bfhi(yw.x), h2 = bflo(yw.y), h3 = bfhi(yw.y), h4 = bflo(yw.z), h5 = bfhi(yw.z), h6 = bflo(yw.w), h7 = bfhi(yw.w);
            ss += (h0 * h0 + h1 * h1) + (h2 * h2 + h3 * h3) + (h4 * h4 + h5 * h5) + (h6 * h6 + h7 * h7); }
        ss += __shfl_xor(ss, 16); ss += __shfl_xor(ss, 32);
        const float rstd = 1.0f / sqrtf(ss * (1.f / D) + EPS);
#pragma unroll
        for (int ks = 0; ks < 32; ++ks) asm volatile("" : "+v"(yv[ks]));
        LDS_BARRIER();
        f32x4 l0 = {0.f, 0.f, 0.f, 0.f}, l1 = {0.f, 0.f, 0.f, 0.f};
        const LAS unsigned char* wcg = lds + RT_WC + 32 * g;
#pragma unroll
        for (int ks = 0; ks < 32; ++ks) {
            const v4u yw = yv[ks];
            const f32x4 a0 = {bflo(yw.x), bfhi(yw.x), bflo(yw.y), bfhi(yw.y)}, a1 = {bflo(yw.z), bfhi(yw.z), bflo(yw.w), bfhi(yw.w)};
            const f32x4 c0 = *(const LAS f32x4*)(wcg + 128 * ks), c1 = *(const LAS f32x4*)(wcg + 128 * ks + 16), s0 = *(const LAS f32x4*)(wcg + 4096 + 128 * ks), s1 = *(const LAS f32x4*)(wcg + 4096 + 128 * ks + 16);
            const f32x4 y0 = (a0 * rstd) * c0 + s0, y1 = (a1 * rstd) * c1 + s1;
            v4u w; w.x = pk2(y0[0], y0[1]); w.y = pk2(y0[2], y0[3]); w.z = pk2(y1[0], y1[1]); w.w = pk2(y1[2], y1[3]);
            { v2u w8; w8.x = pk4_fp8(y0[0], y0[1], y0[2], y0[3]); w8.y = pk4_fp8(y1[0], y1[1], y1[2], y1[3]); *(v2u*)(hn2g + 32 * ks) = w8; }
            const bf16x8 af = __builtin_bit_cast(bf16x8, w);
            const bf16x8 r0 = *(const LAS bf16x8*)(rw0 + 64 * ks), r1 = *(const LAS bf16x8*)(rw1 + 64 * ks);
            l0 = __builtin_amdgcn_mfma_f32_16x16x32_bf16(af, r0, l0, 0, 0, 0); l1 = __builtin_amdgcn_mfma_f32_16x16x32_bf16(af, r1, l1, 0, 0, 0);
            asm volatile("" : "+v"(l0), "+v"(l1) :: "memory"); }
        { const float rb0 = A->in[17][i], rb1 = A->in[17][16 + i];
#pragma unroll
          for (int r = 0; r < 4; ++r) { lg[(wave * 16 + 4 * g + r) * 33 + i] = l0[r] + rb0; lg[(wave * 16 + 4 * g + r) * 33 + 16 + i] = l1[r] + rb1; } }
        __syncthreads();
        int te[4] = {0, 0, 0, 0}; float tv[4] = {-3.0e38f, -3.0e38f, -3.0e38f, -3.0e38f}; int lp[4] = {0, 0, 0, 0};
        if (lane < 16) { const LAS float* lr = lg + (wave * 16 + lane) * 33;
            for (int e = 0; e < 32; ++e) { const float x = lr[e];
                if (x > tv[3]) { if (x > tv[2]) { tv[3] = tv[2]; te[3] = te[2]; if (x > tv[1]) { tv[2] = tv[1]; te[2] = te[1]; if (x > tv[0]) { tv[1] = tv[0]; te[1] = te[0]; tv[0] = x; te[0] = e; } else { tv[1] = x; te[1] = e; } } else { tv[2] = x; te[2] = e; } } else { tv[3] = x; te[3] = e; } } }
            const float e1 = __expf(tv[1] - tv[0]), e2 = __expf(tv[2] - tv[0]), e3 = __expf(tv[3] - tv[0]), inv = 1.0f / (1.0f + e1 + e2 + e3);
            tv[0] = inv; tv[1] = e1 * inv; tv[2] = e2 * inv; tv[3] = e3 * inv;
#pragma unroll
            for (int k = 0; k < 4; ++k) lp[k] = __hip_atomic_fetch_add(&hist[te[k]], 1, __ATOMIC_RELAXED, __HIP_MEMORY_SCOPE_WORKGROUP); }
        __syncthreads();
        if (tid < 32) { const int c = hist[tid]; hist[32 + tid] = c ? (int)__hip_atomic_fetch_add(gcnt + tid, (unsigned)c, RLX_AGENT) : 0; }
        __syncthreads();
        if (lane < 16) { const int Rt = it * 128 + wave * 16 + lane;
#pragma unroll
            for (int k = 0; k < 4; ++k) { const size_t pos = (size_t)te[k] * LISTCAP + hist[32 + te[k]] + lp[k]; ((int*)((unsigned char*)F.out + DO_LAID))[pos] = Rt * 4 + k;
                ((int*)(F.ws + WS_TSLOT))[Rt * 4 + k] = (te[k] << 20) | (hist[32 + te[k]] + lp[k]); ((float*)(F.ws + WS_TW))[Rt * 4 + k] = tv[k]; } }
        __syncthreads();
    }
}

constexpr int P8NR = 1;
struct P8Slots { int ep[P8NR][4]; float wk[P8NR][4]; };
struct P8Rows { int yw8[P8NR][4][4]; v2u hw[P8NR][4]; float wk[P8NR][4]; f32x4 g2v[4]; };
__device__ __forceinline__ int p8_row(int gw, int NGW, int k, int a) { const int r = P8NR * (gw + k * NGW) + a; return r < NLAT ? r : P8NR * gw + a; }
__device__ __forceinline__ void p8_slots(const Frame& F, int gw, int NGW, int k, P8Slots& S) {
#pragma unroll
    for (int a = 0; a < P8NR; ++a) { const int r = p8_row(gw, NGW, k, a);
#pragma unroll
        for (int q = 0; q < 4; ++q) { S.ep[a][q] = ((const int*)(F.ws + WS_TSLOT))[r * 4 + q]; S.wk[a][q] = ((const float*)(F.ws + WS_TW))[r * 4 + q]; } }
}
__device__ __forceinline__ void p8_rows(const Frame& F, const LAS int* TS, int lane, int gw, int NGW, int k, const P8Slots& S, P8Rows& R) {
#pragma unroll
    for (int a = 0; a < P8NR; ++a) { const int r = p8_row(gw, NGW, k, a); const bf16* yr = ((const bf16*)(F.ws + WS_Y1)) + (size_t)r * D;
#pragma unroll
        for (int q = 0; q < 4; ++q) { const int* ys = (const int*)((const unsigned char*)(F.ws + WS_YA) + ((size_t)TS[S.ep[a][q] >> 20] * 256 + (S.ep[a][q] & 0xFFFFF)) * D); R.wk[a][q] = S.wk[a][q];
#pragma unroll
            for (int j = 0; j < 4; ++j) R.yw8[a][q][j] = ys[lane + 64 * j]; }
#pragma unroll
        for (int j = 0; j < 4; ++j) R.hw[a][j] = ((const v2u*)yr)[lane + 64 * j]; }
    { const float* g2 = ((float*)(F.ws + WS_MOD)) + (size_t)(p8_row(gw, NGW, k, 0) >> 12) * 6144 + 5120;
#pragma unroll
      for (int j = 0; j < 4; ++j) R.g2v[j] = ((const f32x4*)g2)[lane + 64 * j]; }
}
__device__ __forceinline__ void p8_pin(P8Rows& R) {
    asm volatile("" ::: "memory");
#pragma unroll
    for (int a = 0; a < P8NR; ++a) {
#pragma unroll
        for (int q = 0; q < 4; ++q) { asm volatile("" : "+v"(R.wk[a][q]));
#pragma unroll
            for (int j = 0; j < 4; ++j) asm volatile("" : "+v"(R.yw8[a][q][j])); }
#pragma unroll
        for (int j = 0; j < 4; ++j) asm volatile("" : "+v"(R.hw[a][j])); }
#pragma unroll
    for (int j = 0; j < 4; ++j) asm volatile("" : "+v"(R.g2v[j]));
}
__device__ __forceinline__ void p8_emit(const Frame& F, const f32x4 (&fw)[4], int lane, int gw, int NGW, int k, const P8Rows& R) {
#pragma unroll
    for (int a = 0; a < P8NR; ++a) { const int r = p8_row(gw, NGW, k, a); float* hr = F.out + (size_t)r * D;
        f32x4 v[4]; float s = 0.f;
#pragma unroll
        for (int j = 0; j < 4; ++j) { const int c4 = lane + 64 * j; f32x4 y = {0.f, 0.f, 0.f, 0.f};
#pragma unroll
            for (int q = 0; q < 4; ++q) { const int w = R.yw8[a][q][j]; const f32x2 lo = __builtin_amdgcn_cvt_pk_f32_fp8(w, false), hi = __builtin_amdgcn_cvt_pk_f32_fp8(w, true);
                y[0] += R.wk[a][q] * lo[0]; y[1] += R.wk[a][q] * lo[1]; y[2] += R.wk[a][q] * hi[0]; y[3] += R.wk[a][q] * hi[1]; }
            const v2u yw = R.hw[a][j]; const f32x4 y1 = {bflo(yw.x), bfhi(yw.x), bflo(yw.y), bfhi(yw.y)};
            v[j] = y1 + R.g2v[j] * y;
            s += (v[j].x * v[j].x + v[j].y * v[j].y) + (v[j].z * v[j].z + v[j].w * v[j].w); }
        const float rstd = 1.0f / sqrtf(wave_sum(s) * (1.f / D) + EPS);
#pragma unroll
        for (int j = 0; j < 4; ++j) { const int c4 = lane + 64 * j; ((f32x4*)hr)[c4] = (v[j] * rstd) * fw[j]; } }
}
__device__ __forceinline__ void p8_phase(const Frame& F, CArgs* A, const LAS int* TS) {
    int tid_ = threadIdx.x; asm volatile("" : "+v"(tid_));
    const int lane = tid_ & 63;
    const int gw = F.bid * NWAVES + F.wave, NGW = F.G * NWAVES;
    if (P8NR * gw >= NLAT) return;
    const int K = (NLAT / P8NR - gw + NGW - 1) / NGW;
    f32x4 fw[4];
#pragma unroll
    for (int j = 0; j < 4; ++j) fw[j] = ((const f32x4*)A->in[22])[lane + 64 * j];
    P8Slots Sa, Sb; P8Rows Ra, Rb;
    p8_slots(F, gw, NGW, 0, Sa); p8_rows(F, TS, lane, gw, NGW, 0, Sa, Ra); p8_slots(F, gw, NGW, 1, Sb);
#pragma unroll 1
    for (int k = 0; k < K; k += 2) {
        int l_ = threadIdx.x; asm volatile("" : "+v"(l_)); l_ &= 63;
        p8_slots(F, gw, NGW, k + 2, Sa); p8_rows(F, TS, l_, gw, NGW, k + 1, Sb, Rb); p8_pin(Ra);
        p8_emit(F, fw, l_, gw, NGW, k, Ra);
        p8_slots(F, gw, NGW, k + 3, Sb); p8_rows(F, TS, l_, gw, NGW, k + 2, Sa, Ra); p8_pin(Rb);
        p8_emit(F, fw, l_, gw, NGW, k + 1, Rb);
    }
}

constexpr int NPHASES = 11;
__global__ void __launch_bounds__(NTHREADS, 2) fwd_kernel(Args args) {
    extern __shared__ __attribute__((aligned(16))) unsigned char lds_raw[];
    Frame F;
    F.lds = (LAS unsigned char*)lds_raw;
    F.tid = threadIdx.x; F.lane = F.tid & 63; F.wave = __builtin_amdgcn_readfirstlane(F.tid >> 6); F.G = gridDim.x; F.bid = blockIdx.x;
    F.out = args.out; F.ws = args.ws;
        for (int u = F.tid; u < (LDS_BYTES - MISC_OFF) / 4; u += NTHREADS) ((LAS unsigned*)(F.lds + MISC_OFF))[u] = 0u;
    __syncthreads();
    volatile LAS unsigned* MISC = (volatile LAS unsigned*)(F.lds + MISC_OFF);
    LAS int* TS = (LAS int*)(F.lds + MISC_OFF + 256);
    const int lo = args.ph_lo, hi = args.ph_hi;
    const bool multi = (hi - lo) > 1;
    XcdBarrier bar; bar.bar = (unsigned*)((unsigned*)(F.ws + WS_CTL)) + CW_BAR; bar.x = 0; bar.st = nullptr;
    if (multi) bar = xcd_barrier_post((unsigned*)((unsigned*)(F.ws + WS_CTL)) + CW_BAR, MISC + 8);
#ifndef PHMASK
#define PHMASK 0x7ff
#endif
#define IN(k) (((PHMASK >> (k)) & 1) && lo <= (k) && (k) < hi)
#define BUILD_TS() do { if (F.tid < NEXP) TS[33 + F.tid] = (int)__hip_atomic_load(((unsigned*)(F.ws + WS_CTL)) + CW_CNT + F.tid, RLX_AGENT);     \
        __syncthreads(); \
        if (F.tid == 0) { int acc_ = 0; for (int e = 0; e < NEXP; ++e) { TS[e] = acc_; acc_ += (TS[33 + e] + 255) >> 8; } TS[32] = acc_; } __syncthreads(); \
        for (int t_ = F.tid; t_ < TS[32]; t_ += NTHREADS) { int e_ = 0; for (int k_ = 1; k_ < NEXP; ++k_) e_ = (TS[k_] <= t_) ? k_ : e_; ((LAS unsigned char*)(TS + 72))[t_] = (unsigned char)e_; } \
        __syncthreads(); } while (0)
#define SEAM(k) do { if (IN(k) && IN((k) + 1)) xcd_barrier(bar); } while (0)
#ifndef PROBE_DUP
#define PROBE_DUP 0
#endif
#define REPS(k) for (int rep_ = 0; rep_ < (((PROBE_DUP >> (k)) & 1) ? 2 : 1); ++rep_)

    if (IN(0)) REPS(0) { p0_phase(F, opaque_args()); } SEAM(0);
    if (IN(1)) REPS(1) { p1_phase(F, opaque_args()); } SEAM(1);
    if (IN(2)) REPS(2) { DenseSched S; S.init(NROWS, PWP, F.G, F.bid, ((bf16*)(F.ws + WS_WIN))); S.build((LAS int*)(TS + 400), F.tid); EpiProj E{((bf16*)(F.ws + WS_P))};
        pg8::gemm_phase<EpiProj, DenseSched, true, false>(F.lds, (const char*)((bf16*)(F.ws + WS_HN)), S, E);
#ifdef PROBE_INNULL
        { EpiNull E0; pg8::gemm_phase<EpiNull, DenseSched, true, false>(F.lds, (const char*)((bf16*)(F.ws + WS_HN)), S, E0); }
#endif
    } SEAM(2);
    if (IN(3)) { p3v3_phase<0>(F, opaque_args());
#ifdef PROBE_P3
        p3v3_phase<PROBE_P3>(F, opaque_args());
#endif
    } SEAM(3);
    if (IN(4)) REPS(4) { p4_phase(F, opaque_args()); } SEAM(4);
    if (IN(5)) {
#ifdef PROBE_P5
        p5a_phase(F, opaque_args()); p5av3_phase<PROBE_P5>(F, opaque_args());
#else
        p5av3_phase<0>(F, opaque_args());
#endif
    } SEAM(5);
    if (IN(6)) REPS(6) { DenseSched S; S.init(NLAT, D, F.G, F.bid, ((bf16*)(F.ws + WS_WOUT))); S.kb = OUTPROJ_F8 ? 1024 : 2048; S.build((LAS int*)(TS + 400), F.tid); EpiOut E{opaque_args()->in[0], ((float*)(F.ws + WS_MOD)), ((bf16*)(F.ws + WS_Y1)), OUTPROJ_F8 ? 1.0f / WSCALE : 1.0f};
        pg8::gemm_phase<EpiOut, DenseSched, true, OUTPROJ_F8 != 0>(F.lds, (const char*)((bf16*)(F.ws + WS_YMIX)), S, E); } SEAM(6);
    if (IN(7)) { p5c_phase(F, opaque_args()); } SEAM(7);
#pragma unroll 1
    for (int ph = 8; ph < 10; ++ph) {
        if (IN(ph)) {
            const bool gu = (ph == 8);
            BUILD_TS();
            const int ntr = TS[32];
            REPS(ph) {
                if (gu) { MoeSched<true> S; S.TS = TS; S.ntr = ntr; S.G = F.G; S.c = F.bid; S.laid = ((int*)((unsigned char*)F.out + DO_LAID)); S.W = (const char*)F.out + DO_WGU;
                    EpiGU E{(unsigned char*)(F.ws + WS_ACT), opaque_args()->in[19]}; pg8::gemm_phase<EpiGU, MoeSched<true>, true, true>(F.lds, (const char*)((unsigned char*)F.out + DO_HN2), S, E);
#ifdef PROBE_GUNULL
                    { EpiNull E0; pg8::gemm_phase<EpiNull, MoeSched<true>, true, true>(F.lds, (const char*)((unsigned char*)F.out + DO_HN2), S, E0); }
#endif
                }
                else { MoeSched<false> S; S.TS = TS; S.ntr = ntr; S.G = F.G; S.c = F.bid; S.laid = nullptr; S.W = (const char*)F.out + DO_WDN;
                    EpiDN E{(unsigned char*)(F.ws + WS_YA), opaque_args()->in[21], TS}; pg8::gemm_phase<EpiDN, MoeSched<false>, true, true>(F.lds, (const char*)(F.ws + WS_ACT), S, E); }
            }
        }
        SEAM(ph);
    }
    if (IN(10)) { BUILD_TS(); p8_phase(F, opaque_args(), TS); }
#undef IN
#undef SEAM
}

extern "C" void kernel_launch(void* const* d_in, const int* in_sizes, int n_in, void* d_out, int out_size, void* d_ws, size_t ws_size, hipStream_t stream) {
    static int grid = 0;
    if (grid == 0) {
        if (n_in != 23 || in_sizes[0] != NLAT * D || out_size != NLAT * D || ws_size < WS_TOTAL) {
            fprintf(stderr, "kernel_launch: unexpected shapes: n_in %d, in0 %d, out %d, ws %zu (need %zu); nothing launched\n", n_in, n_in > 0 ? in_sizes[0] : -1, out_size, ws_size, (size_t)WS_TOTAL); grid = -1; return; }
        int dev = 0, cus = 0, per_cu = 0;
        if (hipGetDevice(&dev) != hipSuccess || hipDeviceGetAttribute(&cus, hipDeviceAttributeMultiprocessorCount, dev) != hipSuccess) { fprintf(stderr, "kernel_launch: device query failed\n"); grid = -1; return; }
        if (hipFuncSetAttribute((const void*)fwd_kernel, hipFuncAttributeMaxDynamicSharedMemorySize, LDS_BYTES) != hipSuccess) { fprintf(stderr, "kernel_launch: hipFuncSetAttribute failed\n"); grid = -1; return; }
        if (hipOccupancyMaxActiveBlocksPerMultiprocessor(&per_cu, (const void*)fwd_kernel, NTHREADS, LDS_BYTES) != hipSuccess || per_cu < 1) {
            fprintf(stderr, "kernel_launch: occupancy query reports %d workgroups per CU; nothing launched\n", per_cu); (void)hipGetLastError(); grid = -1; return; }
        grid = cus;
        if (grid > 256) grid = 256;
    }
    if (grid < 0) return;
    if (hipMemsetAsync((char*)d_ws + WS_CTL, 0, CTL_ZERO_BYTES, stream) != hipSuccess) { fprintf(stderr, "kernel_launch: hipMemsetAsync failed\n"); return; }
    Args a{};
    for (int i = 0; i < 23; ++i) a.in[i] = (const float*)d_in[i];
    a.out = (float*)d_out; a.ws = (unsigned char*)d_ws;
#if MK_N_LAUNCHES == 1
    a.ph_lo = 0; a.ph_hi = NPHASES;
    hipLaunchKernelGGL(fwd_kernel, dim3(grid), dim3(NTHREADS), LDS_BYTES, stream, a);
#else
    for (int p = 0; p < NPHASES; ++p) { a.ph_lo = p; a.ph_hi = p + 1; hipLaunchKernelGGL(fwd_kernel, dim3(grid), dim3(NTHREADS), LDS_BYTES, stream, a); }
#endif
    const hipError_t le = hipPeekAtLastError();
    if (le != hipSuccess) fprintf(stderr, "kernel_launch: launch failed: %s\n", hipGetErrorName(le));
}
```

```cpp
#define NOTOUCH5 1
#define NOTOUCH3 1
#include <hip/hip_runtime.h>
#include <cstdio>
#include <cstdint>

#ifndef MK_N_LAUNCHES
#define MK_N_LAUNCHES 1
#endif

#define GAS __attribute__((address_space(1)))
#define LAS __attribute__((address_space(3)))
typedef unsigned short bf16;
typedef unsigned v4u __attribute__((ext_vector_type(4)));
typedef unsigned v2u __attribute__((ext_vector_type(2)));
typedef float f32x4 __attribute__((ext_vector_type(4)));
typedef float f32x2 __attribute__((ext_vector_type(2)));
typedef short bf16x8 __attribute__((ext_vector_type(8)));
typedef short s16x4 __attribute__((ext_vector_type(4)));
#define RLX_AGENT __ATOMIC_RELAXED, __HIP_MEMORY_SCOPE_AGENT
#define LDS_WAIT() asm volatile("s_waitcnt lgkmcnt(0)" ::: "memory")
#define VM_WAIT() asm volatile("s_waitcnt vmcnt(0)" ::: "memory")
#define LDS_BARRIER() do { asm volatile("s_waitcnt lgkmcnt(0)" ::: "memory"); __builtin_amdgcn_s_barrier(); asm volatile("" ::: "memory"); } while (0)

typedef __bf16 bf16x2_t __attribute__((ext_vector_type(2)));
__device__ __forceinline__ unsigned pk2(float lo, float hi) { const f32x2 v = {lo, hi}; return __builtin_bit_cast(unsigned, __builtin_convertvector(v, bf16x2_t)); }
__device__ __forceinline__ unsigned f2bf(float f) { return (unsigned)__builtin_bit_cast(unsigned short, (__bf16)f); }
__device__ __forceinline__ unsigned pk4_fp8(float a, float b, float c, float d) { int w = __builtin_amdgcn_cvt_pk_fp8_f32(a, b, 0, false); w = __builtin_amdgcn_cvt_pk_fp8_f32(c, d, w, true); return (unsigned)w; }
__device__ __forceinline__ float bflo(unsigned w) { return __builtin_bit_cast(float, w << 16); }
__device__ __forceinline__ float bfhi(unsigned w) { return __builtin_bit_cast(float, w & 0xffff0000u); }
__device__ __forceinline__ float bf2f(bf16 b) { return __builtin_bit_cast(float, ((unsigned)b) << 16); }
__device__ __forceinline__ float fexp(float x) { return __builtin_amdgcn_exp2f(x * 1.4426950408889634f); }
__device__ __forceinline__ float wave_sum(float v) {
#pragma unroll
    for (int o = 1; o < 64; o <<= 1) v += __shfl_xor(v, o);
    return v;
}

constexpr int D = 1024, NBATCH = 16, SEQ = 4096, CTXL = 256;
constexpr int NLAT = NBATCH * SEQ;
constexpr int NCTXR = NBATCH * CTXL;
constexpr int NROWS = NLAT + NCTXR;
constexpr int PW = 3104, PWP = 3328;
constexpr int CQ = 0, CK = 256, CV = 512, CR = 1024, CAF = 1536, CAB = 1552, CPB = 1568, CPC = 2080, CPX = 2592;
constexpr int NCC = 68;
constexpr int NEXP = 32, DFF = 1024;
constexpr float EPS = 1e-6f;
constexpr int LISTCAP = 65536;
constexpr float WSCALE = 32.0f, WSCALE_INV = 1.0f / 32.0f;

#ifndef OUTPROJ_F8
#define OUTPROJ_F8 1
#endif
constexpr size_t MiB = 1u << 20;
constexpr size_t WS_CTL = 0, CTL_ZERO_BYTES = 32768;
constexpr size_t WS_MOD = 1 * MiB;
constexpr size_t WS_DECAY = 2 * MiB;
constexpr size_t WS_WIN = 6 * MiB;
constexpr size_t WS_WOUT = 13 * MiB;
constexpr size_t WS_HN = 16 * MiB;
constexpr size_t WS_KV = 16 * MiB;
constexpr size_t WS_P = 152 * MiB;
constexpr size_t WS_S = 565 * MiB;
constexpr size_t WS_YMIX = 693 * MiB;
constexpr size_t WS_Y1 = 821 * MiB;
constexpr size_t WS_ACT = 16 * MiB;
constexpr size_t WS_YA = 280 * MiB;
constexpr size_t WS_VT = 949 * MiB;
constexpr size_t WS_END = 1013 * MiB;
constexpr size_t WS_TSLOT = 1013 * MiB;
constexpr size_t WS_TW = 1015 * MiB;
constexpr size_t WS_TOTAL = 1017 * MiB;
constexpr size_t DO_WDN = 0;
constexpr size_t DO_WGU = 32 * MiB;
constexpr size_t DO_HN2 = 96 * MiB;
constexpr size_t DO_LAID = 160 * MiB;
constexpr size_t DO_LW = 168 * MiB;
static_assert(WS_P + (size_t)NROWS * PW * 2 <= WS_S && WS_YMIX + (size_t)NLAT * D * 2 <= WS_Y1 && WS_YA + (size_t)1056 * 256 * D <= WS_Y1 && WS_Y1 + (size_t)NLAT * D * 2 <= WS_VT && WS_VT + (size_t)NLAT * 512 * 2 <= WS_END, "ws map");
static_assert(WS_HN + (size_t)NROWS * D * 2 <= WS_P && WS_ACT + (size_t)1056 * 256 * 1024 <= WS_YA && DO_LW + (size_t)NEXP * LISTCAP * 4 <= (size_t)NLAT * D * 4, "ws map 2");
constexpr int CW_CNT = 64;
constexpr int CW_BAR = 4096;

constexpr int RING_BYTES = 131072;
constexpr int MISC_OFF = RING_BYTES;
constexpr int LDS_BYTES = 147456;
constexpr int NWAVES = 8, NTHREADS = 512;

namespace pg8 {
constexpr int BM = 256, BK = 64, HALF = 128, HTB = HALF * BK * 2, STAGE_BYTES = 8 * HTB;
constexpr int BIAS_OFF = 131072 + 8192;
__host__ __device__ __forceinline__ int lds_byte(int r, int c) { const int st = (r >> 4) * 2 + (c >> 5), rr = r & 15, cc = c & 31, ob = rr * 64 + cc * 2; return st * 1024 + (ob ^ (((ob >> 9) & 1) << 5)); }
__host__ __device__ __forceinline__ void stage_rc(int b, int& R, int& C) { const int st = b / 1024, sb = b % 1024, swz = sb ^ (((sb >> 9) & 1) << 5); R = (st >> 1) * 16 + swz / 64; C = (st & 1) * 32 + (swz % 64) / 2; }
__host__ __device__ __forceinline__ int perm32(int rho) { const int n = rho >> 4, i = rho & 15; return 8 * (i >> 2) + 4 * n + (i & 3); }

typedef int v8i __attribute__((ext_vector_type(8)));
typedef int v4i __attribute__((ext_vector_type(4)));
__device__ __forceinline__ v8i cat8(bf16x8 lo, bf16x8 hi) { return __builtin_shufflevector(__builtin_bit_cast(v4i, lo), __builtin_bit_cast(v4i, hi), 0, 1, 2, 3, 4, 5, 6, 7); }
struct Unit { int pm, pn, e, lt; };
__device__ __forceinline__ unsigned cvt_pk_bf16(float lo, float hi) { unsigned r; asm volatile("v_cvt_pk_bf16_f32 %0, %1, %2" : "=v"(r) : "v"(lo), "v"(hi)); return r; }

template <class Epi, class Sched, bool ALIGN_EPI, bool F8>
__device__ __forceinline__ void gemm_phase(LAS unsigned char* lds, const char* Abase, const Sched& S, const Epi& E) {
    int tid_ = threadIdx.x; asm volatile("" : "+v"(tid_));
    const int tid = tid_, wid = __builtin_amdgcn_readfirstlane(tid >> 6), lane = tid & 63, wr = wid >> 2, wc = wid & 3, fr = lane & 15, fq = lane >> 4;
    constexpr int KB = F8 ? 1024 : 2048, NT = KB / 128;
    unsigned voffB[2];
#pragma unroll
    for (int i = 0; i < 2; ++i) { int R, C; stage_rc(tid * 16 + i * 8192, R, C); const int Rb = Epi::PERM ? ((R & ~31) + perm32(R & 31)) : R; voffB[i] = (unsigned)(Rb * KB + C * 2); }
#define PG8_AROWS(u_, dst_) do { _Pragma("unroll") for (int h_ = 0; h_ < 2; ++h_) _Pragma("unroll") for (int i_ = 0; i_ < 2; ++i_) { int R_, C_; stage_rc(tid * 16 + i_ * 8192, R_, C_); \
        dst_[h_][i_] = (unsigned)S.arow(u_, h_ * HALF + R_); } } while (0)
#define PG8_AOFF2(dst_) do { _Pragma("unroll") for (int h_ = 0; h_ < 2; ++h_) _Pragma("unroll") for (int i_ = 0; i_ < 2; ++i_) { int R_, C_; stage_rc(tid * 16 + i_ * 8192, R_, C_); \
        dst_[h_][i_] = dst_[h_][i_] * (unsigned)KB + (unsigned)C_ * 2u; } } while (0)
    const size_t kstep = (size_t)(BK * 2);
    const size_t hstep = (size_t)HALF * KB;
    const unsigned ldsw = (unsigned)wid * 1024u;
    const int aoff = lds_byte(wr * 64 + fr, fq * 8), boff = lds_byte(wc * 32 + fr, fq * 8);
#define PG8_SA(b, h) (((b) * 2 + (h)) * HTB)
#define PG8_SB(b, h) ((4 + (b) * 2 + (h)) * HTB)
#define PG8_STAGE(bufoff, gbase, voff) do { _Pragma("unroll") for (int _i = 0; _i < 2; ++_i) \
        __builtin_amdgcn_global_load_lds((const unsigned*)((const char*)(gbase) + (voff)[_i]), (LAS unsigned*)(lds + (bufoff) + ldsw + _i * 8192), 16, 0, 0); } while (0)
#define PG8_LDA(dst, b, h) do { _Pragma("unroll") for (int m = 0; m < 4; ++m) _Pragma("unroll") for (int k = 0; k < 2; ++k) dst[m][k] = *(const LAS bf16x8*)(lds + PG8_SA(b, h) + aoff + m * 2048 + k * 1024); } while (0)
#define PG8_LDB(dst, b, h) do { _Pragma("unroll") for (int n = 0; n < 2; ++n) _Pragma("unroll") for (int k = 0; k < 2; ++k) dst[n][k] = *(const LAS bf16x8*)(lds + PG8_SB(b, h) + boff + n * 2048 + k * 1024); } while (0)
#define PG8_MMA(ai, bj, At, Bt) do { if (skipmma && ((bj) == 1 || wc > 0)) break; __builtin_amdgcn_s_setprio(1); _Pragma("unroll") for (int m = 0; m < 4; ++m) _Pragma("unroll") for (int n = 0; n < 2; ++n) { \
        if constexpr (F8) { asm volatile("v_mfma_f32_16x16x128_f8f6f4 %0, %1, %2, %0" : "+v"(acc[ai][bj][m][n]) : "v"(cat8(Bt[n][0], Bt[n][1])), "v"(cat8(At[m][0], At[m][1]))); } \
        else { _Pragma("unroll") for (int k = 0; k < 2; ++k) acc[ai][bj][m][n] = __builtin_amdgcn_mfma_f32_16x16x32_bf16(Bt[n][k], At[m][k], acc[ai][bj][m][n], 0, 0, 0); } } \
        __builtin_amdgcn_s_setprio(0); } while (0)
#define PG8_WAIT_V(n) asm volatile("s_waitcnt vmcnt(" #n ")" ::: "memory")
#define PG8_WAIT_L(n) asm volatile("s_waitcnt lgkmcnt(" #n ")" ::: "memory")
#define PG8_BAR __builtin_amdgcn_s_barrier()
#define PG8_SCHED __builtin_amdgcn_sched_barrier(0)
    Unit cur, nxt; int ui = 0;
    if (!S.next(0, cur)) return;
    f32x4 acc[2][2][4][2];
#pragma unroll
    for (int a = 0; a < 2; ++a)
#pragma unroll
        for (int b = 0; b < 2; ++b)
#pragma unroll
            for (int m = 0; m < 4; ++m)
#pragma unroll
                for (int n = 0; n < 2; ++n) acc[a][b][m][n] = (f32x4){0.f, 0.f, 0.f, 0.f};
    bf16x8 At[4][2], B0[2][2], B1[2][2];
    unsigned oC[2][2];
    PG8_AROWS(cur, oC); PG8_AOFF2(oC);
    unsigned rN[2] = {0u, 0u};
    const char* cB = S.bptr(cur);
    PG8_STAGE(PG8_SB(0, 0), cB, voffB); PG8_STAGE(PG8_SB(0, 1), cB + hstep, voffB); PG8_STAGE(PG8_SA(0, 0), Abase, oC[0]); PG8_STAGE(PG8_SA(0, 1), Abase, oC[1]);
    if (wr == 1) PG8_BAR;
    PG8_WAIT_V(2); PG8_BAR;
    PG8_STAGE(PG8_SB(1, 0), cB + kstep, voffB); PG8_STAGE(PG8_SA(1, 0), Abase + kstep, oC[0]); PG8_STAGE(PG8_SB(1, 1), cB + hstep + kstep, voffB);
    PG8_WAIT_V(6); PG8_BAR;
    for (;;) {
        const bool skipmma = S.mostly_padding(cur);
        const bool has_next = S.next(ui + 1, nxt);
        if (!has_next) nxt = cur;
        if constexpr (Epi::LBIAS) { if (wid == 0) __builtin_amdgcn_global_load_lds((const unsigned*)(E.bias_src(cur) + lane * 16), (LAS unsigned*)(lds + BIAS_OFF + (ui & 1) * 1024), 16, 0, 0); }
        const char* nB = S.bptr(nxt);
        for (int t = 0; t < NT; t += 2) {
            const bool last = (t == NT - 2);
            const char* ka1 = Abase + (size_t)(t + 1) * kstep;
            const char* ka2 = last ? Abase : Abase + (size_t)(t + 2) * kstep; const char* b2 = last ? nB : cB + (size_t)(t + 2) * kstep;
            const char* ka3 = ka2 + kstep; const char* b3 = b2 + kstep;
            PG8_LDB(B0, 0, 0); PG8_LDB(B1, 0, 1); PG8_SCHED; PG8_LDA(At, 0, 0); PG8_STAGE(PG8_SA(1, 1), ka1, oC[1]);
            PG8_WAIT_V(8); PG8_WAIT_L(0); PG8_BAR; PG8_MMA(0, 0, At, B0); PG8_MMA(0, 1, At, B1); PG8_BAR; PG8_SCHED;
            if constexpr (Sched::GATHER) { if (t == NT - 4) { unsigned r4[2][2]; PG8_AROWS(nxt, r4); rN[0] = r4[0][0] | (r4[0][1] << 16); rN[1] = r4[1][0] | (r4[1][1] << 16); } }
            if (last) {
                if constexpr (Sched::GATHER) { oC[0][0] = rN[0] & 0xffffu; oC[0][1] = rN[0] >> 16; oC[1][0] = rN[1] & 0xffffu; oC[1][1] = rN[1] >> 16; }
                else { PG8_AROWS(nxt, oC); }
                PG8_AOFF2(oC); }
            PG8_LDA(At, 0, 1); PG8_STAGE(PG8_SB(0, 0), b2, voffB); PG8_STAGE(PG8_SB(0, 1), b2 + hstep, voffB); PG8_STAGE(PG8_SA(0, 0), ka2, oC[0]);
            PG8_WAIT_V(8); PG8_WAIT_L(0); PG8_BAR; PG8_MMA(1, 0, At, B0); PG8_MMA(1, 1, At, B1); PG8_BAR; PG8_SCHED;
            PG8_LDB(B0, 1, 0); PG8_LDB(B1, 1, 1); PG8_SCHED; PG8_LDA(At, 1, 0); PG8_STAGE(PG8_SA(0, 1), ka2, oC[1]);
            PG8_WAIT_V(8); PG8_WAIT_L(0); PG8_BAR; PG8_MMA(0, 0, At, B0); PG8_MMA(0, 1, At, B1); PG8_BAR; PG8_SCHED;
            PG8_LDA(At, 1, 1); PG8_STAGE(PG8_SB(1, 0), b3, voffB); PG8_STAGE(PG8_SB(1, 1), b3 + hstep, voffB); PG8_STAGE(PG8_SA(1, 0), ka3, oC[0]);
            PG8_WAIT_V(8); PG8_WAIT_L(0); PG8_BAR; PG8_MMA(1, 0, At, B0); PG8_MMA(1, 1, At, B1); PG8_BAR; PG8_SCHED;
        }
        if constexpr (ALIGN_EPI) { if (wr == 0) PG8_BAR; }
        if constexpr (F8) asm volatile("s_nop 15\n\ts_nop 7" ::: "memory");
        { int fr_o = fr, fq_o = fq; asm volatile("" : "+v"(fr_o), "+v"(fq_o));
          E(acc, cur, wr, wc, fr_o, fq_o, (const LAS float*)(lds + BIAS_OFF + (ui & 1) * 1024)); }
        if (!has_next) break;
#pragma unroll
        for (int a = 0; a < 2; ++a)
#pragma unroll
            for (int b = 0; b < 2; ++b)
#pragma unroll
                for (int m = 0; m < 4; ++m)
#pragma unroll
                    for (int n = 0; n < 2; ++n) acc[a][b][m][n] = (f32x4){0.f, 0.f, 0.f, 0.f};
        cur = nxt; cB = nB; ++ui;
        if constexpr (ALIGN_EPI) { if (wr == 1) PG8_BAR; }
    }
    PG8_WAIT_V(0);
    if constexpr (!ALIGN_EPI) { if (wr == 0) PG8_BAR; }
    PG8_BAR;
#undef PG8_AROWS
#undef PG8_AOFF2
#undef PG8_SA
#undef PG8_SB
#undef PG8_STAGE
#undef PG8_LDA
#undef PG8_LDB
#undef PG8_MMA
#undef PG8_WAIT_V
#undef PG8_WAIT_L
#undef PG8_BAR
#undef PG8_SCHED
}
}

#define XB_TMO      128
#define XB_XCNT(j)  (256  + 64 * (j))
#define XB_XSUB(j)  (1280 + 64 * (j))
#define XB_XGEN(j)  (2304 + 64 * (j))
#define XB_TOP      3328
#define XB_TOPGEN   3392
#define XCD_BAR_WORDS 3456
#define XB_SPIN_CAP (1u << 22)
__device__ __forceinline__ unsigned xb_ld(unsigned* p)              { return __hip_atomic_load(p, __ATOMIC_RELAXED, __HIP_MEMORY_SCOPE_AGENT); }
__device__ __forceinline__ unsigned xb_add(unsigned* p, unsigned v) { return __hip_atomic_fetch_add(p, v, __ATOMIC_RELAXED, __HIP_MEMORY_SCOPE_AGENT); }
__device__ __forceinline__ unsigned xb_xcc_id() { return (unsigned)__builtin_amdgcn_s_getreg((3 << 11) | 20) & 0xFu; }
#define XB_SPIN(cond, bar) do { unsigned _sp = 0; while (cond) { __builtin_amdgcn_s_sleep(1); \
    if ((++_sp & 255u) == 0u) { if (xb_ld(&(bar)[XB_TMO])) break; if (_sp > XB_SPIN_CAP) { atomicAdd(&(bar)[XB_TMO], 1u); break; } } } } while (0)
struct XcdBarrier { unsigned* bar; unsigned x; volatile LAS unsigned* st; };
__device__ __forceinline__ XcdBarrier xcd_barrier_post(unsigned* bar, volatile LAS unsigned* st) {
    XcdBarrier b; b.bar = bar; b.x = xb_xcc_id(); b.st = st;
    if (threadIdx.x == 0) (void)xb_add(&bar[XB_XCNT(b.x)], 1u);
    return b;
}
__device__ __forceinline__ void xcd_barrier_complete(unsigned* bar, unsigned x, unsigned& nloc, unsigned& nx) {
    const unsigned G = gridDim.x * gridDim.y * gridDim.z;
    unsigned sum, cnt, mine, sp = 0u;
    for (;;) {
        sum = 0u; cnt = 0u; mine = 0u;
#pragma unroll 1
        for (unsigned j = 0; j < 16; ++j) { const unsigned c = xb_ld(&bar[XB_XCNT(j)]); sum += c; cnt += (c > 0u) ? 1u : 0u; mine = (j == x) ? c : mine; }
        if (sum == G) break;
        __builtin_amdgcn_s_sleep(1);
        if ((++sp & 255u) == 0u) { if (xb_ld(&bar[XB_TMO])) break; if (sp > XB_SPIN_CAP) { atomicAdd(&bar[XB_TMO], 1u); break; } }
    }
    nloc = mine > 0u ? mine : 1u; nx = cnt > 0u ? cnt : 1u;
}
__device__ __forceinline__ void xcd_barrier(const XcdBarrier& b) {
    asm volatile("s_waitcnt vmcnt(0)" ::: "memory");
    __syncthreads();
    if (threadIdx.x == 0) {
        unsigned* bar = b.bar;
        __builtin_amdgcn_s_waitcnt(0);
        unsigned nloc = b.st[0], nx = b.st[1];
        if (nloc == 0u) { xcd_barrier_complete(bar, b.x, nloc, nx); b.st[0] = nloc; b.st[1] = nx; }
        const unsigned old = xb_add(&bar[XB_XSUB(b.x)], 1u);
        const unsigned gen = old / nloc;
        if (old + 1u == (gen + 1u) * nloc) {
            __builtin_amdgcn_fence(__ATOMIC_RELEASE, "agent");
            asm volatile("s_waitcnt vmcnt(0)" ::: "memory");
            const unsigned og = xb_add(&bar[XB_TOP], 1u);
            const unsigned tg = og / nx;
            if (og + 1u == (tg + 1u) * nx) xb_add(&bar[XB_TOPGEN], 1u);
            else XB_SPIN(xb_ld(&bar[XB_TOPGEN]) == tg, bar);
            __builtin_amdgcn_fence(__ATOMIC_ACQUIRE, "agent");
            xb_add(&bar[XB_XGEN(b.x)], 1u);
            asm volatile("s_waitcnt vmcnt(0)" ::: "memory");
        } else {
            XB_SPIN(xb_ld(&bar[XB_XGEN(b.x)]) == gen, bar);
            __builtin_amdgcn_fence(__ATOMIC_ACQUIRE, "agent");
            asm volatile("s_waitcnt vmcnt(0)" ::: "memory");
        }
    }
    __syncthreads();
}

struct Args { const float* in[23]; float* out; unsigned char* ws; int ph_lo, ph_hi; };
typedef const Args __attribute__((address_space(4))) CArgs;
__device__ __forceinline__ CArgs* opaque_args() { CArgs* p = (CArgs*)__builtin_amdgcn_kernarg_segment_ptr(); asm volatile("" : "+s"(p)); return p; }
struct Frame {
    LAS unsigned char* lds;
    int tid, lane, wave, G, bid;
    float* out; unsigned char* ws;
};

struct EpiNull {
    static constexpr bool PERM = true, LBIAS = false;
    __device__ __forceinline__ void operator()(const f32x4 (&acc)[2][2][4][2], const pg8::Unit&, int, int, int, int, const LAS float*) const {
#pragma unroll
        for (int a = 0; a < 2; ++a)
#pragma unroll
            for (int b = 0; b < 2; ++b)
#pragma unroll
                for (int m = 0; m < 4; ++m)
#pragma unroll
                    for (int n = 0; n < 2; ++n) asm volatile("" :: "v"(acc[a][b][m][n]));
    }
};
struct DenseSched {
    static constexpr bool GATHER = false;
    int nM, nN, nwg, G, c, kb; const char* Bt; const LAS int* UT;
    __device__ __forceinline__ void init(int M, int N, int G_, int c_, const void* Bt_) { nM = M / 256; nN = N / 256; nwg = nM * nN; G = G_; c = c_; Bt = (const char*)Bt_; UT = nullptr; kb = 2048; }
    __device__ __forceinline__ void build(LAS int* ut, int tid) { if (tid < 32) { pg8::Unit u; ut[tid] = next_calc(tid, u) ? (u.pm | (u.pn << 16)) : -1; } UT = ut; __syncthreads(); }
    __device__ __forceinline__ bool next(int i, pg8::Unit& u) const { const int w = (i < 32) ? UT[i] : -1; if (w < 0) return false; u.pm = w & 0xffff; u.pn = w >> 16; u.e = 0; u.lt = 0; return true; }
    __device__ __forceinline__ bool next_calc(int i, pg8::Unit& u) const {
        const long L = (long)i * G + c; if (L >= nwg) return false;
        int wgid = (int)L; { const int q = nwg / 8, r = nwg % 8, xcd = wgid % 8, off = wgid / 8; wgid = (xcd < r ? xcd * (q + 1) : r * (q + 1) + (xcd - r) * q) + off; }
        const int nig = 8 * nN, gid = wgid / nig, fm = gid * 8, gsz = (nM - fm) < 8 ? (nM - fm) : 8;
        u.pm = fm + ((wgid % nig) % gsz); u.pn = (wgid % nig) / gsz; u.e = 0; u.lt = 0; return true;
    }
    __device__ __forceinline__ int arow(const pg8::Unit& u, int r) const { return u.pm * 256 + r; }
    __device__ __forceinline__ bool mostly_padding(const pg8::Unit& u) const { return nN == PWP / 256 && u.pn == nN - 1; }
    __device__ __forceinline__ const char* bptr(const pg8::Unit& u) const { return Bt + (size_t)u.pn * 256 * kb; }
};
struct EpiProj {
    static constexpr bool PERM = true, LBIAS = false;
    bf16* O;
    __device__ __forceinline__ void operator()(const f32x4 (&acc)[2][2][4][2], const pg8::Unit& u, int wr, int wc, int fr, int fq, const LAS float*) const {
        const int row0 = u.pm * 256 + wr * 64 + fr, col0 = u.pn * 256 + wc * 32 + 8 * fq;
#pragma unroll
        for (int ai = 0; ai < 2; ++ai)
#pragma unroll
            for (int m = 0; m < 4; ++m) { bf16* rowp = O + (size_t)(row0 + ai * 128 + m * 16) * PW + col0;
#pragma unroll
                for (int bj = 0; bj < 2; ++bj) { if (col0 + bj * 128 < PW) { const f32x4 v0 = acc[ai][bj][m][0], v1 = acc[ai][bj][m][1];
                    v4u w; w.x = pk2(v0[0], v0[1]); w.y = pk2(v0[2], v0[3]); w.z = pk2(v1[0], v1[1]); w.w = pk2(v1[2], v1[3]);
                    *(v4u*)(rowp + bj * 128) = w; } } }
    }
};
struct EpiOut {
    static constexpr bool PERM = true, LBIAS = true;
    const float* x; const float* mod; bf16* Y1; float sc;
    __device__ __forceinline__ const char* bias_src(const pg8::Unit& u) const { return (const char*)(mod + (size_t)(u.pm >> 4) * 6144 + 2048 + u.pn * 256); }
    __device__ __forceinline__ void operator()(const f32x4 (&acc)[2][2][4][2], const pg8::Unit& u, int wr, int wc, int fr, int fq, const LAS float* bl) const {
        const int row0 = u.pm * 256 + wr * 64 + fr, col0 = u.pn * 256 + wc * 32 + 8 * fq;
        f32x4 gv[2][2];
#pragma unroll
        for (int bj = 0; bj < 2; ++bj)
#pragma unroll
            for (int n = 0; n < 2; ++n) gv[bj][n] = *(const LAS f32x4*)(bl + wc * 32 + 8 * fq + bj * 128 + 4 * n) * sc;
#pragma unroll
        for (int ai = 0; ai < 2; ++ai)
#pragma unroll
            for (int m = 0; m < 4; ++m) { const size_t off = (size_t)(row0 + ai * 128 + m * 16) * D + col0; bf16* rowp = Y1 + off;
#pragma unroll
                for (int bj = 0; bj < 2; ++bj) { const f32x4 x0 = *(const f32x4*)(x + off + bj * 128), x1 = *(const f32x4*)(x + off + bj * 128 + 4);
                    const f32x4 v0 = x0 + acc[ai][bj][m][0] * gv[bj][0], v1 = x1 + acc[ai][bj][m][1] * gv[bj][1];
                    v4u w; w.x = pk2(v0[0], v0[1]); w.y = pk2(v0[2], v0[3]); w.z = pk2(v1[0], v1[1]); w.w = pk2(v1[2], v1[3]);
                    *(v4u*)(rowp + bj * 128) = w; } }
    }
};
template <bool GU> struct MoeSched {
    static constexpr bool GATHER = GU;
    static constexpr bool gu = GU;
    const LAS int* TS; int ntr, G, c; const int* laid; const char* W;
    __device__ __forceinline__ bool next(int i, pg8::Unit& u) const {
        const int x = c & 7, j = c >> 3; int tl, pn;
        if (G != 256) { const int L = i * G + c, npn = gu ? 8 : 4; tl = L / npn; pn = L % npn; }
        else if (gu) { tl = (i * 8 + x) * 4 + (j >> 3); pn = j & 7; } else { tl = (i * 8 + x) * 8 + (j >> 2); pn = j & 3; }
        if (tl >= ntr) return false;
        const int tau = tl; const int e = ((const LAS unsigned char*)(TS + 72))[tau];
        u.pm = tl; u.pn = pn; u.e = e; u.lt = tau - TS[e]; return true;
    }
    __device__ __forceinline__ bool mostly_padding(const pg8::Unit&) const { return false; }
    __device__ __forceinline__ int arow(const pg8::Unit& u, int r) const {
        if (!gu) return u.pm * 256 + r;
        const int pos = u.lt * 256 + r, cnt = TS[33 + u.e];
        return pos < cnt ? (laid[(size_t)u.e * LISTCAP + pos] >> 2) : 0;
    }
    __device__ __forceinline__ const char* bptr(const pg8::Unit& u) const { return W + ((size_t)u.e * (gu ? 2048 : 1024) + (size_t)u.pn * 256) * 1024; }
};
struct EpiGU {
    static constexpr bool PERM = true, LBIAS = true;
    unsigned char* ACT; const float* b_gu;
    __device__ __forceinline__ const char* bias_src(const pg8::Unit& u) const { return (const char*)(b_gu + (size_t)u.e * 2048 + u.pn * 256); }
    __device__ __forceinline__ void operator()(const f32x4 (&acc)[2][2][4][2], const pg8::Unit& u, int wr, int wc, int fr, int fq, const LAS float* bl) const {
        const int row0 = u.pm * 256 + wr * 64 + fr, j0 = u.pn * 128 + wc * 32 + 8 * fq;
        const LAS float* bp = bl + 2 * (wc * 32 + 8 * fq);
        f32x4 bv[4];
#pragma unroll
        for (int q = 0; q < 4; ++q) bv[q] = *(const LAS f32x4*)(bp + 4 * q);
        f32x2 bg[4], bu[4];
#pragma unroll
        for (int q = 0; q < 4; ++q) { bg[q] = (f32x2){bv[q][0], bv[q][2]}; bu[q] = (f32x2){bv[q][1], bv[q][3]}; }
#pragma unroll
        for (int ai = 0; ai < 2; ++ai)
#pragma unroll
            for (int m = 0; m < 4; ++m) { unsigned char* rowp = ACT + (size_t)(row0 + ai * 128 + m * 16) * DFF + j0; f32x2 a[4];
#pragma unroll
                for (int n = 0; n < 2; ++n)
#pragma unroll
                    for (int p = 0; p < 2; ++p) { const int q = 2 * n + p;
                        const f32x4 ag = acc[ai][0][m][n], au = acc[ai][1][m][n];
                        f32x2 g = (f32x2){ag[2 * p], ag[2 * p + 1]} * WSCALE_INV + bg[q], up = (f32x2){au[2 * p], au[2 * p + 1]} * WSCALE_INV + bu[q];
                        g.x = fminf(g.x, 7.0f); g.y = fminf(g.y, 7.0f); up.x = __builtin_amdgcn_fmed3f(up.x, -7.0f, 7.0f); up.y = __builtin_amdgcn_fmed3f(up.y, -7.0f, 7.0f);
                        const f32x2 t = g * (-1.702f * 1.4426950408889634f); f32x2 e; e.x = __builtin_amdgcn_exp2f(t.x); e.y = __builtin_amdgcn_exp2f(t.y);
                        const f32x2 d = e + 1.0f; f32x2 sg; sg.x = __builtin_amdgcn_rcpf(d.x); sg.y = __builtin_amdgcn_rcpf(d.y);
                        a[q] = ((up + 1.0f) * g) * sg; }
                v2u w; w.x = pk4_fp8(a[0].x, a[0].y, a[1].x, a[1].y); w.y = pk4_fp8(a[2].x, a[2].y, a[3].x, a[3].y);
                *(v2u*)rowp = w; }
    }
};
struct EpiDN {
    static constexpr bool PERM = true, LBIAS = true;
    unsigned char* YA; const float* b_dn; const LAS int* TS;
    __device__ __forceinline__ const char* bias_src(const pg8::Unit& u) const { return (const char*)(b_dn + (size_t)u.e * D + u.pn * 256); }
    __device__ __forceinline__ void operator()(const f32x4 (&acc)[2][2][4][2], const pg8::Unit& u, int wr, int wc, int fr, int fq, const LAS float* bl) const {
        const int col0 = u.pn * 256 + wc * 32 + 8 * fq, cnt = TS[33 + u.e];
        f32x4 bv[2][2];
#pragma unroll
        for (int bj = 0; bj < 2; ++bj)
#pragma unroll
            for (int n = 0; n < 2; ++n) bv[bj][n] = *(const LAS f32x4*)(bl + wc * 32 + 8 * fq + bj * 128 + 4 * n);
#pragma unroll
        for (int ai = 0; ai < 2; ++ai)
#pragma unroll
            for (int m = 0; m < 4; ++m) { const int r = ai * 128 + wr * 64 + m * 16 + fr;
                if (u.lt * 256 + r < cnt) { unsigned char* rowp = YA + ((size_t)u.pm * 256 + r) * D + col0;
#pragma unroll
                    for (int bj = 0; bj < 2; ++bj) { const f32x4 v0 = acc[ai][bj][m][0] * WSCALE_INV + bv[bj][0], v1 = acc[ai][bj][m][1] * WSCALE_INV + bv[bj][1];
                        v2u w; w.x = pk4_fp8(v0[0], v0[1], v0[2], v0[3]); w.y = pk4_fp8(v1[0], v1[1], v1[2], v1[3]);
                        *(v2u*)(rowp + bj * 128) = w; } }
                asm volatile("" ::: "memory"); }
    }
};

template <bool MAPGU>
__device__ __forceinline__ void p0_transpose_item(const float* W, int N, bf16* WT, LAS float* scr, int item, int lane) {
    const int nblk = N / 32, kb = item / nblk, nb = item % nblk, k0 = 64 * kb, n0 = 32 * nb;
#pragma unroll
    for (int i = 0; i < 32; ++i) { const int kk = 2 * i + (lane >> 5); scr[kk * 33 + (lane & 31)] = W[(size_t)(k0 + kk) * N + n0 + (lane & 31)]; }
    LDS_WAIT(); asm volatile("" ::: "memory");
    const int c = lane & 7;
#pragma unroll
    for (int j = 0; j < 4; ++j) { const int n = (lane >> 3) + 8 * j; const LAS float* s = scr + (8 * c) * 33 + n;
        v4u o; o.x = pk2(s[0 * 33], s[1 * 33]); o.y = pk2(s[2 * 33], s[3 * 33]); o.z = pk2(s[4 * 33], s[5 * 33]); o.w = pk2(s[6 * 33], s[7 * 33]);
        int row = n0 + n;
        if (MAPGU) { const int jj = row >> 1; row = (jj >> 7) * 256 + (row & 1) * 128 + (jj & 127); }
        *(v4u*)(WT + (size_t)row * D + k0 + 8 * c) = o; }
    LDS_WAIT(); asm volatile("" ::: "memory");
}
template <bool MAPGU>
__device__ __forceinline__ void p0_transpose_item_f8(const float* W, int N, unsigned char* WT, LAS float* scr, int item, int lane) {
    const int nblk = N / 32, kb = item / nblk, nb = item % nblk, k0 = 64 * kb, n0 = 32 * nb;
#pragma unroll
    for (int i = 0; i < 32; ++i) { const int kk = 2 * i + (lane >> 5); scr[kk * 33 + (lane & 31)] = W[(size_t)(k0 + kk) * N + n0 + (lane & 31)] * WSCALE; }
    LDS_WAIT(); asm volatile("" ::: "memory");
    const int c = lane & 3;
#pragma unroll
    for (int j = 0; j < 2; ++j) { const int n = (lane >> 2) + 16 * j; const LAS float* s = scr + (16 * c) * 33 + n;
        v4u o; o.x = pk4_fp8(s[0 * 33], s[1 * 33], s[2 * 33], s[3 * 33]); o.y = pk4_fp8(s[4 * 33], s[5 * 33], s[6 * 33], s[7 * 33]);
        o.z = pk4_fp8(s[8 * 33], s[9 * 33], s[10 * 33], s[11 * 33]); o.w = pk4_fp8(s[12 * 33], s[13 * 33], s[14 * 33], s[15 * 33]);
        int row = n0 + n;
        if (MAPGU) { const int jj = row >> 1; row = (jj >> 7) * 256 + (row & 1) * 128 + (jj & 127); }
        *(v4u*)(WT + (size_t)row * D + k0 + 16 * c) = o; }
    LDS_WAIT(); asm volatile("" ::: "memory");
}
constexpr int P0_TS = 144;
struct P0Item { const float* W; void* O; int N, k0, n0, kind; };
__device__ __forceinline__ P0Item p0_item(const Frame& F, CArgs* A, int it) {
    constexpr int I_IN = 8 * 25, I_OUT = 8 * 8, I_GU = 8 * 16, I_DN = 8 * 8;
    P0Item r; int x = it;
    if (x < I_IN) { r.W = A->in[7]; r.O = (void*)(F.ws + WS_WIN); r.N = PW; r.k0 = (x / 25) * 128; r.n0 = (x % 25) * 128; r.kind = 0; return r; } x -= I_IN;
    if (x < I_OUT) { r.W = A->in[14]; r.O = (void*)(F.ws + WS_WOUT); r.N = D; r.k0 = (x >> 3) * 128; r.n0 = (x & 7) * 128; r.kind = OUTPROJ_F8 ? 1 : 0; return r; } x -= I_OUT;
    if (x < NEXP * I_GU) { const int e = x / I_GU, y = x % I_GU; r.W = A->in[18] + (size_t)e * D * 2048; r.O = (void*)((unsigned char*)F.out + DO_WGU + (size_t)e * 2048 * D); r.N = 2048; r.k0 = (y >> 4) * 128; r.n0 = (y & 15) * 128; r.kind = 2; return r; } x -= NEXP * I_GU;
    { const int e = x / I_DN, y = x % I_DN; r.W = A->in[20] + (size_t)e * D * D; r.O = (void*)((unsigned char*)F.out + DO_WDN + (size_t)e * D * D); r.N = D; r.k0 = (y >> 3) * 128; r.n0 = (y & 7) * 128; r.kind = 1; return r; }
}
__device__ __forceinline__ void p0_load(const P0Item& I, int tid, f32x4 (&v)[8]) {
#pragma unroll
    for (int q = 0; q < 8; ++q) { const int idx = tid + NTHREADS * q, k = idx >> 5, col = I.n0 + 4 * (idx & 31);
        v[q] = (col < I.N) ? *(const f32x4*)(I.W + (size_t)(I.k0 + k) * I.N + col) : (f32x4){0.f, 0.f, 0.f, 0.f}; }
}
__device__ __forceinline__ void p0_emit(const P0Item& I, LAS unsigned char* lds, int wave, int i, int g) {
    const unsigned a0 = (unsigned)(uintptr_t)lds + (unsigned)(((32 * g + (i >> 2)) * P0_TS + 16 * wave + 4 * (i & 3)) * 2);
    s16x4 r[8];
    asm volatile("ds_read_b64_tr_b16 %0, %8\n\tds_read_b64_tr_b16 %1, %8 offset:1152\n\tds_read_b64_tr_b16 %2, %8 offset:2304\n\tds_read_b64_tr_b16 %3, %8 offset:3456\n\t"
                 "ds_read_b64_tr_b16 %4, %8 offset:4608\n\tds_read_b64_tr_b16 %5, %8 offset:5760\n\tds_read_b64_tr_b16 %6, %8 offset:6912\n\tds_read_b64_tr_b16 %7, %8 offset:8064\n\ts_waitcnt lgkmcnt(0)"
                 : "=&v"(r[0]), "=&v"(r[1]), "=&v"(r[2]), "=&v"(r[3]), "=&v"(r[4]), "=&v"(r[5]), "=&v"(r[6]), "=&v"(r[7]) : "v"(a0) : "memory");
    const int n = I.n0 + 16 * wave + i;
    if (n < I.N) {
        if (I.kind == 0) { bf16* op = (bf16*)I.O + (size_t)n * D + I.k0 + 32 * g;
#pragma unroll
            for (int q = 0; q < 4; ++q) { v4u w; w.x = (unsigned)(unsigned short)r[2 * q][0] | ((unsigned)(unsigned short)r[2 * q][1] << 16); w.y = (unsigned)(unsigned short)r[2 * q][2] | ((unsigned)(unsigned short)r[2 * q][3] << 16);
                w.z = (unsigned)(unsigned short)r[2 * q + 1][0] | ((unsigned)(unsigned short)r[2 * q + 1][1] << 16); w.w = (unsigned)(unsigned short)r[2 * q + 1][2] | ((unsigned)(unsigned short)r[2 * q + 1][3] << 16);
                *(v4u*)(op + 8 * q) = w; } }
        else { int row = n; if (I.kind == 2) { const int jj = n >> 1; row = (jj >> 7) * 256 + (n & 1) * 128 + (jj & 127); }
            unsigned char* op = (unsigned char*)I.O + (size_t)row * D + I.k0 + 32 * g;
#pragma unroll
            for (int q = 0; q < 2; ++q) { v4u w; unsigned* wp = (unsigned*)&w;
#pragma unroll
                for (int j = 0; j < 4; ++j) { const s16x4 x = r[4 * q + j]; wp[j] = pk4_fp8(bf2f((bf16)x[0]) * WSCALE, bf2f((bf16)x[1]) * WSCALE, bf2f((bf16)x[2]) * WSCALE, bf2f((bf16)x[3]) * WSCALE); }
                *(v4u*)(op + 16 * q) = w; } } }
}
__device__ __forceinline__ void p0_phase(const Frame& F, CArgs* A) {
    LAS unsigned char* lds = F.lds; const int tid = F.tid, lane = F.lane, wave = F.wave, i = lane & 15, g = lane >> 4;
    constexpr int NITEMS = 8 * 25 + 8 * 8 + NEXP * 8 * 16 + NEXP * 8 * 8;
    { v4u z = {0u, 0u, 0u, 0u}; v4u* p = (v4u*)(((bf16*)(F.ws + WS_WIN)) + (size_t)PW * D); const int n16 = (PWP - PW) * D * 2 / 16;
      for (int i = F.bid * NTHREADS + F.tid; i < n16; i += F.G * NTHREADS) p[i] = z; }
    __syncthreads();
    LAS float* sl = (LAS float*)F.lds;
    LAS float* red = (LAS float*)(F.lds + 1024 * 20 * 4);
    bool filled = false;
    for (int it = F.bid; it < 6144 / 64; it += F.G) {
        if (!filled) {
            for (int i = F.tid; i < 17 * 1024; i += NTHREADS) { const int m = i >> 10, k = i & 1023; const float v = (m < 16) ? A->in[1][m * 1024 + k] : A->in[3][k]; sl[k * 20 + m] = v * __builtin_amdgcn_rcpf(1.0f + fexp(-v)); }
            filled = true; __syncthreads();
        }
        float a[17];
#pragma unroll
        for (int m = 0; m < 17; ++m) a[m] = 0.f;
        const int j = it * 64 + F.lane;
#pragma unroll 1
        for (int kb = 0; kb < 128; kb += 16) { float wv[16];
#pragma unroll
          for (int q = 0; q < 16; ++q) wv[q] = A->in[4][(size_t)(F.wave * 128 + kb + q) * 6144 + j];
#pragma unroll
          for (int q = 0; q < 16; ++q) { const int k = F.wave * 128 + kb + q; const float w = wv[q];
            const LAS float* sp = sl + k * 20;
            const f32x4 s0 = *(const LAS f32x4*)sp, s1 = *(const LAS f32x4*)(sp + 4), s2 = *(const LAS f32x4*)(sp + 8), s3 = *(const LAS f32x4*)(sp + 12); const float s4 = sp[16];
            a[0] += s0[0] * w; a[1] += s0[1] * w; a[2] += s0[2] * w; a[3] += s0[3] * w; a[4] += s1[0] * w; a[5] += s1[1] * w; a[6] += s1[2] * w; a[7] += s1[3] * w;
            a[8] += s2[0] * w; a[9] += s2[1] * w; a[10] += s2[2] * w; a[11] += s2[3] * w; a[12] += s3[0] * w; a[13] += s3[1] * w; a[14] += s3[2] * w; a[15] += s3[3] * w; a[16] += s4 * w; } }
#pragma unroll
        for (int m = 0; m < 17; ++m) red[(F.wave * 17 + m) * 64 + F.lane] = a[m];
        __syncthreads();
        for (int i = F.tid; i < 17 * 64; i += NTHREADS) { const int m = i >> 6, l = i & 63; float s = 0.f;
#pragma unroll
            for (int w = 0; w < 8; ++w) s += red[(w * 17 + m) * 64 + l];
            ((float*)(F.ws + WS_MOD))[(size_t)m * 6144 + it * 64 + l] = s + A->in[5][it * 64 + l]; }
        __syncthreads();
    }
    __syncthreads();
    int first = F.bid, stride = F.G, cnt = (NITEMS + F.G - 1) / F.G;
    if (F.G == 256) { if (F.bid >= 96) { first = F.bid - 96; stride = 160; cnt = 26; } else { first = 160 * 26 + F.bid; stride = 96; cnt = 24; } }
    static_assert(160 * 26 + 96 * 24 >= NITEMS, "P0 item split");
    f32x4 va[8], vb[8];
    if (first < NITEMS) { const P0Item I0 = p0_item(F, A, first); p0_load(I0, tid, va); }
    if (cnt > 1 && first + stride < NITEMS) { const P0Item I1 = p0_item(F, A, first + stride); p0_load(I1, tid, vb); }
#define P0_STEP(VCUR, k_) do { const int it_ = first + (k_) * stride; const P0Item I = p0_item(F, A, it_); \
        _Pragma("unroll") for (int q = 0; q < 8; ++q) { const int idx = tid + NTHREADS * q, k = idx >> 5, p = idx & 31; v2u w; w.x = pk2(VCUR[q][0], VCUR[q][1]); w.y = pk2(VCUR[q][2], VCUR[q][3]); \
            *(LAS v2u*)(lds + (k * P0_TS + 4 * p) * 2) = w; } \
        if ((k_) + 2 < cnt && it_ + 2 * stride < NITEMS) { const P0Item In = p0_item(F, A, it_ + 2 * stride); p0_load(In, tid, VCUR); } \
        LDS_BARRIER(); \
        p0_emit(I, lds, wave, i, g); \
        LDS_BARRIER(); } while (0)
#pragma unroll 1
    for (int k = 0; k < cnt && first + k * stride < NITEMS; k += 2) {
        P0_STEP(va, k);
        if (k + 1 < cnt && first + (k + 1) * stride < NITEMS) P0_STEP(vb, k + 1);
    }
#undef P0_STEP
}

__device__ __forceinline__ void p1_phase(const Frame& F, CArgs* A) {
    const int gw = F.bid * NWAVES + F.wave, NGW = F.G * NWAVES;
    for (int r0 = gw; r0 < NROWS; r0 += 2 * NGW) {
        const int r1 = r0 + NGW; const bool two = r1 < NROWS;
        const float* xa = (r0 < NLAT) ? A->in[0] + (size_t)r0 * D : A->in[2] + (size_t)(r0 - NLAT) * D;
        const float* xb = !two ? xa : ((r1 < NLAT) ? A->in[0] + (size_t)r1 * D : A->in[2] + (size_t)(r1 - NLAT) * D);
        f32x4 va[4], vb[4];
#pragma unroll
        for (int j = 0; j < 4; ++j) { va[j] = ((const f32x4*)xa)[F.lane + 64 * j]; vb[j] = ((const f32x4*)xb)[F.lane + 64 * j]; }
#pragma unroll
        for (int which = 0; which < 2; ++which) { if (which == 1 && !two) break;
            const int r = which ? r1 : r0; const int mrow = (r < NLAT) ? (r >> 12) : 16;
            const float* sh = ((float*)(F.ws + WS_MOD)) + (size_t)mrow * 6144; const float* sc = sh + 1024;
            float s = 0.f;
#pragma unroll
            for (int j = 0; j < 4; ++j) { const f32x4 v = which ? vb[j] : va[j]; s += (v.x * v.x + v.y * v.y) + (v.z * v.z + v.w * v.w); }
            const float rstd = 1.0f / sqrtf(wave_sum(s) * (1.f / D) + EPS);
            unsigned long long* o8 = (unsigned long long*)(((bf16*)(F.ws + WS_HN)) + (size_t)r * D) + F.lane;
#pragma unroll
            for (int j = 0; j < 4; ++j) { const int c4 = F.lane + 64 * j; const f32x4 v = which ? vb[j] : va[j]; const f32x4 w = ((const f32x4*)A->in[6])[c4], a = ((const f32x4*)sc)[c4], b = ((const f32x4*)sh)[c4];
                const f32x4 y = (v * rstd) * w * (a + 1.0f) + b;
                o8[64 * j] = (unsigned long long)pk2(y.x, y.y) | ((unsigned long long)pk2(y.z, y.w) << 32); } }
    }
}

constexpr int GL_ZL = 0;
constexpr int GL_BC = 8192;
constexpr int GL_TOT = GL_BC + 32768;
constexpr int GL_V = GL_TOT + 512;
constexpr int GL_A = GL_V + 64 * 136 * 2;
constexpr int GL_B = GL_A + 2 * 64 * 72 * 2;
constexpr int GL_P = GL_B + 2 * 64 * 72 * 2;
constexpr int GL_SS = GL_P + 64 * 72 * 2;
constexpr int GL_SEG = GL_SS + 512;
constexpr int GL_END = GL_SEG + 2048;
static_assert(GL_END <= RING_BYTES && (GL_V % 16) == 0 && (GL_A % 16) == 0 && (GL_B % 16) == 0 && (GL_P % 16) == 0, "GLA LDS map");

__device__ __forceinline__ s16x4 tr_read(unsigned lds_addr) { s16x4 r; asm volatile("ds_read_b64_tr_b16 %0, %1\n\ts_waitcnt lgkmcnt(0)" : "=&v"(r) : "v"(lds_addr) : "memory"); return r; }
__device__ __forceinline__ void v_frag2(LAS unsigned char* lds, int v0, int lane, bf16x8& f0, bf16x8& f1) {
    const int i = lane & 15, g = lane >> 4;
    const unsigned a0 = (unsigned)(uintptr_t)(lds + GL_V) + (unsigned)(((8 * g + (i >> 2)) * 136 + v0 + 4 * (i & 3)) * 2);
    s16x4 r0, r1, r2, r3;
    asm volatile("ds_read_b64_tr_b16 %0, %4\n\tds_read_b64_tr_b16 %1, %4 offset:1088\n\tds_read_b64_tr_b16 %2, %4 offset:8704\n\tds_read_b64_tr_b16 %3, %4 offset:9792\n\ts_waitcnt lgkmcnt(0)"
                 : "=&v"(r0), "=&v"(r1), "=&v"(r2), "=&v"(r3) : "v"(a0) : "memory");
    f0[0] = r0[0]; f0[1] = r0[1]; f0[2] = r0[2]; f0[3] = r0[3]; f0[4] = r1[0]; f0[5] = r1[1]; f0[6] = r1[2]; f0[7] = r1[3];
    f1[0] = r2[0]; f1[1] = r2[1]; f1[2] = r2[2]; f1[3] = r2[3]; f1[4] = r3[0]; f1[5] = r3[1]; f1[6] = r3[2]; f1[7] = r3[3];
}
__device__ __forceinline__ bf16x8 v_frag(LAS unsigned char* lds, int ks, int v0, int lane) {
    const int i = lane & 15, g = lane >> 4;
    const unsigned a0 = (unsigned)(uintptr_t)(lds + GL_V) + (unsigned)(((32 * ks + 8 * g + (i >> 2)) * 136 + v0 + 4 * (i & 3)) * 2);
    const s16x4 lo = tr_read(a0), hi = tr_read(a0 + 4 * 136 * 2);
    bf16x8 r; r[0] = lo[0]; r[1] = lo[1]; r[2] = lo[2]; r[3] = lo[3]; r[4] = hi[0]; r[5] = hi[1]; r[6] = hi[2]; r[7] = hi[3]; return r;
}
struct GlaRegs { v4u zw, vw[2]; };
__device__ __forceinline__ GlaRegs gla_load(const Frame& F, size_t prow, int h) {
    GlaRegs r; const int tid = F.tid; const bf16* P = (const bf16*)(F.ws + WS_P);
    { const int t = (tid & 255) >> 2, q = tid & 3; r.zw = *(const v4u*)(P + (prow + t) * PW + CAF + 8 * q); }
#pragma unroll
    for (int i = 0; i < 2; ++i) { const int pc = tid + i * NTHREADS, t = pc >> 4, c = pc & 15; r.vw[i] = *(const v4u*)(P + (prow + t) * PW + CV + h * 128 + c * 8); }
    return r;
}
__device__ __forceinline__ void gla_prep(const Frame& F, CArgs* A, const GlaRegs& R, int h) {
    LAS unsigned char* lds = F.lds; const int tid = F.tid;
    if (tid < 256) { const int t = tid >> 2, q = tid & 3; const v4u w = R.zw;
        LAS float* z = (LAS float*)(lds + GL_ZL) + (q >> 1) * 1024 + t * 16 + (q & 1) * 8;
        *(LAS f32x4*)z = (f32x4){bflo(w.x), bfhi(w.x), bflo(w.y), bfhi(w.y)}; *(LAS f32x4*)(z + 4) = (f32x4){bflo(w.z), bfhi(w.z), bflo(w.w), bfhi(w.w)}; }
#pragma unroll
    for (int i = 0; i < 2; ++i) { const int pc = tid + i * NTHREADS, t = pc >> 4, c = pc & 15; *(LAS v4u*)(lds + GL_V + (t * 136 + c * 8) * 2) = R.vw[i]; }
    __syncthreads();
    { const int dir = tid >> 8, seg = (tid >> 6) & 3, d = tid & 63;
      const float* up = dir ? A->in[10] : A->in[8]; const float bias = (dir ? A->in[11] : A->in[9])[h * 64 + d];
      float u[16];
#pragma unroll
      for (int r = 0; r < 16; ++r) u[r] = up[r * 256 + h * 64 + d];
      const LAS float* zl = (const LAS float*)(lds + GL_ZL) + dir * 1024; LAS float* bc = (LAS float*)(lds + GL_BC) + dir * 4096 + d;
      LAS float* sg = (LAS float*)(lds + GL_SEG) + dir * 256 + d;
      float c[16]; float cum = 0.f;
#pragma unroll
      for (int i = 0; i < 16; ++i) { const int t = seg * 16 + (dir ? 15 - i : i); const LAS float* zp = zl + t * 16;
          const f32x4 z0 = *(const LAS f32x4*)zp, z1 = *(const LAS f32x4*)(zp + 4), z2 = *(const LAS f32x4*)(zp + 8), z3 = *(const LAS f32x4*)(zp + 12);
          float z = bias + z0[0] * u[0] + z0[1] * u[1] + z0[2] * u[2] + z0[3] * u[3] + z1[0] * u[4] + z1[1] * u[5] + z1[2] * u[6] + z1[3] * u[7]
                         + z2[0] * u[8] + z2[1] * u[9] + z2[2] * u[10] + z2[3] * u[11] + z3[0] * u[12] + z3[1] * u[13] + z3[2] * u[14] + z3[3] * u[15];
          const float ls = fminf(z, 0.f) - __logf(1.0f + __expf(-fabsf(z)));
          cum += ls * (1.0f / 16.0f); c[i] = cum; }
      sg[seg * 64] = cum;
      __syncthreads();
      float off = 0.f, tot = 0.f;
#pragma unroll
      for (int s2 = 0; s2 < 4; ++s2) { const float v = sg[s2 * 64]; tot += v; off += (dir ? (s2 > seg) : (s2 < seg)) ? v : 0.f; }
#pragma unroll
      for (int i = 0; i < 16; ++i) { const int t = seg * 16 + (dir ? 15 - i : i); bc[t * 64] = off + c[i]; }
      if (seg == 0) ((LAS float*)(lds + GL_TOT))[dir * 64 + d] = tot; }
    __syncthreads();
}

__device__ __forceinline__ size_t chunk_row(int b, int cc) { return cc < 4 ? (size_t)NLAT + b * CTXL + cc * 64 : (size_t)b * SEQ + (cc - 4) * 64; }
__device__ __forceinline__ void p3_phase(const Frame& F, CArgs* A) {
    LAS unsigned char* lds = F.lds; const int tid = F.tid, lane = F.lane, wave = F.wave;
    GlaRegs cur; if (F.bid < NBATCH * NCC * 4) { const int bc0 = F.bid >> 2; cur = gla_load(F, chunk_row(bc0 / NCC, bc0 % NCC), F.bid & 3); }
    for (int it = F.bid; it < NBATCH * NCC * 4; it += F.G) {
        const int h = it & 3, bc = it >> 2, b = bc / NCC, cc = bc % NCC; const size_t prow = chunk_row(b, cc);
        GlaRegs nxt = cur; { const int itn = it + F.G; if (itn < NBATCH * NCC * 4) { const int bcn = itn >> 2; nxt = gla_load(F, chunk_row(bcn / NCC, bcn % NCC), itn & 3); } }
        float kf[8];
        { const int d = tid & 63, tg = tid >> 6;
#pragma unroll
          for (int j = 0; j < 8; ++j) kf[j] = bf2f(((bf16*)(F.ws + WS_P))[(prow + tg * 8 + j) * PW + CK + h * 64 + d]); }
        gla_prep(F, A, cur, h); cur = nxt;
        if (tid < 128) { const int dir = tid >> 6, d = tid & 63; ((float*)(F.ws + WS_DECAY))[(((size_t)dir * NBATCH + b) * NCC + cc) * 256 + h * 64 + d] = __expf(((const LAS float*)(lds + GL_TOT))[dir * 64 + d]); }
        { const int d = tid & 63, tg = tid >> 6;
#pragma unroll
          for (int dir = 0; dir < 2; ++dir) { const float tot = ((const LAS float*)(lds + GL_TOT))[dir * 64 + d]; const LAS float* bcp = (const LAS float*)(lds + GL_BC) + dir * 4096 + (tg * 8) * 64 + d; float s[8];
#pragma unroll
              for (int j = 0; j < 8; ++j) s[j] = kf[j] * __expf(tot - bcp[j * 64]);
              v4u w; w.x = pk2(s[0], s[1]); w.y = pk2(s[2], s[3]); w.z = pk2(s[4], s[5]); w.w = pk2(s[6], s[7]);
              *(LAS v4u*)(lds + GL_A + ((dir * 64 + d) * 72 + tg * 8) * 2) = w; } }
        __syncthreads();
        { const int dir = wave & 1, dt = wave >> 1, i = lane & 15, g = lane >> 4;
          bf16x8 af[2];
#pragma unroll
          for (int ks = 0; ks < 2; ++ks) af[ks] = *(const LAS bf16x8*)(lds + GL_A + ((dir * 64 + dt * 16 + i) * 72 + 32 * ks + 8 * g) * 2);
          bf16* kvp = ((bf16*)(F.ws + WS_KV)) + ((((size_t)dir * NBATCH + b) * NCC + cc) * 4 + h) * 8192;
#pragma unroll 2
          for (int vt = 0; vt < 8; ++vt) { f32x4 acc = {0.f, 0.f, 0.f, 0.f}; bf16x8 vf0, vf1; v_frag2(lds, vt * 16, lane, vf0, vf1);
              acc = __builtin_amdgcn_mfma_f32_16x16x32_bf16(af[0], vf0, acc, 0, 0, 0); acc = __builtin_amdgcn_mfma_f32_16x16x32_bf16(af[1], vf1, acc, 0, 0, 0);
              v2u w; w.x = pk2(acc[0], acc[1]); w.y = pk2(acc[2], acc[3]);
              *(v2u*)(kvp + (size_t)(vt * 16 + i) * 64 + dt * 16 + 4 * g) = w; } }
        __syncthreads();
    }
}

constexpr int G2_ZL = 0;
constexpr int G2_HT = 8192;
constexpr int G2_TOT = G2_HT + 4096;
constexpr int G2_A = G2_TOT + 1024;
constexpr int G2_B = G2_A + 256 * 72 * 2;
constexpr int G2_VS = 528;
static_assert(G2_B + 64 * G2_VS * 2 <= RING_BYTES && G2_B + 256 * 72 * 2 <= RING_BYTES && (G2_A % 16) == 0 && (G2_B % 16) == 0, "GLA v2 LDS map");
__device__ __forceinline__ void tr_frag2(unsigned tile_addr, int c0, int lane, bf16x8& f0, bf16x8& f1) {
    const int i = lane & 15, g = lane >> 4;
    const unsigned a0 = tile_addr + (unsigned)(((8 * g + (i >> 2)) * G2_VS + c0 + 4 * (i & 3)) * 2);
    s16x4 r0, r1, r2, r3;
    asm volatile("ds_read_b64_tr_b16 %0, %4\n\tds_read_b64_tr_b16 %1, %4 offset:4224\n\tds_read_b64_tr_b16 %2, %4 offset:33792\n\tds_read_b64_tr_b16 %3, %4 offset:38016\n\ts_waitcnt lgkmcnt(0)"
                 : "=&v"(r0), "=&v"(r1), "=&v"(r2), "=&v"(r3) : "v"(a0) : "memory");
    f0[0] = r0[0]; f0[1] = r0[1]; f0[2] = r0[2]; f0[3] = r0[3]; f0[4] = r1[0]; f0[5] = r1[1]; f0[6] = r1[2]; f0[7] = r1[3];
    f1[0] = r2[0]; f1[1] = r2[1]; f1[2] = r2[2]; f1[3] = r2[3]; f1[4] = r3[0]; f1[5] = r3[1]; f1[6] = r3[2]; f1[7] = r3[3];
}
static_assert(4 * G2_VS * 2 == 4224 && 32 * G2_VS * 2 == 33792 && 36 * G2_VS * 2 == 38016, "tr_frag2 offsets");
__device__ __forceinline__ float log_sigmoid16(float z) { return (fminf(z, 0.f) - __logf(1.0f + __expf(-fabsf(z)))) * (1.0f / 16.0f); }

__device__ __forceinline__ void p3v2_phase(const Frame& F, CArgs* A) {
    LAS unsigned char* lds = F.lds; const int tid = F.tid, lane = F.lane, wave = F.wave, i = lane & 15, g = lane >> 4;
    const int c = tid & 255, th = tid >> 8;
    const bf16* P = (const bf16*)(F.ws + WS_P);
#pragma unroll 1
    for (int it = F.bid; it < NBATCH * NCC; it += F.G) {
        const int b = it / NCC, cc = it % NCC; const size_t prow = chunk_row(b, cc);
        if (tid < 256) { const int t = tid >> 2, q = tid & 3; const v4u w = *(const v4u*)(P + (prow + t) * PW + CAF + 8 * q);
            LAS float* z = (LAS float*)(lds + G2_ZL) + (q >> 1) * 1024 + t * 16 + (q & 1) * 8;
            *(LAS f32x4*)z = (f32x4){bflo(w.x), bfhi(w.x), bflo(w.y), bfhi(w.y)}; *(LAS f32x4*)(z + 4) = (f32x4){bflo(w.z), bfhi(w.z), bflo(w.w), bfhi(w.w)}; }
#pragma unroll
        for (int j = 0; j < 8; ++j) { const int pc = tid + j * NTHREADS, t = pc >> 6, cv = pc & 63;
            *(LAS v4u*)(lds + G2_B + (t * G2_VS + cv * 8) * 2) = *(const v4u*)(P + (prow + t) * PW + CV + cv * 8); }
        float kk[32];
#pragma unroll
        for (int tl = 0; tl < 32; ++tl) kk[tl] = bf2f(P[(prow + th * 32 + tl) * PW + CK + c]);
        __syncthreads();
#pragma unroll
        for (int dir = 0; dir < 2; ++dir) {
            { const float* up = dir ? A->in[10] : A->in[8]; const float bias = (dir ? A->in[11] : A->in[9])[c];
              float u[16];
#pragma unroll
              for (int r = 0; r < 16; ++r) u[r] = up[r * 256 + c];
              const LAS float* zl = (const LAS float*)(lds + G2_ZL) + dir * 1024 + th * 512;
              float cl[32]; float cum = 0.f;
#pragma unroll
              for (int ii = 0; ii < 32; ++ii) { const int tl = dir ? 31 - ii : ii; const LAS float* zp = zl + tl * 16;
                  const f32x4 z0 = *(const LAS f32x4*)zp, z1 = *(const LAS f32x4*)(zp + 4), z2 = *(const LAS f32x4*)(zp + 8), z3 = *(const LAS f32x4*)(zp + 12);
                  const float z = bias + z0[0] * u[0] + z0[1] * u[1] + z0[2] * u[2] + z0[3] * u[3] + z1[0] * u[4] + z1[1] * u[5] + z1[2] * u[6] + z1[3] * u[7]
                                       + z2[0] * u[8] + z2[1] * u[9] + z2[2] * u[10] + z2[3] * u[11] + z3[0] * u[12] + z3[1] * u[13] + z3[2] * u[14] + z3[3] * u[15];
                  cum += log_sigmoid16(z); cl[tl] = cum; }
              LAS float* ht = (LAS float*)(lds + G2_HT) + dir * 512;
              ht[th * 256 + c] = cum;
              __syncthreads();
              const float other = ht[(1 - th) * 256 + c], tot = cum + other;
              const float off = (dir == 0) ? (th ? other : 0.f) : (th ? 0.f : other);
              if (th == 0) { ((LAS float*)(lds + G2_TOT))[c] = tot; ((float*)(F.ws + WS_DECAY))[(((size_t)dir * NBATCH + b) * NCC + cc) * 256 + c] = __expf(tot); }
#pragma unroll
              for (int j = 0; j < 4; ++j) { float e[8];
#pragma unroll
                  for (int q = 0; q < 8; ++q) e[q] = kk[8 * j + q] * __expf(-(off + cl[8 * j + q]));
                  v4u w; w.x = pk2(e[0], e[1]); w.y = pk2(e[2], e[3]); w.z = pk2(e[4], e[5]); w.w = pk2(e[6], e[7]);
                  *(LAS v4u*)(lds + G2_A + (c * 72 + th * 32 + 8 * j) * 2) = w; } }
            __syncthreads();
            { const int h = wave >> 1, vh = wave & 1;
              bf16x8 af[4][2];
#pragma unroll
              for (int dt = 0; dt < 4; ++dt)
#pragma unroll
                  for (int ks = 0; ks < 2; ++ks) af[dt][ks] = *(const LAS bf16x8*)(lds + G2_A + ((h * 64 + dt * 16 + i) * 72 + 32 * ks + 8 * g) * 2);
              f32x4 et[4];
#pragma unroll
              for (int dt = 0; dt < 4; ++dt) { const f32x4 tv = *(const LAS f32x4*)(lds + G2_TOT + (h * 64 + dt * 16 + 4 * g) * 4); et[dt] = (f32x4){__expf(tv[0]), __expf(tv[1]), __expf(tv[2]), __expf(tv[3])}; }
              bf16* kvp = ((bf16*)(F.ws + WS_KV)) + ((((size_t)dir * NBATCH + b) * NCC + cc) * 4 + h) * 8192;
              bf16* vtp = ((bf16*)(F.ws + WS_VT)) + (((size_t)b * 64 + (cc - 4)) * 4 + h) * 8192;
#pragma unroll
              for (int vt = 0; vt < 4; ++vt) { const int v0 = vh * 64 + vt * 16; bf16x8 vf0, vf1; tr_frag2((unsigned)(uintptr_t)(lds + G2_B), h * 128 + v0, lane, vf0, vf1);
                  if (dir == 0 && cc >= 4) { *(bf16x8*)(vtp + (size_t)(v0 + i) * 64 + 8 * g) = vf0; *(bf16x8*)(vtp + (size_t)(v0 + i) * 64 + 32 + 8 * g) = vf1; }
#pragma unroll
                  for (int dt = 0; dt < 4; ++dt) { f32x4 acc = {0.f, 0.f, 0.f, 0.f};
                      acc = __builtin_amdgcn_mfma_f32_16x16x32_bf16(af[dt][0], vf0, acc, 0, 0, 0); acc = __builtin_amdgcn_mfma_f32_16x16x32_bf16(af[dt][1], vf1, acc, 0, 0, 0);
                      acc = acc * et[dt];
                      v2u w; w.x = pk2(acc[0], acc[1]); w.y = pk2(acc[2], acc[3]);
                      *(v2u*)(kvp + (size_t)(v0 + i) * 64 + dt * 16 + 4 * g) = w; } } }
            __syncthreads();
        }
    }
}

struct GateConst { bf16x8 bw[2][2]; float bias[2][2]; };
__device__ __forceinline__ GateConst gate_setup(CArgs* A, int wave, int lane) {
    GateConst G; const int i = lane & 15, g = lane >> 4;
#pragma unroll
    for (int dir = 0; dir < 2; ++dir)
#pragma unroll
        for (int cti = 0; cti < 2; ++cti) { const int c = 32 * wave + 16 * cti + i; const float* up = dir ? A->in[10] : A->in[8];
            G.bias[dir][cti] = (dir ? A->in[11] : A->in[9])[c];
#pragma unroll
            for (int jj = 0; jj < 8; ++jj) { const float v = up[(8 * (g & 1) + jj) * 256 + c]; const unsigned hi = f2bf(v); const float rem = v - __builtin_bit_cast(float, hi << 16);
                G.bw[dir][cti][jj] = (short)((g < 2) ? hi : f2bf(rem)); } }
    return G;
}
__device__ __forceinline__ float log_sigmoid16_fast(float z) { const float e = __builtin_amdgcn_exp2f(fabsf(z) * -1.4426950409f); return (fminf(z, 0.f) - __builtin_amdgcn_logf(1.0f + e) * 0.6931471806f) * 0.0625f; }
__device__ __forceinline__ void gate_b(const GateConst& G, const bf16* P, size_t prow, int lane, f32x4 (&bv)[2][2][4], float (&tot)[2][2]) {
    const int i = lane & 15, g = lane >> 4;
    bf16x8 za[2][4];
#pragma unroll
    for (int dir = 0; dir < 2; ++dir)
#pragma unroll
        for (int tt = 0; tt < 4; ++tt) za[dir][tt] = *(const bf16x8*)(P + (prow + 16 * tt + i) * PW + CAF + 16 * dir + 8 * (g & 1));
#pragma unroll
    for (int dir = 0; dir < 2; ++dir)
#pragma unroll
        for (int cti = 0; cti < 2; ++cti) { float carry = 0.f;
#pragma unroll
            for (int q = 0; q < 4; ++q) { const int tt = dir ? 3 - q : q;
                f32x4 z = {0.f, 0.f, 0.f, 0.f}; z = __builtin_amdgcn_mfma_f32_16x16x32_bf16(za[dir][tt], G.bw[dir][cti], z, 0, 0, 0);
                float la[4];
#pragma unroll
                for (int r = 0; r < 4; ++r) la[r] = log_sigmoid16_fast(z[r] + G.bias[dir][cti]);
                float p[4];
                if (dir == 0) { p[0] = la[0]; p[1] = p[0] + la[1]; p[2] = p[1] + la[2]; p[3] = p[2] + la[3];
                    const float s = p[3]; float incl = s; const float t1 = __shfl_up(incl, 16); if (g >= 1) incl += t1; const float t2 = __shfl_up(incl, 32); if (g >= 2) incl += t2;
                    const float base = carry + (incl - s); carry += __shfl(incl, 48 + i);
                    bv[dir][cti][tt] = (f32x4){base + p[0], base + p[1], base + p[2], base + p[3]}; }
                else { p[3] = la[3]; p[2] = p[3] + la[2]; p[1] = p[2] + la[1]; p[0] = p[1] + la[0];
                    const float s = p[0]; float incl = s; const float t1 = __shfl_down(incl, 16); if (g <= 2) incl += t1; const float t2 = __shfl_down(incl, 32); if (g <= 1) incl += t2;
                    const float base = carry + (incl - s); carry += __shfl(incl, i);
                    bv[dir][cti][tt] = (f32x4){base + p[0], base + p[1], base + p[2], base + p[3]}; } }
            tot[dir][cti] = carry; }
}

constexpr int G3_ST = 0;
constexpr int G3_TOT = 8 * 16 * 144;
constexpr int G3_A = G3_TOT + 1024;
constexpr int G3_B = G3_A + 256 * 72 * 2;
static_assert(G3_B + 64 * G2_VS * 2 <= RING_BYTES && (G3_A % 16) == 0 && (G3_B % 16) == 0, "P3 LDS map");
template <int MODE>
__device__ __forceinline__ void p3v3_phase(const Frame& F, CArgs* A) {
    int tid_ = F.tid; asm volatile("" : "+v"(tid_));
    LAS unsigned char* lds = F.lds; const int tid = tid_, lane = tid & 63, wave = __builtin_amdgcn_readfirstlane(tid >> 6), i = lane & 15, g = lane >> 4;
    const bf16* P = (const bf16*)(F.ws + WS_P);
    const GateConst G = gate_setup(A, wave, lane);
    LAS unsigned char* st = lds + G3_ST + wave * (16 * 144);
#pragma unroll 1
    for (int it = F.bid; it < NBATCH * NCC; it += F.G) {
        const int b = it / NCC, cc = it % NCC; const size_t prow = chunk_row(b, cc);
        unsigned pf0 = 0u, pf1 = 0u;
#pragma unroll
        for (int j = 0; j < 8; ++j) { const int pc = tid + j * NTHREADS, t = pc >> 6, cv = pc & 63;
            *(LAS v4u*)(lds + G3_B + (t * G2_VS + cv * 8) * 2) = *(const v4u*)(P + (prow + t) * PW + CV + cv * 8); }
        unsigned kk[2][4][2];
#pragma unroll
        for (int cti = 0; cti < 2; ++cti)
#pragma unroll
            for (int tt = 0; tt < 4; ++tt)
#pragma unroll
                for (int r = 0; r < 4; r += 2) { const bf16* kp = P + (prow + 16 * tt + 4 * g + r) * PW + CK + 32 * wave + 16 * cti + i; kk[cti][tt][r >> 1] = (unsigned)kp[0] | ((unsigned)kp[PW] << 16); }
        f32x4 bv[2][2][4]; float tot[2][2];
        if (MODE < 4) gate_b(G, P, prow, lane, bv, tot); else {
#pragma unroll
            for (int a_ = 0; a_ < 2; ++a_)
#pragma unroll
                for (int b_ = 0; b_ < 2; ++b_) { tot[a_][b_] = 0.f;
#pragma unroll
                    for (int c_ = 0; c_ < 4; ++c_) bv[a_][b_][c_] = (f32x4){0.f, 0.f, 0.f, 0.f}; } }
#pragma unroll
        for (int dir = 0; dir < 2; ++dir) {
#pragma unroll
            for (int cti = 0; cti < 2; ++cti) { const int c = 32 * wave + 16 * cti + i;
#pragma unroll
                for (int tt = 0; tt < 4; ++tt) { float e[4];
#pragma unroll
                    for (int r = 0; r < 4; ++r) e[r] = ((r & 1) ? bfhi(kk[cti][tt][r >> 1]) : bflo(kk[cti][tt][r >> 1])) * __builtin_amdgcn_exp2f(bv[dir][cti][tt][r] * -1.4426950409f);
                    v2u w; w.x = pk2(e[0], e[1]); w.y = pk2(e[2], e[3]);
                    *(LAS v2u*)(lds + G3_A + (c * 72 + 16 * tt + 4 * g) * 2) = w; }
                if (g == 0) { ((LAS float*)(lds + G3_TOT))[c] = tot[dir][cti]; if (!MODE) ((float*)(F.ws + WS_DECAY))[(((size_t)dir * NBATCH + b) * NCC + cc) * 256 + c] = __expf(tot[dir][cti]); } }
            LDS_BARRIER();
            if (dir == 0) {
                const int itn = it + F.G; if (NOTOUCH3 == 0 && itn < NBATCH * NCC) { const char* pr = (const char*)(P + (chunk_row(itn / NCC, itn % NCC) + (tid >> 3)) * PW); const int j = tid & 7;
                    pf0 = *(const unsigned*)(pr + 512 + 128 * j); pf1 = *(const unsigned*)(pr + (j < 5 ? 512 + 128 * (8 + j) : 3072 + 32 * (j - 5))); } }
            if (MODE < 3) { const int h = wave >> 1, vh = wave & 1;
              bf16x8 af[4][2];
#pragma unroll
              for (int dt = 0; dt < 4; ++dt)
#pragma unroll
                  for (int ks = 0; ks < 2; ++ks) af[dt][ks] = *(const LAS bf16x8*)(lds + G3_A + ((h * 64 + dt * 16 + i) * 72 + 32 * ks + 8 * g) * 2);
              bf16* kvp = ((bf16*)(F.ws + WS_KV)) + ((((size_t)dir * NBATCH + b) * NCC + cc) * 4 + h) * 8192;
              bf16* vtp = ((bf16*)(F.ws + WS_VT)) + (((size_t)b * 64 + (cc - 4)) * 4 + h) * 8192;
              if (MODE) { kvp = ((bf16*)(F.ws + WS_TOTAL)) + (size_t)(F.bid * 8 + wave) * 512; vtp = kvp + 1024 * 1024; }
#pragma unroll
              for (int vt = 0; vt < 4; ++vt) { const int v0 = vh * 64 + vt * 16; bf16x8 vf0, vf1; tr_frag2((unsigned)(uintptr_t)(lds + G3_B), h * 128 + v0, lane, vf0, vf1);
                  if (dir == 0 && cc >= 4) {
                      *(LAS bf16x8*)(st + i * 144 + 16 * g) = vf0; *(LAS bf16x8*)(st + i * 144 + 64 + 16 * g) = vf1;
                      LDS_WAIT();
#pragma unroll
                      for (int j = 0; j < 2; ++j) { const int pc = lane + 64 * j, row = pc >> 3, ch = pc & 7; const v4u x_ = *(const LAS v4u*)(st + row * 144 + ch * 16); if (MODE == 2) asm volatile("" :: "v"(x_)); else *(v4u*)(vtp + (size_t)((MODE ? 0 : v0) + row) * 64 + ch * 8) = x_; }
                      LDS_WAIT(); }
#pragma unroll
                  for (int dt = 0; dt < 4; ++dt) { f32x4 acc = {0.f, 0.f, 0.f, 0.f};
                      acc = __builtin_amdgcn_mfma_f32_16x16x32_bf16(af[dt][0], vf0, acc, 0, 0, 0); acc = __builtin_amdgcn_mfma_f32_16x16x32_bf16(af[dt][1], vf1, acc, 0, 0, 0);
                      { const f32x4 tv = *(const LAS f32x4*)(lds + G3_TOT + (h * 64 + dt * 16 + 4 * g) * 4);
                        acc = acc * (f32x4){__builtin_amdgcn_exp2f(tv[0] * 1.4426950409f), __builtin_amdgcn_exp2f(tv[1] * 1.4426950409f), __builtin_amdgcn_exp2f(tv[2] * 1.4426950409f), __builtin_amdgcn_exp2f(tv[3] * 1.4426950409f)}; }
                      v2u w; w.x = pk2(acc[0], acc[1]); w.y = pk2(acc[2], acc[3]);
                      *(LAS v2u*)(st + i * 144 + (16 * dt + 4 * g) * 2) = w; }
                  LDS_WAIT();
#pragma unroll
                  for (int j = 0; j < 2; ++j) { const int pc = lane + 64 * j, row = pc >> 3, ch = pc & 7; const v4u x_ = *(const LAS v4u*)(st + row * 144 + ch * 16); if (MODE == 2) asm volatile("" :: "v"(x_)); else *(v4u*)(kvp + (size_t)((MODE ? 0 : v0) + row) * 64 + ch * 8) = x_; }
                  LDS_WAIT(); } }
            LDS_BARRIER();
        }
        asm volatile("" :: "v"(pf0), "v"(pf1));
    }
}

struct ConvRegs { v4u cw[6], xw[6], bw[4]; };
__device__ __forceinline__ void conv_load(const bf16* P, int u, int t, ConvRegs& R) {
    const int item = u >> 1, b = item >> 6, n = item & 63; const size_t prow = (size_t)b * SEQ + n * 64; const int t0 = (u & 1) * 32 + (t >> 6) * 4, c0 = (t & 63) * 8;
#pragma unroll
    for (int q = 0; q < 6; ++q) { const int tt = t0 - 1 + q, tc = tt < 0 ? 0 : (tt > 63 ? 63 : tt);
        R.cw[q] = *(const v4u*)(P + (prow + tc) * PW + CPC + c0); R.xw[q] = *(const v4u*)(P + (prow + tc) * PW + CPX + c0); }
#pragma unroll
    for (int q = 0; q < 4; ++q) R.bw[q] = *(const v4u*)(P + (prow + t0 + q) * PW + CPB + c0);
}
__device__ __forceinline__ void conv_pin(ConvRegs& R) {
    asm volatile("" ::: "memory");
#pragma unroll
    for (int q = 0; q < 6; ++q) { asm volatile("" : "+v"(R.cw[q])); asm volatile("" : "+v"(R.xw[q])); }
#pragma unroll
    for (int q = 0; q < 4; ++q) asm volatile("" : "+v"(R.bw[q]));
}
__device__ __forceinline__ void conv_emit(unsigned char* ws, const f32x2 (&w2)[3][4], int u, int t, const ConvRegs& R) {
    const int item = u >> 1, b = item >> 6, n = item & 63; const size_t prow = (size_t)b * SEQ + n * 64; const int t0 = (u & 1) * 32 + (t >> 6) * 4, c0 = (t & 63) * 8;
    f32x2 ov[4][4];
#pragma unroll
    for (int j = 0; j < 4; ++j)
#pragma unroll
        for (int p = 0; p < 4; ++p) ov[j][p] = (f32x2){0.f, 0.f};
#pragma unroll
    for (int q = 0; q < 6; ++q) { const int tt = t0 - 1 + q; const bool in = tt >= 0 && tt < 64; v4u c_ = R.cw[q]; const v4u x_ = R.xw[q]; f32x2 uu[4];
        c_.x = in ? c_.x : 0u; c_.y = in ? c_.y : 0u; c_.z = in ? c_.z : 0u; c_.w = in ? c_.w : 0u;
        uu[0] = (f32x2){bflo(c_.x), bfhi(c_.x)} * (f32x2){bflo(x_.x), bfhi(x_.x)}; uu[1] = (f32x2){bflo(c_.y), bfhi(c_.y)} * (f32x2){bflo(x_.y), bfhi(x_.y)};
        uu[2] = (f32x2){bflo(c_.z), bfhi(c_.z)} * (f32x2){bflo(x_.z), bfhi(x_.z)}; uu[3] = (f32x2){bflo(c_.w), bfhi(c_.w)} * (f32x2){bflo(x_.w), bfhi(x_.w)};
#pragma unroll
        for (int dt = 0; dt < 3; ++dt) { const int j = q - dt;
            if (j >= 0 && j < 4) {
#pragma unroll
                for (int p = 0; p < 4; ++p) ov[j][p] += w2[dt][p] * uu[p]; } } }
#pragma unroll
    for (int q = 0; q < 4; ++q) { const v4u b_ = R.bw[q];
        const f32x2 y0 = ov[q][0] * (f32x2){bflo(b_.x), bfhi(b_.x)}, y1 = ov[q][1] * (f32x2){bflo(b_.y), bfhi(b_.y)}, y2 = ov[q][2] * (f32x2){bflo(b_.z), bfhi(b_.z)}, y3 = ov[q][3] * (f32x2){bflo(b_.w), bfhi(b_.w)};
        if (OUTPROJ_F8) { v2u w; w.x = pk4_fp8(y0.x, y0.y, y1.x, y1.y); w.y = pk4_fp8(y2.x, y2.y, y3.x, y3.y);
            *(v2u*)(ws + WS_YMIX + (prow + t0 + q) * D + 512 + c0) = w; }
        else { v4u w; w.x = pk2(y0.x, y0.y); w.y = pk2(y1.x, y1.y); w.z = pk2(y2.x, y2.y); w.w = pk2(y3.x, y3.y);
            *(v4u*)(((bf16*)(ws + WS_YMIX)) + (prow + t0 + q) * D + 512 + c0) = w; } }
}
__device__ __forceinline__ void conv_stream(const Frame& F, CArgs* A, int t) {
    const bf16* P = (const bf16*)(F.ws + WS_P);
    constexpr int NU = NBATCH * 64 * 2;
    f32x2 w2[3][4];
    { const int c0 = (t & 63) * 8;
#pragma unroll
      for (int dt = 0; dt < 3; ++dt) { const f32x4 a = *(const f32x4*)(A->in[13] + dt * 512 + c0), b = *(const f32x4*)(A->in[13] + dt * 512 + c0 + 4);
          w2[dt][0] = (f32x2){a[0], a[1]}; w2[dt][1] = (f32x2){a[2], a[3]}; w2[dt][2] = (f32x2){b[0], b[1]}; w2[dt][3] = (f32x2){b[2], b[3]}; } }
    ConvRegs Ra, Rb;
    int u = F.bid;
    if (u < NU) conv_load(P, u, t, Ra);
#pragma unroll 1
    for (; u < NU; u += 2 * F.G) {
        const int un = (u + F.G < NU) ? u + F.G : u, un2 = (u + 2 * F.G < NU) ? u + 2 * F.G : u;
        conv_load(P, un, t, Rb); conv_pin(Ra);
        conv_emit(F.ws, w2, u, t, Ra);
        conv_load(P, un2, t, Ra); conv_pin(Rb);
        conv_emit(F.ws, w2, un, t, Rb);
    }
}

__device__ __forceinline__ void gate_b_dir(const GateConst& G, const bf16* P, size_t prow, int lane, int dir, f32x4 (&bv)[2][4]) {
    const int i = lane & 15, g = lane >> 4;
    bf16x8 za[4];
#pragma unroll
    for (int tt = 0; tt < 4; ++tt) za[tt] = *(const bf16x8*)(P + (prow + 16 * tt + i) * PW + CAF + 16 * dir + 8 * (g & 1));
#pragma unroll
    for (int cti = 0; cti < 2; ++cti) { float carry = 0.f;
#pragma unroll
        for (int q = 0; q < 4; ++q) { const int tt = dir ? 3 - q : q;
            f32x4 z = {0.f, 0.f, 0.f, 0.f}; z = __builtin_amdgcn_mfma_f32_16x16x32_bf16(za[tt], G.bw[dir][cti], z, 0, 0, 0);
            float la[4];
#pragma unroll
            for (int r = 0; r < 4; ++r) la[r] = log_sigmoid16_fast(z[r] + G.bias[dir][cti]);
            float p[4];
            if (dir == 0) { p[0] = la[0]; p[1] = p[0] + la[1]; p[2] = p[1] + la[2]; p[3] = p[2] + la[3];
                const float s = p[3]; float incl = s; const float t1 = __shfl_up(incl, 16); if (g >= 1) incl += t1; const float t2 = __shfl_up(incl, 32); if (g >= 2) incl += t2;
                const float base = carry + (incl - s); carry += __shfl(incl, 48 + i);
                bv[cti][tt] = (f32x4){base + p[0], base + p[1], base + p[2], base + p[3]}; }
            else { p[3] = la[3]; p[2] = p[3] + la[2]; p[1] = p[2] + la[1]; p[0] = p[1] + la[0];
                const float s = p[0]; float incl = s; const float t1 = __shfl_down(incl, 16); if (g <= 2) incl += t1; const float t2 = __shfl_down(incl, 32); if (g <= 1) incl += t2;
                const float base = carry + (incl - s); carry += __shfl(incl, i);
                bv[cti][tt] = (f32x4){base + p[0], base + p[1], base + p[2], base + p[3]}; } } }
}

constexpr int G5_Q = 0;
constexpr int G5_K = 4 * 64 * 72 * 2;
constexpr int G5_P = 2 * G5_K;
constexpr int G5_GW = 131072 + 12288;
static_assert(G5_P + 4 * 64 * 72 * 2 <= RING_BYTES && 8 * 16 * 272 <= G5_K, "P5 LDS map");
template <int MODE>
__device__ __forceinline__ void p5av3_phase(const Frame& F, CArgs* A) {
    LAS unsigned char* lds = F.lds;
    const bf16* P = (const bf16*)(F.ws + WS_P);
    const GateConst G = gate_setup(A, F.wave, F.lane);
    if (F.tid < 32) *(LAS f32x4*)(lds + G5_GW + F.tid * 16) = *(const f32x4*)(A->in[12] + F.tid * 4);
    __syncthreads();
#pragma unroll 1
    for (int it = F.bid; it < NBATCH * 64; it += F.G) {
        int tid_ = F.tid; asm volatile("" : "+v"(tid_));
        const int tid = tid_, lane = tid & 63, wave = __builtin_amdgcn_readfirstlane(tid >> 6), i = lane & 15, g = lane >> 4;
        const int h = wave >> 1, half = wave & 1;
        LAS unsigned char* st = lds + G5_Q + wave * (16 * 272);
        const int b = it >> 6, n = it & 63; const size_t prow = (size_t)b * SEQ + n * 64;
        unsigned pfv[9];
#pragma unroll
        for (int q = 0; q < 9; ++q) pfv[q] = 0u;
        const int dh = 32 * half + i;
        f32x4 pdiag[2], oacc[2][8];
#pragma unroll
        for (int a = 0; a < 2; ++a) { pdiag[a] = (f32x4){0.f, 0.f, 0.f, 0.f};
#pragma unroll
            for (int q = 0; q < 8; ++q) oacc[a][q] = (f32x4){0.f, 0.f, 0.f, 0.f}; }
#pragma unroll
        for (int dir = 0; dir < (MODE >= 4 ? 0 : 2); ++dir) {
            { unsigned qk[2][4][4];
#pragma unroll
              for (int cti = 0; cti < 2; ++cti)
#pragma unroll
                  for (int tt = 0; tt < 4; ++tt)
#pragma unroll
                      for (int r = 0; r < 4; ++r) { const bf16* rp = P + (prow + 16 * tt + 4 * g + r) * PW + h * 64 + dh + 16 * cti; qk[cti][tt][r] = (unsigned)rp[CQ] | ((unsigned)rp[CK] << 16); }
              f32x4 bv[2][4]; gate_b_dir(G, P, prow, lane, dir, bv);
#pragma unroll
              for (int cti = 0; cti < 2; ++cti)
#pragma unroll
                  for (int tt = 0; tt < 4; ++tt)
#pragma unroll
                      for (int r = 0; r < 4; ++r) { const float e = __builtin_amdgcn_exp2f(bv[cti][tt][r] * 1.4426950409f); const unsigned w = qk[cti][tt][r];
                          const int off = ((h * 64 + 16 * tt + 4 * g + r) * 72 + dh + 16 * cti) * 2;
                          *(LAS bf16*)(lds + G5_Q + off) = (bf16)f2bf(bflo(w) * e * 0.125f); *(LAS bf16*)(lds + G5_K + off) = (bf16)f2bf(bfhi(w) * __builtin_amdgcn_rcpf(e)); } }
            LDS_BARRIER();
            if (MODE < 3) { bf16x8 qf[2][2];
#pragma unroll
              for (int tti = 0; tti < 2; ++tti)
#pragma unroll
                  for (int ks = 0; ks < 2; ++ks) qf[tti][ks] = *(const LAS bf16x8*)(lds + G5_Q + ((h * 64 + (2 * half + tti) * 16 + i) * 72 + 32 * ks + 8 * g) * 2);
              const bf16* sp = ((const bf16*)(F.ws + WS_S)) + ((((size_t)dir * NBATCH + b) * 64 + n) * 4 + h) * 8192 + (size_t)i * 64 + 8 * g;
#pragma unroll
              for (int st_ = 0; st_ < 4; ++st_) { const bf16x8 kf0 = *(const LAS bf16x8*)(lds + G5_K + ((h * 64 + st_ * 16 + i) * 72 + 8 * g) * 2), kf1 = *(const LAS bf16x8*)(lds + G5_K + ((h * 64 + st_ * 16 + i) * 72 + 32 + 8 * g) * 2);
#pragma unroll
                  for (int tti = 0; tti < 2; ++tti) { const int tt = 2 * half + tti;
                      if (dir == 0 ? (st_ <= tt) : (st_ >= tt)) { f32x4 a = {0.f, 0.f, 0.f, 0.f};
                          a = __builtin_amdgcn_mfma_f32_16x16x32_bf16(kf0, qf[tti][0], a, 0, 0, 0); a = __builtin_amdgcn_mfma_f32_16x16x32_bf16(kf1, qf[tti][1], a, 0, 0, 0);
                          const int t = tt * 16 + i, s0 = st_ * 16 + 4 * g;
                          if (st_ == tt) {
#pragma unroll
                              for (int r = 0; r < 4; ++r) pdiag[tti][r] += (dir == 0 ? (s0 + r <= t) : (s0 + r >= t)) ? a[r] : 0.f;
                              a = pdiag[tti]; }
                          if (st_ != tt || dir == 1) { v2u w; w.x = pk2(a[0], a[1]); w.y = pk2(a[2], a[3]);
                              *(LAS v2u*)(lds + G5_P + ((h * 64 + t) * 72 + s0) * 2) = w; } } } }
              bf16x8 sfr[4][2];
#pragma unroll
              for (int vt = 0; vt < 4; ++vt) { sfr[vt][0] = *(const bf16x8*)(sp + (size_t)vt * 1024); sfr[vt][1] = *(const bf16x8*)(sp + (size_t)vt * 1024 + 32); }
#pragma unroll
              for (int vt = 0; vt < 8; ++vt) {
#pragma unroll
                  for (int tti = 0; tti < 2; ++tti) { oacc[tti][vt] = __builtin_amdgcn_mfma_f32_16x16x32_bf16(sfr[vt & 3][0], qf[tti][0], oacc[tti][vt], 0, 0, 0); oacc[tti][vt] = __builtin_amdgcn_mfma_f32_16x16x32_bf16(sfr[vt & 3][1], qf[tti][1], oacc[tti][vt], 0, 0, 0); }
                  asm volatile("" : "+v"(oacc[0][vt]), "+v"(oacc[1][vt]) :: "memory");
                  if (vt < 4) { sfr[vt][0] = *(const bf16x8*)(sp + (size_t)(vt + 4) * 1024); sfr[vt][1] = *(const bf16x8*)(sp + (size_t)(vt + 4) * 1024 + 32); } } }
            LDS_BARRIER();
        }
        LDS_WAIT();
        v2u rwv[2][8];
        if (MODE < 2) {
#pragma unroll
            for (int tti = 0; tti < 2; ++tti)
#pragma unroll
                for (int vt = 0; vt < 8; ++vt) rwv[tti][vt] = *(const v2u*)(P + (prow + (2 * half + tti) * 16 + i) * PW + CR + h * 128 + vt * 16 + 4 * g); }
        if (MODE < 2) { bf16x8 pfr[2][2];
#pragma unroll
          for (int tti = 0; tti < 2; ++tti)
#pragma unroll
              for (int ks = 0; ks < 2; ++ks) pfr[tti][ks] = *(const LAS bf16x8*)(lds + G5_P + ((h * 64 + (2 * half + tti) * 16 + i) * 72 + 32 * ks + 8 * g) * 2);
          const bf16* vp = ((const bf16*)(F.ws + WS_VT)) + (((size_t)b * 64 + n) * 4 + h) * 8192 + (size_t)i * 64 + 8 * g;
          bf16x8 vfr[8][2];
#pragma unroll
          for (int vt = 0; vt < 8; ++vt) { vfr[vt][0] = *(const bf16x8*)(vp + (size_t)vt * 1024); vfr[vt][1] = *(const bf16x8*)(vp + (size_t)vt * 1024 + 32); }
          { const int itn = it + F.G; if (NOTOUCH5 == 0 && itn < NBATCH * 64) { const int bn_ = itn >> 6, nn_ = itn & 63; const char* pr = (const char*)(P + ((size_t)bn_ * SEQ + nn_ * 64 + (tid >> 3)) * PW); const int j = tid & 7;
                pfv[0] = *(const unsigned*)(pr + 128 * j); pfv[1] = *(const unsigned*)(pr + 2048 + 128 * j); if (j == 0) pfv[2] = *(const unsigned*)(pr + 3072);
                const char* sb = (const char*)(((const bf16*)(F.ws + WS_S)) + (((size_t)bn_ * 64 + nn_) * 4) * 8192) + (size_t)tid * 128;
                pfv[6] = *(const unsigned*)sb; pfv[7] = *(const unsigned*)(sb + (size_t)NBATCH * 64 * 4 * 8192 * 2);
                pfv[8] = *(const unsigned*)((const char*)(((const bf16*)(F.ws + WS_VT)) + (((size_t)bn_ * 64 + nn_) * 4) * 8192) + (size_t)tid * 128); } }
#pragma unroll
          for (int vt = 0; vt < 8; ++vt)
#pragma unroll
              for (int tti = 0; tti < 2; ++tti) { oacc[tti][vt] = __builtin_amdgcn_mfma_f32_16x16x32_bf16(vfr[vt][0], pfr[tti][0], oacc[tti][vt], 0, 0, 0); oacc[tti][vt] = __builtin_amdgcn_mfma_f32_16x16x32_bf16(vfr[vt][1], pfr[tti][1], oacc[tti][vt], 0, 0, 0); } }
#pragma unroll
        for (int tti = 0; tti < (MODE >= 2 ? 0 : 2); ++tti) { const int t = (2 * half + tti) * 16 + i; float ss = 0.f;
#pragma unroll
            for (int vt = 0; vt < 8; ++vt) { const f32x4 a = oacc[tti][vt]; ss += (a[0] * a[0] + a[1] * a[1]) + (a[2] * a[2] + a[3] * a[3]); }
            ss += __shfl_xor(ss, 16); ss += __shfl_xor(ss, 32);
            const float rstd = 1.0f / sqrtf(ss * (1.0f / 128.0f) + EPS);
#pragma unroll
            for (int vt = 0; vt < 8; ++vt) { const int v = vt * 16 + 4 * g; const f32x4 gw = *(const LAS f32x4*)(lds + G5_GW + v * 4); const v2u rw = rwv[tti][vt];
                const float r[4] = {bflo(rw.x), bfhi(rw.x), bflo(rw.y), bfhi(rw.y)}; float y[4];
#pragma unroll
                for (int j = 0; j < 4; ++j) y[j] = oacc[tti][vt][j] * rstd * gw[j] * (r[j] * __builtin_amdgcn_rcpf(1.0f + __builtin_amdgcn_exp2f(r[j] * -1.4426950409f)));
                if (OUTPROJ_F8) *(LAS unsigned*)(st + i * 144 + v) = pk4_fp8(y[0], y[1], y[2], y[3]);
                else { v2u w; w.x = pk2(y[0], y[1]); w.y = pk2(y[2], y[3]);
                    *(LAS v2u*)(st + i * 272 + v * 2) = w; }
                if ((vt & 3) == 3) asm volatile("" ::: "memory"); }
            LDS_WAIT();
            if (OUTPROJ_F8) {
#pragma unroll
                for (int j = 0; j < 2; ++j) { const int pc = lane + 64 * j, row = pc >> 3, ch = pc & 7;
                    *(v4u*)(F.ws + WS_YMIX + (prow + (2 * half + tti) * 16 + row) * D + h * 128 + ch * 16) = *(const LAS v4u*)(st + row * 144 + ch * 16); } }
            else {
#pragma unroll
                for (int j = 0; j < 4; ++j) { const int pc = lane + 64 * j, row = pc >> 4, ch = pc & 15;
                    *(v4u*)(((bf16*)(F.ws + WS_YMIX)) + (prow + (2 * half + tti) * 16 + row) * D + h * 128 + ch * 8) = *(const LAS v4u*)(st + row * 272 + ch * 16); } }
            LDS_WAIT(); }
#pragma unroll
        for (int q = 0; q < 9; ++q) asm volatile("" :: "v"(pfv[q]));
        LDS_BARRIER();
    }
    if (MODE < 1) { int tc_ = F.tid; asm volatile("" : "+v"(tc_)); conv_stream(F, A, tc_); }
}

__device__ __forceinline__ void p4_phase(const Frame& F, CArgs* A) {
    int tid_ = threadIdx.x; asm volatile("" : "+v"(tid_));
    const int tid = tid_;
    for (int idx = F.bid * NTHREADS + tid; idx < 2 * NBATCH * 4 * 1024; idx += F.G * NTHREADS) {
        const int e8 = idx & 1023, ch = idx >> 10, h = ch & 3, b = (ch >> 2) & 15, dir = ch >> 6; const int d0 = (e8 & 7) * 8;
        float s[8];
#pragma unroll
        for (int j = 0; j < 8; ++j) s[j] = 0.f;
#pragma unroll 17
        for (int st = 0; st < NCC; ++st) {
            const int cc = dir ? (st < 4 ? 3 - st : 71 - st) : st;
            const size_t ci = ((size_t)dir * NBATCH + b) * NCC + cc;
            const v4u kv = *(const v4u*)(((bf16*)(F.ws + WS_KV)) + (ci * 4 + h) * 8192 + (size_t)e8 * 8);
            const f32x4 dc0 = *(const f32x4*)(((float*)(F.ws + WS_DECAY)) + ci * 256 + h * 64 + d0), dc1 = *(const f32x4*)(((float*)(F.ws + WS_DECAY)) + ci * 256 + h * 64 + d0 + 4);
            if (cc >= 4) { v4u w; w.x = pk2(s[0], s[1]); w.y = pk2(s[2], s[3]); w.z = pk2(s[4], s[5]); w.w = pk2(s[6], s[7]);
                *(v4u*)(((bf16*)(F.ws + WS_S)) + ((((size_t)dir * NBATCH + b) * 64 + (cc - 4)) * 4 + h) * 8192 + (size_t)e8 * 8) = w; }
            s[0] = s[0] * dc0[0] + bflo(kv.x); s[1] = s[1] * dc0[1] + bfhi(kv.x); s[2] = s[2] * dc0[2] + bflo(kv.y); s[3] = s[3] * dc0[3] + bfhi(kv.y);
            s[4] = s[4] * dc1[0] + bflo(kv.z); s[5] = s[5] * dc1[1] + bfhi(kv.z); s[6] = s[6] * dc1[2] + bflo(kv.w); s[7] = s[7] * dc1[3] + bfhi(kv.w);
        }
    }
}

__device__ __forceinline__ void p5a_phase(const Frame& F, CArgs* A) {
    LAS unsigned char* lds = F.lds; const int tid = F.tid, lane = F.lane, wave = F.wave, i = lane & 15, g = lane >> 4;
    GlaRegs cur; if (F.bid < NBATCH * 64 * 4) cur = gla_load(F, (size_t)(F.bid >> 2) * 64, F.bid & 3);
    f32x4 gw[4];
#pragma unroll
    for (int k = 0; k < 4; ++k) gw[k] = *(const f32x4*)(A->in[12] + ((wave >> 2) * 4 + k) * 16 + 4 * g);
    for (int it = F.bid; it < NBATCH * 64 * 4; it += F.G) {
        const int h = it & 3, bn = it >> 2, b = bn >> 6, n = bn & 63; const size_t prow = (size_t)b * SEQ + n * 64;
        GlaRegs nxt = cur; { const int itn = it + F.G; if (itn < NBATCH * 64 * 4) nxt = gla_load(F, (size_t)(itn >> 2) * 64, itn & 3); }
        v4u qw, kw; { const int t = tid >> 3, d0 = (tid & 7) * 8; qw = *(const v4u*)(((bf16*)(F.ws + WS_P)) + (prow + t) * PW + CQ + h * 64 + d0); kw = *(const v4u*)(((bf16*)(F.ws + WS_P)) + (prow + t) * PW + CK + h * 64 + d0); }
        gla_prep(F, A, cur, h); cur = nxt;
        bf16x8 sfr[4][2][2]; v2u rwv[4];
        { const int tt = wave & 3, vh = wave >> 2, t = tt * 16 + i;
#pragma unroll
          for (int k = 0; k < 4; ++k) { const int vt = vh * 4 + k;
#pragma unroll
              for (int dir = 0; dir < 2; ++dir) { const bf16* sp = ((bf16*)(F.ws + WS_S)) + ((((size_t)dir * NBATCH + b) * 64 + n) * 4 + h) * 8192 + (size_t)(vt * 16 + i) * 64 + 8 * g;
                  sfr[k][dir][0] = *(const bf16x8*)sp; sfr[k][dir][1] = *(const bf16x8*)(sp + 32); }
              rwv[k] = *(const v2u*)(((bf16*)(F.ws + WS_P)) + (prow + t) * PW + CR + h * 128 + vt * 16 + 4 * g); } }
        { const int t = tid >> 3, d0 = (tid & 7) * 8;
          const float q[8] = {bflo(qw.x), bfhi(qw.x), bflo(qw.y), bfhi(qw.y), bflo(qw.z), bfhi(qw.z), bflo(qw.w), bfhi(qw.w)};
          const float k[8] = {bflo(kw.x), bfhi(kw.x), bflo(kw.y), bfhi(kw.y), bflo(kw.z), bfhi(kw.z), bflo(kw.w), bfhi(kw.w)};
#pragma unroll
          for (int dir = 0; dir < 2; ++dir) { const LAS float* bp = (const LAS float*)(lds + GL_BC) + dir * 4096 + t * 64 + d0;
              const f32x4 b0 = *(const LAS f32x4*)bp, b1 = *(const LAS f32x4*)(bp + 4); const float bb[8] = {b0[0], b0[1], b0[2], b0[3], b1[0], b1[1], b1[2], b1[3]};
              float qd[8], ki[8];
#pragma unroll
              for (int j = 0; j < 8; ++j) { qd[j] = q[j] * __expf(bb[j]) * 0.125f; ki[j] = k[j] * __expf(-bb[j]); }
              v4u w; w.x = pk2(qd[0], qd[1]); w.y = pk2(qd[2], qd[3]); w.z = pk2(qd[4], qd[5]); w.w = pk2(qd[6], qd[7]);
              *(LAS v4u*)(lds + GL_A + ((dir * 64 + t) * 72 + d0) * 2) = w;
              w.x = pk2(ki[0], ki[1]); w.y = pk2(ki[2], ki[3]); w.z = pk2(ki[4], ki[5]); w.w = pk2(ki[6], ki[7]);
              *(LAS v4u*)(lds + GL_B + ((dir * 64 + t) * 72 + d0) * 2) = w; } }
        __syncthreads();
#pragma unroll
        for (int kk = 0; kk < 2; ++kk) { const int pi = wave * 2 + kk, tt = pi >> 2, st = pi & 3;
            f32x4 aF = {0.f, 0.f, 0.f, 0.f}, aB = {0.f, 0.f, 0.f, 0.f};
            if (st <= tt) {
#pragma unroll
                for (int ks = 0; ks < 2; ++ks) { const bf16x8 kf = *(const LAS bf16x8*)(lds + GL_B + ((st * 16 + i) * 72 + 32 * ks + 8 * g) * 2), qf = *(const LAS bf16x8*)(lds + GL_A + ((tt * 16 + i) * 72 + 32 * ks + 8 * g) * 2);
                    aF = __builtin_amdgcn_mfma_f32_16x16x32_bf16(kf, qf, aF, 0, 0, 0); } }
            if (st >= tt) {
#pragma unroll
                for (int ks = 0; ks < 2; ++ks) { const bf16x8 kf = *(const LAS bf16x8*)(lds + GL_B + ((64 + st * 16 + i) * 72 + 32 * ks + 8 * g) * 2), qf = *(const LAS bf16x8*)(lds + GL_A + ((64 + tt * 16 + i) * 72 + 32 * ks + 8 * g) * 2);
                    aB = __builtin_amdgcn_mfma_f32_16x16x32_bf16(kf, qf, aB, 0, 0, 0); } }
            const int t = tt * 16 + i, s0 = st * 16 + 4 * g; float p[4];
#pragma unroll
            for (int r = 0; r < 4; ++r) p[r] = ((s0 + r <= t) ? aF[r] : 0.f) + ((s0 + r >= t) ? aB[r] : 0.f);
            v2u w; w.x = pk2(p[0], p[1]); w.y = pk2(p[2], p[3]);
            *(LAS v2u*)(lds + GL_P + (t * 72 + s0) * 2) = w; }
        __syncthreads();
        { const int tt = wave & 3, vh = wave >> 2; const int t = tt * 16 + i;
          bf16x8 pf[2], qf[2][2];
#pragma unroll
          for (int ks = 0; ks < 2; ++ks) { pf[ks] = *(const LAS bf16x8*)(lds + GL_P + (t * 72 + 32 * ks + 8 * g) * 2);
              qf[0][ks] = *(const LAS bf16x8*)(lds + GL_A + (t * 72 + 32 * ks + 8 * g) * 2); qf[1][ks] = *(const LAS bf16x8*)(lds + GL_A + ((64 + t) * 72 + 32 * ks + 8 * g) * 2); }
          f32x4 acc[4]; float ss = 0.f;
#pragma unroll
          for (int k = 0; k < 4; ++k) { const int vt = vh * 4 + k; f32x4 a = {0.f, 0.f, 0.f, 0.f};
              { bf16x8 vf0, vf1; v_frag2(lds, vt * 16, lane, vf0, vf1); a = __builtin_amdgcn_mfma_f32_16x16x32_bf16(vf0, pf[0], a, 0, 0, 0); a = __builtin_amdgcn_mfma_f32_16x16x32_bf16(vf1, pf[1], a, 0, 0, 0); }
#pragma unroll
              for (int dir = 0; dir < 2; ++dir)
#pragma unroll
                  for (int ks = 0; ks < 2; ++ks) a = __builtin_amdgcn_mfma_f32_16x16x32_bf16(sfr[k][dir][ks], qf[dir][ks], a, 0, 0, 0);
              acc[k] = a; ss += (a[0] * a[0] + a[1] * a[1]) + (a[2] * a[2] + a[3] * a[3]); }
          ss += __shfl_xor(ss, 16); ss += __shfl_xor(ss, 32);
          if (g == 0) ((LAS float*)(lds + GL_SS))[vh * 64 + t] = ss;
          __syncthreads();
          const float tot = ((const LAS float*)(lds + GL_SS))[t] + ((const LAS float*)(lds + GL_SS))[64 + t];
          const float rstd = 1.0f / sqrtf(tot * (1.0f / 128.0f) + EPS);
#pragma unroll
          for (int k = 0; k < 4; ++k) { const int v = (vh * 4 + k) * 16 + 4 * g;
              const v2u rw = rwv[k];
              const float r[4] = {bflo(rw.x), bfhi(rw.x), bflo(rw.y), bfhi(rw.y)}; float y[4];
#pragma unroll
              for (int j = 0; j < 4; ++j) y[j] = acc[k][j] * rstd * gw[k][j] * (r[j] * __builtin_amdgcn_rcpf(1.0f + __expf(-r[j])));
              v2u w; w.x = pk2(y[0], y[1]); w.y = pk2(y[2], y[3]);
              *(v2u*)(((bf16*)(F.ws + WS_YMIX)) + (prow + t) * D + h * 128 + v) = w; } }
        __syncthreads();
    }
    for (int it = F.bid; it < NBATCH * 64; it += F.G) {
        const size_t prow = (size_t)it * 64;
#pragma unroll 1
        for (int rep = 0; rep < 8; ++rep) { const int idx = tid + rep * NTHREADS, t = idx >> 6, c0 = (idx & 63) * 8;
            float cv[8];
#pragma unroll
            for (int j = 0; j < 8; ++j) cv[j] = 0.f;
#pragma unroll
            for (int dt = -1; dt <= 1; ++dt) { const int tt = t + dt; if (tt >= 0 && tt < 64) {
                const v4u cw = *(const v4u*)(((bf16*)(F.ws + WS_P)) + (prow + tt) * PW + CPC + c0), xw = *(const v4u*)(((bf16*)(F.ws + WS_P)) + (prow + tt) * PW + CPX + c0);
                const f32x4 w0 = *(const f32x4*)(A->in[13] + (dt + 1) * 512 + c0), w1 = *(const f32x4*)(A->in[13] + (dt + 1) * 512 + c0 + 4);
                cv[0] += w0[0] * bflo(cw.x) * bflo(xw.x); cv[1] += w0[1] * bfhi(cw.x) * bfhi(xw.x); cv[2] += w0[2] * bflo(cw.y) * bflo(xw.y); cv[3] += w0[3] * bfhi(cw.y) * bfhi(xw.y);
                cv[4] += w1[0] * bflo(cw.z) * bflo(xw.z); cv[5] += w1[1] * bfhi(cw.z) * bfhi(xw.z); cv[6] += w1[2] * bflo(cw.w) * bflo(xw.w); cv[7] += w1[3] * bfhi(cw.w) * bfhi(xw.w); } }
            const v4u bw = *(const v4u*)(((bf16*)(F.ws + WS_P)) + (prow + t) * PW + CPB + c0);
            v4u w; w.x = pk2(cv[0] * bflo(bw.x), cv[1] * bfhi(bw.x)); w.y = pk2(cv[2] * bflo(bw.y), cv[3] * bfhi(bw.y)); w.z = pk2(cv[4] * bflo(bw.z), cv[5] * bfhi(bw.z)); w.w = pk2(cv[6] * bflo(bw.w), cv[7] * bfhi(bw.w));
            *(v4u*)(((bf16*)(F.ws + WS_YMIX)) + (prow + t) * D + 512 + c0) = w; }
    }
}

constexpr int RT_W = 0;
constexpr int RT_LG = 32 * 1032 * 2;
constexpr int RT_HIST = RT_LG + 128 * 33 * 4;
constexpr int RT_WC = RT_HIST + 256;
__device__ __forceinline__ void p5c_phase(const Frame& F, CArgs* A) {
    LAS unsigned char* lds = F.lds; const int tid = F.tid, lane = F.lane, wave = F.wave, i = lane & 15, g = lane >> 4;
#pragma unroll 1
    for (int i0 = 0; i0 < 32768; i0 += 16 * NTHREADS) { float rv[16];
#pragma unroll
        for (int q = 0; q < 16; ++q) rv[q] = A->in[16][i0 + q * NTHREADS + tid];
#pragma unroll
        for (int q = 0; q < 16; ++q) { const int idx = i0 + q * NTHREADS + tid, k = idx >> 5, e = idx & 31; *(LAS bf16*)(lds + RT_W + (e * 1032 + k) * 2) = (bf16)f2bf(rv[q]); } }
    LAS int* hist = (LAS int*)(lds + RT_HIST); LAS float* lg = (LAS float*)(lds + RT_LG);
    unsigned* gcnt = ((unsigned*)(F.ws + WS_CTL)) + CW_CNT;
    __syncthreads();
#pragma unroll 1
    for (int it = F.bid; it < NLAT / 128; it += F.G) {
        const int R = it * 128 + wave * 16 + i, b = it >> 5;
        const bf16* yg = ((const bf16*)(F.ws + WS_Y1)) + (size_t)R * D + 8 * g;
        unsigned char* hn2g = (unsigned char*)F.out + DO_HN2 + (size_t)R * D + 8 * g;
        const LAS unsigned char* rw0 = lds + RT_W + (i * 1032 + 8 * g) * 2; const LAS unsigned char* rw1 = rw0 + 16 * 1032 * 2;
        if (tid < 32) hist[tid] = 0;
        { const int c0 = 2 * tid; const f32x2 w_ = *(const f32x2*)(A->in[15] + c0), c_ = *(const f32x2*)(((float*)(F.ws + WS_MOD)) + (size_t)b * 6144 + 4096 + c0), s_ = *(const f32x2*)(((float*)(F.ws + WS_MOD)) + (size_t)b * 6144 + 3072 + c0);
          *(LAS f32x2*)(lds + RT_WC + c0 * 4) = w_ * (c_ + 1.0f); *(LAS f32x2*)(lds + RT_WC + 4096 + c0 * 4) = s_; }
        v4u yv[32];
#pragma unroll
        for (int ks = 0; ks < 32; ++ks) yv[ks] = *(const v4u*)(yg + 32 * ks);
        float ss = 0.f;
#pragma unroll
        for (int ks = 0; ks < 32; ++ks) { const v4u yw = yv[ks];
            const float h0 = bflo(yw.x), h1 = bfhi(yw.x), h2 = bflo(yw.y), h3 = bfhi(yw.y), h4 = bflo(yw.z), h5 = bfhi(yw.z), h6 = bflo(yw.w), h7 = bfhi(yw.w);
            ss += (h0 * h0 + h1 * h1) + (h2 * h2 + h3 * h3) + (h4 * h4 + h5 * h5) + (h6 * h6 + h7 * h7); }
        ss += __shfl_xor(ss, 16); ss += __shfl_xor(ss, 32);
        const float rstd = 1.0f / sqrtf(ss * (1.f / D) + EPS);
#pragma unroll
        for (int ks = 0; ks < 32; ++ks) asm volatile("" : "+v"(yv[ks]));
        LDS_BARRIER();
        f32x4 l0 = {0.f, 0.f, 0.f, 0.f}, l1 = {0.f, 0.f, 0.f, 0.f};
        const LAS unsigned char* wcg = lds + RT_WC + 32 * g;
#pragma unroll
        for (int ks = 0; ks < 32; ++ks) {
            const v4u yw = yv[ks];
            const f32x4 a0 = {bflo(yw.x), bfhi(yw.x), bflo(yw.y), bfhi(yw.y)}, a1 = {bflo(yw.z), bfhi(yw.z), bflo(yw.w), bfhi(yw.w)};
            const f32x4 c0 = *(const LAS f32x4*)(wcg + 128 * ks), c1 = *(const LAS f32x4*)(wcg + 128 * ks + 16), s0 = *(const LAS f32x4*)(wcg + 4096 + 128 * ks), s1 = *(const LAS f32x4*)(wcg + 4096 + 128 * ks + 16);
            const f32x4 y0 = (a0 * rstd) * c0 + s0, y1 = (a1 * rstd) * c1 + s1;
            v4u w; w.x = pk2(y0[0], y0[1]); w.y = pk2(y0[2], y0[3]); w.z = pk2(y1[0], y1[1]); w.w = pk2(y1[2], y1[3]);
            { v2u w8; w8.x = pk4_fp8(y0[0], y0[1], y0[2], y0[3]); w8.y = pk4_fp8(y1[0], y1[1], y1[2], y1[3]); *(v2u*)(hn2g + 32 * ks) = w8; }
            const bf16x8 af = __builtin_bit_cast(bf16x8, w);
            const bf16x8 r0 = *(const LAS bf16x8*)(rw0 + 64 * ks), r1 = *(const LAS bf16x8*)(rw1 + 64 * ks);
            l0 = __builtin_amdgcn_mfma_f32_16x16x32_bf16(af, r0, l0, 0, 0, 0); l1 = __builtin_amdgcn_mfma_f32_16x16x32_bf16(af, r1, l1, 0, 0, 0);
            asm volatile("" : "+v"(l0), "+v"(l1) :: "memory"); }
        { const float rb0 = A->in[17][i], rb1 = A->in[17][16 + i];
#pragma unroll
          for (int r = 0; r < 4; ++r) { lg[(wave * 16 + 4 * g + r) * 33 + i] = l0[r] + rb0; lg[(wave * 16 + 4 * g + r) * 33 + 16 + i] = l1[r] + rb1; } }
        __syncthreads();
        int te[4] = {0, 0, 0, 0}; float tv[4] = {-3.0e38f, -3.0e38f, -3.0e38f, -3.0e38f}; int lp[4] = {0, 0, 0, 0};
        if (lane < 16) { const LAS float* lr = lg + (wave * 16 + lane) * 33;
            for (int e = 0; e < 32; ++e) { const float x = lr[e];
                if (x > tv[3]) { if (x > tv[2]) { tv[3] = tv[2]; te[3] = te[2]; if (x > tv[1]) { tv[2] = tv[1]; te[2] = te[1]; if (x > tv[0]) { tv[1] = tv[0]; te[1] = te[0]; tv[0] = x; te[0] = e; } else { tv[1] = x; te[1] = e; } } else { tv[2] = x; te[2] = e; } } else { tv[3] = x; te[3] = e; } } }
            const float e1 = __expf(tv[1] - tv[0]), e2 = __expf(tv[2] - tv[0]), e3 = __expf(tv[3] - tv[0]), inv = 1.0f / (1.0f + e1 + e2 + e3);
            tv[0] = inv; tv[1] = e1 * inv; tv[2] = e2 * inv; tv[3] = e3 * inv;
#pragma unroll
            for (int k = 0; k < 4; ++k) lp[k] = __hip_atomic_fetch_add(&hist[te[k]], 1, __ATOMIC_RELAXED, __HIP_MEMORY_SCOPE_WORKGROUP); }
        __syncthreads();
        if (tid < 32) { const int c = hist[tid]; hist[32 + tid] = c ? (int)__hip_atomic_fetch_add(gcnt + tid, (unsigned)c, RLX_AGENT) : 0; }
        __syncthreads();
        if (lane < 16) { const int Rt = it * 128 + wave * 16 + lane;
#pragma unroll
            for (int k = 0; k < 4; ++k) { const size_t pos = (size_t)te[k] * LISTCAP + hist[32 + te[k]] + lp[k]; ((int*)((unsigned char*)F.out + DO_LAID))[pos] = Rt * 4 + k;
                ((int*)(F.ws + WS_TSLOT))[Rt * 4 + k] = (te[k] << 20) | (hist[32 + te[k]] + lp[k]); ((float*)(F.ws + WS_TW))[Rt * 4 + k] = tv[k]; } }
        __syncthreads();
    }
}

constexpr int P8NR = 1;
struct P8Slots { int ep[P8NR][4]; float wk[P8NR][4]; };
struct P8Rows { int yw8[P8NR][4][4]; v2u hw[P8NR][4]; float wk[P8NR][4]; f32x4 g2v[4]; };
__device__ __forceinline__ int p8_row(int gw, int NGW, int k, int a) { const int r = P8NR * (gw + k * NGW) + a; return r < NLAT ? r : P8NR * gw + a; }
__device__ __forceinline__ void p8_slots(const Frame& F, int gw, int NGW, int k, P8Slots& S) {
#pragma unroll
    for (int a = 0; a < P8NR; ++a) { const int r = p8_row(gw, NGW, k, a);
#pragma unroll
        for (int q = 0; q < 4; ++q) { S.ep[a][q] = ((const int*)(F.ws + WS_TSLOT))[r * 4 + q]; S.wk[a][q] = ((const float*)(F.ws + WS_TW))[r * 4 + q]; } }
}
__device__ __forceinline__ void p8_rows(const Frame& F, const LAS int* TS, int lane, int gw, int NGW, int k, const P8Slots& S, P8Rows& R) {
#pragma unroll
    for (int a = 0; a < P8NR; ++a) { const int r = p8_row(gw, NGW, k, a); const bf16* yr = ((const bf16*)(F.ws + WS_Y1)) + (size_t)r * D;
#pragma unroll
        for (int q = 0; q < 4; ++q) { const int* ys = (const int*)((const unsigned char*)(F.ws + WS_YA) + ((size_t)TS[S.ep[a][q] >> 20] * 256 + (S.ep[a][q] & 0xFFFFF)) * D); R.wk[a][q] = S.wk[a][q];
#pragma unroll
            for (int j = 0; j < 4; ++j) R.yw8[a][q][j] = ys[lane + 64 * j]; }
#pragma unroll
        for (int j = 0; j < 4; ++j) R.hw[a][j] = ((const v2u*)yr)[lane + 64 * j]; }
    { const float* g2 = ((float*)(F.ws + WS_MOD)) + (size_t)(p8_row(gw, NGW, k, 0) >> 12) * 6144 + 5120;
#pragma unroll
      for (int j = 0; j < 4; ++j) R.g2v[j] = ((const f32x4*)g2)[lane + 64 * j]; }
}
__device__ __forceinline__ void p8_pin(P8Rows& R) {
    asm volatile("" ::: "memory");
#pragma unroll
    for (int a = 0; a < P8NR; ++a) {
#pragma unroll
        for (int q = 0; q < 4; ++q) { asm volatile("" : "+v"(R.wk[a][q]));
#pragma unroll
            for (int j = 0; j < 4; ++j) asm volatile("" : "+v"(R.yw8[a][q][j])); }
#pragma unroll
        for (int j = 0; j < 4; ++j) asm volatile("" : "+v"(R.hw[a][j])); }
#pragma unroll
    for (int j = 0; j < 4; ++j) asm volatile("" : "+v"(R.g2v[j]));
}
__device__ __forceinline__ void p8_emit(const Frame& F, const f32x4 (&fw)[4], int lane, int gw, int NGW, int k, const P8Rows& R) {
#pragma unroll
    for (int a = 0; a < P8NR; ++a) { const int r = p8_row(gw, NGW, k, a); float* hr = F.out + (size_t)r * D;
        f32x4 v[4]; float s = 0.f;
#pragma unroll
        for (int j = 0; j < 4; ++j) { const int c4 = lane + 64 * j; f32x4 y = {0.f, 0.f, 0.f, 0.f};
#pragma unroll
            for (int q = 0; q < 4; ++q) { const int w = R.yw8[a][q][j]; const f32x2 lo = __builtin_amdgcn_cvt_pk_f32_fp8(w, false), hi = __builtin_amdgcn_cvt_pk_f32_fp8(w, true);
                y[0] += R.wk[a][q] * lo[0]; y[1] += R.wk[a][q] * lo[1]; y[2] += R.wk[a][q] * hi[0]; y[3] += R.wk[a][q] * hi[1]; }
            const v2u yw = R.hw[a][j]; const f32x4 y1 = {bflo(yw.x), bfhi(yw.x), bflo(yw.y), bfhi(yw.y)};
            v[j] = y1 + R.g2v[j] * y;
            s += (v[j].x * v[j].x + v[j].y * v[j].y) + (v[j].z * v[j].z + v[j].w * v[j].w); }
        const float rstd = 1.0f / sqrtf(wave_sum(s) * (1.f / D) + EPS);
#pragma unroll
        for (int j = 0; j < 4; ++j) { const int c4 = lane + 64 * j; ((f32x4*)hr)[c4] = (v[j] * rstd) * fw[j]; } }
}
__device__ __forceinline__ void p8_phase(const Frame& F, CArgs* A, const LAS int* TS) {
    int tid_ = threadIdx.x; asm volatile("" : "+v"(tid_));
    const int lane = tid_ & 63;
    const int gw = F.bid * NWAVES + F.wave, NGW = F.G * NWAVES;
    if (P8NR * gw >= NLAT) return;
    const int K = (NLAT / P8NR - gw + NGW - 1) / NGW;
    f32x4 fw[4];
#pragma unroll
    for (int j = 0; j < 4; ++j) fw[j] = ((const f32x4*)A->in[22])[lane + 64 * j];
    P8Slots Sa, Sb; P8Rows Ra, Rb;
    p8_slots(F, gw, NGW, 0, Sa); p8_rows(F, TS, lane, gw, NGW, 0, Sa, Ra); p8_slots(F, gw, NGW, 1, Sb);
#pragma unroll 1
    for (int k = 0; k < K; k += 2) {
        int l_ = threadIdx.x; asm volatile("" : "+v"(l_)); l_ &= 63;
        p8_slots(F, gw, NGW, k + 2, Sa); p8_rows(F, TS, l_, gw, NGW, k + 1, Sb, Rb); p8_pin(Ra);
        p8_emit(F, fw, l_, gw, NGW, k, Ra);
        p8_slots(F, gw, NGW, k + 3, Sb); p8_rows(F, TS, l_, gw, NGW, k + 2, Sa, Ra); p8_pin(Rb);
        p8_emit(F, fw, l_, gw, NGW, k + 1, Rb);
    }
}

constexpr int NPHASES = 11;
__global__ void __launch_bounds__(NTHREADS, 2) fwd_kernel(Args args) {
    extern __shared__ __attribute__((aligned(16))) unsigned char lds_raw[];
    Frame F;
    F.lds = (LAS unsigned char*)lds_raw;
    F.tid = threadIdx.x; F.lane = F.tid & 63; F.wave = __builtin_amdgcn_readfirstlane(F.tid >> 6); F.G = gridDim.x; F.bid = blockIdx.x;
    F.out = args.out; F.ws = args.ws;
        for (int u = F.tid; u < (LDS_BYTES - MISC_OFF) / 4; u += NTHREADS) ((LAS unsigned*)(F.lds + MISC_OFF))[u] = 0u;
    __syncthreads();
    volatile LAS unsigned* MISC = (volatile LAS unsigned*)(F.lds + MISC_OFF);
    LAS int* TS = (LAS int*)(F.lds + MISC_OFF + 256);
    const int lo = args.ph_lo, hi = args.ph_hi;
    const bool multi = (hi - lo) > 1;
    XcdBarrier bar; bar.bar = (unsigned*)((unsigned*)(F.ws + WS_CTL)) + CW_BAR; bar.x = 0; bar.st = nullptr;
    if (multi) bar = xcd_barrier_post((unsigned*)((unsigned*)(F.ws + WS_CTL)) + CW_BAR, MISC + 8);
#ifndef PHMASK
#define PHMASK 0x7ff
#endif
#define IN(k) (((PHMASK >> (k)) & 1) && lo <= (k) && (k) < hi)
#define BUILD_TS() do { if (F.tid < NEXP) TS[33 + F.tid] = (int)__hip_atomic_load(((unsigned*)(F.ws + WS_CTL)) + CW_CNT + F.tid, RLX_AGENT);     \
        __syncthreads(); \
        if (F.tid == 0) { int acc_ = 0; for (int e = 0; e < NEXP; ++e) { TS[e] = acc_; acc_ += (TS[33 + e] + 255) >> 8; } TS[32] = acc_; } __syncthreads(); \
        for (int t_ = F.tid; t_ < TS[32]; t_ += NTHREADS) { int e_ = 0; for (int k_ = 1; k_ < NEXP; ++k_) e_ = (TS[k_] <= t_) ? k_ : e_; ((LAS unsigned char*)(TS + 72))[t_] = (unsigned char)e_; } \
        __syncthreads(); } while (0)
#define SEAM(k) do { if (IN(k) && IN((k) + 1)) xcd_barrier(bar); } while (0)
#ifndef PROBE_DUP
#define PROBE_DUP 0
#endif
#define REPS(k) for (int rep_ = 0; rep_ < (((PROBE_DUP >> (k)) & 1) ? 2 : 1); ++rep_)

    if (IN(0)) REPS(0) { p0_phase(F, opaque_args()); } SEAM(0);
    if (IN(1)) REPS(1) { p1_phase(F, opaque_args()); } SEAM(1);
    if (IN(2)) REPS(2) { DenseSched S; S.init(NROWS, PWP, F.G, F.bid, ((bf16*)(F.ws + WS_WIN))); S.build((LAS int*)(TS + 400), F.tid); EpiProj E{((bf16*)(F.ws + WS_P))};
        pg8::gemm_phase<EpiProj, DenseSched, true, false>(F.lds, (const char*)((bf16*)(F.ws + WS_HN)), S, E);
#ifdef PROBE_INNULL
        { EpiNull E0; pg8::gemm_phase<EpiNull, DenseSched, true, false>(F.lds, (const char*)((bf16*)(F.ws + WS_HN)), S, E0); }
#endif
    } SEAM(2);
    if (IN(3)) { p3v3_phase<0>(F, opaque_args());
#ifdef PROBE_P3
        p3v3_phase<PROBE_P3>(F, opaque_args());
#endif
    } SEAM(3);
    if (IN(4)) REPS(4) { p4_phase(F, opaque_args()); } SEAM(4);
    if (IN(5)) {
#ifdef PROBE_P5
        p5a_phase(F, opaque_args()); p5av3_phase<PROBE_P5>(F, opaque_args());
#else
        p5av3_phase<0>(F, opaque_args());
#endif
    } SEAM(5);
    if (IN(6)) REPS(6) { DenseSched S; S.init(NLAT, D, F.G, F.bid, ((bf16*)(F.ws + WS_WOUT))); S.kb = OUTPROJ_F8 ? 1024 : 2048; S.build((LAS int*)(TS + 400), F.tid); EpiOut E{opaque_args()->in[0], ((float*)(F.ws + WS_MOD)), ((bf16*)(F.ws + WS_Y1)), OUTPROJ_F8 ? 1.0f / WSCALE : 1.0f};
        pg8::gemm_phase<EpiOut, DenseSched, true, OUTPROJ_F8 != 0>(F.lds, (const char*)((bf16*)(F.ws + WS_YMIX)), S, E); } SEAM(6);
    if (IN(7)) { p5c_phase(F, opaque_args()); } SEAM(7);
#pragma unroll 1
    for (int ph = 8; ph < 10; ++ph) {
        if (IN(ph)) {
            const bool gu = (ph == 8);
            BUILD_TS();
            const int ntr = TS[32];
            REPS(ph) {
                if (gu) { MoeSched<true> S; S.TS = TS; S.ntr = ntr; S.G = F.G; S.c = F.bid; S.laid = ((int*)((unsigned char*)F.out + DO_LAID)); S.W = (const char*)F.out + DO_WGU;
                    EpiGU E{(unsigned char*)(F.ws + WS_ACT), opaque_args()->in[19]}; pg8::gemm_phase<EpiGU, MoeSched<true>, true, true>(F.lds, (const char*)((unsigned char*)F.out + DO_HN2), S, E);
#ifdef PROBE_GUNULL
                    { EpiNull E0; pg8::gemm_phase<EpiNull, MoeSched<true>, true, true>(F.lds, (const char*)((unsigned char*)F.out + DO_HN2), S, E0); }
#endif
                }
                else { MoeSched<false> S; S.TS = TS; S.ntr = ntr; S.G = F.G; S.c = F.bid; S.laid = nullptr; S.W = (const char*)F.out + DO_WDN;
                    EpiDN E{(unsigned char*)(F.ws + WS_YA), opaque_args()->in[21], TS}; pg8::gemm_phase<EpiDN, MoeSched<false>, true, true>(F.lds, (const char*)(F.ws + WS_ACT), S, E); }
            }
        }
        SEAM(ph);
    }
    if (IN(10)) { BUILD_TS(); p8_phase(F, opaque_args(), TS); }
#undef IN
#undef SEAM
}

extern "C" void kernel_launch(void* const* d_in, const int* in_sizes, int n_in, void* d_out, int out_size, void* d_ws, size_t ws_size, hipStream_t stream) {
    static int grid = 0;
    if (grid == 0) {
        if (n_in != 23 || in_sizes[0] != NLAT * D || out_size != NLAT * D || ws_size < WS_TOTAL) {
            fprintf(stderr, "kernel_launch: unexpected shapes: n_in %d, in0 %d, out %d, ws %zu (need %zu); nothing launched\n", n_in, n_in > 0 ? in_sizes[0] : -1, out_size, ws_size, (size_t)WS_TOTAL); grid = -1; return; }
        int dev = 0, cus = 0, per_cu = 0;
        if (hipGetDevice(&dev) != hipSuccess || hipDeviceGetAttribute(&cus, hipDeviceAttributeMultiprocessorCount, dev) != hipSuccess) { fprintf(stderr, "kernel_launch: device query failed\n"); grid = -1; return; }
        if (hipFuncSetAttribute((const void*)fwd_kernel, hipFuncAttributeMaxDynamicSharedMemorySize, LDS_BYTES) != hipSuccess) { fprintf(stderr, "kernel_launch: hipFuncSetAttribute failed\n"); grid = -1; return; }
        if (hipOccupancyMaxActiveBlocksPerMultiprocessor(&per_cu, (const void*)fwd_kernel, NTHREADS, LDS_BYTES) != hipSuccess || per_cu < 1) {
            fprintf(stderr, "kernel_launch: occupancy query reports %d workgroups per CU; nothing launched\n", per_cu); (void)hipGetLastError(); grid = -1; return; }
        grid = cus;
        if (grid > 256) grid = 256;
    }
    if (grid < 0) return;
    if (hipMemsetAsync((char*)d_ws + WS_CTL, 0, CTL_ZERO_BYTES, stream) != hipSuccess) { fprintf(stderr, "kernel_launch: hipMemsetAsync failed\n"); return; }
    Args a{};
    for (int i = 0; i < 23; ++i) a.in[i] = (const float*)d_in[i];
    a.out = (float*)d_out; a.ws = (unsigned char*)d_ws;
#if MK_N_LAUNCHES == 1
    a.ph_lo = 0; a.ph_hi = NPHASES;
    hipLaunchKernelGGL(fwd_kernel, dim3(grid), dim3(NTHREADS), LDS_BYTES, stream, a);
#else
    for (int p = 0; p < NPHASES; ++p) { a.ph_lo = p; a.ph_hi = p + 1; hipLaunchKernelGGL(fwd_kernel, dim3(grid), dim3(NTHREADS), LDS_BYTES, stream, a); }
#endif
    const hipError_t le = hipPeekAtLastError();
    if (le != hipSuccess) fprintf(stderr, "kernel_launch: launch failed: %s\n", hipGetErrorName(le));
}
```

```cpp
#define NOTOUCH5 1
#ifndef P5REP
#define P5REP 1
#endif
#ifndef DN_REVERSE
#define DN_REVERSE 1
#endif
#ifndef CONV_AT
#define CONV_AT 3
#endif
#ifndef EPO_MB
#define EPO_MB 2
#endif
#define NOTOUCH3 1
#include <hip/hip_runtime.h>
#include <cstdio>
#include <cstdint>

#ifndef MK_N_LAUNCHES
#define MK_N_LAUNCHES 1
#endif

#define GAS __attribute__((address_space(1)))
#define LAS __attribute__((address_space(3)))
typedef unsigned short bf16;
typedef unsigned v4u __attribute__((ext_vector_type(4)));
typedef unsigned v2u __attribute__((ext_vector_type(2)));
typedef float f32x4 __attribute__((ext_vector_type(4)));
typedef float f32x2 __attribute__((ext_vector_type(2)));
typedef short bf16x8 __attribute__((ext_vector_type(8)));
typedef short s16x4 __attribute__((ext_vector_type(4)));
#define RLX_AGENT __ATOMIC_RELAXED, __HIP_MEMORY_SCOPE_AGENT
#define LDS_WAIT() asm volatile("s_waitcnt lgkmcnt(0)" ::: "memory")
#define VM_WAIT() asm volatile("s_waitcnt vmcnt(0)" ::: "memory")
#define LDS_BARRIER() do { asm volatile("s_waitcnt lgkmcnt(0)" ::: "memory"); __builtin_amdgcn_s_barrier(); asm volatile("" ::: "memory"); } while (0)

typedef __bf16 bf16x2_t __attribute__((ext_vector_type(2)));
__device__ __forceinline__ unsigned pk2(float lo, float hi) { const f32x2 v = {lo, hi}; return __builtin_bit_cast(unsigned, __builtin_convertvector(v, bf16x2_t)); }
__device__ __forceinline__ unsigned f2bf(float f) { return (unsigned)__builtin_bit_cast(unsigned short, (__bf16)f); }
__device__ __forceinline__ unsigned pk4_fp8(float a, float b, float c, float d) { int w = __builtin_amdgcn_cvt_pk_fp8_f32(a, b, 0, false); w = __builtin_amdgcn_cvt_pk_fp8_f32(c, d, w, true); return (unsigned)w; }
__device__ __forceinline__ v4u widen16(v2u a, v2u b) {
    const auto rx = __builtin_amdgcn_permlane16_swap(a.x, b.x, false, false); const auto ry = __builtin_amdgcn_permlane16_swap(a.y, b.y, false, false);
    v4u w; w.x = rx[0]; w.y = ry[0]; w.z = rx[1]; w.w = ry[1]; return w;
}
__device__ __forceinline__ float bflo(unsigned w) { return __builtin_bit_cast(float, w << 16); }
__device__ __forceinline__ float bfhi(unsigned w) { return __builtin_bit_cast(float, w & 0xffff0000u); }
__device__ __forceinline__ float bf2f(bf16 b) { return __builtin_bit_cast(float, ((unsigned)b) << 16); }
__device__ __forceinline__ float fexp(float x) { return __builtin_amdgcn_exp2f(x * 1.4426950408889634f); }
__device__ __forceinline__ float wave_sum(float v) {
#pragma unroll
    for (int o = 1; o < 64; o <<= 1) v += __shfl_xor(v, o);
    return v;
}

constexpr int D = 1024, NBATCH = 16, SEQ = 4096, CTXL = 256;
constexpr int NLAT = NBATCH * SEQ;
constexpr int NCTXR = NBATCH * CTXL;
constexpr int NROWS = NLAT + NCTXR;
constexpr int PW = 2592, PWP = 3328;
constexpr int CQ = 0, CK = 256, CV = 512, CR = 1024, CPB = 1536, CU = 2048, CAF = 2560, CAB = 2576;
constexpr int CPC = CU, CPX = CU;
__host__ __device__ __forceinline__ int win_row(int n) {
    if (n < 1536) return n;
    if (n < 1568) return 3072 + (n - 1536);
    if (n < 2080) return 1536 + (n - 1568);
    if (n < 2592) { const int j = n - 2080; return 2048 + (j >> 7) * 256 + (j & 127); }
    { const int j = n - 2592; return 2048 + (j >> 7) * 256 + 128 + (j & 127); }
}
constexpr int NCC = 68;
constexpr int NEXP = 32, DFF = 1024;
constexpr float EPS = 1e-6f;
constexpr int LISTCAP = 65536;
constexpr float WSCALE = 32.0f, WSCALE_INV = 1.0f / 32.0f;

#ifndef OUTPROJ_F8
#define OUTPROJ_F8 1
#endif
constexpr size_t MiB = 1u << 20;
constexpr size_t WS_CTL = 0, CTL_ZERO_BYTES = 32768;
constexpr size_t WS_MOD = 1 * MiB;
constexpr size_t WS_DECAY = 2 * MiB;
constexpr size_t WS_WIN = 6 * MiB;
constexpr size_t WS_WOUT = 13 * MiB;
constexpr size_t WS_HN = 16 * MiB;
constexpr size_t WS_KV = 16 * MiB;
constexpr size_t WS_P = 152 * MiB;
constexpr size_t WS_S = 565 * MiB;
constexpr size_t WS_YMIX = 693 * MiB;
constexpr size_t WS_Y1 = 821 * MiB;
constexpr size_t WS_ACT = 16 * MiB;
constexpr size_t WS_YA = 280 * MiB;
constexpr size_t WS_VT = 949 * MiB;
constexpr size_t WS_END = 1013 * MiB;
constexpr size_t WS_TSLOT = 1013 * MiB;
constexpr size_t WS_TW = 1015 * MiB;
constexpr size_t WS_TOTAL = 1017 * MiB;
constexpr size_t DO_WDN = 0;
constexpr size_t DO_WGU = 32 * MiB;
constexpr size_t DO_HN2 = 96 * MiB;
constexpr size_t DO_LAID = 160 * MiB;
constexpr size_t DO_LW = 168 * MiB;
static_assert(WS_P + (size_t)NROWS * PW * 2 <= WS_S && WS_YMIX + (size_t)NLAT * D * 2 <= WS_Y1 && WS_YA + (size_t)1056 * 256 * D <= WS_Y1 && WS_Y1 + (size_t)NLAT * D * 2 <= WS_VT && WS_VT + (size_t)NLAT * 512 * 2 <= WS_END, "ws map");
static_assert(WS_HN + (size_t)NROWS * D * 2 <= WS_P && WS_ACT + (size_t)1056 * 256 * 1024 <= WS_YA && DO_LW + (size_t)NEXP * LISTCAP * 4 <= (size_t)NLAT * D * 4, "ws map 2");
constexpr int CW_CNT = 64;
constexpr int CW_BAR = 4096;

constexpr int RING_BYTES = 131072;
constexpr int MISC_OFF = RING_BYTES;
constexpr int LDS_BYTES = 147456;
constexpr int NWAVES = 8, NTHREADS = 512;

namespace pg8 {
constexpr int BM = 256, BK = 64, HALF = 128, HTB = HALF * BK * 2, STAGE_BYTES = 8 * HTB;
constexpr int BIAS_OFF = 131072 + 8192;
__host__ __device__ __forceinline__ int lds_byte(int r, int c) { const int st = (r >> 4) * 2 + (c >> 5), rr = r & 15, cc = c & 31, ob = rr * 64 + cc * 2; return st * 1024 + (ob ^ (((ob >> 9) & 1) << 5)); }
__host__ __device__ __forceinline__ void stage_rc(int b, int& R, int& C) { const int st = b / 1024, sb = b % 1024, swz = sb ^ (((sb >> 9) & 1) << 5); R = (st >> 1) * 16 + swz / 64; C = (st & 1) * 32 + (swz % 64) / 2; }
__host__ __device__ __forceinline__ int perm32(int rho) { const int n = rho >> 4, i = rho & 15; return 8 * (i >> 2) + 4 * n + (i & 3); }

typedef int v8i __attribute__((ext_vector_type(8)));
typedef int v4i __attribute__((ext_vector_type(4)));
__device__ __forceinline__ v8i cat8(bf16x8 lo, bf16x8 hi) { return __builtin_shufflevector(__builtin_bit_cast(v4i, lo), __builtin_bit_cast(v4i, hi), 0, 1, 2, 3, 4, 5, 6, 7); }
struct Unit { int pm, pn, e, lt; };
__device__ __forceinline__ unsigned cvt_pk_bf16(float lo, float hi) { unsigned r; asm volatile("v_cvt_pk_bf16_f32 %0, %1, %2" : "=v"(r) : "v"(lo), "v"(hi)); return r; }

template <class Epi, class Sched, bool ALIGN_EPI, bool F8>
__device__ __forceinline__ void gemm_phase(LAS unsigned char* lds, const char* Abase, const Sched& S, const Epi& E) {
    int tid_ = threadIdx.x; asm volatile("" : "+v"(tid_));
    const int tid = tid_, wid = __builtin_amdgcn_readfirstlane(tid >> 6), lane = tid & 63, wr = wid >> 2, wc = wid & 3, fr = lane & 15, fq = lane >> 4;
    constexpr int KB = F8 ? 1024 : 2048, NT = KB / 128;
    unsigned voffB[2];
#pragma unroll
    for (int i = 0; i < 2; ++i) { int R, C; stage_rc(tid * 16 + i * 8192, R, C); const int Rb = Epi::PERM ? ((R & ~31) + perm32(R & 31)) : R; voffB[i] = (unsigned)(Rb * KB + C * 2); }
#define PG8_AROWS(u_, dst_) do { _Pragma("unroll") for (int h_ = 0; h_ < 2; ++h_) _Pragma("unroll") for (int i_ = 0; i_ < 2; ++i_) { int R_, C_; stage_rc(tid * 16 + i_ * 8192, R_, C_); \
        dst_[h_][i_] = (unsigned)S.arow(u_, h_ * HALF + R_); } } while (0)
#define PG8_AOFF2(dst_) do { _Pragma("unroll") for (int h_ = 0; h_ < 2; ++h_) _Pragma("unroll") for (int i_ = 0; i_ < 2; ++i_) { int R_, C_; stage_rc(tid * 16 + i_ * 8192, R_, C_); \
        dst_[h_][i_] = dst_[h_][i_] * (unsigned)KB + (unsigned)C_ * 2u; } } while (0)
    const size_t kstep = (size_t)(BK * 2);
    const size_t hstep = (size_t)HALF * KB;
    const unsigned ldsw = (unsigned)wid * 1024u;
    const int aoff = lds_byte(wr * 64 + fr, fq * 8), boff = lds_byte(wc * 32 + fr, fq * 8);
#define PG8_SA(b, h) (((b) * 2 + (h)) * HTB)
#define PG8_SB(b, h) ((4 + (b) * 2 + (h)) * HTB)
#define PG8_STAGE(bufoff, gbase, voff) do { _Pragma("unroll") for (int _i = 0; _i < 2; ++_i) \
        __builtin_amdgcn_global_load_lds((const unsigned*)((const char*)(gbase) + (voff)[_i]), (LAS unsigned*)(lds + (bufoff) + ldsw + _i * 8192), 16, 0, 0); } while (0)
#define PG8_LDA(dst, b, h) do { _Pragma("unroll") for (int m = 0; m < 4; ++m) _Pragma("unroll") for (int k = 0; k < 2; ++k) dst[m][k] = *(const LAS bf16x8*)(lds + PG8_SA(b, h) + aoff + m * 2048 + k * 1024); } while (0)
#define PG8_LDB(dst, b, h) do { _Pragma("unroll") for (int n = 0; n < 2; ++n) _Pragma("unroll") for (int k = 0; k < 2; ++k) dst[n][k] = *(const LAS bf16x8*)(lds + PG8_SB(b, h) + boff + n * 2048 + k * 1024); } while (0)
#define PG8_MMA(ai, bj, At, Bt, ZF) do { if (skipmma && ((bj) == 1 || wc > 0)) break; __builtin_amdgcn_s_setprio(1); _Pragma("unroll") for (int m = 0; m < 4; ++m) _Pragma("unroll") for (int n = 0; n < 2; ++n) { \
        if constexpr (F8) { if constexpr (ZF) asm volatile("v_mfma_f32_16x16x128_f8f6f4 %0, %1, %2, 0" : "=&v"(acc[ai][bj][m][n]) : "v"(cat8(Bt[n][0], Bt[n][1])), "v"(cat8(At[m][0], At[m][1]))); \
                            else asm volatile("v_mfma_f32_16x16x128_f8f6f4 %0, %1, %2, %0" : "+v"(acc[ai][bj][m][n]) : "v"(cat8(Bt[n][0], Bt[n][1])), "v"(cat8(At[m][0], At[m][1]))); } \
        else { if constexpr (ZF) acc[ai][bj][m][n] = __builtin_amdgcn_mfma_f32_16x16x32_bf16(Bt[n][0], At[m][0], (f32x4){0.f, 0.f, 0.f, 0.f}, 0, 0, 0); \
               else acc[ai][bj][m][n] = __builtin_amdgcn_mfma_f32_16x16x32_bf16(Bt[n][0], At[m][0], acc[ai][bj][m][n], 0, 0, 0); \
               acc[ai][bj][m][n] = __builtin_amdgcn_mfma_f32_16x16x32_bf16(Bt[n][1], At[m][1], acc[ai][bj][m][n], 0, 0, 0); } } \
        __builtin_amdgcn_s_setprio(0); } while (0)
#define PG8_WAIT_V(n) asm volatile("s_waitcnt vmcnt(" #n ")" ::: "memory")
#define PG8_WAIT_V8S() do { if (sfirst == 0) asm volatile("s_waitcnt vmcnt(8)" ::: "memory"); else if (sfirst == 4) asm volatile("s_waitcnt vmcnt(12)" ::: "memory"); \
        else if (sfirst == 8) asm volatile("s_waitcnt vmcnt(16)" ::: "memory"); else if (sfirst == 16) asm volatile("s_waitcnt vmcnt(24)" ::: "memory"); else asm volatile("s_waitcnt vmcnt(56)" ::: "memory"); } while (0)
#define PG8_WAIT_L(n) asm volatile("s_waitcnt lgkmcnt(" #n ")" ::: "memory")
#define PG8_BAR __builtin_amdgcn_s_barrier()
#define PG8_SCHED __builtin_amdgcn_sched_barrier(0)
#define PG8_KITER(T_, ZFLAG) do { \
            constexpr bool ZF_ = (ZFLAG); const int t = (T_); const bool last = (t == NT - 2); \
            const int sfirst = (t == 0) ? sprev : 0; \
            const char* ka1 = Abase + (size_t)(t + 1) * kstep; \
            const char* ka2 = last ? Abase : Abase + (size_t)(t + 2) * kstep; const char* b2 = last ? nB : cB + (size_t)(t + 2) * kstep; \
            const char* ka3 = ka2 + kstep; const char* b3 = b2 + kstep; \
            PG8_LDB(B0, 0, 0); PG8_LDB(B1, 0, 1); PG8_SCHED; PG8_LDA(At, 0, 0); PG8_STAGE(PG8_SA(1, 1), ka1, oC[1]); \
            PG8_WAIT_V8S(); PG8_WAIT_L(0); PG8_BAR; PG8_MMA(0, 0, At, B0, ZF_); PG8_MMA(0, 1, At, B1, ZF_); PG8_BAR; PG8_SCHED; \
            if constexpr (Sched::GATHER) { if (t == NT - 4) { unsigned r4[2][2]; PG8_AROWS(nxt, r4); rN[0] = r4[0][0] | (r4[0][1] << 16); rN[1] = r4[1][0] | (r4[1][1] << 16); } } \
            if (last) { \
                if constexpr (Sched::GATHER) { oC[0][0] = rN[0] & 0xffffu; oC[0][1] = rN[0] >> 16; oC[1][0] = rN[1] & 0xffffu; oC[1][1] = rN[1] >> 16; } \
                else { PG8_AROWS(nxt, oC); } \
                PG8_AOFF2(oC); } \
            PG8_LDA(At, 0, 1); PG8_STAGE(PG8_SB(0, 0), b2, voffB); PG8_STAGE(PG8_SB(0, 1), b2 + hstep, voffB); PG8_STAGE(PG8_SA(0, 0), ka2, oC[0]); \
            PG8_WAIT_V8S(); PG8_WAIT_L(0); PG8_BAR; PG8_MMA(1, 0, At, B0, ZF_); PG8_MMA(1, 1, At, B1, ZF_); PG8_BAR; PG8_SCHED; \
            PG8_LDB(B0, 1, 0); PG8_LDB(B1, 1, 1); PG8_SCHED; PG8_LDA(At, 1, 0); PG8_STAGE(PG8_SA(0, 1), ka2, oC[1]); \
            PG8_WAIT_V8S(); PG8_WAIT_L(0); PG8_BAR; PG8_MMA(0, 0, At, B0, false); PG8_MMA(0, 1, At, B1, false); PG8_BAR; PG8_SCHED; \
            PG8_LDA(At, 1, 1); PG8_STAGE(PG8_SB(1, 0), b3, voffB); PG8_STAGE(PG8_SB(1, 1), b3 + hstep, voffB); PG8_STAGE(PG8_SA(1, 0), ka3, oC[0]); \
            PG8_WAIT_V8S(); PG8_WAIT_L(0); PG8_BAR; PG8_MMA(1, 0, At, B0, false); PG8_MMA(1, 1, At, B1, false); PG8_BAR; PG8_SCHED; \
        } while (0)
    Unit cur, nxt; int ui = 0; int sprev = 0;
    if (!S.next(0, cur)) return;
    f32x4 acc[2][2][4][2];
    bf16x8 At[4][2], B0[2][2], B1[2][2];
    unsigned oC[2][2];
    PG8_AROWS(cur, oC); PG8_AOFF2(oC);
    unsigned rN[2] = {0u, 0u};
    const char* cB = S.bptr(cur);
    PG8_STAGE(PG8_SB(0, 0), cB, voffB); PG8_STAGE(PG8_SB(0, 1), cB + hstep, voffB); PG8_STAGE(PG8_SA(0, 0), Abase, oC[0]); PG8_STAGE(PG8_SA(0, 1), Abase, oC[1]);
    if (wr == 1) PG8_BAR;
    PG8_WAIT_V(2); PG8_BAR;
    PG8_STAGE(PG8_SB(1, 0), cB + kstep, voffB); PG8_STAGE(PG8_SA(1, 0), Abase + kstep, oC[0]); PG8_STAGE(PG8_SB(1, 1), cB + hstep + kstep, voffB);
    PG8_WAIT_V(6); PG8_BAR;
    for (;;) {
        const bool skipmma = S.mostly_padding(cur);
        if constexpr (Epi::LBIAS) { if (wid == 0) __builtin_amdgcn_global_load_lds((const unsigned*)(E.bias_src(cur) + lane * 16), (LAS unsigned*)(lds + BIAS_OFF + (ui & 1) * 1024), 16, 0, 0); }
        const char* nB = cB;
        PG8_KITER(0, true);
        const bool has_next = S.next(ui + 1, nxt);
        if (!has_next) nxt = cur;
        nB = S.bptr(nxt);
        for (int tt_ = 2; tt_ < NT; tt_ += 2) PG8_KITER(tt_, false);
        if constexpr (ALIGN_EPI) { if (wr == 0) PG8_BAR; }
        if constexpr (F8) asm volatile("s_nop 15\n\ts_nop 7" ::: "memory");
        { int fr_o = fr, fq_o = fq; asm volatile("" : "+v"(fr_o), "+v"(fq_o));
          E(acc, cur, wr, wc, fr_o, fq_o, (const LAS float*)(lds + BIAS_OFF + (ui & 1) * 1024)); }
        if (!has_next) break;
        sprev = E.stores(cur, wc); cur = nxt; cB = nB; ++ui;
        if constexpr (ALIGN_EPI) { if (wr == 1) PG8_BAR; }
    }
    PG8_WAIT_V(0);
    if constexpr (!ALIGN_EPI) { if (wr == 0) PG8_BAR; }
    PG8_BAR;
#undef PG8_AROWS
#undef PG8_AOFF2
#undef PG8_SA
#undef PG8_SB
#undef PG8_STAGE
#undef PG8_LDA
#undef PG8_LDB
#undef PG8_MMA
#undef PG8_KITER
#undef PG8_WAIT_V
#undef PG8_WAIT_V8S
#undef PG8_WAIT_L
#undef PG8_BAR
#undef PG8_SCHED
}
}

#define XB_TMO      128
#define XB_XCNT(j)  (256  + 64 * (j))
#define XB_XSUB(j)  (1280 + 64 * (j))
#define XB_XGEN(j)  (2304 + 64 * (j))
#define XB_TOP      3328
#define XB_TOPGEN   3392
#define XCD_BAR_WORDS 3456
#define XB_SPIN_CAP (1u << 22)
#ifndef XB_FLAT
#define XB_FLAT 1
#endif
__device__ __forceinline__ unsigned xb_ld(unsigned* p)              { return __hip_atomic_load(p, __ATOMIC_RELAXED, __HIP_MEMORY_SCOPE_AGENT); }
__device__ __forceinline__ unsigned xb_add(unsigned* p, unsigned v) { return __hip_atomic_fetch_add(p, v, __ATOMIC_RELAXED, __HIP_MEMORY_SCOPE_AGENT); }
__device__ __forceinline__ unsigned xb_xcc_id() { return (unsigned)__builtin_amdgcn_s_getreg((3 << 11) | 20) & 0xFu; }
#define XB_SPIN(cond, bar) do { unsigned _sp = 0; while (cond) { __builtin_amdgcn_s_sleep(1); \
    if ((++_sp & 255u) == 0u) { if (xb_ld(&(bar)[XB_TMO])) break; if (_sp > XB_SPIN_CAP) { atomicAdd(&(bar)[XB_TMO], 1u); break; } } } } while (0)
struct XcdBarrier { unsigned* bar; unsigned x; volatile LAS unsigned* st; };
__device__ __forceinline__ XcdBarrier xcd_barrier_post(unsigned* bar, volatile LAS unsigned* st) {
    XcdBarrier b; b.bar = bar; b.x = xb_xcc_id(); b.st = st;
    if (threadIdx.x == 0) (void)xb_add(&bar[XB_XCNT(b.x)], 1u);
    return b;
}
__device__ __forceinline__ void xcd_barrier_complete(unsigned* bar, unsigned x, unsigned& nloc, unsigned& nx) {
    const unsigned G = gridDim.x * gridDim.y * gridDim.z;
    unsigned sum, cnt, mine, sp = 0u;
    for (;;) {
        sum = 0u; cnt = 0u; mine = 0u;
#pragma unroll 1
        for (unsigned j = 0; j < 16; ++j) { const unsigned c = xb_ld(&bar[XB_XCNT(j)]); sum += c; cnt += (c > 0u) ? 1u : 0u; mine = (j == x) ? c : mine; }
        if (sum == G) break;
        __builtin_amdgcn_s_sleep(1);
        if ((++sp & 255u) == 0u) { if (xb_ld(&bar[XB_TMO])) break; if (sp > XB_SPIN_CAP) { atomicAdd(&bar[XB_TMO], 1u); break; } }
    }
    nloc = mine > 0u ? mine : 1u; nx = cnt > 0u ? cnt : 1u;
}
__device__ __forceinline__ void xcd_barrier(const XcdBarrier& b) {
    asm volatile("s_waitcnt vmcnt(0)" ::: "memory");
    __syncthreads();
    if (threadIdx.x == 0) {
        unsigned* bar = b.bar;
        __builtin_amdgcn_s_waitcnt(0);
        unsigned nloc = b.st[0], nx = b.st[1];
        if (nloc == 0u) { xcd_barrier_complete(bar, b.x, nloc, nx); b.st[0] = nloc; b.st[1] = nx; }
        const unsigned old = xb_add(&bar[XB_XSUB(b.x)], 1u);
        const unsigned gen = old / nloc;
#if XB_FLAT
        if (old + 1u == (gen + 1u) * nloc) {
            __builtin_amdgcn_fence(__ATOMIC_RELEASE, "agent");
            asm volatile("s_waitcnt vmcnt(0)" ::: "memory");
            const unsigned og = xb_add(&bar[XB_TOP], 1u);
            if (og + 1u == (og / nx + 1u) * nx) xb_add(&bar[XB_TOPGEN], 1u);
        }
        XB_SPIN(xb_ld(&bar[XB_TOPGEN]) == gen, bar);
        __builtin_amdgcn_fence(__ATOMIC_ACQUIRE, "agent");
        asm volatile("s_waitcnt vmcnt(0)" ::: "memory");
#else
        if (old + 1u == (gen + 1u) * nloc) {
            __builtin_amdgcn_fence(__ATOMIC_RELEASE, "agent");
            asm volatile("s_waitcnt vmcnt(0)" ::: "memory");
            const unsigned og = xb_add(&bar[XB_TOP], 1u);
            const unsigned tg = og / nx;
            if (og + 1u == (tg + 1u) * nx) xb_add(&bar[XB_TOPGEN], 1u);
            else XB_SPIN(xb_ld(&bar[XB_TOPGEN]) == tg, bar);
            __builtin_amdgcn_fence(__ATOMIC_ACQUIRE, "agent");
            xb_add(&bar[XB_XGEN(b.x)], 1u);
            asm volatile("s_waitcnt vmcnt(0)" ::: "memory");
        } else {
            XB_SPIN(xb_ld(&bar[XB_XGEN(b.x)]) == gen, bar);
            __builtin_amdgcn_fence(__ATOMIC_ACQUIRE, "agent");
            asm volatile("s_waitcnt vmcnt(0)" ::: "memory");
        }
#endif
    }
    __syncthreads();
}

struct Args { const float* in[23]; float* out; unsigned char* ws; int ph_lo, ph_hi; };
typedef const Args __attribute__((address_space(4))) CArgs;
__device__ __forceinline__ CArgs* opaque_args() { CArgs* p = (CArgs*)__builtin_amdgcn_kernarg_segment_ptr(); asm volatile("" : "+s"(p)); return p; }
struct Frame {
    LAS unsigned char* lds;
    int tid, lane, wave, G, bid;
    float* out; unsigned char* ws;
};

struct EpiNull {
    static constexpr bool PERM = true, LBIAS = false;
    __device__ __forceinline__ int stores(const pg8::Unit&, int) const { return 0; }
    __device__ __forceinline__ void operator()(const f32x4 (&acc)[2][2][4][2], const pg8::Unit&, int, int, int, int, const LAS float*) const {
#pragma unroll
        for (int a = 0; a < 2; ++a)
#pragma unroll
            for (int b = 0; b < 2; ++b)
#pragma unroll
                for (int m = 0; m < 4; ++m)
#pragma unroll
                    for (int n = 0; n < 2; ++n) asm volatile("" :: "v"(acc[a][b][m][n]));
    }
};
struct DenseSched {
    static constexpr bool GATHER = false;
    int nM, nN, nwg, G, c, kb; const char* Bt; const LAS int* UT;
    __device__ __forceinline__ void init(int M, int N, int G_, int c_, const void* Bt_) { nM = M / 256; nN = N / 256; nwg = nM * nN; G = G_; c = c_; Bt = (const char*)Bt_; UT = nullptr; kb = 2048; }
    __device__ __forceinline__ void build(LAS int* ut, int tid) { if (tid < 32) { pg8::Unit u; ut[tid] = next_calc(tid, u) ? (u.pm | (u.pn << 16)) : -1; } UT = ut; __syncthreads(); }
    __device__ __forceinline__ bool next(int i, pg8::Unit& u) const { const int w = (i < 32) ? UT[i] : -1; if (w < 0) return false; u.pm = w & 0xffff; u.pn = w >> 16; u.e = 0; u.lt = 0; return true; }
    __device__ __forceinline__ bool next_calc(int i, pg8::Unit& u) const {
        const long L = (long)i * G + c; if (L >= nwg) return false;
        int wgid = (int)L; { const int q = nwg / 8, r = nwg % 8, xcd = wgid % 8, off = wgid / 8; wgid = (xcd < r ? xcd * (q + 1) : r * (q + 1) + (xcd - r) * q) + off; }
        const int nig = 4 * nN, gid = wgid / nig, fm = gid * 4, gsz = (nM - fm) < 4 ? (nM - fm) : 4;
        u.pm = fm + ((wgid % nig) % gsz); u.pn = (wgid % nig) / gsz; u.e = 0; u.lt = 0; return true;
    }
    __device__ __forceinline__ int arow(const pg8::Unit& u, int r) const { return u.pm * 256 + r; }
    __device__ __forceinline__ bool mostly_padding(const pg8::Unit& u) const { return nN == PWP / 256 && u.pn == nN - 1; }
    __device__ __forceinline__ const char* bptr(const pg8::Unit& u) const { return Bt + (size_t)u.pn * 256 * kb; }
};
struct EpiProj {
    static constexpr bool PERM = true, LBIAS = false;
    __device__ __forceinline__ int stores(const pg8::Unit& u, int wc) const { return u.pn < 8 ? 16 : (u.pn < 12 ? 8 : (wc == 0 ? 8 : 0)); }
    bf16* O;
    __device__ __forceinline__ void operator()(const f32x4 (&acc)[2][2][4][2], const pg8::Unit& u, int wr, int wc, int fr, int fq, const LAS float*) const {
        const int row0 = u.pm * 256 + wr * 64 + fr, c8 = wc * 32 + 8 * fq;
        if (u.pn < 8) {
            const int col0 = u.pn * 256 + c8;
#pragma unroll
            for (int ai = 0; ai < 2; ++ai)
#pragma unroll
                for (int m = 0; m < 4; ++m) { bf16* rowp = O + (size_t)(row0 + ai * 128 + m * 16) * PW + col0;
#pragma unroll
                    for (int bj = 0; bj < 2; ++bj) { const f32x4 v0 = acc[ai][bj][m][0], v1 = acc[ai][bj][m][1];
                        v4u w; w.x = pk2(v0[0], v0[1]); w.y = pk2(v0[2], v0[3]); w.z = pk2(v1[0], v1[1]); w.w = pk2(v1[2], v1[3]);
                        *(v4u*)(rowp + bj * 128) = w; } }
        } else if (u.pn < 12) {
            const int col0 = CU + (u.pn - 8) * 128 + c8;
#pragma unroll
            for (int ai = 0; ai < 2; ++ai)
#pragma unroll
                for (int m = 0; m < 4; ++m) { const f32x4 v0 = acc[ai][0][m][0] * acc[ai][1][m][0], v1 = acc[ai][0][m][1] * acc[ai][1][m][1];
                    v4u w; w.x = pk2(v0[0], v0[1]); w.y = pk2(v0[2], v0[3]); w.z = pk2(v1[0], v1[1]); w.w = pk2(v1[2], v1[3]);
                    *(v4u*)(O + (size_t)(row0 + ai * 128 + m * 16) * PW + col0) = w; }
        } else if (wc == 0) {
#pragma unroll
            for (int ai = 0; ai < 2; ++ai)
#pragma unroll
                for (int m = 0; m < 4; ++m) { const f32x4 v0 = acc[ai][0][m][0], v1 = acc[ai][0][m][1];
                    v4u w; w.x = pk2(v0[0], v0[1]); w.y = pk2(v0[2], v0[3]); w.z = pk2(v1[0], v1[1]); w.w = pk2(v1[2], v1[3]);
                    *(v4u*)(O + (size_t)(row0 + ai * 128 + m * 16) * PW + CAF + 8 * fq) = w; }
        }
    }
};
struct EpiOut {
    static constexpr bool PERM = true, LBIAS = true;
    __device__ __forceinline__ int stores(const pg8::Unit&, int) const { return 48; }
    const float* x; const float* mod; bf16* Y1; float sc;
    __device__ __forceinline__ const char* bias_src(const pg8::Unit& u) const { return (const char*)(mod + (size_t)(u.pm >> 4) * 6144 + 2048 + u.pn * 256); }
    __device__ __forceinline__ void operator()(const f32x4 (&acc)[2][2][4][2], const pg8::Unit& u, int wr, int wc, int fr, int fq, const LAS float* bl) const {
        const int row0 = u.pm * 256 + wr * 64 + fr, col0 = u.pn * 256 + wc * 32 + 8 * fq;
        f32x4 gv[2][2];
#pragma unroll
        for (int bj = 0; bj < 2; ++bj)
#pragma unroll
            for (int n = 0; n < 2; ++n) gv[bj][n] = *(const LAS f32x4*)(bl + wc * 32 + 8 * fq + bj * 128 + 4 * n) * sc;
#pragma unroll
        for (int ai = 0; ai < 2; ++ai)
#pragma unroll
            for (int m0 = 0; m0 < 4; m0 += EPO_MB) { f32x4 xv[EPO_MB][2][2];
#pragma unroll
                for (int mm = 0; mm < EPO_MB; ++mm) { const size_t off = (size_t)(row0 + ai * 128 + (m0 + mm) * 16) * D + col0;
#pragma unroll
                    for (int bj = 0; bj < 2; ++bj) { xv[mm][bj][0] = *(const f32x4*)(x + off + bj * 128); xv[mm][bj][1] = *(const f32x4*)(x + off + bj * 128 + 4); } }
                asm volatile("" ::: "memory");
#pragma unroll
                for (int mm = 0; mm < EPO_MB; ++mm)
#pragma unroll
                    for (int bj = 0; bj < 2; ++bj) { asm volatile("" : "+v"(xv[mm][bj][0])); asm volatile("" : "+v"(xv[mm][bj][1])); }
#pragma unroll
                for (int mm = 0; mm < EPO_MB; ++mm) { const int m = m0 + mm; const size_t off = (size_t)(row0 + ai * 128 + m * 16) * D + col0; bf16* rowp = Y1 + off;
#pragma unroll
                    for (int bj = 0; bj < 2; ++bj) { const f32x4 v0 = xv[mm][bj][0] + acc[ai][bj][m][0] * gv[bj][0], v1 = xv[mm][bj][1] + acc[ai][bj][m][1] * gv[bj][1];
                        v4u w; w.x = pk2(v0[0], v0[1]); w.y = pk2(v0[2], v0[3]); w.z = pk2(v1[0], v1[1]); w.w = pk2(v1[2], v1[3]);
                        *(v4u*)(rowp + bj * 128) = w; } } }
    }
};
template <bool GU> struct MoeSched {
    static constexpr bool GATHER = GU;
    static constexpr bool gu = GU;
    const LAS int* TS; int ntr, G, c; const int* laid; const char* W;
    __device__ __forceinline__ bool next(int i, pg8::Unit& u) const {
        const int x = c & 7, j = c >> 3; int tl, pn;
        if (G != 256) { const int L = i * G + c, npn = gu ? 8 : 4; tl = L / npn; pn = L % npn; }
        else if (gu) { tl = (i * 8 + x) * 4 + (j >> 3); pn = j & 7; } else { tl = (i * 8 + x) * 8 + (j >> 2); pn = j & 3; }
        if (tl >= ntr) return false;
        if (!gu && DN_REVERSE) tl = ntr - 1 - tl;
        const int tau = tl; const int e = ((const LAS unsigned char*)(TS + 72))[tau];
        u.pm = tl; u.pn = pn; u.e = e; u.lt = tau - TS[e]; return true;
    }
    __device__ __forceinline__ bool mostly_padding(const pg8::Unit&) const { return false; }
    __device__ __forceinline__ int arow(const pg8::Unit& u, int r) const {
        if (!gu) return u.pm * 256 + r;
        const int pos = u.lt * 256 + r, cnt = TS[33 + u.e];
        return pos < cnt ? (laid[(size_t)u.e * LISTCAP + pos] >> 2) : 0;
    }
    __device__ __forceinline__ const char* bptr(const pg8::Unit& u) const { return W + ((size_t)u.e * (gu ? 2048 : 1024) + (size_t)u.pn * 256) * 1024; }
};
struct EpiGU {
    static constexpr bool PERM = true, LBIAS = true;
    __device__ __forceinline__ int stores(const pg8::Unit&, int) const { return 4; }
    unsigned char* ACT; const float* b_gu;
    __device__ __forceinline__ const char* bias_src(const pg8::Unit& u) const { return (const char*)(b_gu + (size_t)u.e * 2048 + u.pn * 256); }
    __device__ __forceinline__ void operator()(const f32x4 (&acc)[2][2][4][2], const pg8::Unit& u, int wr, int wc, int fr, int fq, const LAS float* bl) const {
        const int row0 = u.pm * 256 + wr * 64 + fr, j0 = u.pn * 128 + wc * 32 + 8 * fq;
        const LAS float* bp = bl + 2 * (wc * 32 + 8 * fq);
        f32x4 bv[4];
#pragma unroll
        for (int q = 0; q < 4; ++q) bv[q] = *(const LAS f32x4*)(bp + 4 * q);
        v2u wprev = {0u, 0u};
        f32x2 bg[4], bu[4];
#pragma unroll
        for (int q = 0; q < 4; ++q) { bg[q] = (f32x2){bv[q][0], bv[q][2]}; bu[q] = (f32x2){bv[q][1], bv[q][3]}; }
#pragma unroll
        for (int ai = 0; ai < 2; ++ai)
#pragma unroll
            for (int m = 0; m < 4; ++m) { f32x2 a[4];
#pragma unroll
                for (int n = 0; n < 2; ++n)
#pragma unroll
                    for (int p = 0; p < 2; ++p) { const int q = 2 * n + p;
                        const f32x4 ag = acc[ai][0][m][n], au = acc[ai][1][m][n];
                        f32x2 g = (f32x2){ag[2 * p], ag[2 * p + 1]} * WSCALE_INV + bg[q], up = (f32x2){au[2 * p], au[2 * p + 1]} * WSCALE_INV + bu[q];
                        g.x = fminf(g.x, 7.0f); g.y = fminf(g.y, 7.0f); up.x = __builtin_amdgcn_fmed3f(up.x, -7.0f, 7.0f); up.y = __builtin_amdgcn_fmed3f(up.y, -7.0f, 7.0f);
                        const f32x2 t = g * (-1.702f * 1.4426950408889634f); f32x2 e; e.x = __builtin_amdgcn_exp2f(t.x); e.y = __builtin_amdgcn_exp2f(t.y);
                        const f32x2 d = e + 1.0f; f32x2 sg; sg.x = __builtin_amdgcn_rcpf(d.x); sg.y = __builtin_amdgcn_rcpf(d.y);
                        a[q] = ((up + 1.0f) * g) * sg; }
                v2u w; w.x = pk4_fp8(a[0].x, a[0].y, a[1].x, a[1].y); w.y = pk4_fp8(a[2].x, a[2].y, a[3].x, a[3].y);
                if (m & 1) { const v4u ww = widen16(wprev, w);
                    *(v4u*)(ACT + (size_t)(row0 + ai * 128 + (m - 1 + (fq & 1)) * 16) * DFF + u.pn * 128 + wc * 32 + 16 * (fq >> 1)) = ww; }
                wprev = w; }
    }
};
struct EpiDN {
    static constexpr bool PERM = true, LBIAS = true;
    __device__ __forceinline__ int stores(const pg8::Unit&, int) const { return 8; }
    unsigned char* YA; const float* b_dn; const LAS int* TS;
    __device__ __forceinline__ const char* bias_src(const pg8::Unit& u) const { return (const char*)(b_dn + (size_t)u.e * D + u.pn * 256); }
    __device__ __forceinline__ void operator()(const f32x4 (&acc)[2][2][4][2], const pg8::Unit& u, int wr, int wc, int fr, int fq, const LAS float* bl) const {
        const int col0 = u.pn * 256 + wc * 32 + 8 * fq, cnt = TS[33 + u.e];
        f32x4 bv[2][2];
#pragma unroll
        for (int bj = 0; bj < 2; ++bj)
#pragma unroll
            for (int n = 0; n < 2; ++n) bv[bj][n] = *(const LAS f32x4*)(bl + wc * 32 + 8 * fq + bj * 128 + 4 * n);
#pragma unroll
        for (int ai = 0; ai < 2; ++ai)
#pragma unroll
            for (int m = 0; m < 4; m += 2) {
                const int r = ai * 128 + wr * 64 + (m + (fq & 1)) * 16 + fr;
                unsigned char* rowp = YA + ((size_t)u.pm * 256 + r) * D + u.pn * 256 + wc * 32 + 16 * (fq >> 1);
#pragma unroll
                for (int bj = 0; bj < 2; ++bj) { v2u w[2];
#pragma unroll
                    for (int q = 0; q < 2; ++q) { const f32x4 v0 = acc[ai][bj][m + q][0] * WSCALE_INV + bv[bj][0], v1 = acc[ai][bj][m + q][1] * WSCALE_INV + bv[bj][1];
                        w[q].x = pk4_fp8(v0[0], v0[1], v0[2], v0[3]); w[q].y = pk4_fp8(v1[0], v1[1], v1[2], v1[3]); }
                    const v4u ww = widen16(w[0], w[1]);
                    *(v4u*)(rowp + bj * 128) = ww; }
                asm volatile("" ::: "memory"); }
    }
};

constexpr int P0_TS = 144;
struct P0Item { const float* W; void* O; int N, k0, n0, kind; };
__device__ __forceinline__ P0Item p0_item(const Frame& F, CArgs* A, int it) {
    constexpr int I_IN = 8 * 25, I_OUT = 8 * 8, I_GU = 8 * 16, I_DN = 8 * 8;
    P0Item r; int x = it;
    if (x < I_IN) { r.W = A->in[7]; r.O = (void*)(F.ws + WS_WIN); r.N = 3104; r.k0 = (x / 25) * 128; r.n0 = (x % 25) * 128; r.kind = 3; return r; } x -= I_IN;
    if (x < I_OUT) { r.W = A->in[14]; r.O = (void*)(F.ws + WS_WOUT); r.N = D; r.k0 = (x >> 3) * 128; r.n0 = (x & 7) * 128; r.kind = OUTPROJ_F8 ? 1 : 0; return r; } x -= I_OUT;
    if (x < NEXP * I_GU) { const int e = x / I_GU, y = x % I_GU; r.W = A->in[18] + (size_t)e * D * 2048; r.O = (void*)((unsigned char*)F.out + DO_WGU + (size_t)e * 2048 * D); r.N = 2048; r.k0 = (y >> 4) * 128; r.n0 = (y & 15) * 128; r.kind = 2; return r; } x -= NEXP * I_GU;
    { const int e = x / I_DN, y = x % I_DN; r.W = A->in[20] + (size_t)e * D * D; r.O = (void*)((unsigned char*)F.out + DO_WDN + (size_t)e * D * D); r.N = D; r.k0 = (y >> 3) * 128; r.n0 = (y & 7) * 128; r.kind = 1; return r; }
}
__device__ __forceinline__ void p0_load(const P0Item& I, int tid, f32x4 (&v)[8]) {
#pragma unroll
    for (int q = 0; q < 8; ++q) { const int idx = tid + NTHREADS * q, k = idx >> 5, col = I.n0 + 4 * (idx & 31);
        v[q] = (col < I.N) ? *(const f32x4*)(I.W + (size_t)(I.k0 + k) * I.N + col) : (f32x4){0.f, 0.f, 0.f, 0.f}; }
}
__device__ __forceinline__ void p0_emit(const P0Item& I, LAS unsigned char* lds, int wave, int i, int g) {
    const unsigned a0 = (unsigned)(uintptr_t)lds + (unsigned)(((32 * g + (i >> 2)) * P0_TS + 16 * wave + 4 * (i & 3)) * 2);
    s16x4 r[8];
    asm volatile("ds_read_b64_tr_b16 %0, %8\n\tds_read_b64_tr_b16 %1, %8 offset:1152\n\tds_read_b64_tr_b16 %2, %8 offset:2304\n\tds_read_b64_tr_b16 %3, %8 offset:3456\n\t"
                 "ds_read_b64_tr_b16 %4, %8 offset:4608\n\tds_read_b64_tr_b16 %5, %8 offset:5760\n\tds_read_b64_tr_b16 %6, %8 offset:6912\n\tds_read_b64_tr_b16 %7, %8 offset:8064\n\ts_waitcnt lgkmcnt(0)"
                 : "=&v"(r[0]), "=&v"(r[1]), "=&v"(r[2]), "=&v"(r[3]), "=&v"(r[4]), "=&v"(r[5]), "=&v"(r[6]), "=&v"(r[7]) : "v"(a0) : "memory");
    const int n = I.n0 + 16 * wave + i;
    if (n < I.N) {
        if (I.kind == 0 || I.kind == 3) { bf16* op = (bf16*)I.O + (size_t)(I.kind == 3 ? win_row(n) : n) * D + I.k0 + 32 * g;
#pragma unroll
            for (int q = 0; q < 4; ++q) { v4u w; w.x = (unsigned)(unsigned short)r[2 * q][0] | ((unsigned)(unsigned short)r[2 * q][1] << 16); w.y = (unsigned)(unsigned short)r[2 * q][2] | ((unsigned)(unsigned short)r[2 * q][3] << 16);
                w.z = (unsigned)(unsigned short)r[2 * q + 1][0] | ((unsigned)(unsigned short)r[2 * q + 1][1] << 16); w.w = (unsigned)(unsigned short)r[2 * q + 1][2] | ((unsigned)(unsigned short)r[2 * q + 1][3] << 16);
                *(v4u*)(op + 8 * q) = w; } }
        else { int row = n; if (I.kind == 2) { const int jj = n >> 1; row = (jj >> 7) * 256 + (n & 1) * 128 + (jj & 127); }
            unsigned char* op = (unsigned char*)I.O + (size_t)row * D + I.k0 + 32 * g;
#pragma unroll
            for (int q = 0; q < 2; ++q) { v4u w; unsigned* wp = (unsigned*)&w;
#pragma unroll
                for (int j = 0; j < 4; ++j) { const s16x4 x = r[4 * q + j]; wp[j] = pk4_fp8(bf2f((bf16)x[0]) * WSCALE, bf2f((bf16)x[1]) * WSCALE, bf2f((bf16)x[2]) * WSCALE, bf2f((bf16)x[3]) * WSCALE); }
                *(v4u*)(op + 16 * q) = w; } } }
}
__device__ __forceinline__ void p0_phase(const Frame& F, CArgs* A) {
    LAS unsigned char* lds = F.lds; const int tid = F.tid, lane = F.lane, wave = F.wave, i = lane & 15, g = lane >> 4;
    constexpr int NITEMS = 8 * 25 + 8 * 8 + NEXP * 8 * 16 + NEXP * 8 * 8;
    { v4u z = {0u, 0u, 0u, 0u}; v4u* p = (v4u*)(((bf16*)(F.ws + WS_WIN)) + (size_t)3104 * D); const int n16 = (PWP - 3104) * D * 2 / 16;
      for (int i = F.bid * NTHREADS + F.tid; i < n16; i += F.G * NTHREADS) p[i] = z; }
    __syncthreads();
    LAS float* sl = (LAS float*)F.lds;
    LAS float* red = (LAS float*)(F.lds + 1024 * 20 * 4);
    bool filled = false;
    for (int it = F.bid; it < 6144 / 64; it += F.G) {
        if (!filled) {
            for (int i = F.tid; i < 17 * 1024; i += NTHREADS) { const int m = i >> 10, k = i & 1023; const float v = (m < 16) ? A->in[1][m * 1024 + k] : A->in[3][k]; sl[k * 20 + m] = v * __builtin_amdgcn_rcpf(1.0f + fexp(-v)); }
            filled = true; __syncthreads();
        }
        float a[17];
#pragma unroll
        for (int m = 0; m < 17; ++m) a[m] = 0.f;
        const int j = it * 64 + F.lane;
#pragma unroll 1
        for (int kb = 0; kb < 128; kb += 16) { float wv[16];
#pragma unroll
          for (int q = 0; q < 16; ++q) wv[q] = A->in[4][(size_t)(F.wave * 128 + kb + q) * 6144 + j];
#pragma unroll
          for (int q = 0; q < 16; ++q) { const int k = F.wave * 128 + kb + q; const float w = wv[q];
            const LAS float* sp = sl + k * 20;
            const f32x4 s0 = *(const LAS f32x4*)sp, s1 = *(const LAS f32x4*)(sp + 4), s2 = *(const LAS f32x4*)(sp + 8), s3 = *(const LAS f32x4*)(sp + 12); const float s4 = sp[16];
            a[0] += s0[0] * w; a[1] += s0[1] * w; a[2] += s0[2] * w; a[3] += s0[3] * w; a[4] += s1[0] * w; a[5] += s1[1] * w; a[6] += s1[2] * w; a[7] += s1[3] * w;
            a[8] += s2[0] * w; a[9] += s2[1] * w; a[10] += s2[2] * w; a[11] += s2[3] * w; a[12] += s3[0] * w; a[13] += s3[1] * w; a[14] += s3[2] * w; a[15] += s3[3] * w; a[16] += s4 * w; } }
#pragma unroll
        for (int m = 0; m < 17; ++m) red[(F.wave * 17 + m) * 64 + F.lane] = a[m];
        __syncthreads();
        for (int i = F.tid; i < 17 * 64; i += NTHREADS) { const int m = i >> 6, l = i & 63; float s = 0.f;
#pragma unroll
            for (int w = 0; w < 8; ++w) s += red[(w * 17 + m) * 64 + l];
            ((float*)(F.ws + WS_MOD))[(size_t)m * 6144 + it * 64 + l] = s + A->in[5][it * 64 + l]; }
        __syncthreads();
    }
    __syncthreads();
    int first = F.bid, stride = F.G, cnt = (NITEMS + F.G - 1) / F.G;
    if (F.G == 256) { if (F.bid >= 96) { first = F.bid - 96; stride = 160; cnt = 26; } else { first = 160 * 26 + F.bid; stride = 96; cnt = 24; } }
    static_assert(160 * 26 + 96 * 24 >= NITEMS, "P0 item split");
    f32x4 va[8], vb[8];
    if (first < NITEMS) { const P0Item I0 = p0_item(F, A, first); p0_load(I0, tid, va); }
    if (cnt > 1 && first + stride < NITEMS) { const P0Item I1 = p0_item(F, A, first + stride); p0_load(I1, tid, vb); }
#define P0_STEP(VCUR, k_) do { const int it_ = first + (k_) * stride; const P0Item I = p0_item(F, A, it_); \
        _Pragma("unroll") for (int q = 0; q < 8; ++q) { const int idx = tid + NTHREADS * q, k = idx >> 5, p = idx & 31; v2u w; w.x = pk2(VCUR[q][0], VCUR[q][1]); w.y = pk2(VCUR[q][2], VCUR[q][3]); \
            *(LAS v2u*)(lds + (k * P0_TS + 4 * p) * 2) = w; } \
        if ((k_) + 2 < cnt && it_ + 2 * stride < NITEMS) { const P0Item In = p0_item(F, A, it_ + 2 * stride); p0_load(In, tid, VCUR); } \
        LDS_BARRIER(); \
        p0_emit(I, lds, wave, i, g); \
        LDS_BARRIER(); } while (0)
#pragma unroll 1
    for (int k = 0; k < cnt && first + k * stride < NITEMS; k += 2) {
        P0_STEP(va, k);
        if (k + 1 < cnt && first + (k + 1) * stride < NITEMS) P0_STEP(vb, k + 1);
    }
#undef P0_STEP
}

__device__ __forceinline__ void p1_phase(const Frame& F, CArgs* A) {
    const int gw = F.bid * NWAVES + F.wave, NGW = F.G * NWAVES;
    const int cl = 4 * (F.lane & 15) + (F.lane >> 4), fq = F.lane >> 4;
    for (int r0 = gw; r0 < NROWS; r0 += 2 * NGW) {
        const int r1 = r0 + NGW; const bool two = r1 < NROWS;
        const float* xa = (r0 < NLAT) ? A->in[0] + (size_t)r0 * D : A->in[2] + (size_t)(r0 - NLAT) * D;
        const float* xb = !two ? xa : ((r1 < NLAT) ? A->in[0] + (size_t)r1 * D : A->in[2] + (size_t)(r1 - NLAT) * D);
        f32x4 va[4], vb[4];
#pragma unroll
        for (int j = 0; j < 4; ++j) { va[j] = ((const f32x4*)xa)[cl + 64 * j]; vb[j] = ((const f32x4*)xb)[cl + 64 * j]; }
#pragma unroll
        for (int which = 0; which < 2; ++which) { if (which == 1 && !two) break;
            const int r = which ? r1 : r0; const int mrow = (r < NLAT) ? (r >> 12) : 16;
            const float* sh = ((float*)(F.ws + WS_MOD)) + (size_t)mrow * 6144; const float* sc = sh + 1024;
            float s = 0.f;
#pragma unroll
            for (int j = 0; j < 4; ++j) { const f32x4 v = which ? vb[j] : va[j]; s += (v.x * v.x + v.y * v.y) + (v.z * v.z + v.w * v.w); }
            const float rstd = 1.0f / sqrtf(wave_sum(s) * (1.f / D) + EPS);
            unsigned char* orow = (unsigned char*)(((bf16*)(F.ws + WS_HN)) + (size_t)r * D);
            v2u pw[4];
#pragma unroll
            for (int j = 0; j < 4; ++j) { const int c4 = cl + 64 * j; const f32x4 v = which ? vb[j] : va[j]; const f32x4 w = ((const f32x4*)A->in[6])[c4], a = ((const f32x4*)sc)[c4], b = ((const f32x4*)sh)[c4];
                const f32x4 y = (v * rstd) * w * (a + 1.0f) + b;
                pw[j].x = pk2(y.x, y.y); pw[j].y = pk2(y.z, y.w); }
#pragma unroll
            for (int j = 0; j < 4; j += 2) { const v4u ww = widen16(pw[j], pw[j + 1]);
                *(v4u*)(orow + (size_t)(4 * (F.lane & 15) + 2 * (fq >> 1) + 64 * (j + (fq & 1))) * 8) = ww; } }
    }
}

constexpr int GL_ZL = 0;
constexpr int GL_BC = 8192;
constexpr int GL_TOT = GL_BC + 32768;
constexpr int GL_V = GL_TOT + 512;
constexpr int GL_A = GL_V + 64 * 136 * 2;
constexpr int GL_B = GL_A + 2 * 64 * 72 * 2;
constexpr int GL_P = GL_B + 2 * 64 * 72 * 2;
constexpr int GL_SS = GL_P + 64 * 72 * 2;
constexpr int GL_SEG = GL_SS + 512;
constexpr int GL_END = GL_SEG + 2048;
static_assert(GL_END <= RING_BYTES && (GL_V % 16) == 0 && (GL_A % 16) == 0 && (GL_B % 16) == 0 && (GL_P % 16) == 0, "GLA LDS map");

__device__ __forceinline__ s16x4 tr_read(unsigned lds_addr) { s16x4 r; asm volatile("ds_read_b64_tr_b16 %0, %1\n\ts_waitcnt lgkmcnt(0)" : "=&v"(r) : "v"(lds_addr) : "memory"); return r; }
__device__ __forceinline__ void v_frag2(LAS unsigned char* lds, int v0, int lane, bf16x8& f0, bf16x8& f1) {
    const int i = lane & 15, g = lane >> 4;
    const unsigned a0 = (unsigned)(uintptr_t)(lds + GL_V) + (unsigned)(((8 * g + (i >> 2)) * 136 + v0 + 4 * (i & 3)) * 2);
    s16x4 r0, r1, r2, r3;
    asm volatile("ds_read_b64_tr_b16 %0, %4\n\tds_read_b64_tr_b16 %1, %4 offset:1088\n\tds_read_b64_tr_b16 %2, %4 offset:8704\n\tds_read_b64_tr_b16 %3, %4 offset:9792\n\ts_waitcnt lgkmcnt(0)"
                 : "=&v"(r0), "=&v"(r1), "=&v"(r2), "=&v"(r3) : "v"(a0) : "memory");
    f0[0] = r0[0]; f0[1] = r0[1]; f0[2] = r0[2]; f0[3] = r0[3]; f0[4] = r1[0]; f0[5] = r1[1]; f0[6] = r1[2]; f0[7] = r1[3];
    f1[0] = r2[0]; f1[1] = r2[1]; f1[2] = r2[2]; f1[3] = r2[3]; f1[4] = r3[0]; f1[5] = r3[1]; f1[6] = r3[2]; f1[7] = r3[3];
}
__device__ __forceinline__ bf16x8 v_frag(LAS unsigned char* lds, int ks, int v0, int lane) {
    const int i = lane & 15, g = lane >> 4;
    const unsigned a0 = (unsigned)(uintptr_t)(lds + GL_V) + (unsigned)(((32 * ks + 8 * g + (i >> 2)) * 136 + v0 + 4 * (i & 3)) * 2);
    const s16x4 lo = tr_read(a0), hi = tr_read(a0 + 4 * 136 * 2);
    bf16x8 r; r[0] = lo[0]; r[1] = lo[1]; r[2] = lo[2]; r[3] = lo[3]; r[4] = hi[0]; r[5] = hi[1]; r[6] = hi[2]; r[7] = hi[3]; return r;
}
struct GlaRegs { v4u zw, vw[2]; };

__device__ __forceinline__ size_t chunk_row(int b, int cc) { return cc < 4 ? (size_t)NLAT + b * CTXL + cc * 64 : (size_t)b * SEQ + (cc - 4) * 64; }

constexpr int G2_ZL = 0;
constexpr int G2_HT = 8192;
constexpr int G2_TOT = G2_HT + 4096;
constexpr int G2_A = G2_TOT + 1024;
constexpr int G2_B = G2_A + 256 * 72 * 2;
constexpr int G2_VS = 528;
static_assert(G2_B + 64 * G2_VS * 2 <= RING_BYTES && G2_B + 256 * 72 * 2 <= RING_BYTES && (G2_A % 16) == 0 && (G2_B % 16) == 0, "GLA v2 LDS map");
__device__ __forceinline__ void tr_frag2(unsigned tile_addr, int c0, int lane, bf16x8& f0, bf16x8& f1) {
    const int i = lane & 15, g = lane >> 4;
    const unsigned a0 = tile_addr + (unsigned)(((8 * g + (i >> 2)) * G2_VS + c0 + 4 * (i & 3)) * 2);
    s16x4 r0, r1, r2, r3;
    asm volatile("ds_read_b64_tr_b16 %0, %4\n\tds_read_b64_tr_b16 %1, %4 offset:4224\n\tds_read_b64_tr_b16 %2, %4 offset:33792\n\tds_read_b64_tr_b16 %3, %4 offset:38016\n\ts_waitcnt lgkmcnt(0)"
                 : "=&v"(r0), "=&v"(r1), "=&v"(r2), "=&v"(r3) : "v"(a0) : "memory");
    f0[0] = r0[0]; f0[1] = r0[1]; f0[2] = r0[2]; f0[3] = r0[3]; f0[4] = r1[0]; f0[5] = r1[1]; f0[6] = r1[2]; f0[7] = r1[3];
    f1[0] = r2[0]; f1[1] = r2[1]; f1[2] = r2[2]; f1[3] = r2[3]; f1[4] = r3[0]; f1[5] = r3[1]; f1[6] = r3[2]; f1[7] = r3[3];
}
static_assert(4 * G2_VS * 2 == 4224 && 32 * G2_VS * 2 == 33792 && 36 * G2_VS * 2 == 38016, "tr_frag2 offsets");
__device__ __forceinline__ float log_sigmoid16(float z) { return (fminf(z, 0.f) - __logf(1.0f + __expf(-fabsf(z)))) * (1.0f / 16.0f); }


struct GateConst { bf16x8 bw[2][2]; float bias[2][2]; };
__device__ __forceinline__ GateConst gate_setup(CArgs* A, int wave, int lane) {
    GateConst G; const int i = lane & 15, g = lane >> 4;
#pragma unroll
    for (int dir = 0; dir < 2; ++dir)
#pragma unroll
        for (int cti = 0; cti < 2; ++cti) { const int c = 32 * wave + 16 * cti + i; const float* up = dir ? A->in[10] : A->in[8];
            G.bias[dir][cti] = (dir ? A->in[11] : A->in[9])[c];
#pragma unroll
            for (int jj = 0; jj < 8; ++jj) { const float v = up[(8 * (g & 1) + jj) * 256 + c]; const unsigned hi = f2bf(v); const float rem = v - __builtin_bit_cast(float, hi << 16);
                G.bw[dir][cti][jj] = (short)((g < 2) ? hi : f2bf(rem)); } }
    return G;
}
__device__ __forceinline__ float log_sigmoid16_fast(float z) { const float e = __builtin_amdgcn_exp2f(fabsf(z) * -1.4426950409f); return (fminf(z, 0.f) - __builtin_amdgcn_logf(1.0f + e) * 0.6931471806f) * 0.0625f; }
__device__ __forceinline__ void gate_b_load(const bf16* P, size_t prow, int lane, bf16x8 (&za)[2][4]) {
    const int i = lane & 15, g = lane >> 4;
#pragma unroll
    for (int dir = 0; dir < 2; ++dir)
#pragma unroll
        for (int tt = 0; tt < 4; ++tt) za[dir][tt] = *(const bf16x8*)(P + (prow + 16 * tt + i) * PW + CAF + 16 * dir + 8 * (g & 1));
}
__device__ __forceinline__ void gate_b(const GateConst& G, const bf16x8 (&za)[2][4], int lane, f32x4 (&bv)[2][2][4], float (&tot)[2][2]) {
    const int i = lane & 15, g = lane >> 4;
#pragma unroll
    for (int dir = 0; dir < 2; ++dir)
#pragma unroll
        for (int cti = 0; cti < 2; ++cti) { float carry = 0.f;
#pragma unroll
            for (int q = 0; q < 4; ++q) { const int tt = dir ? 3 - q : q;
                f32x4 z = {0.f, 0.f, 0.f, 0.f}; z = __builtin_amdgcn_mfma_f32_16x16x32_bf16(za[dir][tt], G.bw[dir][cti], z, 0, 0, 0);
                float la[4];
#pragma unroll
                for (int r = 0; r < 4; ++r) la[r] = log_sigmoid16_fast(z[r] + G.bias[dir][cti]);
                float p[4];
                if (dir == 0) { p[0] = la[0]; p[1] = p[0] + la[1]; p[2] = p[1] + la[2]; p[3] = p[2] + la[3];
                    const float s = p[3]; float incl = s; const float t1 = __shfl_up(incl, 16); if (g >= 1) incl += t1; const float t2 = __shfl_up(incl, 32); if (g >= 2) incl += t2;
                    const float base = carry + (incl - s); carry += __shfl(incl, 48 + i);
                    bv[dir][cti][tt] = (f32x4){base + p[0], base + p[1], base + p[2], base + p[3]}; }
                else { p[3] = la[3]; p[2] = p[3] + la[2]; p[1] = p[2] + la[1]; p[0] = p[1] + la[0];
                    const float s = p[0]; float incl = s; const float t1 = __shfl_down(incl, 16); if (g <= 2) incl += t1; const float t2 = __shfl_down(incl, 32); if (g <= 1) incl += t2;
                    const float base = carry + (incl - s); carry += __shfl(incl, i);
                    bv[dir][cti][tt] = (f32x4){base + p[0], base + p[1], base + p[2], base + p[3]}; } }
            tot[dir][cti] = carry; }
}

constexpr int G3_ST = 0;
constexpr int G3_TOT = 8 * 16 * 144;
constexpr int G3_A = G3_TOT + 1024;
constexpr int G3_B = G3_A + 256 * 72 * 2;
static_assert(G3_B + 64 * G2_VS * 2 <= RING_BYTES && (G3_A % 16) == 0 && (G3_B % 16) == 0, "P3 LDS map");
template <int MODE>
__device__ __forceinline__ void p3v3_phase(const Frame& F, CArgs* A) {
    int tid_ = F.tid; asm volatile("" : "+v"(tid_));
    LAS unsigned char* lds = F.lds; const int tid = tid_, lane = tid & 63, wave = __builtin_amdgcn_readfirstlane(tid >> 6), i = lane & 15, g = lane >> 4;
    const bf16* P = (const bf16*)(F.ws + WS_P);
    const GateConst G = gate_setup(A, wave, lane);
    LAS unsigned char* st = lds + G3_ST + wave * (16 * 144);
    bf16x8 zn[2][4];
#define P3_LOAD_SMALL(it_) do { const size_t pr_ = chunk_row((it_) / NCC, (it_) % NCC); gate_b_load(P, pr_, lane, zn); } while (0)
    if (F.bid < NBATCH * NCC) P3_LOAD_SMALL(F.bid);
#pragma unroll 1
    for (int it = F.bid; it < NBATCH * NCC; it += F.G) {
        const int b = it / NCC, cc = it % NCC; const size_t prow = chunk_row(b, cc);
        unsigned pf0 = 0u, pf1 = 0u;
        bf16x8 za[2][4];
#pragma unroll
        for (int a_ = 0; a_ < 2; ++a_)
#pragma unroll
            for (int b_ = 0; b_ < 4; ++b_) za[a_][b_] = zn[a_][b_];
        unsigned kk[2][4][2];
#pragma unroll
        for (int cti = 0; cti < 2; ++cti)
#pragma unroll
            for (int tt = 0; tt < 4; ++tt)
#pragma unroll
                for (int r = 0; r < 4; r += 2) { const bf16* kp = P + (prow + 16 * tt + 4 * g + r) * PW + CK + 32 * wave + 16 * cti + i; kk[cti][tt][r >> 1] = (unsigned)kp[0] | ((unsigned)kp[PW] << 16); }
#pragma unroll
        for (int j = 0; j < 8; ++j) { const int t = wave + 8 * j;
            __builtin_amdgcn_global_load_lds((const unsigned*)(P + (prow + t) * PW + CV + lane * 8), (LAS unsigned*)(lds + G3_B + t * G2_VS * 2), 16, 0, 0); }
        f32x4 bv[2][2][4]; float tot[2][2];
        if (MODE < 4) gate_b(G, za, lane, bv, tot); else {
#pragma unroll
            for (int a_ = 0; a_ < 2; ++a_)
#pragma unroll
                for (int b_ = 0; b_ < 2; ++b_) { tot[a_][b_] = 0.f;
#pragma unroll
                    for (int c_ = 0; c_ < 4; ++c_) bv[a_][b_][c_] = (f32x4){0.f, 0.f, 0.f, 0.f}; } }
#pragma unroll
        for (int dir = 0; dir < 2; ++dir) {
#pragma unroll
            for (int cti = 0; cti < 2; ++cti) { const int c = 32 * wave + 16 * cti + i;
#pragma unroll
                for (int tt = 0; tt < 4; ++tt) { float e[4];
#pragma unroll
                    for (int r = 0; r < 4; ++r) e[r] = ((r & 1) ? bfhi(kk[cti][tt][r >> 1]) : bflo(kk[cti][tt][r >> 1])) * __builtin_amdgcn_exp2f(bv[dir][cti][tt][r] * -1.4426950409f);
                    v2u w; w.x = pk2(e[0], e[1]); w.y = pk2(e[2], e[3]);
                    *(LAS v2u*)(lds + G3_A + (c * 72 + 16 * tt + 4 * g) * 2) = w; }
                if (g == 0) { const float et = __expf(tot[dir][cti]); ((LAS float*)(lds + G3_TOT))[c] = et;
                    if (!MODE) ((float*)(F.ws + WS_DECAY))[(((size_t)dir * NBATCH + b) * NCC + cc) * 256 + c] = et; } }
            if (dir == 0) asm volatile("s_waitcnt vmcnt(0)" ::: "memory");
            LDS_BARRIER();
            if (dir == 0) { const int itp = (it + F.G < NBATCH * NCC) ? it + F.G : it; P3_LOAD_SMALL(itp); }
            if (dir == 0) {
                const int itn = it + F.G; if (NOTOUCH3 == 0 && itn < NBATCH * NCC) { const char* pr = (const char*)(P + (chunk_row(itn / NCC, itn % NCC) + (tid >> 3)) * PW); const int j = tid & 7;
                    pf0 = *(const unsigned*)(pr + 512 + 128 * j); pf1 = *(const unsigned*)(pr + (j < 5 ? 512 + 128 * (8 + j) : 3072 + 32 * (j - 5))); } }
            if (MODE < 3) { const int h = wave >> 1, vh = wave & 1;
              bf16x8 af[4][2];
#pragma unroll
              for (int dt = 0; dt < 4; ++dt)
#pragma unroll
                  for (int ks = 0; ks < 2; ++ks) af[dt][ks] = *(const LAS bf16x8*)(lds + G3_A + ((h * 64 + dt * 16 + i) * 72 + 32 * ks + 8 * g) * 2);
              bf16* kvp = ((bf16*)(F.ws + WS_KV)) + ((((size_t)dir * NBATCH + b) * NCC + cc) * 4 + h) * 8192;
              bf16* vtp = ((bf16*)(F.ws + WS_VT)) + (((size_t)b * 64 + (cc - 4)) * 4 + h) * 8192;
              if (MODE) { kvp = ((bf16*)(F.ws + WS_TOTAL)) + (size_t)(F.bid * 8 + wave) * 512; vtp = kvp + 1024 * 1024; }
#pragma unroll
              for (int vt = 0; vt < 4; ++vt) { const int v0 = vh * 64 + vt * 16; bf16x8 vf0, vf1; tr_frag2((unsigned)(uintptr_t)(lds + G3_B), h * 128 + v0, lane, vf0, vf1);
                  if (dir == 0 && cc >= 4) {
                      *(LAS bf16x8*)(st + i * 144 + 16 * g) = vf0; *(LAS bf16x8*)(st + i * 144 + 64 + 16 * g) = vf1;
                      LDS_WAIT();
#pragma unroll
                      for (int j = 0; j < 2; ++j) { const int pc = lane + 64 * j, row = pc >> 3, ch = pc & 7; const v4u x_ = *(const LAS v4u*)(st + row * 144 + ch * 16); if (MODE == 2) asm volatile("" :: "v"(x_)); else *(v4u*)(vtp + (size_t)((MODE ? 0 : v0) + row) * 64 + ch * 8) = x_; }
                      LDS_WAIT(); }
#pragma unroll
                  for (int dt = 0; dt < 4; ++dt) { f32x4 acc = {0.f, 0.f, 0.f, 0.f};
                      acc = __builtin_amdgcn_mfma_f32_16x16x32_bf16(af[dt][0], vf0, acc, 0, 0, 0); acc = __builtin_amdgcn_mfma_f32_16x16x32_bf16(af[dt][1], vf1, acc, 0, 0, 0);
                      acc = acc * *(const LAS f32x4*)(lds + G3_TOT + (h * 64 + dt * 16 + 4 * g) * 4);
                      v2u w; w.x = pk2(acc[0], acc[1]); w.y = pk2(acc[2], acc[3]);
                      *(LAS v2u*)(st + i * 144 + (16 * dt + 4 * g) * 2) = w; }
                  LDS_WAIT();
#pragma unroll
                  for (int j = 0; j < 2; ++j) { const int pc = lane + 64 * j, row = pc >> 3, ch = pc & 7; const v4u x_ = *(const LAS v4u*)(st + row * 144 + ch * 16); if (MODE == 2) asm volatile("" :: "v"(x_)); else *(v4u*)(kvp + (size_t)((MODE ? 0 : v0) + row) * 64 + ch * 8) = x_; }
                  LDS_WAIT(); } }
            LDS_BARRIER();
        }
        asm volatile("" :: "v"(pf0), "v"(pf1));
    }
}

struct ConvRegs { v4u uw[6], bw[4]; };
__device__ __forceinline__ void conv_load(const bf16* P, int u, int t, ConvRegs& R) {
    const int item = u >> 1, b = item >> 6, n = item & 63; const size_t prow = (size_t)b * SEQ + n * 64; const int t0 = (u & 1) * 32 + (t >> 6) * 4, c0 = (t & 63) * 8;
#pragma unroll
    for (int q = 0; q < 6; ++q) { const int tt = t0 - 1 + q, tc = tt < 0 ? 0 : (tt > 63 ? 63 : tt);
        R.uw[q] = *(const v4u*)(P + (prow + tc) * PW + CU + c0); }
#pragma unroll
    for (int q = 0; q < 4; ++q) R.bw[q] = *(const v4u*)(P + (prow + t0 + q) * PW + CPB + c0);
}
__device__ __forceinline__ void conv_pin(ConvRegs& R) {
    asm volatile("" ::: "memory");
#pragma unroll
    for (int q = 0; q < 6; ++q) asm volatile("" : "+v"(R.uw[q]));
#pragma unroll
    for (int q = 0; q < 4; ++q) asm volatile("" : "+v"(R.bw[q]));
}
__device__ __forceinline__ void conv_emit(unsigned char* ws, const f32x2 (&w2)[3][4], int u, int t, const ConvRegs& R) {
    const int item = u >> 1, b = item >> 6, n = item & 63; const size_t prow = (size_t)b * SEQ + n * 64; const int t0 = (u & 1) * 32 + (t >> 6) * 4, c0 = (t & 63) * 8;
    f32x2 ov[4][4];
#pragma unroll
    for (int j = 0; j < 4; ++j)
#pragma unroll
        for (int p = 0; p < 4; ++p) ov[j][p] = (f32x2){0.f, 0.f};
#pragma unroll
    for (int q = 0; q < 6; ++q) { const int tt = t0 - 1 + q; const bool in = tt >= 0 && tt < 64; v4u c_ = R.uw[q]; f32x2 uu[4];
        c_.x = in ? c_.x : 0u; c_.y = in ? c_.y : 0u; c_.z = in ? c_.z : 0u; c_.w = in ? c_.w : 0u;
        uu[0] = (f32x2){bflo(c_.x), bfhi(c_.x)}; uu[1] = (f32x2){bflo(c_.y), bfhi(c_.y)}; uu[2] = (f32x2){bflo(c_.z), bfhi(c_.z)}; uu[3] = (f32x2){bflo(c_.w), bfhi(c_.w)};
#pragma unroll
        for (int dt = 0; dt < 3; ++dt) { const int j = q - dt;
            if (j >= 0 && j < 4) {
#pragma unroll
                for (int p = 0; p < 4; ++p) ov[j][p] += w2[dt][p] * uu[p]; } } }
#pragma unroll
    for (int q = 0; q < 4; ++q) { const v4u b_ = R.bw[q];
        const f32x2 y0 = ov[q][0] * (f32x2){bflo(b_.x), bfhi(b_.x)}, y1 = ov[q][1] * (f32x2){bflo(b_.y), bfhi(b_.y)}, y2 = ov[q][2] * (f32x2){bflo(b_.z), bfhi(b_.z)}, y3 = ov[q][3] * (f32x2){bflo(b_.w), bfhi(b_.w)};
        if (OUTPROJ_F8) { v2u w; w.x = pk4_fp8(y0.x, y0.y, y1.x, y1.y); w.y = pk4_fp8(y2.x, y2.y, y3.x, y3.y);
            *(v2u*)(ws + WS_YMIX + (prow + t0 + q) * D + 512 + c0) = w; }
        else { v4u w; w.x = pk2(y0.x, y0.y); w.y = pk2(y1.x, y1.y); w.z = pk2(y2.x, y2.y); w.w = pk2(y3.x, y3.y);
            *(v4u*)(((bf16*)(ws + WS_YMIX)) + (prow + t0 + q) * D + 512 + c0) = w; } }
}
__device__ __forceinline__ void conv_stream(const Frame& F, CArgs* A, int t) {
    const bf16* P = (const bf16*)(F.ws + WS_P);
    constexpr int NU = NBATCH * 64 * 2;
    f32x2 w2[3][4];
    { const int c0 = (t & 63) * 8;
#pragma unroll
      for (int dt = 0; dt < 3; ++dt) { const f32x4 a = *(const f32x4*)(A->in[13] + dt * 512 + c0), b = *(const f32x4*)(A->in[13] + dt * 512 + c0 + 4);
          w2[dt][0] = (f32x2){a[0], a[1]}; w2[dt][1] = (f32x2){a[2], a[3]}; w2[dt][2] = (f32x2){b[0], b[1]}; w2[dt][3] = (f32x2){b[2], b[3]}; } }
    ConvRegs Ra, Rb;
    int u = F.bid;
    if (u < NU) conv_load(P, u, t, Ra);
#pragma unroll 1
    for (; u < NU; u += 2 * F.G) {
        const int un = (u + F.G < NU) ? u + F.G : u, un2 = (u + 2 * F.G < NU) ? u + 2 * F.G : u;
        conv_load(P, un, t, Rb); conv_pin(Ra);
        conv_emit(F.ws, w2, u, t, Ra);
        conv_load(P, un2, t, Ra); conv_pin(Rb);
        conv_emit(F.ws, w2, un, t, Rb);
    }
}

__device__ __forceinline__ void gate_dir_load(const bf16* P, size_t prow, int lane, int dir, bf16x8 (&za)[4]) {
    const int i = lane & 15, g = lane >> 4;
#pragma unroll
    for (int tt = 0; tt < 4; ++tt) za[tt] = *(const bf16x8*)(P + (prow + 16 * tt + i) * PW + CAF + 16 * dir + 8 * (g & 1));
}
__device__ __forceinline__ void gate_b_dir(const GateConst& G, const bf16x8 (&za)[4], int lane, int dir, f32x4 (&bv)[2][4]) {
    const int i = lane & 15, g = lane >> 4;
#pragma unroll
    for (int cti = 0; cti < 2; ++cti) { float carry = 0.f;
#pragma unroll
        for (int q = 0; q < 4; ++q) { const int tt = dir ? 3 - q : q;
            f32x4 z = {0.f, 0.f, 0.f, 0.f}; z = __builtin_amdgcn_mfma_f32_16x16x32_bf16(za[tt], G.bw[dir][cti], z, 0, 0, 0);
            float la[4];
#pragma unroll
            for (int r = 0; r < 4; ++r) la[r] = log_sigmoid16_fast(z[r] + G.bias[dir][cti]);
            float p[4];
            if (dir == 0) { p[0] = la[0]; p[1] = p[0] + la[1]; p[2] = p[1] + la[2]; p[3] = p[2] + la[3];
                const float s = p[3]; float incl = s; const float t1 = __shfl_up(incl, 16); if (g >= 1) incl += t1; const float t2 = __shfl_up(incl, 32); if (g >= 2) incl += t2;
                const float base = carry + (incl - s); carry += __shfl(incl, 48 + i);
                bv[cti][tt] = (f32x4){base + p[0], base + p[1], base + p[2], base + p[3]}; }
            else { p[3] = la[3]; p[2] = p[3] + la[2]; p[1] = p[2] + la[1]; p[0] = p[1] + la[0];
                const float s = p[0]; float incl = s; const float t1 = __shfl_down(incl, 16); if (g <= 2) incl += t1; const float t2 = __shfl_down(incl, 32); if (g <= 1) incl += t2;
                const float base = carry + (incl - s); carry += __shfl(incl, i);
                bv[cti][tt] = (f32x4){base + p[0], base + p[1], base + p[2], base + p[3]}; } } }
}

constexpr int G5_Q = 0;
constexpr int G5_K = 4 * 64 * 72 * 2;
constexpr int G5_P = 2 * G5_K;
constexpr int G5_GW = 131072 + 12288;
static_assert(G5_P + 4 * 64 * 72 * 2 <= RING_BYTES && 8 * 16 * 272 <= G5_K, "P5 LDS map");
template <int MODE>
__device__ __forceinline__ void p5av3_phase(const Frame& F, CArgs* A) {
    LAS unsigned char* lds = F.lds;
    const bf16* P = (const bf16*)(F.ws + WS_P);
    const GateConst G = gate_setup(A, F.wave, F.lane);
    if (F.tid < 32) *(LAS f32x4*)(lds + G5_GW + F.tid * 16) = *(const f32x4*)(A->in[12] + F.tid * 4);
    __syncthreads();
#pragma unroll 1
    for (int it_ = F.bid; it_ < P5REP * NBATCH * 64; it_ += F.G) { const int it = it_ & (NBATCH * 64 - 1);
        int tid_ = F.tid; asm volatile("" : "+v"(tid_));
        const int tid = tid_, lane = tid & 63, wave = __builtin_amdgcn_readfirstlane(tid >> 6), i = lane & 15, g = lane >> 4;
        const int h = wave >> 1, half = wave & 1;
        LAS unsigned char* st = lds + G5_Q + wave * (16 * 272);
        const int b = it >> 6, n = it & 63; const size_t prow = (size_t)b * SEQ + n * 64;
        unsigned pfv[9];
#pragma unroll
        for (int q = 0; q < 9; ++q) pfv[q] = 0u;
        const int dh = 32 * half + i;
        f32x4 pdiag[2], oacc[2][8];
#pragma unroll
        for (int a = 0; a < 2; ++a) { pdiag[a] = (f32x4){0.f, 0.f, 0.f, 0.f};
#pragma unroll
            for (int q = 0; q < 8; ++q) oacc[a][q] = (f32x4){0.f, 0.f, 0.f, 0.f}; }
        unsigned qk[2][4][4];
#pragma unroll
        for (int cti = 0; cti < 2; ++cti)
#pragma unroll
            for (int tt = 0; tt < 4; ++tt)
#pragma unroll
                for (int r = 0; r < 4; ++r) { const bf16* rp = P + (prow + 16 * tt + 4 * g + r) * PW + h * 64 + dh + 16 * cti; qk[cti][tt][r] = (unsigned)rp[CQ] | ((unsigned)rp[CK] << 16); }
        bf16x8 zg0[4], zg1[4];
        gate_dir_load(P, prow, lane, 0, zg0); gate_dir_load(P, prow, lane, 1, zg1);
#pragma unroll
        for (int dir = 0; dir < (MODE >= 4 ? 0 : 2); ++dir) {
            { f32x4 bv[2][4]; gate_b_dir(G, dir == 0 ? zg0 : zg1, lane, dir, bv);
#pragma unroll
              for (int cti = 0; cti < 2; ++cti)
#pragma unroll
                  for (int tt = 0; tt < 4; ++tt)
#pragma unroll
                      for (int r = 0; r < 4; ++r) { const float e = __builtin_amdgcn_exp2f(bv[cti][tt][r] * 1.4426950409f); const unsigned w = qk[cti][tt][r];
                          const int off = ((h * 64 + 16 * tt + 4 * g + r) * 72 + dh + 16 * cti) * 2;
                          *(LAS bf16*)(lds + G5_Q + off) = (bf16)f2bf(bflo(w) * e * 0.125f); *(LAS bf16*)(lds + G5_K + off) = (bf16)f2bf(bfhi(w) * __builtin_amdgcn_rcpf(e)); } }
            LDS_BARRIER();
            if (MODE < 3) { bf16x8 qf[2][2];
#pragma unroll
              for (int tti = 0; tti < 2; ++tti)
#pragma unroll
                  for (int ks = 0; ks < 2; ++ks) qf[tti][ks] = *(const LAS bf16x8*)(lds + G5_Q + ((h * 64 + (2 * half + tti) * 16 + i) * 72 + 32 * ks + 8 * g) * 2);
              const bf16* sp = ((const bf16*)(F.ws + WS_S)) + ((((size_t)dir * NBATCH + b) * 64 + n) * 4 + h) * 8192 + (size_t)i * 64 + 8 * g;
              bf16x8 sfr[8][2];
#pragma unroll
              for (int vt = 0; vt < 8; ++vt) { sfr[vt][0] = *(const bf16x8*)(sp + (size_t)vt * 1024); sfr[vt][1] = *(const bf16x8*)(sp + (size_t)vt * 1024 + 32); }
#pragma unroll
              for (int st_ = 0; st_ < 4; ++st_) { const bf16x8 kf0 = *(const LAS bf16x8*)(lds + G5_K + ((h * 64 + st_ * 16 + i) * 72 + 8 * g) * 2), kf1 = *(const LAS bf16x8*)(lds + G5_K + ((h * 64 + st_ * 16 + i) * 72 + 32 + 8 * g) * 2);
#pragma unroll
                  for (int tti = 0; tti < 2; ++tti) { const int tt = 2 * half + tti;
                      if (dir == 0 ? (st_ <= tt) : (st_ >= tt)) { f32x4 a = {0.f, 0.f, 0.f, 0.f};
                          a = __builtin_amdgcn_mfma_f32_16x16x32_bf16(kf0, qf[tti][0], a, 0, 0, 0); a = __builtin_amdgcn_mfma_f32_16x16x32_bf16(kf1, qf[tti][1], a, 0, 0, 0);
                          const int t = tt * 16 + i, s0 = st_ * 16 + 4 * g;
                          if (st_ == tt) {
#pragma unroll
                              for (int r = 0; r < 4; ++r) pdiag[tti][r] += (dir == 0 ? (s0 + r <= t) : (s0 + r >= t)) ? a[r] : 0.f;
                              a = pdiag[tti]; }
                          if (st_ != tt || dir == 1) { v2u w; w.x = pk2(a[0], a[1]); w.y = pk2(a[2], a[3]);
                              *(LAS v2u*)(lds + G5_P + ((h * 64 + t) * 72 + s0) * 2) = w; } } } }
#pragma unroll
              for (int vt = 0; vt < 8; ++vt) {
#pragma unroll
                  for (int tti = 0; tti < 2; ++tti) { oacc[tti][vt] = __builtin_amdgcn_mfma_f32_16x16x32_bf16(sfr[vt][0], qf[tti][0], oacc[tti][vt], 0, 0, 0); oacc[tti][vt] = __builtin_amdgcn_mfma_f32_16x16x32_bf16(sfr[vt][1], qf[tti][1], oacc[tti][vt], 0, 0, 0); }
                  asm volatile("" : "+v"(oacc[0][vt]), "+v"(oacc[1][vt]) :: "memory");
                  } }
            LDS_BARRIER();
        }
        LDS_WAIT();
        v2u rwv[2][8];
        if (MODE < 2) {
#pragma unroll
            for (int tti = 0; tti < 2; ++tti)
#pragma unroll
                for (int vt = 0; vt < 8; ++vt) rwv[tti][vt] = *(const v2u*)(P + (prow + (2 * half + tti) * 16 + i) * PW + CR + h * 128 + vt * 16 + 4 * g); }
        if (MODE < 2) { bf16x8 pfr[2][2];
#pragma unroll
          for (int tti = 0; tti < 2; ++tti)
#pragma unroll
              for (int ks = 0; ks < 2; ++ks) pfr[tti][ks] = *(const LAS bf16x8*)(lds + G5_P + ((h * 64 + (2 * half + tti) * 16 + i) * 72 + 32 * ks + 8 * g) * 2);
          const bf16* vp = ((const bf16*)(F.ws + WS_VT)) + (((size_t)b * 64 + n) * 4 + h) * 8192 + (size_t)i * 64 + 8 * g;
          bf16x8 vfr[8][2];
#pragma unroll
          for (int vt = 0; vt < 8; ++vt) { vfr[vt][0] = *(const bf16x8*)(vp + (size_t)vt * 1024); vfr[vt][1] = *(const bf16x8*)(vp + (size_t)vt * 1024 + 32); }
          { const int itn = it + F.G; if (NOTOUCH5 == 0 && itn < NBATCH * 64) { const int bn_ = itn >> 6, nn_ = itn & 63; const char* pr = (const char*)(P + ((size_t)bn_ * SEQ + nn_ * 64 + (tid >> 3)) * PW); const int j = tid & 7;
                pfv[0] = *(const unsigned*)(pr + 128 * j); pfv[1] = *(const unsigned*)(pr + 2048 + 128 * j); if (j == 0) pfv[2] = *(const unsigned*)(pr + 3072);
                const char* sb = (const char*)(((const bf16*)(F.ws + WS_S)) + (((size_t)bn_ * 64 + nn_) * 4) * 8192) + (size_t)tid * 128;
                pfv[6] = *(const unsigned*)sb; pfv[7] = *(const unsigned*)(sb + (size_t)NBATCH * 64 * 4 * 8192 * 2);
                pfv[8] = *(const unsigned*)((const char*)(((const bf16*)(F.ws + WS_VT)) + (((size_t)bn_ * 64 + nn_) * 4) * 8192) + (size_t)tid * 128); } }
#pragma unroll
          for (int vt = 0; vt < 8; ++vt)
#pragma unroll
              for (int tti = 0; tti < 2; ++tti) { oacc[tti][vt] = __builtin_amdgcn_mfma_f32_16x16x32_bf16(vfr[vt][0], pfr[tti][0], oacc[tti][vt], 0, 0, 0); oacc[tti][vt] = __builtin_amdgcn_mfma_f32_16x16x32_bf16(vfr[vt][1], pfr[tti][1], oacc[tti][vt], 0, 0, 0); } }
#pragma unroll
        for (int tti = 0; tti < (MODE >= 2 ? 0 : 2); ++tti) { const int t = (2 * half + tti) * 16 + i; float ss = 0.f;
#pragma unroll
            for (int vt = 0; vt < 8; ++vt) { const f32x4 a = oacc[tti][vt]; ss += (a[0] * a[0] + a[1] * a[1]) + (a[2] * a[2] + a[3] * a[3]); }
            ss += __shfl_xor(ss, 16); ss += __shfl_xor(ss, 32);
            const float rstd = 1.0f / sqrtf(ss * (1.0f / 128.0f) + EPS);
#pragma unroll
            for (int vt = 0; vt < 8; ++vt) { const int v = vt * 16 + 4 * g; const f32x4 gw = *(const LAS f32x4*)(lds + G5_GW + v * 4); const v2u rw = rwv[tti][vt];
                const float r[4] = {bflo(rw.x), bfhi(rw.x), bflo(rw.y), bfhi(rw.y)}; float y[4];
#pragma unroll
                for (int j = 0; j < 4; ++j) y[j] = oacc[tti][vt][j] * rstd * gw[j] * (r[j] * __builtin_amdgcn_rcpf(1.0f + __builtin_amdgcn_exp2f(r[j] * -1.4426950409f)));
                if (OUTPROJ_F8) *(LAS unsigned*)(st + i * 144 + v) = pk4_fp8(y[0], y[1], y[2], y[3]);
                else { v2u w; w.x = pk2(y[0], y[1]); w.y = pk2(y[2], y[3]);
                    *(LAS v2u*)(st + i * 272 + v * 2) = w; }
                if ((vt & 3) == 3) asm volatile("" ::: "memory"); }
            LDS_WAIT();
            if (OUTPROJ_F8) {
#pragma unroll
                for (int j = 0; j < 2; ++j) { const int pc = lane + 64 * j, row = pc >> 3, ch = pc & 7;
                    *(v4u*)(F.ws + WS_YMIX + (prow + (2 * half + tti) * 16 + row) * D + h * 128 + ch * 16) = *(const LAS v4u*)(st + row * 144 + ch * 16); } }
            else {
#pragma unroll
                for (int j = 0; j < 4; ++j) { const int pc = lane + 64 * j, row = pc >> 4, ch = pc & 15;
                    *(v4u*)(((bf16*)(F.ws + WS_YMIX)) + (prow + (2 * half + tti) * 16 + row) * D + h * 128 + ch * 8) = *(const LAS v4u*)(st + row * 272 + ch * 16); } }
            LDS_WAIT(); }
#pragma unroll
        for (int q = 0; q < 9; ++q) asm volatile("" :: "v"(pfv[q]));
        LDS_BARRIER();
    }
    if (MODE < 1 && CONV_AT == 5) { int tc_ = F.tid; asm volatile("" : "+v"(tc_)); conv_stream(F, A, tc_); }
}

__device__ __forceinline__ void p4_phase(const Frame& F, CArgs* A) {
    int tid_ = threadIdx.x; asm volatile("" : "+v"(tid_));
    const int tid = tid_;
    for (int idx = F.bid * NTHREADS + tid; idx < 2 * NBATCH * 4 * 1024; idx += F.G * NTHREADS) {
        const int e8 = idx & 1023, ch = idx >> 10, h = ch & 3, b = (ch >> 2) & 15, dir = ch >> 6; const int d0 = (e8 & 7) * 8;
        float s[8];
#pragma unroll
        for (int j = 0; j < 8; ++j) s[j] = 0.f;
#pragma unroll 17
        for (int st = 0; st < NCC; ++st) {
            const int cc = dir ? (st < 4 ? 3 - st : 71 - st) : st;
            const size_t ci = ((size_t)dir * NBATCH + b) * NCC + cc;
            const v4u kv = *(const v4u*)(((bf16*)(F.ws + WS_KV)) + (ci * 4 + h) * 8192 + (size_t)e8 * 8);
            const f32x4 dc0 = *(const f32x4*)(((float*)(F.ws + WS_DECAY)) + ci * 256 + h * 64 + d0), dc1 = *(const f32x4*)(((float*)(F.ws + WS_DECAY)) + ci * 256 + h * 64 + d0 + 4);
            if (cc >= 4) { v4u w; w.x = pk2(s[0], s[1]); w.y = pk2(s[2], s[3]); w.z = pk2(s[4], s[5]); w.w = pk2(s[6], s[7]);
                *(v4u*)(((bf16*)(F.ws + WS_S)) + ((((size_t)dir * NBATCH + b) * 64 + (cc - 4)) * 4 + h) * 8192 + (size_t)e8 * 8) = w; }
            s[0] = s[0] * dc0[0] + bflo(kv.x); s[1] = s[1] * dc0[1] + bfhi(kv.x); s[2] = s[2] * dc0[2] + bflo(kv.y); s[3] = s[3] * dc0[3] + bfhi(kv.y);
            s[4] = s[4] * dc1[0] + bflo(kv.z); s[5] = s[5] * dc1[1] + bfhi(kv.z); s[6] = s[6] * dc1[2] + bflo(kv.w); s[7] = s[7] * dc1[3] + bfhi(kv.w);
        }
    }
}


constexpr int RT_W = 0;
constexpr int RT_LG = 32 * 1032 * 2;
constexpr int RT_HIST = RT_LG + 128 * 33 * 4;
constexpr int RT_WC = RT_HIST + 256;
__device__ __forceinline__ void p5c_phase(const Frame& F, CArgs* A) {
    LAS unsigned char* lds = F.lds; const int tid = F.tid, lane = F.lane, wave = F.wave, i = lane & 15, g = lane >> 4;
#pragma unroll 1
    for (int i0 = 0; i0 < 32768; i0 += 16 * NTHREADS) { float rv[16];
#pragma unroll
        for (int q = 0; q < 16; ++q) rv[q] = A->in[16][i0 + q * NTHREADS + tid];
#pragma unroll
        for (int q = 0; q < 16; ++q) { const int idx = i0 + q * NTHREADS + tid, k = idx >> 5, e = idx & 31; *(LAS bf16*)(lds + RT_W + (e * 1032 + k) * 2) = (bf16)f2bf(rv[q]); } }
    LAS int* hist = (LAS int*)(lds + RT_HIST); LAS float* lg = (LAS float*)(lds + RT_LG);
    unsigned* gcnt = ((unsigned*)(F.ws + WS_CTL)) + CW_CNT;
    __syncthreads();
#pragma unroll 1
    for (int it = F.bid; it < NLAT / 128; it += F.G) {
        const int R = it * 128 + wave * 16 + i, b = it >> 5;
        const bf16* yg = ((const bf16*)(F.ws + WS_Y1)) + (size_t)R * D + 8 * g;
        unsigned char* hn2g = (unsigned char*)F.out + DO_HN2 + (size_t)R * D + 32 * (g & 1) + 16 * (g >> 1);
        v2u w8p = {0u, 0u};
        const LAS unsigned char* rw0 = lds + RT_W + (i * 1032 + 8 * g) * 2; const LAS unsigned char* rw1 = rw0 + 16 * 1032 * 2;
        if (tid < 32) hist[tid] = 0;
        { const int c0 = 2 * tid; const f32x2 w_ = *(const f32x2*)(A->in[15] + c0), c_ = *(const f32x2*)(((float*)(F.ws + WS_MOD)) + (size_t)b * 6144 + 4096 + c0), s_ = *(const f32x2*)(((float*)(F.ws + WS_MOD)) + (size_t)b * 6144 + 3072 + c0);
          *(LAS f32x2*)(lds + RT_WC + c0 * 4) = w_ * (c_ + 1.0f); *(LAS f32x2*)(lds + RT_WC + 4096 + c0 * 4) = s_; }
        v4u yv[32];
#pragma unroll
        for (int ks = 0; ks < 32; ++ks) yv[ks] = *(const v4u*)(yg + 32 * ks);
        float ss = 0.f;
#pragma unroll
        for (int ks = 0; ks < 32; ++ks) { const v4u yw = yv[ks];
            const float h0 = bflo(yw.x), h1 = bfhi(yw.x), h2 = bflo(yw.y), h3 = bfhi(yw.y), h4 = bflo(yw.z), h5 = bfhi(yw.z), h6 = bflo(yw.w), h7 = bfhi(yw.w);
            ss += (h0 * h0 + h1 * h1) + (h2 * h2 + h3 * h3) + (h4 * h4 + h5 * h5) + (h6 * h6 + h7 * h7); }
        ss += __shfl_xor(ss, 16); ss += __shfl_xor(ss, 32);
        const float rstd = 1.0f / sqrtf(ss * (1.f / D) + EPS);
#pragma unroll
        for (int ks = 0; ks < 32; ++ks) asm volatile("" : "+v"(yv[ks]));
        LDS_BARRIER();
        f32x4 l0 = {0.f, 0.f, 0.f, 0.f}, l1 = {0.f, 0.f, 0.f, 0.f};
        const LAS unsigned char* wcg = lds + RT_WC + 32 * g;
#pragma unroll
        for (int ks = 0; ks < 32; ++ks) {
            const v4u yw = yv[ks];
            const f32x4 a0 = {bflo(yw.x), bfhi(yw.x), bflo(yw.y), bfhi(yw.y)}, a1 = {bflo(yw.z), bfhi(yw.z), bflo(yw.w), bfhi(yw.w)};
            const f32x4 c0 = *(const LAS f32x4*)(wcg + 128 * ks), c1 = *(const LAS f32x4*)(wcg + 128 * ks + 16), s0 = *(const LAS f32x4*)(wcg + 4096 + 128 * ks), s1 = *(const LAS f32x4*)(wcg + 4096 + 128 * ks + 16);
            const f32x4 y0 = (a0 * rstd) * c0 + s0, y1 = (a1 * rstd) * c1 + s1;
            v4u w; w.x = pk2(y0[0], y0[1]); w.y = pk2(y0[2], y0[3]); w.z = pk2(y1[0], y1[1]); w.w = pk2(y1[2], y1[3]);
            { v2u w8; w8.x = pk4_fp8(y0[0], y0[1], y0[2], y0[3]); w8.y = pk4_fp8(y1[0], y1[1], y1[2], y1[3]);
              if (ks & 1) { const v4u ww = widen16(w8p, w8); *(v4u*)(hn2g + 32 * (ks - 1)) = ww; }
              w8p = w8; }
            const bf16x8 af = __builtin_bit_cast(bf16x8, w);
            const bf16x8 r0 = *(const LAS bf16x8*)(rw0 + 64 * ks), r1 = *(const LAS bf16x8*)(rw1 + 64 * ks);
            l0 = __builtin_amdgcn_mfma_f32_16x16x32_bf16(af, r0, l0, 0, 0, 0); l1 = __builtin_amdgcn_mfma_f32_16x16x32_bf16(af, r1, l1, 0, 0, 0);
            asm volatile("" : "+v"(l0), "+v"(l1) :: "memory"); }
        { const float rb0 = A->in[17][i], rb1 = A->in[17][16 + i];
#pragma unroll
          for (int r = 0; r < 4; ++r) { lg[(wave * 16 + 4 * g + r) * 33 + i] = l0[r] + rb0; lg[(wave * 16 + 4 * g + r) * 33 + 16 + i] = l1[r] + rb1; } }
        __syncthreads();
        int te[4] = {0, 0, 0, 0}; float tv[4] = {-3.0e38f, -3.0e38f, -3.0e38f, -3.0e38f}; int lp[4] = {0, 0, 0, 0};
        if (lane < 16) { const LAS float* lr = lg + (wave * 16 + lane) * 33;
            for (int e = 0; e < 32; ++e) { const float x = lr[e];
                if (x > tv[3]) { if (x > tv[2]) { tv[3] = tv[2]; te[3] = te[2]; if (x > tv[1]) { tv[2] = tv[1]; te[2] = te[1]; if (x > tv[0]) { tv[1] = tv[0]; te[1] = te[0]; tv[0] = x; te[0] = e; } else { tv[1] = x; te[1] = e; } } else { tv[2] = x; te[2] = e; } } else { tv[3] = x; te[3] = e; } } }
            const float e1 = __expf(tv[1] - tv[0]), e2 = __expf(tv[2] - tv[0]), e3 = __expf(tv[3] - tv[0]), inv = 1.0f / (1.0f + e1 + e2 + e3);
            tv[0] = inv; tv[1] = e1 * inv; tv[2] = e2 * inv; tv[3] = e3 * inv;
#pragma unroll
            for (int k = 0; k < 4; ++k) lp[k] = __hip_atomic_fetch_add(&hist[te[k]], 1, __ATOMIC_RELAXED, __HIP_MEMORY_SCOPE_WORKGROUP); }
        __syncthreads();
        if (tid < 32) { const int c = hist[tid]; hist[32 + tid] = c ? (int)__hip_atomic_fetch_add(gcnt + tid, (unsigned)c, RLX_AGENT) : 0; }
        __syncthreads();
        if (lane < 16) { const int Rt = it * 128 + wave * 16 + lane;
#pragma unroll
            for (int k = 0; k < 4; ++k) { const size_t pos = (size_t)te[k] * LISTCAP + hist[32 + te[k]] + lp[k]; ((int*)((unsigned char*)F.out + DO_LAID))[pos] = Rt * 4 + k;
                ((int*)(F.ws + WS_TSLOT))[Rt * 4 + k] = (te[k] << 20) | (hist[32 + te[k]] + lp[k]); ((float*)(F.ws + WS_TW))[Rt * 4 + k] = tv[k]; } }
        __syncthreads();
    }
}

constexpr int P8NR = 1;
struct P8Slots { int ep[P8NR][4]; float wk[P8NR][4]; };
struct P8Rows { int yw8[P8NR][4][4]; v2u hw[P8NR][4]; float wk[P8NR][4]; f32x4 g2v[4]; };
__device__ __forceinline__ int p8_row(int gw, int NGW, int k, int a) { const int r = P8NR * (gw + k * NGW) + a; return r < NLAT ? r : P8NR * gw + a; }
__device__ __forceinline__ void p8_slots(const Frame& F, int gw, int NGW, int k, P8Slots& S) {
#pragma unroll
    for (int a = 0; a < P8NR; ++a) { const int r = p8_row(gw, NGW, k, a);
#pragma unroll
        for (int q = 0; q < 4; ++q) { S.ep[a][q] = ((const int*)(F.ws + WS_TSLOT))[r * 4 + q]; S.wk[a][q] = ((const float*)(F.ws + WS_TW))[r * 4 + q]; } }
}
__device__ __forceinline__ void p8_rows(const Frame& F, const LAS int* TS, int lane, int gw, int NGW, int k, const P8Slots& S, P8Rows& R) {
#pragma unroll
    for (int a = 0; a < P8NR; ++a) { const int r = p8_row(gw, NGW, k, a); const bf16* yr = ((const bf16*)(F.ws + WS_Y1)) + (size_t)r * D;
#pragma unroll
        for (int q = 0; q < 4; ++q) { const int* ys = (const int*)((const unsigned char*)(F.ws + WS_YA) + ((size_t)TS[S.ep[a][q] >> 20] * 256 + (S.ep[a][q] & 0xFFFFF)) * D); R.wk[a][q] = S.wk[a][q];
#pragma unroll
            for (int j = 0; j < 4; ++j) R.yw8[a][q][j] = ys[lane + 64 * j]; }
#pragma unroll
        for (int j = 0; j < 4; ++j) R.hw[a][j] = ((const v2u*)yr)[lane + 64 * j]; }
    { const float* g2 = ((float*)(F.ws + WS_MOD)) + (size_t)(p8_row(gw, NGW, k, 0) >> 12) * 6144 + 5120;
#pragma unroll
      for (int j = 0; j < 4; ++j) R.g2v[j] = ((const f32x4*)g2)[lane + 64 * j]; }
}
__device__ __forceinline__ void p8_pin(P8Rows& R) {
    asm volatile("" ::: "memory");
#pragma unroll
    for (int a = 0; a < P8NR; ++a) {
#pragma unroll
        for (int q = 0; q < 4; ++q) { asm volatile("" : "+v"(R.wk[a][q]));
#pragma unroll
            for (int j = 0; j < 4; ++j) asm volatile("" : "+v"(R.yw8[a][q][j])); }
#pragma unroll
        for (int j = 0; j < 4; ++j) asm volatile("" : "+v"(R.hw[a][j])); }
#pragma unroll
    for (int j = 0; j < 4; ++j) asm volatile("" : "+v"(R.g2v[j]));
}
__device__ __forceinline__ void p8_emit(const Frame& F, const f32x4 (&fw)[4], int lane, int gw, int NGW, int k, const P8Rows& R) {
#pragma unroll
    for (int a = 0; a < P8NR; ++a) { const int r = p8_row(gw, NGW, k, a); float* hr = F.out + (size_t)r * D;
        f32x4 v[4]; float s = 0.f;
#pragma unroll
        for (int j = 0; j < 4; ++j) { const int c4 = lane + 64 * j; f32x4 y = {0.f, 0.f, 0.f, 0.f};
#pragma unroll
            for (int q = 0; q < 4; ++q) { const int w = R.yw8[a][q][j]; const f32x2 lo = __builtin_amdgcn_cvt_pk_f32_fp8(w, false), hi = __builtin_amdgcn_cvt_pk_f32_fp8(w, true);
                y[0] += R.wk[a][q] * lo[0]; y[1] += R.wk[a][q] * lo[1]; y[2] += R.wk[a][q] * hi[0]; y[3] += R.wk[a][q] * hi[1]; }
            const v2u yw = R.hw[a][j]; const f32x4 y1 = {bflo(yw.x), bfhi(yw.x), bflo(yw.y), bfhi(yw.y)};
            v[j] = y1 + R.g2v[j] * y;
            s += (v[j].x * v[j].x + v[j].y * v[j].y) + (v[j].z * v[j].z + v[j].w * v[j].w); }
        const float rstd = 1.0f / sqrtf(wave_sum(s) * (1.f / D) + EPS);
#pragma unroll
        for (int j = 0; j < 4; ++j) { const int c4 = lane + 64 * j; ((f32x4*)hr)[c4] = (v[j] * rstd) * fw[j]; } }
}
__device__ __forceinline__ void p8_phase(const Frame& F, CArgs* A, const LAS int* TS) {
    int tid_ = threadIdx.x; asm volatile("" : "+v"(tid_));
    const int lane = tid_ & 63;
    const int gw = F.bid * NWAVES + F.wave, NGW = F.G * NWAVES;
    if (P8NR * gw >= NLAT) return;
    const int K = (NLAT / P8NR - gw + NGW - 1) / NGW;
    f32x4 fw[4];
#pragma unroll
    for (int j = 0; j < 4; ++j) fw[j] = ((const f32x4*)A->in[22])[lane + 64 * j];
    P8Slots Sa, Sb; P8Rows Ra, Rb;
    p8_slots(F, gw, NGW, 0, Sa); p8_rows(F, TS, lane, gw, NGW, 0, Sa, Ra); p8_slots(F, gw, NGW, 1, Sb);
#pragma unroll 1
    for (int k = 0; k < K; k += 2) {
        int l_ = threadIdx.x; asm volatile("" : "+v"(l_)); l_ &= 63;
        p8_slots(F, gw, NGW, k + 2, Sa); p8_rows(F, TS, l_, gw, NGW, k + 1, Sb, Rb); p8_pin(Ra);
        p8_emit(F, fw, l_, gw, NGW, k, Ra);
        p8_slots(F, gw, NGW, k + 3, Sb); p8_rows(F, TS, l_, gw, NGW, k + 2, Sa, Ra); p8_pin(Rb);
        p8_emit(F, fw, l_, gw, NGW, k + 1, Rb);
    }
}

constexpr int NPHASES = 11;
__global__ void __launch_bounds__(NTHREADS, 2) fwd_kernel(Args args) {
    extern __shared__ __attribute__((aligned(16))) unsigned char lds_raw[];
    Frame F;
    F.lds = (LAS unsigned char*)lds_raw;
    F.tid = threadIdx.x; F.lane = F.tid & 63; F.wave = __builtin_amdgcn_readfirstlane(F.tid >> 6); F.G = gridDim.x; F.bid = blockIdx.x;
    F.out = args.out; F.ws = args.ws;
        for (int u = F.tid; u < (LDS_BYTES - MISC_OFF) / 4; u += NTHREADS) ((LAS unsigned*)(F.lds + MISC_OFF))[u] = 0u;
    __syncthreads();
    volatile LAS unsigned* MISC = (volatile LAS unsigned*)(F.lds + MISC_OFF);
    LAS int* TS = (LAS int*)(F.lds + MISC_OFF + 256);
    const int lo = args.ph_lo, hi = args.ph_hi;
    const bool multi = (hi - lo) > 1;
    XcdBarrier bar; bar.bar = (unsigned*)((unsigned*)(F.ws + WS_CTL)) + CW_BAR; bar.x = 0; bar.st = nullptr;
    if (multi) bar = xcd_barrier_post((unsigned*)((unsigned*)(F.ws + WS_CTL)) + CW_BAR, MISC + 8);
#ifndef PHMASK
#define PHMASK 0x7ff
#endif
#define IN(k) (((PHMASK >> (k)) & 1) && lo <= (k) && (k) < hi)
#define BUILD_TS() do { if (F.tid < NEXP) TS[33 + F.tid] = (int)__hip_atomic_load(((unsigned*)(F.ws + WS_CTL)) + CW_CNT + F.tid, RLX_AGENT);     \
        __syncthreads(); \
        if (F.tid == 0) { int acc_ = 0; for (int e = 0; e < NEXP; ++e) { TS[e] = acc_; acc_ += (TS[33 + e] + 255) >> 8; } TS[32] = acc_; } __syncthreads(); \
        for (int t_ = F.tid; t_ < TS[32]; t_ += NTHREADS) { int e_ = 0; for (int k_ = 1; k_ < NEXP; ++k_) e_ = (TS[k_] <= t_) ? k_ : e_; ((LAS unsigned char*)(TS + 72))[t_] = (unsigned char)e_; } \
        __syncthreads(); } while (0)
#define SEAM(k) do { if (IN(k) && IN((k) + 1)) xcd_barrier(bar); } while (0)
#ifndef PROBE_DUP
#define PROBE_DUP 0
#endif
#define REPS(k) for (int rep_ = 0; rep_ < (((PROBE_DUP >> (k)) & 1) ? 2 : 1); ++rep_)

    if (IN(0)) REPS(0) { p0_phase(F, opaque_args()); } SEAM(0);
    if (IN(1)) REPS(1) { p1_phase(F, opaque_args()); } SEAM(1);
    if (IN(2)) REPS(2) { DenseSched S; S.init(NROWS, PWP, F.G, F.bid, ((bf16*)(F.ws + WS_WIN))); S.build((LAS int*)(TS + 400), F.tid); EpiProj E{((bf16*)(F.ws + WS_P))};
        pg8::gemm_phase<EpiProj, DenseSched, true, false>(F.lds, (const char*)((bf16*)(F.ws + WS_HN)), S, E);
#ifdef PROBE_INNULL
        { EpiNull E0; pg8::gemm_phase<EpiNull, DenseSched, true, false>(F.lds, (const char*)((bf16*)(F.ws + WS_HN)), S, E0); }
#endif
    } SEAM(2);
    if (IN(3)) {
        if (CONV_AT == 3) { int tc_ = F.tid; asm volatile("" : "+v"(tc_)); conv_stream(F, opaque_args(), tc_); }
        p3v3_phase<0>(F, opaque_args());
#ifdef PROBE_P3
        p3v3_phase<PROBE_P3>(F, opaque_args());
#endif
    } SEAM(3);
    if (IN(4)) REPS(4) { p4_phase(F, opaque_args()); } SEAM(4);
    if (IN(5)) {
#ifdef PROBE_P5
        p5av3_phase<0>(F, opaque_args()); p5av3_phase<PROBE_P5>(F, opaque_args());
#else
        p5av3_phase<0>(F, opaque_args());
#endif
    } SEAM(5);
    if (IN(6)) REPS(6) { DenseSched S; S.init(NLAT, D, F.G, F.bid, ((bf16*)(F.ws + WS_WOUT))); S.kb = OUTPROJ_F8 ? 1024 : 2048; S.build((LAS int*)(TS + 400), F.tid); EpiOut E{opaque_args()->in[0], ((float*)(F.ws + WS_MOD)), ((bf16*)(F.ws + WS_Y1)), OUTPROJ_F8 ? 1.0f / WSCALE : 1.0f};
        pg8::gemm_phase<EpiOut, DenseSched, true, OUTPROJ_F8 != 0>(F.lds, (const char*)((bf16*)(F.ws + WS_YMIX)), S, E); } SEAM(6);
    if (IN(7)) { p5c_phase(F, opaque_args()); } SEAM(7);
    bool ts_built = false;
#pragma unroll 1
    for (int ph = 8; ph < 10; ++ph) {
        if (IN(ph)) {
            const bool gu = (ph == 8);
            if (!ts_built) { BUILD_TS(); ts_built = multi; }
            const int ntr = TS[32];
            REPS(ph) {
                if (gu) { MoeSched<true> S; S.TS = TS; S.ntr = ntr; S.G = F.G; S.c = F.bid; S.laid = ((int*)((unsigned char*)F.out + DO_LAID)); S.W = (const char*)F.out + DO_WGU;
                    EpiGU E{(unsigned char*)(F.ws + WS_ACT), opaque_args()->in[19]}; pg8::gemm_phase<EpiGU, MoeSched<true>, true, true>(F.lds, (const char*)((unsigned char*)F.out + DO_HN2), S, E);
#ifdef PROBE_GUNULL
                    { EpiNull E0; pg8::gemm_phase<EpiNull, MoeSched<true>, true, true>(F.lds, (const char*)((unsigned char*)F.out + DO_HN2), S, E0); }
#endif
                }
                else { MoeSched<false> S; S.TS = TS; S.ntr = ntr; S.G = F.G; S.c = F.bid; S.laid = nullptr; S.W = (const char*)F.out + DO_WDN;
                    EpiDN E{(unsigned char*)(F.ws + WS_YA), opaque_args()->in[21], TS}; pg8::gemm_phase<EpiDN, MoeSched<false>, true, true>(F.lds, (const char*)(F.ws + WS_ACT), S, E); }
            }
        }
        SEAM(ph);
    }
    if (IN(10)) { if (!ts_built) { BUILD_TS(); } p8_phase(F, opaque_args(), TS); }
#undef IN
#undef SEAM
}

extern "C" void kernel_launch(void* const* d_in, const int* in_sizes, int n_in, void* d_out, int out_size, void* d_ws, size_t ws_size, hipStream_t stream) {
    static int grid = 0;
    if (grid == 0) {
        if (n_in != 23 || in_sizes[0] != NLAT * D || out_size != NLAT * D || ws_size < WS_TOTAL) {
            fprintf(stderr, "kernel_launch: unexpected shapes: n_in %d, in0 %d, out %d, ws %zu (need %zu); nothing launched\n", n_in, n_in > 0 ? in_sizes[0] : -1, out_size, ws_size, (size_t)WS_TOTAL); grid = -1; return; }
        int dev = 0, cus = 0, per_cu = 0;
        if (hipGetDevice(&dev) != hipSuccess || hipDeviceGetAttribute(&cus, hipDeviceAttributeMultiprocessorCount, dev) != hipSuccess) { fprintf(stderr, "kernel_launch: device query failed\n"); grid = -1; return; }
        if (hipFuncSetAttribute((const void*)fwd_kernel, hipFuncAttributeMaxDynamicSharedMemorySize, LDS_BYTES) != hipSuccess) { fprintf(stderr, "kernel_launch: hipFuncSetAttribute failed\n"); grid = -1; return; }
        if (hipOccupancyMaxActiveBlocksPerMultiprocessor(&per_cu, (const void*)fwd_kernel, NTHREADS, LDS_BYTES) != hipSuccess || per_cu < 1) {
            fprintf(stderr, "kernel_launch: occupancy query reports %d workgroups per CU; nothing launched\n", per_cu); (void)hipGetLastError(); grid = -1; return; }
        grid = cus;
        if (grid > 256) grid = 256;
    }
    if (grid < 0) return;
    if (hipMemsetAsync((char*)d_ws + WS_CTL, 0, CTL_ZERO_BYTES, stream) != hipSuccess) { fprintf(stderr, "kernel_launch: hipMemsetAsync failed\n"); return; }
    Args a{};
    for (int i = 0; i < 23; ++i) a.in[i] = (const float*)d_in[i];
    a.out = (float*)d_out; a.ws = (unsigned char*)d_ws;
#if MK_N_LAUNCHES == 1
    a.ph_lo = 0; a.ph_hi = NPHASES;
    hipLaunchKernelGGL(fwd_kernel, dim3(grid), dim3(NTHREADS), LDS_BYTES, stream, a);
#else
    for (int p = 0; p < NPHASES; ++p) { a.ph_lo = p; a.ph_hi = p + 1; hipLaunchKernelGGL(fwd_kernel, dim3(grid), dim3(NTHREADS), LDS_BYTES, stream, a); }
#endif
    const hipError_t le = hipPeekAtLastError();
    if (le != hipSuccess) fprintf(stderr, "kernel_launch: launch failed: %s\n", hipGetErrorName(le));
}
```
